# Optimizing an MI355X kernel written in HIP

```python
import math
import jax
import jax.numpy as jnp
from jax import lax
import numpy as np

D_MODEL = 1024
BATCH = 2
SEQ = 8192
DEPTH = 2

GRID_W = 64
CTX_LEN = 256
EPS = 1e-6
ROPE_BASE = 10000.0
BLOCK = 128
MOD_CHUNKS = 6

MLA_HEADS = 8
MLA_NOPE = 64
MLA_ROPE = 32
MLA_V = 64
MLA_Q_RANK = 256
MLA_KV_RANK = 128

LRU_WIDTH = 512
LRU_BLOCKS = 8
LRU_CONV = 4
LRU_C = 8.0

HY_WIDTH = 512
HY_CONV = 3
HY_EMB = 33
HY_BANDS = (HY_EMB - 1) // 2
HY_FFN = 64
HY_TARGET = 1e-2
HY_FAST_DECAY = 0.3
HY_SLOW_DECAY = 1.5

GQA_HEADS = 8
GQA_KV_HEADS = 2
GQA_DIM = 64
WINDOW = 128

N_BRANCH = 4
BRANCH_WIDTH = 512

PEER_HEADS = 8
PEER_NKEYS = 128
PEER_EXPERTS = PEER_NKEYS * PEER_NKEYS
PEER_DKEY = 128
PEER_TOPK = 16
PEER_TOKEN_BLOCK = 128

IN_SIZES = (MLA_Q_RANK, MLA_KV_RANK, MLA_ROPE, LRU_WIDTH, LRU_WIDTH, 3 * HY_WIDTH,
            GQA_HEADS * GQA_DIM, 2 * GQA_KV_HEADS * GQA_DIM, N_BRANCH * D_MODEL)
IN_COLS = sum(IN_SIZES)
IN_SPLITS = tuple(sum(IN_SIZES[:i + 1]) for i in range(len(IN_SIZES) - 1))

kernel_name = 'hybrid_latent_diffusion_block'


def rmsnorm(x, g):
    xf = x.astype(jnp.float32)
    y = xf * lax.rsqrt(jnp.mean(xf * xf, axis=-1, keepdims=True) + EPS)
    return (y * g.astype(jnp.float32)).astype(x.dtype)


def modulate(xn, shift, scale):
    return xn * (1.0 + scale) + shift


def axial_rope(x, row, col):
    d = x.shape[-1]
    half = d // 2
    nf = half // 2
    inv = ROPE_BASE ** (-jnp.arange(nf, dtype=jnp.float32) / nf)
    xf = x.astype(jnp.float32)

    def rot(xa, pos):
        ang = pos.astype(jnp.float32)[:, None] * inv[None, :]
        cos = jnp.cos(ang)[None, :, None, :]
        sin = jnp.sin(ang)[None, :, None, :]
        x1, x2 = xa[..., :nf], xa[..., nf:]
        return jnp.concatenate([x1 * cos - x2 * sin, x1 * sin + x2 * cos], axis=-1)

    out = jnp.concatenate([rot(xf[..., :half], row), rot(xf[..., half:], col)], axis=-1)
    return out.astype(x.dtype)


def short_conv(x, w, b):
    K = w.shape[0]
    L = x.shape[1]
    lo = (K - 1) // 2
    hi = K - 1 - lo
    xp = jnp.pad(x, ((0, 0), (lo, hi), (0, 0)))
    y = xp[:, 0:L] * w[0]
    for k in range(1, K):
        y = y + xp[:, k:k + L] * w[k]
    return y + b


def mla_queries(cq, g_cq, w_uq, row, col):
    B, L, _ = cq.shape
    q = (rmsnorm(cq, g_cq) @ w_uq).reshape(B, L, MLA_HEADS, MLA_NOPE + MLA_ROPE)
    qn, qr = q[..., :MLA_NOPE], q[..., MLA_NOPE:]
    if row is not None:
        qr = axial_rope(qr, row, col)
    return qn, qr


def mla_keys(ckv, kr, g_ckv, w_ukv, row, col):
    B, L, _ = ckv.shape
    kv = (rmsnorm(ckv, g_ckv) @ w_ukv).reshape(B, L, MLA_HEADS, MLA_NOPE + MLA_V)
    kn, v = kv[..., :MLA_NOPE], kv[..., MLA_NOPE:]
    if row is not None:
        kr = axial_rope(kr[:, :, None, :], row, col)[:, :, 0, :]
    return kn, kr, v


def mla_attend(qn, qr, kn, kr, v):
    B, Lq, H, dn = qn.shape
    nb = Lq // BLOCK
    scale = 1.0 / math.sqrt(dn + qr.shape[-1])

    def to_blocks(t):
        return t.reshape(B, nb, BLOCK, *t.shape[2:]).swapaxes(0, 1)

    def one_block(args):
        qn_b, qr_b = args
        s = (jnp.einsum('bqhd,bkhd->bhqk', qn_b, kn)
             + jnp.einsum('bqhr,bkr->bhqk', qr_b, kr))
        p = jax.nn.softmax(s.astype(jnp.float32) * scale, axis=-1).astype(v.dtype)
        return jnp.einsum('bhqk,bkhd->bqhd', p, v)

    o = lax.map(one_block, (to_blocks(qn), to_blocks(qr)))
    return o.swapaxes(0, 1).reshape(B, Lq, H * v.shape[-1])


def block_diag(x, w, b):
    B, L, C = x.shape
    nblk = w.shape[0]
    y = jnp.einsum('blhi,hij->blhj', x.reshape(B, L, nblk, C // nblk), w).reshape(B, L, C)
    return y + b


def rglru_coeffs(xc, w_r, b_r, w_i, b_i, lam):
    r = jax.nn.sigmoid(block_diag(xc, w_r, b_r).astype(jnp.float32))
    i = jax.nn.sigmoid(block_diag(xc, w_i, b_i).astype(jnp.float32))
    log_a = -LRU_C * r * jax.nn.softplus(-lam.astype(jnp.float32))
    a = jnp.exp(log_a)
    bterm = jnp.sqrt(-jnp.expm1(2.0 * log_a)) * i * xc.astype(jnp.float32)
    return a, bterm


def linear_scan(a, b, h0, reverse):
    def combine(e1, e2):
        a1, b1 = e1
        a2, b2 = e2
        return a1 * a2, a2 * b1 + b2

    A, Bc = lax.associative_scan(combine, (a, b), reverse=reverse, axis=1)
    return A * h0[:, None, :] + Bc


def rglru_branch(lx, lg, lxc, lgc, conv_w, conv_b, w_r, b_r, w_i, b_i, lam, ctx_out):
    xl = short_conv(lx, conv_w, conv_b)
    xc = short_conv(lxc, conv_w, conv_b)
    B, _, C = xl.shape
    zero = jnp.zeros((B, C), jnp.float32)
    hl_dirs = []
    hc_dirs = []
    for d, rev in enumerate((False, True)):
        ac, bc = rglru_coeffs(xc, w_r[d], b_r[d], w_i[d], b_i[d], lam[d])
        hc = linear_scan(ac, bc, zero, rev)
        h_last = hc[:, 0] if rev else hc[:, -1]
        al, bl = rglru_coeffs(xl, w_r[d], b_r[d], w_i[d], b_i[d], lam[d])
        hl_dirs.append(linear_scan(al, bl, h_last, rev))
        hc_dirs.append(hc)
    y = jax.nn.gelu(lg) * (hl_dirs[0] + hl_dirs[1]).astype(lg.dtype)
    yc = jax.nn.gelu(lgc) * (hc_dirs[0] + hc_dirs[1]).astype(lgc.dtype) if ctx_out else None
    return y, yc


def hyena_filters(L, w1, b1, f1, w2, b2, f2, w3):
    t = jnp.linspace(0.0, 1.0, L, dtype=jnp.float32)[:, None]
    bands = jnp.linspace(1e-4, HY_BANDS - 1, HY_BANDS, dtype=jnp.float32)[None, :]
    w = 2.0 * math.pi * jnp.arange(L, dtype=jnp.float32)[:, None] / L
    z = jnp.concatenate([t, jnp.cos(bands * w), -jnp.sin(bands * w)], axis=-1)
    hdn = jnp.sin(f1 * (z @ w1 + b1))
    hdn = jnp.sin(f2 * (hdn @ w2 + b2))
    filt = (hdn @ w3).astype(jnp.float32)
    max_decay = math.log(HY_TARGET) / HY_FAST_DECAY
    min_decay = math.log(HY_TARGET) / HY_SLOW_DECAY
    deltas = jnp.linspace(min_decay, max_decay, filt.shape[-1], dtype=jnp.float32)
    filt = filt * jnp.exp(-t * jnp.abs(deltas)[None, :])
    filt = filt.reshape(L, 2, HY_WIDTH)
    return filt * lax.rsqrt(jnp.sum(filt * filt, axis=(0, 1), keepdims=True) + EPS)


def long_conv(u, filt):
    B, L, C = u.shape
    h2 = jnp.concatenate([filt[:, 0], jnp.zeros((1, C), jnp.float32), filt[:0:-1, 1]], axis=0)
    Hf = jnp.fft.rfft(h2, n=2 * L, axis=0)
    Uf = jnp.fft.rfft(u.astype(jnp.float32), n=2 * L, axis=1)
    y = jnp.fft.irfft(Uf * Hf[None], n=2 * L, axis=1)[:, :L]
    return y.astype(u.dtype)


def hyena_branch(hu, conv_w, conv_b, w1, b1, f1, w2, b2, f2, w3, skip):
    L = hu.shape[1]
    u = short_conv(hu, conv_w, conv_b)
    x0, x1, v = jnp.split(u, 3, axis=-1)
    filt = hyena_filters(L, w1, b1, f1, w2, b2, f2, w3)
    z = x1 * v
    y = long_conv(z, filt) + skip * z
    return x0 * y


def gqa_window_attend(q, k, v, kc, vc, sink):
    B, N, H, d = q.shape
    KH = k.shape[2]
    G = H // KH
    Lc = kc.shape[1]
    nb = N // BLOCK
    W = 3 * BLOCK
    scale = d ** -0.5
    qb = q.reshape(B, nb, BLOCK, KH, G, d)
    pad = ((0, 0), (BLOCK, BLOCK), (0, 0), (0, 0))
    kp = jnp.pad(k, pad).reshape(B, nb + 2, BLOCK, KH, d)
    vp = jnp.pad(v, pad).reshape(B, nb + 2, BLOCK, KH, d)
    kw = jnp.concatenate([kp[:, :-2], kp[:, 1:-1], kp[:, 2:]], axis=2)
    vw = jnp.concatenate([vp[:, :-2], vp[:, 1:-1], vp[:, 2:]], axis=2)
    qpos = jnp.arange(nb)[:, None, None] * BLOCK + jnp.arange(BLOCK)[None, :, None]
    kpos = (jnp.arange(nb)[:, None, None] - 1) * BLOCK + jnp.arange(W)[None, None, :]
    mask = (jnp.abs(kpos - qpos) <= WINDOW) & (kpos >= 0) & (kpos < N)
    s_loc = jnp.einsum('bnqkgd,bnjkd->bnkgqj', qb, kw).astype(jnp.float32) * scale
    s_loc = jnp.where(mask[None, :, None, None], s_loc, -jnp.inf)
    s_ctx = jnp.einsum('bnqkgd,bckd->bnkgqc', qb, kc).astype(jnp.float32) * scale
    s_sink = jnp.broadcast_to(sink.astype(jnp.float32).reshape(1, 1, KH, G, 1, 1),
                              (B, nb, KH, G, BLOCK, 1))
    p = jax.nn.softmax(jnp.concatenate([s_loc, s_ctx, s_sink], axis=-1), axis=-1).astype(v.dtype)
    o = (jnp.einsum('bnkgqj,bnjkd->bnqkgd', p[..., :W], vw)
         + jnp.einsum('bnkgqc,bckd->bnqkgd', p[..., W:W + Lc], vc))
    return o.reshape(B, N, H * d)


def gqa_ctx_attend(qc, kc, vc, sink):
    B, Lc, H, d = qc.shape
    KH = kc.shape[2]
    G = H // KH
    qg = qc.reshape(B, Lc, KH, G, d)
    s = jnp.einsum('bqkgd,bckd->bkgqc', qg, kc).astype(jnp.float32) * (d ** -0.5)
    s_sink = jnp.broadcast_to(sink.astype(jnp.float32).reshape(1, KH, G, 1, 1), (B, KH, G, Lc, 1))
    p = jax.nn.softmax(jnp.concatenate([s, s_sink], axis=-1), axis=-1)[..., :Lc].astype(vc.dtype)
    o = jnp.einsum('bkgqc,bckd->bqkgd', p, vc)
    return o.reshape(B, Lc, H * d)


def merge_branches(outs, gate_logits, w_branch, w_out):
    B, L, _ = gate_logits.shape
    D = gate_logits.shape[-1] // N_BRANCH
    gates = jax.nn.sigmoid(gate_logits.reshape(B, L, N_BRANCH, D))
    m = gates[..., 0, :] * (outs[0] @ w_branch[0])
    for i in range(1, N_BRANCH):
        m = m + gates[..., i, :] * (outs[i] @ w_branch[i])
    return m @ w_out


def token_mixer(h, hc, row, col, p, ctx_out):
    B, N, _ = h.shape
    Lc = hc.shape[1]
    (cq, ckv, kr, lx, lg, hu, gq, gkv, gt) = jnp.split(h @ p['w_in'], IN_SPLITS, axis=-1)
    (cqc, ckvc, krc, lxc, lgc, huc, gqc, gkvc, gtc) = jnp.split(hc @ p['w_in'], IN_SPLITS, axis=-1)

    qn, qr = mla_queries(cq, p['mla_g_cq'], p['mla_w_uq'], row, col)
    kn, kr_r, v_a = mla_keys(ckv, kr, p['mla_g_ckv'], p['mla_w_ukv'], row, col)
    knc, krc_r, vc_a = mla_keys(ckvc, krc, p['mla_g_ckv'], p['mla_w_ukv'], None, None)
    y_a = mla_attend(qn, qr, jnp.concatenate([kn, knc], axis=1),
                     jnp.concatenate([kr_r, krc_r], axis=1), jnp.concatenate([v_a, vc_a], axis=1))

    y_b, y_bc = rglru_branch(lx, lg, lxc, lgc, p['lru_conv_w'], p['lru_conv_b'], p['lru_w_r'],
                             p['lru_b_r'], p['lru_w_i'], p['lru_b_i'], p['lru_lam'], ctx_out)

    hy = (p['hy_conv_w'], p['hy_conv_b'], p['hy_w1'], p['hy_b1'], p['hy_f1'],
          p['hy_w2'], p['hy_b2'], p['hy_f2'], p['hy_w3'], p['hy_skip'])
    y_c = hyena_branch(hu, *hy)

    q_d = axial_rope(gq.reshape(B, N, GQA_HEADS, GQA_DIM), row, col)
    k_d, v_d = jnp.split(gkv.reshape(B, N, 2 * GQA_KV_HEADS, GQA_DIM), 2, axis=2)
    k_d = axial_rope(k_d, row, col)
    kc_d, vc_d = jnp.split(gkvc.reshape(B, Lc, 2 * GQA_KV_HEADS, GQA_DIM), 2, axis=2)
    y_d = gqa_window_attend(q_d, k_d, v_d, kc_d, vc_d, p['gqa_sink'])

    y = merge_branches((y_a, y_b, y_c, y_d), gt, p['w_branch'], p['w_out'])
    if not ctx_out:
        return y, None

    qnc, qrc = mla_queries(cqc, p['mla_g_cq'], p['mla_w_uq'], None, None)
    y_ac = mla_attend(qnc, qrc, knc, krc_r, vc_a)
    y_cc = hyena_branch(huc, *hy)
    y_dc = gqa_ctx_attend(gqc.reshape(B, Lc, GQA_HEADS, GQA_DIM), kc_d, vc_d, p['gqa_sink'])
    yc = merge_branches((y_ac, y_bc, y_cc, y_dc), gtc, p['w_branch'], p['w_out'])
    return y, yc


def peer(h, w_q, keys, u_tab, v_tab):
    B, L, D = h.shape
    T = B * L
    ht = h.reshape(T, D)
    q = (ht @ w_q).reshape(T, PEER_HEADS, 2, PEER_DKEY // 2)
    s = jnp.einsum('thpd,hpkd->thpk', q, keys).astype(jnp.float32)
    s1, i1 = lax.top_k(s[:, :, 0], PEER_TOPK)
    s2, i2 = lax.top_k(s[:, :, 1], PEER_TOPK)
    cand = (s1[..., :, None] + s2[..., None, :]).reshape(T, PEER_HEADS, PEER_TOPK * PEER_TOPK)
    cidx = (i1[..., :, None] * PEER_NKEYS + i2[..., None, :]).reshape(T, PEER_HEADS, PEER_TOPK * PEER_TOPK)
    sc, j = lax.top_k(cand, PEER_TOPK)
    idx = jnp.take_along_axis(cidx, j, axis=-1)
    g = jax.nn.softmax(sc, axis=-1)
    nb = T // PEER_TOKEN_BLOCK

    def one_block(args):
        hb, ib, gb = args
        ue = u_tab[ib]
        act = jax.nn.gelu(jnp.einsum('td,thkd->thk', hb, ue).astype(jnp.float32))
        ve = v_tab[ib]
        return jnp.einsum('thk,thkd->td', (gb * act).astype(hb.dtype), ve)

    out = lax.map(one_block, (ht.reshape(nb, PEER_TOKEN_BLOCK, D),
                              idx.reshape(nb, PEER_TOKEN_BLOCK, PEER_HEADS, PEER_TOPK),
                              g.reshape(nb, PEER_TOKEN_BLOCK, PEER_HEADS, PEER_TOPK)))
    return out.reshape(B, L, D)


def setup_inputs(seed: int = 0) -> dict:
    key = jax.random.key(seed)
    ks = jax.random.split(key, 40)
    f32 = jnp.float32
    D, L = D_MODEL, DEPTH
    bw = LRU_WIDTH // LRU_BLOCKS

    def nrm(i, shape, scale):
        return jax.random.normal(ks[i], shape, f32) * scale

    def gain(i, shape, noise=0.02):
        return 1.0 + noise * jax.random.normal(ks[i], shape, f32)

    a_pow = jax.random.uniform(ks[17], (L, 2, LRU_WIDTH), f32, 0.9, 0.999)
    s_a = a_pow ** (1.0 / LRU_C)
    lam = jnp.log(s_a) - jnp.log1p(-s_a)
    return {
        'x': nrm(0, (BATCH, SEQ, D), 1.0),
        'c': nrm(1, (BATCH, D), 1.0),
        'ctx': nrm(2, (BATCH, CTX_LEN, D), 1.0),
        'c_ctx': nrm(3, (D,), 0.5),
        'g_mix': gain(4, (L, D)),
        'g_ffn': gain(5, (L, D)),
        'w_mod': nrm(6, (L, D, MOD_CHUNKS * D), 0.5 * D ** -0.5),
        'b_mod': nrm(7, (L, MOD_CHUNKS * D), 0.02),
        'w_in': nrm(8, (L, D, IN_COLS), D ** -0.5),
        'mla_g_cq': gain(9, (L, MLA_Q_RANK)),
        'mla_g_ckv': gain(10, (L, MLA_KV_RANK)),
        'mla_w_uq': nrm(11, (L, MLA_Q_RANK, MLA_HEADS * (MLA_NOPE + MLA_ROPE)), MLA_Q_RANK ** -0.5),
        'mla_w_ukv': nrm(12, (L, MLA_KV_RANK, MLA_HEADS * (MLA_NOPE + MLA_V)), MLA_KV_RANK ** -0.5),
        'lru_conv_w': nrm(13, (L, LRU_CONV, LRU_WIDTH), 0.5),
        'lru_conv_b': nrm(14, (L, LRU_WIDTH), 0.02),
        'lru_w_r': nrm(15, (L, 2, LRU_BLOCKS, bw, bw), bw ** -0.5),
        'lru_b_r': nrm(16, (L, 2, LRU_WIDTH), 0.1),
        'lru_w_i': nrm(18, (L, 2, LRU_BLOCKS, bw, bw), bw ** -0.5),
        'lru_b_i': nrm(19, (L, 2, LRU_WIDTH), 0.1),
        'lru_lam': lam,
        'hy_conv_w': nrm(20, (L, HY_CONV, 3 * HY_WIDTH), 0.5),
        'hy_conv_b': nrm(21, (L, 3 * HY_WIDTH), 0.02),
        'hy_w1': nrm(22, (L, HY_EMB, HY_FFN), HY_EMB ** -0.5),
        'hy_b1': nrm(23, (L, HY_FFN), 0.1),
        'hy_f1': gain(24, (L, HY_FFN), 0.1),
        'hy_w2': nrm(25, (L, HY_FFN, HY_FFN), HY_FFN ** -0.5),
        'hy_b2': nrm(26, (L, HY_FFN), 0.1),
        'hy_f2': gain(27, (L, HY_FFN), 0.1),
        'hy_w3': nrm(28, (L, HY_FFN, 2 * HY_WIDTH), HY_FFN ** -0.5),
        'hy_skip': nrm(29, (L, HY_WIDTH), 0.5),
        'gqa_sink': nrm(30, (L, GQA_HEADS), 0.5),
        'w_branch': nrm(31, (L, N_BRANCH, BRANCH_WIDTH, D), BRANCH_WIDTH ** -0.5),
        'w_out': nrm(32, (L, D, D), D ** -0.5),
        'peer_w_q': nrm(33, (L, D, PEER_HEADS * PEER_DKEY), D ** -0.5),
        'peer_keys': nrm(34, (L, PEER_HEADS, 2, PEER_NKEYS, PEER_DKEY // 2), (PEER_DKEY // 2) ** -0.5),
        'peer_u': nrm(35, (L, PEER_EXPERTS, D), D ** -0.5),
        'peer_v': nrm(36, (L, PEER_EXPERTS, D), 1.0),
        'g_final': gain(37, (D,)),
    }


def reference(x, c, ctx, c_ctx, g_mix, g_ffn, w_mod, b_mod, w_in, mla_g_cq, mla_g_ckv, mla_w_uq,
              mla_w_ukv, lru_conv_w, lru_conv_b, lru_w_r, lru_b_r, lru_w_i, lru_b_i, lru_lam,
              hy_conv_w, hy_conv_b, hy_w1, hy_b1, hy_f1, hy_w2, hy_b2, hy_f2, hy_w3, hy_skip,
              gqa_sink, w_branch, w_out, peer_w_q, peer_keys, peer_u, peer_v, g_final):
    B, N, D = x.shape
    ROWS = N // GRID_W
    row = jnp.repeat(jnp.arange(ROWS, dtype=jnp.int32), GRID_W)
    col = jnp.tile(jnp.arange(GRID_W, dtype=jnp.int32), ROWS)
    sc = jax.nn.silu(c)
    scc = jax.nn.silu(c_ctx)
    for l in range(DEPTH):
        last = l == DEPTH - 1
        mod = (sc @ w_mod[l] + b_mod[l])[:, None, :]
        modc = scc @ w_mod[l] + b_mod[l]
        sh1, s1, g1, sh2, s2, g2 = jnp.split(mod, MOD_CHUNKS, axis=-1)
        sh1c, s1c, g1c, sh2c, s2c, g2c = jnp.split(modc, MOD_CHUNKS, axis=-1)
        p = {
            'w_in': w_in[l], 'mla_g_cq': mla_g_cq[l], 'mla_g_ckv': mla_g_ckv[l],
            'mla_w_uq': mla_w_uq[l], 'mla_w_ukv': mla_w_ukv[l],
            'lru_conv_w': lru_conv_w[l], 'lru_conv_b': lru_conv_b[l], 'lru_w_r': lru_w_r[l],
            'lru_b_r': lru_b_r[l], 'lru_w_i': lru_w_i[l], 'lru_b_i': lru_b_i[l], 'lru_lam': lru_lam[l],
            'hy_conv_w': hy_conv_w[l], 'hy_conv_b': hy_conv_b[l], 'hy_w1': hy_w1[l], 'hy_b1': hy_b1[l],
            'hy_f1': hy_f1[l], 'hy_w2': hy_w2[l], 'hy_b2': hy_b2[l], 'hy_f2': hy_f2[l],
            'hy_w3': hy_w3[l], 'hy_skip': hy_skip[l], 'gqa_sink': gqa_sink[l],
            'w_branch': w_branch[l], 'w_out': w_out[l],
        }
        h = modulate(rmsnorm(x, g_mix[l]), sh1, s1)
        hc = modulate(rmsnorm(ctx, g_mix[l]), sh1c, s1c)
        y, yc = token_mixer(h, hc, row, col, p, not last)
        x = x + g1 * y
        hf = modulate(rmsnorm(x, g_ffn[l]), sh2, s2)
        x = x + g2 * peer(hf, peer_w_q[l], peer_keys[l], peer_u[l], peer_v[l])
        if not last:
            ctx = ctx + g1c * yc
            hcf = modulate(rmsnorm(ctx, g_ffn[l]), sh2c, s2c)
            ctx = ctx + g2c * peer(hcf, peer_w_q[l], peer_keys[l], peer_u[l], peer_v[l])
    return rmsnorm(x, g_final)
```

```cpp
#ifndef CPU_SIM
#include <hip/hip_runtime.h>
#include <hip/hip_cooperative_groups.h>
#include <cstdio>
#include <cstring>
namespace cg = cooperative_groups;
#define DEV __device__ __forceinline__
#define DEVN __device__ __forceinline__
#else
#include <cmath>
#include <cstdio>
#include <cstdint>
#include <cstring>
#define DEV static inline
#define DEVN static
#endif

#ifndef SEQ_N
#define SEQ_N 8192
#endif
#ifndef CTX_L
#define CTX_L 256
#endif

typedef long long i64;

constexpr int D = 1024, NB = 2, N = SEQ_N, LC = CTX_L;
constexpr int NLAT = NB * N, NCTX = NB * LC, TT = NLAT + NCTX;
constexpr int GRIDW = 64;
constexpr int INC = 7840, PC = 3744;
constexpr int C_CQ = 0, C_CKV = 256, C_KR = 384, C_LX = 416, C_LG = 928, C_HU = 1440, C_GQ = 2976, C_GKV = 3488, C_GT = 3744;
constexpr int NEXP = 16384;
constexpr float EPS = 1e-6f;

enum { I_x, I_c, I_ctx, I_c_ctx, I_g_mix, I_g_ffn, I_w_mod, I_b_mod, I_w_in, I_mla_g_cq, I_mla_g_ckv, I_mla_w_uq,
       I_mla_w_ukv, I_lru_conv_w, I_lru_conv_b, I_lru_w_r, I_lru_b_r, I_lru_w_i, I_lru_b_i, I_lru_lam,
       I_hy_conv_w, I_hy_conv_b, I_hy_w1, I_hy_b1, I_hy_f1, I_hy_w2, I_hy_b2, I_hy_f2, I_hy_w3, I_hy_skip,
       I_gqa_sink, I_w_branch, I_w_out, I_peer_w_q, I_peer_keys, I_peer_u, I_peer_v, I_g_final, N_IN };

struct bf { unsigned short v; };
DEV float b2f(bf x) { union { unsigned u; float f; } c; c.u = ((unsigned)x.v) << 16; return c.f; }
DEV bf f2b(float f) { union { unsigned u; float f; } c; c.f = f; unsigned r = c.u + 0x7FFFu + ((c.u >> 16) & 1u); bf o; o.v = (unsigned short)(r >> 16); return o; }

struct Params {
  const float* in[N_IN];
  float* out;
  float* xcur;
  float* mods;
  float* hdn2;
  bf* h;
  bf* P;
  bf* QA;
  bf* KVA;
  bf* XC;
  bf* LA;
  bf* LB;
  float* F;
  float* fnorm;
  float* Z;
  bf* Y;
  bf* M;
  float* PQ;
  float* TKs;
  int* TKi;
  int* SELi;
  float* SELg;
  float* W;
};

constexpr size_t al256(size_t x) { return (x + 255) & ~(size_t)255; }
struct WsLayout {
  size_t xcur, mods, hdn2, h, P, QA, KVA, XC, LA, LB, F, fnorm, Z, Y, M, PQ, TKs, TKi, SELi, SELg, W, total;
};
constexpr WsLayout make_layout() {
  WsLayout w{};
  size_t o = 0;
  w.xcur = o; o = al256(o + (size_t)TT * D * 4);
  w.mods = o; o = al256(o + (size_t)2 * 3 * 6 * D * 4);
  w.hdn2 = o; o = al256(o + (size_t)2 * (N + LC) * 64 * 4);
  w.h = o; o = al256(o + (size_t)TT * D * 2);
  w.fnorm = o; o = al256(o + (size_t)2 * 512 * 4);
  w.Y = o; o = al256(o + (size_t)TT * 2048 * 2);
  w.XC = o; o = al256(o + (size_t)TT * 512 * 2);
  w.LA = o; o = al256(o + (size_t)2 * TT * 512 * 2);
  w.LB = o; o = al256(o + (size_t)2 * TT * 512 * 2);
  w.F = o; o = al256(o + (size_t)(N + LC) * 1024 * 4);
  w.Z = o; o = al256(o + (size_t)TT * 512 * 4);
  size_t r0 = o;
  w.P = o; o = al256(o + (size_t)TT * PC * 2);
  w.QA = o; o = al256(o + (size_t)TT * 768 * 2);
  w.KVA = o; o = al256(o + (size_t)TT * 1024 * 2);
  size_t end1 = o;
  o = r0;
  w.M = o; o = al256(o + (size_t)TT * D * 2);
  w.PQ = o; o = al256(o + (size_t)TT * 1024 * 4);
  w.TKs = o; o = al256(o + (size_t)TT * 256 * 4);
  w.TKi = o; o = al256(o + (size_t)TT * 256 * 4);
  w.SELi = o; o = al256(o + (size_t)TT * 128 * 4);
  w.SELg = o; o = al256(o + (size_t)TT * 128 * 4);
  w.W = o; o = al256(o + (size_t)TT * 128 * 4);
  size_t end2 = o;
  w.total = end1 > end2 ? end1 : end2;
  return w;
}
constexpr WsLayout WL = make_layout();
static_assert(WL.total <= (size_t)512 * 1024 * 1024, "workspace too large");

DEV float sigmoidf_(float x) { return 1.0f / (1.0f + expf(-x)); }
DEV float siluf_(float x) { return x * sigmoidf_(x); }
DEV float geluf_(float x) { return 0.5f * x * (1.0f + tanhf(0.7978845608028654f * (x + 0.044715f * x * x * x))); }
DEV float softplusf_(float x) { return x > 20.f ? x : log1pf(expf(x)); }

struct RowInfo { int b, t, L, base, lat; };
DEV RowInfo rowinfo(int r) {
  RowInfo ri;
  if (r < NLAT) { ri.b = r / N; ri.t = r - ri.b * N; ri.L = N; ri.base = ri.b * N; ri.lat = 1; }
  else { int rc = r - NLAT; ri.b = rc / LC; ri.t = rc - ri.b * LC; ri.L = LC; ri.base = NLAT + ri.b * LC; ri.lat = 0; }
  return ri;
}
DEV int modrow(int r) { return r < NLAT ? r / N : 2; }

DEVN void ph_init(const Params& p, i64 gtid, i64 gsz) {
  const float* x = p.in[I_x]; const float* ctx = p.in[I_ctx];
  for (i64 i = gtid; i < (i64)TT * D; i += gsz) p.xcur[i] = i < (i64)NLAT * D ? x[i] : ctx[i - (i64)NLAT * D];
  for (i64 i = gtid; i < 2 * 3 * 6 * D; i += gsz) {
    int l = (int)(i / (3 * 6 * D)); int rr = (int)((i / (6 * D)) % 3); int j = (int)(i % (6 * D));
    const float* cv = rr < 2 ? p.in[I_c] + rr * D : p.in[I_c_ctx];
    const float* w = p.in[I_w_mod] + (size_t)l * D * 6 * D;
    float acc = p.in[I_b_mod][l * 6 * D + j];
    for (int k = 0; k < D; ++k) acc += siluf_(cv[k]) * w[(size_t)k * 6 * D + j];
    p.mods[i] = acc;
  }
  for (i64 i = gtid; i < (i64)2 * (N + LC) * 64; i += gsz) {
    int l = (int)(i / ((i64)(N + LC) * 64)); int tt = (int)((i / 64) % (N + LC)); int j2 = (int)(i % 64);
    int t, L; if (tt < N) { t = tt; L = N; } else { t = tt - N; L = LC; }
    float tn = (float)t / (float)(L - 1);
    float wt = 6.283185307179586f * (float)t / (float)L;
    const float* w1 = p.in[I_hy_w1] + l * 33 * 64; const float* b1 = p.in[I_hy_b1] + l * 64; const float* f1 = p.in[I_hy_f1] + l * 64;
    const float* w2 = p.in[I_hy_w2] + l * 64 * 64; const float* b2 = p.in[I_hy_b2] + l * 64; const float* f2 = p.in[I_hy_f2] + l * 64;
    float acc2 = b2[j2];
    for (int k1 = 0; k1 < 64; ++k1) {
      float a1 = b1[k1] + tn * w1[k1];
      for (int bd = 0; bd < 16; ++bd) {
        float band = 1e-4f + (float)bd * ((15.0f - 1e-4f) / 15.0f);
        float ang = band * wt;
        a1 += cosf(ang) * w1[(1 + bd) * 64 + k1] - sinf(ang) * w1[(17 + bd) * 64 + k1];
      }
      acc2 += sinf(f1[k1] * a1) * w2[k1 * 64 + j2];
    }
    p.hdn2[i] = sinf(f2[j2] * acc2);
  }
}

DEVN void ph_norm(const Params& p, int l, int which, int nrows, i64 gtid, i64 gsz) {
  const float* g = p.in[which ? I_g_ffn : I_g_mix] + l * D;
  for (i64 r = gtid; r < nrows; r += gsz) {
    const float* xr = p.xcur + (size_t)r * D;
    float ss = 0.f;
    for (int k = 0; k < D; ++k) ss += xr[k] * xr[k];
    float rstd = 1.0f / sqrtf(ss / D + EPS);
    const float* md = p.mods + ((size_t)l * 3 + modrow((int)r)) * 6 * D + (which ? 3 * D : 0);
    for (int k = 0; k < D; ++k) p.h[(size_t)r * D + k] = f2b(xr[k] * rstd * g[k] * (1.0f + md[D + k]) + md[k]);
  }
}

DEVN void ph_inproj(const Params& p, int l, i64 gtid, i64 gsz) {
  const float* w = p.in[I_w_in] + (size_t)l * D * INC;
  for (i64 i = gtid; i < (i64)TT * PC; i += gsz) {
    int r = (int)(i / PC), j = (int)(i % PC);
    const bf* hr = p.h + (size_t)r * D;
    float acc = 0.f;
    for (int k = 0; k < D; ++k) acc += b2f(hr[k]) * w[(size_t)k * INC + j];
    p.P[i] = f2b(acc);
  }
}

DEV void rope_pair(float& x1, float& x2, int pos, int f, int nf) {
  float inv = powf(10000.0f, -(float)f / (float)nf);
  float ang = (float)pos * inv;
  float c = cosf(ang), s = sinf(ang);
  float a = x1 * c - x2 * s, b = x1 * s + x2 * c;
  x1 = a; x2 = b;
}

DEVN void ph_B0(const Params& p, int l, i64 gtid, i64 gsz) {
  {
    const float* g = p.in[I_mla_g_cq] + l * 256; const float* w = p.in[I_mla_w_uq] + (size_t)l * 256 * 768;
    for (i64 i = gtid; i < (i64)TT * 768; i += gsz) {
      int r = (int)(i / 768), j = (int)(i % 768);
      const bf* cq = p.P + (size_t)r * PC + C_CQ;
      float ss = 0.f;
      for (int k = 0; k < 256; ++k) { float v = b2f(cq[k]); ss += v * v; }
      float rstd = 1.0f / sqrtf(ss / 256 + EPS);
      int dh = j % 96;
      int jp = j;
      int within = 0, first = 0;
      bool rope = (r < NLAT) && dh >= 64;
      if (rope) { within = (dh - 64) % 16; first = within < 8; jp = first ? j + 8 : j - 8; }
      float acc = 0.f, accp = 0.f;
      for (int k = 0; k < 256; ++k) {
        float a = b2f(cq[k]) * rstd * g[k];
        acc += a * w[(size_t)k * 768 + j];
        accp += a * w[(size_t)k * 768 + jp];
      }
      if (rope) {
        RowInfo ri = rowinfo(r);
        int pos = ((dh - 64) < 16) ? ri.t / GRIDW : ri.t % GRIDW;
        float x1 = first ? acc : accp, x2 = first ? accp : acc;
        rope_pair(x1, x2, pos, within % 8, 8);
        acc = first ? x1 : x2;
      }
      p.QA[i] = f2b(acc);
    }
  }
  {
    const float* g = p.in[I_mla_g_ckv] + l * 128; const float* w = p.in[I_mla_w_ukv] + (size_t)l * 128 * 1024;
    for (i64 i = gtid; i < (i64)TT * 1024; i += gsz) {
      int r = (int)(i / 1024), j = (int)(i % 1024);
      const bf* ck = p.P + (size_t)r * PC + C_CKV;
      float ss = 0.f;
      for (int k = 0; k < 128; ++k) { float v = b2f(ck[k]); ss += v * v; }
      float rstd = 1.0f / sqrtf(ss / 128 + EPS);
      float acc = 0.f;
      for (int k = 0; k < 128; ++k) acc += b2f(ck[k]) * rstd * g[k] * w[(size_t)k * 1024 + j];
      p.KVA[i] = f2b(acc);
    }
  }
  {
    const float* cw = p.in[I_lru_conv_w] + l * 4 * 512; const float* cb = p.in[I_lru_conv_b] + l * 512;
    for (i64 i = gtid; i < (i64)TT * 512; i += gsz) {
      int r = (int)(i / 512), c = (int)(i % 512);
      RowInfo ri = rowinfo(r);
      float acc = cb[c];
      for (int k = 0; k < 4; ++k) {
        int ts = ri.t - 1 + k;
        if (ts >= 0 && ts < ri.L) acc += cw[k * 512 + c] * b2f(p.P[(size_t)(ri.base + ts) * PC + C_LX + c]);
      }
      p.XC[i] = f2b(acc);
    }
  }
  {
    const float* cw = p.in[I_hy_conv_w] + l * 3 * 1536; const float* cb = p.in[I_hy_conv_b] + l * 1536;
    for (i64 i = gtid; i < (i64)TT * 512; i += gsz) {
      int r = (int)(i / 512), c = (int)(i % 512);
      RowInfo ri = rowinfo(r);
      float a1 = cb[512 + c], a2 = cb[1024 + c];
      for (int k = 0; k < 3; ++k) {
        int ts = ri.t - 1 + k;
        if (ts >= 0 && ts < ri.L) {
          const bf* pr = p.P + (size_t)(ri.base + ts) * PC + C_HU;
          a1 += cw[k * 1536 + 512 + c] * b2f(pr[512 + c]);
          a2 += cw[k * 1536 + 1024 + c] * b2f(pr[1024 + c]);
        }
      }
      p.Z[i] = a1 * a2;
    }
  }
  {
    const float* w3 = p.in[I_hy_w3] + (size_t)l * 64 * 1024;
    const float maxd = logf(1e-2f) / 0.3f, mind = logf(1e-2f) / 1.5f;
    for (i64 i = gtid; i < (i64)(N + LC) * 1024; i += gsz) {
      int tt = (int)(i / 1024), j = (int)(i % 1024);
      int t, L; if (tt < N) { t = tt; L = N; } else { t = tt - N; L = LC; }
      const float* hd = p.hdn2 + ((size_t)l * (N + LC) + tt) * 64;
      float acc = 0.f;
      for (int k = 0; k < 64; ++k) acc += hd[k] * w3[k * 1024 + j];
      float tn = (float)t / (float)(L - 1);
      float delta = mind + (float)j * ((maxd - mind) / 1023.0f);
      p.F[i] = acc * expf(-tn * fabsf(delta));
    }
  }
  {
    for (i64 i = gtid; i < (i64)NLAT * (8 * 32 + 2 * 32 + 16); i += gsz) {
      int r = (int)(i / 336), q = (int)(i % 336);
      int t = r % N; int prow = t / GRIDW, pcol = t % GRIDW;
      bf* pr = p.P + (size_t)r * PC;
      int c1, c2, pos, f, nf;
      if (q < 320) {
        int hh = q / 32, pi = q % 32;
        int basec = hh < 8 ? C_GQ + hh * 64 : C_GKV + (hh - 8) * 64;
        int half = pi / 16; f = pi % 16; nf = 16;
        c1 = basec + half * 32 + f; c2 = c1 + 16; pos = half ? pcol : prow;
      } else {
        int pi = q - 320; int half = pi / 8; f = pi % 8; nf = 8;
        c1 = C_KR + half * 16 + f; c2 = c1 + 8; pos = half ? pcol : prow;
      }
      float x1 = b2f(pr[c1]), x2 = b2f(pr[c2]);
      rope_pair(x1, x2, pos, f, nf);
      pr[c1] = f2b(x1); pr[c2] = f2b(x2);
    }
  }
}

DEVN void ph_B1(const Params& p, int l, i64 gtid, i64 gsz) {
  for (i64 i = gtid; i < (i64)2 * TT * 512; i += gsz) {
    int dir = (int)(i / ((i64)TT * 512)); int r = (int)((i / 512) % TT); int c = (int)(i % 512);
    int blk = c / 64, jc = c % 64;
    const float* wr = p.in[I_lru_w_r] + (((size_t)l * 2 + dir) * 8 + blk) * 64 * 64;
    const float* wi = p.in[I_lru_w_i] + (((size_t)l * 2 + dir) * 8 + blk) * 64 * 64;
    const bf* xc = p.XC + (size_t)r * 512 + blk * 64;
    float ar = p.in[I_lru_b_r][(l * 2 + dir) * 512 + c], ai = p.in[I_lru_b_i][(l * 2 + dir) * 512 + c];
    for (int k = 0; k < 64; ++k) { float xv = b2f(xc[k]); ar += xv * wr[k * 64 + jc]; ai += xv * wi[k * 64 + jc]; }
    float rg = sigmoidf_(ar), ig = sigmoidf_(ai);
    float lam = p.in[I_lru_lam][(l * 2 + dir) * 512 + c];
    float log_a = -8.0f * rg * softplusf_(-lam);
    float bt = sqrtf(-expm1f(2.0f * log_a)) * ig * b2f(p.XC[(size_t)r * 512 + c]);
    p.LA[i] = f2b(log_a); p.LB[i] = f2b(bt);
  }
  for (i64 i = gtid; i < 2 * 512; i += gsz) {
    int which = (int)(i / 512), c = (int)(i % 512);
    int L = which ? LC : N; int off = which ? N : 0;
    float ss = 0.f;
    for (int t = 0; t < L; ++t) { float a = p.F[(size_t)(off + t) * 1024 + c], b = p.F[(size_t)(off + t) * 1024 + 512 + c]; ss += a * a + b * b; }
    p.fnorm[i] = 1.0f / sqrtf(ss + EPS);
  }
}

DEVN void ph_C(const Params& p, int l, int last, i64 gtid, i64 gsz) {
  const int QR = last ? NLAT : TT;
  for (i64 i = gtid; i < (i64)8 * QR; i += gsz) {
    int hh = (int)(i / QR), r = (int)(i % QR);
    RowInfo ri = rowinfo(r);
    float q[96];
#pragma unroll
    for (int d = 0; d < 96; ++d) q[d] = b2f(p.QA[(size_t)r * 768 + hh * 96 + d]);
    float o[64];
#pragma unroll
    for (int d = 0; d < 64; ++d) o[d] = 0.f;
    float m = -1e30f, lsum = 0.f;
    const float scale = 0.10206207261596577f;
    int nseg = ri.lat ? 2 : 1;
    for (int sg = 0; sg < nseg; ++sg) {
      int kb, kn_;
      if (ri.lat && sg == 0) { kb = ri.b * N; kn_ = N; } else { kb = NLAT + ri.b * LC; kn_ = LC; }
      for (int kk = 0; kk < kn_; ++kk) {
        const bf* kr_ = p.KVA + (size_t)(kb + kk) * 1024 + hh * 128;
        const bf* krp = p.P + (size_t)(kb + kk) * PC + C_KR;
        float s = 0.f;
#pragma unroll
        for (int d = 0; d < 64; ++d) s += q[d] * b2f(kr_[d]);
#pragma unroll
        for (int d = 0; d < 32; ++d) s += q[64 + d] * b2f(krp[d]);
        s *= scale;
        float mn = fmaxf(m, s);
        float corr = expf(m - mn), pe = expf(s - mn);
        lsum = lsum * corr + pe;
#pragma unroll
        for (int d = 0; d < 64; ++d) o[d] = o[d] * corr + pe * b2f(kr_[64 + d]);
        m = mn;
      }
    }
    float inv = 1.0f / lsum;
#pragma unroll
    for (int d = 0; d < 64; ++d) p.Y[(size_t)r * 2048 + hh * 64 + d] = f2b(o[d] * inv);
  }
  for (i64 i = gtid; i < 2 * 512; i += gsz) {
    int b = (int)(i / 512), c = (int)(i % 512);
    size_t cb = (size_t)(NLAT + b * LC), lb = (size_t)b * N;
    {
      const bf* la = p.LA; bf* lbp = p.LB;
      float hst = 0.f;
      for (int t = 0; t < LC; ++t) { size_t ix = (cb + t) * 512 + c; hst = expf(b2f(la[ix])) * hst + b2f(lbp[ix]); lbp[ix] = f2b(hst); }
      for (int t = 0; t < N; ++t) { size_t ix = (lb + t) * 512 + c; hst = expf(b2f(la[ix])) * hst + b2f(lbp[ix]); lbp[ix] = f2b(hst); }
    }
    {
      const bf* la = p.LA + (size_t)TT * 512; bf* lbp = p.LB + (size_t)TT * 512;
      float hst = 0.f;
      for (int t = LC - 1; t >= 0; --t) { size_t ix = (cb + t) * 512 + c; hst = expf(b2f(la[ix])) * hst + b2f(lbp[ix]); lbp[ix] = f2b(hst); }
      for (int t = N - 1; t >= 0; --t) { size_t ix = (lb + t) * 512 + c; hst = expf(b2f(la[ix])) * hst + b2f(lbp[ix]); lbp[ix] = f2b(hst); }
    }
    for (int s = 0; s < 2; ++s) {
      size_t rb = s ? cb : lb; int L = s ? LC : N;
      if (s && last) break;
      for (int t = 0; t < L; ++t) {
        size_t r = rb + t;
        float hs = b2f(p.LB[r * 512 + c]) + b2f(p.LB[((size_t)TT + r) * 512 + c]);
        float lg = b2f(p.P[r * PC + C_LG + c]);
        p.Y[r * 2048 + 512 + c] = f2b(geluf_(lg) * hs);
      }
    }
  }
  {
    const float* cw = p.in[I_hy_conv_w] + l * 3 * 1536; const float* cb = p.in[I_hy_conv_b] + l * 1536;
    const float* skip = p.in[I_hy_skip] + l * 512;
    for (i64 i = gtid; i < (i64)QR * 512; i += gsz) {
      int r = (int)(i / 512), c = (int)(i % 512);
      RowInfo ri = rowinfo(r);
      int foff = ri.lat ? 0 : N;
      float acc = 0.f;
      for (int s = 0; s < ri.L; ++s) {
        int dd = ri.t - s;
        float fv = dd >= 0 ? p.F[(size_t)(foff + dd) * 1024 + c] : p.F[(size_t)(foff - dd) * 1024 + 512 + c];
        acc += fv * p.Z[(size_t)(ri.base + s) * 512 + c];
      }
      acc *= p.fnorm[(ri.lat ? 0 : 512) + c];
      float x0 = cb[c];
      for (int k = 0; k < 3; ++k) {
        int ts = ri.t - 1 + k;
        if (ts >= 0 && ts < ri.L) x0 += cw[k * 1536 + c] * b2f(p.P[(size_t)(ri.base + ts) * PC + C_HU + c]);
      }
      float y = acc + skip[c] * p.Z[(size_t)r * 512 + c];
      p.Y[(size_t)r * 2048 + 1024 + c] = f2b(x0 * y);
    }
  }
  for (i64 i = gtid; i < (i64)8 * QR; i += gsz) {
    int hh = (int)(i / QR), r = (int)(i % QR);
    RowInfo ri = rowinfo(r);
    int kh = hh / 4;
    float q[64];
#pragma unroll
    for (int d = 0; d < 64; ++d) q[d] = b2f(p.P[(size_t)r * PC + C_GQ + hh * 64 + d]);
    float o[64];
#pragma unroll
    for (int d = 0; d < 64; ++d) o[d] = 0.f;
    float m = p.in[I_gqa_sink][l * 8 + hh], lsum = 1.0f;
    int nseg = ri.lat ? 2 : 1;
    for (int sg = 0; sg < nseg; ++sg) {
      int k0, k1;
      if (ri.lat && sg == 0) { int lo = ri.t - 128; if (lo < 0) lo = 0; int hi = ri.t + 128; if (hi > N - 1) hi = N - 1; k0 = ri.b * N + lo; k1 = ri.b * N + hi + 1; }
      else { k0 = NLAT + ri.b * LC; k1 = k0 + LC; }
      for (int kk = k0; kk < k1; ++kk) {
        const bf* kp = p.P + (size_t)kk * PC + C_GKV + kh * 64;
        const bf* vp = kp + 128;
        float s = 0.f;
#pragma unroll
        for (int d = 0; d < 64; ++d) s += q[d] * b2f(kp[d]);
        s *= 0.125f;
        float mn = fmaxf(m, s);
        float corr = expf(m - mn), pe = expf(s - mn);
        lsum = lsum * corr + pe;
#pragma unroll
        for (int d = 0; d < 64; ++d) o[d] = o[d] * corr + pe * b2f(vp[d]);
        m = mn;
      }
    }
    float inv = 1.0f / lsum;
#pragma unroll
    for (int d = 0; d < 64; ++d) p.Y[(size_t)r * 2048 + 1536 + hh * 64 + d] = f2b(o[d] * inv);
  }
}

DEVN void ph_D0(const Params& p, int l, int nrows, i64 gtid, i64 gsz) {
  const float* w = p.in[I_w_in] + (size_t)l * D * INC + C_GT;
  const float* wb = p.in[I_w_branch] + (size_t)l * 4 * 512 * D;
  for (i64 i = gtid; i < (i64)nrows * D; i += gsz) {
    int r = (int)(i / D), n = (int)(i % D);
    const bf* hr = p.h + (size_t)r * D;
    float g0 = 0.f, g1 = 0.f, g2 = 0.f, g3 = 0.f;
    for (int k = 0; k < D; ++k) {
      float hv = b2f(hr[k]); const float* wk = w + (size_t)k * INC + n;
      g0 += hv * wk[0]; g1 += hv * wk[1024]; g2 += hv * wk[2048]; g3 += hv * wk[3072];
    }
    const bf* yr = p.Y + (size_t)r * 2048;
    float a0 = 0.f, a1 = 0.f, a2 = 0.f, a3 = 0.f;
    for (int k = 0; k < 512; ++k) {
      a0 += b2f(yr[k]) * wb[(size_t)(0 * 512 + k) * D + n];
      a1 += b2f(yr[512 + k]) * wb[(size_t)(1 * 512 + k) * D + n];
      a2 += b2f(yr[1024 + k]) * wb[(size_t)(2 * 512 + k) * D + n];
      a3 += b2f(yr[1536 + k]) * wb[(size_t)(3 * 512 + k) * D + n];
    }
    p.M[i] = f2b(sigmoidf_(g0) * a0 + sigmoidf_(g1) * a1 + sigmoidf_(g2) * a2 + sigmoidf_(g3) * a3);
  }
}

DEVN void ph_D1(const Params& p, int l, int nrows, i64 gtid, i64 gsz) {
  const float* w = p.in[I_w_out] + (size_t)l * D * D;
  for (i64 i = gtid; i < (i64)nrows * D; i += gsz) {
    int r = (int)(i / D), n = (int)(i % D);
    const bf* mr = p.M + (size_t)r * D;
    float acc = 0.f;
    for (int k = 0; k < D; ++k) acc += b2f(mr[k]) * w[(size_t)k * D + n];
    float g1 = p.mods[((size_t)l * 3 + modrow(r)) * 6 * D + 2 * D + n];
    p.xcur[i] += g1 * acc;
  }
}

DEVN void ph_E1(const Params& p, int l, int nrows, i64 gtid, i64 gsz) {
  const float* w = p.in[I_peer_w_q] + (size_t)l * D * 1024;
  for (i64 i = gtid; i < (i64)nrows * 1024; i += gsz) {
    int r = (int)(i / 1024), j = (int)(i % 1024);
    const bf* hr = p.h + (size_t)r * D;
    float acc = 0.f;
    for (int k = 0; k < D; ++k) acc += b2f(hr[k]) * w[(size_t)k * 1024 + j];
    p.PQ[i] = acc;
  }
}

DEVN void ph_E2a(const Params& p, int l, int nrows, i64 gtid, i64 gsz) {
  for (i64 i = gtid; i < (i64)nrows * 16; i += gsz) {
    int r = (int)(i / 16), hp = (int)(i % 16);
    const float* q = p.PQ + (size_t)r * 1024 + hp * 64;
    const float* keys = p.in[I_peer_keys] + ((size_t)l * 16 + hp) * 128 * 64;
    float ps = 3.0e38f; int pi = -1;
    for (int k = 0; k < 16; ++k) {
      float bs = -3.0e38f; int bi = -1;
      for (int j = 0; j < 128; ++j) {
        float s = 0.f;
        for (int d = 0; d < 64; ++d) s += q[d] * keys[j * 64 + d];
        bool elig = (s < ps) || (s == ps && j > pi);
        if (elig && (s > bs)) { bs = s; bi = j; }
      }
      p.TKs[(size_t)i * 16 + k] = bs; p.TKi[(size_t)i * 16 + k] = bi;
      ps = bs; pi = bi;
    }
  }
}

DEVN void ph_E2b(const Params& p, int l, int nrows, i64 gtid, i64 gsz) {
  for (i64 i = gtid; i < (i64)nrows * 8; i += gsz) {
    const float* s1 = p.TKs + (size_t)i * 32; const float* s2 = s1 + 16;
    const int* i1 = p.TKi + (size_t)i * 32; const int* i2 = i1 + 16;
    float ps = 3.0e38f; int pi = -1;
    float mx = 0.f;
    for (int k = 0; k < 16; ++k) {
      float bs = -3.0e38f; int bi = -1;
      for (int j = 0; j < 256; ++j) {
        float s = s1[j >> 4] + s2[j & 15];
        bool elig = (s < ps) || (s == ps && j > pi);
        if (elig && (s > bs)) { bs = s; bi = j; }
      }
      if (k == 0) mx = bs;
      p.SELi[(size_t)i * 16 + k] = i1[bi >> 4] * 128 + i2[bi & 15];
      p.SELg[(size_t)i * 16 + k] = expf(bs - mx);
      ps = bs; pi = bi;
    }
    float sum = 0.f;
    for (int k = 0; k < 16; ++k) sum += p.SELg[(size_t)i * 16 + k];
    float inv = 1.0f / sum;
    for (int k = 0; k < 16; ++k) p.SELg[(size_t)i * 16 + k] *= inv;
  }
}

DEVN void ph_E3(const Params& p, int l, int nrows, i64 gtid, i64 gsz) {
  const float* u = p.in[I_peer_u] + (size_t)l * NEXP * D;
  for (i64 i = gtid; i < (i64)nrows * 128; i += gsz) {
    int r = (int)(i / 128);
    const float* ur = u + (size_t)p.SELi[i] * D;
    const bf* hr = p.h + (size_t)r * D;
    float acc = 0.f;
    for (int k = 0; k < D; ++k) acc += b2f(hr[k]) * ur[k];
    p.W[i] = p.SELg[i] * geluf_(acc);
  }
}

DEVN void ph_E4(const Params& p, int l, int nrows, i64 gtid, i64 gsz) {
  const float* v = p.in[I_peer_v] + (size_t)l * NEXP * D;
  for (i64 i = gtid; i < (i64)nrows * D; i += gsz) {
    int r = (int)(i / D), n = (int)(i % D);
    float acc = 0.f;
    for (int j = 0; j < 128; ++j) acc += p.W[(size_t)r * 128 + j] * v[(size_t)p.SELi[(size_t)r * 128 + j] * D + n];
    float g2 = p.mods[((size_t)l * 3 + modrow(r)) * 6 * D + 5 * D + n];
    p.xcur[i] += g2 * acc;
  }
}

DEVN void ph_final(const Params& p, i64 gtid, i64 gsz) {
  const float* g = p.in[I_g_final];
  for (i64 r = gtid; r < NLAT; r += gsz) {
    const float* xr = p.xcur + (size_t)r * D;
    float ss = 0.f;
    for (int k = 0; k < D; ++k) ss += xr[k] * xr[k];
    float rstd = 1.0f / sqrtf(ss / D + EPS);
    for (int k = 0; k < D; ++k) p.out[(size_t)r * D + k] = xr[k] * rstd * g[k];
  }
}

DEV void run_phase(const Params& p, int ph, i64 gtid, i64 gsz) {
  if (ph == 0) { ph_init(p, gtid, gsz); return; }
  if (ph == 1 + 2 * 13) { ph_final(p, gtid, gsz); return; }
  int l = (ph - 1) / 13, s = (ph - 1) % 13;
  int last = (l == 1);
  int nr = last ? NLAT : TT;
  switch (s) {
    case 0: ph_norm(p, l, 0, TT, gtid, gsz); break;
    case 1: ph_inproj(p, l, gtid, gsz); break;
    case 2: ph_B0(p, l, gtid, gsz); break;
    case 3: ph_B1(p, l, gtid, gsz); break;
    case 4: ph_C(p, l, last, gtid, gsz); break;
    case 5: ph_D0(p, l, nr, gtid, gsz); break;
    case 6: ph_D1(p, l, nr, gtid, gsz); break;
    case 7: ph_norm(p, l, 1, nr, gtid, gsz); break;
    case 8: ph_E1(p, l, nr, gtid, gsz); break;
    case 9: ph_E2a(p, l, nr, gtid, gsz); break;
    case 10: ph_E2b(p, l, nr, gtid, gsz); break;
    case 11: ph_E3(p, l, nr, gtid, gsz); break;
    case 12: ph_E4(p, l, nr, gtid, gsz); break;
  }
}
constexpr int NPHASES = 2 + 2 * 13;

static void fill_params(Params& p, void* const* d_in, void* d_out, void* d_ws) {
  for (int i = 0; i < N_IN; ++i) p.in[i] = (const float*)d_in[i];
  p.out = (float*)d_out;
  char* ws = (char*)d_ws;
  p.xcur = (float*)(ws + WL.xcur); p.mods = (float*)(ws + WL.mods); p.hdn2 = (float*)(ws + WL.hdn2);
  p.h = (bf*)(ws + WL.h); p.P = (bf*)(ws + WL.P); p.QA = (bf*)(ws + WL.QA); p.KVA = (bf*)(ws + WL.KVA);
  p.XC = (bf*)(ws + WL.XC); p.LA = (bf*)(ws + WL.LA); p.LB = (bf*)(ws + WL.LB);
  p.F = (float*)(ws + WL.F); p.fnorm = (float*)(ws + WL.fnorm); p.Z = (float*)(ws + WL.Z);
  p.Y = (bf*)(ws + WL.Y); p.M = (bf*)(ws + WL.M); p.PQ = (float*)(ws + WL.PQ);
  p.TKs = (float*)(ws + WL.TKs); p.TKi = (int*)(ws + WL.TKi); p.SELi = (int*)(ws + WL.SELi);
  p.SELg = (float*)(ws + WL.SELg); p.W = (float*)(ws + WL.W);
}

#ifndef CPU_SIM
__global__ void __launch_bounds__(256) mega_kernel(Params p) {
  cg::grid_group grid = cg::this_grid();
  i64 gtid = (i64)blockIdx.x * 256 + threadIdx.x, gsz = (i64)gridDim.x * 256;
  for (int ph = 0; ph < NPHASES; ++ph) {
    run_phase(p, ph, gtid, gsz);
    if (ph + 1 < NPHASES) grid.sync();
  }
}

extern "C" void kernel_launch(void* const* d_in, const int* in_sizes, int n_in, void* d_out, int out_size,
                              void* d_ws, size_t ws_size, hipStream_t stream) {
  static int grid_blocks = 0;
  if (!grid_blocks) {
    int dev = 0, cus = 0, per_cu = 0;
    (void)hipGetDevice(&dev);
    (void)hipDeviceGetAttribute(&cus, hipDeviceAttributeMultiprocessorCount, dev);
    (void)hipOccupancyMaxActiveBlocksPerMultiprocessor(&per_cu, mega_kernel, 256, 0);
    if (per_cu > 4) per_cu = 4;
    if (per_cu < 1) per_cu = 1;
    grid_blocks = cus * per_cu;
  }
  Params p;
  std::memset((void*)&p, 0, sizeof(p));
  fill_params(p, d_in, d_out, d_ws);
  void* args[] = {&p};
  hipError_t e = hipLaunchCooperativeKernel((void*)mega_kernel, dim3(grid_blocks), dim3(256), args, 0, stream);
  if (e != hipSuccess) fprintf(stderr, "cooperative launch failed: %s (grid %d)\n", hipGetErrorString(e), grid_blocks);
}
#endif
```

```cpp
#ifndef CPU_SIM
#include <hip/hip_runtime.h>
#include <hip/hip_cooperative_groups.h>
#include <cstdio>
#include <cstring>
namespace cg = cooperative_groups;
#define DEV __device__ __forceinline__
#define DEVN __device__ __forceinline__
#define MDEV __device__ __forceinline__
typedef _Float16 sc_t;
#else
#include <cmath>
#include <cstdio>
#include <cstdint>
#include <cstring>
#define DEV static inline
#define DEVN static
#define MDEV inline
typedef float sc_t;
#endif

#ifndef SEQ_N
#define SEQ_N 8192
#endif
#ifndef CTX_L
#define CTX_L 256
#endif

typedef long long i64;

constexpr int D = 1024, NB = 2, N = SEQ_N, LC = CTX_L;
constexpr int NLAT = NB * N, NCTX = NB * LC, TT = NLAT + NCTX;
constexpr int GRIDW = 64;
constexpr int INC = 7840, PC = 3840;
constexpr int C_CQ = 0, C_CKV = 256, C_KR = 384, C_LX = 416, C_LG = 928, C_HU = 1440, C_GQ = 2976, C_GKV = 3488, C_GT = 3744;
constexpr int NEXP = 16384;
constexpr float EPS = 1e-6f;

enum { I_x, I_c, I_ctx, I_c_ctx, I_g_mix, I_g_ffn, I_w_mod, I_b_mod, I_w_in, I_mla_g_cq, I_mla_g_ckv, I_mla_w_uq,
       I_mla_w_ukv, I_lru_conv_w, I_lru_conv_b, I_lru_w_r, I_lru_b_r, I_lru_w_i, I_lru_b_i, I_lru_lam,
       I_hy_conv_w, I_hy_conv_b, I_hy_w1, I_hy_b1, I_hy_f1, I_hy_w2, I_hy_b2, I_hy_f2, I_hy_w3, I_hy_skip,
       I_gqa_sink, I_w_branch, I_w_out, I_peer_w_q, I_peer_keys, I_peer_u, I_peer_v, I_g_final, N_IN };

struct bf { unsigned short v; };
DEV float b2f(bf x) { union { unsigned u; float f; } c; c.u = ((unsigned)x.v) << 16; return c.f; }
DEV bf f2b(float f) { union { unsigned u; float f; } c; c.f = f; unsigned r = c.u + 0x7FFFu + ((c.u >> 16) & 1u); bf o; o.v = (unsigned short)(r >> 16); return o; }

struct Params;

constexpr size_t al256(size_t x) { return (x + 255) & ~(size_t)255; }
struct WsLayout {
  size_t xcur, mods, hdn2, ssq, tabA, tabD, fnorm, h, Y, Z, XC, LA, LB, P, QA, KVA;
  size_t W_in, W_g, W_uq, W_ukv, W_lru, W_br, W_out, W_q, W_key;
  size_t M, Gs, SC, TKs, TKi, SELi, SELg, W, total;
};
constexpr WsLayout make_layout() {
  WsLayout w{};
  size_t o = 0;
  w.xcur = o; o = al256(o + (size_t)TT * D * 4);
  w.mods = o; o = al256(o + (size_t)2 * 3 * 6 * D * 4);
  w.hdn2 = o; o = al256(o + (size_t)2 * (N + LC) * 64 * 4);
  w.ssq = o; o = al256(o + (size_t)2 * TT * 4);
  w.tabA = o; o = al256(o + (size_t)128 * 8 * 2 * 4);
  w.tabD = o; o = al256(o + (size_t)128 * 16 * 2 * 4);
  w.fnorm = o; o = al256(o + (size_t)2 * 512 * 4);
  w.h = o; o = al256(o + (size_t)TT * D * 2);
  w.Y = o; o = al256(o + (size_t)TT * 2048 * 2);
  w.Z = o; o = al256(o + (size_t)TT * 512 * 2);
  w.W_in = o; o = al256(o + (size_t)3840 * 1024 * 2);
  w.W_g = o; o = al256(o + (size_t)4096 * 1024 * 2);
  w.W_uq = o; o = al256(o + (size_t)768 * 256 * 2);
  w.W_ukv = o; o = al256(o + (size_t)1024 * 256 * 2);
  w.W_lru = o; o = al256(o + (size_t)2048 * 256 * 2);
  w.W_br = o; o = al256(o + (size_t)4 * 1024 * 512 * 2);
  w.W_out = o; o = al256(o + (size_t)1024 * 1024 * 2);
  w.W_q = o; o = al256(o + (size_t)1024 * 1024 * 2);
  w.W_key = o; o = al256(o + (size_t)2048 * 256 * 2);
  size_t rl = o;
  w.XC = o; o = al256(o + (size_t)TT * 512 * 2);
  w.LA = o; o = al256(o + (size_t)2 * TT * 512 * 2);
  w.LB = o; o = al256(o + (size_t)2 * TT * 512 * 2);
  size_t rl_end = o;
  o = rl;
  w.TKs = o; o = al256(o + (size_t)TT * 256 * 4);
  w.TKi = o; o = al256(o + (size_t)TT * 256 * 4);
  w.SELi = o; o = al256(o + (size_t)TT * 128 * 4);
  w.SELg = o; o = al256(o + (size_t)TT * 128 * 4);
  w.W = o; o = al256(o + (size_t)TT * 128 * 4);
  if (o > rl_end) rl_end = o;
  o = rl_end;
  size_t rp = o;
  w.P = o; o = al256(o + (size_t)TT * PC * 2);
  w.QA = o; o = al256(o + (size_t)TT * 768 * 2);
  w.KVA = o; o = al256(o + (size_t)TT * 1024 * 2);
  size_t rp_end = o;
  o = rp;
  w.M = o; o = al256(o + (size_t)TT * D * 2);
  w.Gs = o; o = al256(o + (size_t)TT * D * 2);
  w.SC = o; o = al256(o + (size_t)TT * 2048 * sizeof(sc_t));
  if (o > rp_end) rp_end = o;
  w.total = rp_end;
  return w;
}
constexpr WsLayout WL = make_layout();
static_assert(WL.total <= (size_t)512 * 1024 * 1024, "workspace too large");
struct Params {
  const float* in[N_IN];
  float* out;
  char* ws;
  MDEV float* xcur() const { return (float*)(ws + WL.xcur); }
  MDEV float* mods() const { return (float*)(ws + WL.mods); }
  MDEV float* hdn2() const { return (float*)(ws + WL.hdn2); }
  MDEV float* ssq() const { return (float*)(ws + WL.ssq); }
  MDEV float* tabA() const { return (float*)(ws + WL.tabA); }
  MDEV float* tabD() const { return (float*)(ws + WL.tabD); }
  MDEV float* fnorm() const { return (float*)(ws + WL.fnorm); }
  MDEV bf* h() const { return (bf*)(ws + WL.h); }
  MDEV bf* Y() const { return (bf*)(ws + WL.Y); }
  MDEV bf* Z() const { return (bf*)(ws + WL.Z); }
  MDEV bf* XC() const { return (bf*)(ws + WL.XC); }
  MDEV bf* LA() const { return (bf*)(ws + WL.LA); }
  MDEV bf* LB() const { return (bf*)(ws + WL.LB); }
  MDEV bf* P() const { return (bf*)(ws + WL.P); }
  MDEV bf* QA() const { return (bf*)(ws + WL.QA); }
  MDEV bf* KVA() const { return (bf*)(ws + WL.KVA); }
  MDEV float* F() const { return out; }
  MDEV bf* W_in() const { return (bf*)(ws + WL.W_in); }
  MDEV bf* W_g() const { return (bf*)(ws + WL.W_g); }
  MDEV bf* W_uq() const { return (bf*)(ws + WL.W_uq); }
  MDEV bf* W_ukv() const { return (bf*)(ws + WL.W_ukv); }
  MDEV bf* W_lru() const { return (bf*)(ws + WL.W_lru); }
  MDEV bf* W_br() const { return (bf*)(ws + WL.W_br); }
  MDEV bf* W_out() const { return (bf*)(ws + WL.W_out); }
  MDEV bf* W_q() const { return (bf*)(ws + WL.W_q); }
  MDEV bf* W_key() const { return (bf*)(ws + WL.W_key); }
  MDEV bf* M() const { return (bf*)(ws + WL.M); }
  MDEV bf* Gs() const { return (bf*)(ws + WL.Gs); }
  MDEV bf* PQ() const { return (bf*)(ws + WL.Gs); }
  MDEV sc_t* SC() const { return (sc_t*)(ws + WL.SC); }
  MDEV float* TKs() const { return (float*)(ws + WL.TKs); }
  MDEV int* TKi() const { return (int*)(ws + WL.TKi); }
  MDEV int* SELi() const { return (int*)(ws + WL.SELi); }
  MDEV float* SELg() const { return (float*)(ws + WL.SELg); }
  MDEV float* W() const { return (float*)(ws + WL.W); }
};
static_assert((size_t)(N + LC) * 1024 <= (size_t)NLAT * D, "F must fit in d_out");

DEV float sigmoidf_(float x) { return 1.0f / (1.0f + expf(-x)); }
DEV float siluf_(float x) { return x * sigmoidf_(x); }
DEV float geluf_(float x) { return 0.5f * x * (1.0f + tanhf(0.7978845608028654f * (x + 0.044715f * x * x * x))); }
DEV float softplusf_(float x) { return x > 20.f ? x : log1pf(expf(x)); }

struct RowInfo { int b, t, L, base, lat; };
DEV RowInfo rowinfo(int r) {
  RowInfo ri;
  if (r < NLAT) { ri.b = r / N; ri.t = r - ri.b * N; ri.L = N; ri.base = ri.b * N; ri.lat = 1; }
  else { int rc = r - NLAT; ri.b = rc / LC; ri.t = rc - ri.b * LC; ri.L = LC; ri.base = NLAT + ri.b * LC; ri.lat = 0; }
  return ri;
}
DEV int modrow(int r) { return r < NLAT ? r / N : 2; }

DEV void atomic_addf(float* p, float v) {
#ifndef CPU_SIM
  atomicAdd(p, v);
#else
#pragma omp atomic
  *p += v;
#endif
}
DEV void store8bf(bf* dst, const float* v) {
#ifndef CPU_SIM
  uint4 w;
  w.x = (unsigned)f2b(v[0]).v | ((unsigned)f2b(v[1]).v << 16);
  w.y = (unsigned)f2b(v[2]).v | ((unsigned)f2b(v[3]).v << 16);
  w.z = (unsigned)f2b(v[4]).v | ((unsigned)f2b(v[5]).v << 16);
  w.w = (unsigned)f2b(v[6]).v | ((unsigned)f2b(v[7]).v << 16);
  *(uint4*)dst = w;
#else
  for (int j = 0; j < 8; ++j) dst[j] = f2b(v[j]);
#endif
}
DEV void load8bf(const bf* src, float* v) {
#ifndef CPU_SIM
  uint4 w = *(const uint4*)src;
  union { unsigned u; float f; } c;
  c.u = w.x << 16; v[0] = c.f; c.u = w.x & 0xFFFF0000u; v[1] = c.f;
  c.u = w.y << 16; v[2] = c.f; c.u = w.y & 0xFFFF0000u; v[3] = c.f;
  c.u = w.z << 16; v[4] = c.f; c.u = w.z & 0xFFFF0000u; v[5] = c.f;
  c.u = w.w << 16; v[6] = c.f; c.u = w.w & 0xFFFF0000u; v[7] = c.f;
#else
  for (int j = 0; j < 8; ++j) v[j] = b2f(src[j]);
#endif
}

DEV int win_src(int n) {
  if (n >= 3744) return -1;
  if (n >= C_KR && n < C_KR + 32) { int q = n - C_KR; int pi = q >> 1, wh = q & 1, half = pi >> 3, f = pi & 7; return C_KR + half * 16 + f + wh * 8; }
  if (n >= C_GQ && n < C_GKV + 128) { int q = n - C_GQ; int hh = q >> 6, d = q & 63; int pi = d >> 1, wh = d & 1, half = pi >> 4, f = pi & 15; return C_GQ + hh * 64 + half * 32 + f + wh * 16; }
  return n;
}
DEV int wuq_src(int n) {
  int hh = n / 96, d = n % 96;
  if (d < 64) return n;
  int q = d - 64; int pi = q >> 1, wh = q & 1, half = pi >> 3, f = pi & 7;
  return hh * 96 + 64 + half * 16 + f + wh * 8;
}

DEVN void ph_init(const Params& p, i64 gtid, i64 gsz) {
  const float* x = p.in[I_x]; const float* ctx = p.in[I_ctx];
  for (i64 i = gtid; i < (i64)TT * D; i += gsz) p.xcur()[i] = i < (i64)NLAT * D ? x[i] : ctx[i - (i64)NLAT * D];
  for (i64 i = gtid; i < 2 * 3 * 6 * D; i += gsz) {
    int l = (int)(i / (3 * 6 * D)); int rr = (int)((i / (6 * D)) % 3); int j = (int)(i % (6 * D));
    const float* cv = rr < 2 ? p.in[I_c] + rr * D : p.in[I_c_ctx];
    const float* w = p.in[I_w_mod] + (size_t)l * D * 6 * D;
    float acc = p.in[I_b_mod][l * 6 * D + j];
    for (int k = 0; k < D; ++k) acc += siluf_(cv[k]) * w[(size_t)k * 6 * D + j];
    p.mods()[i] = acc;
  }
  for (i64 i = gtid; i < (i64)2 * (N + LC) * 64; i += gsz) {
    int l = (int)(i / ((i64)(N + LC) * 64)); int tt = (int)((i / 64) % (N + LC)); int j2 = (int)(i % 64);
    int t, L; if (tt < N) { t = tt; L = N; } else { t = tt - N; L = LC; }
    float tn = (float)t / (float)(L - 1);
    float wt = 6.283185307179586f * (float)t / (float)L;
    const float* w1 = p.in[I_hy_w1] + l * 33 * 64; const float* b1 = p.in[I_hy_b1] + l * 64; const float* f1 = p.in[I_hy_f1] + l * 64;
    const float* w2 = p.in[I_hy_w2] + l * 64 * 64; const float* b2 = p.in[I_hy_b2] + l * 64; const float* f2 = p.in[I_hy_f2] + l * 64;
    float acc2 = b2[j2];
    for (int k1 = 0; k1 < 64; ++k1) {
      float a1 = b1[k1] + tn * w1[k1];
      for (int bd = 0; bd < 16; ++bd) {
        float band = 1e-4f + (float)bd * ((15.0f - 1e-4f) / 15.0f);
        float ang = band * wt;
        a1 += cosf(ang) * w1[(1 + bd) * 64 + k1] - sinf(ang) * w1[(17 + bd) * 64 + k1];
      }
      acc2 += sinf(f1[k1] * a1) * w2[k1 * 64 + j2];
    }
    p.hdn2()[i] = sinf(f2[j2] * acc2);
  }
  for (i64 i = gtid; i < 128 * 8; i += gsz) {
    int pos = (int)(i / 8), f = (int)(i % 8);
    float ang = (float)pos * powf(10000.0f, -(float)f / 8.0f);
    p.tabA()[i * 2] = cosf(ang); p.tabA()[i * 2 + 1] = sinf(ang);
  }
  for (i64 i = gtid; i < 128 * 16; i += gsz) {
    int pos = (int)(i / 16), f = (int)(i % 16);
    float ang = (float)pos * powf(10000.0f, -(float)f / 16.0f);
    p.tabD()[i * 2] = cosf(ang); p.tabD()[i * 2 + 1] = sinf(ang);
  }
}

DEVN void ph_prep(const Params& p, int l, i64 gtid, i64 gsz) {
  {
    const float* w = p.in[I_w_in] + (size_t)l * D * INC;
    for (i64 i = gtid; i < (i64)1024 * 3840; i += gsz) {
      int k = (int)(i / 3840), n = (int)(i % 3840);
      int s = win_src(n);
      p.W_in()[(size_t)n * 1024 + k] = f2b(s < 0 ? 0.f : w[(size_t)k * INC + s]);
    }
    for (i64 i = gtid; i < (i64)1024 * 4096; i += gsz) {
      int k = (int)(i / 4096), n = (int)(i % 4096);
      p.W_g()[(size_t)n * 1024 + k] = f2b(w[(size_t)k * INC + C_GT + n]);
    }
  }
  {
    const float* w = p.in[I_mla_w_uq] + (size_t)l * 256 * 768; const float* g = p.in[I_mla_g_cq] + l * 256;
    for (i64 i = gtid; i < 256 * 768; i += gsz) { int k = (int)(i / 768), n = (int)(i % 768); p.W_uq()[(size_t)n * 256 + k] = f2b(g[k] * w[(size_t)k * 768 + wuq_src(n)]); }
  }
  {
    const float* w = p.in[I_mla_w_ukv] + (size_t)l * 128 * 1024; const float* g = p.in[I_mla_g_ckv] + l * 128;
    for (i64 i = gtid; i < 256 * 1024; i += gsz) { int k = (int)(i / 1024), n = (int)(i % 1024); p.W_ukv()[(size_t)n * 256 + k] = f2b(k < 128 ? g[k] * w[(size_t)k * 1024 + n] : 0.f); }
  }
  {
    for (i64 i = gtid; i < 2048 * 256; i += gsz) {
      int n = (int)(i / 256), k = (int)(i % 256);
      int kw = n >> 10, dir = (n >> 9) & 1, blk4 = (n >> 7) & 3, jc = (n & 127) >> 1, gate = n & 1;
      float v = 0.f;
      if ((k >> 6) == blk4) {
        const float* wsrc = p.in[gate ? I_lru_w_i : I_lru_w_r] + ((((size_t)l * 2 + dir) * 8 + kw * 4 + blk4) * 64 + (k & 63)) * 64 + jc;
        v = *wsrc;
      }
      p.W_lru()[i] = f2b(v);
    }
  }
  {
    const float* w = p.in[I_w_branch] + (size_t)l * 4 * 512 * D;
    for (i64 i = gtid; i < (i64)4 * 512 * 1024; i += gsz) {
      int br = (int)(i / (512 * 1024)), k = (int)((i / 1024) % 512), n = (int)(i % 1024);
      p.W_br()[((size_t)br * 1024 + n) * 512 + k] = f2b(w[i]);
    }
  }
  {
    const float* w = p.in[I_w_out] + (size_t)l * D * D; const float* wq = p.in[I_peer_w_q] + (size_t)l * D * 1024;
    for (i64 i = gtid; i < (i64)1024 * 1024; i += gsz) {
      int k = (int)(i / 1024), n = (int)(i % 1024);
      p.W_out()[(size_t)n * 1024 + k] = f2b(w[i]);
      p.W_q()[(size_t)n * 1024 + k] = f2b(wq[i]);
    }
  }
  {
    const float* keys = p.in[I_peer_keys] + (size_t)l * 16 * 128 * 64;
    for (i64 i = gtid; i < 2048 * 256; i += gsz) {
      int n = (int)(i / 256), k = (int)(i % 256);
      int hp = n >> 7, key = n & 127;
      float v = ((k >> 6) == (hp & 3)) ? keys[((size_t)hp * 128 + key) * 64 + (k & 63)] : 0.f;
      p.W_key()[i] = f2b(v);
    }
  }
}

DEVN void ph_norm(const Params& p, int l, int which, int nrows, i64 gtid, i64 gsz) {
  const float* g = p.in[which ? I_g_ffn : I_g_mix] + l * D;
  for (i64 r = gtid; r < nrows; r += gsz) {
    const float* xr = p.xcur() + (size_t)r * D;
    float ss = 0.f;
    for (int k = 0; k < D; ++k) ss += xr[k] * xr[k];
    float rstd = 1.0f / sqrtf(ss / D + EPS);
    const float* md = p.mods() + ((size_t)l * 3 + modrow((int)r)) * 6 * D + (which ? 3 * D : 0);
    for (int k = 0; k < D; ++k) p.h()[(size_t)r * D + k] = f2b(xr[k] * rstd * g[k] * (1.0f + md[D + k]) + md[k]);
  }
}

DEVN void ph_B0(const Params& p, int l, i64 gtid, i64 gsz) {
#ifndef CPU_SIM
  {
    const int lane = (int)(gtid & 63);
    for (i64 r = gtid >> 6; r < TT; r += gsz >> 6) {
      const bf* pr = p.P() + (size_t)r * PC;
      uint2 a = *(const uint2*)(pr + C_CQ + lane * 4);
      unsigned b = *(const unsigned*)(pr + C_CKV + lane * 2);
      union { unsigned u; float f; } c;
      float sq = 0.f, sk = 0.f;
      c.u = a.x << 16; sq += c.f * c.f; c.u = a.x & 0xFFFF0000u; sq += c.f * c.f;
      c.u = a.y << 16; sq += c.f * c.f; c.u = a.y & 0xFFFF0000u; sq += c.f * c.f;
      c.u = b << 16; sk += c.f * c.f; c.u = b & 0xFFFF0000u; sk += c.f * c.f;
#pragma unroll
      for (int o = 32; o >= 1; o >>= 1) { sq += __shfl_xor(sq, o); sk += __shfl_xor(sk, o); }
      if (lane == 0) { p.ssq()[r] = sq; p.ssq()[TT + r] = sk; }
    }
  }
#else
  for (i64 r = gtid; r < TT; r += gsz) {
    const bf* pr = p.P() + (size_t)r * PC;
    float sq = 0.f, sk = 0.f;
    for (int k = 0; k < 256; ++k) { float v = b2f(pr[C_CQ + k]); sq += v * v; }
    for (int k = 0; k < 128; ++k) { float v = b2f(pr[C_CKV + k]); sk += v * v; }
    p.ssq()[r] = sq; p.ssq()[TT + r] = sk;
  }
#endif
  {
    const float* cw = p.in[I_lru_conv_w] + l * 4 * 512; const float* cb = p.in[I_lru_conv_b] + l * 512;
    for (i64 i = gtid; i < (i64)TT * 512; i += gsz) {
      int r = (int)(i / 512), c = (int)(i % 512);
      RowInfo ri = rowinfo(r);
      float acc = cb[c];
      for (int k = 0; k < 4; ++k) {
        int ts = ri.t - 1 + k;
        if (ts >= 0 && ts < ri.L) acc += cw[k * 512 + c] * b2f(p.P()[(size_t)(ri.base + ts) * PC + C_LX + c]);
      }
      p.XC()[i] = f2b(acc);
    }
  }
  {
    const float* cw = p.in[I_hy_conv_w] + l * 3 * 1536; const float* cb = p.in[I_hy_conv_b] + l * 1536;
    for (i64 i = gtid; i < (i64)TT * 512; i += gsz) {
      int r = (int)(i / 512), c = (int)(i % 512);
      RowInfo ri = rowinfo(r);
      float a1 = cb[512 + c], a2 = cb[1024 + c];
      for (int k = 0; k < 3; ++k) {
        int ts = ri.t - 1 + k;
        if (ts >= 0 && ts < ri.L) {
          const bf* pr = p.P() + (size_t)(ri.base + ts) * PC + C_HU;
          a1 += cw[k * 1536 + 512 + c] * b2f(pr[512 + c]);
          a2 += cw[k * 1536 + 1024 + c] * b2f(pr[1024 + c]);
        }
      }
      p.Z()[i] = f2b(a1 * a2);
    }
  }
  {
    const float* w3 = p.in[I_hy_w3] + (size_t)l * 64 * 1024;
    const float maxd = logf(1e-2f) / 0.3f, mind = logf(1e-2f) / 1.5f;
    for (i64 i = gtid; i < (i64)(N + LC) * 1024; i += gsz) {
      int tt = (int)(i / 1024), j = (int)(i % 1024);
      int t, L; if (tt < N) { t = tt; L = N; } else { t = tt - N; L = LC; }
      const float* hd = p.hdn2() + ((size_t)l * (N + LC) + tt) * 64;
      float acc = 0.f;
      for (int k = 0; k < 64; ++k) acc += hd[k] * w3[k * 1024 + j];
      float tn = (float)t / (float)(L - 1);
      float delta = mind + (float)j * ((maxd - mind) / 1023.0f);
      p.F()[i] = acc * expf(-tn * fabsf(delta));
    }
  }
}

DEVN void ph_fnorm(const Params& p, i64 gtid, i64 gsz) {
  for (i64 i = gtid; i < 2 * 512; i += gsz) {
    int which = (int)(i / 512), c = (int)(i % 512);
    int L = which ? LC : N; int off = which ? N : 0;
    float ss = 0.f;
    for (int t = 0; t < L; ++t) { float a = p.F()[(size_t)(off + t) * 1024 + c], b = p.F()[(size_t)(off + t) * 1024 + 512 + c]; ss += a * a + b * b; }
    p.fnorm()[i] = 1.0f / sqrtf(ss + EPS);
  }
}

DEVN void ph_C(const Params& p, int l, int last, i64 gtid, i64 gsz) {
  const int QR = last ? NLAT : TT;
  for (i64 i = gtid; i < (i64)8 * QR; i += gsz) {
    int hh = (int)(i / QR), r = (int)(i % QR);
    RowInfo ri = rowinfo(r);
    float q[96];
#pragma unroll
    for (int d = 0; d < 96; ++d) q[d] = b2f(p.QA()[(size_t)r * 768 + hh * 96 + d]);
    float o[64];
#pragma unroll
    for (int d = 0; d < 64; ++d) o[d] = 0.f;
    float m = -1e30f, lsum = 0.f;
    const float scale = 0.10206207261596577f;
    int nseg = ri.lat ? 2 : 1;
    for (int sg = 0; sg < nseg; ++sg) {
      int kb, kn_;
      if (ri.lat && sg == 0) { kb = ri.b * N; kn_ = N; } else { kb = NLAT + ri.b * LC; kn_ = LC; }
      for (int kk = 0; kk < kn_; ++kk) {
        const bf* kr_ = p.KVA() + (size_t)(kb + kk) * 1024 + hh * 128;
        const bf* krp = p.P() + (size_t)(kb + kk) * PC + C_KR;
        float s = 0.f;
#pragma unroll
        for (int d = 0; d < 64; ++d) s += q[d] * b2f(kr_[d]);
#pragma unroll
        for (int d = 0; d < 32; ++d) s += q[64 + d] * b2f(krp[d]);
        s *= scale;
        float mn = fmaxf(m, s);
        float corr = expf(m - mn), pe = expf(s - mn);
        lsum = lsum * corr + pe;
#pragma unroll
        for (int d = 0; d < 64; ++d) o[d] = o[d] * corr + pe * b2f(kr_[64 + d]);
        m = mn;
      }
    }
    float inv = 1.0f / lsum;
#pragma unroll
    for (int d = 0; d < 64; ++d) p.Y()[(size_t)r * 2048 + hh * 64 + d] = f2b(o[d] * inv);
  }
  for (i64 i = gtid; i < 2 * 512; i += gsz) {
    int b = (int)(i / 512), c = (int)(i % 512);
    size_t cb = (size_t)(NLAT + b * LC), lb = (size_t)b * N;
    {
      const bf* la = p.LA(); bf* lbp = p.LB();
      float hst = 0.f;
      for (int t = 0; t < LC; ++t) { size_t ix = (cb + t) * 512 + c; hst = expf(b2f(la[ix])) * hst + b2f(lbp[ix]); lbp[ix] = f2b(hst); }
      for (int t = 0; t < N; ++t) { size_t ix = (lb + t) * 512 + c; hst = expf(b2f(la[ix])) * hst + b2f(lbp[ix]); lbp[ix] = f2b(hst); }
    }
    {
      const bf* la = p.LA() + (size_t)TT * 512; bf* lbp = p.LB() + (size_t)TT * 512;
      float hst = 0.f;
      for (int t = LC - 1; t >= 0; --t) { size_t ix = (cb + t) * 512 + c; hst = expf(b2f(la[ix])) * hst + b2f(lbp[ix]); lbp[ix] = f2b(hst); }
      for (int t = N - 1; t >= 0; --t) { size_t ix = (lb + t) * 512 + c; hst = expf(b2f(la[ix])) * hst + b2f(lbp[ix]); lbp[ix] = f2b(hst); }
    }
    for (int s = 0; s < 2; ++s) {
      size_t rb = s ? cb : lb; int L = s ? LC : N;
      if (s && last) break;
      for (int t = 0; t < L; ++t) {
        size_t r = rb + t;
        float hs = b2f(p.LB()[r * 512 + c]) + b2f(p.LB()[((size_t)TT + r) * 512 + c]);
        float lg = b2f(p.P()[r * PC + C_LG + c]);
        p.Y()[r * 2048 + 512 + c] = f2b(geluf_(lg) * hs);
      }
    }
  }
  {
    const float* cw = p.in[I_hy_conv_w] + l * 3 * 1536; const float* cb = p.in[I_hy_conv_b] + l * 1536;
    const float* skip = p.in[I_hy_skip] + l * 512;
    for (i64 i = gtid; i < (i64)QR * 512; i += gsz) {
      int r = (int)(i / 512), c = (int)(i % 512);
      RowInfo ri = rowinfo(r);
      int foff = ri.lat ? 0 : N;
      float acc = 0.f;
      for (int s = 0; s < ri.L; ++s) {
        int dd = ri.t - s;
        float fv = dd >= 0 ? p.F()[(size_t)(foff + dd) * 1024 + c] : p.F()[(size_t)(foff - dd) * 1024 + 512 + c];
        acc += fv * b2f(p.Z()[(size_t)(ri.base + s) * 512 + c]);
      }
      acc *= p.fnorm()[(ri.lat ? 0 : 512) + c];
      float x0 = cb[c];
      for (int k = 0; k < 3; ++k) {
        int ts = ri.t - 1 + k;
        if (ts >= 0 && ts < ri.L) x0 += cw[k * 1536 + c] * b2f(p.P()[(size_t)(ri.base + ts) * PC + C_HU + c]);
      }
      float y = acc + skip[c] * b2f(p.Z()[(size_t)r * 512 + c]);
      p.Y()[(size_t)r * 2048 + 1024 + c] = f2b(x0 * y);
    }
  }
  for (i64 i = gtid; i < (i64)8 * QR; i += gsz) {
    int hh = (int)(i / QR), r = (int)(i % QR);
    RowInfo ri = rowinfo(r);
    int kh = hh / 4;
    float q[64];
#pragma unroll
    for (int d = 0; d < 64; ++d) q[d] = b2f(p.P()[(size_t)r * PC + C_GQ + hh * 64 + d]);
    float o[64];
#pragma unroll
    for (int d = 0; d < 64; ++d) o[d] = 0.f;
    float m = p.in[I_gqa_sink][l * 8 + hh], lsum = 1.0f;
    int nseg = ri.lat ? 2 : 1;
    for (int sg = 0; sg < nseg; ++sg) {
      int k0, k1;
      if (ri.lat && sg == 0) { int lo = ri.t - 128; if (lo < 0) lo = 0; int hi = ri.t + 128; if (hi > N - 1) hi = N - 1; k0 = ri.b * N + lo; k1 = ri.b * N + hi + 1; }
      else { k0 = NLAT + ri.b * LC; k1 = k0 + LC; }
      for (int kk = k0; kk < k1; ++kk) {
        const bf* kp = p.P() + (size_t)kk * PC + C_GKV + kh * 64;
        const bf* vp = kp + 128;
        float s = 0.f;
#pragma unroll
        for (int d = 0; d < 64; ++d) s += q[d] * b2f(kp[d]);
        s *= 0.125f;
        float mn = fmaxf(m, s);
        float corr = expf(m - mn), pe = expf(s - mn);
        lsum = lsum * corr + pe;
#pragma unroll
        for (int d = 0; d < 64; ++d) o[d] = o[d] * corr + pe * b2f(vp[d]);
        m = mn;
      }
    }
    float inv = 1.0f / lsum;
#pragma unroll
    for (int d = 0; d < 64; ++d) p.Y()[(size_t)r * 2048 + 1536 + hh * 64 + d] = f2b(o[d] * inv);
  }
}

DEVN void ph_E2a(const Params& p, int nrows, i64 gtid, i64 gsz) {
  for (i64 i = gtid; i < (i64)nrows * 16; i += gsz) {
    const sc_t* s_ = p.SC() + (size_t)i * 128;
    float ps = 3.0e38f; int pi = -1;
    for (int k = 0; k < 16; ++k) {
      float bs = -3.0e38f; int bi = -1;
      for (int j = 0; j < 128; ++j) {
        float s = (float)s_[j];
        bool elig = (s < ps) || (s == ps && j > pi);
        if (elig && (s > bs)) { bs = s; bi = j; }
      }
      p.TKs()[(size_t)i * 16 + k] = bs; p.TKi()[(size_t)i * 16 + k] = bi;
      ps = bs; pi = bi;
    }
  }
}

DEVN void ph_E2b(const Params& p, int nrows, i64 gtid, i64 gsz) {
  for (i64 i = gtid; i < (i64)nrows * 8; i += gsz) {
    const float* s1 = p.TKs() + (size_t)i * 32; const float* s2 = s1 + 16;
    const int* i1 = p.TKi() + (size_t)i * 32; const int* i2 = i1 + 16;
    float ps = 3.0e38f; int pi = -1;
    float mx = 0.f;
    for (int k = 0; k < 16; ++k) {
      float bs = -3.0e38f; int bi = -1;
      for (int j = 0; j < 256; ++j) {
        float s = s1[j >> 4] + s2[j & 15];
        bool elig = (s < ps) || (s == ps && j > pi);
        if (elig && (s > bs)) { bs = s; bi = j; }
      }
      if (k == 0) mx = bs;
      p.SELi()[(size_t)i * 16 + k] = i1[bi >> 4] * 128 + i2[bi & 15];
      p.SELg()[(size_t)i * 16 + k] = expf(bs - mx);
      ps = bs; pi = bi;
    }
    float sum = 0.f;
    for (int k = 0; k < 16; ++k) sum += p.SELg()[(size_t)i * 16 + k];
    float inv = 1.0f / sum;
    for (int k = 0; k < 16; ++k) p.SELg()[(size_t)i * 16 + k] *= inv;
  }
}

DEVN void ph_E3(const Params& p, int l, int nrows, i64 gtid, i64 gsz) {
  const float* u = p.in[I_peer_u] + (size_t)l * NEXP * D;
  for (i64 i = gtid; i < (i64)nrows * 128; i += gsz) {
    int r = (int)(i / 128);
    const float* ur = u + (size_t)p.SELi()[i] * D;
    const bf* hr = p.h() + (size_t)r * D;
    float acc = 0.f;
    for (int k = 0; k < D; ++k) acc += b2f(hr[k]) * ur[k];
    p.W()[i] = p.SELg()[i] * geluf_(acc);
  }
}

DEVN void ph_E4(const Params& p, int l, int nrows, i64 gtid, i64 gsz) {
  const float* v = p.in[I_peer_v] + (size_t)l * NEXP * D;
  for (i64 i = gtid; i < (i64)nrows * D; i += gsz) {
    int r = (int)(i / D), n = (int)(i % D);
    float acc = 0.f;
    for (int j = 0; j < 128; ++j) acc += p.W()[(size_t)r * 128 + j] * v[(size_t)p.SELi()[(size_t)r * 128 + j] * D + n];
    float g2 = p.mods()[((size_t)l * 3 + modrow(r)) * 6 * D + 5 * D + n];
    p.xcur()[i] += g2 * acc;
  }
}

DEVN void ph_final(const Params& p, i64 gtid, i64 gsz) {
  const float* g = p.in[I_g_final];
  for (i64 r = gtid; r < NLAT; r += gsz) {
    const float* xr = p.xcur() + (size_t)r * D;
    float ss = 0.f;
    for (int k = 0; k < D; ++k) ss += xr[k] * xr[k];
    float rstd = 1.0f / sqrtf(ss / D + EPS);
    for (int k = 0; k < D; ++k) p.out[(size_t)r * D + k] = xr[k] * rstd * g[k];
  }
}

DEV void rope4(float* v, const float* tab, int nf, int pos, int f0) {
#pragma unroll
  for (int jj = 0; jj < 4; ++jj) {
    float c = tab[(pos * nf + f0 + jj) * 2], s = tab[(pos * nf + f0 + jj) * 2 + 1];
    float x1 = v[2 * jj], x2 = v[2 * jj + 1];
    v[2 * jj] = x1 * c - x2 * s; v[2 * jj + 1] = x1 * s + x2 * c;
  }
}
struct EpiInproj {
  static constexpr int W = 8;
  const Params& p;
  MDEV void apply(int r, int c0, float* v) const {
    if (c0 >= 3744) return;
    if (c0 >= 384 && r < NLAT) {
      int t = r % N;
      if (c0 < C_KR + 32) { int pi = (c0 - C_KR) >> 1; int half = pi >> 3; rope4(v, p.tabA(), 8, half ? t % GRIDW : t / GRIDW, pi & 7); }
      else if (c0 >= C_GQ && c0 < C_GKV + 128) { int pi = ((c0 - C_GQ) & 63) >> 1; int half = pi >> 4; rope4(v, p.tabD(), 16, half ? t % GRIDW : t / GRIDW, pi & 15); }
    }
    store8bf(p.P() + (size_t)r * PC + c0, v);
  }
};
struct EpiUq {
  static constexpr int W = 8;
  const Params& p;
  MDEV void apply(int r, int c0, float* v) const {
    float rstd = 1.0f / sqrtf(p.ssq()[r] * (1.0f / 256.0f) + EPS);
#pragma unroll
    for (int j = 0; j < 8; ++j) v[j] *= rstd;
    int d0 = c0 % 96;
    if (d0 >= 64 && r < NLAT) { int t = r % N; int pi = (d0 - 64) >> 1; int half = pi >> 3; rope4(v, p.tabA(), 8, half ? t % GRIDW : t / GRIDW, pi & 7); }
    store8bf(p.QA() + (size_t)r * 768 + c0, v);
  }
};
struct EpiUkv {
  static constexpr int W = 8;
  const Params& p;
  MDEV void apply(int r, int c0, float* v) const {
    float rstd = 1.0f / sqrtf(p.ssq()[TT + r] * (1.0f / 128.0f) + EPS);
#pragma unroll
    for (int j = 0; j < 8; ++j) v[j] *= rstd;
    store8bf(p.KVA() + (size_t)r * 1024 + c0, v);
  }
};
struct EpiLru {
  static constexpr int W = 8;
  const Params& p; int l;
  MDEV void apply(int r, int c0, float* v) const {
    int kw = c0 >> 10, dir = (c0 >> 9) & 1, blk4 = (c0 >> 7) & 3, jc0 = (c0 & 127) >> 1;
    int cb = kw * 256 + blk4 * 64 + jc0;
    const float* br = p.in[I_lru_b_r] + (l * 2 + dir) * 512 + cb;
    const float* bi = p.in[I_lru_b_i] + (l * 2 + dir) * 512 + cb;
    const float* lam = p.in[I_lru_lam] + (l * 2 + dir) * 512 + cb;
    bf* la = p.LA() + ((size_t)dir * TT + r) * 512 + cb;
    bf* lb = p.LB() + ((size_t)dir * TT + r) * 512 + cb;
#pragma unroll
    for (int jj = 0; jj < 4; ++jj) {
      float rg = sigmoidf_(v[2 * jj] + br[jj]), ig = sigmoidf_(v[2 * jj + 1] + bi[jj]);
      float log_a = -8.0f * rg * softplusf_(-lam[jj]);
      float bt = sqrtf(-expm1f(2.0f * log_a)) * ig * b2f(p.XC()[(size_t)r * 512 + cb + jj]);
      la[jj] = f2b(log_a); lb[jj] = f2b(bt);
    }
  }
};
struct EpiGate {
  static constexpr int W = 8;
  const Params& p;
  MDEV void apply(int r, int c0, float* v) const {
#pragma unroll
    for (int j = 0; j < 8; ++j) v[j] = sigmoidf_(v[j]);
    store8bf(p.Gs() + (size_t)r * D + c0, v);
  }
};
struct EpiBranch {
  static constexpr int W = 8;
  const Params& p; int br;
  MDEV void apply(int r, int c0, float* v) const {
    float g[8]; load8bf(p.Gs() + (size_t)r * D + c0, g);
    if (br > 0) {
      float mo[8]; load8bf(p.M() + (size_t)r * D + c0, mo);
#pragma unroll
      for (int j = 0; j < 8; ++j) v[j] = mo[j] + g[j] * v[j];
    } else {
#pragma unroll
      for (int j = 0; j < 8; ++j) v[j] = g[j] * v[j];
    }
    store8bf(p.M() + (size_t)r * D + c0, v);
  }
};
struct EpiOut {
  static constexpr int W = 4;
  const Params& p; int l;
  MDEV void apply(int r, int c0, float* v) const {
    const float* g1 = p.mods() + ((size_t)l * 3 + modrow(r)) * 6 * D + 2 * D + c0;
    float* xr = p.xcur() + (size_t)r * D + c0;
#pragma unroll
    for (int j = 0; j < 4; ++j) xr[j] += g1[j] * v[j];
  }
};
struct EpiPQ {
  static constexpr int W = 8;
  const Params& p;
  MDEV void apply(int r, int c0, float* v) const { store8bf(p.PQ() + (size_t)r * 1024 + c0, v); }
};
struct EpiSC {
  static constexpr int W = 8;
  const Params& p;
  MDEV void apply(int r, int c0, float* v) const {
    sc_t* d = p.SC() + (size_t)r * 2048 + c0;
#pragma unroll
    for (int j = 0; j < 8; ++j) d[j] = (sc_t)v[j];
  }
};

struct GemmDesc { const bf* A; const bf* Bt; int lda, ldb, K, nrows, ncols; int a_pn_shift, a_pn_mul; };

#ifndef CPU_SIM
namespace pg8 {
#define PG8_LAS __attribute__((address_space(3)))
typedef short bf16x8 __attribute__((ext_vector_type(8)));
typedef float f32x4 __attribute__((ext_vector_type(4)));
constexpr int BM = 256, BK = 64, HALF = 128, HTB = HALF * BK * 2, STAGE_BYTES = 8 * HTB, NXCD = 8, WGM = 8;
__device__ __forceinline__ int lds_byte(int r, int c) { const int st = (r >> 4) * 2 + (c >> 5), rr = r & 15, cc = c & 31, ob = rr * 64 + cc * 2; return st * 1024 + (ob ^ (((ob >> 9) & 1) << 5)); }
__device__ __forceinline__ void stage_rc(int b, int& R, int& C) { const int st = b / 1024, sb = b % 1024, swz = sb ^ (((sb >> 9) & 1) << 5); R = (st >> 1) * 16 + swz / 64; C = (st & 1) * 32 + (swz % 64) / 2; }
__device__ __forceinline__ int perm32(int rho) { const int n = rho >> 4, i = rho & 15; return 8 * (i >> 2) + 4 * n + (i & 3); }
struct Unit { int pm, pn; };
struct StaticOrder {
  int nM, nN, nwg, G, c;
  __device__ void init(int nM_, int nN_, int G_, int c_) { nM = nM_; nN = nN_; nwg = nM * nN; G = G_; c = c_; }
  __device__ bool next(int i, Unit& u) const {
    const long L = (long)i * G + c; if (L >= nwg) return false;
    int wgid = (int)L; { const int q = nwg / NXCD, r = nwg % NXCD, xcd = wgid % NXCD, off = wgid / NXCD; wgid = (xcd < r ? xcd * (q + 1) : r * (q + 1) + (xcd - r) * q) + off; }
    const int nig = WGM * nN, gid = wgid / nig, fm = gid * WGM, gsz = (nM - fm) < WGM ? (nM - fm) : WGM;
    u.pm = fm + ((wgid % nig) % gsz); u.pn = (wgid % nig) / gsz; return true;
  }
};

template <class E>
__device__ __forceinline__ void epi_call(const E& e, const f32x4 (&acc)[2][2][4][2], const Unit& u, int wr, int wc, int fr_, int fq_) {
  int fr = fr_, fq = fq_;
  asm volatile("" : "+v"(fr), "+v"(fq));
#pragma unroll
  for (int ai = 0; ai < 2; ++ai)
#pragma unroll
    for (int m = 0; m < 4; ++m) {
      const int r = u.pm * BM + ai * HALF + wr * 64 + m * 16 + fr;
#pragma unroll
      for (int bj = 0; bj < 2; ++bj) {
        if constexpr (E::W == 8) {
          const int c0 = u.pn * BM + bj * HALF + wc * 32 + 8 * fq;
          float v[8];
#pragma unroll
          for (int j = 0; j < 4; ++j) { v[j] = acc[ai][bj][m][0][j]; v[4 + j] = acc[ai][bj][m][1][j]; }
          e.apply(r, c0, v);
          __builtin_amdgcn_sched_barrier(0);
        } else {
#pragma unroll
          for (int n = 0; n < 2; ++n) {
            const int c0 = u.pn * BM + bj * HALF + wc * 32 + 16 * n + 4 * fq;
            float v[4];
#pragma unroll
            for (int j = 0; j < 4; ++j) v[j] = acc[ai][bj][m][n][j];
            e.apply(r, c0, v);
            __builtin_amdgcn_sched_barrier(0);
          }
        }
      }
    }
}

template <class Epi>
__device__ __forceinline__ void gemm_phase(PG8_LAS unsigned char* lds, const int tid, const GemmDesc g, const Epi& E) {
  constexpr bool PERM = (Epi::W == 8);
  const int wid = __builtin_amdgcn_readfirstlane(tid >> 6), lane = tid & 63, wr = wid >> 2, wc = wid & 3, fr = lane & 15, fq = lane >> 4;
  const int K = g.K, nt = K / BK;
  StaticOrder S; S.init(g.nrows / BM, g.ncols / BM, (int)gridDim.x, (int)blockIdx.x);
  unsigned voffA[2], voffB[2];
#pragma unroll
  for (int i = 0; i < 2; ++i) { int R, C; stage_rc(tid * 16 + i * 8192, R, C); const int Rb = PERM ? ((R & ~31) + perm32(R & 31)) : R;
    voffA[i] = (unsigned)(R * g.lda + C) * 2u; voffB[i] = (unsigned)(Rb * g.ldb + C) * 2u; }
  const size_t kstep = (size_t)(BK * 2);
  const size_t hstepA = (size_t)HALF * g.lda * 2, hstepB = (size_t)HALF * g.ldb * 2;
  const unsigned ldsw = (unsigned)wid * 1024u;
  const int aoff = lds_byte(wr * 64 + fr, fq * 8), boff = lds_byte(wc * 32 + fr, fq * 8);
#define PG8_SA(b, h) (((b) * 2 + (h)) * HTB)
#define PG8_SB(b, h) ((4 + (b) * 2 + (h)) * HTB)
#define PG8_STAGE(bufoff, gbase, voff) do { _Pragma("unroll") for (int _i = 0; _i < 2; ++_i) \
        __builtin_amdgcn_global_load_lds((const unsigned*)((const char*)(gbase) + (voff)[_i]), (PG8_LAS unsigned*)(lds + (bufoff) + ldsw + _i * 8192), 16, 0, 0); } while (0)
#define PG8_LDA(dst, b, h) do { _Pragma("unroll") for (int m = 0; m < 4; ++m) _Pragma("unroll") for (int k = 0; k < 2; ++k) dst[m][k] = *(const PG8_LAS bf16x8*)(lds + PG8_SA(b, h) + aoff + m * 2048 + k * 1024); } while (0)
#define PG8_LDB(dst, b, h) do { _Pragma("unroll") for (int n = 0; n < 2; ++n) _Pragma("unroll") for (int k = 0; k < 2; ++k) dst[n][k] = *(const PG8_LAS bf16x8*)(lds + PG8_SB(b, h) + boff + n * 2048 + k * 1024); } while (0)
#define PG8_MMA(ai, bj, At, Bt) do { __builtin_amdgcn_s_setprio(1); _Pragma("unroll") for (int m = 0; m < 4; ++m) _Pragma("unroll") for (int n = 0; n < 2; ++n) _Pragma("unroll") for (int k = 0; k < 2; ++k) \
        acc[ai][bj][m][n] = __builtin_amdgcn_mfma_f32_16x16x32_bf16(Bt[n][k], At[m][k], acc[ai][bj][m][n], 0, 0, 0); __builtin_amdgcn_s_setprio(0); } while (0)
#define PG8_WAIT_V(n) asm volatile("s_waitcnt vmcnt(" #n ")" ::: "memory")
#define PG8_WAIT_L(n) asm volatile("s_waitcnt lgkmcnt(" #n ")" ::: "memory")
#define PG8_BAR __builtin_amdgcn_s_barrier()
#define PG8_SCHED __builtin_amdgcn_sched_barrier(0)
#define PG8_ABASE(u) ((const char*)g.A + ((size_t)(u).pm * BM * g.lda + (size_t)((u).pn >> g.a_pn_shift) * g.a_pn_mul) * 2)
#define PG8_BBASE(u) ((const char*)g.Bt + (size_t)(u).pn * BM * g.ldb * 2)
  Unit cur, nxt; int ui = 0;
  if (!S.next(0, cur)) return;
  f32x4 acc[2][2][4][2];
#pragma unroll
  for (int a = 0; a < 2; ++a)
#pragma unroll
    for (int b = 0; b < 2; ++b)
#pragma unroll
      for (int m = 0; m < 4; ++m)
#pragma unroll
        for (int n = 0; n < 2; ++n) acc[a][b][m][n] = (f32x4){0.f, 0.f, 0.f, 0.f};
  bf16x8 At[4][2], B0[2][2], B1[2][2];
  const char* cA = PG8_ABASE(cur); const char* cB = PG8_BBASE(cur);
  asm volatile("" : "+v"(voffA[0]), "+v"(voffA[1]), "+v"(voffB[0]), "+v"(voffB[1]));
  PG8_STAGE(PG8_SB(0, 0), cB, voffB); PG8_STAGE(PG8_SA(0, 0), cA, voffA); PG8_STAGE(PG8_SB(0, 1), cB + hstepB, voffB); PG8_STAGE(PG8_SA(0, 1), cA + hstepA, voffA);
  if (wr == 1) PG8_BAR;
  PG8_WAIT_V(4); PG8_BAR;
  PG8_STAGE(PG8_SB(1, 0), cB + kstep, voffB); PG8_STAGE(PG8_SA(1, 0), cA + kstep, voffA); PG8_STAGE(PG8_SB(1, 1), cB + hstepB + kstep, voffB);
  PG8_WAIT_V(6); PG8_BAR;
  for (;;) {
    const bool has_next = S.next(ui + 1, nxt);
    const char* nA = has_next ? PG8_ABASE(nxt) : cA; const char* nB = has_next ? PG8_BBASE(nxt) : cB;
    for (int t = 0; t < nt; t += 2) {
      const bool last = (t == nt - 2);
      asm volatile("" : "+v"(voffA[0]), "+v"(voffA[1]), "+v"(voffB[0]), "+v"(voffB[1]));
      const char* a1 = cA + (size_t)(t + 1) * kstep;
      const char* a2 = last ? nA : cA + (size_t)(t + 2) * kstep; const char* b2 = last ? nB : cB + (size_t)(t + 2) * kstep;
      const char* a3 = a2 + kstep; const char* b3 = b2 + kstep;
      PG8_LDB(B0, 0, 0); PG8_SCHED; PG8_LDA(At, 0, 0); PG8_STAGE(PG8_SA(1, 1), a1 + hstepA, voffA);
      PG8_WAIT_L(8); PG8_BAR; PG8_WAIT_L(0); PG8_MMA(0, 0, At, B0); PG8_BAR; PG8_SCHED;
      PG8_LDB(B1, 0, 1); PG8_STAGE(PG8_SB(0, 0), b2, voffB);
      PG8_BAR; PG8_WAIT_L(0); PG8_MMA(0, 1, At, B1); PG8_BAR;
      PG8_LDA(At, 0, 1); PG8_STAGE(PG8_SA(0, 0), a2, voffA);
      PG8_BAR; PG8_WAIT_L(0); PG8_MMA(1, 0, At, B0); PG8_BAR; PG8_SCHED;
      PG8_STAGE(PG8_SB(0, 1), b2 + hstepB, voffB);
      PG8_WAIT_V(6); PG8_BAR; PG8_MMA(1, 1, At, B1); PG8_BAR;
      PG8_LDB(B0, 1, 0); PG8_SCHED; PG8_LDA(At, 1, 0); PG8_STAGE(PG8_SA(0, 1), a2 + hstepA, voffA);
      PG8_WAIT_L(8); PG8_BAR; PG8_WAIT_L(0); PG8_MMA(0, 0, At, B0); PG8_BAR; PG8_SCHED;
      PG8_LDB(B1, 1, 1); PG8_STAGE(PG8_SB(1, 0), b3, voffB);
      PG8_BAR; PG8_WAIT_L(0); PG8_MMA(0, 1, At, B1); PG8_BAR;
      PG8_LDA(At, 1, 1); PG8_STAGE(PG8_SA(1, 0), a3, voffA);
      PG8_BAR; PG8_WAIT_L(0); PG8_MMA(1, 0, At, B0); PG8_BAR; PG8_SCHED;
      PG8_STAGE(PG8_SB(1, 1), b3 + hstepB, voffB);
      PG8_WAIT_V(6); PG8_BAR; PG8_MMA(1, 1, At, B1); PG8_BAR;
    }
    epi_call(E, acc, cur, wr, wc, fr, fq);
    if (!has_next) break;
#pragma unroll
    for (int a = 0; a < 2; ++a)
#pragma unroll
      for (int b = 0; b < 2; ++b)
#pragma unroll
        for (int m = 0; m < 4; ++m)
#pragma unroll
          for (int n = 0; n < 2; ++n) acc[a][b][m][n] = (f32x4){0.f, 0.f, 0.f, 0.f};
    cur = nxt; cA = nA; cB = nB; ++ui;
  }
  PG8_WAIT_V(0);
  if (wr == 0) PG8_BAR;
  PG8_BAR;
#undef PG8_SA
#undef PG8_SB
#undef PG8_STAGE
#undef PG8_LDA
#undef PG8_LDB
#undef PG8_MMA
#undef PG8_WAIT_V
#undef PG8_WAIT_L
#undef PG8_BAR
#undef PG8_SCHED
#undef PG8_ABASE
#undef PG8_BBASE
}
}
struct Ctx { i64 gtid, gsz; PG8_LAS unsigned char* lds; int tid; };
template <class E> DEV void run_gemm(const Ctx& cx, const GemmDesc& g, const E& e) { pg8::gemm_phase<E>(cx.lds, cx.tid, g, e); }
#else
struct Ctx { i64 gtid, gsz; };
template <class E> static void run_gemm(const Ctx& cx, const GemmDesc& g, const E& e) {
  constexpr int W = E::W;
  const int ng = g.ncols / W;
  for (i64 i = cx.gtid; i < (i64)g.nrows * ng; i += cx.gsz) {
    int r = (int)(i / ng), c0 = (int)(i % ng) * W;
    int pn = c0 / 256;
    const bf* a = g.A + (size_t)r * g.lda + (size_t)(pn >> g.a_pn_shift) * g.a_pn_mul;
    float v[8];
    for (int j = 0; j < W; ++j) {
      const bf* b = g.Bt + (size_t)(c0 + j) * g.ldb;
      float acc = 0.f;
      for (int k = 0; k < g.K; ++k) acc += b2f(a[k]) * b2f(b[k]);
      v[j] = acc;
    }
    e.apply(r, c0, v);
  }
}
#endif

constexpr int NOSH = 30;
constexpr int PH_PER_LAYER = 14;
constexpr int NPHASES = 2 + 2 * PH_PER_LAYER;

DEV void run_phase(const Params& p, int ph, const Ctx& cx) {
  const i64 gtid = cx.gtid, gsz = cx.gsz;
  if (ph == 0) { ph_init(p, gtid, gsz); return; }
  if (ph == NPHASES - 1) { ph_final(p, gtid, gsz); return; }
  const int l = (ph - 1) / PH_PER_LAYER, s = (ph - 1) % PH_PER_LAYER;
  const int last = (l == 1);
  const int nr = last ? NLAT : TT;
#ifdef ONLY
  if (s != ONLY) return;
#endif
  switch (s) {
    case 0: ph_prep(p, l, gtid, gsz); ph_norm(p, l, 0, TT, gtid, gsz); break;
    case 1: { GemmDesc g{p.h(), p.W_in(), D, D, D, TT, 3840, NOSH, 0}; EpiInproj e{p}; run_gemm(cx, g, e); } break;
    case 2: ph_B0(p, l, gtid, gsz); break;
    case 3: {
      { GemmDesc g{p.P() + C_CQ, p.W_uq(), PC, 256, 256, nr, 768, NOSH, 0}; EpiUq e{p}; run_gemm(cx, g, e); }
      { GemmDesc g{p.P() + C_CKV, p.W_ukv(), PC, 256, 256, TT, 1024, NOSH, 0}; EpiUkv e{p}; run_gemm(cx, g, e); }
      { GemmDesc g{p.XC(), p.W_lru(), 512, 256, 256, TT, 2048, 2, 256}; EpiLru e{p, l}; run_gemm(cx, g, e); }
      ph_fnorm(p, gtid, gsz);
    } break;
    case 4: ph_C(p, l, last, gtid, gsz); break;
    case 5:
      for (int br = 0; br < 4; ++br) {
        { GemmDesc g{p.h(), p.W_g() + (size_t)br * 1024 * 1024, D, D, D, nr, 1024, NOSH, 0}; EpiGate e{p}; run_gemm(cx, g, e); }
        { GemmDesc g{p.Y() + br * 512, p.W_br() + (size_t)br * 1024 * 512, 2048, 512, 512, nr, 1024, NOSH, 0}; EpiBranch e{p, br}; run_gemm(cx, g, e); }
      }
      break;
    case 6: { GemmDesc g{p.M(), p.W_out(), D, D, D, nr, 1024, NOSH, 0}; EpiOut e{p, l}; run_gemm(cx, g, e); } break;
    case 7: ph_norm(p, l, 1, nr, gtid, gsz); break;
    case 8: { GemmDesc g{p.h(), p.W_q(), D, D, D, nr, 1024, NOSH, 0}; EpiPQ e{p}; run_gemm(cx, g, e); } break;
    case 9: { GemmDesc g{p.PQ(), p.W_key(), 1024, 256, 256, nr, 2048, 1, 256}; EpiSC e{p}; run_gemm(cx, g, e); } break;
    case 10: ph_E2a(p, nr, gtid, gsz); break;
    case 11: ph_E2b(p, nr, gtid, gsz); break;
    case 12: ph_E3(p, l, nr, gtid, gsz); break;
    case 13: ph_E4(p, l, nr, gtid, gsz); break;
  }
}

static void fill_params(Params& p, void* const* d_in, void* d_out, void* d_ws) {
  for (int i = 0; i < N_IN; ++i) p.in[i] = (const float*)d_in[i];
  p.out = (float*)d_out;
  p.ws = (char*)d_ws;
}

#ifndef CPU_SIM
static_assert(TT % 256 == 0 && NLAT % 256 == 0, "row tiles");
constexpr int LDS_BYTES = 131072;
__global__ void __launch_bounds__(512, 2) mega_kernel(Params p) {
  extern __shared__ __attribute__((aligned(16))) unsigned char shm[];
  cg::grid_group grid = cg::this_grid();
  for (int ph = 0; ph < NPHASES; ++ph) {
    int tid = threadIdx.x;
    asm volatile("" : "+v"(tid));
    Ctx cx;
    cx.tid = tid;
    cx.gtid = (i64)blockIdx.x * 512 + tid; cx.gsz = (i64)gridDim.x * 512;
    cx.lds = (PG8_LAS unsigned char*)shm;
    run_phase(p, ph, cx);
    if (ph + 1 < NPHASES) grid.sync();
  }
}

extern "C" void kernel_launch(void* const* d_in, const int* in_sizes, int n_in, void* d_out, int out_size,
                              void* d_ws, size_t ws_size, hipStream_t stream) {
  static int grid_blocks = 0;
  if (!grid_blocks) {
    int dev = 0, cus = 0, per_cu = 0;
    (void)hipGetDevice(&dev);
    (void)hipDeviceGetAttribute(&cus, hipDeviceAttributeMultiprocessorCount, dev);
    if (hipFuncSetAttribute((const void*)mega_kernel, hipFuncAttributeMaxDynamicSharedMemorySize, LDS_BYTES) != hipSuccess)
      fprintf(stderr, "hipFuncSetAttribute failed\n");
    (void)hipOccupancyMaxActiveBlocksPerMultiprocessor(&per_cu, mega_kernel, 512, LDS_BYTES);
    if (per_cu > 1) per_cu = 1;
    if (per_cu < 1) per_cu = 1;
    grid_blocks = cus * per_cu;
  }
  Params p;
  std::memset((void*)&p, 0, sizeof(p));
  fill_params(p, d_in, d_out, d_ws);
  void* args[] = {&p};
  hipError_t e = hipLaunchCooperativeKernel((void*)mega_kernel, dim3(grid_blocks), dim3(512), args, LDS_BYTES, stream);
  if (e != hipSuccess) fprintf(stderr, "cooperative launch failed: %s (grid %d)\n", hipGetErrorString(e), grid_blocks);
}
#endif
```

```cpp
#ifndef CPU_SIM
#include <hip/hip_runtime.h>
#include <hip/hip_cooperative_groups.h>
#include <cstdio>
#include <cstring>
namespace cg = cooperative_groups;
#define DEV __device__ __forceinline__
#define DEVN __device__ __forceinline__
#define MDEV __device__ __forceinline__
typedef _Float16 sc_t;
#else
#include <cmath>
#include <cstdio>
#include <cstdint>
#include <cstring>
#define DEV static inline
#define DEVN static
#define MDEV inline
typedef float sc_t;
#endif

#ifndef SEQ_N
#define SEQ_N 8192
#endif
#ifndef CTX_L
#define CTX_L 256
#endif

typedef long long i64;

constexpr int D = 1024, NB = 2, N = SEQ_N, LC = CTX_L;
constexpr int NLAT = NB * N, NCTX = NB * LC, TT = NLAT + NCTX;
constexpr int GRIDW = 64;
constexpr int INC = 7840, PC = 3840;
constexpr int C_CQ = 0, C_CKV = 256, C_KR = 384, C_LX = 416, C_LG = 928, C_HU = 1440, C_GQ = 2976, C_GKV = 3488, C_GT = 3744;
constexpr int NEXP = 16384;
constexpr float EPS = 1e-6f;
constexpr int LCH = 64, NCC = LC / LCH, NCL = N / LCH, NCHK = NCC + NCL;

enum { I_x, I_c, I_ctx, I_c_ctx, I_g_mix, I_g_ffn, I_w_mod, I_b_mod, I_w_in, I_mla_g_cq, I_mla_g_ckv, I_mla_w_uq,
       I_mla_w_ukv, I_lru_conv_w, I_lru_conv_b, I_lru_w_r, I_lru_b_r, I_lru_w_i, I_lru_b_i, I_lru_lam,
       I_hy_conv_w, I_hy_conv_b, I_hy_w1, I_hy_b1, I_hy_f1, I_hy_w2, I_hy_b2, I_hy_f2, I_hy_w3, I_hy_skip,
       I_gqa_sink, I_w_branch, I_w_out, I_peer_w_q, I_peer_keys, I_peer_u, I_peer_v, I_g_final, N_IN };

struct bf { unsigned short v; };
DEV float b2f(bf x) { union { unsigned u; float f; } c; c.u = ((unsigned)x.v) << 16; return c.f; }
DEV bf f2b(float f) { union { unsigned u; float f; } c; c.f = f; unsigned r = c.u + 0x7FFFu + ((c.u >> 16) & 1u); bf o; o.v = (unsigned short)(r >> 16); return o; }


constexpr size_t al256(size_t x) { return (x + 255) & ~(size_t)255; }
struct WsLayout {
  size_t xcur, mods, hdn2, ssq, tabA, tabD, fnorm, SA, SB, tw, tbl, h, Y, Z, XC, LA, LB, P, QA, KVA;
  size_t W_in, W_g, W_uq, W_ukv, W_lru, W_br, W_out, W_q, W_key;
  size_t M, Gs, SC, TKs, TKi, SELi, SELg, W, total;
};
constexpr WsLayout make_layout() {
  WsLayout w{};
  size_t o = 0;
  w.xcur = o; o = al256(o + (size_t)TT * D * 4);
  w.mods = o; o = al256(o + (size_t)2 * 3 * 6 * D * 4);
  w.hdn2 = o; o = al256(o + (size_t)2 * (N + LC) * 64 * 4);
  w.ssq = o; o = al256(o + (size_t)2 * TT * 4);
  w.tabA = o; o = al256(o + (size_t)128 * 8 * 2 * 4);
  w.tabD = o; o = al256(o + (size_t)128 * 16 * 2 * 4);
  w.fnorm = o; o = al256(o + (size_t)2 * 512 * 4);
  w.tw = o; o = al256(o + (size_t)2 * N * 8);
  w.tbl = o; o = al256(o + (size_t)N_IN * 8);
  w.SA = o; o = al256(o + (size_t)2 * NB * NCHK * 512 * 4);
  w.SB = o; o = al256(o + (size_t)2 * NB * NCHK * 512 * 4);
  w.h = o; o = al256(o + (size_t)TT * D * 2);
  w.Y = o; o = al256(o + (size_t)TT * 2048 * 2);
  w.Z = o; o = al256(o + (size_t)TT * 512 * 2);
  w.W_in = o; o = al256(o + (size_t)3840 * 1024 * 2);
  w.W_g = o; o = al256(o + (size_t)4096 * 1024 * 2);
  w.W_uq = o; o = al256(o + (size_t)768 * 256 * 2);
  w.W_ukv = o; o = al256(o + (size_t)1024 * 256 * 2);
  w.W_lru = o; o = al256(o + (size_t)2048 * 256 * 2);
  w.W_br = o; o = al256(o + (size_t)4 * 1024 * 512 * 2);
  w.W_out = o; o = al256(o + (size_t)1024 * 1024 * 2);
  w.W_q = o; o = al256(o + (size_t)1024 * 1024 * 2);
  w.W_key = o; o = al256(o + (size_t)2048 * 256 * 2);
  size_t rl = o;
  w.XC = o; o = al256(o + (size_t)TT * 512 * 2);
  w.LA = o; o = al256(o + (size_t)2 * TT * 512 * 2);
  w.LB = o; o = al256(o + (size_t)2 * TT * 512 * 2);
  size_t rl_end = o;
  o = rl;
  w.TKs = o; o = al256(o + (size_t)TT * 256 * 4);
  w.TKi = o; o = al256(o + (size_t)TT * 256 * 4);
  w.SELi = o; o = al256(o + (size_t)TT * 128 * 4);
  w.SELg = o; o = al256(o + (size_t)TT * 128 * 4);
  w.W = o; o = al256(o + (size_t)TT * 128 * 4);
  if (o > rl_end) rl_end = o;
  o = rl_end;
  size_t rp = o;
  w.P = o; o = al256(o + (size_t)TT * PC * 2);
  w.QA = o; o = al256(o + (size_t)TT * 768 * 2);
  w.KVA = o; o = al256(o + (size_t)TT * 1024 * 2);
  size_t rp_end = o;
  o = rp;
  w.M = o; o = al256(o + (size_t)TT * D * 2);
  w.Gs = o; o = al256(o + (size_t)TT * D * 2);
  w.SC = o; o = al256(o + (size_t)TT * 2048 * sizeof(sc_t));
  if (o > rp_end) rp_end = o;
  w.total = rp_end;
  return w;
}
constexpr WsLayout WL = make_layout();
static_assert(WL.total <= (size_t)512 * 1024 * 1024, "workspace too large");
struct WsAcc {
  float* out;
  char* ws;
  MDEV float* xcur() const { return (float*)(ws + WL.xcur); }
  MDEV float* mods() const { return (float*)(ws + WL.mods); }
  MDEV float* hdn2() const { return (float*)(ws + WL.hdn2); }
  MDEV float* ssq() const { return (float*)(ws + WL.ssq); }
  MDEV float* tabA() const { return (float*)(ws + WL.tabA); }
  MDEV float* tabD() const { return (float*)(ws + WL.tabD); }
  MDEV float* fnorm() const { return (float*)(ws + WL.fnorm); }
  MDEV float* tw() const { return (float*)(ws + WL.tw); }
  MDEV unsigned* Hs() const { return (unsigned*)((char*)out + (((size_t)(N + LC) * 1024 * 4 + 255) & ~(size_t)255)); }
  MDEV float* SA() const { return (float*)(ws + WL.SA); }
  MDEV float* SB() const { return (float*)(ws + WL.SB); }
  MDEV bf* h() const { return (bf*)(ws + WL.h); }
  MDEV bf* Y() const { return (bf*)(ws + WL.Y); }
  MDEV bf* Z() const { return (bf*)(ws + WL.Z); }
  MDEV bf* XC() const { return (bf*)(ws + WL.XC); }
  MDEV bf* LA() const { return (bf*)(ws + WL.LA); }
  MDEV bf* LB() const { return (bf*)(ws + WL.LB); }
  MDEV bf* P() const { return (bf*)(ws + WL.P); }
  MDEV bf* QA() const { return (bf*)(ws + WL.QA); }
  MDEV bf* KVA() const { return (bf*)(ws + WL.KVA); }
  MDEV float* F() const { return out; }
  MDEV bf* W_in() const { return (bf*)(ws + WL.W_in); }
  MDEV bf* W_g() const { return (bf*)(ws + WL.W_g); }
  MDEV bf* W_uq() const { return (bf*)(ws + WL.W_uq); }
  MDEV bf* W_ukv() const { return (bf*)(ws + WL.W_ukv); }
  MDEV bf* W_lru() const { return (bf*)(ws + WL.W_lru); }
  MDEV bf* W_br() const { return (bf*)(ws + WL.W_br); }
  MDEV bf* W_out() const { return (bf*)(ws + WL.W_out); }
  MDEV bf* W_q() const { return (bf*)(ws + WL.W_q); }
  MDEV bf* W_key() const { return (bf*)(ws + WL.W_key); }
  MDEV bf* M() const { return (bf*)(ws + WL.M); }
  MDEV bf* Gs() const { return (bf*)(ws + WL.Gs); }
  MDEV bf* PQ() const { return (bf*)(ws + WL.Gs); }
  MDEV sc_t* SC() const { return (sc_t*)(ws + WL.SC); }
  MDEV float* TKs() const { return (float*)(ws + WL.TKs); }
  MDEV int* TKi() const { return (int*)(ws + WL.TKi); }
  MDEV int* SELi() const { return (int*)(ws + WL.SELi); }
  MDEV float* SELg() const { return (float*)(ws + WL.SELg); }
  MDEV float* W() const { return (float*)(ws + WL.W); }
};
struct KArgs : WsAcc { const float* in[N_IN]; };
struct Params : WsAcc { const float* const* in; };
static_assert((size_t)(N + LC) * 1024 * 4 + 256 + (size_t)256 * 2 * N * 4 <= (size_t)NLAT * D * 4, "F + spectrum scratch must fit in d_out");

DEV float sigmoidf_(float x) { return 1.0f / (1.0f + expf(-x)); }
DEV float siluf_(float x) { return x * sigmoidf_(x); }
DEV float geluf_(float x) { return 0.5f * x * (1.0f + tanhf(0.7978845608028654f * (x + 0.044715f * x * x * x))); }
DEV float softplusf_(float x) { return x > 20.f ? x : log1pf(expf(x)); }

#ifndef CPU_SIM
DEV float lane_xor(float v, int lane, int o) { return __int_as_float(__builtin_amdgcn_ds_bpermute(((lane ^ o) & 63) << 2, __float_as_int(v))); }
#endif
struct RowInfo { int b, t, L, base, lat; };
DEV RowInfo rowinfo(int r) {
  RowInfo ri;
  if (r < NLAT) { ri.b = r / N; ri.t = r - ri.b * N; ri.L = N; ri.base = ri.b * N; ri.lat = 1; }
  else { int rc = r - NLAT; ri.b = rc / LC; ri.t = rc - ri.b * LC; ri.L = LC; ri.base = NLAT + ri.b * LC; ri.lat = 0; }
  return ri;
}
DEV int modrow(int r) { return r < NLAT ? r / N : 2; }

DEV void atomic_addf(float* p, float v) {
#ifndef CPU_SIM
  atomicAdd(p, v);
#else
#pragma omp atomic
  *p += v;
#endif
}
DEV void store8bf(bf* dst, const float* v) {
#ifndef CPU_SIM
  uint4 w;
  w.x = (unsigned)f2b(v[0]).v | ((unsigned)f2b(v[1]).v << 16);
  w.y = (unsigned)f2b(v[2]).v | ((unsigned)f2b(v[3]).v << 16);
  w.z = (unsigned)f2b(v[4]).v | ((unsigned)f2b(v[5]).v << 16);
  w.w = (unsigned)f2b(v[6]).v | ((unsigned)f2b(v[7]).v << 16);
  *(uint4*)dst = w;
#else
  for (int j = 0; j < 8; ++j) dst[j] = f2b(v[j]);
#endif
}
DEV void load8bf(const bf* src, float* v) {
#ifndef CPU_SIM
  uint4 w = *(const uint4*)src;
  union { unsigned u; float f; } c;
  c.u = w.x << 16; v[0] = c.f; c.u = w.x & 0xFFFF0000u; v[1] = c.f;
  c.u = w.y << 16; v[2] = c.f; c.u = w.y & 0xFFFF0000u; v[3] = c.f;
  c.u = w.z << 16; v[4] = c.f; c.u = w.z & 0xFFFF0000u; v[5] = c.f;
  c.u = w.w << 16; v[6] = c.f; c.u = w.w & 0xFFFF0000u; v[7] = c.f;
#else
  for (int j = 0; j < 8; ++j) v[j] = b2f(src[j]);
#endif
}

DEV int win_src(int n) {
  if (n >= 3744) return -1;
  if (n >= C_KR && n < C_KR + 32) { int q = n - C_KR; int pi = q >> 1, wh = q & 1, half = pi >> 3, f = pi & 7; return C_KR + half * 16 + f + wh * 8; }
  if (n >= C_GQ && n < C_GKV + 128) { int q = n - C_GQ; int hh = q >> 6, d = q & 63; int pi = d >> 1, wh = d & 1, half = pi >> 4, f = pi & 15; return C_GQ + hh * 64 + half * 32 + f + wh * 16; }
  return n;
}
DEV int wuq_src(int n) {
  int hh = n / 96, d = n % 96;
  if (d < 64) return n;
  int q = d - 64; int pi = q >> 1, wh = q & 1, half = pi >> 3, f = pi & 7;
  return hh * 96 + 64 + half * 16 + f + wh * 8;
}

template <class PT> DEVN void ph_init(const PT& p, i64 gtid, i64 gsz) {
  const float* x = p.in[I_x]; const float* ctx = p.in[I_ctx];
  for (i64 i = gtid; i < (i64)TT * D; i += gsz) p.xcur()[i] = i < (i64)NLAT * D ? x[i] : ctx[i - (i64)NLAT * D];
  for (i64 i = gtid; i < 2 * 3 * 6 * D; i += gsz) {
    int l = (int)(i / (3 * 6 * D)); int rr = (int)((i / (6 * D)) % 3); int j = (int)(i % (6 * D));
    const float* cv = rr < 2 ? p.in[I_c] + rr * D : p.in[I_c_ctx];
    const float* w = p.in[I_w_mod] + (size_t)l * D * 6 * D;
    float acc = p.in[I_b_mod][l * 6 * D + j];
    for (int k = 0; k < D; ++k) acc += siluf_(cv[k]) * w[(size_t)k * 6 * D + j];
    p.mods()[i] = acc;
  }
  for (i64 i = gtid; i < (i64)2 * (N + LC) * 64; i += gsz) {
    int l = (int)(i / ((i64)(N + LC) * 64)); int tt = (int)((i / 64) % (N + LC)); int j2 = (int)(i % 64);
    int t, L; if (tt < N) { t = tt; L = N; } else { t = tt - N; L = LC; }
    float tn = (float)t / (float)(L - 1);
    float wt = 6.283185307179586f * (float)t / (float)L;
    const float* w1 = p.in[I_hy_w1] + l * 33 * 64; const float* b1 = p.in[I_hy_b1] + l * 64; const float* f1 = p.in[I_hy_f1] + l * 64;
    const float* w2 = p.in[I_hy_w2] + l * 64 * 64; const float* b2 = p.in[I_hy_b2] + l * 64; const float* f2 = p.in[I_hy_f2] + l * 64;
    float acc2 = b2[j2];
    for (int k1 = 0; k1 < 64; ++k1) {
      float a1 = b1[k1] + tn * w1[k1];
      for (int bd = 0; bd < 16; ++bd) {
        float band = 1e-4f + (float)bd * ((15.0f - 1e-4f) / 15.0f);
        float ang = band * wt;
        a1 += cosf(ang) * w1[(1 + bd) * 64 + k1] - sinf(ang) * w1[(17 + bd) * 64 + k1];
      }
      acc2 += sinf(f1[k1] * a1) * w2[k1 * 64 + j2];
    }
    p.hdn2()[i] = sinf(f2[j2] * acc2);
  }
  for (i64 i = gtid; i < 2 * N; i += gsz) {
    double a = 6.283185307179586476925 * (double)i / (double)(2 * N);
    p.tw()[i * 2] = (float)cos(a); p.tw()[i * 2 + 1] = (float)-sin(a);
  }
  for (i64 i = gtid; i < 128 * 8; i += gsz) {
    int pos = (int)(i / 8), f = (int)(i % 8);
    float ang = (float)pos * powf(10000.0f, -(float)f / 8.0f);
    p.tabA()[i * 2] = cosf(ang); p.tabA()[i * 2 + 1] = sinf(ang);
  }
  for (i64 i = gtid; i < 128 * 16; i += gsz) {
    int pos = (int)(i / 16), f = (int)(i % 16);
    float ang = (float)pos * powf(10000.0f, -(float)f / 16.0f);
    p.tabD()[i * 2] = cosf(ang); p.tabD()[i * 2 + 1] = sinf(ang);
  }
}

#ifndef CPU_SIM
template <class F> DEV void xpose_tiles(bf* dst, int K, int NN, const F& val, int tid, float* tl) {
  const int tk = K / 64, tn = NN / 64;
  for (int t = blockIdx.x; t < tk * tn; t += gridDim.x) {
    const int k0 = (t / tn) * 64, n0 = (t % tn) * 64;
    __syncthreads();
#pragma unroll
    for (int i = 0; i < 8; ++i) { const int kk = (tid >> 6) + 8 * i, nn = tid & 63; tl[nn * 65 + kk] = val(k0 + kk, n0 + nn); }
    __syncthreads();
#pragma unroll
    for (int i = 0; i < 8; ++i) { const int nn = (tid >> 6) + 8 * i, kk = tid & 63; dst[(size_t)(n0 + nn) * K + k0 + kk] = f2b(tl[nn * 65 + kk]); }
  }
}
#else
template <class F> static void xpose_tiles(bf* dst, int K, int NN, const F& val, i64 gtid, i64 gsz) {
  for (i64 i = gtid; i < (i64)K * NN; i += gsz) { int k = (int)(i / NN), n = (int)(i % NN); dst[(size_t)n * K + k] = f2b(val(k, n)); }
}
#endif
struct PrepCtx {
#ifndef CPU_SIM
  int tid; float* tl;
#else
  i64 gtid, gsz;
#endif
};
#ifndef CPU_SIM
#define XPOSE(dst, K, NN, val) xpose_tiles(dst, K, NN, val, pc.tid, pc.tl)
#else
#define XPOSE(dst, K, NN, val) xpose_tiles(dst, K, NN, val, pc.gtid, pc.gsz)
#endif
DEVN void ph_prep(const Params& p, int l, const PrepCtx& pc, i64 gtid, i64 gsz) {
  {
    const float* w = p.in[I_w_in] + (size_t)l * D * INC;
    XPOSE(p.W_in(), 1024, 3840, [=](int k, int n) { int s_ = win_src(n); return s_ < 0 ? 0.f : w[(size_t)k * INC + s_]; });
    XPOSE(p.W_g(), 1024, 4096, [=](int k, int n) { return w[(size_t)k * INC + C_GT + n]; });
  }
  {
    const float* w = p.in[I_mla_w_uq] + (size_t)l * 256 * 768; const float* g = p.in[I_mla_g_cq] + l * 256;
    XPOSE(p.W_uq(), 256, 768, [=](int k, int n) { return g[k] * w[(size_t)k * 768 + wuq_src(n)]; });
  }
  {
    const float* w = p.in[I_mla_w_ukv] + (size_t)l * 128 * 1024; const float* g = p.in[I_mla_g_ckv] + l * 128;
    XPOSE(p.W_ukv(), 256, 1024, [=](int k, int n) { return k < 128 ? g[k] * w[(size_t)k * 1024 + n] : 0.f; });
  }
  {
    const float* w = p.in[I_w_branch] + (size_t)l * 4 * 512 * D;
    for (int br = 0; br < 4; ++br) { const float* wb = w + (size_t)br * 512 * D; XPOSE(p.W_br() + (size_t)br * 1024 * 512, 512, 1024, [=](int k, int n) { return wb[(size_t)k * D + n]; }); }
  }
  {
    const float* w = p.in[I_w_out] + (size_t)l * D * D; const float* wq = p.in[I_peer_w_q] + (size_t)l * D * 1024;
    XPOSE(p.W_out(), 1024, 1024, [=](int k, int n) { return w[(size_t)k * D + n]; });
    XPOSE(p.W_q(), 1024, 1024, [=](int k, int n) { return wq[(size_t)k * 1024 + n]; });
  }
  {
    for (i64 i = gtid; i < 2048 * 256; i += gsz) {
      int n = (int)(i / 256), k = (int)(i % 256);
      int kw = n >> 10, dir = (n >> 9) & 1, blk4 = (n >> 7) & 3, jc = (n & 127) >> 1, gate = n & 1;
      float v = 0.f;
      if ((k >> 6) == blk4) {
        const float* wsrc = p.in[gate ? I_lru_w_i : I_lru_w_r] + ((((size_t)l * 2 + dir) * 8 + kw * 4 + blk4) * 64 + (k & 63)) * 64 + jc;
        v = *wsrc;
      }
      p.W_lru()[i] = f2b(v);
    }
  }
  {
    const float* keys = p.in[I_peer_keys] + (size_t)l * 16 * 128 * 64;
    for (i64 i = gtid; i < 2048 * 256; i += gsz) {
      int n = (int)(i / 256), k = (int)(i % 256);
      int hp = n >> 7, key = n & 127;
      float v = ((k >> 6) == (hp & 3)) ? keys[((size_t)hp * 128 + key) * 64 + (k & 63)] : 0.f;
      p.W_key()[i] = f2b(v);
    }
  }
}

DEVN void ph_norm(const Params& p, int l, int which, int nrows, i64 gtid, i64 gsz) {
  const float* g = p.in[which ? I_g_ffn : I_g_mix] + l * D;
#ifndef CPU_SIM
  const int lane = (int)(gtid & 63);
  for (i64 r = gtid >> 6; r < nrows; r += gsz >> 6) {
    const float4* xr = (const float4*)(p.xcur() + (size_t)r * D);
    float4 xv[4]; float ss = 0.f;
#pragma unroll
    for (int i = 0; i < 4; ++i) { xv[i] = xr[lane + i * 64]; ss += xv[i].x * xv[i].x + xv[i].y * xv[i].y + xv[i].z * xv[i].z + xv[i].w * xv[i].w; }
#pragma unroll
    for (int o = 32; o >= 1; o >>= 1) ss += lane_xor(ss, lane, o);
    const float rstd = 1.0f / sqrtf(ss * (1.0f / D) + EPS);
    const float* md = p.mods() + ((size_t)l * 3 + modrow((int)r)) * 6 * D + (which ? 3 * D : 0);
#pragma unroll
    for (int i = 0; i < 4; ++i) {
      const int k = (lane + i * 64) * 4;
      const float4 gv = *(const float4*)(g + k), sh = *(const float4*)(md + k), sc = *(const float4*)(md + D + k);
      uint2 w;
      w.x = (unsigned)f2b(xv[i].x * rstd * gv.x * (1.0f + sc.x) + sh.x).v | ((unsigned)f2b(xv[i].y * rstd * gv.y * (1.0f + sc.y) + sh.y).v << 16);
      w.y = (unsigned)f2b(xv[i].z * rstd * gv.z * (1.0f + sc.z) + sh.z).v | ((unsigned)f2b(xv[i].w * rstd * gv.w * (1.0f + sc.w) + sh.w).v << 16);
      *(uint2*)(p.h() + (size_t)r * D + k) = w;
    }
  }
#else
  for (i64 r = gtid; r < nrows; r += gsz) {
    const float* xr = p.xcur() + (size_t)r * D;
    float ss = 0.f;
    for (int k = 0; k < D; ++k) ss += xr[k] * xr[k];
    float rstd = 1.0f / sqrtf(ss / D + EPS);
    const float* md = p.mods() + ((size_t)l * 3 + modrow((int)r)) * 6 * D + (which ? 3 * D : 0);
    for (int k = 0; k < D; ++k) p.h()[(size_t)r * D + k] = f2b(xr[k] * rstd * g[k] * (1.0f + md[D + k]) + md[k]);
  }
#endif
}

DEVN void ph_B0(const Params& p, int l, i64 gtid, i64 gsz) {
#ifndef CPU_SIM
  {
    const int lane = (int)(gtid & 63);
    for (i64 r = gtid >> 6; r < TT; r += gsz >> 6) {
      const bf* pr = p.P() + (size_t)r * PC;
      uint2 a = *(const uint2*)(pr + C_CQ + lane * 4);
      unsigned b = *(const unsigned*)(pr + C_CKV + lane * 2);
      union { unsigned u; float f; } c;
      float sq = 0.f, sk = 0.f;
      c.u = a.x << 16; sq += c.f * c.f; c.u = a.x & 0xFFFF0000u; sq += c.f * c.f;
      c.u = a.y << 16; sq += c.f * c.f; c.u = a.y & 0xFFFF0000u; sq += c.f * c.f;
      c.u = b << 16; sk += c.f * c.f; c.u = b & 0xFFFF0000u; sk += c.f * c.f;
#pragma unroll
      for (int o = 32; o >= 1; o >>= 1) { sq += lane_xor(sq, lane, o); sk += lane_xor(sk, lane, o); }
      if (lane == 0) { p.ssq()[r] = sq; p.ssq()[TT + r] = sk; }
    }
  }
#else
  for (i64 r = gtid; r < TT; r += gsz) {
    const bf* pr = p.P() + (size_t)r * PC;
    float sq = 0.f, sk = 0.f;
    for (int k = 0; k < 256; ++k) { float v = b2f(pr[C_CQ + k]); sq += v * v; }
    for (int k = 0; k < 128; ++k) { float v = b2f(pr[C_CKV + k]); sk += v * v; }
    p.ssq()[r] = sq; p.ssq()[TT + r] = sk;
  }
#endif
  {
    const float* cw = p.in[I_lru_conv_w] + l * 4 * 512; const float* cb = p.in[I_lru_conv_b] + l * 512;
    for (i64 i = gtid; i < (i64)TT * 512; i += gsz) {
      int r = (int)(i / 512), c = (int)(i % 512);
      RowInfo ri = rowinfo(r);
      float acc = cb[c];
      for (int k = 0; k < 4; ++k) {
        int ts = ri.t - 1 + k;
        if (ts >= 0 && ts < ri.L) acc += cw[k * 512 + c] * b2f(p.P()[(size_t)(ri.base + ts) * PC + C_LX + c]);
      }
      p.XC()[i] = f2b(acc);
    }
  }
  {
    const float* cw = p.in[I_hy_conv_w] + l * 3 * 1536; const float* cb = p.in[I_hy_conv_b] + l * 1536;
    for (i64 i = gtid; i < (i64)TT * 512; i += gsz) {
      int r = (int)(i / 512), c = (int)(i % 512);
      RowInfo ri = rowinfo(r);
      float a1 = cb[512 + c], a2 = cb[1024 + c];
      for (int k = 0; k < 3; ++k) {
        int ts = ri.t - 1 + k;
        if (ts >= 0 && ts < ri.L) {
          const bf* pr = p.P() + (size_t)(ri.base + ts) * PC + C_HU;
          a1 += cw[k * 1536 + 512 + c] * b2f(pr[512 + c]);
          a2 += cw[k * 1536 + 1024 + c] * b2f(pr[1024 + c]);
        }
      }
      p.Z()[i] = f2b(a1 * a2);
    }
  }
  {
    const float* w3 = p.in[I_hy_w3] + (size_t)l * 64 * 1024;
    const float maxd = logf(1e-2f) / 0.3f, mind = logf(1e-2f) / 1.5f;
    for (i64 i = gtid; i < (i64)(N + LC) * 1024; i += gsz) {
      int tt = (int)(i / 1024), j = (int)(i % 1024);
      int t, L; if (tt < N) { t = tt; L = N; } else { t = tt - N; L = LC; }
      const float* hd = p.hdn2() + ((size_t)l * (N + LC) + tt) * 64;
      float acc = 0.f;
      for (int k = 0; k < 64; ++k) acc += hd[k] * w3[k * 1024 + j];
      float tn = (float)t / (float)(L - 1);
      float delta = mind + (float)j * ((maxd - mind) / 1023.0f);
      p.F()[i] = acc * expf(-tn * fabsf(delta));
    }
  }
}

DEVN void ph_fnorm(const Params& p, i64 gtid, i64 gsz) {
#ifndef CPU_SIM
  for (i64 i = 512 + gtid; i < 2 * 512; i += gsz) {
#else
  for (i64 i = gtid; i < 2 * 512; i += gsz) {
#endif
    int which = (int)(i / 512), c = (int)(i % 512);
    int L = which ? LC : N; int off = which ? N : 0;
    float ss = 0.f;
    for (int t = 0; t < L; ++t) { float a = p.F()[(size_t)(off + t) * 1024 + c], b = p.F()[(size_t)(off + t) * 1024 + 512 + c]; ss += a * a + b * b; }
    p.fnorm()[i] = 1.0f / sqrtf(ss + EPS);
  }
}


DEV void lru_chunk_rows(int dir, int b, int k, int& row0, int& step) {
  int seg_chunk;
  if (k < NCC) { seg_chunk = dir ? NCC - 1 - k : k; row0 = NLAT + b * LC + seg_chunk * LCH; }
  else { int kl = k - NCC; seg_chunk = dir ? NCL - 1 - kl : kl; row0 = b * N + seg_chunk * LCH; }
  if (dir) { row0 += LCH - 1; step = -1; } else step = 1;
}
DEVN void ph_lru1(const Params& p, i64 gtid, i64 gsz) {
  for (i64 i = gtid; i < (i64)2 * NB * NCHK * 512; i += gsz) {
    int c = (int)(i % 512), k = (int)((i / 512) % NCHK), b = (int)((i / (512 * NCHK)) % NB), dir = (int)(i / ((i64)512 * NCHK * NB));
    int row0, step; lru_chunk_rows(dir, b, k, row0, step);
    const bf* la = p.LA() + (size_t)dir * TT * 512 + c; const bf* lb = p.LB() + (size_t)dir * TT * 512 + c;
    float h = 0.f, sl = 0.f;
    for (int t = 0; t < LCH; ++t) {
      size_t r = (size_t)(row0 + step * t);
      float lav = b2f(la[r * 512]);
      h = expf(lav) * h + b2f(lb[r * 512]); sl += lav;
    }
    p.SA()[i] = expf(sl); p.SB()[i] = h;
  }
}
DEVN void ph_lru3(const Params& p, int last, i64 gtid, i64 gsz) {
  for (i64 i = gtid; i < (i64)NB * NCHK * 512; i += gsz) {
    int c = (int)(i % 512), j = (int)((i / 512) % NCHK), b = (int)(i / (512 * NCHK));
    if (last && j < NCC) continue;
    int kf = j, kr = j < NCC ? NCC - 1 - j : NCC + (NCL - 1 - (j - NCC));
    const float* sa0 = p.SA() + ((size_t)(0 * NB + b) * NCHK) * 512 + c; const float* sb0 = p.SB() + ((size_t)(0 * NB + b) * NCHK) * 512 + c;
    const float* sa1 = p.SA() + ((size_t)(1 * NB + b) * NCHK) * 512 + c; const float* sb1 = p.SB() + ((size_t)(1 * NB + b) * NCHK) * 512 + c;
    float hf = 0.f, hr = 0.f;
    for (int k = 0; k < kf; ++k) hf = sa0[(size_t)k * 512] * hf + sb0[(size_t)k * 512];
    for (int k = 0; k < kr; ++k) hr = sa1[(size_t)k * 512] * hr + sb1[(size_t)k * 512];
    int row0 = j < NCC ? NLAT + b * LC + j * LCH : b * N + (j - NCC) * LCH;
    const bf* la0 = p.LA() + c; const bf* lb0 = p.LB() + c;
    const bf* la1 = p.LA() + (size_t)TT * 512 + c; bf* lb1 = p.LB() + (size_t)TT * 512 + c;
    for (int t = LCH - 1; t >= 0; --t) { size_t r = (size_t)(row0 + t); hr = expf(b2f(la1[r * 512])) * hr + b2f(lb1[r * 512]); lb1[r * 512] = f2b(hr); }
    for (int t = 0; t < LCH; ++t) {
      size_t r = (size_t)(row0 + t);
      hf = expf(b2f(la0[r * 512])) * hf + b2f(lb0[r * 512]);
      float lg = b2f(p.P()[r * PC + C_LG + c]);
      p.Y()[r * 2048 + 512 + c] = f2b(geluf_(lg) * (hf + b2f(lb1[r * 512])));
    }
  }
}

DEVN void ph_C(const Params& p, int l, int last, i64 gtid, i64 gsz) {
  const int QR = last ? NLAT : TT;
#ifdef CPU_SIM
  for (i64 i = gtid; i < (i64)8 * QR; i += gsz) {
    int hh = (int)(i / QR), r = (int)(i % QR);
    RowInfo ri = rowinfo(r);
    float q[96];
#pragma unroll
    for (int d = 0; d < 96; ++d) q[d] = b2f(p.QA()[(size_t)r * 768 + hh * 96 + d]);
    float o[64];
#pragma unroll
    for (int d = 0; d < 64; ++d) o[d] = 0.f;
    float m = -1e30f, lsum = 0.f;
    const float scale = 0.10206207261596577f;
    int nseg = ri.lat ? 2 : 1;
    for (int sg = 0; sg < nseg; ++sg) {
      int kb, kn_;
      if (ri.lat && sg == 0) { kb = ri.b * N; kn_ = N; } else { kb = NLAT + ri.b * LC; kn_ = LC; }
      for (int kk = 0; kk < kn_; ++kk) {
        const bf* kr_ = p.KVA() + (size_t)(kb + kk) * 1024 + hh * 128;
        const bf* krp = p.P() + (size_t)(kb + kk) * PC + C_KR;
        float s = 0.f;
#pragma unroll
        for (int d = 0; d < 64; ++d) s += q[d] * b2f(kr_[d]);
#pragma unroll
        for (int d = 0; d < 32; ++d) s += q[64 + d] * b2f(krp[d]);
        s *= scale;
        float mn = fmaxf(m, s);
        float corr = expf(m - mn), pe = expf(s - mn);
        lsum = lsum * corr + pe;
#pragma unroll
        for (int d = 0; d < 64; ++d) o[d] = o[d] * corr + pe * b2f(kr_[64 + d]);
        m = mn;
      }
    }
    float inv = 1.0f / lsum;
#pragma unroll
    for (int d = 0; d < 64; ++d) p.Y()[(size_t)r * 2048 + hh * 64 + d] = f2b(o[d] * inv);
  }
#endif
  {
    const float* cw = p.in[I_hy_conv_w] + l * 3 * 1536; const float* cb = p.in[I_hy_conv_b] + l * 1536;
    const float* skip = p.in[I_hy_skip] + l * 512;
#ifndef CPU_SIM
    const i64 hy_first = (i64)NLAT * 512;
#else
    const i64 hy_first = 0;
#endif
    for (i64 i = hy_first + gtid; i < (i64)QR * 512; i += gsz) {
      int r = (int)(i / 512), c = (int)(i % 512);
      RowInfo ri = rowinfo(r);
      int foff = ri.lat ? 0 : N;
      float acc = 0.f;
      for (int s = 0; s < ri.L; ++s) {
        int dd = ri.t - s;
        float fv = dd >= 0 ? p.F()[(size_t)(foff + dd) * 1024 + c] : p.F()[(size_t)(foff - dd) * 1024 + 512 + c];
        acc += fv * b2f(p.Z()[(size_t)(ri.base + s) * 512 + c]);
      }
      acc *= p.fnorm()[(ri.lat ? 0 : 512) + c];
      float x0 = cb[c];
      for (int k = 0; k < 3; ++k) {
        int ts = ri.t - 1 + k;
        if (ts >= 0 && ts < ri.L) x0 += cw[k * 1536 + c] * b2f(p.P()[(size_t)(ri.base + ts) * PC + C_HU + c]);
      }
      float y = acc + skip[c] * b2f(p.Z()[(size_t)r * 512 + c]);
      p.Y()[(size_t)r * 2048 + 1024 + c] = f2b(x0 * y);
    }
  }
  for (i64 i = gtid; i < (i64)8 * QR; i += gsz) {
    int hh = (int)(i / QR), r = (int)(i % QR);
    RowInfo ri = rowinfo(r);
    int kh = hh / 4;
    float q[64];
#pragma unroll
    for (int d = 0; d < 64; ++d) q[d] = b2f(p.P()[(size_t)r * PC + C_GQ + hh * 64 + d]);
    float o[64];
#pragma unroll
    for (int d = 0; d < 64; ++d) o[d] = 0.f;
    float m = p.in[I_gqa_sink][l * 8 + hh], lsum = 1.0f;
    int nseg = ri.lat ? 2 : 1;
    for (int sg = 0; sg < nseg; ++sg) {
      int k0, k1;
      if (ri.lat && sg == 0) { int lo = ri.t - 128; if (lo < 0) lo = 0; int hi = ri.t + 128; if (hi > N - 1) hi = N - 1; k0 = ri.b * N + lo; k1 = ri.b * N + hi + 1; }
      else { k0 = NLAT + ri.b * LC; k1 = k0 + LC; }
      for (int kk = k0; kk < k1; ++kk) {
        const bf* kp = p.P() + (size_t)kk * PC + C_GKV + kh * 64;
        const bf* vp = kp + 128;
        float s = 0.f;
#pragma unroll
        for (int d = 0; d < 64; ++d) s += q[d] * b2f(kp[d]);
        s *= 0.125f;
        float mn = fmaxf(m, s);
        float corr = expf(m - mn), pe = expf(s - mn);
        lsum = lsum * corr + pe;
#pragma unroll
        for (int d = 0; d < 64; ++d) o[d] = o[d] * corr + pe * b2f(vp[d]);
        m = mn;
      }
    }
    float inv = 1.0f / lsum;
#pragma unroll
    for (int d = 0; d < 64; ++d) p.Y()[(size_t)r * 2048 + 1536 + hh * 64 + d] = f2b(o[d] * inv);
  }
}

DEVN void ph_E2a(const Params& p, int nrows, i64 gtid, i64 gsz) {
  for (i64 i = gtid; i < (i64)nrows * 16; i += gsz) {
    const sc_t* s_ = p.SC() + (size_t)i * 128;
    float ps = 3.0e38f; int pi = -1;
    for (int k = 0; k < 16; ++k) {
      float bs = -3.0e38f; int bi = -1;
      for (int j = 0; j < 128; ++j) {
        float s = (float)s_[j];
        bool elig = (s < ps) || (s == ps && j > pi);
        if (elig && (s > bs)) { bs = s; bi = j; }
      }
      p.TKs()[(size_t)i * 16 + k] = bs; p.TKi()[(size_t)i * 16 + k] = bi;
      ps = bs; pi = bi;
    }
  }
}

DEVN void ph_E2b(const Params& p, int nrows, i64 gtid, i64 gsz) {
  for (i64 i = gtid; i < (i64)nrows * 8; i += gsz) {
    const float* s1 = p.TKs() + (size_t)i * 32; const float* s2 = s1 + 16;
    const int* i1 = p.TKi() + (size_t)i * 32; const int* i2 = i1 + 16;
    float ps = 3.0e38f; int pi = -1;
    float mx = 0.f;
    for (int k = 0; k < 16; ++k) {
      float bs = -3.0e38f; int bi = -1;
      for (int j = 0; j < 256; ++j) {
        float s = s1[j >> 4] + s2[j & 15];
        bool elig = (s < ps) || (s == ps && j > pi);
        if (elig && (s > bs)) { bs = s; bi = j; }
      }
      if (k == 0) mx = bs;
      p.SELi()[(size_t)i * 16 + k] = i1[bi >> 4] * 128 + i2[bi & 15];
      p.SELg()[(size_t)i * 16 + k] = expf(bs - mx);
      ps = bs; pi = bi;
    }
    float sum = 0.f;
    for (int k = 0; k < 16; ++k) sum += p.SELg()[(size_t)i * 16 + k];
    float inv = 1.0f / sum;
    for (int k = 0; k < 16; ++k) p.SELg()[(size_t)i * 16 + k] *= inv;
  }
}

DEVN void ph_E3(const Params& p, int l, int nrows, i64 gtid, i64 gsz) {
  const float* u = p.in[I_peer_u] + (size_t)l * NEXP * D;
#ifndef CPU_SIM
  const int lane = (int)(gtid & 63);
  for (i64 i = gtid >> 6; i < (i64)nrows * 128; i += gsz >> 6) {
    const int r = (int)(i >> 7);
    const float4* ur = (const float4*)(u + (size_t)p.SELi()[i] * D);
    const uint2* hr = (const uint2*)(p.h() + (size_t)r * D);
    float acc = 0.f;
#pragma unroll
    for (int q = 0; q < 4; ++q) {
      const float4 uv = ur[lane + q * 64]; const uint2 hv = hr[lane + q * 64];
      union { unsigned u_; float f; } c0, c1, c2, c3;
      c0.u_ = hv.x << 16; c1.u_ = hv.x & 0xFFFF0000u; c2.u_ = hv.y << 16; c3.u_ = hv.y & 0xFFFF0000u;
      acc += uv.x * c0.f + uv.y * c1.f + uv.z * c2.f + uv.w * c3.f;
    }
#pragma unroll
    for (int o = 32; o >= 1; o >>= 1) acc += lane_xor(acc, lane, o);
    if (lane == 0) p.W()[i] = p.SELg()[i] * geluf_(acc);
  }
#else
  for (i64 i = gtid; i < (i64)nrows * 128; i += gsz) {
    int r = (int)(i / 128);
    const float* ur = u + (size_t)p.SELi()[i] * D;
    const bf* hr = p.h() + (size_t)r * D;
    float acc = 0.f;
    for (int k = 0; k < D; ++k) acc += b2f(hr[k]) * ur[k];
    p.W()[i] = p.SELg()[i] * geluf_(acc);
  }
#endif
}

DEVN void ph_E4(const Params& p, int l, int nrows, i64 gtid, i64 gsz) {
  const float* v = p.in[I_peer_v] + (size_t)l * NEXP * D;
  for (i64 i = gtid; i < (i64)nrows * D; i += gsz) {
    int r = (int)(i / D), n = (int)(i % D);
    float acc = 0.f;
    for (int j = 0; j < 128; ++j) acc += p.W()[(size_t)r * 128 + j] * v[(size_t)p.SELi()[(size_t)r * 128 + j] * D + n];
    float g2 = p.mods()[((size_t)l * 3 + modrow(r)) * 6 * D + 5 * D + n];
    p.xcur()[i] += g2 * acc;
  }
}

DEVN void ph_final(const Params& p, i64 gtid, i64 gsz) {
  const float* g = p.in[I_g_final];
#ifndef CPU_SIM
  const int lane = (int)(gtid & 63);
  for (i64 r = gtid >> 6; r < NLAT; r += gsz >> 6) {
    const float4* xr = (const float4*)(p.xcur() + (size_t)r * D);
    float4 xv[4]; float ss = 0.f;
#pragma unroll
    for (int i = 0; i < 4; ++i) { xv[i] = xr[lane + i * 64]; ss += xv[i].x * xv[i].x + xv[i].y * xv[i].y + xv[i].z * xv[i].z + xv[i].w * xv[i].w; }
#pragma unroll
    for (int o = 32; o >= 1; o >>= 1) ss += lane_xor(ss, lane, o);
    const float rstd = 1.0f / sqrtf(ss * (1.0f / D) + EPS);
#pragma unroll
    for (int i = 0; i < 4; ++i) {
      const int k = (lane + i * 64) * 4;
      const float4 gv = *(const float4*)(g + k);
      float4 o4; o4.x = xv[i].x * rstd * gv.x; o4.y = xv[i].y * rstd * gv.y; o4.z = xv[i].z * rstd * gv.z; o4.w = xv[i].w * rstd * gv.w;
      *(float4*)(p.out + (size_t)r * D + k) = o4;
    }
  }
#else
  for (i64 r = gtid; r < NLAT; r += gsz) {
    const float* xr = p.xcur() + (size_t)r * D;
    float ss = 0.f;
    for (int k = 0; k < D; ++k) ss += xr[k] * xr[k];
    float rstd = 1.0f / sqrtf(ss / D + EPS);
    for (int k = 0; k < D; ++k) p.out[(size_t)r * D + k] = xr[k] * rstd * g[k];
  }
#endif
}

DEV void rope4(float* v, const float* tab, int nf, int pos, int f0) {
#pragma unroll
  for (int jj = 0; jj < 4; ++jj) {
    float c = tab[(pos * nf + f0 + jj) * 2], s = tab[(pos * nf + f0 + jj) * 2 + 1];
    float x1 = v[2 * jj], x2 = v[2 * jj + 1];
    v[2 * jj] = x1 * c - x2 * s; v[2 * jj + 1] = x1 * s + x2 * c;
  }
}
struct EpiInproj {
  static constexpr int W = 8;
  const Params& p;
  MDEV void apply(int r, int c0, float* v) const {
    if (c0 >= 3744) return;
    if (c0 >= 384 && r < NLAT) {
      int t = r % N;
      if (c0 < C_KR + 32) { int pi = (c0 - C_KR) >> 1; int half = pi >> 3; rope4(v, p.tabA(), 8, half ? t % GRIDW : t / GRIDW, pi & 7); }
      else if (c0 >= C_GQ && c0 < C_GKV + 128) { int pi = ((c0 - C_GQ) & 63) >> 1; int half = pi >> 4; rope4(v, p.tabD(), 16, half ? t % GRIDW : t / GRIDW, pi & 15); }
    }
    store8bf(p.P() + (size_t)r * PC + c0, v);
  }
};
struct EpiUq {
  static constexpr int W = 8;
  const Params& p;
  MDEV void apply(int r, int c0, float* v) const {
    float rstd = 1.0f / sqrtf(p.ssq()[r] * (1.0f / 256.0f) + EPS);
#pragma unroll
    for (int j = 0; j < 8; ++j) v[j] *= rstd;
    int d0 = c0 % 96;
    if (d0 >= 64 && r < NLAT) { int t = r % N; int pi = (d0 - 64) >> 1; int half = pi >> 3; rope4(v, p.tabA(), 8, half ? t % GRIDW : t / GRIDW, pi & 7); }
    store8bf(p.QA() + (size_t)r * 768 + c0, v);
  }
};
struct EpiUkv {
  static constexpr int W = 8;
  const Params& p;
  MDEV void apply(int r, int c0, float* v) const {
    float rstd = 1.0f / sqrtf(p.ssq()[TT + r] * (1.0f / 128.0f) + EPS);
#pragma unroll
    for (int j = 0; j < 8; ++j) v[j] *= rstd;
    store8bf(p.KVA() + (size_t)r * 1024 + c0, v);
  }
};
struct EpiLru {
  static constexpr int W = 8;
  const Params& p; int l;
  MDEV void apply(int r, int c0, float* v) const {
    int kw = c0 >> 10, dir = (c0 >> 9) & 1, blk4 = (c0 >> 7) & 3, jc0 = (c0 & 127) >> 1;
    int cb = kw * 256 + blk4 * 64 + jc0;
    const float* br = p.in[I_lru_b_r] + (l * 2 + dir) * 512 + cb;
    const float* bi = p.in[I_lru_b_i] + (l * 2 + dir) * 512 + cb;
    const float* lam = p.in[I_lru_lam] + (l * 2 + dir) * 512 + cb;
    bf* la = p.LA() + ((size_t)dir * TT + r) * 512 + cb;
    bf* lb = p.LB() + ((size_t)dir * TT + r) * 512 + cb;
#pragma unroll
    for (int jj = 0; jj < 4; ++jj) {
      float rg = sigmoidf_(v[2 * jj] + br[jj]), ig = sigmoidf_(v[2 * jj + 1] + bi[jj]);
      float log_a = -8.0f * rg * softplusf_(-lam[jj]);
      float bt = sqrtf(-expm1f(2.0f * log_a)) * ig * b2f(p.XC()[(size_t)r * 512 + cb + jj]);
      la[jj] = f2b(log_a); lb[jj] = f2b(bt);
    }
  }
};
struct EpiGate {
  static constexpr int W = 8;
  const Params& p;
  MDEV void apply(int r, int c0, float* v) const {
#pragma unroll
    for (int j = 0; j < 8; ++j) v[j] = sigmoidf_(v[j]);
    store8bf(p.Gs() + (size_t)r * D + c0, v);
  }
};
struct EpiBranch {
  static constexpr int W = 8;
  const Params& p; int br;
  MDEV void apply(int r, int c0, float* v) const {
    float g[8]; load8bf(p.Gs() + (size_t)r * D + c0, g);
    if (br > 0) {
      float mo[8]; load8bf(p.M() + (size_t)r * D + c0, mo);
#pragma unroll
      for (int j = 0; j < 8; ++j) v[j] = mo[j] + g[j] * v[j];
    } else {
#pragma unroll
      for (int j = 0; j < 8; ++j) v[j] = g[j] * v[j];
    }
    store8bf(p.M() + (size_t)r * D + c0, v);
  }
};
struct EpiOut {
  static constexpr int W = 4;
  const Params& p; int l;
  MDEV void apply(int r, int c0, float* v) const {
    const float* g1 = p.mods() + ((size_t)l * 3 + modrow(r)) * 6 * D + 2 * D + c0;
    float* xr = p.xcur() + (size_t)r * D + c0;
#pragma unroll
    for (int j = 0; j < 4; ++j) xr[j] += g1[j] * v[j];
  }
};
struct EpiPQ {
  static constexpr int W = 8;
  const Params& p;
  MDEV void apply(int r, int c0, float* v) const { store8bf(p.PQ() + (size_t)r * 1024 + c0, v); }
};
struct EpiSC {
  static constexpr int W = 8;
  const Params& p;
  MDEV void apply(int r, int c0, float* v) const {
    sc_t* d = p.SC() + (size_t)r * 2048 + c0;
#pragma unroll
    for (int j = 0; j < 8; ++j) d[j] = (sc_t)v[j];
  }
};

struct GemmDesc { const bf* A; const bf* Bt; int lda, ldb, K, nrows, ncols; int a_pn_shift, a_pn_mul; };

#ifndef CPU_SIM
namespace pg8 {
#define PG8_LAS __attribute__((address_space(3)))
typedef short bf16x8 __attribute__((ext_vector_type(8)));
typedef float f32x4 __attribute__((ext_vector_type(4)));
constexpr int BM = 256, BK = 64, HALF = 128, HTB = HALF * BK * 2, STAGE_BYTES = 8 * HTB, NXCD = 8, WGM = 8;
__device__ __forceinline__ int lds_byte(int r, int c) { const int st = (r >> 4) * 2 + (c >> 5), rr = r & 15, cc = c & 31, ob = rr * 64 + cc * 2; return st * 1024 + (ob ^ (((ob >> 9) & 1) << 5)); }
__device__ __forceinline__ void stage_rc(int b, int& R, int& C) { const int st = b / 1024, sb = b % 1024, swz = sb ^ (((sb >> 9) & 1) << 5); R = (st >> 1) * 16 + swz / 64; C = (st & 1) * 32 + (swz % 64) / 2; }
__device__ __forceinline__ int perm32(int rho) { const int n = rho >> 4, i = rho & 15; return 8 * (i >> 2) + 4 * n + (i & 3); }
struct Unit { int pm, pn; };
struct StaticOrder {
  int nM, nN, nwg, G, c;
  __device__ void init(int nM_, int nN_, int G_, int c_) { nM = nM_; nN = nN_; nwg = nM * nN; G = G_; c = c_; }
  __device__ bool next(int i, Unit& u) const {
    const long L = (long)i * G + c; if (L >= nwg) return false;
    int wgid = (int)L; { const int q = nwg / NXCD, r = nwg % NXCD, xcd = wgid % NXCD, off = wgid / NXCD; wgid = (xcd < r ? xcd * (q + 1) : r * (q + 1) + (xcd - r) * q) + off; }
    const int nig = WGM * nN, gid = wgid / nig, fm = gid * WGM, gsz = (nM - fm) < WGM ? (nM - fm) : WGM;
    u.pm = fm + ((wgid % nig) % gsz); u.pn = (wgid % nig) / gsz; return true;
  }
};

template <class E>
__device__ __forceinline__ void epi_call(const E& e, const f32x4 (&acc)[2][2][4][2], const Unit& u, int wr, int wc, int fr_, int fq_) {
  int fr = fr_, fq = fq_;
  asm volatile("" : "+v"(fr), "+v"(fq));
#pragma unroll
  for (int ai = 0; ai < 2; ++ai)
#pragma unroll
    for (int m = 0; m < 4; ++m) {
      const int r = u.pm * BM + ai * HALF + wr * 64 + m * 16 + fr;
#pragma unroll
      for (int bj = 0; bj < 2; ++bj) {
        if constexpr (E::W == 8) {
          const int c0 = u.pn * BM + bj * HALF + wc * 32 + 8 * fq;
          float v[8];
#pragma unroll
          for (int j = 0; j < 4; ++j) { v[j] = acc[ai][bj][m][0][j]; v[4 + j] = acc[ai][bj][m][1][j]; }
          e.apply(r, c0, v);
          __builtin_amdgcn_sched_barrier(0);
        } else {
#pragma unroll
          for (int n = 0; n < 2; ++n) {
            const int c0 = u.pn * BM + bj * HALF + wc * 32 + 16 * n + 4 * fq;
            float v[4];
#pragma unroll
            for (int j = 0; j < 4; ++j) v[j] = acc[ai][bj][m][n][j];
            e.apply(r, c0, v);
            __builtin_amdgcn_sched_barrier(0);
          }
        }
      }
    }
}

template <class Epi>
__device__ __forceinline__ void gemm_phase(PG8_LAS unsigned char* lds, const int tid, const GemmDesc g, const Epi& E) {
  constexpr bool PERM = (Epi::W == 8);
  const int wid = __builtin_amdgcn_readfirstlane(tid >> 6), lane = tid & 63, wr = wid >> 2, wc = wid & 3, fr = lane & 15, fq = lane >> 4;
  const int K = g.K, nt = K / BK;
  StaticOrder S; S.init(g.nrows / BM, g.ncols / BM, (int)gridDim.x, (int)blockIdx.x);
  unsigned voffA[2], voffB[2];
#pragma unroll
  for (int i = 0; i < 2; ++i) { int R, C; stage_rc(tid * 16 + i * 8192, R, C); const int Rb = PERM ? ((R & ~31) + perm32(R & 31)) : R;
    voffA[i] = (unsigned)(R * g.lda + C) * 2u; voffB[i] = (unsigned)(Rb * g.ldb + C) * 2u; }
  const size_t kstep = (size_t)(BK * 2);
  const size_t hstepA = (size_t)HALF * g.lda * 2, hstepB = (size_t)HALF * g.ldb * 2;
  const unsigned ldsw = (unsigned)wid * 1024u;
  const int aoff = lds_byte(wr * 64 + fr, fq * 8), boff = lds_byte(wc * 32 + fr, fq * 8);
#define PG8_SA(b, h) (((b) * 2 + (h)) * HTB)
#define PG8_SB(b, h) ((4 + (b) * 2 + (h)) * HTB)
#define PG8_STAGE(bufoff, gbase, voff) do { _Pragma("unroll") for (int _i = 0; _i < 2; ++_i) \
        __builtin_amdgcn_global_load_lds((const unsigned*)((const char*)(gbase) + (voff)[_i]), (PG8_LAS unsigned*)(lds + (bufoff) + ldsw + _i * 8192), 16, 0, 0); } while (0)
#define PG8_LDA(dst, b, h) do { _Pragma("unroll") for (int m = 0; m < 4; ++m) _Pragma("unroll") for (int k = 0; k < 2; ++k) dst[m][k] = *(const PG8_LAS bf16x8*)(lds + PG8_SA(b, h) + aoff + m * 2048 + k * 1024); } while (0)
#define PG8_LDB(dst, b, h) do { _Pragma("unroll") for (int n = 0; n < 2; ++n) _Pragma("unroll") for (int k = 0; k < 2; ++k) dst[n][k] = *(const PG8_LAS bf16x8*)(lds + PG8_SB(b, h) + boff + n * 2048 + k * 1024); } while (0)
#define PG8_MMA(ai, bj, At, Bt) do { __builtin_amdgcn_s_setprio(1); _Pragma("unroll") for (int m = 0; m < 4; ++m) _Pragma("unroll") for (int n = 0; n < 2; ++n) _Pragma("unroll") for (int k = 0; k < 2; ++k) \
        acc[ai][bj][m][n] = __builtin_amdgcn_mfma_f32_16x16x32_bf16(Bt[n][k], At[m][k], acc[ai][bj][m][n], 0, 0, 0); __builtin_amdgcn_s_setprio(0); } while (0)
#define PG8_WAIT_V(n) asm volatile("s_waitcnt vmcnt(" #n ")" ::: "memory")
#define PG8_WAIT_L(n) asm volatile("s_waitcnt lgkmcnt(" #n ")" ::: "memory")
#define PG8_BAR __builtin_amdgcn_s_barrier()
#define PG8_SCHED __builtin_amdgcn_sched_barrier(0)
#define PG8_ABASE(u) ((const char*)g.A + ((size_t)(u).pm * BM * g.lda + (size_t)((u).pn >> g.a_pn_shift) * g.a_pn_mul) * 2)
#define PG8_BBASE(u) ((const char*)g.Bt + (size_t)(u).pn * BM * g.ldb * 2)
  Unit cur, nxt; int ui = 0;
  if (!S.next(0, cur)) return;
  f32x4 acc[2][2][4][2];
#pragma unroll
  for (int a = 0; a < 2; ++a)
#pragma unroll
    for (int b = 0; b < 2; ++b)
#pragma unroll
      for (int m = 0; m < 4; ++m)
#pragma unroll
        for (int n = 0; n < 2; ++n) acc[a][b][m][n] = (f32x4){0.f, 0.f, 0.f, 0.f};
  bf16x8 At[4][2], B0[2][2], B1[2][2];
  const char* cA = PG8_ABASE(cur); const char* cB = PG8_BBASE(cur);
  asm volatile("" : "+v"(voffA[0]), "+v"(voffA[1]), "+v"(voffB[0]), "+v"(voffB[1]));
  PG8_STAGE(PG8_SB(0, 0), cB, voffB); PG8_STAGE(PG8_SA(0, 0), cA, voffA); PG8_STAGE(PG8_SB(0, 1), cB + hstepB, voffB); PG8_STAGE(PG8_SA(0, 1), cA + hstepA, voffA);
  if (wr == 1) PG8_BAR;
  PG8_WAIT_V(4); PG8_BAR;
  PG8_STAGE(PG8_SB(1, 0), cB + kstep, voffB); PG8_STAGE(PG8_SA(1, 0), cA + kstep, voffA); PG8_STAGE(PG8_SB(1, 1), cB + hstepB + kstep, voffB);
  PG8_WAIT_V(6); PG8_BAR;
  for (;;) {
    const bool has_next = S.next(ui + 1, nxt);
    const char* nA = has_next ? PG8_ABASE(nxt) : cA; const char* nB = has_next ? PG8_BBASE(nxt) : cB;
    for (int t = 0; t < nt; t += 2) {
      const bool last = (t == nt - 2);
      asm volatile("" : "+v"(voffA[0]), "+v"(voffA[1]), "+v"(voffB[0]), "+v"(voffB[1]));
      const char* a1 = cA + (size_t)(t + 1) * kstep;
      const char* a2 = last ? nA : cA + (size_t)(t + 2) * kstep; const char* b2 = last ? nB : cB + (size_t)(t + 2) * kstep;
      const char* a3 = a2 + kstep; const char* b3 = b2 + kstep;
      PG8_LDB(B0, 0, 0); PG8_SCHED; PG8_LDA(At, 0, 0); PG8_STAGE(PG8_SA(1, 1), a1 + hstepA, voffA);
      PG8_WAIT_L(8); PG8_BAR; PG8_WAIT_L(0); PG8_MMA(0, 0, At, B0); PG8_BAR; PG8_SCHED;
      PG8_LDB(B1, 0, 1); PG8_STAGE(PG8_SB(0, 0), b2, voffB);
      PG8_BAR; PG8_WAIT_L(0); PG8_MMA(0, 1, At, B1); PG8_BAR;
      PG8_LDA(At, 0, 1); PG8_STAGE(PG8_SA(0, 0), a2, voffA);
      PG8_BAR; PG8_WAIT_L(0); PG8_MMA(1, 0, At, B0); PG8_BAR; PG8_SCHED;
      PG8_STAGE(PG8_SB(0, 1), b2 + hstepB, voffB);
      PG8_WAIT_V(6); PG8_BAR; PG8_MMA(1, 1, At, B1); PG8_BAR;
      PG8_LDB(B0, 1, 0); PG8_SCHED; PG8_LDA(At, 1, 0); PG8_STAGE(PG8_SA(0, 1), a2 + hstepA, voffA);
      PG8_WAIT_L(8); PG8_BAR; PG8_WAIT_L(0); PG8_MMA(0, 0, At, B0); PG8_BAR; PG8_SCHED;
      PG8_LDB(B1, 1, 1); PG8_STAGE(PG8_SB(1, 0), b3, voffB);
      PG8_BAR; PG8_WAIT_L(0); PG8_MMA(0, 1, At, B1); PG8_BAR;
      PG8_LDA(At, 1, 1); PG8_STAGE(PG8_SA(1, 0), a3, voffA);
      PG8_BAR; PG8_WAIT_L(0); PG8_MMA(1, 0, At, B0); PG8_BAR; PG8_SCHED;
      PG8_STAGE(PG8_SB(1, 1), b3 + hstepB, voffB);
      PG8_WAIT_V(6); PG8_BAR; PG8_MMA(1, 1, At, B1); PG8_BAR;
    }
    epi_call(E, acc, cur, wr, wc, fr, fq);
    if (!has_next) break;
#pragma unroll
    for (int a = 0; a < 2; ++a)
#pragma unroll
      for (int b = 0; b < 2; ++b)
#pragma unroll
        for (int m = 0; m < 4; ++m)
#pragma unroll
          for (int n = 0; n < 2; ++n) acc[a][b][m][n] = (f32x4){0.f, 0.f, 0.f, 0.f};
    cur = nxt; cA = nA; cB = nB; ++ui;
  }
  PG8_WAIT_V(0);
  if (wr == 0) PG8_BAR;
  PG8_BAR;
#undef PG8_SA
#undef PG8_SB
#undef PG8_STAGE
#undef PG8_LDA
#undef PG8_LDB
#undef PG8_MMA
#undef PG8_WAIT_V
#undef PG8_WAIT_L
#undef PG8_BAR
#undef PG8_SCHED
#undef PG8_ABASE
#undef PG8_BBASE
}
}
struct Ctx { i64 gtid, gsz; PG8_LAS unsigned char* lds; char* ldsg; int tid; };
template <class E> DEV void run_gemm(const Ctx& cx, const GemmDesc& g, const E& e) { pg8::gemm_phase<E>(cx.lds, cx.tid, g, e); }
#else
struct Ctx { i64 gtid, gsz; };
template <class E> static void run_gemm(const Ctx& cx, const GemmDesc& g, const E& e) {
  constexpr int W = E::W;
  const int ng = g.ncols / W;
  for (i64 i = cx.gtid; i < (i64)g.nrows * ng; i += cx.gsz) {
    int r = (int)(i / ng), c0 = (int)(i % ng) * W;
    int pn = c0 / 256;
    const bf* a = g.A + (size_t)r * g.lda + (size_t)(pn >> g.a_pn_shift) * g.a_pn_mul;
    float v[8];
    for (int j = 0; j < W; ++j) {
      const bf* b = g.Bt + (size_t)(c0 + j) * g.ldb;
      float acc = 0.f;
      for (int k = 0; k < g.K; ++k) acc += b2f(a[k]) * b2f(b[k]);
      v[j] = acc;
    }
    e.apply(r, c0, v);
  }
}
#endif


#ifndef CPU_SIM
namespace mla {
using bf16x8 = __attribute__((ext_vector_type(8))) short;
using s16x4 = __attribute__((ext_vector_type(4))) short;
using f32x16 = __attribute__((ext_vector_type(16))) float;
using u32x4 = __attribute__((ext_vector_type(4))) unsigned;
constexpr int KVBLK = 64, QBLK = 32;
constexpr float SCALE = 0.10206207261596577f;
constexpr float THR = 8.f;
constexpr int SHM_V = KVBLK * 128 * 2, SHM_K = KVBLK * 128 * 2;
constexpr int SHM_ATTN = 2 * SHM_V + 2 * SHM_K + 8 * 64 * 4;
#define KSWZ(row, colB) ((row) * 256 + ((colB) ^ (((row) & 7) << 4)))
#define SBAR() __builtin_amdgcn_sched_barrier(0)
__device__ __forceinline__ int crow(int r, int hi) { return (r & 3) + 8 * (r >> 2) + 4 * hi; }
__device__ __forceinline__ unsigned cvtpk(float lo, float hi) { unsigned r; asm volatile("v_cvt_pk_bf16_f32 %0, %1, %2" : "=v"(r) : "v"(lo), "v"(hi)); return r; }
__device__ __forceinline__ void partialSM(f32x16& p0, f32x16& p1, float& m_reg, float& mn, float& alpha) {
  constexpr float C = SCALE * 1.4426950408889634f;
  float pmax = p0[0];
#pragma unroll
  for (int r = 1; r < 16; ++r) pmax = fmaxf(pmax, p0[r]);
#pragma unroll
  for (int r = 0; r < 16; ++r) pmax = fmaxf(pmax, p1[r]);
  { auto rr = __builtin_amdgcn_permlane32_swap(__float_as_uint(pmax), __float_as_uint(pmax), false, false);
    pmax = fmaxf(__uint_as_float(rr[0]), __uint_as_float(rr[1])); }
  if (__builtin_expect(__all(pmax - m_reg <= THR / SCALE), 1)) { mn = m_reg; alpha = 1.f; }
  else { mn = fmaxf(m_reg, pmax); alpha = __builtin_amdgcn_exp2f((m_reg - mn) * C); m_reg = mn; }
  float mnC = -mn * C;
#pragma unroll
  for (int r = 0; r < 16; ++r) p0[r] = fmaf(p0[r], C, mnC);
#pragma unroll
  for (int r = 0; r < 16; ++r) p1[r] = fmaf(p1[r], C, mnC);
#pragma unroll
  for (int r = 0; r < 16; ++r) p0[r] = __builtin_amdgcn_exp2f(p0[r]);
}
__device__ __forceinline__ void finishSM(f32x16& p0, f32x16& p1, float alpha, float& l_reg, bf16x8& pa0, bf16x8& pa1, bf16x8& pa2, bf16x8& pa3) {
#pragma unroll
  for (int r = 0; r < 16; ++r) p1[r] = __builtin_amdgcn_exp2f(p1[r]);
  float ps = 0;
#pragma unroll
  for (int r = 0; r < 16; ++r) ps += p0[r];
#pragma unroll
  for (int r = 0; r < 16; ++r) ps += p1[r];
  { auto rr = __builtin_amdgcn_permlane32_swap(__float_as_uint(ps), __float_as_uint(ps), false, false);
    ps = __uint_as_float(rr[0]) + __uint_as_float(rr[1]); }
  l_reg = l_reg * alpha + ps;
#define PK4(P, BASE, OUT) do { unsigned a0 = cvtpk(P[BASE + 0], P[BASE + 1]), a1 = cvtpk(P[BASE + 2], P[BASE + 3]);   \
    unsigned b0 = cvtpk(P[BASE + 4], P[BASE + 5]), b1 = cvtpk(P[BASE + 6], P[BASE + 7]);                              \
    auto r0 = __builtin_amdgcn_permlane32_swap(a0, b0, false, false); auto r1 = __builtin_amdgcn_permlane32_swap(a1, b1, false, false); \
    u32x4 w = {r0[0], r1[0], r0[1], r1[1]}; OUT = *reinterpret_cast<bf16x8*>(&w); } while (0)
  PK4(p0, 0, pa0); PK4(p0, 8, pa1); PK4(p1, 0, pa2); PK4(p1, 8, pa3);
#undef PK4
}
template <int NK16>
__device__ __forceinline__ void qkt(f32x16& p0, f32x16& p1, const char* Ks, const bf16x8* qr, int r32, int hi) {
  p0 = f32x16{}; p1 = f32x16{};
#pragma unroll
  for (int d0 = 0; d0 < NK16; ++d0) { int cb = (d0 * 16 + hi * 8) * 2;
    bf16x8 b0 = *reinterpret_cast<const bf16x8*>(Ks + KSWZ(r32, cb));
    bf16x8 b1 = *reinterpret_cast<const bf16x8*>(Ks + KSWZ(32 + r32, cb));
    p0 = __builtin_amdgcn_mfma_f32_32x32x16_bf16(b0, qr[d0], p0, 0, 0, 0);
    p1 = __builtin_amdgcn_mfma_f32_32x32x16_bf16(b1, qr[d0], p1, 0, 0, 0); }
}
__device__ __forceinline__ int v_st(int k, int c) { const int kk = (k & ~0xC) | ((k & 4) << 1) | ((k & 8) >> 1); return ((kk >> 3) * 4 + (c >> 5)) * 512 + ((kk & 7) * 32 + (c & 31)) * 2; }
__device__ __forceinline__ int v_rd_base(int lane) { return ((lane & 3) << 3) | (((lane >> 2) & 3) << 6) | (((lane >> 4) & 1) << 5) | (((lane >> 5) & 1) << 8); }
constexpr int v_rd_off(int d0, int ks, int half) { return d0 * 512 + ks * 4096 + half * 2048; }
template <int OFF> __device__ __forceinline__ s16x4 tr_read(int vb) {
  s16x4 r; asm volatile("ds_read_b64_tr_b16 %0, %1 offset:%2" : "=&v"(r) : "v"(vb), "i"(OFF) : "memory"); return r;
}
template <int D0> __device__ __forceinline__ void pv_one(f32x16& od, int vb, bf16x8 pa0, bf16x8 pa1, bf16x8 pa2, bf16x8 pa3) {
  const s16x4 l0 = tr_read<v_rd_off(D0, 0, 0)>(vb), h0 = tr_read<v_rd_off(D0, 0, 1)>(vb), l1 = tr_read<v_rd_off(D0, 1, 0)>(vb), h1 = tr_read<v_rd_off(D0, 1, 1)>(vb);
  const s16x4 l2 = tr_read<v_rd_off(D0, 2, 0)>(vb), h2 = tr_read<v_rd_off(D0, 2, 1)>(vb), l3 = tr_read<v_rd_off(D0, 3, 0)>(vb), h3 = tr_read<v_rd_off(D0, 3, 1)>(vb);
  asm volatile("s_waitcnt lgkmcnt(0)" ::: "memory"); SBAR();
#define PK(L, H) (bf16x8){L[0], L[1], L[2], L[3], H[0], H[1], H[2], H[3]}
  od = __builtin_amdgcn_mfma_f32_32x32x16_bf16(pa0, PK(l0, h0), od, 0, 0, 0);
  od = __builtin_amdgcn_mfma_f32_32x32x16_bf16(pa1, PK(l1, h1), od, 0, 0, 0);
  od = __builtin_amdgcn_mfma_f32_32x32x16_bf16(pa2, PK(l2, h2), od, 0, 0, 0);
  od = __builtin_amdgcn_mfma_f32_32x32x16_bf16(pa3, PK(l3, h3), od, 0, 0, 0);
#undef PK
}
__device__ __forceinline__ void pv_d0(f32x16* o, int vb, bf16x8 pa0, bf16x8 pa1, bf16x8 pa2, bf16x8 pa3) {
  pv_one<0>(o[0], vb, pa0, pa1, pa2, pa3); pv_one<1>(o[1], vb, pa0, pa1, pa2, pa3);
}

__device__ __forceinline__ void unit(const Params& p, const int tid, char* lds, int qrow0, int hh, int kbase0, int nt0, int kbase1, int NT) {
  const int wid = tid >> 6, lane = tid & 63, r32 = lane & 31, hi = lane >> 5;
  char* V_lds = lds; char* K_lds = lds + 2 * SHM_V;
  float* wsl = (float*)(lds + 2 * SHM_V + 2 * SHM_K) + wid * 64; float* li_l = wsl; float* al_l = wsl + 32;
  float m_reg = -1e30f, l_reg = 0; f32x16 o[2] = {}; bf16x8 qr[6];
  const bf* Qw = p.QA() + (size_t)(qrow0 + wid * QBLK + r32) * 768 + hh * 96 + hi * 8;
#pragma unroll
  for (int d0 = 0; d0 < 6; ++d0) qr[d0] = *reinterpret_cast<const bf16x8*>(Qw + d0 * 16);
  const int sr = tid >> 4, sc = (tid & 15) * 8, vst0 = v_st(sr, sc), vst1 = v_st(32 + sr, sc);
  const int vb0 = (int)(uintptr_t)V_lds + v_rd_base(lane);
  const bf* ksrc; int kstride;
  if (sc < 64) { ksrc = p.KVA() + hh * 128 + sc; kstride = 1024; } else { ksrc = p.P() + C_KR + ((sc - 64) & 31); kstride = PC; }
  const bf* vsrc = p.KVA() + hh * 128 + 64 + (sc & 63);
  struct { bf16x8 vs0, vs1, ks0, ks1; } sr_[2];
#define KROW(j) ((j) < nt0 ? kbase0 + (j) * KVBLK : kbase1 + ((j) - nt0) * KVBLK)
#define SLOAD(i, j) do { const int _kr = KROW(j); \
    sr_[i].vs0 = *reinterpret_cast<const bf16x8*>(vsrc + (size_t)(_kr + sr) * 1024); sr_[i].vs1 = *reinterpret_cast<const bf16x8*>(vsrc + (size_t)(_kr + 32 + sr) * 1024); \
    sr_[i].ks0 = *reinterpret_cast<const bf16x8*>(ksrc + (size_t)(_kr + sr) * kstride); sr_[i].ks1 = *reinterpret_cast<const bf16x8*>(ksrc + (size_t)(_kr + 32 + sr) * kstride); } while (0)
#define SWRITE(b, i) do { *(bf16x8*)(V_lds + (b) * SHM_V + vst0) = sr_[i].vs0;          \
    *(bf16x8*)(V_lds + (b) * SHM_V + vst1) = sr_[i].vs1; int kc = sc * 2;               \
    *(bf16x8*)(K_lds + (b) * SHM_K + KSWZ(sr, kc)) = sr_[i].ks0;                       \
    *(bf16x8*)(K_lds + (b) * SHM_K + KSWZ(32 + sr, kc)) = sr_[i].ks1; } while (0)
#define SWAIT() asm volatile("s_waitcnt vmcnt(4)" ::: "memory")
#define RESC(a) do { if (__any((a) < 1.f)) { if (hi == 0) al_l[r32] = (a); asm volatile("s_waitcnt lgkmcnt(0)" ::: "memory"); \
    _Pragma("unroll") for (int d = 0; d < 2; ++d) _Pragma("unroll") for (int r = 0; r < 16; ++r) o[d][r] *= al_l[crow(r, hi)]; } } while (0)
  f32x16 pA0, pA1, pB0, pB1; float mnA, mnB, alA, alB; bf16x8 pa0, pa1, pa2, pa3;
  constexpr int SE = 0, SO = 1;
  __syncthreads();
  SLOAD(SE, 0); asm volatile("s_waitcnt vmcnt(0)" ::: "memory"); SWRITE(0, SE); __syncthreads();
  qkt<6>(pA0, pA1, K_lds, qr, r32, hi); partialSM(pA0, pA1, m_reg, mnA, alA);
  SLOAD(SO, 1); if (2 < NT) SLOAD(SE, 2);
  SWAIT();
  SWRITE(1, SO); __syncthreads();
  for (int j = 1; j + 1 < NT; j += 2) {
    SBAR(); qkt<6>(pB0, pB1, K_lds + SHM_K, qr, r32, hi);
    finishSM(pA0, pA1, alA, l_reg, pa0, pa1, pa2, pa3); SBAR();
    SLOAD(SO, j + 2); SBAR();
    pv_d0(o, vb0, pa0, pa1, pa2, pa3); partialSM(pB0, pB1, m_reg, mnB, alB);
    __syncthreads(); SWAIT(); SWRITE(0, SE);
    RESC(alB); __syncthreads();
    SBAR(); qkt<6>(pA0, pA1, K_lds, qr, r32, hi);
    finishSM(pB0, pB1, alB, l_reg, pa0, pa1, pa2, pa3); SBAR();
    if (j + 3 < NT) SLOAD(SE, j + 3); SBAR();
    pv_d0(o, vb0 + SHM_V, pa0, pa1, pa2, pa3); partialSM(pA0, pA1, m_reg, mnA, alA);
    __syncthreads(); SWAIT(); SWRITE(1, SO);
    RESC(alA); __syncthreads();
  }
  SBAR(); qkt<6>(pB0, pB1, K_lds + SHM_K, qr, r32, hi);
  finishSM(pA0, pA1, alA, l_reg, pa0, pa1, pa2, pa3); SBAR();
  pv_d0(o, vb0, pa0, pa1, pa2, pa3); partialSM(pB0, pB1, m_reg, mnB, alB);
  __syncthreads(); RESC(alB);
  finishSM(pB0, pB1, alB, l_reg, pa0, pa1, pa2, pa3); SBAR();
  pv_d0(o, vb0 + SHM_V, pa0, pa1, pa2, pa3);
  asm volatile("s_waitcnt vmcnt(0)" ::: "memory");
  if (hi == 0) li_l[r32] = l_reg; asm volatile("s_waitcnt lgkmcnt(0)" ::: "memory");
  float rli[16];
#pragma unroll
  for (int r = 0; r < 16; ++r) rli[r] = __builtin_amdgcn_rcpf(li_l[crow(r, hi)]);
  bf* Ow = p.Y() + (size_t)(qrow0 + wid * QBLK) * 2048 + hh * 64;
#pragma unroll
  for (int r = 0; r < 16; ++r) { int orow = crow(r, hi);
#pragma unroll
    for (int d0 = 0; d0 < 2; ++d0) Ow[(size_t)orow * 2048 + d0 * 32 + r32] = f2b(o[d0][r] * rli[r]); }
#undef SLOAD
#undef SWRITE
#undef SWAIT
#undef RESC
#undef KROW
}
#undef KSWZ
#undef SBAR
}

DEV void ph_mla(const Params& p, const Ctx& cx, int last) {
  const int nlat_units = NB * 8 * (N / 256);
  const int nctx_units = last ? 0 : NB * 8 * (LC / 256);
  for (int u = blockIdx.x; u < nlat_units + nctx_units; u += gridDim.x) {
    if (u < nlat_units) {
      int qb = u % (N / 256), hh = (u / (N / 256)) % 8, b = u / (8 * (N / 256));
      mla::unit(p, cx.tid, (char*)cx.ldsg, b * N + qb * 256, hh, b * N, N / 64, NLAT + b * LC, (N + LC) / 64);
    } else {
      int v = u - nlat_units; int qb = v % (LC / 256), hh = (v / (LC / 256)) % 8, b = v / (8 * (LC / 256));
      mla::unit(p, cx.tid, (char*)cx.ldsg, NLAT + b * LC + qb * 256, hh, NLAT + b * LC, LC / 64, 0, LC / 64);
    }
  }
}
#endif


namespace hy {
constexpr int NF = 2 * N;
struct f2 { float x, y; };
DEV f2 cmul(f2 a, f2 b) { f2 r; r.x = a.x * b.x - a.y * b.y; r.y = a.x * b.y + a.y * b.x; return r; }
DEV f2 cmulc(f2 a, f2 b) { f2 r; r.x = a.x * b.x + a.y * b.y; r.y = a.y * b.x - a.x * b.y; return r; }
DEV void fwd_pass(f2* buf, const f2* tw, int L, int tid, int nthr) {
  const int Q = L >> 2, tws = NF / L;
  for (int u = tid; u < NF / 4; u += nthr) {
    const int g = u / Q, j = u - g * Q, base = g * L + j;
    const f2 x0 = buf[base], x1 = buf[base + Q], x2 = buf[base + 2 * Q], x3 = buf[base + 3 * Q];
    f2 a0{x0.x + x2.x, x0.y + x2.y}, a1{x0.x - x2.x, x0.y - x2.y}, a2{x1.x + x3.x, x1.y + x3.y};
    f2 d{x1.x - x3.x, x1.y - x3.y}; f2 a3{d.y, -d.x};
    f2 y0{a0.x + a2.x, a0.y + a2.y}, y1{a1.x + a3.x, a1.y + a3.y}, y2{a0.x - a2.x, a0.y - a2.y}, y3{a1.x - a3.x, a1.y - a3.y};
    buf[base] = y0; buf[base + Q] = cmul(y1, tw[j * tws]); buf[base + 2 * Q] = cmul(y2, tw[2 * j * tws]); buf[base + 3 * Q] = cmul(y3, tw[3 * j * tws]);
  }
}
DEV void inv_pass(f2* buf, const f2* tw, int L, int tid, int nthr) {
  const int Q = L >> 2, tws = NF / L;
  for (int u = tid; u < NF / 4; u += nthr) {
    const int g = u / Q, j = u - g * Q, base = g * L + j;
    const f2 u0 = buf[base], u1 = cmulc(buf[base + Q], tw[j * tws]), u2 = cmulc(buf[base + 2 * Q], tw[2 * j * tws]), u3 = cmulc(buf[base + 3 * Q], tw[3 * j * tws]);
    f2 a0{u0.x + u2.x, u0.y + u2.y}, a1{u0.x - u2.x, u0.y - u2.y}, a2{u1.x + u3.x, u1.y + u3.y};
    f2 d{u1.x - u3.x, u1.y - u3.y}; f2 a3{-d.y, d.x};
    buf[base] = f2{a0.x + a2.x, a0.y + a2.y}; buf[base + Q] = f2{a1.x + a3.x, a1.y + a3.y};
    buf[base + 2 * Q] = f2{a0.x - a2.x, a0.y - a2.y}; buf[base + 3 * Q] = f2{a1.x - a3.x, a1.y - a3.y};
  }
}
DEV void s1_taps(const Params& p, f2* buf, float* red, int c, int tid, int nthr) {
  float ss = 0.f;
  for (int k = tid; k < NF; k += nthr) {
    float v = 0.f;
    if (k < N) v = p.F()[(size_t)k * 1024 + c];
    else if (k > N) v = p.F()[(size_t)(NF - k) * 1024 + 512 + c];
    buf[k] = f2{v, 0.f}; ss += v * v;
  }
  red[tid] = ss;
}
DEV float red_total(const float* red, int nthr) { float s = 0.f; for (int i = 0; i < nthr; ++i) s += red[i]; return s; }
DEV void s3_store(const f2* buf, unsigned* hs, int tid, int nthr) {
  for (int k = tid; k < NF; k += nthr) hs[k] = (unsigned)f2b(buf[k].x).v | ((unsigned)f2b(buf[k].y).v << 16);
}
DEV void s4_loadz(const Params& p, f2* buf, int c, int tid, int nthr) {
  for (int t = tid; t < NF; t += nthr) {
    f2 v{0.f, 0.f};
    if (t < N) { v.x = b2f(p.Z()[(size_t)t * 512 + c]); v.y = b2f(p.Z()[(size_t)(N + t) * 512 + c]); }
    buf[t] = v;
  }
}
DEV void s6_mul(f2* buf, const unsigned* hs, int tid, int nthr) {
  for (int k = tid; k < NF; k += nthr) {
    union { unsigned u; float f; } a, b; const unsigned w = hs[k]; a.u = w << 16; b.u = w & 0xFFFF0000u;
    buf[k] = cmul(buf[k], f2{a.f, b.f});
  }
}
DEV void s8_out(const Params& p, const f2* buf, const float* red, int l, int c, int tid, int nthr) {
  const float fn = 1.0f / sqrtf(red_total(red, nthr) + EPS) * (1.0f / (float)NF);
  const float* cw = p.in[I_hy_conv_w] + l * 3 * 1536; const float cb = p.in[I_hy_conv_b][l * 1536 + c];
  const float w0 = cw[c], w1 = cw[1536 + c], w2 = cw[2 * 1536 + c];
  const float skip = p.in[I_hy_skip][l * 512 + c];
  for (int i = tid; i < 2 * N; i += nthr) {
    const int b = i / N, t = i - b * N;
    const size_t r = (size_t)b * N + t;
    const float conv = (b ? buf[t].y : buf[t].x) * fn;
    float x0 = cb + w1 * b2f(p.P()[r * PC + C_HU + c]);
    if (t > 0) x0 += w0 * b2f(p.P()[(r - 1) * PC + C_HU + c]);
    if (t < N - 1) x0 += w2 * b2f(p.P()[(r + 1) * PC + C_HU + c]);
    const float y = conv + skip * b2f(p.Z()[r * 512 + c]);
    p.Y()[r * 2048 + 1024 + c] = f2b(x0 * y);
  }
}
#ifndef CPU_SIM
DEV void channel(const Params& p, int l, int c, int tid, f2* buf, float* red, unsigned* hs) {
  const f2* tw = (const f2*)p.tw();
  __syncthreads();
  s1_taps(p, buf, red, c, tid, 512); __syncthreads();
  for (int L = NF; L >= 4; L >>= 2) { fwd_pass(buf, tw, L, tid, 512); __syncthreads(); }
  s3_store(buf, hs, tid, 512); __syncthreads();
  s4_loadz(p, buf, c, tid, 512); __syncthreads();
  for (int L = NF; L >= 4; L >>= 2) { fwd_pass(buf, tw, L, tid, 512); __syncthreads(); }
  s6_mul(buf, hs, tid, 512); __syncthreads();
  for (int L = 4; L <= NF; L <<= 2) { inv_pass(buf, tw, L, tid, 512); __syncthreads(); }
  s8_out(p, buf, red, l, c, tid, 512);
}
#endif
}

#ifndef CPU_SIM
DEV void ph_hyena_fft(const Params& p, const Ctx& cx, int l) {
  hy::f2* buf = (hy::f2*)cx.ldsg; float* red = (float*)(cx.ldsg + (size_t)hy::NF * 8);
  unsigned* hs = p.Hs() + (size_t)blockIdx.x * hy::NF;
  const int nb = gridDim.x;
  for (int i = blockIdx.x; i < 512; i += nb) {
    const int xcd = i & 7, idx = i >> 3;
    const int c = xcd * 64 + idx;
    hy::channel(p, l, c, cx.tid, buf, red, hs);
  }
}
#endif

constexpr int NOSH = 30;
constexpr int PH_PER_LAYER = 15;
constexpr int NPHASES = 2 + 2 * PH_PER_LAYER;

DEV void run_phase(const Params& p, int ph, const Ctx& cx) {
  const i64 gtid = cx.gtid, gsz = cx.gsz;
  if (ph == 0) { ph_init(p, gtid, gsz); return; }
  if (ph == NPHASES - 1) { ph_final(p, gtid, gsz); return; }
  const int l = (ph - 1) / PH_PER_LAYER, s = (ph - 1) % PH_PER_LAYER;
  const int last = (l == 1);
  const int nr = last ? NLAT : TT;
#ifdef ONLY
  if (s != ONLY) return;
#endif
  switch (s) {
    case 0: {
      PrepCtx pc;
#ifndef CPU_SIM
      pc.tid = cx.tid; pc.tl = (float*)cx.ldsg;
#else
      pc.gtid = gtid; pc.gsz = gsz;
#endif
      ph_prep(p, l, pc, gtid, gsz); ph_norm(p, l, 0, TT, gtid, gsz);
    } break;
    case 1: { GemmDesc g{p.h(), p.W_in(), D, D, D, TT, 3840, NOSH, 0}; EpiInproj e{p}; run_gemm(cx, g, e); } break;
    case 2: ph_B0(p, l, gtid, gsz); break;
    case 3: {
      { GemmDesc g{p.P() + C_CQ, p.W_uq(), PC, 256, 256, nr, 768, NOSH, 0}; EpiUq e{p}; run_gemm(cx, g, e); }
      { GemmDesc g{p.P() + C_CKV, p.W_ukv(), PC, 256, 256, TT, 1024, NOSH, 0}; EpiUkv e{p}; run_gemm(cx, g, e); }
      { GemmDesc g{p.XC(), p.W_lru(), 512, 256, 256, TT, 2048, 2, 256}; EpiLru e{p, l}; run_gemm(cx, g, e); }
      ph_fnorm(p, gtid, gsz);
    } break;
    case 4:
      ph_lru1(p, gtid, gsz);
#ifndef CPU_SIM
      ph_hyena_fft(p, cx, l);
      ph_mla(p, cx, last);
#endif
      ph_C(p, l, last, gtid, gsz); break;
    case 5: ph_lru3(p, last, gtid, gsz); break;
    case 6:
      for (int br = 0; br < 4; ++br) {
        { GemmDesc g{p.h(), p.W_g() + (size_t)br * 1024 * 1024, D, D, D, nr, 1024, NOSH, 0}; EpiGate e{p}; run_gemm(cx, g, e); }
        { GemmDesc g{p.Y() + br * 512, p.W_br() + (size_t)br * 1024 * 512, 2048, 512, 512, nr, 1024, NOSH, 0}; EpiBranch e{p, br}; run_gemm(cx, g, e); }
      }
      break;
    case 7: { GemmDesc g{p.M(), p.W_out(), D, D, D, nr, 1024, NOSH, 0}; EpiOut e{p, l}; run_gemm(cx, g, e); } break;
    case 8: ph_norm(p, l, 1, nr, gtid, gsz); break;
    case 9: { GemmDesc g{p.h(), p.W_q(), D, D, D, nr, 1024, NOSH, 0}; EpiPQ e{p}; run_gemm(cx, g, e); } break;
    case 10: { GemmDesc g{p.PQ(), p.W_key(), 1024, 256, 256, nr, 2048, 1, 256}; EpiSC e{p}; run_gemm(cx, g, e); } break;
    case 11: ph_E2a(p, nr, gtid, gsz); break;
    case 12: ph_E2b(p, nr, gtid, gsz); break;
    case 13: ph_E3(p, l, nr, gtid, gsz); break;
    case 14: ph_E4(p, l, nr, gtid, gsz); break;
  }
}

#ifdef CPU_SIM
static void fill_params(Params& p, void* const* d_in, void* d_out, void* d_ws) {
  p.in = (const float* const*)d_in;
  p.out = (float*)d_out;
  p.ws = (char*)d_ws;
}
#endif

#ifndef CPU_SIM
static_assert(TT % 256 == 0 && NLAT % 256 == 0, "row tiles");
constexpr int LDS_BYTES = 131072 + 4096;
__global__ void __launch_bounds__(512, 2) mega_kernel(KArgs ka) {
  extern __shared__ __attribute__((aligned(16))) unsigned char shm[];
  cg::grid_group grid = cg::this_grid();
  {
    int tid = threadIdx.x;
    asm volatile("" : "+v"(tid));
    const i64 gtid = (i64)blockIdx.x * 512 + tid, gsz = (i64)gridDim.x * 512;
    ph_init(ka, gtid, gsz);
    if (gtid < N_IN) ((const float**)(ka.ws + WL.tbl))[gtid] = ka.in[gtid];
  }
  grid.sync();
  Params p; p.out = ka.out; p.ws = ka.ws; p.in = (const float* const*)(ka.ws + WL.tbl);
  for (int ph = 1; ph < NPHASES - 1; ++ph) {
    int tid = threadIdx.x;
    asm volatile("" : "+v"(tid));
    Ctx cx;
    cx.tid = tid;
    cx.gtid = (i64)blockIdx.x * 512 + tid; cx.gsz = (i64)gridDim.x * 512;
    cx.lds = (PG8_LAS unsigned char*)shm; cx.ldsg = (char*)shm;
    run_phase(p, ph, cx);
    grid.sync();
  }
  {
    int tid = threadIdx.x;
    asm volatile("" : "+v"(tid));
    ph_final(p, (i64)blockIdx.x * 512 + tid, (i64)gridDim.x * 512);
  }
}

extern "C" void kernel_launch(void* const* d_in, const int* in_sizes, int n_in, void* d_out, int out_size,
                              void* d_ws, size_t ws_size, hipStream_t stream) {
  static int grid_blocks = 0;
  if (!grid_blocks) {
    int dev = 0, cus = 0, per_cu = 0;
    (void)hipGetDevice(&dev);
    (void)hipDeviceGetAttribute(&cus, hipDeviceAttributeMultiprocessorCount, dev);
    if (hipFuncSetAttribute((const void*)mega_kernel, hipFuncAttributeMaxDynamicSharedMemorySize, LDS_BYTES) != hipSuccess)
      fprintf(stderr, "hipFuncSetAttribute failed\n");
    (void)hipOccupancyMaxActiveBlocksPerMultiprocessor(&per_cu, mega_kernel, 512, LDS_BYTES);
    if (per_cu > 1) per_cu = 1;
    if (per_cu < 1) per_cu = 1;
    grid_blocks = cus * per_cu;
  }
  KArgs ka;
  std::memset((void*)&ka, 0, sizeof(ka));
  for (int i = 0; i < N_IN; ++i) ka.in[i] = (const float*)d_in[i];
  ka.out = (float*)d_out; ka.ws = (char*)d_ws;
  void* args[] = {&ka};
  hipError_t e = hipLaunchCooperativeKernel((void*)mega_kernel, dim3(grid_blocks), dim3(512), args, LDS_BYTES, stream);
  if (e != hipSuccess) fprintf(stderr, "cooperative launch failed: %s (grid %d)\n", hipGetErrorString(e), grid_blocks);
}
#endif
```

```cpp
#ifndef CPU_SIM
#include <hip/hip_runtime.h>
#include <hip/hip_cooperative_groups.h>
#include <cstdio>
#include <cstring>
namespace cg = cooperative_groups;
#define DEV __device__ __forceinline__
#define DEVN __device__ __forceinline__
#define MDEV __device__ __forceinline__
typedef _Float16 sc_t;
#else
#include <cmath>
#include <cstdio>
#include <cstdint>
#include <cstring>
#define DEV static inline
#define DEVN static
#define MDEV inline
typedef float sc_t;
#endif

#ifndef REPEAT_S
#define REPEAT_S -1
#endif
#ifndef PROBE_K
#define PROBE_K -1
#endif
#ifndef SEQ_N
#define SEQ_N 8192
#endif
#ifndef CTX_L
#define CTX_L 256
#endif

typedef long long i64;

constexpr int D = 1024, NB = 2, N = SEQ_N, LC = CTX_L;
constexpr int NLAT = NB * N, NCTX = NB * LC, TT = NLAT + NCTX;
constexpr int GRIDW = 64;
constexpr int INC = 7840, PC = 3840;
constexpr int C_CQ = 0, C_CKV = 256, C_KR = 384, C_LX = 416, C_LG = 928, C_HU = 1440, C_GQ = 2976, C_GKV = 3488, C_GT = 3744;
constexpr int NEXP = 16384;
constexpr float EPS = 1e-6f;
#ifndef CPU_SIM
constexpr int PH_PER_LAYER = 13;
#else
constexpr int PH_PER_LAYER = 16;
#endif
constexpr int NPHASES = 2 + 2 * PH_PER_LAYER;
constexpr int LCH = 64, NCC = LC / LCH, NCL = N / LCH, NCHK = NCC + NCL;

enum { I_x, I_c, I_ctx, I_c_ctx, I_g_mix, I_g_ffn, I_w_mod, I_b_mod, I_w_in, I_mla_g_cq, I_mla_g_ckv, I_mla_w_uq,
       I_mla_w_ukv, I_lru_conv_w, I_lru_conv_b, I_lru_w_r, I_lru_b_r, I_lru_w_i, I_lru_b_i, I_lru_lam,
       I_hy_conv_w, I_hy_conv_b, I_hy_w1, I_hy_b1, I_hy_f1, I_hy_w2, I_hy_b2, I_hy_f2, I_hy_w3, I_hy_skip,
       I_gqa_sink, I_w_branch, I_w_out, I_peer_w_q, I_peer_keys, I_peer_u, I_peer_v, I_g_final, N_IN };

struct bf { unsigned short v; };
DEV float b2f(bf x) { union { unsigned u; float f; } c; c.u = ((unsigned)x.v) << 16; return c.f; }
DEV bf f2b(float f) { union { unsigned u; float f; } c; c.f = f; unsigned r = c.u + 0x7FFFu + ((c.u >> 16) & 1u); bf o; o.v = (unsigned short)(r >> 16); return o; }


constexpr size_t al256(size_t x) { return (x + 255) & ~(size_t)255; }
struct WsLayout {
  size_t xcur, mods, hdn2, ssq, tabA, tabD, fnorm, SA, SB, tw, tbl, ts, spl, bar, hdn2b, W3T, h, Y, Z, XC, LA, LB, P, QA, KVA;
  size_t W_in, W_g, W_uq, W_ukv, W_lru, W_br, W_out, W_q, W_key;
  size_t M, Gs, G, SC, TKs, TKi, SELi, SELg, W, Ub, Vb, YT, total;
};
constexpr WsLayout make_layout() {
  WsLayout w{};
  size_t o = 0;
  w.xcur = o; o = al256(o + (size_t)TT * D * 4);
  w.mods = o; o = al256(o + (size_t)2 * 3 * 6 * D * 4);
  w.hdn2 = o; o = al256(o + (size_t)2 * (N + LC) * 64 * 4);
  w.ssq = o; o = al256(o + (size_t)2 * TT * 4);
  w.tabA = o; o = al256(o + (size_t)128 * 8 * 2 * 4);
  w.tabD = o; o = al256(o + (size_t)128 * 16 * 2 * 4);
  w.fnorm = o; o = al256(o + (size_t)2 * 512 * 4);
  w.tw = o; o = al256(o + (size_t)2 * N * 8);
  w.tbl = o; o = al256(o + (size_t)N_IN * 8);
  w.ts = o; o = al256(o + (size_t)64 * 8);
  w.spl = o; o = al256(o + (size_t)2 * 2 * 512 * 4);
  w.bar = o; o = al256(o + (size_t)3456 * 4);
  w.hdn2b = o; o = al256(o + (size_t)2 * (N + LC) * 256 * 2);
  w.W3T = o; o = al256(o + (size_t)1024 * 256 * 2);
  w.SA = o; o = al256(o + (size_t)2 * NB * NCHK * 512 * 4);
  w.SB = o; o = al256(o + (size_t)2 * NB * NCHK * 512 * 4);
  w.h = o; o = al256(o + (size_t)TT * D * 2);
  w.Y = o; w.Ub = o; w.Vb = o + (size_t)NEXP * D; o = al256(o + (size_t)TT * 2048 * 2);
  w.Z = o; o = al256(o + (size_t)TT * 512 * 2);
  w.W_in = o; o = al256(o + (size_t)3840 * 1024 * 2);
  w.W_g = o; o = al256(o + (size_t)4096 * 1024 * 2);
  w.W_uq = o; o = al256(o + (size_t)768 * 256 * 2);
  w.W_ukv = o; o = al256(o + (size_t)1024 * 256 * 2);
  w.W_lru = o; o = al256(o + (size_t)2048 * 256 * 2);
  w.W_br = o; o = al256(o + (size_t)4 * 1024 * 512 * 2);
  w.W_out = o; o = al256(o + (size_t)1024 * 1024 * 2);
  w.W_q = o; o = al256(o + (size_t)1024 * 1024 * 2);
  w.W_key = o; o = al256(o + (size_t)2048 * 256 * 2);
  size_t rl = o;
  w.XC = o; o = al256(o + (size_t)TT * 512 * 2);
  w.LA = o; o = al256(o + (size_t)2 * TT * 512 * 2);
  w.LB = o; o = al256(o + (size_t)2 * TT * 512 * 2);
  size_t rl_end = o;
  o = rl;
  w.TKs = o; o = al256(o + (size_t)TT * 256 * 4);
  w.TKi = o; o = al256(o + (size_t)TT * 256 * 4);
  w.SELi = o; o = al256(o + (size_t)TT * 128 * 4);
  w.SELg = o; o = al256(o + (size_t)TT * 128 * 4);
  w.W = o; o = al256(o + (size_t)TT * 128 * 4);
  if (o > rl_end) rl_end = o;
  o = rl_end;
  size_t rp = o;
  w.P = o; o = al256(o + (size_t)TT * PC * 2);
  w.QA = o; o = al256(o + (size_t)TT * 768 * 2);
  w.KVA = o; o = al256(o + (size_t)TT * 1024 * 2);
  size_t rp_end = o;
  o = rp;
  w.M = o; o = al256(o + (size_t)TT * D * 2);
  w.G = o; if (o + (size_t)TT * 3072 * 2 > rp_end) rp_end = o + (size_t)TT * 3072 * 2;
  w.Gs = o; o = al256(o + (size_t)TT * D * 2);
  w.SC = o; o = al256(o + (size_t)TT * 2048 * sizeof(sc_t));
  if (o > rp_end) rp_end = o;
  w.YT = rp_end; rp_end = al256(rp_end + (size_t)512 * NB * N * 2);
  w.total = rp_end;
  return w;
}
constexpr WsLayout WL = make_layout();
static_assert((size_t)TT * 4096 <= (size_t)TT * 512 * 2 + (size_t)4 * TT * 512 * 2, "uint8 gates must fit in the XC/LA/LB region");
static_assert(WL.LB == WL.LA + (size_t)2 * TT * 512 * 2, "LA and LB must be contiguous (packed GPU layout)");
static_assert(WL.total <= (size_t)512 * 1024 * 1024, "workspace too large");
#ifndef CPU_SIM
static_assert((size_t)2 * NEXP * D * 2 <= (size_t)TT * 2048 * 2, "bf16 expert tables must fit in Y");
#endif
struct WsAcc {
  float* out;
  char* ws;
  MDEV float* xcur() const { return (float*)(ws + WL.xcur); }
  MDEV float* mods() const { return (float*)(ws + WL.mods); }
  MDEV float* hdn2() const { return (float*)(ws + WL.hdn2); }
  MDEV float* ssq() const { return (float*)(ws + WL.ssq); }
  MDEV float* tabA() const { return (float*)(ws + WL.tabA); }
  MDEV float* tabD() const { return (float*)(ws + WL.tabD); }
  MDEV float* fnorm() const { return (float*)(ws + WL.fnorm); }
  MDEV float* tw() const { return (float*)(ws + WL.tw); }
  MDEV unsigned* Hs() const { return (unsigned*)((char*)out + (((size_t)(N + LC) * 1024 * 4 + 255) & ~(size_t)255)); }
  MDEV float* spl() const { return (float*)(ws + WL.spl); }
  MDEV bf* XYT() const { return (bf*)((char*)out + (((size_t)(N + LC) * 1024 * 4 + 255) & ~(size_t)255)); }
  MDEV bf* hdn2b() const { return (bf*)(ws + WL.hdn2b); }
  MDEV bf* W3T() const { return (bf*)(ws + WL.W3T); }
  MDEV float* SA() const { return (float*)(ws + WL.SA); }
  MDEV float* SB() const { return (float*)(ws + WL.SB); }
  MDEV bf* h() const { return (bf*)(ws + WL.h); }
  MDEV bf* Y() const { return (bf*)(ws + WL.Y); }
  MDEV bf* Z() const { return (bf*)(ws + WL.Z); }
  MDEV bf* XC() const { return (bf*)(ws + WL.XC); }
  MDEV bf* LA() const { return (bf*)(ws + WL.LA); }
  MDEV bf* LB() const { return (bf*)(ws + WL.LB); }
  MDEV bf* P() const { return (bf*)(ws + WL.P); }
  MDEV bf* QA() const { return (bf*)(ws + WL.QA); }
  MDEV bf* KVA() const { return (bf*)(ws + WL.KVA); }
  MDEV float* F() const { return out; }
  MDEV bf* W_in() const { return (bf*)(ws + WL.W_in); }
  MDEV bf* W_g() const { return (bf*)(ws + WL.W_g); }
  MDEV bf* W_uq() const { return (bf*)(ws + WL.W_uq); }
  MDEV bf* W_ukv() const { return (bf*)(ws + WL.W_ukv); }
  MDEV bf* W_lru() const { return (bf*)(ws + WL.W_lru); }
  MDEV bf* W_br() const { return (bf*)(ws + WL.W_br); }
  MDEV bf* W_out() const { return (bf*)(ws + WL.W_out); }
  MDEV bf* W_q() const { return (bf*)(ws + WL.W_q); }
  MDEV bf* W_key() const { return (bf*)(ws + WL.W_key); }
  MDEV bf* M() const { return (bf*)(ws + WL.M); }
  MDEV bf* Gs() const { return (bf*)(ws + WL.Gs); }
  MDEV bf* PQ() const { return (bf*)(ws + WL.Gs); }
  MDEV bf* BR() const { return (bf*)(ws + WL.G); }
  MDEV unsigned char* G8() const { return (unsigned char*)(ws + WL.XC); }
  MDEV unsigned* LAB() const { return (unsigned*)(ws + WL.LA); }
  MDEV bf* YT() const { return (bf*)(ws + WL.YT); }
  MDEV sc_t* SC() const { return (sc_t*)(ws + WL.SC); }
  MDEV float* TKs() const { return (float*)(ws + WL.TKs); }
  MDEV int* TKi() const { return (int*)(ws + WL.TKi); }
  MDEV int* SELi() const { return (int*)(ws + WL.SELi); }
  MDEV float* SELg() const { return (float*)(ws + WL.SELg); }
  MDEV float* W() const { return (float*)(ws + WL.W); }
  MDEV bf* Ub() const { return (bf*)(ws + WL.Ub); }
  MDEV bf* Vb() const { return (bf*)(ws + WL.Vb); }
};
struct KArgs : WsAcc { const float* in[N_IN]; };
struct Params : WsAcc { const float* const* in; };
static_assert((size_t)(N + LC) * 1024 * 4 + 256 + (size_t)256 * 2 * N * 4 <= (size_t)NLAT * D * 4, "F + spectrum scratch must fit in d_out");

#ifndef CPU_SIM
DEV float fexpf_(float x) { return __builtin_amdgcn_exp2f(x * 1.4426950408889634f); }
DEV float sigmoidf_(float x) { return __builtin_amdgcn_rcpf(1.0f + __builtin_amdgcn_exp2f(-x * 1.4426950408889634f)); }
DEV float siluf_(float x) { return x * sigmoidf_(x); }
DEV float geluf_(float x) { return x * sigmoidf_(1.5957691216057308f * (x + 0.044715f * x * x * x)); }
#else
DEV float fexpf_(float x) { return expf(x); }
DEV float sigmoidf_(float x) { return 1.0f / (1.0f + expf(-x)); }
DEV float siluf_(float x) { return x * sigmoidf_(x); }
DEV float geluf_(float x) { return 0.5f * x * (1.0f + tanhf(0.7978845608028654f * (x + 0.044715f * x * x * x))); }
#endif
DEV float softplusf_(float x) { return x > 20.f ? x : log1pf(expf(x)); }

#ifndef CPU_SIM
DEV float lane_xor(float v, int lane, int o) { return __int_as_float(__builtin_amdgcn_ds_bpermute(((lane ^ o) & 63) << 2, __float_as_int(v))); }
#endif
#ifndef CPU_SIM
DEV void unpack8(const uint4 w, float* f) {
  union { unsigned u; float x; } c;
  c.u = w.x << 16; f[0] = c.x; c.u = w.x & 0xFFFF0000u; f[1] = c.x; c.u = w.y << 16; f[2] = c.x; c.u = w.y & 0xFFFF0000u; f[3] = c.x;
  c.u = w.z << 16; f[4] = c.x; c.u = w.z & 0xFFFF0000u; f[5] = c.x; c.u = w.w << 16; f[6] = c.x; c.u = w.w & 0xFFFF0000u; f[7] = c.x;
}
#endif
struct RowInfo { int b, t, L, base, lat; };
DEV RowInfo rowinfo(int r) {
  RowInfo ri;
  if (r < NLAT) { ri.b = r / N; ri.t = r - ri.b * N; ri.L = N; ri.base = ri.b * N; ri.lat = 1; }
  else { int rc = r - NLAT; ri.b = rc / LC; ri.t = rc - ri.b * LC; ri.L = LC; ri.base = NLAT + ri.b * LC; ri.lat = 0; }
  return ri;
}
DEV int modrow(int r) { return r < NLAT ? r / N : 2; }
template <class PT> DEV const float* xin_row(const PT& p, int r) { return r < NLAT ? p.in[I_x] + (size_t)r * D : p.in[I_ctx] + (size_t)(r - NLAT) * D; }

DEV void atomic_addf(float* p, float v) {
#ifndef CPU_SIM
  atomicAdd(p, v);
#else
#pragma omp atomic
  *p += v;
#endif
}
DEV void store8bf(bf* dst, const float* v) {
#ifndef CPU_SIM
  uint4 w;
  asm volatile("v_cvt_pk_bf16_f32 %0, %1, %2" : "=v"(w.x) : "v"(v[0]), "v"(v[1]));
  asm volatile("v_cvt_pk_bf16_f32 %0, %1, %2" : "=v"(w.y) : "v"(v[2]), "v"(v[3]));
  asm volatile("v_cvt_pk_bf16_f32 %0, %1, %2" : "=v"(w.z) : "v"(v[4]), "v"(v[5]));
  asm volatile("v_cvt_pk_bf16_f32 %0, %1, %2" : "=v"(w.w) : "v"(v[6]), "v"(v[7]));
  *(uint4*)dst = w;
#else
  for (int j = 0; j < 8; ++j) dst[j] = f2b(v[j]);
#endif
}
#ifndef CPU_SIM
DEV unsigned pk2bf(float lo, float hi) { unsigned r; asm volatile("v_cvt_pk_bf16_f32 %0, %1, %2" : "=v"(r) : "v"(lo), "v"(hi)); return r; }
#endif
DEV void load8bf(const bf* src, float* v) {
#ifndef CPU_SIM
  uint4 w = *(const uint4*)src;
  union { unsigned u; float f; } c;
  c.u = w.x << 16; v[0] = c.f; c.u = w.x & 0xFFFF0000u; v[1] = c.f;
  c.u = w.y << 16; v[2] = c.f; c.u = w.y & 0xFFFF0000u; v[3] = c.f;
  c.u = w.z << 16; v[4] = c.f; c.u = w.z & 0xFFFF0000u; v[5] = c.f;
  c.u = w.w << 16; v[6] = c.f; c.u = w.w & 0xFFFF0000u; v[7] = c.f;
#else
  for (int j = 0; j < 8; ++j) v[j] = b2f(src[j]);
#endif
}

DEV int win_src(int n) {
  if (n >= 3744) return -1;
  if (n >= C_KR && n < C_KR + 32) { int q = n - C_KR; int pi = q >> 1, wh = q & 1, half = pi >> 3, f = pi & 7; return C_KR + half * 16 + f + wh * 8; }
  if (n >= C_GQ && n < C_GKV + 128) { int q = n - C_GQ; int hh = q >> 6, d = q & 63; int pi = d >> 1, wh = d & 1, half = pi >> 4, f = pi & 15; return C_GQ + hh * 64 + half * 32 + f + wh * 16; }
  return n;
}
DEV int wuq_src(int n) {
  int hh = n / 96, d = n % 96;
  if (d < 64) return n;
  int q = d - 64; int pi = q >> 1, wh = q & 1, half = pi >> 3, f = pi & 7;
  return hh * 96 + 64 + half * 16 + f + wh * 8;
}

template <class PT> DEVN void ph_init(const PT& p, i64 gtid, i64 gsz, char* ilds = nullptr, int itid = 0) {
#ifndef CPU_SIM
  {
    float* sl = (float*)ilds;
    for (int q = itid; q < 3 * D; q += 512) { const int rr = q / D, k = q - rr * D; sl[q] = siluf_(rr < 2 ? p.in[I_c][rr * D + k] : p.in[I_c_ctx][k]); }
    __syncthreads();
    float* red3 = sl + 3 * D;
    const int wv_ = itid >> 6, ln_ = itid & 63;
    for (int task = blockIdx.x; task < 2 * 6 * D / 64; task += gridDim.x) {
      const int l = task / (6 * D / 64), j = (task % (6 * D / 64)) * 64 + ln_;
      const float* w = p.in[I_w_mod] + (size_t)l * D * 6 * D + j;
      float a0 = 0.f, a1 = 0.f, a2 = 0.f;
#pragma unroll 1
      for (int k0 = wv_ * 128; k0 < wv_ * 128 + 128; k0 += 16) {
        float wv[16];
#pragma unroll
        for (int q = 0; q < 16; ++q) wv[q] = w[(size_t)(k0 + q) * 6 * D];
#pragma unroll
        for (int q = 0; q < 16; ++q) { a0 += sl[k0 + q] * wv[q]; a1 += sl[D + k0 + q] * wv[q]; a2 += sl[2 * D + k0 + q] * wv[q]; }
      }
      __syncthreads();
      red3[(wv_ * 3 + 0) * 64 + ln_] = a0; red3[(wv_ * 3 + 1) * 64 + ln_] = a1; red3[(wv_ * 3 + 2) * 64 + ln_] = a2;
      __syncthreads();
      if (itid < 192) {
        const int v3 = itid >> 6, jj = itid & 63;
        float sum = p.in[I_b_mod][l * 6 * D + (task % (6 * D / 64)) * 64 + jj];
#pragma unroll
        for (int w8 = 0; w8 < 8; ++w8) sum += red3[(w8 * 3 + v3) * 64 + jj];
        p.mods()[((size_t)l * 3 + v3) * 6 * D + (task % (6 * D / 64)) * 64 + jj] = sum;
      }
    }
    __syncthreads();
  }
  {
    float* h1 = (float*)ilds;
    for (i64 i = gtid; i < (i64)2 * (N + LC); i += gsz) {
      const int l = (int)(i / (N + LC)), tt = (int)(i % (N + LC));
      int t, L; if (tt < N) { t = tt; L = N; } else { t = tt - N; L = LC; }
      const float tn = (float)t / (float)(L - 1);
      const float wt = 6.283185307179586f * (float)t / (float)L;
      const float* w1 = p.in[I_hy_w1] + l * 33 * 64; const float* b1 = p.in[I_hy_b1] + l * 64; const float* f1 = p.in[I_hy_f1] + l * 64;
      const float* w2 = p.in[I_hy_w2] + l * 64 * 64; const float* b2 = p.in[I_hy_b2] + l * 64; const float* f2 = p.in[I_hy_f2] + l * 64;
      { uint4* zp_ = (uint4*)(p.hdn2b() + ((size_t)l * (N + LC) + tt) * 256 + 64);
#pragma unroll
        for (int q = 0; q < 24; ++q) zp_[q] = uint4{0, 0, 0, 0}; }
      float zc[16], zs[16];
#pragma unroll
      for (int bd = 0; bd < 16; ++bd) { const float ang = (1e-4f + (float)bd * ((15.0f - 1e-4f) / 15.0f)) * wt; zc[bd] = cosf(ang); zs[bd] = sinf(ang); }
#pragma unroll 1
      for (int k1 = 0; k1 < 64; ++k1) {
        float a1 = b1[k1] + tn * w1[k1];
#pragma unroll
        for (int bd = 0; bd < 16; ++bd) a1 += zc[bd] * w1[(1 + bd) * 64 + k1] - zs[bd] * w1[(17 + bd) * 64 + k1];
        h1[k1 * 512 + itid] = sinf(f1[k1] * a1);
      }
#pragma unroll 1
      for (int j0 = 0; j0 < 64; j0 += 4) {
        float c0 = b2[j0], c1 = b2[j0 + 1], c2 = b2[j0 + 2], c3 = b2[j0 + 3];
#pragma unroll 8
        for (int k1 = 0; k1 < 64; ++k1) { const float hv = h1[k1 * 512 + itid]; const float4 wv = *(const float4*)(w2 + k1 * 64 + j0); c0 += hv * wv.x; c1 += hv * wv.y; c2 += hv * wv.z; c3 += hv * wv.w; }
        bf* ot = p.hdn2b() + ((size_t)l * (N + LC) + tt) * 256 + j0;
        ot[0] = f2b(sinf(f2[j0] * c0)); ot[1] = f2b(sinf(f2[j0 + 1] * c1)); ot[2] = f2b(sinf(f2[j0 + 2] * c2)); ot[3] = f2b(sinf(f2[j0 + 3] * c3));
      }
    }
  }
#else
  for (i64 i = gtid; i < 2 * 3 * 6 * D; i += gsz) {
    int l = (int)(i / (3 * 6 * D)); int rr = (int)((i / (6 * D)) % 3); int j = (int)(i % (6 * D));
    const float* cv = rr < 2 ? p.in[I_c] + rr * D : p.in[I_c_ctx];
    const float* w = p.in[I_w_mod] + (size_t)l * D * 6 * D;
    float acc = p.in[I_b_mod][l * 6 * D + j];
    for (int k = 0; k < D; ++k) acc += siluf_(cv[k]) * w[(size_t)k * 6 * D + j];
    p.mods()[i] = acc;
  }
  for (i64 i = gtid; i < (i64)2 * (N + LC) * 64; i += gsz) {
    int l = (int)(i / ((i64)(N + LC) * 64)); int tt = (int)((i / 64) % (N + LC)); int j2 = (int)(i % 64);
    int t, L; if (tt < N) { t = tt; L = N; } else { t = tt - N; L = LC; }
    float tn = (float)t / (float)(L - 1);
    float wt = 6.283185307179586f * (float)t / (float)L;
    const float* w1 = p.in[I_hy_w1] + l * 33 * 64; const float* b1 = p.in[I_hy_b1] + l * 64; const float* f1 = p.in[I_hy_f1] + l * 64;
    const float* w2 = p.in[I_hy_w2] + l * 64 * 64; const float* b2 = p.in[I_hy_b2] + l * 64; const float* f2 = p.in[I_hy_f2] + l * 64;
    float acc2 = b2[j2];
    for (int k1 = 0; k1 < 64; ++k1) {
      float a1 = b1[k1] + tn * w1[k1];
      for (int bd = 0; bd < 16; ++bd) {
        float band = 1e-4f + (float)bd * ((15.0f - 1e-4f) / 15.0f);
        float ang = band * wt;
        a1 += cosf(ang) * w1[(1 + bd) * 64 + k1] - sinf(ang) * w1[(17 + bd) * 64 + k1];
      }
      acc2 += sinf(f1[k1] * a1) * w2[k1 * 64 + j2];
    }
    p.hdn2()[i] = sinf(f2[j2] * acc2);
  }
#endif
#ifdef CPU_SIM
  for (i64 i = gtid; i < 2 * N; i += gsz) {
    double a = 6.283185307179586476925 * (double)i / (double)(2 * N);
    p.tw()[i * 2] = (float)cos(a); p.tw()[i * 2 + 1] = (float)-sin(a);
  }
#endif
  for (i64 i = gtid; i < 2 * 2 * 512; i += gsz) p.spl()[i] = softplusf_(-p.in[I_lru_lam][i]);
  for (i64 i = gtid; i < 128 * 8; i += gsz) {
    int pos = (int)(i / 8), f = (int)(i % 8);
    float ang = (float)pos * powf(10000.0f, -(float)f / 8.0f);
    p.tabA()[i * 2] = cosf(ang); p.tabA()[i * 2 + 1] = sinf(ang);
  }
  for (i64 i = gtid; i < 128 * 16; i += gsz) {
    int pos = (int)(i / 16), f = (int)(i % 16);
    float ang = (float)pos * powf(10000.0f, -(float)f / 16.0f);
    p.tabD()[i * 2] = cosf(ang); p.tabD()[i * 2 + 1] = sinf(ang);
  }
}

#ifndef CPU_SIM
template <class F> DEV void xpose_tiles(bf* dst, int K, int NN, const F& val, int tid, float* tl, int& xoff, int rank, int nranks) {
  const int tk = K / 64, tn = NN / 64;
  const int t0 = (rank + nranks - xoff % nranks) % nranks;
  xoff += tk * tn;
  for (int t = t0; t < tk * tn; t += nranks) {
    const int k0 = (t / tn) * 64, n0 = (t % tn) * 64;
    __syncthreads();
#pragma unroll
    for (int i = 0; i < 8; ++i) { const int kk = (tid >> 6) + 8 * i, nn = tid & 63; tl[nn * 65 + kk] = val(k0 + kk, n0 + nn); }
    __syncthreads();
#pragma unroll
    for (int i = 0; i < 8; ++i) { const int nn = (tid >> 6) + 8 * i, kk = tid & 63; dst[(size_t)(n0 + nn) * K + k0 + kk] = f2b(tl[nn * 65 + kk]); }
  }
}
#else
template <class F> static void xpose_tiles(bf* dst, int K, int NN, const F& val, i64 gtid, i64 gsz) {
  for (i64 i = gtid; i < (i64)K * NN; i += gsz) { int k = (int)(i / NN), n = (int)(i % NN); dst[(size_t)n * K + k] = f2b(val(k, n)); }
}
#endif
struct PrepCtx {
#ifndef CPU_SIM
  int tid; float* tl; int rank, nranks;
#else
  i64 gtid, gsz;
#endif
};
#ifndef CPU_SIM
#define XPOSE(dst, K, NN, val) xpose_tiles(dst, K, NN, val, pc.tid, pc.tl, xoff, pc.rank, pc.nranks)
#else
#define XPOSE(dst, K, NN, val) xpose_tiles(dst, K, NN, val, pc.gtid, pc.gsz)
#endif
DEVN void ph_prep(const Params& p, int l, const PrepCtx& pc, i64 gtid, i64 gsz, const int parts) {
  int xoff = 0; (void)xoff;
  if (parts & 1) {
    const float* w = p.in[I_w_in] + (size_t)l * D * INC;
    XPOSE(p.W_in(), 1024, 3840, [=](int k, int n) { int s_ = win_src(n); return s_ < 0 ? 0.f : w[(size_t)k * INC + s_]; });
    XPOSE(p.W_g(), 1024, 4096, [=](int k, int n) { return w[(size_t)k * INC + C_GT + n]; });
  }
  if (parts & 1) {
    const float* w = p.in[I_mla_w_uq] + (size_t)l * 256 * 768; const float* g = p.in[I_mla_g_cq] + l * 256;
    XPOSE(p.W_uq(), 256, 768, [=](int k, int n) { return g[k] * w[(size_t)k * 768 + wuq_src(n)]; });
  }
  if (parts & 1) {
    const float* w = p.in[I_mla_w_ukv] + (size_t)l * 128 * 1024; const float* g = p.in[I_mla_g_ckv] + l * 128;
    XPOSE(p.W_ukv(), 256, 1024, [=](int k, int n) { return k < 128 ? g[k] * w[(size_t)k * 1024 + n] : 0.f; });
  }
  if (parts & 2) {
    const float* w = p.in[I_w_branch] + (size_t)l * 4 * 512 * D;
    for (int br = 0; br < 4; ++br) { const float* wb = w + (size_t)br * 512 * D; XPOSE(p.W_br() + (size_t)br * 1024 * 512, 512, 1024, [=](int k, int n) { return wb[(size_t)k * D + n]; }); }
  }
  if (parts & 2) {
    const float* w = p.in[I_w_out] + (size_t)l * D * D;
    XPOSE(p.W_out(), 1024, 1024, [=](int k, int n) { return w[(size_t)k * D + n]; });
  }
  if (parts & 4) {
    const float* wq = p.in[I_peer_w_q] + (size_t)l * D * 1024;
    XPOSE(p.W_q(), 1024, 1024, [=](int k, int n) { return wq[(size_t)k * 1024 + n]; });
  }
#ifndef CPU_SIM
  if (parts & 1) {
    const float* w3 = p.in[I_hy_w3] + (size_t)l * 64 * 1024;
    XPOSE(p.W3T(), 256, 1024, [=](int k, int n) { return k < 64 ? w3[(size_t)k * 1024 + n] : 0.f; });
  }
#endif
  if (parts & 1) {
    for (i64 i = gtid; i < 2048 * 256; i += gsz) {
      int n = (int)(i / 256), k = (int)(i % 256);
      int kw = n >> 10, dir = (n >> 9) & 1, blk4 = (n >> 7) & 3, jc = (n & 127) >> 1, gate = n & 1;
      float v = 0.f;
      if ((k >> 6) == blk4) {
        const float* wsrc = p.in[gate ? I_lru_w_i : I_lru_w_r] + ((((size_t)l * 2 + dir) * 8 + kw * 4 + blk4) * 64 + (k & 63)) * 64 + jc;
        v = *wsrc;
      }
      p.W_lru()[i] = f2b(v);
    }
  }
  if (parts & 8) {
    const float* keys = p.in[I_peer_keys] + (size_t)l * 16 * 128 * 64;
    for (i64 i = gtid; i < 2048 * 256; i += gsz) {
      int n = (int)(i / 256), k = (int)(i % 256);
      int hp = n >> 7, key = n & 127;
      float v = ((k >> 6) == (hp & 3)) ? keys[((size_t)hp * 128 + key) * 64 + (k & 63)] : 0.f;
      p.W_key()[i] = f2b(v);
    }
  }
}

DEVN void ph_norm(const Params& p, int l, int which, int nrows, i64 gtid, i64 gsz) {
  const float* g = p.in[which ? I_g_ffn : I_g_mix] + l * D;
#ifndef CPU_SIM
  const int lane = (int)(gtid & 63);
  const i64 W = gsz >> 6;
  float4 gv[4];
#pragma unroll
  for (int i = 0; i < 4; ++i) gv[i] = *(const float4*)(g + (lane + i * 64) * 4);
  for (i64 r = gtid >> 6; r < nrows; r += 2 * W) {
    const bool two = r + W < nrows;
    const i64 rb = two ? r + W : r;
    const float4* xra = (const float4*)((l == 0 && which == 0) ? xin_row(p, (int)r) : p.xcur() + (size_t)r * D);
    const float4* xrb = (const float4*)((l == 0 && which == 0) ? xin_row(p, (int)rb) : p.xcur() + (size_t)rb * D);
    const float* mda = p.mods() + ((size_t)l * 3 + modrow((int)r)) * 6 * D + (which ? 3 * D : 0);
    const float* mdb = p.mods() + ((size_t)l * 3 + modrow((int)rb)) * 6 * D + (which ? 3 * D : 0);
    float4 xa[4], xb[4], sha[4], sca[4], shb[4], scb[4]; float sa = 0.f, sb = 0.f;
#pragma unroll
    for (int i = 0; i < 4; ++i) { xa[i] = xra[lane + i * 64]; xb[i] = xrb[lane + i * 64]; }
#pragma unroll
    for (int i = 0; i < 4; ++i) { const int k = (lane + i * 64) * 4; sha[i] = *(const float4*)(mda + k); sca[i] = *(const float4*)(mda + D + k); shb[i] = *(const float4*)(mdb + k); scb[i] = *(const float4*)(mdb + D + k); }
#pragma unroll
    for (int i = 0; i < 4; ++i) { sa += xa[i].x * xa[i].x + xa[i].y * xa[i].y + xa[i].z * xa[i].z + xa[i].w * xa[i].w; sb += xb[i].x * xb[i].x + xb[i].y * xb[i].y + xb[i].z * xb[i].z + xb[i].w * xb[i].w; }
#pragma unroll
    for (int o = 32; o >= 1; o >>= 1) { sa += lane_xor(sa, lane, o); sb += lane_xor(sb, lane, o); }
    const float rsa = 1.0f / sqrtf(sa * (1.0f / D) + EPS), rsb = 1.0f / sqrtf(sb * (1.0f / D) + EPS);
#pragma unroll
    for (int i = 0; i < 4; ++i) {
      const int k = (lane + i * 64) * 4;
      uint2 w;
      w.x = pk2bf(xa[i].x * rsa * gv[i].x * (1.0f + sca[i].x) + sha[i].x, xa[i].y * rsa * gv[i].y * (1.0f + sca[i].y) + sha[i].y);
      w.y = pk2bf(xa[i].z * rsa * gv[i].z * (1.0f + sca[i].z) + sha[i].z, xa[i].w * rsa * gv[i].w * (1.0f + sca[i].w) + sha[i].w);
      *(uint2*)(p.h() + (size_t)r * D + k) = w;
    }
    if (two) {
#pragma unroll
      for (int i = 0; i < 4; ++i) {
        const int k = (lane + i * 64) * 4;
        uint2 w;
        w.x = pk2bf(xb[i].x * rsb * gv[i].x * (1.0f + scb[i].x) + shb[i].x, xb[i].y * rsb * gv[i].y * (1.0f + scb[i].y) + shb[i].y);
        w.y = pk2bf(xb[i].z * rsb * gv[i].z * (1.0f + scb[i].z) + shb[i].z, xb[i].w * rsb * gv[i].w * (1.0f + scb[i].w) + shb[i].w);
        *(uint2*)(p.h() + (size_t)rb * D + k) = w;
      }
    }
  }
#else
  for (i64 r = gtid; r < nrows; r += gsz) {
    const float* xr = (l == 0 && which == 0) ? xin_row(p, (int)r) : p.xcur() + (size_t)r * D;
    float ss = 0.f;
    for (int k = 0; k < D; ++k) ss += xr[k] * xr[k];
    float rstd = 1.0f / sqrtf(ss / D + EPS);
    const float* md = p.mods() + ((size_t)l * 3 + modrow((int)r)) * 6 * D + (which ? 3 * D : 0);
    for (int k = 0; k < D; ++k) p.h()[(size_t)r * D + k] = f2b(xr[k] * rstd * g[k] * (1.0f + md[D + k]) + md[k]);
  }
#endif
}

DEVN void ph_B0(const Params& p, int l, i64 gtid, i64 gsz, char* b0lds = nullptr, int b0tid = 0) {
#ifndef CPU_SIM
  {
    const int lane = (int)(gtid & 63);
    const i64 W = gsz >> 6;
    for (i64 r = gtid >> 6; r < TT; r += 4 * W) {
      uint2 a[4]; unsigned b[4]; i64 rr[4];
#pragma unroll
      for (int j = 0; j < 4; ++j) { rr[j] = r + j * W < TT ? r + j * W : r; const bf* pr = p.P() + (size_t)rr[j] * PC; a[j] = *(const uint2*)(pr + C_CQ + lane * 4); b[j] = *(const unsigned*)(pr + C_CKV + lane * 2); }
      float sq[4], sk[4];
#pragma unroll
      for (int j = 0; j < 4; ++j) {
        const float f0 = __uint_as_float(a[j].x << 16), f1 = __uint_as_float(a[j].x & 0xFFFF0000u), f2 = __uint_as_float(a[j].y << 16), f3 = __uint_as_float(a[j].y & 0xFFFF0000u);
        const float g0 = __uint_as_float(b[j] << 16), g1 = __uint_as_float(b[j] & 0xFFFF0000u);
        sq[j] = 0.f; sq[j] += f0 * f0; sq[j] += f1 * f1; sq[j] += f2 * f2; sq[j] += f3 * f3;
        sk[j] = 0.f; sk[j] += g0 * g0; sk[j] += g1 * g1;
      }
#pragma unroll
      for (int o = 32; o >= 1; o >>= 1) {
#pragma unroll
        for (int j = 0; j < 4; ++j) { sq[j] += lane_xor(sq[j], lane, o); sk[j] += lane_xor(sk[j], lane, o); }
      }
#pragma unroll
      for (int j = 0; j < 4; ++j) if (lane == 0 && r + j * W < TT) { p.ssq()[rr[j]] = sq[j]; p.ssq()[TT + rr[j]] = sk[j]; }
    }
  }
#else
  for (i64 r = gtid; r < TT; r += gsz) {
    const bf* pr = p.P() + (size_t)r * PC;
    float sq = 0.f, sk = 0.f;
    for (int k = 0; k < 256; ++k) { float v = b2f(pr[C_CQ + k]); sq += v * v; }
    for (int k = 0; k < 128; ++k) { float v = b2f(pr[C_CKV + k]); sk += v * v; }
    p.ssq()[r] = sq; p.ssq()[TT + r] = sk;
  }
#endif
#ifndef CPU_SIM
  {
    const float* cw = p.in[I_lru_conv_w] + l * 4 * 512; const float* cb = p.in[I_lru_conv_b] + l * 512;
    for (i64 i = gtid; i < (i64)TT * 64; i += gsz) {
      const int r = (int)(i >> 6), c8 = (int)(i & 63) * 8;
      const RowInfo ri = rowinfo(r);
      float acc[8];
      { const float4 b0 = *(const float4*)(cb + c8), b1 = *(const float4*)(cb + c8 + 4); acc[0] = b0.x; acc[1] = b0.y; acc[2] = b0.z; acc[3] = b0.w; acc[4] = b1.x; acc[5] = b1.y; acc[6] = b1.z; acc[7] = b1.w; }
      uint4 xv[4]; bool ok[4];
#pragma unroll
      for (int k = 0; k < 4; ++k) { const int ts = ri.t - 1 + k; ok[k] = ts >= 0 && ts < ri.L; xv[k] = ok[k] ? *(const uint4*)(p.P() + (size_t)(ri.base + ts) * PC + C_LX + c8) : uint4{0, 0, 0, 0}; }
#pragma unroll
      for (int k = 0; k < 4; ++k) {
        float f[8]; unpack8(xv[k], f);
        const float4 w0 = *(const float4*)(cw + k * 512 + c8), w1 = *(const float4*)(cw + k * 512 + c8 + 4);
        acc[0] += w0.x * f[0]; acc[1] += w0.y * f[1]; acc[2] += w0.z * f[2]; acc[3] += w0.w * f[3];
        acc[4] += w1.x * f[4]; acc[5] += w1.y * f[5]; acc[6] += w1.z * f[6]; acc[7] += w1.w * f[7];
      }
      store8bf(p.XC() + (size_t)r * 512 + c8, acc);
    }
  }
  {
    const float* cw = p.in[I_hy_conv_w] + l * 3 * 1536; const float* cb = p.in[I_hy_conv_b] + l * 1536;
    for (i64 i = (i64)NLAT * 64 + gtid; i < (i64)TT * 64; i += gsz) {
      const int r = (int)(i >> 6), c8 = (int)(i & 63) * 8;
      const RowInfo ri = rowinfo(r);
      float a1[8], a2[8];
#pragma unroll
      for (int j = 0; j < 8; ++j) { a1[j] = cb[512 + c8 + j]; a2[j] = cb[1024 + c8 + j]; }
#pragma unroll
      for (int k = 0; k < 3; ++k) {
        const int ts = ri.t - 1 + k; if (ts < 0 || ts >= ri.L) continue;
        const bf* pr = p.P() + (size_t)(ri.base + ts) * PC + C_HU;
        float f[8], g[8]; unpack8(*(const uint4*)(pr + 512 + c8), f); unpack8(*(const uint4*)(pr + 1024 + c8), g);
#pragma unroll
        for (int j = 0; j < 8; ++j) { a1[j] += cw[k * 1536 + 512 + c8 + j] * f[j]; a2[j] += cw[k * 1536 + 1024 + c8 + j] * g[j]; }
      }
#pragma unroll
      for (int j = 0; j < 8; ++j) a1[j] *= a2[j];
      store8bf(p.Z() + (size_t)r * 512 + c8, a1);
    }
  }
  {
    const float* cw = p.in[I_hy_conv_w] + l * 3 * 1536; const float* cb = p.in[I_hy_conv_b] + l * 1536;
    unsigned short* tz_ = (unsigned short*)b0lds; unsigned short* tx_ = tz_ + 64 * 72;
    for (int tile = blockIdx.x; tile < (NLAT / 64) * 8; tile += gridDim.x) {
      const int rt = tile >> 3, c0 = (tile & 7) * 64;
      const int tr = b0tid >> 3, cg8 = (b0tid & 7) * 8;
      const int r = rt * 64 + tr, t = r % N;
      float a0[8], a1[8], a2[8];
#pragma unroll
      for (int j = 0; j < 8; ++j) { a0[j] = cb[c0 + cg8 + j]; a1[j] = cb[512 + c0 + cg8 + j]; a2[j] = cb[1024 + c0 + cg8 + j]; }
      uint4 v0[3], v1[3], v2[3]; bool ok[3];
#pragma unroll
      for (int k = 0; k < 3; ++k) {
        const int ts = t - 1 + k; ok[k] = ts >= 0 && ts < N;
        const bf* pr = p.P() + (size_t)(r - 1 + (ok[k] ? k : 1)) * PC + C_HU + c0 + cg8;
        v0[k] = *(const uint4*)pr; v1[k] = *(const uint4*)(pr + 512); v2[k] = *(const uint4*)(pr + 1024);
      }
#pragma unroll
      for (int k = 0; k < 3; ++k) {
        if (!ok[k]) continue;
        float f0[8], f1[8], f2_[8]; unpack8(v0[k], f0); unpack8(v1[k], f1); unpack8(v2[k], f2_);
        const float* w = cw + k * 1536 + c0 + cg8;
#pragma unroll
        for (int j = 0; j < 8; ++j) { a0[j] += w[j] * f0[j]; a1[j] += w[512 + j] * f1[j]; a2[j] += w[1024 + j] * f2_[j]; }
      }
      __syncthreads();
#pragma unroll
      for (int j = 0; j < 8; ++j) { tz_[(cg8 + j) * 72 + tr] = f2b(a1[j] * a2[j]).v; tx_[(cg8 + j) * 72 + tr] = f2b(a0[j]).v; }
      __syncthreads();
      { const int cc = b0tid >> 3, tg = (b0tid & 7) * 8;
        const int bq = (rt * 64) / N, tq = (rt * 64) % N + tg;
        const size_t o = ((size_t)(c0 + cc) * NB + bq) * N + tq;
        *(uint4*)((unsigned short*)p.Z() + o) = *(const uint4*)(tz_ + cc * 72 + tg);
        *(uint4*)((unsigned short*)p.XYT() + o) = *(const uint4*)(tx_ + cc * 72 + tg); }
    }
  }
#else
  {
    const float* cw = p.in[I_lru_conv_w] + l * 4 * 512; const float* cb = p.in[I_lru_conv_b] + l * 512;
    for (i64 i = gtid; i < (i64)TT * 512; i += gsz) {
      int r = (int)(i / 512), c = (int)(i % 512);
      RowInfo ri = rowinfo(r);
      float acc = cb[c];
      for (int k = 0; k < 4; ++k) {
        int ts = ri.t - 1 + k;
        if (ts >= 0 && ts < ri.L) acc += cw[k * 512 + c] * b2f(p.P()[(size_t)(ri.base + ts) * PC + C_LX + c]);
      }
      p.XC()[i] = f2b(acc);
    }
  }
  {
    const float* cw = p.in[I_hy_conv_w] + l * 3 * 1536; const float* cb = p.in[I_hy_conv_b] + l * 1536;
    for (i64 i = gtid; i < (i64)TT * 512; i += gsz) {
      int r = (int)(i / 512), c = (int)(i % 512);
      RowInfo ri = rowinfo(r);
      float a1 = cb[512 + c], a2 = cb[1024 + c];
      for (int k = 0; k < 3; ++k) {
        int ts = ri.t - 1 + k;
        if (ts >= 0 && ts < ri.L) {
          const bf* pr = p.P() + (size_t)(ri.base + ts) * PC + C_HU;
          a1 += cw[k * 1536 + 512 + c] * b2f(pr[512 + c]);
          a2 += cw[k * 1536 + 1024 + c] * b2f(pr[1024 + c]);
        }
      }
      p.Z()[i] = f2b(a1 * a2);
    }
  }
  {
    const float* w3 = p.in[I_hy_w3] + (size_t)l * 64 * 1024;
    const float maxd = logf(1e-2f) / 0.3f, mind = logf(1e-2f) / 1.5f;
    for (i64 i = gtid; i < (i64)(N + LC) * 1024; i += gsz) {
      int tt = (int)(i / 1024), j = (int)(i % 1024);
      int t, L; if (tt < N) { t = tt; L = N; } else { t = tt - N; L = LC; }
      const float* hd = p.hdn2() + ((size_t)l * (N + LC) + tt) * 64;
      float acc = 0.f;
      for (int k = 0; k < 64; ++k) acc += hd[k] * w3[k * 1024 + j];
      float tn = (float)t / (float)(L - 1);
      float delta = mind + (float)j * ((maxd - mind) / 1023.0f);
      p.F()[i] = acc * expf(-tn * fabsf(delta));
    }
  }
#endif
}

DEVN void ph_fnorm(const Params& p, i64 gtid, i64 gsz) {
#ifndef CPU_SIM
  for (i64 i = 512 + gtid; i < 2 * 512; i += gsz) {
#else
  for (i64 i = gtid; i < 2 * 512; i += gsz) {
#endif
    int which = (int)(i / 512), c = (int)(i % 512);
    int L = which ? LC : N; int off = which ? N : 0;
    float ss = 0.f;
    for (int t = 0; t < L; ++t) { float a = p.F()[(size_t)(off + t) * 1024 + c], b = p.F()[(size_t)(off + t) * 1024 + 512 + c]; ss += a * a + b * b; }
    p.fnorm()[i] = 1.0f / sqrtf(ss + EPS);
  }
}


DEV void lru_chunk_rows(int dir, int b, int k, int& row0, int& step) {
  int seg_chunk;
  if (k < NCC) { seg_chunk = dir ? NCC - 1 - k : k; row0 = NLAT + b * LC + seg_chunk * LCH; }
  else { int kl = k - NCC; seg_chunk = dir ? NCL - 1 - kl : kl; row0 = b * N + seg_chunk * LCH; }
  if (dir) { row0 += LCH - 1; step = -1; } else step = 1;
}
DEVN void ph_lru1(const Params& p, i64 gtid, i64 gsz) {
#ifndef CPU_SIM
  for (i64 i = gtid; i < (i64)2 * NB * NCHK * 128; i += gsz) {
    const int c = (int)(i % 128) * 4, k = (int)((i / 128) % NCHK), b = (int)((i / (128 * NCHK)) % NB), dir = (int)(i / ((i64)128 * NCHK * NB));
    int row0, step; lru_chunk_rows(dir, b, k, row0, step);
    const uint4* lab4 = (const uint4*)(p.LAB() + (size_t)dir * TT * 512 + c);
    float h0 = 0.f, h1 = 0.f, h2 = 0.f, h3 = 0.f, s0 = 0.f, s1 = 0.f, s2 = 0.f, s3 = 0.f;
    uint4 wn[8];
#pragma unroll
    for (int t = 0; t < 8; ++t) wn[t] = lab4[(size_t)(row0 + step * t) * 128];
#pragma unroll 1
    for (int t0 = 0; t0 < LCH; t0 += 8) {
      uint4 w[8];
#pragma unroll
      for (int t = 0; t < 8; ++t) w[t] = wn[t];
      if (t0 + 8 < LCH) {
#pragma unroll
        for (int t = 0; t < 8; ++t) wn[t] = lab4[(size_t)(row0 + step * (t0 + 8 + t)) * 128];
      }
#pragma unroll
      for (int t = 0; t < 8; ++t) {
        const float a0 = __uint_as_float(w[t].x << 16), a1 = __uint_as_float(w[t].y << 16), a2 = __uint_as_float(w[t].z << 16), a3 = __uint_as_float(w[t].w << 16);
        s0 += a0; s1 += a1; s2 += a2; s3 += a3;
        h0 = fexpf_(a0) * h0 + __uint_as_float(w[t].x & 0xFFFF0000u); h1 = fexpf_(a1) * h1 + __uint_as_float(w[t].y & 0xFFFF0000u);
        h2 = fexpf_(a2) * h2 + __uint_as_float(w[t].z & 0xFFFF0000u); h3 = fexpf_(a3) * h3 + __uint_as_float(w[t].w & 0xFFFF0000u);
      }
    }
    const size_t o = ((size_t)(dir * NB + b) * NCHK + k) * 512 + c;
    *(float4*)(p.SA() + o) = float4{fexpf_(s0), fexpf_(s1), fexpf_(s2), fexpf_(s3)};
    *(float4*)(p.SB() + o) = float4{h0, h1, h2, h3};
  }
#else
  for (i64 i = gtid; i < (i64)2 * NB * NCHK * 512; i += gsz) {
    int c = (int)(i % 512), k = (int)((i / 512) % NCHK), b = (int)((i / (512 * NCHK)) % NB), dir = (int)(i / ((i64)512 * NCHK * NB));
    int row0, step; lru_chunk_rows(dir, b, k, row0, step);
    const bf* la = p.LA() + (size_t)dir * TT * 512 + c; const bf* lb = p.LB() + (size_t)dir * TT * 512 + c;
    float h = 0.f, sl = 0.f;
    for (int t = 0; t < LCH; ++t) {
      size_t r = (size_t)(row0 + step * t);
      float lav = b2f(la[r * 512]);
      h = expf(lav) * h + b2f(lb[r * 512]); sl += lav;
    }
    p.SA()[i] = fexpf_(sl); p.SB()[i] = h;
  }
#endif
}
DEVN void ph_lru3(const Params& p, int last, i64 gtid, i64 gsz, float* hrs, int ltid) {
#ifndef CPU_SIM
  unsigned* hrp = (unsigned*)hrs;
  for (i64 i = gtid; i < (i64)NB * NCHK * 256; i += gsz) {
    const int c = (int)(i % 256) * 2, j = (int)((i / 256) % NCHK), b = (int)(i / (256 * NCHK));
    if (last && j < NCC) continue;
    const int kf = j, kr = j < NCC ? NCC - 1 - j : NCC + (NCL - 1 - (j - NCC));
    const float* sa0 = p.SA() + ((size_t)(0 * NB + b) * NCHK) * 512 + c; const float* sb0 = p.SB() + ((size_t)(0 * NB + b) * NCHK) * 512 + c;
    const float* sa1 = p.SA() + ((size_t)(1 * NB + b) * NCHK) * 512 + c; const float* sb1 = p.SB() + ((size_t)(1 * NB + b) * NCHK) * 512 + c;
    float hf0 = 0.f, hf1 = 0.f, hr0 = 0.f, hr1 = 0.f;
    const int row0 = j < NCC ? NLAT + b * LC + j * LCH : b * N + (j - NCC) * LCH;
    const unsigned* lab0 = p.LAB() + c; const unsigned* lab1 = p.LAB() + (size_t)TT * 512 + c;
    uint2 wr[16], wf[16]; unsigned gf[16];
#pragma unroll
    for (int t = 0; t < 16; ++t) { wr[t] = *(const uint2*)(lab1 + (size_t)(row0 + LCH - 16 + t) * 512); wf[t] = uint2{0u, 0u}; gf[t] = 0u; }
#pragma unroll 1
    for (int k0 = 0; k0 < kf; k0 += 8) {
      float2 av[8], bv[8];
#pragma unroll
      for (int q = 0; q < 8; ++q) { const bool ok = k0 + q < kf; av[q] = ok ? *(const float2*)(sa0 + (size_t)(k0 + q) * 512) : float2{1.f, 1.f}; bv[q] = ok ? *(const float2*)(sb0 + (size_t)(k0 + q) * 512) : float2{0.f, 0.f}; }
#pragma unroll
      for (int q = 0; q < 8; ++q) { hf0 = av[q].x * hf0 + bv[q].x; hf1 = av[q].y * hf1 + bv[q].y; }
    }
#pragma unroll 1
    for (int k0 = 0; k0 < kr; k0 += 8) {
      float2 av[8], bv[8];
#pragma unroll
      for (int q = 0; q < 8; ++q) { const bool ok = k0 + q < kr; av[q] = ok ? *(const float2*)(sa1 + (size_t)(k0 + q) * 512) : float2{1.f, 1.f}; bv[q] = ok ? *(const float2*)(sb1 + (size_t)(k0 + q) * 512) : float2{0.f, 0.f}; }
#pragma unroll
      for (int q = 0; q < 8; ++q) { hr0 = av[q].x * hr0 + bv[q].x; hr1 = av[q].y * hr1 + bv[q].y; }
    }
#pragma unroll 1
    for (int t0 = LCH - 16; t0 >= 0; t0 -= 16) {
      uint2 w[16];
#pragma unroll
      for (int t = 0; t < 16; ++t) w[t] = wr[t];
      if (t0 >= 16) {
#pragma unroll
        for (int t = 0; t < 16; ++t) wr[t] = *(const uint2*)(lab1 + (size_t)(row0 + t0 - 16 + t) * 512);
      } else {
#pragma unroll
        for (int t = 0; t < 16; ++t) { const size_t r = (size_t)(row0 + t); wf[t] = *(const uint2*)(lab0 + r * 512); gf[t] = *(const unsigned*)(p.P() + r * PC + C_LG + c); }
      }
#pragma unroll
      for (int t = 15; t >= 0; --t) {
        hr0 = fexpf_(__uint_as_float(w[t].x << 16)) * hr0 + __uint_as_float(w[t].x & 0xFFFF0000u);
        hr1 = fexpf_(__uint_as_float(w[t].y << 16)) * hr1 + __uint_as_float(w[t].y & 0xFFFF0000u);
        hrp[(t0 + t) * 512 + ltid] = pk2bf(hr0, hr1);
      }
    }
#pragma unroll 1
    for (int t0 = 0; t0 < LCH; t0 += 16) {
      uint2 w[16]; unsigned gw[16];
#pragma unroll
      for (int t = 0; t < 16; ++t) { w[t] = wf[t]; gw[t] = gf[t]; }
      if (t0 + 16 < LCH) {
#pragma unroll
        for (int t = 0; t < 16; ++t) { const size_t r = (size_t)(row0 + t0 + 16 + t); wf[t] = *(const uint2*)(lab0 + r * 512); gf[t] = *(const unsigned*)(p.P() + r * PC + C_LG + c); }
      }
#pragma unroll
      for (int t = 0; t < 16; ++t) {
        hf0 = fexpf_(__uint_as_float(w[t].x << 16)) * hf0 + __uint_as_float(w[t].x & 0xFFFF0000u);
        hf1 = fexpf_(__uint_as_float(w[t].y << 16)) * hf1 + __uint_as_float(w[t].y & 0xFFFF0000u);
        const unsigned hw = hrp[(t0 + t) * 512 + ltid];
        const float y0 = geluf_(__uint_as_float(gw[t] << 16)) * (hf0 + __uint_as_float(hw << 16));
        const float y1 = geluf_(__uint_as_float(gw[t] & 0xFFFF0000u)) * (hf1 + __uint_as_float(hw & 0xFFFF0000u));
        *(unsigned*)(p.Y() + (size_t)(row0 + t0 + t) * 2048 + 512 + c) = pk2bf(y0, y1);
      }
    }
  }
#else
  for (i64 i = gtid; i < (i64)NB * NCHK * 512; i += gsz) {
    int c = (int)(i % 512), j = (int)((i / 512) % NCHK), b = (int)(i / (512 * NCHK));
    if (last && j < NCC) continue;
    int kf = j, kr = j < NCC ? NCC - 1 - j : NCC + (NCL - 1 - (j - NCC));
    const float* sa0 = p.SA() + ((size_t)(0 * NB + b) * NCHK) * 512 + c; const float* sb0 = p.SB() + ((size_t)(0 * NB + b) * NCHK) * 512 + c;
    const float* sa1 = p.SA() + ((size_t)(1 * NB + b) * NCHK) * 512 + c; const float* sb1 = p.SB() + ((size_t)(1 * NB + b) * NCHK) * 512 + c;
    float hf = 0.f, hr = 0.f;
    int row0 = j < NCC ? NLAT + b * LC + j * LCH : b * N + (j - NCC) * LCH;
    const bf* la0 = p.LA() + c; const bf* lb0 = p.LB() + c;
    const bf* la1 = p.LA() + (size_t)TT * 512 + c; bf* lb1 = p.LB() + (size_t)TT * 512 + c;
    for (int k = 0; k < kf; ++k) hf = sa0[(size_t)k * 512] * hf + sb0[(size_t)k * 512];
    for (int k = 0; k < kr; ++k) hr = sa1[(size_t)k * 512] * hr + sb1[(size_t)k * 512];
    for (int t = LCH - 1; t >= 0; --t) { size_t r = (size_t)(row0 + t); hr = expf(b2f(la1[r * 512])) * hr + b2f(lb1[r * 512]); lb1[r * 512] = f2b(hr); }
    for (int t = 0; t < LCH; ++t) {
      size_t r = (size_t)(row0 + t);
      hf = expf(b2f(la0[r * 512])) * hf + b2f(lb0[r * 512]);
      float lg = b2f(p.P()[r * PC + C_LG + c]);
      p.Y()[r * 2048 + 512 + c] = f2b(geluf_(lg) * (hf + b2f(lb1[r * 512])));
    }
  }
#endif
}

DEVN void ph_C(const Params& p, int l, int last, i64 gtid, i64 gsz) {
  const int QR = last ? NLAT : TT;
#ifdef CPU_SIM
  for (i64 i = gtid; i < (i64)8 * QR; i += gsz) {
    int hh = (int)(i / QR), r = (int)(i % QR);
    RowInfo ri = rowinfo(r);
    float q[96];
#pragma unroll
    for (int d = 0; d < 96; ++d) q[d] = b2f(p.QA()[(size_t)r * 768 + hh * 96 + d]);
    float o[64];
#pragma unroll
    for (int d = 0; d < 64; ++d) o[d] = 0.f;
    float m = -1e30f, lsum = 0.f;
    const float scale = 0.10206207261596577f;
    int nseg = ri.lat ? 2 : 1;
    for (int sg = 0; sg < nseg; ++sg) {
      int kb, kn_;
      if (ri.lat && sg == 0) { kb = ri.b * N; kn_ = N; } else { kb = NLAT + ri.b * LC; kn_ = LC; }
      for (int kk = 0; kk < kn_; ++kk) {
        const bf* kr_ = p.KVA() + (size_t)(kb + kk) * 1024 + hh * 128;
        const bf* krp = p.P() + (size_t)(kb + kk) * PC + C_KR;
        float s = 0.f;
#pragma unroll
        for (int d = 0; d < 64; ++d) s += q[d] * b2f(kr_[d]);
#pragma unroll
        for (int d = 0; d < 32; ++d) s += q[64 + d] * b2f(krp[d]);
        s *= scale;
        float mn = fmaxf(m, s);
        float corr = expf(m - mn), pe = expf(s - mn);
        lsum = lsum * corr + pe;
#pragma unroll
        for (int d = 0; d < 64; ++d) o[d] = o[d] * corr + pe * b2f(kr_[64 + d]);
        m = mn;
      }
    }
    float inv = 1.0f / lsum;
#pragma unroll
    for (int d = 0; d < 64; ++d) p.Y()[(size_t)r * 2048 + hh * 64 + d] = f2b(o[d] * inv);
  }
#endif
  {
    const float* cw = p.in[I_hy_conv_w] + l * 3 * 1536; const float* cb = p.in[I_hy_conv_b] + l * 1536;
    const float* skip = p.in[I_hy_skip] + l * 512;
#ifndef CPU_SIM
    const i64 hy_first = (i64)NLAT * 512;
#else
    const i64 hy_first = 0;
#endif
    for (i64 i = hy_first + gtid; i < (i64)QR * 512; i += gsz) {
      int r = (int)(i / 512), c = (int)(i % 512);
      RowInfo ri = rowinfo(r);
      int foff = ri.lat ? 0 : N;
      float acc = 0.f;
      for (int s = 0; s < ri.L; ++s) {
        int dd = ri.t - s;
        float fv = dd >= 0 ? p.F()[(size_t)(foff + dd) * 1024 + c] : p.F()[(size_t)(foff - dd) * 1024 + 512 + c];
        acc += fv * b2f(p.Z()[(size_t)(ri.base + s) * 512 + c]);
      }
      acc *= p.fnorm()[(ri.lat ? 0 : 512) + c];
      float x0 = cb[c];
      for (int k = 0; k < 3; ++k) {
        int ts = ri.t - 1 + k;
        if (ts >= 0 && ts < ri.L) x0 += cw[k * 1536 + c] * b2f(p.P()[(size_t)(ri.base + ts) * PC + C_HU + c]);
      }
      float y = acc + skip[c] * b2f(p.Z()[(size_t)r * 512 + c]);
      p.Y()[(size_t)r * 2048 + 1024 + c] = f2b(x0 * y);
    }
  }
#ifdef CPU_SIM
  for (i64 i = gtid; i < (i64)8 * QR; i += gsz) {
    int hh = (int)(i / QR), r = (int)(i % QR);
    RowInfo ri = rowinfo(r);
    int kh = hh / 4;
    float q[64];
#pragma unroll
    for (int d = 0; d < 64; ++d) q[d] = b2f(p.P()[(size_t)r * PC + C_GQ + hh * 64 + d]);
    float o[64];
#pragma unroll
    for (int d = 0; d < 64; ++d) o[d] = 0.f;
    float m = p.in[I_gqa_sink][l * 8 + hh], lsum = 1.0f;
    int nseg = ri.lat ? 2 : 1;
    for (int sg = 0; sg < nseg; ++sg) {
      int k0, k1;
      if (ri.lat && sg == 0) { int lo = ri.t - 128; if (lo < 0) lo = 0; int hi = ri.t + 128; if (hi > N - 1) hi = N - 1; k0 = ri.b * N + lo; k1 = ri.b * N + hi + 1; }
      else { k0 = NLAT + ri.b * LC; k1 = k0 + LC; }
      for (int kk = k0; kk < k1; ++kk) {
        const bf* kp = p.P() + (size_t)kk * PC + C_GKV + kh * 64;
        const bf* vp = kp + 128;
        float s = 0.f;
#pragma unroll
        for (int d = 0; d < 64; ++d) s += q[d] * b2f(kp[d]);
        s *= 0.125f;
        float mn = fmaxf(m, s);
        float corr = expf(m - mn), pe = expf(s - mn);
        lsum = lsum * corr + pe;
#pragma unroll
        for (int d = 0; d < 64; ++d) o[d] = o[d] * corr + pe * b2f(vp[d]);
        m = mn;
      }
    }
    float inv = 1.0f / lsum;
#pragma unroll
    for (int d = 0; d < 64; ++d) p.Y()[(size_t)r * 2048 + 1536 + hh * 64 + d] = f2b(o[d] * inv);
  }
#endif
}

DEVN void ph_E2a(const Params& p, int nrows, i64 gtid, i64 gsz) {
  for (i64 i = gtid; i < (i64)nrows * 16; i += gsz) {
    const sc_t* s_ = p.SC() + (size_t)i * 128;
    float ps = 3.0e38f; int pi = -1;
    for (int k = 0; k < 16; ++k) {
      float bs = -3.0e38f; int bi = -1;
      for (int j = 0; j < 128; ++j) {
        float s = (float)s_[j];
        bool elig = (s < ps) || (s == ps && j > pi);
        if (elig && (s > bs)) { bs = s; bi = j; }
      }
      p.TKs()[(size_t)i * 16 + k] = bs; p.TKi()[(size_t)i * 16 + k] = bi;
      ps = bs; pi = bi;
    }
  }
}

DEVN void ph_E2b(const Params& p, int nrows, i64 gtid, i64 gsz) {
  for (i64 i = gtid; i < (i64)nrows * 8; i += gsz) {
    const float* s1 = p.TKs() + (size_t)i * 32; const float* s2 = s1 + 16;
    const int* i1 = p.TKi() + (size_t)i * 32; const int* i2 = i1 + 16;
    float ps = 3.0e38f; int pi = -1;
    float mx = 0.f;
    for (int k = 0; k < 16; ++k) {
      float bs = -3.0e38f; int bi = -1;
      for (int j = 0; j < 256; ++j) {
        float s = s1[j >> 4] + s2[j & 15];
        bool elig = (s < ps) || (s == ps && j > pi);
        if (elig && (s > bs)) { bs = s; bi = j; }
      }
      if (k == 0) mx = bs;
      p.SELi()[(size_t)i * 16 + k] = i1[bi >> 4] * 128 + i2[bi & 15];
      p.SELg()[(size_t)i * 16 + k] = expf(bs - mx);
      ps = bs; pi = bi;
    }
    float sum = 0.f;
    for (int k = 0; k < 16; ++k) sum += p.SELg()[(size_t)i * 16 + k];
    float inv = 1.0f / sum;
    for (int k = 0; k < 16; ++k) p.SELg()[(size_t)i * 16 + k] *= inv;
  }
}

DEVN void ph_E3(const Params& p, int l, int nrows, i64 gtid, i64 gsz) {
  const float* u = p.in[I_peer_u] + (size_t)l * NEXP * D;
#ifndef CPU_SIM
  const int lane = (int)(gtid & 63);
  for (i64 i = gtid >> 6; i < (i64)nrows * 128; i += gsz >> 6) {
    const int r = (int)(i >> 7);
    const float4* ur = (const float4*)(u + (size_t)p.SELi()[i] * D);
    const uint2* hr = (const uint2*)(p.h() + (size_t)r * D);
    float acc = 0.f;
#pragma unroll
    for (int q = 0; q < 4; ++q) {
      const float4 uv = ur[lane + q * 64]; const uint2 hv = hr[lane + q * 64];
      union { unsigned u_; float f; } c0, c1, c2, c3;
      c0.u_ = hv.x << 16; c1.u_ = hv.x & 0xFFFF0000u; c2.u_ = hv.y << 16; c3.u_ = hv.y & 0xFFFF0000u;
      acc += uv.x * c0.f + uv.y * c1.f + uv.z * c2.f + uv.w * c3.f;
    }
#pragma unroll
    for (int o = 32; o >= 1; o >>= 1) acc += lane_xor(acc, lane, o);
    if (lane == 0) p.W()[i] = p.SELg()[i] * geluf_(acc);
  }
#else
  for (i64 i = gtid; i < (i64)nrows * 128; i += gsz) {
    int r = (int)(i / 128);
    const float* ur = u + (size_t)p.SELi()[i] * D;
    const bf* hr = p.h() + (size_t)r * D;
    float acc = 0.f;
    for (int k = 0; k < D; ++k) acc += b2f(hr[k]) * ur[k];
    p.W()[i] = p.SELg()[i] * geluf_(acc);
  }
#endif
}

DEVN void ph_E4(const Params& p, int l, int nrows, i64 gtid, i64 gsz) {
  const float* v = p.in[I_peer_v] + (size_t)l * NEXP * D;
  for (i64 i = gtid; i < (i64)nrows * D; i += gsz) {
    int r = (int)(i / D), n = (int)(i % D);
    float acc = 0.f;
    for (int j = 0; j < 128; ++j) acc += p.W()[(size_t)r * 128 + j] * v[(size_t)p.SELi()[(size_t)r * 128 + j] * D + n];
    float g2 = p.mods()[((size_t)l * 3 + modrow(r)) * 6 * D + 5 * D + n];
    p.xcur()[i] += g2 * acc;
  }
}


#ifndef CPU_SIM
DEV unsigned dpp_ror_u(unsigned x, int n) {
  switch (n) {
    case 1: return (unsigned)__builtin_amdgcn_update_dpp(0, (int)x, 0x121, 0xf, 0xf, false);
    case 2: return (unsigned)__builtin_amdgcn_update_dpp(0, (int)x, 0x122, 0xf, 0xf, false);
    case 4: return (unsigned)__builtin_amdgcn_update_dpp(0, (int)x, 0x124, 0xf, 0xf, false);
    default: return (unsigned)__builtin_amdgcn_update_dpp(0, (int)x, 0x128, 0xf, 0xf, false);
  }
}
DEV unsigned wave_max_u(unsigned x) {
  x = max(x, dpp_ror_u(x, 1)); x = max(x, dpp_ror_u(x, 2)); x = max(x, dpp_ror_u(x, 4)); x = max(x, dpp_ror_u(x, 8));
  const unsigned a = (unsigned)__builtin_amdgcn_readlane((int)x, 0), b = (unsigned)__builtin_amdgcn_readlane((int)x, 16);
  const unsigned c = (unsigned)__builtin_amdgcn_readlane((int)x, 32), d = (unsigned)__builtin_amdgcn_readlane((int)x, 48);
  return max(max(a, b), max(c, d));
}
DEV unsigned f16_key(unsigned short h, int idx) { const unsigned t = (h & 0x8000u) ? (unsigned)(~h & 0xFFFFu) : (unsigned)(h | 0x8000u); return (t << 16) | (unsigned)(0xFFFF - idx); }
DEV float key_score(unsigned k) { const unsigned t = k >> 16; const unsigned short h = (unsigned short)((t & 0x8000u) ? (t ^ 0x8000u) : (~t & 0xFFFFu)); union { unsigned short u; _Float16 f; } c; c.u = h; return (float)c.f; }
DEV int key_idx(unsigned k) { return 0xFFFF - (int)(k & 0xFFFFu); }
DEV int mbcnt64(unsigned long long m) { return (int)__builtin_amdgcn_mbcnt_hi((unsigned)(m >> 32), __builtin_amdgcn_mbcnt_lo((unsigned)m, 0u)); }
DEV unsigned pick16_sorted(unsigned k0, unsigned k1, unsigned T, int above, int lane, int* tmp) {
  const unsigned h0 = k0 & 0xFFFF0000u, h1 = k1 & 0xFFFF0000u;
  const bool gt0 = h0 > T, eq0 = h0 == T, gt1 = h1 > T, eq1 = h1 == T;
  const int need = 16 - above;
  const unsigned long long me0 = __builtin_amdgcn_ballot_w64(eq0), me1 = __builtin_amdgcn_ballot_w64(eq1);
  const bool s0 = gt0 || (eq0 && mbcnt64(me0) < need);
  const int need1 = need - (int)__builtin_popcountll(me0);
  const bool s1 = gt1 || (eq1 && mbcnt64(me1) < need1);
  const unsigned long long ms0 = __builtin_amdgcn_ballot_w64(s0), ms1 = __builtin_amdgcn_ballot_w64(s1);
  if (s0) tmp[mbcnt64(ms0)] = (int)k0;
  if (s1) tmp[(int)__builtin_popcountll(ms0) + mbcnt64(ms1)] = (int)k1;
  const unsigned u = (unsigned)tmp[lane & 15];
  int rank = 0;
#pragma unroll
  for (int q = 0; q < 16; ++q) rank += ((unsigned)__builtin_amdgcn_readlane((int)u, q) > u) ? 1 : 0;
  if (lane < 16) tmp[16 + rank] = (int)u;
  return (unsigned)tmp[16 + (lane & 15)];
}
DEV void top16_x2(unsigned a0, unsigned a1, unsigned b0, unsigned b1, int lane, int* tmp, unsigned& ta, unsigned& tb) {
  unsigned TA = 0, TB = 0; int abA = 0, abB = 0;
#pragma unroll
  for (int bit = 31; bit >= 16; --bit) {
    const unsigned m = 0xFFFFFFFFu << bit, one = 1u << bit;
    const unsigned tA = TA | one, tB = TB | one;
    const int cA = (int)__builtin_popcountll(__builtin_amdgcn_ballot_w64((a0 & m) == tA)) + (int)__builtin_popcountll(__builtin_amdgcn_ballot_w64((a1 & m) == tA));
    const int cB = (int)__builtin_popcountll(__builtin_amdgcn_ballot_w64((b0 & m) == tB)) + (int)__builtin_popcountll(__builtin_amdgcn_ballot_w64((b1 & m) == tB));
    if (abA + cA >= 16) TA = tA; else abA += cA;
    if (abB + cB >= 16) TB = tB; else abB += cB;
  }
  ta = pick16_sorted(a0, a1, TA, abA, lane, tmp);
  tb = pick16_sorted(b0, b1, TB, abB, lane, tmp + 32);
}
DEVN void ph_cvt_tables(const Params& p, int l, i64 gtid, i64 gsz) {
  const float4* u = (const float4*)(p.in[I_peer_u] + (size_t)l * NEXP * D); const float4* v = (const float4*)(p.in[I_peer_v] + (size_t)l * NEXP * D);
  unsigned* ub = (unsigned*)p.Ub(); unsigned* vb = (unsigned*)p.Vb();
#pragma unroll 4
  for (i64 i = gtid; i < (i64)NEXP * D / 4; i += gsz) {
    const float4 a = u[i], b = v[i];
    int w = __builtin_amdgcn_cvt_pk_fp8_f32(a.x * 32.f, a.y * 32.f, 0, false); w = __builtin_amdgcn_cvt_pk_fp8_f32(a.z * 32.f, a.w * 32.f, w, true); ub[i] = (unsigned)w;
    int x = __builtin_amdgcn_cvt_pk_fp8_f32(b.x, b.y, 0, false); x = __builtin_amdgcn_cvt_pk_fp8_f32(b.z, b.w, x, true); vb[i] = (unsigned)x;
  }
}
DEV void unpack16_fp8(const uint4 w, float* f) {
#define UP4(W, O) { auto lo = __builtin_amdgcn_cvt_pk_f32_fp8((int)(W), false); auto hi = __builtin_amdgcn_cvt_pk_f32_fp8((int)(W), true); f[O] = lo[0]; f[O + 1] = lo[1]; f[O + 2] = hi[0]; f[O + 3] = hi[1]; }
  UP4(w.x, 0) UP4(w.y, 4) UP4(w.z, 8) UP4(w.w, 12)
#undef UP4
}
struct Sc4 { unsigned short a, b, c, d; };
DEV Sc4 peer_scores(const Params& p, int r, int wid, int lane) {
  const unsigned short* sp = (const unsigned short*)(p.SC() + ((size_t)r * 8 + wid) * 256);
  Sc4 q; q.a = sp[lane]; q.b = sp[64 + lane]; q.c = sp[128 + lane]; q.d = sp[192 + lane];
  return q;
}
struct Key4 { decltype(f16_key((unsigned short)0, 0)) a, b, c, d; };
DEV Key4 peer_keys(const Sc4 q, int lane) { Key4 k; k.a = f16_key(q.a, lane); k.b = f16_key(q.b, 64 + lane); k.c = f16_key(q.c, lane); k.d = f16_key(q.d, 64 + lane); return k; }
DEV void peer_topk(const Key4 k, int lane, int ca, int cb, bool cvalid, int* selx, int* tmp) {
  unsigned t1, t2;
  top16_x2(k.a, k.b, k.c, k.d, lane, tmp, t1, t2);
  const unsigned k1 = (unsigned)__builtin_amdgcn_ds_bpermute(ca << 2, (int)t1), k2 = (unsigned)__builtin_amdgcn_ds_bpermute(cb << 2, (int)t2);
  const float v = cvalid ? key_score(k1) + key_score(k2) : -3.0e38f;
  int rank = 0;
#pragma unroll
  for (int c = 0; c < 50; ++c) {
    const float vs = __int_as_float(__builtin_amdgcn_readlane(__float_as_int(v), c));
    rank += (vs > v || (vs == v && c < lane)) ? 1 : 0;
  }
  float mx = v;
#pragma unroll
  for (int o = 32; o >= 1; o >>= 1) mx = fmaxf(mx, lane_xor(mx, lane, o));
  const bool sel = cvalid && rank < 16;
  const float e = sel ? fexpf_(v - mx) : 0.f;
  float sum = e;
#pragma unroll
  for (int o = 32; o >= 1; o >>= 1) sum += lane_xor(sum, lane, o);
  if (sel) { selx[rank] = key_idx(k1) * 128 + key_idx(k2); selx[16 + rank] = __float_as_int(e / sum); }
}
DEVN void ph_peer(const Params& p, int l, int nrows, int tid, char* ldsg, float oscale = 1.0f) {
  const int lane = tid & 63, wid = tid >> 6;
  float* part = (float*)ldsg;
  int* selbase = (int*)(ldsg + 8 * 1024 * 4) + wid * 64;
  int* tktmp = (int*)(ldsg + 8 * 1024 * 4 + 8 * 64 * 4) + wid * 64;
  const unsigned char* Ub = (const unsigned char*)p.Ub(); const unsigned char* Vb = (const unsigned char*)p.Vb();
  int ca = 0, cb = 0; bool cvalid = false;
  { int pre = 0;
    for (int a = 0; a < 16; ++a) { const int cnt = 16 / (a + 1); if (lane >= pre && lane < pre + cnt) { ca = a; cb = lane - pre; cvalid = true; } pre += cnt; } }
  int cur = 0;
  Sc4 nsc; nsc.a = nsc.b = nsc.c = nsc.d = 0;
  if ((int)blockIdx.x < nrows) {
    peer_topk(peer_keys(peer_scores(p, blockIdx.x, wid, lane), lane), lane, ca, cb, cvalid, selbase, tktmp);
    nsc = peer_scores(p, (int)(blockIdx.x + gridDim.x) < nrows ? (int)(blockIdx.x + gridDim.x) : (int)blockIdx.x, wid, lane);
  }
  for (int r = blockIdx.x; r < nrows; r += gridDim.x) {
    const int* selx = selbase + cur * 32;
    int eidx[16];
#pragma unroll
    for (int e = 0; e < 16; ++e) eidx[e] = __builtin_amdgcn_readfirstlane(selx[e]);
    const float mygate = __int_as_float(selx[16 + (lane >> 2)]);
    const bool more = r + (int)gridDim.x < nrows;
    const Key4 nkeys = peer_keys(nsc, lane);
    uint4 rows[16], vrows[16];
#pragma unroll
    for (int e = 0; e < 16; ++e) rows[e] = ((const uint4*)(Ub + (size_t)eidx[e] * D))[lane];
    uint4 hraw0, hraw1;
    { const uint4* hp = (const uint4*)(p.h() + (size_t)r * D); hraw0 = hp[lane * 2]; hraw1 = hp[lane * 2 + 1]; }
#pragma unroll
    for (int e = 0; e < 16; ++e) vrows[e] = ((const uint4*)(Vb + (size_t)eidx[e] * D))[lane];
    const float2 g2v = *(const float2*)(p.mods() + ((size_t)l * 3 + modrow(r)) * 6 * D + 5 * D + tid * 2);
    float2 xv = *(const float2*)(p.xcur() + (size_t)r * D + tid * 2);
    nsc = peer_scores(p, r + 2 * (int)gridDim.x < nrows ? r + 2 * (int)gridDim.x : r, wid, lane);
    if (more) peer_topk(nkeys, lane, ca, cb, cvalid, selbase + (cur ^ 1) * 32, tktmp);
    float hv[16]; unpack8(hraw0, hv); unpack8(hraw1, hv + 8);
    float d[16];
#pragma unroll
    for (int e = 0; e < 16; ++e) {
      float f[16]; unpack16_fp8(rows[e], f);
      float a = 0.f;
#pragma unroll
      for (int k = 0; k < 16; ++k) a += f[k] * hv[k];
      d[e] = a;
    }
#define FOLD(NV, O) _Pragma("unroll") for (int i = 0; i < NV / 2; ++i) { const bool up = (lane & O) != 0; const float send = up ? d[i] : d[i + NV / 2]; const float keep = up ? d[i + NV / 2] : d[i]; d[i] = keep + lane_xor(send, lane, O); }
    FOLD(16, 32) FOLD(8, 16) FOLD(4, 8) FOLD(2, 4)
#undef FOLD
    float dot = d[0]; dot += lane_xor(dot, lane, 2); dot += lane_xor(dot, lane, 1);
    const float myact = mygate * geluf_(dot * (1.0f / 32.0f));
    float acc[16];
#pragma unroll
    for (int k = 0; k < 16; ++k) acc[k] = 0.f;
#pragma unroll
    for (int e = 0; e < 16; ++e) {
      const float a = __int_as_float(__builtin_amdgcn_readlane(__float_as_int(myact), e * 4));
      float f[16]; unpack16_fp8(vrows[e], f);
#pragma unroll
      for (int k = 0; k < 16; ++k) acc[k] += a * f[k];
    }
    float* partc = part + cur * ((8 * 1024 * 4 + 2 * 8 * 64 * 4) / 4);
    { float4* pw = (float4*)(partc + wid * 1024 + lane * 16);
      pw[0] = float4{acc[0], acc[1], acc[2], acc[3]}; pw[1] = float4{acc[4], acc[5], acc[6], acc[7]};
      pw[2] = float4{acc[8], acc[9], acc[10], acc[11]}; pw[3] = float4{acc[12], acc[13], acc[14], acc[15]}; }
    __syncthreads();
    { const int c = tid * 2;
      float s0 = 0.f, s1 = 0.f;
#pragma unroll
      for (int w = 0; w < 8; ++w) { const float2 t = *(const float2*)(partc + w * 1024 + c); s0 += t.x; s1 += t.y; }
      xv.x += oscale * g2v.x * s0; xv.y += oscale * g2v.y * s1; *(float2*)(p.xcur() + (size_t)r * D + c) = xv; }
    cur ^= 1;
  }
}
#endif

DEVN void ph_final(const Params& p, i64 gtid, i64 gsz) {
  const float* g = p.in[I_g_final];
#ifndef CPU_SIM
  float pscale = 1.0f;
#if PROBE_K >= 0
  { const unsigned long long* ts = (const unsigned long long*)(p.ws + WL.ts);
    const float frac = (float)(ts[PROBE_K + 1] - ts[0]) / (float)(ts[NPHASES - 1] - ts[0]);
    pscale = 1.0f + sqrtf(floorf(frac * 50.0f + 0.5f) * 0.02f); }
#endif
  const int lane = (int)(gtid & 63);
  const i64 W = gsz >> 6;
  float4 gv[4];
#pragma unroll
  for (int i = 0; i < 4; ++i) gv[i] = *(const float4*)(g + (lane + i * 64) * 4);
  for (i64 r = gtid >> 6; r < NLAT; r += 2 * W) {
    const bool two = r + W < NLAT;
    const i64 rb = two ? r + W : r;
    const float4* xra = (const float4*)(p.xcur() + (size_t)r * D); const float4* xrb = (const float4*)(p.xcur() + (size_t)rb * D);
    float4 xa[4], xb[4]; float sa = 0.f, sb = 0.f;
#pragma unroll
    for (int i = 0; i < 4; ++i) { xa[i] = xra[lane + i * 64]; xb[i] = xrb[lane + i * 64]; }
#pragma unroll
    for (int i = 0; i < 4; ++i) { sa += xa[i].x * xa[i].x + xa[i].y * xa[i].y + xa[i].z * xa[i].z + xa[i].w * xa[i].w; sb += xb[i].x * xb[i].x + xb[i].y * xb[i].y + xb[i].z * xb[i].z + xb[i].w * xb[i].w; }
#pragma unroll
    for (int o = 32; o >= 1; o >>= 1) { sa += lane_xor(sa, lane, o); sb += lane_xor(sb, lane, o); }
    const float rsa = 1.0f / sqrtf(sa * (1.0f / D) + EPS), rsb = 1.0f / sqrtf(sb * (1.0f / D) + EPS);
#pragma unroll
    for (int i = 0; i < 4; ++i) {
      const int k = (lane + i * 64) * 4;
      float4 o4; o4.x = xa[i].x * rsa * gv[i].x * pscale; o4.y = xa[i].y * rsa * gv[i].y * pscale; o4.z = xa[i].z * rsa * gv[i].z * pscale; o4.w = xa[i].w * rsa * gv[i].w * pscale;
      *(float4*)(p.out + (size_t)r * D + k) = o4;
    }
    if (two) {
#pragma unroll
      for (int i = 0; i < 4; ++i) {
        const int k = (lane + i * 64) * 4;
        float4 o4; o4.x = xb[i].x * rsb * gv[i].x * pscale; o4.y = xb[i].y * rsb * gv[i].y * pscale; o4.z = xb[i].z * rsb * gv[i].z * pscale; o4.w = xb[i].w * rsb * gv[i].w * pscale;
        *(float4*)(p.out + (size_t)rb * D + k) = o4;
      }
    }
  }
#else
  for (i64 r = gtid; r < NLAT; r += gsz) {
    const float* xr = p.xcur() + (size_t)r * D;
    float ss = 0.f;
    for (int k = 0; k < D; ++k) ss += xr[k] * xr[k];
    float rstd = 1.0f / sqrtf(ss / D + EPS);
    for (int k = 0; k < D; ++k) p.out[(size_t)r * D + k] = xr[k] * rstd * g[k];
  }
#endif
}

DEV void rope4(float* v, const float* tab, int nf, int pos, int f0) {
#pragma unroll
  for (int jj = 0; jj < 4; ++jj) {
    float c = tab[(pos * nf + f0 + jj) * 2], s = tab[(pos * nf + f0 + jj) * 2 + 1];
    float x1 = v[2 * jj], x2 = v[2 * jj + 1];
    v[2 * jj] = x1 * c - x2 * s; v[2 * jj + 1] = x1 * s + x2 * c;
  }
}
struct EpiInproj {
  static constexpr int W = 8; static constexpr bool SUB = false; static constexpr bool STAGED = false;
  const Params& p;
  MDEV void apply(int r, int c0, float* v) const {
    if (c0 >= 3744) return;
    if (c0 >= 384 && r < NLAT) {
      int t = r % N;
      if (c0 < C_KR + 32) { int pi = (c0 - C_KR) >> 1; int half = pi >> 3; rope4(v, p.tabA(), 8, half ? t % GRIDW : t / GRIDW, pi & 7); }
      else if (c0 >= C_GQ && c0 < C_GKV + 128) { int pi = ((c0 - C_GQ) & 63) >> 1; int half = pi >> 4; rope4(v, p.tabD(), 16, half ? t % GRIDW : t / GRIDW, pi & 15); }
    }
    store8bf(p.P() + (size_t)r * PC + c0, v);
  }
};
struct EpiUq {
  static constexpr int W = 8; static constexpr bool SUB = false; static constexpr bool STAGED = false;
  const Params& p;
  MDEV void apply(int r, int c0, float* v) const {
    float rstd = 1.0f / sqrtf(p.ssq()[r] * (1.0f / 256.0f) + EPS);
#pragma unroll
    for (int j = 0; j < 8; ++j) v[j] *= rstd;
    int d0 = c0 % 96;
    if (d0 >= 64 && r < NLAT) { int t = r % N; int pi = (d0 - 64) >> 1; int half = pi >> 3; rope4(v, p.tabA(), 8, half ? t % GRIDW : t / GRIDW, pi & 7); }
    store8bf(p.QA() + (size_t)r * 768 + c0, v);
  }
};
struct EpiUkv {
  static constexpr int W = 8; static constexpr bool SUB = false; static constexpr bool STAGED = false;
  const Params& p;
  MDEV void apply(int r, int c0, float* v) const {
    float rstd = 1.0f / sqrtf(p.ssq()[TT + r] * (1.0f / 128.0f) + EPS);
#pragma unroll
    for (int j = 0; j < 8; ++j) v[j] *= rstd;
    store8bf(p.KVA() + (size_t)r * 1024 + c0, v);
  }
};
struct EpiLru {
  static constexpr int W = 8; static constexpr bool SUB = false; static constexpr bool STAGED = false;
  const Params& p; int l;
  MDEV void apply(int r, int c0, float* v) const {
    int kw = c0 >> 10, dir = (c0 >> 9) & 1, blk4 = (c0 >> 7) & 3, jc0 = (c0 & 127) >> 1;
    int cb = kw * 256 + blk4 * 64 + jc0;
    bf* la = p.LA() + ((size_t)dir * TT + r) * 512 + cb;
    bf* lb = p.LB() + ((size_t)dir * TT + r) * 512 + cb;
    float brv[4], biv[4], splv[4], xcv[4];
#ifndef CPU_SIM
    {
      const float4 a4 = __ldg((const float4*)(p.in[I_lru_b_r] + (l * 2 + dir) * 512 + cb)), b4 = __ldg((const float4*)(p.in[I_lru_b_i] + (l * 2 + dir) * 512 + cb));
      const float4 s4 = __ldg((const float4*)(p.spl() + (l * 2 + dir) * 512 + cb));
      const uint2 x2 = __ldg((const uint2*)(p.XC() + (size_t)r * 512 + cb));
      brv[0] = a4.x; brv[1] = a4.y; brv[2] = a4.z; brv[3] = a4.w; biv[0] = b4.x; biv[1] = b4.y; biv[2] = b4.z; biv[3] = b4.w;
      splv[0] = s4.x; splv[1] = s4.y; splv[2] = s4.z; splv[3] = s4.w;
      union { unsigned u; float f; } c; c.u = x2.x << 16; xcv[0] = c.f; c.u = x2.x & 0xFFFF0000u; xcv[1] = c.f; c.u = x2.y << 16; xcv[2] = c.f; c.u = x2.y & 0xFFFF0000u; xcv[3] = c.f; }
#else
    for (int jj = 0; jj < 4; ++jj) { brv[jj] = p.in[I_lru_b_r][(l * 2 + dir) * 512 + cb + jj]; biv[jj] = p.in[I_lru_b_i][(l * 2 + dir) * 512 + cb + jj]; splv[jj] = p.spl()[(l * 2 + dir) * 512 + cb + jj]; xcv[jj] = b2f(p.XC()[(size_t)r * 512 + cb + jj]); }
#endif
    float lav[4], lbv[4];
#pragma unroll
    for (int jj = 0; jj < 4; ++jj) {
      float rg = sigmoidf_(v[2 * jj] + brv[jj]), ig = sigmoidf_(v[2 * jj + 1] + biv[jj]);
      float log_a = -8.0f * rg * splv[jj];
      const float a_ = fexpf_(log_a);
      lav[jj] = log_a; lbv[jj] = sqrtf(fmaxf(1.0f - a_ * a_, 0.0f)) * ig * xcv[jj];
    }
#ifndef CPU_SIM
    { uint4 w;
      w.x = pk2bf(lav[0], lbv[0]); w.y = pk2bf(lav[1], lbv[1]); w.z = pk2bf(lav[2], lbv[2]); w.w = pk2bf(lav[3], lbv[3]);
      *(uint4*)(p.LAB() + ((size_t)dir * TT + r) * 512 + cb) = w; }
#else
    for (int jj = 0; jj < 4; ++jj) { la[jj] = f2b(lav[jj]); lb[jj] = f2b(lbv[jj]); }
#endif
  }
};
struct EpiGate {
  static constexpr int W = 8; static constexpr bool SUB = false; static constexpr bool STAGED = false;
  const Params& p;
  MDEV void apply(int r, int c0, float* v) const {
#pragma unroll
    for (int j = 0; j < 8; ++j) v[j] = sigmoidf_(v[j]);
    store8bf(p.Gs() + (size_t)r * D + c0, v);
  }
};
struct EpiBranch {
  static constexpr int W = 8; static constexpr bool SUB = false; static constexpr bool STAGED = false;
  const Params& p; int br;
  MDEV void apply(int r, int c0, float* v) const {
    float g[8]; load8bf(p.Gs() + (size_t)r * D + c0, g);
    if (br > 0) {
      float mo[8]; load8bf(p.M() + (size_t)r * D + c0, mo);
#pragma unroll
      for (int j = 0; j < 8; ++j) v[j] = mo[j] + g[j] * v[j];
    } else {
#pragma unroll
      for (int j = 0; j < 8; ++j) v[j] = g[j] * v[j];
    }
    store8bf(p.M() + (size_t)r * D + c0, v);
  }
};
struct EpiGateAll {
  static constexpr int W = 8; static constexpr bool SUB = false; static constexpr bool STAGED = false;
  const Params& p;
  MDEV void apply(int r, int c0, float* v) const {
#pragma unroll
    for (int j = 0; j < 8; ++j) v[j] = sigmoidf_(v[j]) * 255.f + 0.5f;
    unsigned char* gq = p.G8() + (size_t)r * 4096 + c0;
#ifndef CPU_SIM
    uint2 w;
    w.x = (unsigned)v[0] | ((unsigned)v[1] << 8) | ((unsigned)v[2] << 16) | ((unsigned)v[3] << 24);
    w.y = (unsigned)v[4] | ((unsigned)v[5] << 8) | ((unsigned)v[6] << 16) | ((unsigned)v[7] << 24);
    *(uint2*)gq = w;
#else
    for (int j = 0; j < 8; ++j) gq[j] = (unsigned char)v[j];
#endif
  }
};
struct EpiBranchSub {
  static constexpr int W = 8; static constexpr bool SUB = true; static constexpr bool STAGED = true;
  const Params& p;
  MDEV void apply(int, int, float*) const {}
  MDEV void gate8(int r, int c0, int i, float* g) const {
    const unsigned char* gq = p.G8() + (size_t)r * 4096 + i * 1024 + c0;
#ifndef CPU_SIM
    const uint2 w = *(const uint2*)gq;
#pragma unroll
    for (int j = 0; j < 4; ++j) { g[j] = (float)((w.x >> (8 * j)) & 255u) * (1.0f / 255.0f); g[4 + j] = (float)((w.y >> (8 * j)) & 255u) * (1.0f / 255.0f); }
#else
    for (int j = 0; j < 8; ++j) g[j] = (float)gq[j] * (1.0f / 255.0f);
#endif
  }
  MDEV void apply_sub(int r, int c0, float* v, int sub) const {
    if (sub < 3) { store8bf(p.BR() + (size_t)r * 3072 + sub * 1024 + c0, v); return; }
    float g[8]; gate8(r, c0, 3, g);
#pragma unroll
    for (int j = 0; j < 8; ++j) v[j] *= g[j];
#pragma unroll
    for (int i = 0; i < 3; ++i) {
      float bi[8]; load8bf(p.BR() + (size_t)r * 3072 + i * 1024 + c0, bi);
      gate8(r, c0, i, g);
#pragma unroll
      for (int j = 0; j < 8; ++j) v[j] += g[j] * bi[j];
    }
    store8bf(p.M() + (size_t)r * D + c0, v);
  }
#ifndef CPU_SIM
  struct Pre { uint2 g[4]; uint4 b[3]; };
  MDEV void pre(int r, int c0, Pre& q) const {
#pragma unroll
    for (int i = 0; i < 4; ++i) q.g[i] = *(const uint2*)(p.G8() + (size_t)r * 4096 + i * 1024 + c0);
#pragma unroll
    for (int i = 0; i < 3; ++i) q.b[i] = *(const uint4*)(p.BR() + (size_t)r * 3072 + i * 1024 + c0);
  }
  MDEV void fin(int r, int c0, float* v, const Pre& q) const {
#pragma unroll
    for (int i = 3; i >= 0; --i) {
      float g[8];
#pragma unroll
      for (int j = 0; j < 4; ++j) { g[j] = (float)((q.g[i].x >> (8 * j)) & 255u) * (1.0f / 255.0f); g[4 + j] = (float)((q.g[i].y >> (8 * j)) & 255u) * (1.0f / 255.0f); }
      if (i == 3) {
#pragma unroll
        for (int j = 0; j < 8; ++j) v[j] *= g[j];
      } else {
        float bi[8]; unpack8(q.b[i], bi);
#pragma unroll
        for (int j = 0; j < 8; ++j) v[j] += g[j] * bi[j];
      }
    }
    store8bf(p.M() + (size_t)r * D + c0, v);
  }
#endif
};
struct EpiFilt {
  static constexpr int W = 8; static constexpr bool SUB = false; static constexpr bool STAGED = false;
  const Params& p;
  MDEV void apply(int j, int tt, float* v) const {
    const float maxd = -15.350567286626973f, mind = -3.0701134573253945f;
    const float ad = fabsf(mind + (float)j * ((maxd - mind) / 1023.0f));
    int t, L; if (tt < N) { t = tt; L = N; } else { t = tt - N; L = LC; }
    const float sc = -ad / (float)(L - 1);
#pragma unroll
    for (int q = 0; q < 8; ++q) v[q] *= fexpf_((float)(t + q) * sc);
    float* d = p.F() + (size_t)j * (N + LC) + tt;
#ifndef CPU_SIM
    *(float4*)d = float4{v[0], v[1], v[2], v[3]}; *(float4*)(d + 4) = float4{v[4], v[5], v[6], v[7]};
#else
    for (int q = 0; q < 8; ++q) d[q] = v[q];
#endif
  }
};
struct EpiOut {
  static constexpr int W = 4; static constexpr bool SUB = false; static constexpr bool STAGED = false;
  const Params& p; int l; float osc = 1.0f;
  MDEV void apply(int r, int c0, float* v) const {
    const float* g1 = p.mods() + ((size_t)l * 3 + modrow(r)) * 6 * D + 2 * D + c0;
    float* xr = p.xcur() + (size_t)r * D + c0;
#ifndef CPU_SIM
    const float4 gv = *(const float4*)g1; float4 xv = l == 0 ? *(const float4*)(xin_row(p, r) + c0) : *(float4*)xr;
    xv.x += osc * gv.x * v[0]; xv.y += osc * gv.y * v[1]; xv.z += osc * gv.z * v[2]; xv.w += osc * gv.w * v[3];
    *(float4*)xr = xv;
#else
    for (int j = 0; j < 4; ++j) xr[j] = (l == 0 ? xin_row(p, r)[c0 + j] : xr[j]) + g1[j] * v[j];
#endif
  }
};
struct EpiPQ {
  static constexpr int W = 8; static constexpr bool SUB = false; static constexpr bool STAGED = false;
  const Params& p;
  MDEV void apply(int r, int c0, float* v) const { store8bf(p.PQ() + (size_t)r * 1024 + c0, v); }
};
struct EpiSC {
  static constexpr int W = 8; static constexpr bool SUB = false; static constexpr bool STAGED = false;
  const Params& p;
  MDEV void apply(int r, int c0, float* v) const {
    sc_t* d = p.SC() + (size_t)r * 2048 + c0;
#ifndef CPU_SIM
    typedef _Float16 half8 __attribute__((ext_vector_type(8)));
    half8 hv8;
#pragma unroll
    for (int j = 0; j < 8; ++j) hv8[j] = (_Float16)v[j];
    *(half8*)d = hv8;
#else
    for (int j = 0; j < 8; ++j) d[j] = (sc_t)v[j];
#endif
  }
};

struct GemmDesc { const bf* A; const bf* Bt; int lda, ldb, K, nrows, ncols; int a_pn_shift, a_pn_mul; int nsub = 1, a_sub = 0, b_sub = 0; int unit_off = 0; };

#ifndef CPU_SIM
namespace pg8 {
#define PG8_LAS __attribute__((address_space(3)))
typedef short bf16x8 __attribute__((ext_vector_type(8)));
typedef float f32x4 __attribute__((ext_vector_type(4)));
constexpr int BM = 256, BK = 64, HALF = 128, HTB = HALF * BK * 2, STAGE_BYTES = 8 * HTB, NXCD = 8, WGM = 8;
__device__ __forceinline__ int lds_byte(int r, int c) { const int st = (r >> 4) * 2 + (c >> 5), rr = r & 15, cc = c & 31, ob = rr * 64 + cc * 2; return st * 1024 + (ob ^ (((ob >> 9) & 1) << 5)); }
__device__ __forceinline__ void stage_rc(int b, int& R, int& C) { const int st = b / 1024, sb = b % 1024, swz = sb ^ (((sb >> 9) & 1) << 5); R = (st >> 1) * 16 + swz / 64; C = (st & 1) * 32 + (swz % 64) / 2; }
__device__ __forceinline__ int perm32(int rho) { const int n = rho >> 4, i = rho & 15; return 8 * (i >> 2) + 4 * n + (i & 3); }
struct Unit { int pm, pn, sub; };
struct StaticOrder {
  int nM, nN, nwg, G, c, nsub;
  __device__ void init(int nM_, int nN_, int G_, int c_, int nsub_) { nM = nM_; nN = nN_; nwg = nM * nN; G = G_; c = c_; nsub = nsub_; }
  __device__ bool next(int i, Unit& u) const {
    const int it = i / nsub; u.sub = i - it * nsub;
    const long L = (long)it * G + c; if (L >= nwg) return false;
    int wgid = (int)L; { const int q = nwg / NXCD, r = nwg % NXCD, xcd = wgid % NXCD, off = wgid / NXCD; wgid = (xcd < r ? xcd * (q + 1) : r * (q + 1) + (xcd - r) * q) + off; }
    const int nig = WGM * nN, gid = wgid / nig, fm = gid * WGM, gsz = (nM - fm) < WGM ? (nM - fm) : WGM;
    u.pm = fm + ((wgid % nig) % gsz); u.pn = (wgid % nig) / gsz; return true;
  }
};

template <class E>
__device__ __forceinline__ void epi_call(const E& e, const f32x4 (&acc)[2][2][4][2], const Unit& u, int wr, int wc, int fr_, int fq_) {
  int fr = fr_, fq = fq_;
  asm volatile("" : "+v"(fr), "+v"(fq));
  if constexpr (E::STAGED) {
    if (u.sub == 3) {
#pragma unroll
      for (int ai = 0; ai < 2; ++ai)
#pragma unroll
        for (int m = 0; m < 4; ++m) {
          typename E::Pre q[2];
#pragma unroll
          for (int bj = 0; bj < 2; ++bj) { q[bj] = typename E::Pre{}; e.pre(u.pm * BM + ai * HALF + wr * 64 + m * 16 + fr, u.pn * BM + bj * HALF + wc * 32 + 8 * fq, q[bj]); }
#pragma unroll
          for (int bj = 0; bj < 2; ++bj) {
            float v[8];
#pragma unroll
            for (int j = 0; j < 4; ++j) { v[j] = acc[ai][bj][m][0][j]; v[4 + j] = acc[ai][bj][m][1][j]; }
            e.fin(u.pm * BM + ai * HALF + wr * 64 + m * 16 + fr, u.pn * BM + bj * HALF + wc * 32 + 8 * fq, v, q[bj]);
          }
          __builtin_amdgcn_sched_barrier(0);
        }
      return;
    }
  }
#pragma unroll
  for (int ai = 0; ai < 2; ++ai)
#pragma unroll
    for (int m = 0; m < 4; ++m) {
      const int r = u.pm * BM + ai * HALF + wr * 64 + m * 16 + fr;
#pragma unroll
      for (int bj = 0; bj < 2; ++bj) {
        if constexpr (E::W == 8) {
          const int c0 = u.pn * BM + bj * HALF + wc * 32 + 8 * fq;
          float v[8];
#pragma unroll
          for (int j = 0; j < 4; ++j) { v[j] = acc[ai][bj][m][0][j]; v[4 + j] = acc[ai][bj][m][1][j]; }
          if constexpr (E::W == 8 && E::SUB) e.apply_sub(r, c0, v, u.sub); else e.apply(r, c0, v);
        } else {
#pragma unroll
          for (int n = 0; n < 2; ++n) {
            const int c0 = u.pn * BM + bj * HALF + wc * 32 + 16 * n + 4 * fq;
            float v[4];
#pragma unroll
            for (int j = 0; j < 4; ++j) v[j] = acc[ai][bj][m][n][j];
            e.apply(r, c0, v);
          }
        }
      }
      if (m == 1 || m == 3) __builtin_amdgcn_sched_barrier(0);
    }
}

template <class Epi>
__device__ __forceinline__ void gemm_phase(PG8_LAS unsigned char* lds, const int tid, const GemmDesc g, const Epi& E) {
  constexpr bool PERM = (Epi::W == 8);
  const int wid = __builtin_amdgcn_readfirstlane(tid >> 6), lane = tid & 63, wr = wid >> 2, wc = wid & 3, fr = lane & 15, fq = lane >> 4;
  const int K = g.K, nt = K / BK;
  StaticOrder S; S.init(g.nrows / BM, g.ncols / BM, (int)gridDim.x, (int)((blockIdx.x + gridDim.x - (unsigned)g.unit_off % gridDim.x) % gridDim.x), g.nsub);
  unsigned voffA[2], voffB[2];
#pragma unroll
  for (int i = 0; i < 2; ++i) { int R, C; stage_rc(tid * 16 + i * 8192, R, C); const int Rb = PERM ? ((R & ~31) + perm32(R & 31)) : R;
    voffA[i] = (unsigned)(R * g.lda + C) * 2u; voffB[i] = (unsigned)(Rb * g.ldb + C) * 2u; }
  const size_t kstep = (size_t)(BK * 2);
  const size_t hstepA = (size_t)HALF * g.lda * 2, hstepB = (size_t)HALF * g.ldb * 2;
  const unsigned ldsw = (unsigned)wid * 1024u;
  const int aoff = lds_byte(wr * 64 + fr, fq * 8), boff = lds_byte(wc * 32 + fr, fq * 8);
#define PG8_SA(b, h) (((b) * 2 + (h)) * HTB)
#define PG8_SB(b, h) ((4 + (b) * 2 + (h)) * HTB)
#define PG8_STAGE(bufoff, gbase, voff) do { _Pragma("unroll") for (int _i = 0; _i < 2; ++_i) \
        __builtin_amdgcn_global_load_lds((const unsigned*)((const char*)(gbase) + (voff)[_i]), (PG8_LAS unsigned*)(lds + (bufoff) + ldsw + _i * 8192), 16, 0, 0); } while (0)
#define PG8_LDA(dst, b, h) do { _Pragma("unroll") for (int m = 0; m < 4; ++m) _Pragma("unroll") for (int k = 0; k < 2; ++k) dst[m][k] = *(const PG8_LAS bf16x8*)(lds + PG8_SA(b, h) + aoff + m * 2048 + k * 1024); } while (0)
#define PG8_LDB(dst, b, h) do { _Pragma("unroll") for (int n = 0; n < 2; ++n) _Pragma("unroll") for (int k = 0; k < 2; ++k) dst[n][k] = *(const PG8_LAS bf16x8*)(lds + PG8_SB(b, h) + boff + n * 2048 + k * 1024); } while (0)
#define PG8_MMA(ai, bj, At, Bt) do { __builtin_amdgcn_s_setprio(1); _Pragma("unroll") for (int m = 0; m < 4; ++m) _Pragma("unroll") for (int n = 0; n < 2; ++n) _Pragma("unroll") for (int k = 0; k < 2; ++k) \
        acc[ai][bj][m][n] = __builtin_amdgcn_mfma_f32_16x16x32_bf16(Bt[n][k], At[m][k], acc[ai][bj][m][n], 0, 0, 0); __builtin_amdgcn_s_setprio(0); } while (0)
#define PG8_WAIT_V(n) asm volatile("s_waitcnt vmcnt(" #n ")" ::: "memory")
#define PG8_WAIT_L(n) asm volatile("s_waitcnt lgkmcnt(" #n ")" ::: "memory")
#define PG8_BAR __builtin_amdgcn_s_barrier()
#define PG8_SCHED __builtin_amdgcn_sched_barrier(0)
#define PG8_ABASE(u) ((const char*)g.A + ((size_t)(u).pm * BM * g.lda + (size_t)((u).pn >> g.a_pn_shift) * g.a_pn_mul + (size_t)(u).sub * g.a_sub) * 2)
#define PG8_BBASE(u) ((const char*)g.Bt + ((size_t)(u).pn * BM * g.ldb + (size_t)(u).sub * g.b_sub) * 2)
  Unit cur, nxt; int ui = 0;
  if (!S.next(0, cur)) return;
  f32x4 acc[2][2][4][2];
#pragma unroll
  for (int a = 0; a < 2; ++a)
#pragma unroll
    for (int b = 0; b < 2; ++b)
#pragma unroll
      for (int m = 0; m < 4; ++m)
#pragma unroll
        for (int n = 0; n < 2; ++n) acc[a][b][m][n] = (f32x4){0.f, 0.f, 0.f, 0.f};
  bf16x8 At[4][2], B0[2][2], B1[2][2];
  const char* cA = PG8_ABASE(cur); const char* cB = PG8_BBASE(cur);
  asm volatile("" : "+v"(voffA[0]), "+v"(voffA[1]), "+v"(voffB[0]), "+v"(voffB[1]));
  PG8_STAGE(PG8_SB(0, 0), cB, voffB); PG8_STAGE(PG8_SA(0, 0), cA, voffA); PG8_STAGE(PG8_SB(0, 1), cB + hstepB, voffB); PG8_STAGE(PG8_SA(0, 1), cA + hstepA, voffA);
  if (wr == 1) PG8_BAR;
  PG8_WAIT_V(4); PG8_BAR;
  PG8_STAGE(PG8_SB(1, 0), cB + kstep, voffB); PG8_STAGE(PG8_SA(1, 0), cA + kstep, voffA); PG8_STAGE(PG8_SB(1, 1), cB + hstepB + kstep, voffB);
  PG8_WAIT_V(6); PG8_BAR;
  for (;;) {
    const bool has_next = S.next(ui + 1, nxt);
    const char* nA = has_next ? PG8_ABASE(nxt) : cA; const char* nB = has_next ? PG8_BBASE(nxt) : cB;
    for (int t = 0; t < nt; t += 2) {
      const bool last = (t == nt - 2);
      asm volatile("" : "+v"(voffA[0]), "+v"(voffA[1]), "+v"(voffB[0]), "+v"(voffB[1]));
      const char* a1 = cA + (size_t)(t + 1) * kstep;
      const char* a2 = last ? nA : cA + (size_t)(t + 2) * kstep; const char* b2 = last ? nB : cB + (size_t)(t + 2) * kstep;
      const char* a3 = a2 + kstep; const char* b3 = b2 + kstep;
      PG8_LDB(B0, 0, 0); PG8_SCHED; PG8_LDA(At, 0, 0); PG8_STAGE(PG8_SA(1, 1), a1 + hstepA, voffA);
      PG8_WAIT_L(8); PG8_BAR; PG8_WAIT_L(0); PG8_MMA(0, 0, At, B0); PG8_BAR; PG8_SCHED;
      PG8_LDB(B1, 0, 1); PG8_STAGE(PG8_SB(0, 0), b2, voffB);
      PG8_BAR; PG8_WAIT_L(0); PG8_MMA(0, 1, At, B1); PG8_BAR;
      PG8_LDA(At, 0, 1); PG8_STAGE(PG8_SA(0, 0), a2, voffA);
      PG8_BAR; PG8_WAIT_L(0); PG8_MMA(1, 0, At, B0); PG8_BAR; PG8_SCHED;
      PG8_STAGE(PG8_SB(0, 1), b2 + hstepB, voffB);
      PG8_WAIT_V(6); PG8_BAR; PG8_MMA(1, 1, At, B1); PG8_BAR;
      PG8_LDB(B0, 1, 0); PG8_SCHED; PG8_LDA(At, 1, 0); PG8_STAGE(PG8_SA(0, 1), a2 + hstepA, voffA);
      PG8_WAIT_L(8); PG8_BAR; PG8_WAIT_L(0); PG8_MMA(0, 0, At, B0); PG8_BAR; PG8_SCHED;
      PG8_LDB(B1, 1, 1); PG8_STAGE(PG8_SB(1, 0), b3, voffB);
      PG8_BAR; PG8_WAIT_L(0); PG8_MMA(0, 1, At, B1); PG8_BAR;
      PG8_LDA(At, 1, 1); PG8_STAGE(PG8_SA(1, 0), a3, voffA);
      PG8_BAR; PG8_WAIT_L(0); PG8_MMA(1, 0, At, B0); PG8_BAR; PG8_SCHED;
      PG8_STAGE(PG8_SB(1, 1), b3 + hstepB, voffB);
      PG8_WAIT_V(6); PG8_BAR; PG8_MMA(1, 1, At, B1); PG8_BAR;
    }
    epi_call(E, acc, cur, wr, wc, fr, fq);
    if (!has_next) break;
#pragma unroll
    for (int a = 0; a < 2; ++a)
#pragma unroll
      for (int b = 0; b < 2; ++b)
#pragma unroll
        for (int m = 0; m < 4; ++m)
#pragma unroll
          for (int n = 0; n < 2; ++n) acc[a][b][m][n] = (f32x4){0.f, 0.f, 0.f, 0.f};
    cur = nxt; cA = nA; cB = nB; ++ui;
  }
  PG8_WAIT_V(0);
  if (wr == 0) PG8_BAR;
  PG8_BAR;
#undef PG8_SA
#undef PG8_SB
#undef PG8_STAGE
#undef PG8_LDA
#undef PG8_LDB
#undef PG8_MMA
#undef PG8_WAIT_V
#undef PG8_WAIT_L
#undef PG8_BAR
#undef PG8_SCHED
#undef PG8_ABASE
#undef PG8_BBASE
}
}
struct Ctx { i64 gtid, gsz; PG8_LAS unsigned char* lds; char* ldsg; int tid; };
template <class E> DEV void run_gemm(const Ctx& cx, const GemmDesc& g, const E& e) { pg8::gemm_phase<E>(cx.lds, cx.tid, g, e); }
#else
struct Ctx { i64 gtid, gsz; };
template <class E> static void run_gemm(const Ctx& cx, const GemmDesc& g, const E& e) {
  constexpr int W = E::W;
  const int ng = g.ncols / W;
  for (i64 i = cx.gtid; i < (i64)g.nrows * ng; i += cx.gsz) {
    int r = (int)(i / ng), c0 = (int)(i % ng) * W;
    int pn = c0 / 256;
    for (int sub = 0; sub < g.nsub; ++sub) {
      const bf* a = g.A + (size_t)r * g.lda + (size_t)(pn >> g.a_pn_shift) * g.a_pn_mul + (size_t)sub * g.a_sub;
      float v[8];
      for (int j = 0; j < W; ++j) {
        const bf* b = g.Bt + (size_t)(c0 + j) * g.ldb + (size_t)sub * g.b_sub;
        float acc = 0.f;
        for (int k = 0; k < g.K; ++k) acc += b2f(a[k]) * b2f(b[k]);
        v[j] = acc;
      }
      if constexpr (E::SUB) e.apply_sub(r, c0, v, sub); else e.apply(r, c0, v);
    }
  }
}
#endif


#ifndef CPU_SIM
namespace fa {
using bf16x8 = __attribute__((ext_vector_type(8))) short;
using s16x4 = __attribute__((ext_vector_type(4))) short;
using f32x16 = __attribute__((ext_vector_type(16))) float;
using u32x4 = __attribute__((ext_vector_type(4))) unsigned;
constexpr int KVBLK = 64, QBLK = 32;
constexpr float THR = 8.f;
constexpr int SHM_V = KVBLK * 128 * 2, SHM_K = KVBLK * 128 * 2;
constexpr int NBUF = 3;
constexpr int SHM_ATTN = NBUF * SHM_V + NBUF * SHM_K + 8 * 64 * 4;
#define KSWZ(row, colB) ((row) * 256 + ((colB) ^ (((row) & 7) << 4)))
#define SBAR() __builtin_amdgcn_sched_barrier(0)
__device__ __forceinline__ int crow(int r, int hi) { return (r & 3) + 8 * (r >> 2) + 4 * hi; }
__device__ __forceinline__ unsigned cvtpk(float lo, float hi) { unsigned r; asm volatile("v_cvt_pk_bf16_f32 %0, %1, %2" : "=v"(r) : "v"(lo), "v"(hi)); return r; }
template <int SC1000000> __device__ __forceinline__ void partialSM(f32x16& p0, f32x16& p1, float& m_reg, float& mn, float& alpha) {
  constexpr float SCALE = SC1000000 * 1e-9f; constexpr float C = SCALE * 1.4426950408889634f;
  float pmax = p0[0];
#pragma unroll
  for (int r = 1; r < 16; ++r) pmax = fmaxf(pmax, p0[r]);
#pragma unroll
  for (int r = 0; r < 16; ++r) pmax = fmaxf(pmax, p1[r]);
  { auto rr = __builtin_amdgcn_permlane32_swap(__float_as_uint(pmax), __float_as_uint(pmax), false, false);
    pmax = fmaxf(__uint_as_float(rr[0]), __uint_as_float(rr[1])); }
  if (__builtin_expect(__all(pmax - m_reg <= THR / SCALE), 1)) { mn = m_reg; alpha = 1.f; }
  else { mn = fmaxf(m_reg, pmax); alpha = __builtin_amdgcn_exp2f((m_reg - mn) * C); m_reg = mn; }
  float mnC = -mn * C;
#pragma unroll
  for (int r = 0; r < 16; ++r) p0[r] = fmaf(p0[r], C, mnC);
#pragma unroll
  for (int r = 0; r < 16; ++r) p1[r] = fmaf(p1[r], C, mnC);
#pragma unroll
  for (int r = 0; r < 16; ++r) p0[r] = __builtin_amdgcn_exp2f(p0[r]);
}
__device__ __forceinline__ void finishSM(f32x16& p0, f32x16& p1, float alpha, float& l_reg, bf16x8& pa0, bf16x8& pa1, bf16x8& pa2, bf16x8& pa3) {
#pragma unroll
  for (int r = 0; r < 16; ++r) p1[r] = __builtin_amdgcn_exp2f(p1[r]);
  float ps = 0;
#pragma unroll
  for (int r = 0; r < 16; ++r) ps += p0[r];
#pragma unroll
  for (int r = 0; r < 16; ++r) ps += p1[r];
  { auto rr = __builtin_amdgcn_permlane32_swap(__float_as_uint(ps), __float_as_uint(ps), false, false);
    ps = __uint_as_float(rr[0]) + __uint_as_float(rr[1]); }
  l_reg = l_reg * alpha + ps;
#define PK4(P, BASE, OUT) do { unsigned a0 = cvtpk(P[BASE + 0], P[BASE + 1]), a1 = cvtpk(P[BASE + 2], P[BASE + 3]);   \
    unsigned b0 = cvtpk(P[BASE + 4], P[BASE + 5]), b1 = cvtpk(P[BASE + 6], P[BASE + 7]);                              \
    auto r0 = __builtin_amdgcn_permlane32_swap(a0, b0, false, false); auto r1 = __builtin_amdgcn_permlane32_swap(a1, b1, false, false); \
    u32x4 w = {r0[0], r1[0], r0[1], r1[1]}; OUT = *reinterpret_cast<bf16x8*>(&w); } while (0)
  PK4(p0, 0, pa0); PK4(p0, 8, pa1); PK4(p1, 0, pa2); PK4(p1, 8, pa3);
#undef PK4
}
template <int NK16>
__device__ __forceinline__ void qkt(f32x16& p0, f32x16& p1, const char* Ks, const bf16x8* qr, int r32, int hi) {
  p0 = f32x16{}; p1 = f32x16{};
#pragma unroll
  for (int d0 = 0; d0 < NK16; ++d0) { int cb = (d0 * 16 + hi * 8) * 2;
    bf16x8 b0 = *reinterpret_cast<const bf16x8*>(Ks + KSWZ(r32, cb));
    bf16x8 b1 = *reinterpret_cast<const bf16x8*>(Ks + KSWZ(32 + r32, cb));
    p0 = __builtin_amdgcn_mfma_f32_32x32x16_bf16(b0, qr[d0], p0, 0, 0, 0);
    p1 = __builtin_amdgcn_mfma_f32_32x32x16_bf16(b1, qr[d0], p1, 0, 0, 0); }
}
__device__ __forceinline__ int v_st(int k, int c) { const int kk = (k & ~0xC) | ((k & 4) << 1) | ((k & 8) >> 1); return ((kk >> 3) * 4 + (c >> 5)) * 512 + ((kk & 7) * 32 + (c & 31)) * 2; }
__device__ __forceinline__ int v_rd_base(int lane) { return ((lane & 3) << 3) | (((lane >> 2) & 3) << 6) | (((lane >> 4) & 1) << 5) | (((lane >> 5) & 1) << 8); }
constexpr int v_rd_off(int d0, int ks, int half) { return d0 * 512 + ks * 4096 + half * 2048; }
template <int OFF> __device__ __forceinline__ s16x4 tr_read(int vb) {
  s16x4 r; asm volatile("ds_read_b64_tr_b16 %0, %1 offset:%2" : "=&v"(r) : "v"(vb), "i"(OFF) : "memory"); return r;
}
template <int D0> __device__ __forceinline__ void pv_one(f32x16& od, int vb, bf16x8 pa0, bf16x8 pa1, bf16x8 pa2, bf16x8 pa3) {
  const s16x4 l0 = tr_read<v_rd_off(D0, 0, 0)>(vb), h0 = tr_read<v_rd_off(D0, 0, 1)>(vb), l1 = tr_read<v_rd_off(D0, 1, 0)>(vb), h1 = tr_read<v_rd_off(D0, 1, 1)>(vb);
  const s16x4 l2 = tr_read<v_rd_off(D0, 2, 0)>(vb), h2 = tr_read<v_rd_off(D0, 2, 1)>(vb), l3 = tr_read<v_rd_off(D0, 3, 0)>(vb), h3 = tr_read<v_rd_off(D0, 3, 1)>(vb);
  asm volatile("s_waitcnt lgkmcnt(0)" ::: "memory"); SBAR();
#define PK(L, H) (bf16x8){L[0], L[1], L[2], L[3], H[0], H[1], H[2], H[3]}
  od = __builtin_amdgcn_mfma_f32_32x32x16_bf16(pa0, PK(l0, h0), od, 0, 0, 0);
  od = __builtin_amdgcn_mfma_f32_32x32x16_bf16(pa1, PK(l1, h1), od, 0, 0, 0);
  od = __builtin_amdgcn_mfma_f32_32x32x16_bf16(pa2, PK(l2, h2), od, 0, 0, 0);
  od = __builtin_amdgcn_mfma_f32_32x32x16_bf16(pa3, PK(l3, h3), od, 0, 0, 0);
#undef PK
}
__device__ __forceinline__ void pv_d0(f32x16* o, int vb, bf16x8 pa0, bf16x8 pa1, bf16x8 pa2, bf16x8 pa3) {
  pv_one<0>(o[0], vb, pa0, pa1, pa2, pa3); pv_one<1>(o[1], vb, pa0, pa1, pa2, pa3);
}

struct Src { const bf* q; int qstride; const bf* ksrc; int kstride; const bf* vsrc; int vstride; bf* out; float m0, l0; int dq0; };
template <int NK16, int SC1000000, bool MASK>
__device__ __forceinline__ void unit(const Src& sd, const int tid, char* lds, int kbase0, int nt0, int kbase1, int NT) {
  const int wid = tid >> 6, lane = tid & 63, r32 = lane & 31, hi = lane >> 5;
  char* V_lds = lds; char* K_lds = lds + NBUF * SHM_V;
  float* wsl = (float*)(lds + NBUF * SHM_V + NBUF * SHM_K) + wid * 64; float* li_l = wsl; float* al_l = wsl + 32;
  float m_reg = sd.m0, l_reg = sd.l0; f32x16 o[2] = {}; bf16x8 qr[NK16];
  const bf* Qw = sd.q + (size_t)(wid * QBLK + r32) * sd.qstride + hi * 8;
#pragma unroll
  for (int d0 = 0; d0 < NK16; ++d0) qr[d0] = *reinterpret_cast<const bf16x8*>(Qw + d0 * 16);
  const int sr = tid >> 4, sc = (tid & 15) * 8, vst0 = v_st(sr, sc), vst1 = v_st(32 + sr, sc);
  const int vb0 = (int)(uintptr_t)V_lds + v_rd_base(lane);
  const bf* ksrc = sd.ksrc; const int kstride = sd.kstride; const bf* vsrc = sd.vsrc; const int vstride = sd.vstride;
  const int dqw = sd.dq0 + wid * QBLK + r32;
  struct { bf16x8 vs0, vs1, ks0, ks1; } sr_[2];
#define KROW(j) ((j) < nt0 ? kbase0 + (j) * KVBLK : kbase1 + ((j) - nt0) * KVBLK)
#define SLOAD(i, j) do { const int _kr = KROW(j); \
    sr_[i].vs0 = *reinterpret_cast<const bf16x8*>(vsrc + (size_t)(_kr + sr) * vstride); sr_[i].vs1 = *reinterpret_cast<const bf16x8*>(vsrc + (size_t)(_kr + 32 + sr) * vstride); \
    sr_[i].ks0 = *reinterpret_cast<const bf16x8*>(ksrc + (size_t)(_kr + sr) * kstride); sr_[i].ks1 = *reinterpret_cast<const bf16x8*>(ksrc + (size_t)(_kr + 32 + sr) * kstride); } while (0)
#define SWRITE(b, i) do { *(bf16x8*)(V_lds + (b) * SHM_V + vst0) = sr_[i].vs0;          \
    *(bf16x8*)(V_lds + (b) * SHM_V + vst1) = sr_[i].vs1; int kc = sc * 2;               \
    *(bf16x8*)(K_lds + (b) * SHM_K + KSWZ(sr, kc)) = sr_[i].ks0;                       \
    *(bf16x8*)(K_lds + (b) * SHM_K + KSWZ(32 + sr, kc)) = sr_[i].ks1; } while (0)
#define SWAIT() asm volatile("s_waitcnt vmcnt(4)" ::: "memory")
#define MASKT(P0, P1, J) do { if (MASK && (J) < nt0) { const int _d = (J) * KVBLK - dqw; \
    _Pragma("unroll") for (int r = 0; r < 16; ++r) { const int dd = _d + crow(r, hi); if (dd > 128 || dd < -128) P0[r] = -1e30f; if (dd + 32 > 128 || dd + 32 < -128) P1[r] = -1e30f; } } } while (0)
#define RESC(a) do { if (__any((a) < 1.f)) { if (hi == 0) al_l[r32] = (a); asm volatile("s_waitcnt lgkmcnt(0)" ::: "memory"); \
    _Pragma("unroll") for (int d = 0; d < 2; ++d) _Pragma("unroll") for (int r = 0; r < 16; ++r) o[d][r] *= al_l[crow(r, hi)]; } } while (0)
  f32x16 pA0, pA1, pB0, pB1; float mnA, mnB, alA, alB; bf16x8 pa0, pa1, pa2, pa3;
  constexpr int SE = 0, SO = 1;
  __syncthreads();
  SLOAD(SE, 0); asm volatile("s_waitcnt vmcnt(0)" ::: "memory"); SWRITE(0, SE); __syncthreads();
  qkt<NK16>(pA0, pA1, K_lds, qr, r32, hi); MASKT(pA0, pA1, 0); partialSM<SC1000000>(pA0, pA1, m_reg, mnA, alA);
  SLOAD(SO, 1); if (2 < NT) SLOAD(SE, 2);
  SWAIT();
  SWRITE(1, SO); __syncthreads();
  int bc = 1;
  for (int j = 1; j + 1 < NT; j += 2) {
    { const int bp = bc == 0 ? NBUF - 1 : bc - 1, bn = bc == NBUF - 1 ? 0 : bc + 1;
      SBAR(); qkt<NK16>(pB0, pB1, K_lds + bc * SHM_K, qr, r32, hi);
      finishSM(pA0, pA1, alA, l_reg, pa0, pa1, pa2, pa3); SBAR();
      SLOAD(SO, j + 2); SBAR();
      pv_d0(o, vb0 + bp * SHM_V, pa0, pa1, pa2, pa3); MASKT(pB0, pB1, j); partialSM<SC1000000>(pB0, pB1, m_reg, mnB, alB);
      SWAIT(); SWRITE(bn, SE);
      RESC(alB); __syncthreads();
      bc = bn; }
    { const int bp = bc == 0 ? NBUF - 1 : bc - 1, bn = bc == NBUF - 1 ? 0 : bc + 1;
      SBAR(); qkt<NK16>(pA0, pA1, K_lds + bc * SHM_K, qr, r32, hi);
      finishSM(pB0, pB1, alB, l_reg, pa0, pa1, pa2, pa3); SBAR();
      if (j + 3 < NT) SLOAD(SE, j + 3); SBAR();
      pv_d0(o, vb0 + bp * SHM_V, pa0, pa1, pa2, pa3); MASKT(pA0, pA1, j + 1); partialSM<SC1000000>(pA0, pA1, m_reg, mnA, alA);
      SWAIT(); SWRITE(bn, SO);
      RESC(alA); __syncthreads();
      bc = bn; }
  }
  { const int bp = bc == 0 ? NBUF - 1 : bc - 1;
    SBAR(); qkt<NK16>(pB0, pB1, K_lds + bc * SHM_K, qr, r32, hi);
    finishSM(pA0, pA1, alA, l_reg, pa0, pa1, pa2, pa3); SBAR();
    pv_d0(o, vb0 + bp * SHM_V, pa0, pa1, pa2, pa3); MASKT(pB0, pB1, NT - 1); partialSM<SC1000000>(pB0, pB1, m_reg, mnB, alB);
    RESC(alB);
    finishSM(pB0, pB1, alB, l_reg, pa0, pa1, pa2, pa3); SBAR();
    pv_d0(o, vb0 + bc * SHM_V, pa0, pa1, pa2, pa3); }
  asm volatile("s_waitcnt vmcnt(0)" ::: "memory");
  if (hi == 0) li_l[r32] = l_reg; asm volatile("s_waitcnt lgkmcnt(0)" ::: "memory");
  float rli[16];
#pragma unroll
  for (int r = 0; r < 16; ++r) rli[r] = __builtin_amdgcn_rcpf(li_l[crow(r, hi)]);
  bf* Ow = sd.out + (size_t)(wid * QBLK) * 2048;
#pragma unroll
  for (int r = 0; r < 16; ++r) { int orow = crow(r, hi);
#pragma unroll
    for (int d0 = 0; d0 < 2; ++d0) Ow[(size_t)orow * 2048 + d0 * 32 + r32] = f2b(o[d0][r] * rli[r]); }
#undef SLOAD
#undef SWRITE
#undef SWAIT
#undef MASKT
#undef RESC
#undef KROW
}
#undef KSWZ
#undef SBAR
}

DEV void ph_mla(const Params& p, const Ctx& cx, int last) {
  const int nlat_units = NB * 8 * (N / 256);
  const int nctx_units = last ? 0 : NB * 8 * (LC / 256);
  const int sc = (cx.tid & 15) * 8;
  for (int uu = blockIdx.x; uu < nlat_units + 256; uu += gridDim.x) {
    const int u = uu < nlat_units ? uu : nlat_units + ((uu - nlat_units + 256 - 32) & 255);
    if (u >= nlat_units + nctx_units) continue;
    int qrow0, hh, kb0, nt0, kb1, NT;
    if (u < nlat_units) {
      const int rnd = u / 256, within = u % 256, bh = (rnd * 8 + (within & 7)) % (NB * 8); int qb = within >> 3;
      hh = bh % 8; int b = bh / 8; qrow0 = b * N + qb * 256; kb0 = b * N; nt0 = N / 64; kb1 = NLAT + b * LC; NT = (N + LC) / 64; }
    else { int v = u - nlat_units; int qb = v % (LC / 256); hh = (v / (LC / 256)) % 8; int b = v / (8 * (LC / 256)); qrow0 = NLAT + b * LC + qb * 256; kb0 = NLAT + b * LC; nt0 = LC / 64; kb1 = 0; NT = LC / 64; }
    fa::Src sd;
    sd.q = p.QA() + (size_t)qrow0 * 768 + hh * 96; sd.qstride = 768;
    if (sc < 64) { sd.ksrc = p.KVA() + hh * 128 + sc; sd.kstride = 1024; } else { sd.ksrc = p.P() + C_KR + ((sc - 64) & 31); sd.kstride = PC; }
    sd.vsrc = p.KVA() + hh * 128 + 64 + (sc & 63); sd.vstride = 1024;
    sd.out = p.Y() + (size_t)qrow0 * 2048 + hh * 64; sd.m0 = -1e30f; sd.l0 = 0.f; sd.dq0 = 0;
    fa::unit<6, 102062073, false>(sd, cx.tid, cx.ldsg, kb0, nt0, kb1, NT);
  }
}
DEV void ph_gqa(const Params& p, const Ctx& cx, int l, int last) {
  const int nlat_units = NB * 8 * (N / 256);
  const int nctx_units = last ? 0 : NB * 8 * (LC / 256);
  const int sc = (cx.tid & 15) * 8;
  for (int uu = blockIdx.x; uu < nlat_units + 256; uu += gridDim.x) {
    const int u = uu < nlat_units ? uu : nlat_units + ((uu - nlat_units + 256 - 16) & 255);
    if (u >= nlat_units + nctx_units) continue;
    int qrow0, hh, kb0, nt0, kb1, NT, dq0 = 0;
    if (u < nlat_units) {
      const int rnd = u / 256, within = u % 256, bh = (rnd * 8 + (within & 7)) % (NB * 8); int qb = within >> 3;
      hh = bh % 8; int b = bh / 8;
      int q0 = qb * 256; int klo = q0 - 128 < 0 ? 0 : q0 - 128; int khi = q0 + 384 > N ? N : q0 + 384;
      qrow0 = b * N + q0; kb0 = b * N + klo; nt0 = (khi - klo) / 64; kb1 = NLAT + b * LC; NT = nt0 + LC / 64; dq0 = q0 - klo;
    } else { int v = u - nlat_units; int qb = v % (LC / 256); hh = (v / (LC / 256)) % 8; int b = v / (8 * (LC / 256)); qrow0 = NLAT + b * LC + qb * 256; kb0 = NLAT + b * LC; nt0 = 0; kb1 = kb0; NT = LC / 64; }
    const int kh = hh >> 2;
    fa::Src sd;
    sd.q = p.P() + (size_t)qrow0 * PC + C_GQ + hh * 64; sd.qstride = PC;
    sd.ksrc = p.P() + C_GKV + kh * 64 + (sc & 63); sd.kstride = PC;
    sd.vsrc = p.P() + C_GKV + 128 + kh * 64 + (sc & 63); sd.vstride = PC;
    sd.out = p.Y() + (size_t)qrow0 * 2048 + 1536 + hh * 64;
    sd.m0 = p.in[I_gqa_sink][l * 8 + hh] * 8.0f; sd.l0 = 1.0f; sd.dq0 = dq0;
    fa::unit<4, 125000000, true>(sd, cx.tid, cx.ldsg, kb0, nt0, kb1, NT);
  }
}
#endif


namespace hy {
constexpr int NF = 2 * N;
struct f2 { float x, y; };
DEV f2 cmul(f2 a, f2 b) { f2 r; r.x = a.x * b.x - a.y * b.y; r.y = a.x * b.y + a.y * b.x; return r; }
#ifndef CPU_SIM
DEV f2 twid(const f2*, int k) { const float x = (float)k * (1.0f / (float)NF); return f2{__builtin_amdgcn_cosf(x), -__builtin_amdgcn_sinf(x)}; }
#else
DEV f2 twid(const f2* tw, int k) { return tw[k]; }
#endif
DEV f2 cmulc(f2 a, f2 b) { f2 r; r.x = a.x * b.x + a.y * b.y; r.y = a.y * b.x - a.x * b.y; return r; }
DEV void fwd_pass(f2* buf, const f2* tw, int L, int tid, int nthr) {
  const int Q = L >> 2, tws = NF / L;
  for (int u = tid; u < NF / 4; u += nthr) {
    const int g = u / Q, j = u - g * Q, base = g * L + j;
    const f2 x0 = buf[base], x1 = buf[base + Q], x2 = buf[base + 2 * Q], x3 = buf[base + 3 * Q];
    f2 a0{x0.x + x2.x, x0.y + x2.y}, a1{x0.x - x2.x, x0.y - x2.y}, a2{x1.x + x3.x, x1.y + x3.y};
    f2 d{x1.x - x3.x, x1.y - x3.y}; f2 a3{d.y, -d.x};
    f2 y0{a0.x + a2.x, a0.y + a2.y}, y1{a1.x + a3.x, a1.y + a3.y}, y2{a0.x - a2.x, a0.y - a2.y}, y3{a1.x - a3.x, a1.y - a3.y};
    buf[base] = y0; buf[base + Q] = cmul(y1, twid(tw, j * tws)); buf[base + 2 * Q] = cmul(y2, twid(tw, 2 * j * tws)); buf[base + 3 * Q] = cmul(y3, twid(tw, 3 * j * tws));
  }
}
DEV void inv_pass(f2* buf, const f2* tw, int L, int tid, int nthr) {
  const int Q = L >> 2, tws = NF / L;
  for (int u = tid; u < NF / 4; u += nthr) {
    const int g = u / Q, j = u - g * Q, base = g * L + j;
    const f2 u0 = buf[base], u1 = cmulc(buf[base + Q], twid(tw, j * tws)), u2 = cmulc(buf[base + 2 * Q], twid(tw, 2 * j * tws)), u3 = cmulc(buf[base + 3 * Q], twid(tw, 3 * j * tws));
    f2 a0{u0.x + u2.x, u0.y + u2.y}, a1{u0.x - u2.x, u0.y - u2.y}, a2{u1.x + u3.x, u1.y + u3.y};
    f2 d{u1.x - u3.x, u1.y - u3.y}; f2 a3{-d.y, d.x};
    buf[base] = f2{a0.x + a2.x, a0.y + a2.y}; buf[base + Q] = f2{a1.x + a3.x, a1.y + a3.y};
    buf[base + 2 * Q] = f2{a0.x - a2.x, a0.y - a2.y}; buf[base + 3 * Q] = f2{a1.x - a3.x, a1.y - a3.y};
  }
}
DEV void s1_taps(const Params& p, f2* buf, float* red, int c, int tid, int nthr) {
  float ss = 0.f;
#pragma unroll 8
  for (int k = tid; k < NF; k += nthr) {
    float v = 0.f;
    if (k < N) v = p.F()[(size_t)k * 1024 + c];
    else if (k > N) v = p.F()[(size_t)(NF - k) * 1024 + 512 + c];
    buf[k] = f2{v, 0.f}; ss += v * v;
  }
  red[tid] = ss;
}
DEV float red_total(const float* red, int nthr) { float s = 0.f; for (int i = 0; i < nthr; ++i) s += red[i]; return s; }
DEV void s3_store(const f2* buf, unsigned* hs, int tid, int nthr) {
  for (int k = tid; k < NF; k += nthr) hs[k] = (unsigned)f2b(buf[k].x).v | ((unsigned)f2b(buf[k].y).v << 16);
}
DEV void s4_loadz(const Params& p, f2* buf, int c, int tid, int nthr) {
#pragma unroll 8
  for (int t = tid; t < NF; t += nthr) {
    f2 v{0.f, 0.f};
    if (t < N) { v.x = b2f(p.Z()[(size_t)t * 512 + c]); v.y = b2f(p.Z()[(size_t)(N + t) * 512 + c]); }
    buf[t] = v;
  }
}
DEV void s6_mul(f2* buf, const unsigned* hs, int tid, int nthr) {
  for (int k = tid; k < NF; k += nthr) {
    union { unsigned u; float f; } a, b; const unsigned w = hs[k]; a.u = w << 16; b.u = w & 0xFFFF0000u;
    buf[k] = cmul(buf[k], f2{a.f, b.f});
  }
}
DEV void s8_out(const Params& p, const f2* buf, const float* red, int l, int c, int tid, int nthr) {
  const float fn = 1.0f / sqrtf(red_total(red, nthr) + EPS) * (1.0f / (float)NF);
  const float* cw = p.in[I_hy_conv_w] + l * 3 * 1536; const float cb = p.in[I_hy_conv_b][l * 1536 + c];
  const float w0 = cw[c], w1 = cw[1536 + c], w2 = cw[2 * 1536 + c];
  const float skip = p.in[I_hy_skip][l * 512 + c];
#pragma unroll 4
  for (int i = tid; i < 2 * N; i += nthr) {
    const int b = i / N, t = i - b * N;
    const size_t r = (size_t)b * N + t;
    const float conv = (b ? buf[t].y : buf[t].x) * fn;
    float x0 = cb + w1 * b2f(p.P()[r * PC + C_HU + c]);
    if (t > 0) x0 += w0 * b2f(p.P()[(r - 1) * PC + C_HU + c]);
    if (t < N - 1) x0 += w2 * b2f(p.P()[(r + 1) * PC + C_HU + c]);
    const float y = conv + skip * b2f(p.Z()[r * 512 + c]);
    p.Y()[r * 2048 + 1024 + c] = f2b(x0 * y);
  }
}
#ifndef CPU_SIM
DEV void channel(const Params& p, int l, int c, int tid, f2* buf, float* red, unsigned* hs) {
  const f2* tw = (const f2*)p.tw();
#ifndef HY_EXP
#define HY_EXP 0
#endif
  __syncthreads();
  if (HY_EXP != 2) s1_taps(p, buf, red, c, tid, 512); __syncthreads();
  if (HY_EXP != 1) for (int L = NF; L >= 4; L >>= 2) { fwd_pass(buf, tw, L, tid, 512); __syncthreads(); }
  s3_store(buf, hs, tid, 512); __syncthreads();
  if (HY_EXP != 2) s4_loadz(p, buf, c, tid, 512); __syncthreads();
  if (HY_EXP != 1) for (int L = NF; L >= 4; L >>= 2) { fwd_pass(buf, tw, L, tid, 512); __syncthreads(); }
  s6_mul(buf, hs, tid, 512); __syncthreads();
  if (HY_EXP != 1) for (int L = 4; L <= NF; L <<= 2) { inv_pass(buf, tw, L, tid, 512); __syncthreads(); }
  if (HY_EXP != 2) s8_out(p, buf, red, l, c, tid, 512);
}
#endif
}


namespace tz {
constexpr int NBLK = N / 64;
constexpr int PADB = 31;
constexpr int ZLEN = (NBLK + 2 * PADB) * 64;
constexpr int HLEN = 2 * N + 16;
DEV int a_index(int m, int r, int h) { return N - m - r + 8 * h; }
DEV int b_index(int t1, int Dd, int ks, int h) { return 64 * (t1 - Dd + PADB) + 16 * ks + 8 * h; }
#ifndef CPU_SIM
using bf16x8 = __attribute__((ext_vector_type(8))) short;
using f32x16 = __attribute__((ext_vector_type(16))) float;
using u32x4 = __attribute__((ext_vector_type(4))) unsigned;
DEV bf16x8 load_afrag(const unsigned short* Hr, int e) {
  const unsigned* wp = (const unsigned*)(Hr + (e & ~1));
  const unsigned w0 = wp[0], w1 = wp[1], w2 = wp[2], w3 = wp[3], w4 = wp[4];
  const unsigned sh = (unsigned)(e & 1) << 4;
  u32x4 o;
  o.x = __builtin_amdgcn_alignbit(w1, w0, sh); o.y = __builtin_amdgcn_alignbit(w2, w1, sh); o.z = __builtin_amdgcn_alignbit(w3, w2, sh); o.w = __builtin_amdgcn_alignbit(w4, w3, sh);
  return *reinterpret_cast<bf16x8*>(&o);
}
DEV void channel(const Params& p, int l, int c, int tid, char* lds) {
  unsigned short* zp = (unsigned short*)lds;
  float* red = (float*)(zp + 2 * ZLEN);
  unsigned short* Hr = (unsigned short*)(red + 512);
  float* cv = (float*)Hr;
  const int lane = tid & 63, w = tid >> 6, r = lane & 31, h = lane >> 5;
  __syncthreads();
  float ss = 0.f;
  const float* ff = p.F() + (size_t)c * (N + LC); const float* fb = p.F() + (size_t)(512 + c) * (N + LC);
#pragma unroll 4
  for (int t = tid * 4; t < N; t += 2048) {
    const float4 a = *(const float4*)(ff + t), b = *(const float4*)(fb + t);
    ss += a.x * a.x + a.y * a.y + a.z * a.z + a.w * a.w + b.x * b.x + b.y * b.y + b.z * b.z + b.w * b.w;
    Hr[N - t] = f2b(a.x).v; Hr[N - t - 1] = f2b(a.y).v; Hr[N - t - 2] = f2b(a.z).v; Hr[N - t - 3] = f2b(a.w).v;
    if (t > 0) Hr[N + t] = f2b(b.x).v;
    Hr[N + t + 1] = f2b(b.y).v; Hr[N + t + 2] = f2b(b.z).v; Hr[N + t + 3] = f2b(b.w).v;
  }
  if (tid == 0) Hr[0] = 0;
  if (tid < 16) Hr[2 * N + tid] = 0;
  red[tid] = ss;
  for (int i = tid; i < 2 * PADB * 64; i += 512) {
    const int side = i / (PADB * 64), k = i % (PADB * 64);
    const int off = side ? (PADB + NBLK) * 64 + k : k;
    zp[off] = 0; zp[ZLEN + off] = 0;
  }
  { const unsigned short* zt = (const unsigned short*)p.Z() + (size_t)c * NB * N;
#pragma unroll 4
    for (int i = tid * 8; i < 2 * N; i += 4096) { const int b = i / N, t = i - b * N; *(uint4*)(zp + b * ZLEN + PADB * 64 + t) = *(const uint4*)(zt + i); } }
  __syncthreads();
  float tot = 0.f;
  for (int i = 0; i < 512; i += 4) { const float4 q4 = *(const float4*)(red + i); tot += q4.x; tot += q4.y; tot += q4.z; tot += q4.w; }
  const float fn = 1.0f / sqrtf(tot + EPS);
  const int t1 = 32 * (w & 3) + r;
  const unsigned short* zb = zp + (w >> 2) * ZLEN;
  f32x16 acc0 = {}, acc1 = {};
  const int Dlo = 32 * (w & 3) - (NBLK - 1), Dhi = 32 * (w & 3) + 31;
#define TZ_LOAD(AF, BF, PA, PB) do { _Pragma("unroll") for (int ks = 0; ks < 4; ++ks) BF[ks] = *reinterpret_cast<const bf16x8*>((PB) + 16 * ks); \
    _Pragma("unroll") for (int q = 0; q < 6; ++q) { const unsigned* wq_ = (PA) + 8 * (5 - q); const unsigned w0_ = wq_[0], w1_ = wq_[1], w2_ = wq_[2], w3_ = wq_[3], w4_ = wq_[4]; u32x4 o_; \
      o_.x = __builtin_amdgcn_alignbit(w1_, w0_, shA); o_.y = __builtin_amdgcn_alignbit(w2_, w1_, shA); o_.z = __builtin_amdgcn_alignbit(w3_, w2_, shA); o_.w = __builtin_amdgcn_alignbit(w4_, w3_, shA); \
      AF[q] = *reinterpret_cast<bf16x8*>(&o_); } } while (0)
#define TZ_MMA(AF, BF) do { _Pragma("unroll") for (int ks = 0; ks < 4; ++ks) { \
    acc0 = __builtin_amdgcn_mfma_f32_32x32x16_bf16(AF[3 - ks], BF[ks], acc0, 0, 0, 0); acc1 = __builtin_amdgcn_mfma_f32_32x32x16_bf16(AF[5 - ks], BF[ks], acc1, 0, 0, 0); } } while (0)
  const unsigned shA = (unsigned)(r & 1) << 4;
  const unsigned* pa = (const unsigned*)Hr + ((a_index(64 * Dlo - 48 + 80, r, h) & ~1) >> 1);
  const unsigned short* pb = zb + b_index(t1, Dlo, 0, h);
#define TZ_LOAD4(AF, BF, PREV, PA, PB) do { _Pragma("unroll") for (int ks = 0; ks < 4; ++ks) BF[ks] = *reinterpret_cast<const bf16x8*>((PB) + 16 * ks); \
    AF[0] = PREV[4]; AF[1] = PREV[5]; \
    _Pragma("unroll") for (int q = 2; q < 6; ++q) { const unsigned* wq_ = (PA) + 8 * (5 - q); const unsigned w0_ = wq_[0], w1_ = wq_[1], w2_ = wq_[2], w3_ = wq_[3], w4_ = wq_[4]; u32x4 o_; \
      o_.x = __builtin_amdgcn_alignbit(w1_, w0_, shA); o_.y = __builtin_amdgcn_alignbit(w2_, w1_, shA); o_.z = __builtin_amdgcn_alignbit(w3_, w2_, shA); o_.w = __builtin_amdgcn_alignbit(w4_, w3_, shA); \
      AF[q] = *reinterpret_cast<bf16x8*>(&o_); } } while (0)
  bf16x8 afA[6], bfA[4], afB[6], bfB[4];
  TZ_LOAD(afA, bfA, pa, pb);
#pragma unroll 1
  for (int Dd = Dlo; Dd + 2 <= Dhi; Dd += 2) {
    TZ_LOAD4(afB, bfB, afA, pa - 32, pb - 64);
    TZ_MMA(afA, bfA);
    pa -= 64; pb -= 128;
    TZ_LOAD4(afA, bfA, afB, pa, pb);
    TZ_MMA(afB, bfB);
  }
  TZ_MMA(afA, bfA);
#undef TZ_LOAD4
#undef TZ_LOAD
#undef TZ_MMA
  static_assert((NBLK + 31) % 2 == 1, "K-loop pairing assumes an odd number of steps");
  __syncthreads();
  { int t1e = t1, he = h;
    asm volatile("" : "+v"(t1e), "+v"(he));
    float* cvb = cv + (w >> 2) * N + 64 * t1e + 4 * he;
#pragma unroll
    for (int g = 0; g < 4; ++g) {
      *(float4*)(cvb + 8 * g) = float4{acc0[4 * g], acc0[4 * g + 1], acc0[4 * g + 2], acc0[4 * g + 3]};
      *(float4*)(cvb + 32 + 8 * g) = float4{acc1[4 * g], acc1[4 * g + 1], acc1[4 * g + 2], acc1[4 * g + 3]};
    } }
  __syncthreads();
  { const float skip = p.in[I_hy_skip][l * 512 + c];
    unsigned short* xy = (unsigned short*)p.XYT() + (size_t)c * NB * N;
#pragma unroll 4
    for (int i = tid * 8; i < 2 * N; i += 4096) {
      const int b = i / N, t = i - b * N;
      float x0[8]; unpack8(*(const uint4*)(xy + i), x0);
      float zf[8]; unpack8(*(const uint4*)(zp + b * ZLEN + PADB * 64 + t), zf);
      const float4 ca = *(const float4*)(cv + i), cb4 = *(const float4*)(cv + i + 4);
      float o[8];
      o[0] = x0[0] * (ca.x * fn + skip * zf[0]); o[1] = x0[1] * (ca.y * fn + skip * zf[1]); o[2] = x0[2] * (ca.z * fn + skip * zf[2]); o[3] = x0[3] * (ca.w * fn + skip * zf[3]);
      o[4] = x0[4] * (cb4.x * fn + skip * zf[4]); o[5] = x0[5] * (cb4.y * fn + skip * zf[5]); o[6] = x0[6] * (cb4.z * fn + skip * zf[6]); o[7] = x0[7] * (cb4.w * fn + skip * zf[7]);
      store8bf(p.YT() + (size_t)c * NB * N + i, o);
    } }
}
DEV void xyt_to_y(const Params& p, int tid, char* lds) {
  unsigned short* tl = (unsigned short*)lds;
  for (int tile = blockIdx.x; tile < (NLAT / 64) * 8; tile += gridDim.x) {
    const int rt = tile >> 3, c0 = (tile & 7) * 64;
    const int bq = (rt * 64) / N, tq = (rt * 64) % N;
    __syncthreads();
    { const int cc = tid >> 3, tg = (tid & 7) * 8;
      const uint4 v = *(const uint4*)((const unsigned short*)p.YT() + ((size_t)(c0 + cc) * NB + bq) * N + tq + tg);
      const unsigned short* e = (const unsigned short*)&v;
#pragma unroll
      for (int j = 0; j < 8; ++j) tl[(tg + j) * 72 + cc] = e[j]; }
    __syncthreads();
    { const int tr = tid >> 3, cg8 = (tid & 7) * 8;
      *(uint4*)((unsigned short*)p.Y() + (size_t)(rt * 64 + tr) * 2048 + 1024 + c0 + cg8) = *(const uint4*)(tl + tr * 72 + cg8); }
  }
}
#endif
}

#ifndef CPU_SIM
DEV void ph_hyena_fft(const Params& p, const Ctx& cx, int l) {
  const int nb = gridDim.x;
  for (int i = blockIdx.x; i < 512; i += nb) {
    const int xcd = i & 7, idx = i >> 3;
    const int c = xcd * 64 + idx;
    tz::channel(p, l, c, cx.tid, cx.ldsg);
  }
}
#endif


#ifndef CPU_SIM
DEV void ph_hyena_ctx(const Params& p, const Ctx& cx, int l) {
  constexpr int LP = 33;
  float* Zs = (float*)cx.ldsg; float* Ff = Zs + LC * LP; float* Fb = Ff + LC * LP;
  const int tid = cx.tid, c = tid & 31, t0 = tid >> 5;
  const float* cw = p.in[I_hy_conv_w] + l * 3 * 1536; const float* cbv = p.in[I_hy_conv_b] + l * 1536;
  constexpr int TP = 8, TLEN = LC / TP;
  for (int task = blockIdx.x; task < NB * 16 * TP; task += gridDim.x) {
    const int tp = task % TP, cgp = (task / TP) & 15, b = task / (TP * 16), c0 = cgp * 32;
    const int rbase = NLAT + b * LC;
    __syncthreads();
    for (int idx = tid; idx < LC * 32; idx += 512) {
      { const int t = idx >> 5, cc = idx & 31; Zs[t * LP + cc] = b2f(p.Z()[(size_t)(rbase + t) * 512 + c0 + cc]); }
      { const int cc = idx / LC, t = idx % LC;
        Ff[t * LP + cc] = p.F()[(size_t)(c0 + cc) * (N + LC) + N + t]; Fb[t * LP + cc] = p.F()[(size_t)(512 + c0 + cc) * (N + LC) + N + t]; }
    }
    __syncthreads();
    float ss = 0.f;
    for (int t = 0; t < LC; ++t) { const float a = Ff[t * LP + c], bb = Fb[t * LP + c]; ss += a * a + bb * bb; }
    const float fn = 1.0f / sqrtf(ss + EPS);
    const int cg_ = c0 + c;
    const float w0 = cw[cg_], w1 = cw[1536 + cg_], w2 = cw[2 * 1536 + cg_], cb0 = cbv[cg_], skip = p.in[I_hy_skip][l * 512 + cg_];
    for (int t = tp * TLEN + t0; t < (tp + 1) * TLEN; t += 16) {
      float acc = 0.f;
      for (int s_ = 0; s_ <= t; ++s_) acc += Ff[(t - s_) * LP + c] * Zs[s_ * LP + c];
      for (int s_ = t + 1; s_ < LC; ++s_) acc += Fb[(s_ - t) * LP + c] * Zs[s_ * LP + c];
      const size_t r = (size_t)(rbase + t);
      float x0 = cb0 + w1 * b2f(p.P()[r * PC + C_HU + cg_]);
      if (t > 0) x0 += w0 * b2f(p.P()[(r - 1) * PC + C_HU + cg_]);
      if (t < LC - 1) x0 += w2 * b2f(p.P()[(r + 1) * PC + C_HU + cg_]);
      p.Y()[r * 2048 + 1024 + cg_] = f2b(x0 * (acc * fn + skip * Zs[t * LP + c]));
    }
  }
}
#endif

constexpr int NOSH = 30;

#ifndef CPU_SIM
#define SIDE_PREP(NB0, PARTS) do { if (l == 0 && (int)blockIdx.x >= (NB0)) { PrepCtx pc; pc.tid = cx.tid; pc.tl = (float*)cx.ldsg; pc.rank = (int)blockIdx.x - (NB0); pc.nranks = (int)gridDim.x - (NB0); \
    ph_prep(p, 1, pc, gtid - (NB0) * 512, gsz - (NB0) * 512, (PARTS)); } } while (0)
#else
#define SIDE_PREP(NB0, PARTS)
#endif
DEV void run_phase(const Params& p, int ph, const Ctx& cx) {
  const i64 gtid = cx.gtid, gsz = cx.gsz;
  if (ph == 0) { ph_init(p, gtid, gsz); return; }
  if (ph == NPHASES - 1) { ph_final(p, gtid, gsz); return; }
  const int l = (ph - 1) / PH_PER_LAYER, s = (ph - 1) % PH_PER_LAYER;
  const int last = (l == 1);
  const int nr = last ? NLAT : TT;
#ifdef ONLY
  if (s != ONLY) return;
#endif
  switch (s) {
    case 0: {
      PrepCtx pc;
#ifndef CPU_SIM
      pc.tid = cx.tid; pc.tl = (float*)cx.ldsg; pc.rank = (int)blockIdx.x; pc.nranks = (int)gridDim.x;
      if (l == 0) ph_prep(p, l, pc, gtid, gsz, 15); else ph_prep(p, l, pc, gtid, gsz, 8);
#else
      pc.gtid = gtid; pc.gsz = gsz;
      ph_prep(p, l, pc, gtid, gsz, 15);
#endif
      ph_norm(p, l, 0, TT, gtid, gsz);
    } break;
    case 1: { GemmDesc g{p.h(), p.W_in(), D, D, D, TT, 3840, NOSH, 0}; EpiInproj e{p}; run_gemm(cx, g, e); } break;
#ifndef CPU_SIM
    case 2: ph_B0(p, l, gtid, gsz, cx.ldsg, cx.tid); break;
#else
    case 2: ph_B0(p, l, gtid, gsz); break;
#endif
    case 3: {
      { const int n_uq = (nr / 256) * 3, n_ukv = (TT / 256) * 4, n_lru = (TT / 256) * 8;
        { GemmDesc g{p.P() + C_CQ, p.W_uq(), PC, 256, 256, nr, 768, NOSH, 0}; EpiUq e{p}; run_gemm(cx, g, e); }
        { GemmDesc g{p.P() + C_CKV, p.W_ukv(), PC, 256, 256, TT, 1024, NOSH, 0}; g.unit_off = n_uq; EpiUkv e{p}; run_gemm(cx, g, e); }
        { GemmDesc g{p.XC(), p.W_lru(), 512, 256, 256, TT, 2048, 2, 256}; g.unit_off = n_uq + n_ukv; EpiLru e{p, l}; run_gemm(cx, g, e); }
#ifndef CPU_SIM
        { GemmDesc g{p.W3T(), p.hdn2b() + (size_t)l * (N + LC) * 256, 256, 256, 256, 1024, N + LC, NOSH, 0}; g.unit_off = n_uq + n_ukv + n_lru; EpiFilt e{p}; run_gemm(cx, g, e); }
#endif
      }
#ifdef CPU_SIM
      ph_fnorm(p, gtid, gsz);
#endif
    } break;
    case 4:
      ph_lru1(p, gtid, gsz);
#ifndef CPU_SIM
#if PROBE_K >= 0
#define SUBSTAMP(k) do { cg::this_grid().sync(); if (l == 0) { const unsigned long long t_ = wall_clock64(); if (blockIdx.x == 0 && cx.tid == 0) ((unsigned long long*)(p.ws + WL.ts))[40 + (k)] = t_; } } while (0)
#else
#define SUBSTAMP(k)
#endif
      if (REPEAT_S == 40) ph_lru1(p, gtid, gsz);
      SUBSTAMP(0);
      ph_hyena_fft(p, cx, l);
      if (REPEAT_S == 41) ph_hyena_fft(p, cx, l);
      SUBSTAMP(1);
      ph_gqa(p, cx, l, last);
      if (REPEAT_S == 42) ph_gqa(p, cx, l, last);
      SUBSTAMP(2);
      ph_mla(p, cx, last);
      if (REPEAT_S == 43) ph_mla(p, cx, last);
      SUBSTAMP(3);
      if (!last) ph_hyena_ctx(p, cx, l);
      if (REPEAT_S == 44 && !last) ph_hyena_ctx(p, cx, l);
#else
      ph_C(p, l, last, gtid, gsz);
#endif
      break;
#ifndef CPU_SIM
    case 5: ph_lru3(p, last, gtid, gsz, (float*)cx.ldsg, cx.tid); __syncthreads(); tz::xyt_to_y(p, cx.tid, cx.ldsg); break;
#else
    case 5: ph_lru3(p, last, gtid, gsz, nullptr, 0); break;
#endif
    case 6: { GemmDesc g{p.h(), p.W_g(), D, D, D, nr, 4096, NOSH, 0}; EpiGateAll e{p}; run_gemm(cx, g, e); } break;
    case 7: { GemmDesc g{p.Y(), p.W_br(), 2048, 512, 512, nr, 1024, NOSH, 0, 4, 512, 1024 * 512}; EpiBranchSub e{p}; run_gemm(cx, g, e); }
      SIDE_PREP(8, 1);
      break;
    case 8: { GemmDesc g{p.M(), p.W_out(), D, D, D, nr, 1024, NOSH, 0}; EpiOut e{p, l}; run_gemm(cx, g, e); if (REPEAT_S == 48) { EpiOut e0{p, l, 0.0f}; run_gemm(cx, g, e0); } }
#ifndef CPU_SIM
      if (l == 0 && blockIdx.x >= 8) ph_cvt_tables(p, l, gtid - 8 * 512, gsz - 8 * 512);
#endif
      break;
    case 9:
#ifndef CPU_SIM
      if (l != 0) ph_cvt_tables(p, l, gtid, gsz);
#endif
      ph_norm(p, l, 1, nr, gtid, gsz); break;
    case 10: { GemmDesc g{p.h(), p.W_q(), D, D, D, nr, 1024, NOSH, 0}; EpiPQ e{p}; run_gemm(cx, g, e); }
      SIDE_PREP(8, 2);
      break;
    case 11: { GemmDesc g{p.PQ(), p.W_key(), 1024, 256, 256, nr, 2048, 1, 256}; EpiSC e{p}; run_gemm(cx, g, e); }
      SIDE_PREP(16, 4);
      break;
#ifndef CPU_SIM
    case 12: ph_peer(p, l, nr, cx.tid, cx.ldsg); if (REPEAT_S == 52) { __syncthreads(); ph_peer(p, l, nr, cx.tid, cx.ldsg, 0.0f); } break;
#else
    case 12: ph_E2a(p, nr, gtid, gsz); break;
    case 13: ph_E2b(p, nr, gtid, gsz); break;
    case 14: ph_E3(p, l, nr, gtid, gsz); break;
    case 15: ph_E4(p, l, nr, gtid, gsz); break;
#endif
  }
}

#ifdef CPU_SIM
static void fill_params(Params& p, void* const* d_in, void* d_out, void* d_ws) {
  p.in = (const float* const*)d_in;
  p.out = (float*)d_out;
  p.ws = (char*)d_ws;
}
#endif


#ifndef CPU_SIM
#define XB_TMO      128
#define XB_XCNT(j)  (256  + 64 * (j))
#define XB_XSUB(j)  (1280 + 64 * (j))
#define XB_XGEN(j)  (2304 + 64 * (j))
#define XB_TOP      3328
#define XB_TOPGEN   3392
#define XCD_BAR_WORDS 3456
#define XB_SPIN_CAP (1u << 18)
#define XB_LAS __attribute__((address_space(3)))
__device__ __forceinline__ unsigned xb_ld(unsigned* p)              { return __hip_atomic_load(p, __ATOMIC_RELAXED, __HIP_MEMORY_SCOPE_AGENT); }
__device__ __forceinline__ unsigned xb_add(unsigned* p, unsigned v) { return __hip_atomic_fetch_add(p, v, __ATOMIC_RELAXED, __HIP_MEMORY_SCOPE_AGENT); }
__device__ __forceinline__ unsigned xb_xcc_id() { return (unsigned)__builtin_amdgcn_s_getreg((3 << 11) | 20) & 0xFu; }
#define XB_SPIN(cond, bar) do { unsigned _sp = 0; while (cond) { __builtin_amdgcn_s_sleep(1); \
    if ((++_sp & 255u) == 0u) { if (xb_ld(&(bar)[XB_TMO])) break; if (_sp > XB_SPIN_CAP) { atomicAdd(&(bar)[XB_TMO], 1u); break; } } } } while (0)
struct XcdBarrier { unsigned* bar; unsigned x; volatile XB_LAS unsigned* st; };
__device__ __forceinline__ XcdBarrier xcd_barrier_post(unsigned* bar, volatile XB_LAS unsigned* st) {
  XcdBarrier b; b.bar = bar; b.x = xb_xcc_id(); b.st = st;
  if (threadIdx.x == 0) (void)xb_add(&bar[XB_XCNT(b.x)], 1u);
  return b;
}
__device__ __forceinline__ void xcd_barrier_complete(unsigned* bar, unsigned x, unsigned& nloc, unsigned& nx) {
  const unsigned G = gridDim.x * gridDim.y * gridDim.z;
  unsigned sum, cnt, mine, sp = 0u;
  for (;;) {
    sum = 0u; cnt = 0u; mine = 0u;
#pragma unroll
    for (unsigned j = 0; j < 16; ++j) { const unsigned c = xb_ld(&bar[XB_XCNT(j)]); sum += c; cnt += (c > 0u) ? 1u : 0u; mine = (j == x) ? c : mine; }
    if (sum == G) break;
    __builtin_amdgcn_s_sleep(1);
    if ((++sp & 255u) == 0u) { if (xb_ld(&bar[XB_TMO])) break; if (sp > XB_SPIN_CAP) { atomicAdd(&bar[XB_TMO], 1u); break; } }
  }
  nloc = mine > 0u ? mine : 1u; nx = cnt > 0u ? cnt : 1u;
}
__device__ __forceinline__ void xcd_barrier(const XcdBarrier& b) {
  asm volatile("s_waitcnt vmcnt(0)" ::: "memory");
  __syncthreads();
  if (threadIdx.x == 0) {
    unsigned* bar = b.bar;
    __builtin_amdgcn_s_waitcnt(0);
    unsigned nloc = b.st[0], nx = b.st[1];
    if (nloc == 0u) { xcd_barrier_complete(bar, b.x, nloc, nx); b.st[0] = nloc; b.st[1] = nx; }
    const unsigned old = xb_add(&bar[XB_XSUB(b.x)], 1u);
    const unsigned gen = old / nloc;
    if (old + 1u == (gen + 1u) * nloc) {
      __builtin_amdgcn_fence(__ATOMIC_RELEASE, "agent");
      asm volatile("s_waitcnt vmcnt(0)" ::: "memory");
      const unsigned og = xb_add(&bar[XB_TOP], 1u);
      const unsigned tg = og / nx;
      if (og + 1u == (tg + 1u) * nx) xb_add(&bar[XB_TOPGEN], 1u);
      else XB_SPIN(xb_ld(&bar[XB_TOPGEN]) == tg, bar);
      __builtin_amdgcn_fence(__ATOMIC_ACQUIRE, "agent");
      xb_add(&bar[XB_XGEN(b.x)], 1u);
      asm volatile("s_waitcnt vmcnt(0)" ::: "memory");
    } else {
      XB_SPIN(xb_ld(&bar[XB_XGEN(b.x)]) == gen, bar);
      __builtin_amdgcn_fence(__ATOMIC_ACQUIRE, "agent");
      asm volatile("s_waitcnt vmcnt(0)" ::: "memory");
    }
  }
  __syncthreads();
}
#endif

#ifndef CPU_SIM
static_assert(TT % 256 == 0 && NLAT % 256 == 0 && (N + LC) % 256 == 0, "row / column tiles");
static_assert(N / 256 == 32 && NB * 8 * (N / 256) == 512, "attention unit mapping assumes 32 q-blocks per (batch, head) and a 256-block grid");
constexpr int LDS_PHASE_BYTES = 131072 + 4096;
constexpr int LDS_BYTES = LDS_PHASE_BYTES + 16;
__global__ void __launch_bounds__(512, 2) mega_kernel(KArgs ka) {
  extern __shared__ __attribute__((aligned(16))) unsigned char shm[];
  cg::grid_group grid = cg::this_grid();
#if PROBE_K >= 0
  unsigned long long* const tsp = (unsigned long long*)(ka.ws + WL.ts);
#endif
  {
    int tid = threadIdx.x;
    asm volatile("" : "+v"(tid));
    const i64 gtid = (i64)blockIdx.x * 512 + tid, gsz = (i64)gridDim.x * 512;
    ph_init(ka, gtid, gsz, (char*)shm, tid);
    if (gtid < N_IN) ((const float**)(ka.ws + WL.tbl))[gtid] = ka.in[gtid];
#if PROBE_K >= 0
    { const unsigned long long t_ = wall_clock64(); if (gtid == 0) tsp[0] = t_; }
#endif
  }
  volatile XB_LAS unsigned* xst = (volatile XB_LAS unsigned*)(shm + LDS_PHASE_BYTES);
  if (threadIdx.x == 0) { xst[0] = 0u; xst[1] = 0u; }
  __syncthreads();
  const XcdBarrier xb = xcd_barrier_post((unsigned*)(ka.ws + WL.bar), xst);
  grid.sync();
#if PROBE_K >= 0
  { const unsigned long long t_ = wall_clock64(); if (blockIdx.x == 0 && threadIdx.x == 0) tsp[1] = t_; }
#endif
  Params p; p.out = ka.out; p.ws = ka.ws; p.in = (const float* const*)(ka.ws + WL.tbl);
  for (int ph = 1; ph < NPHASES - 1; ++ph) {
    int tid = threadIdx.x;
    asm volatile("" : "+v"(tid));
    Ctx cx;
    cx.tid = tid;
    cx.gtid = (i64)blockIdx.x * 512 + tid; cx.gsz = (i64)gridDim.x * 512;
    cx.lds = (PG8_LAS unsigned char*)shm; cx.ldsg = (char*)shm;
    run_phase(p, ph, cx);
    if (REPEAT_S >= 0 && REPEAT_S < 40 && (ph - 1) % PH_PER_LAYER == REPEAT_S) { __syncthreads(); run_phase(p, ph, cx); }
    xcd_barrier(xb);
#if PROBE_K >= 0
    { const unsigned long long t_ = wall_clock64(); if (blockIdx.x == 0 && threadIdx.x == 0) tsp[ph + 1] = t_; }
    if (ph == NPHASES - 2) grid.sync();
#endif
  }
  {
    int tid = threadIdx.x;
    asm volatile("" : "+v"(tid));
    ph_final(p, (i64)blockIdx.x * 512 + tid, (i64)gridDim.x * 512);
  }
}

extern "C" void kernel_launch(void* const* d_in, const int* in_sizes, int n_in, void* d_out, int out_size,
                              void* d_ws, size_t ws_size, hipStream_t stream) {
  static int grid_blocks = 0;
  if (!grid_blocks) {
    int dev = 0, cus = 0, per_cu = 0;
    (void)hipGetDevice(&dev);
    (void)hipDeviceGetAttribute(&cus, hipDeviceAttributeMultiprocessorCount, dev);
    if (hipFuncSetAttribute((const void*)mega_kernel, hipFuncAttributeMaxDynamicSharedMemorySize, LDS_BYTES) != hipSuccess)
      fprintf(stderr, "hipFuncSetAttribute failed\n");
    (void)hipOccupancyMaxActiveBlocksPerMultiprocessor(&per_cu, mega_kernel, 512, LDS_BYTES);
    if (per_cu > 1) per_cu = 1;
    if (per_cu < 1) per_cu = 1;
    grid_blocks = cus * per_cu;
  }
  (void)hipMemsetAsync((char*)d_ws + WL.bar, 0, (size_t)3456 * 4, stream);
  KArgs ka;
  std::memset((void*)&ka, 0, sizeof(ka));
  for (int i = 0; i < N_IN; ++i) ka.in[i] = (const float*)d_in[i];
  ka.out = (float*)d_out; ka.ws = (char*)d_ws;
  void* args[] = {&ka};
  hipError_t e = hipLaunchCooperativeKernel((void*)mega_kernel, dim3(grid_blocks), dim3(512), args, LDS_BYTES, stream);
  if (e != hipSuccess) fprintf(stderr, "cooperative launch failed: %s (grid %d)\n", hipGetErrorString(e), grid_blocks);
}
#endif
```

```cpp
#ifndef CPU_SIM
#include <hip/hip_runtime.h>
#include <hip/hip_cooperative_groups.h>
#include <cstdio>
#include <cstring>
namespace cg = cooperative_groups;
#define DEV __device__ __forceinline__
#define DEVN __device__ __forceinline__
#define MDEV __device__ __forceinline__
typedef _Float16 sc_t;
#else
#include <cmath>
#include <cstdio>
#include <cstdint>
#include <cstring>
#define DEV static inline
#define DEVN static
#define MDEV inline
typedef float sc_t;
#endif

#ifndef REPEAT_S
#define REPEAT_S -1
#endif
#ifndef PROBE_K
#define PROBE_K -1
#endif
#ifndef SEQ_N
#define SEQ_N 8192
#endif
#ifndef CTX_L
#define CTX_L 256
#endif

typedef long long i64;

constexpr int D = 1024, NB = 2, N = SEQ_N, LC = CTX_L;
constexpr int NLAT = NB * N, NCTX = NB * LC, TT = NLAT + NCTX;
constexpr int GRIDW = 64;
constexpr int INC = 7840, PC = 3840;
constexpr int C_CQ = 0, C_CKV = 256, C_KR = 384, C_LX = 416, C_LG = 928, C_HU = 1440, C_GQ = 2976, C_GKV = 3488, C_GT = 3744;
constexpr int NEXP = 16384;
constexpr float EPS = 1e-6f;
#ifndef CPU_SIM
constexpr int PH_PER_LAYER = 13;
#else
constexpr int PH_PER_LAYER = 16;
#endif
constexpr int NPHASES = 2 + 2 * PH_PER_LAYER;
constexpr int LCH = 64, NCC = LC / LCH, NCL = N / LCH, NCHK = NCC + NCL;

enum { I_x, I_c, I_ctx, I_c_ctx, I_g_mix, I_g_ffn, I_w_mod, I_b_mod, I_w_in, I_mla_g_cq, I_mla_g_ckv, I_mla_w_uq,
       I_mla_w_ukv, I_lru_conv_w, I_lru_conv_b, I_lru_w_r, I_lru_b_r, I_lru_w_i, I_lru_b_i, I_lru_lam,
       I_hy_conv_w, I_hy_conv_b, I_hy_w1, I_hy_b1, I_hy_f1, I_hy_w2, I_hy_b2, I_hy_f2, I_hy_w3, I_hy_skip,
       I_gqa_sink, I_w_branch, I_w_out, I_peer_w_q, I_peer_keys, I_peer_u, I_peer_v, I_g_final, N_IN };

struct bf { unsigned short v; };
DEV float b2f(bf x) { union { unsigned u; float f; } c; c.u = ((unsigned)x.v) << 16; return c.f; }
DEV bf f2b(float f) { union { unsigned u; float f; } c; c.f = f; unsigned r = c.u + 0x7FFFu + ((c.u >> 16) & 1u); bf o; o.v = (unsigned short)(r >> 16); return o; }


constexpr size_t al256(size_t x) { return (x + 255) & ~(size_t)255; }
struct WsLayout {
  size_t xcur, mods, hdn2, ssq, tabA, tabD, fnorm, SA, SB, tw, tbl, ts, spl, bar, hdn2b, W3T, h, Y, Z, XC, LA, LB, P, QA, KVA;
  size_t W_in, W_g, W_uq, W_ukv, W_lru, W_br, W_out, W_q, W_key;
  size_t M, Gs, G, SC, TKs, TKi, SELi, SELg, W, Ub, Vb, YT, total;
};
constexpr WsLayout make_layout() {
  WsLayout w{};
  size_t o = 0;
  w.xcur = o; o = al256(o + (size_t)TT * D * 4);
  w.mods = o; o = al256(o + (size_t)2 * 3 * 6 * D * 4);
  w.hdn2 = o; o = al256(o + (size_t)2 * (N + LC) * 64 * 4);
  w.ssq = o; o = al256(o + (size_t)2 * TT * 4);
  w.tabA = o; o = al256(o + (size_t)128 * 8 * 2 * 4);
  w.tabD = o; o = al256(o + (size_t)128 * 16 * 2 * 4);
  w.fnorm = o; o = al256(o + (size_t)2 * 512 * 4);
  w.tw = o; o = al256(o + (size_t)2 * N * 8);
  w.tbl = o; o = al256(o + (size_t)N_IN * 8);
  w.ts = o; o = al256(o + (size_t)64 * 8);
  w.spl = o; o = al256(o + (size_t)2 * 2 * 512 * 4);
  w.bar = o; o = al256(o + (size_t)3456 * 4);
  w.hdn2b = o; o = al256(o + (size_t)2 * (N + LC) * 256 * 2);
  w.W3T = o; o = al256(o + (size_t)1024 * 256 * 2);
  w.SA = o; o = al256(o + (size_t)2 * NB * NCHK * 512 * 4);
  w.SB = o; o = al256(o + (size_t)2 * NB * NCHK * 512 * 4);
  w.h = o; o = al256(o + (size_t)TT * D * 2);
  w.Y = o; w.Ub = o; w.Vb = o + (size_t)NEXP * D; o = al256(o + (size_t)TT * 2048 * 2);
  w.Z = o; o = al256(o + (size_t)TT * 512 * 2);
  w.W_in = o; o = al256(o + (size_t)3840 * 1024 * 2);
  w.W_g = o; o = al256(o + (size_t)4096 * 1024 * 2);
  w.W_uq = o; o = al256(o + (size_t)768 * 256 * 2);
  w.W_ukv = o; o = al256(o + (size_t)1024 * 256 * 2);
  w.W_lru = o; o = al256(o + (size_t)2048 * 256 * 2);
  w.W_br = o; o = al256(o + (size_t)4 * 1024 * 512 * 2);
  w.W_out = o; o = al256(o + (size_t)1024 * 1024 * 2);
  w.W_q = o; o = al256(o + (size_t)1024 * 1024 * 2);
  w.W_key = o; o = al256(o + (size_t)2048 * 256 * 2);
  size_t rl = o;
  w.XC = o; o = al256(o + (size_t)TT * 512 * 2);
  w.LA = o; o = al256(o + (size_t)2 * TT * 512 * 2);
  w.LB = o; o = al256(o + (size_t)2 * TT * 512 * 2);
  size_t rl_end = o;
  o = rl;
  w.TKs = o; o = al256(o + (size_t)TT * 256 * 4);
  w.TKi = o; o = al256(o + (size_t)TT * 256 * 4);
  w.SELi = o; o = al256(o + (size_t)TT * 128 * 4);
  w.SELg = o; o = al256(o + (size_t)TT * 128 * 4);
  w.W = o; o = al256(o + (size_t)TT * 128 * 4);
  if (o > rl_end) rl_end = o;
  o = rl_end;
  size_t rp = o;
  w.P = o; o = al256(o + (size_t)TT * PC * 2);
  w.QA = o; o = al256(o + (size_t)TT * 768 * 2);
  w.KVA = o; o = al256(o + (size_t)TT * 1024 * 2);
  size_t rp_end = o;
  o = rp;
  w.M = o; o = al256(o + (size_t)TT * D * 2);
  w.G = o; if (o + (size_t)TT * 3072 * 2 > rp_end) rp_end = o + (size_t)TT * 3072 * 2;
  w.Gs = o; o = al256(o + (size_t)TT * D * 2);
  w.SC = o; o = al256(o + (size_t)TT * 2048 * sizeof(sc_t));
  if (o > rp_end) rp_end = o;
  w.YT = rp_end; rp_end = al256(rp_end + (size_t)512 * NB * N * 2);
  w.total = rp_end;
  return w;
}
constexpr WsLayout WL = make_layout();
static_assert((size_t)TT * 4096 <= (size_t)TT * 512 * 2 + (size_t)4 * TT * 512 * 2, "uint8 gates must fit in the XC/LA/LB region");
static_assert(WL.LB == WL.LA + (size_t)2 * TT * 512 * 2, "LA and LB must be contiguous (packed GPU layout)");
static_assert(WL.total <= (size_t)512 * 1024 * 1024, "workspace too large");
#ifndef CPU_SIM
static_assert((size_t)2 * NEXP * D * 2 <= (size_t)TT * 2048 * 2, "bf16 expert tables must fit in Y");
#endif
struct WsAcc {
  float* out;
  char* ws;
  MDEV float* xcur() const { return (float*)(ws + WL.xcur); }
  MDEV float* mods() const { return (float*)(ws + WL.mods); }
  MDEV float* hdn2() const { return (float*)(ws + WL.hdn2); }
  MDEV float* ssq() const { return (float*)(ws + WL.ssq); }
  MDEV float* tabA() const { return (float*)(ws + WL.tabA); }
  MDEV float* tabD() const { return (float*)(ws + WL.tabD); }
  MDEV float* fnorm() const { return (float*)(ws + WL.fnorm); }
  MDEV float* tw() const { return (float*)(ws + WL.tw); }
  MDEV unsigned* Hs() const { return (unsigned*)((char*)out + (((size_t)(N + LC) * 1024 * 4 + 255) & ~(size_t)255)); }
  MDEV float* spl() const { return (float*)(ws + WL.spl); }
  MDEV bf* XYT() const { return (bf*)((char*)out + (((size_t)(N + LC) * 1024 * 4 + 255) & ~(size_t)255)); }
  MDEV bf* hdn2b() const { return (bf*)(ws + WL.hdn2b); }
  MDEV bf* W3T() const { return (bf*)(ws + WL.W3T); }
  MDEV float* SA() const { return (float*)(ws + WL.SA); }
  MDEV float* SB() const { return (float*)(ws + WL.SB); }
  MDEV bf* h() const { return (bf*)(ws + WL.h); }
  MDEV bf* Y() const { return (bf*)(ws + WL.Y); }
  MDEV bf* Z() const { return (bf*)(ws + WL.Z); }
  MDEV bf* XC() const { return (bf*)(ws + WL.XC); }
  MDEV bf* LA() const { return (bf*)(ws + WL.LA); }
  MDEV bf* LB() const { return (bf*)(ws + WL.LB); }
  MDEV bf* P() const { return (bf*)(ws + WL.P); }
  MDEV bf* QA() const { return (bf*)(ws + WL.QA); }
  MDEV bf* KVA() const { return (bf*)(ws + WL.KVA); }
  MDEV float* F() const { return out; }
  MDEV bf* W_in() const { return (bf*)(ws + WL.W_in); }
  MDEV bf* W_g() const { return (bf*)(ws + WL.W_g); }
  MDEV bf* W_uq() const { return (bf*)(ws + WL.W_uq); }
  MDEV bf* W_ukv() const { return (bf*)(ws + WL.W_ukv); }
  MDEV bf* W_lru() const { return (bf*)(ws + WL.W_lru); }
  MDEV bf* W_br() const { return (bf*)(ws + WL.W_br); }
  MDEV bf* W_out() const { return (bf*)(ws + WL.W_out); }
  MDEV bf* W_q() const { return (bf*)(ws + WL.W_q); }
  MDEV bf* W_key() const { return (bf*)(ws + WL.W_key); }
  MDEV bf* M() const { return (bf*)(ws + WL.M); }
  MDEV bf* Gs() const { return (bf*)(ws + WL.Gs); }
  MDEV bf* PQ() const { return (bf*)(ws + WL.Gs); }
  MDEV bf* BR() const { return (bf*)(ws + WL.G); }
  MDEV unsigned char* G8() const { return (unsigned char*)(ws + WL.XC); }
  MDEV unsigned* LAB() const { return (unsigned*)(ws + WL.LA); }
  MDEV bf* YT() const { return (bf*)(ws + WL.YT); }
  MDEV sc_t* SC() const { return (sc_t*)(ws + WL.SC); }
  MDEV float* TKs() const { return (float*)(ws + WL.TKs); }
  MDEV int* TKi() const { return (int*)(ws + WL.TKi); }
  MDEV int* SELi() const { return (int*)(ws + WL.SELi); }
  MDEV float* SELg() const { return (float*)(ws + WL.SELg); }
  MDEV float* W() const { return (float*)(ws + WL.W); }
  MDEV bf* Ub() const { return (bf*)(ws + WL.Ub); }
  MDEV bf* Vb() const { return (bf*)(ws + WL.Vb); }
};
struct KArgs : WsAcc { const float* in[N_IN]; };
#ifndef CPU_SIM
typedef float v4f_gl __attribute__((ext_vector_type(4)));
DEV float4 gld4(const void* q) { const v4f_gl r = *(const __attribute__((address_space(1))) v4f_gl*)q; return float4{r.x, r.y, r.z, r.w}; }
DEV float gld1(const float* q) { return *(const __attribute__((address_space(1))) float*)q; }
#else
DEV float gld1(const float* q) { return *q; }
#endif
struct InTab {
  const float* const* t;
#ifndef CPU_SIM
  MDEV const float* operator[](int i) const { return t[i]; }
#else
  MDEV const float* operator[](int i) const { return t[i]; }
#endif
};
struct Params : WsAcc { InTab in; };
static_assert((size_t)(N + LC) * 1024 * 4 + 256 + (size_t)256 * 2 * N * 4 <= (size_t)NLAT * D * 4, "F + spectrum scratch must fit in d_out");

#ifndef CPU_SIM
DEV float fexpf_(float x) { return __builtin_amdgcn_exp2f(x * 1.4426950408889634f); }
DEV float sigmoidf_(float x) { return __builtin_amdgcn_rcpf(1.0f + __builtin_amdgcn_exp2f(-x * 1.4426950408889634f)); }
DEV float siluf_(float x) { return x * sigmoidf_(x); }
DEV float geluf_(float x) { return x * sigmoidf_(1.5957691216057308f * (x + 0.044715f * x * x * x)); }
#else
DEV float fexpf_(float x) { return expf(x); }
DEV float sigmoidf_(float x) { return 1.0f / (1.0f + expf(-x)); }
DEV float siluf_(float x) { return x * sigmoidf_(x); }
DEV float geluf_(float x) { return 0.5f * x * (1.0f + tanhf(0.7978845608028654f * (x + 0.044715f * x * x * x))); }
#endif
DEV float softplusf_(float x) { return x > 20.f ? x : log1pf(expf(x)); }

#ifndef CPU_SIM
DEV float lane_xor(float v, int lane, int o) { return __int_as_float(__builtin_amdgcn_ds_bpermute(((lane ^ o) & 63) << 2, __float_as_int(v))); }
#endif
#ifndef CPU_SIM
DEV void unpack8(const uint4 w, float* f) {
  union { unsigned u; float x; } c;
  c.u = w.x << 16; f[0] = c.x; c.u = w.x & 0xFFFF0000u; f[1] = c.x; c.u = w.y << 16; f[2] = c.x; c.u = w.y & 0xFFFF0000u; f[3] = c.x;
  c.u = w.z << 16; f[4] = c.x; c.u = w.z & 0xFFFF0000u; f[5] = c.x; c.u = w.w << 16; f[6] = c.x; c.u = w.w & 0xFFFF0000u; f[7] = c.x;
}
#endif
struct RowInfo { int b, t, L, base, lat; };
DEV RowInfo rowinfo(int r) {
  RowInfo ri;
  if (r < NLAT) { ri.b = r / N; ri.t = r - ri.b * N; ri.L = N; ri.base = ri.b * N; ri.lat = 1; }
  else { int rc = r - NLAT; ri.b = rc / LC; ri.t = rc - ri.b * LC; ri.L = LC; ri.base = NLAT + ri.b * LC; ri.lat = 0; }
  return ri;
}
DEV int modrow(int r) { return r < NLAT ? r / N : 2; }
template <class PT> DEV const float* xin_row(const PT& p, int r) { return r < NLAT ? p.in[I_x] + (size_t)r * D : p.in[I_ctx] + (size_t)(r - NLAT) * D; }

DEV void atomic_addf(float* p, float v) {
#ifndef CPU_SIM
  atomicAdd(p, v);
#else
#pragma omp atomic
  *p += v;
#endif
}
DEV void store8bf(bf* dst, const float* v) {
#ifndef CPU_SIM
  uint4 w;
  asm volatile("v_cvt_pk_bf16_f32 %0, %1, %2" : "=v"(w.x) : "v"(v[0]), "v"(v[1]));
  asm volatile("v_cvt_pk_bf16_f32 %0, %1, %2" : "=v"(w.y) : "v"(v[2]), "v"(v[3]));
  asm volatile("v_cvt_pk_bf16_f32 %0, %1, %2" : "=v"(w.z) : "v"(v[4]), "v"(v[5]));
  asm volatile("v_cvt_pk_bf16_f32 %0, %1, %2" : "=v"(w.w) : "v"(v[6]), "v"(v[7]));
  *(uint4*)dst = w;
#else
  for (int j = 0; j < 8; ++j) dst[j] = f2b(v[j]);
#endif
}
#ifndef CPU_SIM
DEV unsigned pk2bf(float lo, float hi) { unsigned r; asm volatile("v_cvt_pk_bf16_f32 %0, %1, %2" : "=v"(r) : "v"(lo), "v"(hi)); return r; }
#endif
DEV void load8bf(const bf* src, float* v) {
#ifndef CPU_SIM
  uint4 w = *(const uint4*)src;
  union { unsigned u; float f; } c;
  c.u = w.x << 16; v[0] = c.f; c.u = w.x & 0xFFFF0000u; v[1] = c.f;
  c.u = w.y << 16; v[2] = c.f; c.u = w.y & 0xFFFF0000u; v[3] = c.f;
  c.u = w.z << 16; v[4] = c.f; c.u = w.z & 0xFFFF0000u; v[5] = c.f;
  c.u = w.w << 16; v[6] = c.f; c.u = w.w & 0xFFFF0000u; v[7] = c.f;
#else
  for (int j = 0; j < 8; ++j) v[j] = b2f(src[j]);
#endif
}

DEV int win_src(int n) {
  if (n >= 3744) return -1;
  if (n >= C_KR && n < C_KR + 32) { int q = n - C_KR; int pi = q >> 1, wh = q & 1, half = pi >> 3, f = pi & 7; return C_KR + half * 16 + f + wh * 8; }
  if (n >= C_GQ && n < C_GKV + 128) { int q = n - C_GQ; int hh = q >> 6, d = q & 63; int pi = d >> 1, wh = d & 1, half = pi >> 4, f = pi & 15; return C_GQ + hh * 64 + half * 32 + f + wh * 16; }
  return n;
}
DEV int wuq_src(int n) {
  int hh = n / 96, d = n % 96;
  if (d < 64) return n;
  int q = d - 64; int pi = q >> 1, wh = q & 1, half = pi >> 3, f = pi & 7;
  return hh * 96 + 64 + half * 16 + f + wh * 8;
}

template <class PT> DEVN void ph_init(const PT& p, i64 gtid, i64 gsz, char* ilds = nullptr, int itid = 0) {
#ifndef CPU_SIM
  {
    float* sl = (float*)ilds;
    for (int q = itid; q < 3 * D; q += 512) { const int rr = q / D, k = q - rr * D; sl[q] = siluf_(rr < 2 ? p.in[I_c][rr * D + k] : p.in[I_c_ctx][k]); }
    __syncthreads();
    float* red3 = sl + 3 * D;
    const int wv_ = itid >> 6, ln_ = itid & 63;
    for (int task = blockIdx.x; task < 2 * 6 * D / 64; task += gridDim.x) {
      const int l = task / (6 * D / 64), j = (task % (6 * D / 64)) * 64 + ln_;
      const float* w = p.in[I_w_mod] + (size_t)l * D * 6 * D + j;
      float a0 = 0.f, a1 = 0.f, a2 = 0.f;
#pragma unroll 1
      for (int k0 = wv_ * 128; k0 < wv_ * 128 + 128; k0 += 16) {
        float wv[16];
#pragma unroll
        for (int q = 0; q < 16; ++q) wv[q] = w[(size_t)(k0 + q) * 6 * D];
#pragma unroll
        for (int q = 0; q < 16; ++q) { a0 += sl[k0 + q] * wv[q]; a1 += sl[D + k0 + q] * wv[q]; a2 += sl[2 * D + k0 + q] * wv[q]; }
      }
      __syncthreads();
      red3[(wv_ * 3 + 0) * 64 + ln_] = a0; red3[(wv_ * 3 + 1) * 64 + ln_] = a1; red3[(wv_ * 3 + 2) * 64 + ln_] = a2;
      __syncthreads();
      if (itid < 192) {
        const int v3 = itid >> 6, jj = itid & 63;
        float sum = p.in[I_b_mod][l * 6 * D + (task % (6 * D / 64)) * 64 + jj];
#pragma unroll
        for (int w8 = 0; w8 < 8; ++w8) sum += red3[(w8 * 3 + v3) * 64 + jj];
        p.mods()[((size_t)l * 3 + v3) * 6 * D + (task % (6 * D / 64)) * 64 + jj] = sum;
      }
    }
    __syncthreads();
  }
  {
    float* h1 = (float*)ilds;
    for (i64 i = gtid; i < (i64)2 * (N + LC); i += gsz) {
      const int l = (int)(i / (N + LC)), tt = (int)(i % (N + LC));
      int t, L; if (tt < N) { t = tt; L = N; } else { t = tt - N; L = LC; }
      const float tn = (float)t / (float)(L - 1);
      const float wt = 6.283185307179586f * (float)t / (float)L;
      const float* w1 = p.in[I_hy_w1] + l * 33 * 64; const float* b1 = p.in[I_hy_b1] + l * 64; const float* f1 = p.in[I_hy_f1] + l * 64;
      const float* w2 = p.in[I_hy_w2] + l * 64 * 64; const float* b2 = p.in[I_hy_b2] + l * 64; const float* f2 = p.in[I_hy_f2] + l * 64;
      { uint4* zp_ = (uint4*)(p.hdn2b() + ((size_t)l * (N + LC) + tt) * 256 + 64);
#pragma unroll
        for (int q = 0; q < 24; ++q) zp_[q] = uint4{0, 0, 0, 0}; }
      float zc[16], zs[16];
#pragma unroll
      for (int bd = 0; bd < 16; ++bd) { const float ang = (1e-4f + (float)bd * ((15.0f - 1e-4f) / 15.0f)) * wt; zc[bd] = cosf(ang); zs[bd] = sinf(ang); }
#pragma unroll 1
      for (int k1 = 0; k1 < 64; ++k1) {
        float a1 = b1[k1] + tn * w1[k1];
#pragma unroll
        for (int bd = 0; bd < 16; ++bd) a1 += zc[bd] * w1[(1 + bd) * 64 + k1] - zs[bd] * w1[(17 + bd) * 64 + k1];
        h1[k1 * 512 + itid] = sinf(f1[k1] * a1);
      }
#pragma unroll 1
      for (int j0 = 0; j0 < 64; j0 += 4) {
        float c0 = b2[j0], c1 = b2[j0 + 1], c2 = b2[j0 + 2], c3 = b2[j0 + 3];
#pragma unroll 8
        for (int k1 = 0; k1 < 64; ++k1) { const float hv = h1[k1 * 512 + itid]; const float4 wv = *(const float4*)(w2 + k1 * 64 + j0); c0 += hv * wv.x; c1 += hv * wv.y; c2 += hv * wv.z; c3 += hv * wv.w; }
        bf* ot = p.hdn2b() + ((size_t)l * (N + LC) + tt) * 256 + j0;
        ot[0] = f2b(sinf(f2[j0] * c0)); ot[1] = f2b(sinf(f2[j0 + 1] * c1)); ot[2] = f2b(sinf(f2[j0 + 2] * c2)); ot[3] = f2b(sinf(f2[j0 + 3] * c3));
      }
    }
  }
#else
  for (i64 i = gtid; i < 2 * 3 * 6 * D; i += gsz) {
    int l = (int)(i / (3 * 6 * D)); int rr = (int)((i / (6 * D)) % 3); int j = (int)(i % (6 * D));
    const float* cv = rr < 2 ? p.in[I_c] + rr * D : p.in[I_c_ctx];
    const float* w = p.in[I_w_mod] + (size_t)l * D * 6 * D;
    float acc = p.in[I_b_mod][l * 6 * D + j];
    for (int k = 0; k < D; ++k) acc += siluf_(cv[k]) * w[(size_t)k * 6 * D + j];
    p.mods()[i] = acc;
  }
  for (i64 i = gtid; i < (i64)2 * (N + LC) * 64; i += gsz) {
    int l = (int)(i / ((i64)(N + LC) * 64)); int tt = (int)((i / 64) % (N + LC)); int j2 = (int)(i % 64);
    int t, L; if (tt < N) { t = tt; L = N; } else { t = tt - N; L = LC; }
    float tn = (float)t / (float)(L - 1);
    float wt = 6.283185307179586f * (float)t / (float)L;
    const float* w1 = p.in[I_hy_w1] + l * 33 * 64; const float* b1 = p.in[I_hy_b1] + l * 64; const float* f1 = p.in[I_hy_f1] + l * 64;
    const float* w2 = p.in[I_hy_w2] + l * 64 * 64; const float* b2 = p.in[I_hy_b2] + l * 64; const float* f2 = p.in[I_hy_f2] + l * 64;
    float acc2 = b2[j2];
    for (int k1 = 0; k1 < 64; ++k1) {
      float a1 = b1[k1] + tn * w1[k1];
      for (int bd = 0; bd < 16; ++bd) {
        float band = 1e-4f + (float)bd * ((15.0f - 1e-4f) / 15.0f);
        float ang = band * wt;
        a1 += cosf(ang) * w1[(1 + bd) * 64 + k1] - sinf(ang) * w1[(17 + bd) * 64 + k1];
      }
      acc2 += sinf(f1[k1] * a1) * w2[k1 * 64 + j2];
    }
    p.hdn2()[i] = sinf(f2[j2] * acc2);
  }
#endif
#ifdef CPU_SIM
  for (i64 i = gtid; i < 2 * N; i += gsz) {
    double a = 6.283185307179586476925 * (double)i / (double)(2 * N);
    p.tw()[i * 2] = (float)cos(a); p.tw()[i * 2 + 1] = (float)-sin(a);
  }
#endif
  for (i64 i = gtid; i < 2 * 2 * 512; i += gsz) p.spl()[i] = softplusf_(-p.in[I_lru_lam][i]);
  for (i64 i = gtid; i < 128 * 8; i += gsz) {
    int pos = (int)(i / 8), f = (int)(i % 8);
    float ang = (float)pos * powf(10000.0f, -(float)f / 8.0f);
    p.tabA()[i * 2] = cosf(ang); p.tabA()[i * 2 + 1] = sinf(ang);
  }
  for (i64 i = gtid; i < 128 * 16; i += gsz) {
    int pos = (int)(i / 16), f = (int)(i % 16);
    float ang = (float)pos * powf(10000.0f, -(float)f / 16.0f);
    p.tabD()[i * 2] = cosf(ang); p.tabD()[i * 2 + 1] = sinf(ang);
  }
}

#ifndef CPU_SIM
template <class F> DEV void xpose_tiles(bf* dst, int K, int NN, const F& val, int tid, float* tl, int& xoff, int rank, int nranks) {
  const int tk = K / 64, tn = NN / 64;
  const int t0 = (rank + nranks - xoff % nranks) % nranks;
  xoff += tk * tn;
  for (int t = t0; t < tk * tn; t += nranks) {
    const int k0 = (t / tn) * 64, n0 = (t % tn) * 64;
    __syncthreads();
#pragma unroll
    for (int i = 0; i < 8; ++i) { const int kk = (tid >> 6) + 8 * i, nn = tid & 63; tl[nn * 65 + kk] = val(k0 + kk, n0 + nn); }
    __syncthreads();
#pragma unroll
    for (int i = 0; i < 8; ++i) { const int nn = (tid >> 6) + 8 * i, kk = tid & 63; dst[(size_t)(n0 + nn) * K + k0 + kk] = f2b(tl[nn * 65 + kk]); }
  }
}
#else
template <class F> static void xpose_tiles(bf* dst, int K, int NN, const F& val, i64 gtid, i64 gsz) {
  for (i64 i = gtid; i < (i64)K * NN; i += gsz) { int k = (int)(i / NN), n = (int)(i % NN); dst[(size_t)n * K + k] = f2b(val(k, n)); }
}
#endif
struct PrepCtx {
#ifndef CPU_SIM
  int tid; float* tl; int rank, nranks;
#else
  i64 gtid, gsz;
#endif
};
#ifndef CPU_SIM
#define XPOSE(dst, K, NN, val) xpose_tiles(dst, K, NN, val, pc.tid, pc.tl, xoff, pc.rank, pc.nranks)
#else
#define XPOSE(dst, K, NN, val) xpose_tiles(dst, K, NN, val, pc.gtid, pc.gsz)
#endif
DEVN void ph_prep(const Params& p, int l, const PrepCtx& pc, i64 gtid, i64 gsz, const int parts) {
  int xoff = 0; (void)xoff;
  if (parts & 1) {
    const float* w = p.in[I_w_in] + (size_t)l * D * INC;
    XPOSE(p.W_in(), 1024, 3840, [=](int k, int n) { int s_ = win_src(n); return s_ < 0 ? 0.f : w[(size_t)k * INC + s_]; });
    XPOSE(p.W_g(), 1024, 4096, [=](int k, int n) { return w[(size_t)k * INC + C_GT + n]; });
  }
  if (parts & 1) {
    const float* w = p.in[I_mla_w_uq] + (size_t)l * 256 * 768; const float* g = p.in[I_mla_g_cq] + l * 256;
    XPOSE(p.W_uq(), 256, 768, [=](int k, int n) { return g[k] * w[(size_t)k * 768 + wuq_src(n)]; });
  }
  if (parts & 1) {
    const float* w = p.in[I_mla_w_ukv] + (size_t)l * 128 * 1024; const float* g = p.in[I_mla_g_ckv] + l * 128;
    XPOSE(p.W_ukv(), 256, 1024, [=](int k, int n) { return k < 128 ? g[k] * w[(size_t)k * 1024 + n] : 0.f; });
  }
  if (parts & 2) {
    const float* w = p.in[I_w_branch] + (size_t)l * 4 * 512 * D;
    for (int br = 0; br < 4; ++br) { const float* wb = w + (size_t)br * 512 * D; XPOSE(p.W_br() + (size_t)br * 1024 * 512, 512, 1024, [=](int k, int n) { return wb[(size_t)k * D + n]; }); }
  }
  if (parts & 2) {
    const float* w = p.in[I_w_out] + (size_t)l * D * D;
    XPOSE(p.W_out(), 1024, 1024, [=](int k, int n) { return w[(size_t)k * D + n]; });
  }
  if (parts & 4) {
    const float* wq = p.in[I_peer_w_q] + (size_t)l * D * 1024;
    XPOSE(p.W_q(), 1024, 1024, [=](int k, int n) { return wq[(size_t)k * 1024 + n]; });
  }
#ifndef CPU_SIM
  if (parts & 1) {
    const float* w3 = p.in[I_hy_w3] + (size_t)l * 64 * 1024;
    XPOSE(p.W3T(), 256, 1024, [=](int k, int n) { return k < 64 ? w3[(size_t)k * 1024 + n] : 0.f; });
  }
#endif
  if (parts & 1) {
    for (i64 i = gtid; i < 2048 * 256; i += gsz) {
      int n = (int)(i / 256), k = (int)(i % 256);
      int kw = n >> 10, dir = (n >> 9) & 1, blk4 = (n >> 7) & 3, jc = (n & 127) >> 1, gate = n & 1;
      float v = 0.f;
      if ((k >> 6) == blk4) {
        const float* wsrc = p.in[gate ? I_lru_w_i : I_lru_w_r] + ((((size_t)l * 2 + dir) * 8 + kw * 4 + blk4) * 64 + (k & 63)) * 64 + jc;
        v = *wsrc;
      }
      p.W_lru()[i] = f2b(v);
    }
  }
  if (parts & 8) {
    const float* keys = p.in[I_peer_keys] + (size_t)l * 16 * 128 * 64;
    for (i64 i = gtid; i < 2048 * 256; i += gsz) {
      int n = (int)(i / 256), k = (int)(i % 256);
      int hp = n >> 7, key = n & 127;
      float v = ((k >> 6) == (hp & 3)) ? keys[((size_t)hp * 128 + key) * 64 + (k & 63)] : 0.f;
      p.W_key()[i] = f2b(v);
    }
  }
}

DEVN void ph_norm(const Params& p, int l, int which, int nrows, i64 gtid, i64 gsz) {
  const float* g = p.in[which ? I_g_ffn : I_g_mix] + l * D;
#ifndef CPU_SIM
  const int lane = (int)(gtid & 63);
  const i64 W = gsz >> 6;
  float4 gv[4];
#pragma unroll
  for (int i = 0; i < 4; ++i) gv[i] = *(const float4*)(g + (lane + i * 64) * 4);
  for (i64 r = gtid >> 6; r < nrows; r += 2 * W) {
    const bool two = r + W < nrows;
    const i64 rb = two ? r + W : r;
    const float4* xra = (const float4*)((l == 0 && which == 0) ? xin_row(p, (int)r) : p.xcur() + (size_t)r * D);
    const float4* xrb = (const float4*)((l == 0 && which == 0) ? xin_row(p, (int)rb) : p.xcur() + (size_t)rb * D);
    const float* mda = p.mods() + ((size_t)l * 3 + modrow((int)r)) * 6 * D + (which ? 3 * D : 0);
    const float* mdb = p.mods() + ((size_t)l * 3 + modrow((int)rb)) * 6 * D + (which ? 3 * D : 0);
    float4 xa[4], xb[4], sha[4], sca[4], shb[4], scb[4]; float sa = 0.f, sb = 0.f;
#pragma unroll
    for (int i = 0; i < 4; ++i) { xa[i] = xra[lane + i * 64]; xb[i] = xrb[lane + i * 64]; }
#pragma unroll
    for (int i = 0; i < 4; ++i) { const int k = (lane + i * 64) * 4; sha[i] = *(const float4*)(mda + k); sca[i] = *(const float4*)(mda + D + k); shb[i] = *(const float4*)(mdb + k); scb[i] = *(const float4*)(mdb + D + k); }
#pragma unroll
    for (int i = 0; i < 4; ++i) { sa += xa[i].x * xa[i].x + xa[i].y * xa[i].y + xa[i].z * xa[i].z + xa[i].w * xa[i].w; sb += xb[i].x * xb[i].x + xb[i].y * xb[i].y + xb[i].z * xb[i].z + xb[i].w * xb[i].w; }
#pragma unroll
    for (int o = 32; o >= 1; o >>= 1) { sa += lane_xor(sa, lane, o); sb += lane_xor(sb, lane, o); }
    const float rsa = 1.0f / sqrtf(sa * (1.0f / D) + EPS), rsb = 1.0f / sqrtf(sb * (1.0f / D) + EPS);
#pragma unroll
    for (int i = 0; i < 4; ++i) {
      const int k = (lane + i * 64) * 4;
      uint2 w;
      w.x = pk2bf(xa[i].x * rsa * gv[i].x * (1.0f + sca[i].x) + sha[i].x, xa[i].y * rsa * gv[i].y * (1.0f + sca[i].y) + sha[i].y);
      w.y = pk2bf(xa[i].z * rsa * gv[i].z * (1.0f + sca[i].z) + sha[i].z, xa[i].w * rsa * gv[i].w * (1.0f + sca[i].w) + sha[i].w);
      *(uint2*)(p.h() + (size_t)r * D + k) = w;
    }
    if (two) {
#pragma unroll
      for (int i = 0; i < 4; ++i) {
        const int k = (lane + i * 64) * 4;
        uint2 w;
        w.x = pk2bf(xb[i].x * rsb * gv[i].x * (1.0f + scb[i].x) + shb[i].x, xb[i].y * rsb * gv[i].y * (1.0f + scb[i].y) + shb[i].y);
        w.y = pk2bf(xb[i].z * rsb * gv[i].z * (1.0f + scb[i].z) + shb[i].z, xb[i].w * rsb * gv[i].w * (1.0f + scb[i].w) + shb[i].w);
        *(uint2*)(p.h() + (size_t)rb * D + k) = w;
      }
    }
  }
#else
  for (i64 r = gtid; r < nrows; r += gsz) {
    const float* xr = (l == 0 && which == 0) ? xin_row(p, (int)r) : p.xcur() + (size_t)r * D;
    float ss = 0.f;
    for (int k = 0; k < D; ++k) ss += xr[k] * xr[k];
    float rstd = 1.0f / sqrtf(ss / D + EPS);
    const float* md = p.mods() + ((size_t)l * 3 + modrow((int)r)) * 6 * D + (which ? 3 * D : 0);
    for (int k = 0; k < D; ++k) p.h()[(size_t)r * D + k] = f2b(xr[k] * rstd * g[k] * (1.0f + md[D + k]) + md[k]);
  }
#endif
}

DEVN void ph_B0(const Params& p, int l, i64 gtid, i64 gsz, char* b0lds = nullptr, int b0tid = 0) {
#ifndef CPU_SIM
  {
    const int lane = (int)(gtid & 63);
    const i64 W = gsz >> 6;
    for (i64 r = gtid >> 6; r < TT; r += 4 * W) {
      uint2 a[4]; unsigned b[4]; i64 rr[4];
#pragma unroll
      for (int j = 0; j < 4; ++j) { rr[j] = r + j * W < TT ? r + j * W : r; const bf* pr = p.P() + (size_t)rr[j] * PC; a[j] = *(const uint2*)(pr + C_CQ + lane * 4); b[j] = *(const unsigned*)(pr + C_CKV + lane * 2); }
      float sq[4], sk[4];
#pragma unroll
      for (int j = 0; j < 4; ++j) {
        const float f0 = __uint_as_float(a[j].x << 16), f1 = __uint_as_float(a[j].x & 0xFFFF0000u), f2 = __uint_as_float(a[j].y << 16), f3 = __uint_as_float(a[j].y & 0xFFFF0000u);
        const float g0 = __uint_as_float(b[j] << 16), g1 = __uint_as_float(b[j] & 0xFFFF0000u);
        sq[j] = 0.f; sq[j] += f0 * f0; sq[j] += f1 * f1; sq[j] += f2 * f2; sq[j] += f3 * f3;
        sk[j] = 0.f; sk[j] += g0 * g0; sk[j] += g1 * g1;
      }
#pragma unroll
      for (int o = 32; o >= 1; o >>= 1) {
#pragma unroll
        for (int j = 0; j < 4; ++j) { sq[j] += lane_xor(sq[j], lane, o); sk[j] += lane_xor(sk[j], lane, o); }
      }
#pragma unroll
      for (int j = 0; j < 4; ++j) if (lane == 0 && r + j * W < TT) { p.ssq()[rr[j]] = sq[j]; p.ssq()[TT + rr[j]] = sk[j]; }
    }
  }
#else
  for (i64 r = gtid; r < TT; r += gsz) {
    const bf* pr = p.P() + (size_t)r * PC;
    float sq = 0.f, sk = 0.f;
    for (int k = 0; k < 256; ++k) { float v = b2f(pr[C_CQ + k]); sq += v * v; }
    for (int k = 0; k < 128; ++k) { float v = b2f(pr[C_CKV + k]); sk += v * v; }
    p.ssq()[r] = sq; p.ssq()[TT + r] = sk;
  }
#endif
#ifndef CPU_SIM
  {
    const float* cw = p.in[I_lru_conv_w] + l * 4 * 512; const float* cb = p.in[I_lru_conv_b] + l * 512;
    for (i64 i = gtid; i < (i64)TT * 64; i += gsz) {
      const int r = (int)(i >> 6), c8 = (int)(i & 63) * 8;
      const RowInfo ri = rowinfo(r);
      float acc[8];
      { const float4 b0 = *(const float4*)(cb + c8), b1 = *(const float4*)(cb + c8 + 4); acc[0] = b0.x; acc[1] = b0.y; acc[2] = b0.z; acc[3] = b0.w; acc[4] = b1.x; acc[5] = b1.y; acc[6] = b1.z; acc[7] = b1.w; }
      uint4 xv[4]; bool ok[4];
#pragma unroll
      for (int k = 0; k < 4; ++k) { const int ts = ri.t - 1 + k; ok[k] = ts >= 0 && ts < ri.L; xv[k] = ok[k] ? *(const uint4*)(p.P() + (size_t)(ri.base + ts) * PC + C_LX + c8) : uint4{0, 0, 0, 0}; }
#pragma unroll
      for (int k = 0; k < 4; ++k) {
        float f[8]; unpack8(xv[k], f);
        const float4 w0 = *(const float4*)(cw + k * 512 + c8), w1 = *(const float4*)(cw + k * 512 + c8 + 4);
        acc[0] += w0.x * f[0]; acc[1] += w0.y * f[1]; acc[2] += w0.z * f[2]; acc[3] += w0.w * f[3];
        acc[4] += w1.x * f[4]; acc[5] += w1.y * f[5]; acc[6] += w1.z * f[6]; acc[7] += w1.w * f[7];
      }
      store8bf(p.XC() + (size_t)r * 512 + c8, acc);
    }
  }
  {
    const float* cw = p.in[I_hy_conv_w] + l * 3 * 1536; const float* cb = p.in[I_hy_conv_b] + l * 1536;
    for (i64 i = (i64)NLAT * 64 + gtid; i < (i64)TT * 64; i += gsz) {
      const int r = (int)(i >> 6), c8 = (int)(i & 63) * 8;
      const RowInfo ri = rowinfo(r);
      float a1[8], a2[8];
#pragma unroll
      for (int j = 0; j < 8; ++j) { a1[j] = cb[512 + c8 + j]; a2[j] = cb[1024 + c8 + j]; }
#pragma unroll
      for (int k = 0; k < 3; ++k) {
        const int ts = ri.t - 1 + k; if (ts < 0 || ts >= ri.L) continue;
        const bf* pr = p.P() + (size_t)(ri.base + ts) * PC + C_HU;
        float f[8], g[8]; unpack8(*(const uint4*)(pr + 512 + c8), f); unpack8(*(const uint4*)(pr + 1024 + c8), g);
#pragma unroll
        for (int j = 0; j < 8; ++j) { a1[j] += cw[k * 1536 + 512 + c8 + j] * f[j]; a2[j] += cw[k * 1536 + 1024 + c8 + j] * g[j]; }
      }
#pragma unroll
      for (int j = 0; j < 8; ++j) a1[j] *= a2[j];
      store8bf(p.Z() + (size_t)r * 512 + c8, a1);
    }
  }
  {
    const float* cw = p.in[I_hy_conv_w] + l * 3 * 1536; const float* cb = p.in[I_hy_conv_b] + l * 1536;
    unsigned short* tz_ = (unsigned short*)b0lds; unsigned short* tx_ = tz_ + 64 * 72;
    for (int tile = blockIdx.x; tile < (NLAT / 64) * 8; tile += gridDim.x) {
      const int rt = tile >> 3, c0 = (tile & 7) * 64;
      const int tr = b0tid >> 3, cg8 = (b0tid & 7) * 8;
      const int r = rt * 64 + tr, t = r % N;
      float a0[8], a1[8], a2[8];
#pragma unroll
      for (int j = 0; j < 8; ++j) { a0[j] = cb[c0 + cg8 + j]; a1[j] = cb[512 + c0 + cg8 + j]; a2[j] = cb[1024 + c0 + cg8 + j]; }
      uint4 v0[3], v1[3], v2[3]; bool ok[3];
#pragma unroll
      for (int k = 0; k < 3; ++k) {
        const int ts = t - 1 + k; ok[k] = ts >= 0 && ts < N;
        const bf* pr = p.P() + (size_t)(r - 1 + (ok[k] ? k : 1)) * PC + C_HU + c0 + cg8;
        v0[k] = *(const uint4*)pr; v1[k] = *(const uint4*)(pr + 512); v2[k] = *(const uint4*)(pr + 1024);
      }
#pragma unroll
      for (int k = 0; k < 3; ++k) {
        if (!ok[k]) continue;
        float f0[8], f1[8], f2_[8]; unpack8(v0[k], f0); unpack8(v1[k], f1); unpack8(v2[k], f2_);
        const float* w = cw + k * 1536 + c0 + cg8;
#pragma unroll
        for (int j = 0; j < 8; ++j) { a0[j] += w[j] * f0[j]; a1[j] += w[512 + j] * f1[j]; a2[j] += w[1024 + j] * f2_[j]; }
      }
      __syncthreads();
#pragma unroll
      for (int j = 0; j < 8; ++j) { tz_[(cg8 + j) * 72 + tr] = f2b(a1[j] * a2[j]).v; tx_[(cg8 + j) * 72 + tr] = f2b(a0[j]).v; }
      __syncthreads();
      { const int cc = b0tid >> 3, tg = (b0tid & 7) * 8;
        const int bq = (rt * 64) / N, tq = (rt * 64) % N + tg;
        const size_t o = ((size_t)(c0 + cc) * NB + bq) * N + tq;
        *(uint4*)((unsigned short*)p.Z() + o) = *(const uint4*)(tz_ + cc * 72 + tg);
        *(uint4*)((unsigned short*)p.XYT() + o) = *(const uint4*)(tx_ + cc * 72 + tg); }
    }
  }
#else
  {
    const float* cw = p.in[I_lru_conv_w] + l * 4 * 512; const float* cb = p.in[I_lru_conv_b] + l * 512;
    for (i64 i = gtid; i < (i64)TT * 512; i += gsz) {
      int r = (int)(i / 512), c = (int)(i % 512);
      RowInfo ri = rowinfo(r);
      float acc = cb[c];
      for (int k = 0; k < 4; ++k) {
        int ts = ri.t - 1 + k;
        if (ts >= 0 && ts < ri.L) acc += cw[k * 512 + c] * b2f(p.P()[(size_t)(ri.base + ts) * PC + C_LX + c]);
      }
      p.XC()[i] = f2b(acc);
    }
  }
  {
    const float* cw = p.in[I_hy_conv_w] + l * 3 * 1536; const float* cb = p.in[I_hy_conv_b] + l * 1536;
    for (i64 i = gtid; i < (i64)TT * 512; i += gsz) {
      int r = (int)(i / 512), c = (int)(i % 512);
      RowInfo ri = rowinfo(r);
      float a1 = cb[512 + c], a2 = cb[1024 + c];
      for (int k = 0; k < 3; ++k) {
        int ts = ri.t - 1 + k;
        if (ts >= 0 && ts < ri.L) {
          const bf* pr = p.P() + (size_t)(ri.base + ts) * PC + C_HU;
          a1 += cw[k * 1536 + 512 + c] * b2f(pr[512 + c]);
          a2 += cw[k * 1536 + 1024 + c] * b2f(pr[1024 + c]);
        }
      }
      p.Z()[i] = f2b(a1 * a2);
    }
  }
  {
    const float* w3 = p.in[I_hy_w3] + (size_t)l * 64 * 1024;
    const float maxd = logf(1e-2f) / 0.3f, mind = logf(1e-2f) / 1.5f;
    for (i64 i = gtid; i < (i64)(N + LC) * 1024; i += gsz) {
      int tt = (int)(i / 1024), j = (int)(i % 1024);
      int t, L; if (tt < N) { t = tt; L = N; } else { t = tt - N; L = LC; }
      const float* hd = p.hdn2() + ((size_t)l * (N + LC) + tt) * 64;
      float acc = 0.f;
      for (int k = 0; k < 64; ++k) acc += hd[k] * w3[k * 1024 + j];
      float tn = (float)t / (float)(L - 1);
      float delta = mind + (float)j * ((maxd - mind) / 1023.0f);
      p.F()[i] = acc * expf(-tn * fabsf(delta));
    }
  }
#endif
}

DEVN void ph_fnorm(const Params& p, i64 gtid, i64 gsz) {
#ifndef CPU_SIM
  for (i64 i = 512 + gtid; i < 2 * 512; i += gsz) {
#else
  for (i64 i = gtid; i < 2 * 512; i += gsz) {
#endif
    int which = (int)(i / 512), c = (int)(i % 512);
    int L = which ? LC : N; int off = which ? N : 0;
    float ss = 0.f;
    for (int t = 0; t < L; ++t) { float a = p.F()[(size_t)(off + t) * 1024 + c], b = p.F()[(size_t)(off + t) * 1024 + 512 + c]; ss += a * a + b * b; }
    p.fnorm()[i] = 1.0f / sqrtf(ss + EPS);
  }
}


DEV void lru_chunk_rows(int dir, int b, int k, int& row0, int& step) {
  int seg_chunk;
  if (k < NCC) { seg_chunk = dir ? NCC - 1 - k : k; row0 = NLAT + b * LC + seg_chunk * LCH; }
  else { int kl = k - NCC; seg_chunk = dir ? NCL - 1 - kl : kl; row0 = b * N + seg_chunk * LCH; }
  if (dir) { row0 += LCH - 1; step = -1; } else step = 1;
}
DEVN void ph_lru1(const Params& p, i64 gtid, i64 gsz) {
#ifndef CPU_SIM
  for (i64 i = gtid; i < (i64)2 * NB * NCHK * 128; i += gsz) {
    const int c = (int)(i % 128) * 4, k = (int)((i / 128) % NCHK), b = (int)((i / (128 * NCHK)) % NB), dir = (int)(i / ((i64)128 * NCHK * NB));
    int row0, step; lru_chunk_rows(dir, b, k, row0, step);
    const uint4* lab4 = (const uint4*)(p.LAB() + (size_t)dir * TT * 512 + c);
    float h0 = 0.f, h1 = 0.f, h2 = 0.f, h3 = 0.f, s0 = 0.f, s1 = 0.f, s2 = 0.f, s3 = 0.f;
    uint4 wn[8];
#pragma unroll
    for (int t = 0; t < 8; ++t) wn[t] = lab4[(size_t)(row0 + step * t) * 128];
#pragma unroll 1
    for (int t0 = 0; t0 < LCH; t0 += 8) {
      uint4 w[8];
#pragma unroll
      for (int t = 0; t < 8; ++t) w[t] = wn[t];
      if (t0 + 8 < LCH) {
#pragma unroll
        for (int t = 0; t < 8; ++t) wn[t] = lab4[(size_t)(row0 + step * (t0 + 8 + t)) * 128];
      }
#pragma unroll
      for (int t = 0; t < 8; ++t) {
        const float a0 = __uint_as_float(w[t].x << 16), a1 = __uint_as_float(w[t].y << 16), a2 = __uint_as_float(w[t].z << 16), a3 = __uint_as_float(w[t].w << 16);
        s0 += a0; s1 += a1; s2 += a2; s3 += a3;
        h0 = fexpf_(a0) * h0 + __uint_as_float(w[t].x & 0xFFFF0000u); h1 = fexpf_(a1) * h1 + __uint_as_float(w[t].y & 0xFFFF0000u);
        h2 = fexpf_(a2) * h2 + __uint_as_float(w[t].z & 0xFFFF0000u); h3 = fexpf_(a3) * h3 + __uint_as_float(w[t].w & 0xFFFF0000u);
      }
    }
    const size_t o = ((size_t)(dir * NB + b) * NCHK + k) * 512 + c;
    *(float4*)(p.SA() + o) = float4{fexpf_(s0), fexpf_(s1), fexpf_(s2), fexpf_(s3)};
    *(float4*)(p.SB() + o) = float4{h0, h1, h2, h3};
  }
#else
  for (i64 i = gtid; i < (i64)2 * NB * NCHK * 512; i += gsz) {
    int c = (int)(i % 512), k = (int)((i / 512) % NCHK), b = (int)((i / (512 * NCHK)) % NB), dir = (int)(i / ((i64)512 * NCHK * NB));
    int row0, step; lru_chunk_rows(dir, b, k, row0, step);
    const bf* la = p.LA() + (size_t)dir * TT * 512 + c; const bf* lb = p.LB() + (size_t)dir * TT * 512 + c;
    float h = 0.f, sl = 0.f;
    for (int t = 0; t < LCH; ++t) {
      size_t r = (size_t)(row0 + step * t);
      float lav = b2f(la[r * 512]);
      h = expf(lav) * h + b2f(lb[r * 512]); sl += lav;
    }
    p.SA()[i] = fexpf_(sl); p.SB()[i] = h;
  }
#endif
}
DEVN void ph_lru3(const Params& p, int last, i64 gtid, i64 gsz, float* hrs, int ltid) {
#ifndef CPU_SIM
  unsigned* hrp = (unsigned*)hrs;
  for (i64 i = gtid; i < (i64)NB * NCHK * 256; i += gsz) {
    const int c = (int)(i % 256) * 2, j = (int)((i / 256) % NCHK), b = (int)(i / (256 * NCHK));
    if (last && j < NCC) continue;
    const int kf = j, kr = j < NCC ? NCC - 1 - j : NCC + (NCL - 1 - (j - NCC));
    const float* sa0 = p.SA() + ((size_t)(0 * NB + b) * NCHK) * 512 + c; const float* sb0 = p.SB() + ((size_t)(0 * NB + b) * NCHK) * 512 + c;
    const float* sa1 = p.SA() + ((size_t)(1 * NB + b) * NCHK) * 512 + c; const float* sb1 = p.SB() + ((size_t)(1 * NB + b) * NCHK) * 512 + c;
    float hf0 = 0.f, hf1 = 0.f, hr0 = 0.f, hr1 = 0.f;
    const int row0 = j < NCC ? NLAT + b * LC + j * LCH : b * N + (j - NCC) * LCH;
    const unsigned* lab0 = p.LAB() + c; const unsigned* lab1 = p.LAB() + (size_t)TT * 512 + c;
#pragma unroll 1
    for (int k0 = 0; k0 < kf; k0 += 8) {
      float2 av[8], bv[8];
#pragma unroll
      for (int q = 0; q < 8; ++q) { const bool ok = k0 + q < kf; av[q] = ok ? *(const float2*)(sa0 + (size_t)(k0 + q) * 512) : float2{1.f, 1.f}; bv[q] = ok ? *(const float2*)(sb0 + (size_t)(k0 + q) * 512) : float2{0.f, 0.f}; }
#pragma unroll
      for (int q = 0; q < 8; ++q) { hf0 = av[q].x * hf0 + bv[q].x; hf1 = av[q].y * hf1 + bv[q].y; }
    }
#pragma unroll 1
    for (int k0 = 0; k0 < kr; k0 += 8) {
      float2 av[8], bv[8];
#pragma unroll
      for (int q = 0; q < 8; ++q) { const bool ok = k0 + q < kr; av[q] = ok ? *(const float2*)(sa1 + (size_t)(k0 + q) * 512) : float2{1.f, 1.f}; bv[q] = ok ? *(const float2*)(sb1 + (size_t)(k0 + q) * 512) : float2{0.f, 0.f}; }
#pragma unroll
      for (int q = 0; q < 8; ++q) { hr0 = av[q].x * hr0 + bv[q].x; hr1 = av[q].y * hr1 + bv[q].y; }
    }
#pragma unroll 1
    for (int t0 = LCH - 16; t0 >= 0; t0 -= 16) {
      uint2 w[16];
#pragma unroll
      for (int t = 0; t < 16; ++t) w[t] = *(const uint2*)(lab1 + (size_t)(row0 + t0 + t) * 512);
#pragma unroll
      for (int t = 15; t >= 0; --t) {
        hr0 = fexpf_(__uint_as_float(w[t].x << 16)) * hr0 + __uint_as_float(w[t].x & 0xFFFF0000u);
        hr1 = fexpf_(__uint_as_float(w[t].y << 16)) * hr1 + __uint_as_float(w[t].y & 0xFFFF0000u);
        hrp[(t0 + t) * 512 + ltid] = pk2bf(hr0, hr1);
      }
    }
#pragma unroll 1
    for (int t0 = 0; t0 < LCH; t0 += 16) {
      uint2 w[16]; unsigned gw[16];
#pragma unroll
      for (int t = 0; t < 16; ++t) { const size_t r = (size_t)(row0 + t0 + t); w[t] = *(const uint2*)(lab0 + r * 512); gw[t] = *(const unsigned*)(p.P() + r * PC + C_LG + c); }
#pragma unroll
      for (int t = 0; t < 16; ++t) {
        hf0 = fexpf_(__uint_as_float(w[t].x << 16)) * hf0 + __uint_as_float(w[t].x & 0xFFFF0000u);
        hf1 = fexpf_(__uint_as_float(w[t].y << 16)) * hf1 + __uint_as_float(w[t].y & 0xFFFF0000u);
        const unsigned hw = hrp[(t0 + t) * 512 + ltid];
        const float y0 = geluf_(__uint_as_float(gw[t] << 16)) * (hf0 + __uint_as_float(hw << 16));
        const float y1 = geluf_(__uint_as_float(gw[t] & 0xFFFF0000u)) * (hf1 + __uint_as_float(hw & 0xFFFF0000u));
        *(unsigned*)(p.Y() + (size_t)(row0 + t0 + t) * 2048 + 512 + c) = pk2bf(y0, y1);
      }
    }
  }
#else
  for (i64 i = gtid; i < (i64)NB * NCHK * 512; i += gsz) {
    int c = (int)(i % 512), j = (int)((i / 512) % NCHK), b = (int)(i / (512 * NCHK));
    if (last && j < NCC) continue;
    int kf = j, kr = j < NCC ? NCC - 1 - j : NCC + (NCL - 1 - (j - NCC));
    const float* sa0 = p.SA() + ((size_t)(0 * NB + b) * NCHK) * 512 + c; const float* sb0 = p.SB() + ((size_t)(0 * NB + b) * NCHK) * 512 + c;
    const float* sa1 = p.SA() + ((size_t)(1 * NB + b) * NCHK) * 512 + c; const float* sb1 = p.SB() + ((size_t)(1 * NB + b) * NCHK) * 512 + c;
    float hf = 0.f, hr = 0.f;
    int row0 = j < NCC ? NLAT + b * LC + j * LCH : b * N + (j - NCC) * LCH;
    const bf* la0 = p.LA() + c; const bf* lb0 = p.LB() + c;
    const bf* la1 = p.LA() + (size_t)TT * 512 + c; bf* lb1 = p.LB() + (size_t)TT * 512 + c;
    for (int k = 0; k < kf; ++k) hf = sa0[(size_t)k * 512] * hf + sb0[(size_t)k * 512];
    for (int k = 0; k < kr; ++k) hr = sa1[(size_t)k * 512] * hr + sb1[(size_t)k * 512];
    for (int t = LCH - 1; t >= 0; --t) { size_t r = (size_t)(row0 + t); hr = expf(b2f(la1[r * 512])) * hr + b2f(lb1[r * 512]); lb1[r * 512] = f2b(hr); }
    for (int t = 0; t < LCH; ++t) {
      size_t r = (size_t)(row0 + t);
      hf = expf(b2f(la0[r * 512])) * hf + b2f(lb0[r * 512]);
      float lg = b2f(p.P()[r * PC + C_LG + c]);
      p.Y()[r * 2048 + 512 + c] = f2b(geluf_(lg) * (hf + b2f(lb1[r * 512])));
    }
  }
#endif
}

DEVN void ph_C(const Params& p, int l, int last, i64 gtid, i64 gsz) {
  const int QR = last ? NLAT : TT;
#ifdef CPU_SIM
  for (i64 i = gtid; i < (i64)8 * QR; i += gsz) {
    int hh = (int)(i / QR), r = (int)(i % QR);
    RowInfo ri = rowinfo(r);
    float q[96];
#pragma unroll
    for (int d = 0; d < 96; ++d) q[d] = b2f(p.QA()[(size_t)r * 768 + hh * 96 + d]);
    float o[64];
#pragma unroll
    for (int d = 0; d < 64; ++d) o[d] = 0.f;
    float m = -1e30f, lsum = 0.f;
    const float scale = 0.10206207261596577f;
    int nseg = ri.lat ? 2 : 1;
    for (int sg = 0; sg < nseg; ++sg) {
      int kb, kn_;
      if (ri.lat && sg == 0) { kb = ri.b * N; kn_ = N; } else { kb = NLAT + ri.b * LC; kn_ = LC; }
      for (int kk = 0; kk < kn_; ++kk) {
        const bf* kr_ = p.KVA() + (size_t)(kb + kk) * 1024 + hh * 128;
        const bf* krp = p.P() + (size_t)(kb + kk) * PC + C_KR;
        float s = 0.f;
#pragma unroll
        for (int d = 0; d < 64; ++d) s += q[d] * b2f(kr_[d]);
#pragma unroll
        for (int d = 0; d < 32; ++d) s += q[64 + d] * b2f(krp[d]);
        s *= scale;
        float mn = fmaxf(m, s);
        float corr = expf(m - mn), pe = expf(s - mn);
        lsum = lsum * corr + pe;
#pragma unroll
        for (int d = 0; d < 64; ++d) o[d] = o[d] * corr + pe * b2f(kr_[64 + d]);
        m = mn;
      }
    }
    float inv = 1.0f / lsum;
#pragma unroll
    for (int d = 0; d < 64; ++d) p.Y()[(size_t)r * 2048 + hh * 64 + d] = f2b(o[d] * inv);
  }
#endif
  {
    const float* cw = p.in[I_hy_conv_w] + l * 3 * 1536; const float* cb = p.in[I_hy_conv_b] + l * 1536;
    const float* skip = p.in[I_hy_skip] + l * 512;
#ifndef CPU_SIM
    const i64 hy_first = (i64)NLAT * 512;
#else
    const i64 hy_first = 0;
#endif
    for (i64 i = hy_first + gtid; i < (i64)QR * 512; i += gsz) {
      int r = (int)(i / 512), c = (int)(i % 512);
      RowInfo ri = rowinfo(r);
      int foff = ri.lat ? 0 : N;
      float acc = 0.f;
      for (int s = 0; s < ri.L; ++s) {
        int dd = ri.t - s;
        float fv = dd >= 0 ? p.F()[(size_t)(foff + dd) * 1024 + c] : p.F()[(size_t)(foff - dd) * 1024 + 512 + c];
        acc += fv * b2f(p.Z()[(size_t)(ri.base + s) * 512 + c]);
      }
      acc *= p.fnorm()[(ri.lat ? 0 : 512) + c];
      float x0 = cb[c];
      for (int k = 0; k < 3; ++k) {
        int ts = ri.t - 1 + k;
        if (ts >= 0 && ts < ri.L) x0 += cw[k * 1536 + c] * b2f(p.P()[(size_t)(ri.base + ts) * PC + C_HU + c]);
      }
      float y = acc + skip[c] * b2f(p.Z()[(size_t)r * 512 + c]);
      p.Y()[(size_t)r * 2048 + 1024 + c] = f2b(x0 * y);
    }
  }
#ifdef CPU_SIM
  for (i64 i = gtid; i < (i64)8 * QR; i += gsz) {
    int hh = (int)(i / QR), r = (int)(i % QR);
    RowInfo ri = rowinfo(r);
    int kh = hh / 4;
    float q[64];
#pragma unroll
    for (int d = 0; d < 64; ++d) q[d] = b2f(p.P()[(size_t)r * PC + C_GQ + hh * 64 + d]);
    float o[64];
#pragma unroll
    for (int d = 0; d < 64; ++d) o[d] = 0.f;
    float m = p.in[I_gqa_sink][l * 8 + hh], lsum = 1.0f;
    int nseg = ri.lat ? 2 : 1;
    for (int sg = 0; sg < nseg; ++sg) {
      int k0, k1;
      if (ri.lat && sg == 0) { int lo = ri.t - 128; if (lo < 0) lo = 0; int hi = ri.t + 128; if (hi > N - 1) hi = N - 1; k0 = ri.b * N + lo; k1 = ri.b * N + hi + 1; }
      else { k0 = NLAT + ri.b * LC; k1 = k0 + LC; }
      for (int kk = k0; kk < k1; ++kk) {
        const bf* kp = p.P() + (size_t)kk * PC + C_GKV + kh * 64;
        const bf* vp = kp + 128;
        float s = 0.f;
#pragma unroll
        for (int d = 0; d < 64; ++d) s += q[d] * b2f(kp[d]);
        s *= 0.125f;
        float mn = fmaxf(m, s);
        float corr = expf(m - mn), pe = expf(s - mn);
        lsum = lsum * corr + pe;
#pragma unroll
        for (int d = 0; d < 64; ++d) o[d] = o[d] * corr + pe * b2f(vp[d]);
        m = mn;
      }
    }
    float inv = 1.0f / lsum;
#pragma unroll
    for (int d = 0; d < 64; ++d) p.Y()[(size_t)r * 2048 + 1536 + hh * 64 + d] = f2b(o[d] * inv);
  }
#endif
}

DEVN void ph_E2a(const Params& p, int nrows, i64 gtid, i64 gsz) {
  for (i64 i = gtid; i < (i64)nrows * 16; i += gsz) {
    const sc_t* s_ = p.SC() + (size_t)i * 128;
    float ps = 3.0e38f; int pi = -1;
    for (int k = 0; k < 16; ++k) {
      float bs = -3.0e38f; int bi = -1;
      for (int j = 0; j < 128; ++j) {
        float s = (float)s_[j];
        bool elig = (s < ps) || (s == ps && j > pi);
        if (elig && (s > bs)) { bs = s; bi = j; }
      }
      p.TKs()[(size_t)i * 16 + k] = bs; p.TKi()[(size_t)i * 16 + k] = bi;
      ps = bs; pi = bi;
    }
  }
}

DEVN void ph_E2b(const Params& p, int nrows, i64 gtid, i64 gsz) {
  for (i64 i = gtid; i < (i64)nrows * 8; i += gsz) {
    const float* s1 = p.TKs() + (size_t)i * 32; const float* s2 = s1 + 16;
    const int* i1 = p.TKi() + (size_t)i * 32; const int* i2 = i1 + 16;
    float ps = 3.0e38f; int pi = -1;
    float mx = 0.f;
    for (int k = 0; k < 16; ++k) {
      float bs = -3.0e38f; int bi = -1;
      for (int j = 0; j < 256; ++j) {
        float s = s1[j >> 4] + s2[j & 15];
        bool elig = (s < ps) || (s == ps && j > pi);
        if (elig && (s > bs)) { bs = s; bi = j; }
      }
      if (k == 0) mx = bs;
      p.SELi()[(size_t)i * 16 + k] = i1[bi >> 4] * 128 + i2[bi & 15];
      p.SELg()[(size_t)i * 16 + k] = expf(bs - mx);
      ps = bs; pi = bi;
    }
    float sum = 0.f;
    for (int k = 0; k < 16; ++k) sum += p.SELg()[(size_t)i * 16 + k];
    float inv = 1.0f / sum;
    for (int k = 0; k < 16; ++k) p.SELg()[(size_t)i * 16 + k] *= inv;
  }
}

DEVN void ph_E3(const Params& p, int l, int nrows, i64 gtid, i64 gsz) {
  const float* u = p.in[I_peer_u] + (size_t)l * NEXP * D;
#ifndef CPU_SIM
  const int lane = (int)(gtid & 63);
  for (i64 i = gtid >> 6; i < (i64)nrows * 128; i += gsz >> 6) {
    const int r = (int)(i >> 7);
    const float4* ur = (const float4*)(u + (size_t)p.SELi()[i] * D);
    const uint2* hr = (const uint2*)(p.h() + (size_t)r * D);
    float acc = 0.f;
#pragma unroll
    for (int q = 0; q < 4; ++q) {
      const float4 uv = ur[lane + q * 64]; const uint2 hv = hr[lane + q * 64];
      union { unsigned u_; float f; } c0, c1, c2, c3;
      c0.u_ = hv.x << 16; c1.u_ = hv.x & 0xFFFF0000u; c2.u_ = hv.y << 16; c3.u_ = hv.y & 0xFFFF0000u;
      acc += uv.x * c0.f + uv.y * c1.f + uv.z * c2.f + uv.w * c3.f;
    }
#pragma unroll
    for (int o = 32; o >= 1; o >>= 1) acc += lane_xor(acc, lane, o);
    if (lane == 0) p.W()[i] = p.SELg()[i] * geluf_(acc);
  }
#else
  for (i64 i = gtid; i < (i64)nrows * 128; i += gsz) {
    int r = (int)(i / 128);
    const float* ur = u + (size_t)p.SELi()[i] * D;
    const bf* hr = p.h() + (size_t)r * D;
    float acc = 0.f;
    for (int k = 0; k < D; ++k) acc += b2f(hr[k]) * ur[k];
    p.W()[i] = p.SELg()[i] * geluf_(acc);
  }
#endif
}

DEVN void ph_E4(const Params& p, int l, int nrows, i64 gtid, i64 gsz) {
  const float* v = p.in[I_peer_v] + (size_t)l * NEXP * D;
  for (i64 i = gtid; i < (i64)nrows * D; i += gsz) {
    int r = (int)(i / D), n = (int)(i % D);
    float acc = 0.f;
    for (int j = 0; j < 128; ++j) acc += p.W()[(size_t)r * 128 + j] * v[(size_t)p.SELi()[(size_t)r * 128 + j] * D + n];
    float g2 = p.mods()[((size_t)l * 3 + modrow(r)) * 6 * D + 5 * D + n];
    p.xcur()[i] += g2 * acc;
  }
}


#ifndef CPU_SIM
DEV unsigned dpp_ror_u(unsigned x, int n) {
  switch (n) {
    case 1: return (unsigned)__builtin_amdgcn_update_dpp(0, (int)x, 0x121, 0xf, 0xf, false);
    case 2: return (unsigned)__builtin_amdgcn_update_dpp(0, (int)x, 0x122, 0xf, 0xf, false);
    case 4: return (unsigned)__builtin_amdgcn_update_dpp(0, (int)x, 0x124, 0xf, 0xf, false);
    default: return (unsigned)__builtin_amdgcn_update_dpp(0, (int)x, 0x128, 0xf, 0xf, false);
  }
}
DEV unsigned wave_max_u(unsigned x) {
  x = max(x, dpp_ror_u(x, 1)); x = max(x, dpp_ror_u(x, 2)); x = max(x, dpp_ror_u(x, 4)); x = max(x, dpp_ror_u(x, 8));
  const unsigned a = (unsigned)__builtin_amdgcn_readlane((int)x, 0), b = (unsigned)__builtin_amdgcn_readlane((int)x, 16);
  const unsigned c = (unsigned)__builtin_amdgcn_readlane((int)x, 32), d = (unsigned)__builtin_amdgcn_readlane((int)x, 48);
  return max(max(a, b), max(c, d));
}
DEV unsigned f16_key(unsigned short h, int idx) { const unsigned t = (h & 0x8000u) ? (unsigned)(~h & 0xFFFFu) : (unsigned)(h | 0x8000u); return (t << 16) | (unsigned)(0xFFFF - idx); }
DEV float key_score(unsigned k) { const unsigned t = k >> 16; const unsigned short h = (unsigned short)((t & 0x8000u) ? (t ^ 0x8000u) : (~t & 0xFFFFu)); union { unsigned short u; _Float16 f; } c; c.u = h; return (float)c.f; }
DEV int key_idx(unsigned k) { return 0xFFFF - (int)(k & 0xFFFFu); }
DEV int mbcnt64(unsigned long long m) { return (int)__builtin_amdgcn_mbcnt_hi((unsigned)(m >> 32), __builtin_amdgcn_mbcnt_lo((unsigned)m, 0u)); }
DEV unsigned pick16_sorted(unsigned k0, unsigned k1, unsigned T, int above, int lane, int* tmp) {
  const unsigned h0 = k0 & 0xFFFF0000u, h1 = k1 & 0xFFFF0000u;
  const bool gt0 = h0 > T, eq0 = h0 == T, gt1 = h1 > T, eq1 = h1 == T;
  const int need = 16 - above;
  const unsigned long long me0 = __builtin_amdgcn_ballot_w64(eq0), me1 = __builtin_amdgcn_ballot_w64(eq1);
  const bool s0 = gt0 || (eq0 && mbcnt64(me0) < need);
  const int need1 = need - (int)__builtin_popcountll(me0);
  const bool s1 = gt1 || (eq1 && mbcnt64(me1) < need1);
  const unsigned long long ms0 = __builtin_amdgcn_ballot_w64(s0), ms1 = __builtin_amdgcn_ballot_w64(s1);
  if (s0) tmp[mbcnt64(ms0)] = (int)k0;
  if (s1) tmp[(int)__builtin_popcountll(ms0) + mbcnt64(ms1)] = (int)k1;
  const unsigned u = (unsigned)tmp[lane & 15];
  int rank = 0;
#pragma unroll
  for (int q = 0; q < 16; ++q) rank += ((unsigned)__builtin_amdgcn_readlane((int)u, q) > u) ? 1 : 0;
  if (lane < 16) tmp[16 + rank] = (int)u;
  return (unsigned)tmp[16 + (lane & 15)];
}
DEV void top16_x2(unsigned a0, unsigned a1, unsigned b0, unsigned b1, int lane, int* tmp, unsigned& ta, unsigned& tb) {
  unsigned TA = 0, TB = 0; int abA = 0, abB = 0;
#pragma unroll
  for (int bit = 31; bit >= 16; --bit) {
    const unsigned m = 0xFFFFFFFFu << bit, one = 1u << bit;
    const unsigned tA = TA | one, tB = TB | one;
    const int cA = (int)__builtin_popcountll(__builtin_amdgcn_ballot_w64((a0 & m) == tA)) + (int)__builtin_popcountll(__builtin_amdgcn_ballot_w64((a1 & m) == tA));
    const int cB = (int)__builtin_popcountll(__builtin_amdgcn_ballot_w64((b0 & m) == tB)) + (int)__builtin_popcountll(__builtin_amdgcn_ballot_w64((b1 & m) == tB));
    if (abA + cA >= 16) TA = tA; else abA += cA;
    if (abB + cB >= 16) TB = tB; else abB += cB;
  }
  ta = pick16_sorted(a0, a1, TA, abA, lane, tmp);
  tb = pick16_sorted(b0, b1, TB, abB, lane, tmp + 32);
}
DEVN void ph_cvt_tables(const Params& p, int l, i64 gtid, i64 gsz) {
  const float4* u = (const float4*)(p.in[I_peer_u] + (size_t)l * NEXP * D); const float4* v = (const float4*)(p.in[I_peer_v] + (size_t)l * NEXP * D);
  unsigned* ub = (unsigned*)p.Ub(); unsigned* vb = (unsigned*)p.Vb();
#pragma unroll 4
  for (i64 i = gtid; i < (i64)NEXP * D / 4; i += gsz) {
    const float4 a = u[i], b = v[i];
    int w = __builtin_amdgcn_cvt_pk_fp8_f32(a.x * 32.f, a.y * 32.f, 0, false); w = __builtin_amdgcn_cvt_pk_fp8_f32(a.z * 32.f, a.w * 32.f, w, true); ub[i] = (unsigned)w;
    int x = __builtin_amdgcn_cvt_pk_fp8_f32(b.x, b.y, 0, false); x = __builtin_amdgcn_cvt_pk_fp8_f32(b.z, b.w, x, true); vb[i] = (unsigned)x;
  }
}
DEV void unpack16_fp8(const uint4 w, float* f) {
#define UP4(W, O) { auto lo = __builtin_amdgcn_cvt_pk_f32_fp8((int)(W), false); auto hi = __builtin_amdgcn_cvt_pk_f32_fp8((int)(W), true); f[O] = lo[0]; f[O + 1] = lo[1]; f[O + 2] = hi[0]; f[O + 3] = hi[1]; }
  UP4(w.x, 0) UP4(w.y, 4) UP4(w.z, 8) UP4(w.w, 12)
#undef UP4
}
struct Sc4 { unsigned short a, b, c, d; };
DEV Sc4 peer_scores(const Params& p, int r, int wid, int lane) {
  const unsigned short* sp = (const unsigned short*)(p.SC() + ((size_t)r * 8 + wid) * 256);
  Sc4 q; q.a = sp[lane]; q.b = sp[64 + lane]; q.c = sp[128 + lane]; q.d = sp[192 + lane];
  return q;
}
struct Key4 { decltype(f16_key((unsigned short)0, 0)) a, b, c, d; };
DEV Key4 peer_keys(const Sc4 q, int lane) { Key4 k; k.a = f16_key(q.a, lane); k.b = f16_key(q.b, 64 + lane); k.c = f16_key(q.c, lane); k.d = f16_key(q.d, 64 + lane); return k; }
DEV void peer_topk(const Key4 k, int lane, int ca, int cb, bool cvalid, int* selx, int* tmp) {
  unsigned t1, t2;
  top16_x2(k.a, k.b, k.c, k.d, lane, tmp, t1, t2);
  const unsigned k1 = (unsigned)__builtin_amdgcn_ds_bpermute(ca << 2, (int)t1), k2 = (unsigned)__builtin_amdgcn_ds_bpermute(cb << 2, (int)t2);
  const float v = cvalid ? key_score(k1) + key_score(k2) : -3.0e38f;
  int rank = 0;
#pragma unroll
  for (int c = 0; c < 50; ++c) {
    const float vs = __int_as_float(__builtin_amdgcn_readlane(__float_as_int(v), c));
    rank += (vs > v || (vs == v && c < lane)) ? 1 : 0;
  }
  float mx = v;
#pragma unroll
  for (int o = 32; o >= 1; o >>= 1) mx = fmaxf(mx, lane_xor(mx, lane, o));
  const bool sel = cvalid && rank < 16;
  const float e = sel ? fexpf_(v - mx) : 0.f;
  float sum = e;
#pragma unroll
  for (int o = 32; o >= 1; o >>= 1) sum += lane_xor(sum, lane, o);
  if (sel) { selx[rank] = key_idx(k1) * 128 + key_idx(k2); selx[16 + rank] = __float_as_int(e / sum); }
}
DEVN void ph_peer(const Params& p, int l, int nrows, int tid, char* ldsg, float oscale = 1.0f) {
  const int lane = tid & 63, wid = tid >> 6;
  float* part = (float*)ldsg;
  int* selbase = (int*)(ldsg + 8 * 1024 * 4) + wid * 64;
  int* tktmp = (int*)(ldsg + 8 * 1024 * 4 + 8 * 64 * 4) + wid * 64;
  const unsigned char* Ub = (const unsigned char*)p.Ub(); const unsigned char* Vb = (const unsigned char*)p.Vb();
  int ca = 0, cb = 0; bool cvalid = false;
  { int pre = 0;
    for (int a = 0; a < 16; ++a) { const int cnt = 16 / (a + 1); if (lane >= pre && lane < pre + cnt) { ca = a; cb = lane - pre; cvalid = true; } pre += cnt; } }
  int cur = 0;
  Sc4 nsc; nsc.a = nsc.b = nsc.c = nsc.d = 0;
  if ((int)blockIdx.x < nrows) {
    peer_topk(peer_keys(peer_scores(p, blockIdx.x, wid, lane), lane), lane, ca, cb, cvalid, selbase, tktmp);
    nsc = peer_scores(p, (int)(blockIdx.x + gridDim.x) < nrows ? (int)(blockIdx.x + gridDim.x) : (int)blockIdx.x, wid, lane);
  }
  for (int r = blockIdx.x; r < nrows; r += gridDim.x) {
    const int* selx = selbase + cur * 32;
    int eidx[16];
#pragma unroll
    for (int e = 0; e < 16; ++e) eidx[e] = __builtin_amdgcn_readfirstlane(selx[e]);
    const float mygate = __int_as_float(selx[16 + (lane >> 2)]);
    const bool more = r + (int)gridDim.x < nrows;
    const Key4 nkeys = peer_keys(nsc, lane);
    uint4 rows[16], vrows[16];
#pragma unroll
    for (int e = 0; e < 16; ++e) rows[e] = ((const uint4*)(Ub + (size_t)eidx[e] * D))[lane];
    uint4 hraw0, hraw1;
    { const uint4* hp = (const uint4*)(p.h() + (size_t)r * D); hraw0 = hp[lane * 2]; hraw1 = hp[lane * 2 + 1]; }
#pragma unroll
    for (int e = 0; e < 16; ++e) vrows[e] = ((const uint4*)(Vb + (size_t)eidx[e] * D))[lane];
    const float2 g2v = *(const float2*)(p.mods() + ((size_t)l * 3 + modrow(r)) * 6 * D + 5 * D + tid * 2);
    float2 xv = *(const float2*)(p.xcur() + (size_t)r * D + tid * 2);
    nsc = peer_scores(p, r + 2 * (int)gridDim.x < nrows ? r + 2 * (int)gridDim.x : r, wid, lane);
    if (more) peer_topk(nkeys, lane, ca, cb, cvalid, selbase + (cur ^ 1) * 32, tktmp);
    float hv[16]; unpack8(hraw0, hv); unpack8(hraw1, hv + 8);
    float d[16];
#pragma unroll
    for (int e = 0; e < 16; ++e) {
      float f[16]; unpack16_fp8(rows[e], f);
      float a = 0.f;
#pragma unroll
      for (int k = 0; k < 16; ++k) a += f[k] * hv[k];
      d[e] = a;
    }
#define FOLD(NV, O) _Pragma("unroll") for (int i = 0; i < NV / 2; ++i) { const bool up = (lane & O) != 0; const float send = up ? d[i] : d[i + NV / 2]; const float keep = up ? d[i + NV / 2] : d[i]; d[i] = keep + lane_xor(send, lane, O); }
    FOLD(16, 32) FOLD(8, 16) FOLD(4, 8) FOLD(2, 4)
#undef FOLD
    float dot = d[0]; dot += lane_xor(dot, lane, 2); dot += lane_xor(dot, lane, 1);
    const float myact = mygate * geluf_(dot * (1.0f / 32.0f));
    float acc[16];
#pragma unroll
    for (int k = 0; k < 16; ++k) acc[k] = 0.f;
#pragma unroll
    for (int e = 0; e < 16; ++e) {
      const float a = __int_as_float(__builtin_amdgcn_readlane(__float_as_int(myact), e * 4));
      float f[16]; unpack16_fp8(vrows[e], f);
#pragma unroll
      for (int k = 0; k < 16; ++k) acc[k] += a * f[k];
    }
    float* partc = part + cur * ((8 * 1024 * 4 + 2 * 8 * 64 * 4) / 4);
    { float4* pw = (float4*)(partc + wid * 1024 + lane * 16);
      pw[0] = float4{acc[0], acc[1], acc[2], acc[3]}; pw[1] = float4{acc[4], acc[5], acc[6], acc[7]};
      pw[2] = float4{acc[8], acc[9], acc[10], acc[11]}; pw[3] = float4{acc[12], acc[13], acc[14], acc[15]}; }
    __syncthreads();
    { const int c = tid * 2;
      float s0 = 0.f, s1 = 0.f;
#pragma unroll
      for (int w = 0; w < 8; ++w) { const float2 t = *(const float2*)(partc + w * 1024 + c); s0 += t.x; s1 += t.y; }
      xv.x += oscale * g2v.x * s0; xv.y += oscale * g2v.y * s1; *(float2*)(p.xcur() + (size_t)r * D + c) = xv; }
    cur ^= 1;
  }
}
#endif

DEVN void ph_final(const Params& p, i64 gtid, i64 gsz) {
  const float* g = p.in[I_g_final];
#ifndef CPU_SIM
  float pscale = 1.0f;
#if PROBE_K >= 0
  { const unsigned long long* ts = (const unsigned long long*)(p.ws + WL.ts);
    const float frac = (float)(ts[PROBE_K + 1] - ts[0]) / (float)(ts[NPHASES - 1] - ts[0]);
    pscale = 1.0f + sqrtf(floorf(frac * 50.0f + 0.5f) * 0.02f); }
#endif
  const int lane = (int)(gtid & 63);
  const i64 W = gsz >> 6;
  float4 gv[4];
#pragma unroll
  for (int i = 0; i < 4; ++i) gv[i] = *(const float4*)(g + (lane + i * 64) * 4);
  for (i64 r = gtid >> 6; r < NLAT; r += 2 * W) {
    const bool two = r + W < NLAT;
    const i64 rb = two ? r + W : r;
    const float4* xra = (const float4*)(p.xcur() + (size_t)r * D); const float4* xrb = (const float4*)(p.xcur() + (size_t)rb * D);
    float4 xa[4], xb[4]; float sa = 0.f, sb = 0.f;
#pragma unroll
    for (int i = 0; i < 4; ++i) { xa[i] = xra[lane + i * 64]; xb[i] = xrb[lane + i * 64]; }
#pragma unroll
    for (int i = 0; i < 4; ++i) { sa += xa[i].x * xa[i].x + xa[i].y * xa[i].y + xa[i].z * xa[i].z + xa[i].w * xa[i].w; sb += xb[i].x * xb[i].x + xb[i].y * xb[i].y + xb[i].z * xb[i].z + xb[i].w * xb[i].w; }
#pragma unroll
    for (int o = 32; o >= 1; o >>= 1) { sa += lane_xor(sa, lane, o); sb += lane_xor(sb, lane, o); }
    const float rsa = 1.0f / sqrtf(sa * (1.0f / D) + EPS), rsb = 1.0f / sqrtf(sb * (1.0f / D) + EPS);
#pragma unroll
    for (int i = 0; i < 4; ++i) {
      const int k = (lane + i * 64) * 4;
      float4 o4; o4.x = xa[i].x * rsa * gv[i].x * pscale; o4.y = xa[i].y * rsa * gv[i].y * pscale; o4.z = xa[i].z * rsa * gv[i].z * pscale; o4.w = xa[i].w * rsa * gv[i].w * pscale;
      *(float4*)(p.out + (size_t)r * D + k) = o4;
    }
    if (two) {
#pragma unroll
      for (int i = 0; i < 4; ++i) {
        const int k = (lane + i * 64) * 4;
        float4 o4; o4.x = xb[i].x * rsb * gv[i].x * pscale; o4.y = xb[i].y * rsb * gv[i].y * pscale; o4.z = xb[i].z * rsb * gv[i].z * pscale; o4.w = xb[i].w * rsb * gv[i].w * pscale;
        *(float4*)(p.out + (size_t)rb * D + k) = o4;
      }
    }
  }
#else
  for (i64 r = gtid; r < NLAT; r += gsz) {
    const float* xr = p.xcur() + (size_t)r * D;
    float ss = 0.f;
    for (int k = 0; k < D; ++k) ss += xr[k] * xr[k];
    float rstd = 1.0f / sqrtf(ss / D + EPS);
    for (int k = 0; k < D; ++k) p.out[(size_t)r * D + k] = xr[k] * rstd * g[k];
  }
#endif
}

DEV void rope4(float* v, const float* tab, int nf, int pos, int f0) {
#pragma unroll
  for (int jj = 0; jj < 4; ++jj) {
    float c = tab[(pos * nf + f0 + jj) * 2], s = tab[(pos * nf + f0 + jj) * 2 + 1];
    float x1 = v[2 * jj], x2 = v[2 * jj + 1];
    v[2 * jj] = x1 * c - x2 * s; v[2 * jj + 1] = x1 * s + x2 * c;
  }
}
struct EpiInproj {
  static constexpr int W = 8; static constexpr bool SUB = false; static constexpr bool STAGED = false;
  const Params& p;
  MDEV void apply(int r, int c0, float* v) const {
    if (c0 >= 3744) return;
    if (c0 >= 384 && r < NLAT) {
      int t = r % N;
      if (c0 < C_KR + 32) { int pi = (c0 - C_KR) >> 1; int half = pi >> 3; rope4(v, p.tabA(), 8, half ? t % GRIDW : t / GRIDW, pi & 7); }
      else if (c0 >= C_GQ && c0 < C_GKV + 128) { int pi = ((c0 - C_GQ) & 63) >> 1; int half = pi >> 4; rope4(v, p.tabD(), 16, half ? t % GRIDW : t / GRIDW, pi & 15); }
    }
    store8bf(p.P() + (size_t)r * PC + c0, v);
  }
};
struct EpiUq {
  static constexpr int W = 8; static constexpr bool SUB = false; static constexpr bool STAGED = false;
  const Params& p;
  MDEV void apply(int r, int c0, float* v) const {
    float rstd = 1.0f / sqrtf(p.ssq()[r] * (1.0f / 256.0f) + EPS);
#pragma unroll
    for (int j = 0; j < 8; ++j) v[j] *= rstd;
    int d0 = c0 % 96;
    if (d0 >= 64 && r < NLAT) { int t = r % N; int pi = (d0 - 64) >> 1; int half = pi >> 3; rope4(v, p.tabA(), 8, half ? t % GRIDW : t / GRIDW, pi & 7); }
    store8bf(p.QA() + (size_t)r * 768 + c0, v);
  }
};
struct EpiUkv {
  static constexpr int W = 8; static constexpr bool SUB = false; static constexpr bool STAGED = false;
  const Params& p;
  MDEV void apply(int r, int c0, float* v) const {
    float rstd = 1.0f / sqrtf(p.ssq()[TT + r] * (1.0f / 128.0f) + EPS);
#pragma unroll
    for (int j = 0; j < 8; ++j) v[j] *= rstd;
    store8bf(p.KVA() + (size_t)r * 1024 + c0, v);
  }
};
struct EpiLru {
  static constexpr int W = 8; static constexpr bool SUB = false; static constexpr bool STAGED = true; static constexpr bool STAGED_ALL = true;
  const Params& p; int l; const float* br; const float* bi;
  MDEV void finish(int r, int c0, const float* v, const float* brv, const float* biv, const float* splv, const float* xcv) const {
    int kw = c0 >> 10, dir = (c0 >> 9) & 1, blk4 = (c0 >> 7) & 3, jc0 = (c0 & 127) >> 1;
    int cb = kw * 256 + blk4 * 64 + jc0;
    float lav[4], lbv[4];
#pragma unroll
    for (int jj = 0; jj < 4; ++jj) {
      float rg = sigmoidf_(v[2 * jj] + brv[jj]), ig = sigmoidf_(v[2 * jj + 1] + biv[jj]);
      float log_a = -8.0f * rg * splv[jj];
      const float a_ = fexpf_(log_a);
      lav[jj] = log_a; lbv[jj] = sqrtf(fmaxf(1.0f - a_ * a_, 0.0f)) * ig * xcv[jj];
    }
#ifndef CPU_SIM
    { uint4 w;
      w.x = pk2bf(lav[0], lbv[0]); w.y = pk2bf(lav[1], lbv[1]); w.z = pk2bf(lav[2], lbv[2]); w.w = pk2bf(lav[3], lbv[3]);
      *(uint4*)(p.LAB() + ((size_t)dir * TT + r) * 512 + cb) = w; }
#else
    bf* la = p.LA() + ((size_t)dir * TT + r) * 512 + cb;
    bf* lb = p.LB() + ((size_t)dir * TT + r) * 512 + cb;
    for (int jj = 0; jj < 4; ++jj) { la[jj] = f2b(lav[jj]); lb[jj] = f2b(lbv[jj]); }
#endif
  }
  MDEV void apply(int r, int c0, float* v) const {
    int kw = c0 >> 10, dir = (c0 >> 9) & 1, blk4 = (c0 >> 7) & 3, jc0 = (c0 & 127) >> 1;
    int cb = kw * 256 + blk4 * 64 + jc0;
    float brv[4], biv[4], splv[4], xcv[4];
    for (int jj = 0; jj < 4; ++jj) { brv[jj] = br[(l * 2 + dir) * 512 + cb + jj]; biv[jj] = bi[(l * 2 + dir) * 512 + cb + jj]; splv[jj] = p.spl()[(l * 2 + dir) * 512 + cb + jj]; xcv[jj] = b2f(p.XC()[(size_t)r * 512 + cb + jj]); }
    finish(r, c0, v, brv, biv, splv, xcv);
  }
#ifndef CPU_SIM
  struct Pre { float4 a4, b4, s4; uint2 x2; };
  MDEV void pre(int r, int c0, Pre& q) const {
    int kw = c0 >> 10, dir = (c0 >> 9) & 1, blk4 = (c0 >> 7) & 3, jc0 = (c0 & 127) >> 1;
    int cb = kw * 256 + blk4 * 64 + jc0;
    q.a4 = gld4(br + (l * 2 + dir) * 512 + cb); q.b4 = gld4(bi + (l * 2 + dir) * 512 + cb);
    q.s4 = *(const float4*)(p.spl() + (l * 2 + dir) * 512 + cb);
    q.x2 = *(const uint2*)(p.XC() + (size_t)r * 512 + cb);
  }
  MDEV void fin(int r, int c0, float* v, const Pre& q) const {
    const float brv[4] = {q.a4.x, q.a4.y, q.a4.z, q.a4.w}, biv[4] = {q.b4.x, q.b4.y, q.b4.z, q.b4.w}, splv[4] = {q.s4.x, q.s4.y, q.s4.z, q.s4.w};
    const float xcv[4] = {__uint_as_float(q.x2.x << 16), __uint_as_float(q.x2.x & 0xFFFF0000u), __uint_as_float(q.x2.y << 16), __uint_as_float(q.x2.y & 0xFFFF0000u)};
    finish(r, c0, v, brv, biv, splv, xcv);
  }
#endif
};
struct EpiGate {
  static constexpr int W = 8; static constexpr bool SUB = false; static constexpr bool STAGED = false;
  const Params& p;
  MDEV void apply(int r, int c0, float* v) const {
#pragma unroll
    for (int j = 0; j < 8; ++j) v[j] = sigmoidf_(v[j]);
    store8bf(p.Gs() + (size_t)r * D + c0, v);
  }
};
struct EpiBranch {
  static constexpr int W = 8; static constexpr bool SUB = false; static constexpr bool STAGED = false;
  const Params& p; int br;
  MDEV void apply(int r, int c0, float* v) const {
    float g[8]; load8bf(p.Gs() + (size_t)r * D + c0, g);
    if (br > 0) {
      float mo[8]; load8bf(p.M() + (size_t)r * D + c0, mo);
#pragma unroll
      for (int j = 0; j < 8; ++j) v[j] = mo[j] + g[j] * v[j];
    } else {
#pragma unroll
      for (int j = 0; j < 8; ++j) v[j] = g[j] * v[j];
    }
    store8bf(p.M() + (size_t)r * D + c0, v);
  }
};
struct EpiGateAll {
  static constexpr int W = 8; static constexpr bool SUB = false; static constexpr bool STAGED = false;
  const Params& p;
  MDEV void apply(int r, int c0, float* v) const {
#pragma unroll
    for (int j = 0; j < 8; ++j) v[j] = sigmoidf_(v[j]) * 255.f + 0.5f;
    unsigned char* gq = p.G8() + (size_t)r * 4096 + c0;
#ifndef CPU_SIM
    uint2 w;
    w.x = (unsigned)v[0] | ((unsigned)v[1] << 8) | ((unsigned)v[2] << 16) | ((unsigned)v[3] << 24);
    w.y = (unsigned)v[4] | ((unsigned)v[5] << 8) | ((unsigned)v[6] << 16) | ((unsigned)v[7] << 24);
    *(uint2*)gq = w;
#else
    for (int j = 0; j < 8; ++j) gq[j] = (unsigned char)v[j];
#endif
  }
};
struct EpiBranchSub {
  static constexpr int W = 8; static constexpr bool SUB = true; static constexpr bool STAGED = true; static constexpr bool STAGED_ALL = false;
  const Params& p;
  MDEV void apply(int, int, float*) const {}
  MDEV void gate8(int r, int c0, int i, float* g) const {
    const unsigned char* gq = p.G8() + (size_t)r * 4096 + i * 1024 + c0;
#ifndef CPU_SIM
    const uint2 w = *(const uint2*)gq;
#pragma unroll
    for (int j = 0; j < 4; ++j) { g[j] = (float)((w.x >> (8 * j)) & 255u) * (1.0f / 255.0f); g[4 + j] = (float)((w.y >> (8 * j)) & 255u) * (1.0f / 255.0f); }
#else
    for (int j = 0; j < 8; ++j) g[j] = (float)gq[j] * (1.0f / 255.0f);
#endif
  }
  MDEV void apply_sub(int r, int c0, float* v, int sub) const {
    if (sub < 3) { store8bf(p.BR() + (size_t)r * 3072 + sub * 1024 + c0, v); return; }
    float g[8]; gate8(r, c0, 3, g);
#pragma unroll
    for (int j = 0; j < 8; ++j) v[j] *= g[j];
#pragma unroll
    for (int i = 0; i < 3; ++i) {
      float bi[8]; load8bf(p.BR() + (size_t)r * 3072 + i * 1024 + c0, bi);
      gate8(r, c0, i, g);
#pragma unroll
      for (int j = 0; j < 8; ++j) v[j] += g[j] * bi[j];
    }
    store8bf(p.M() + (size_t)r * D + c0, v);
  }
#ifndef CPU_SIM
  struct Pre { uint2 g[4]; uint4 b[3]; };
  MDEV void pre(int r, int c0, Pre& q) const {
#pragma unroll
    for (int i = 0; i < 4; ++i) q.g[i] = *(const uint2*)(p.G8() + (size_t)r * 4096 + i * 1024 + c0);
#pragma unroll
    for (int i = 0; i < 3; ++i) q.b[i] = *(const uint4*)(p.BR() + (size_t)r * 3072 + i * 1024 + c0);
  }
  MDEV void fin(int r, int c0, float* v, const Pre& q) const {
#pragma unroll
    for (int i = 3; i >= 0; --i) {
      float g[8];
#pragma unroll
      for (int j = 0; j < 4; ++j) { g[j] = (float)((q.g[i].x >> (8 * j)) & 255u) * (1.0f / 255.0f); g[4 + j] = (float)((q.g[i].y >> (8 * j)) & 255u) * (1.0f / 255.0f); }
      if (i == 3) {
#pragma unroll
        for (int j = 0; j < 8; ++j) v[j] *= g[j];
      } else {
        float bi[8]; unpack8(q.b[i], bi);
#pragma unroll
        for (int j = 0; j < 8; ++j) v[j] += g[j] * bi[j];
      }
    }
    store8bf(p.M() + (size_t)r * D + c0, v);
  }
#endif
};
struct EpiFilt {
  static constexpr int W = 8; static constexpr bool SUB = false; static constexpr bool STAGED = false;
  const Params& p;
  MDEV void apply(int j, int tt, float* v) const {
    const float maxd = -15.350567286626973f, mind = -3.0701134573253945f;
    const float ad = fabsf(mind + (float)j * ((maxd - mind) / 1023.0f));
    int t, L; if (tt < N) { t = tt; L = N; } else { t = tt - N; L = LC; }
    const float sc = -ad / (float)(L - 1);
#pragma unroll
    for (int q = 0; q < 8; ++q) v[q] *= fexpf_((float)(t + q) * sc);
    float* d = p.F() + (size_t)j * (N + LC) + tt;
#ifndef CPU_SIM
    *(float4*)d = float4{v[0], v[1], v[2], v[3]}; *(float4*)(d + 4) = float4{v[4], v[5], v[6], v[7]};
#else
    for (int q = 0; q < 8; ++q) d[q] = v[q];
#endif
  }
};
struct EpiOut {
  static constexpr int W = 8; static constexpr bool SUB = false; static constexpr bool STAGED = true; static constexpr bool STAGED_ALL = true;
  const Params& p; int l; float osc; const float* xlat; const float* xctx;
  MDEV void apply(int r, int c0, float* v) const {
    const float* g1 = p.mods() + ((size_t)l * 3 + modrow(r)) * 6 * D + 2 * D + c0;
    const float* xs = (r < NLAT ? xlat + (size_t)r * D : xctx + (size_t)(r - NLAT) * D) + c0;
    float* xr = p.xcur() + (size_t)r * D + c0;
    for (int j = 0; j < 8; ++j) xr[j] = xs[j] + osc * g1[j] * v[j];
  }
#ifndef CPU_SIM
  struct Pre { float4 g0, g1, x0, x1; };
  MDEV void pre(int r, int c0, Pre& q) const {
    const float* g1 = p.mods() + ((size_t)l * 3 + modrow(r)) * 6 * D + 2 * D + c0;
    const float* xs = (r < NLAT ? xlat + (size_t)r * D : xctx + (size_t)(r - NLAT) * D) + c0;
    q.g0 = *(const float4*)g1; q.g1 = *(const float4*)(g1 + 4); q.x0 = gld4(xs); q.x1 = gld4(xs + 4);
  }
  MDEV void fin(int r, int c0, float* v, const Pre& q) const {
    float* xr = p.xcur() + (size_t)r * D + c0;
    float4 o0, o1;
    o0.x = q.x0.x + osc * q.g0.x * v[0]; o0.y = q.x0.y + osc * q.g0.y * v[1]; o0.z = q.x0.z + osc * q.g0.z * v[2]; o0.w = q.x0.w + osc * q.g0.w * v[3];
    o1.x = q.x1.x + osc * q.g1.x * v[4]; o1.y = q.x1.y + osc * q.g1.y * v[5]; o1.z = q.x1.z + osc * q.g1.z * v[6]; o1.w = q.x1.w + osc * q.g1.w * v[7];
    *(float4*)xr = o0; *(float4*)(xr + 4) = o1;
  }
#endif
};
struct EpiPQ {
  static constexpr int W = 8; static constexpr bool SUB = false; static constexpr bool STAGED = false;
  const Params& p;
  MDEV void apply(int r, int c0, float* v) const { store8bf(p.PQ() + (size_t)r * 1024 + c0, v); }
};
struct EpiSC {
  static constexpr int W = 8; static constexpr bool SUB = false; static constexpr bool STAGED = false;
  const Params& p;
  MDEV void apply(int r, int c0, float* v) const {
    sc_t* d = p.SC() + (size_t)r * 2048 + c0;
#ifndef CPU_SIM
    typedef _Float16 half8 __attribute__((ext_vector_type(8)));
    half8 hv8;
#pragma unroll
    for (int j = 0; j < 8; ++j) hv8[j] = (_Float16)v[j];
    *(half8*)d = hv8;
#else
    for (int j = 0; j < 8; ++j) d[j] = (sc_t)v[j];
#endif
  }
};

struct GemmDesc { const bf* A; const bf* Bt; int lda, ldb, K, nrows, ncols; int a_pn_shift, a_pn_mul; int nsub = 1, a_sub = 0, b_sub = 0; int unit_off = 0; };

#ifndef CPU_SIM
namespace pg8 {
#define PG8_LAS __attribute__((address_space(3)))
typedef short bf16x8 __attribute__((ext_vector_type(8)));
typedef float f32x4 __attribute__((ext_vector_type(4)));
constexpr int BM = 256, BK = 64, HALF = 128, HTB = HALF * BK * 2, STAGE_BYTES = 8 * HTB, NXCD = 8, WGM = 8;
__device__ __forceinline__ int lds_byte(int r, int c) { const int st = (r >> 4) * 2 + (c >> 5), rr = r & 15, cc = c & 31, ob = rr * 64 + cc * 2; return st * 1024 + (ob ^ (((ob >> 9) & 1) << 5)); }
__device__ __forceinline__ void stage_rc(int b, int& R, int& C) { const int st = b / 1024, sb = b % 1024, swz = sb ^ (((sb >> 9) & 1) << 5); R = (st >> 1) * 16 + swz / 64; C = (st & 1) * 32 + (swz % 64) / 2; }
__device__ __forceinline__ int perm32(int rho) { const int n = rho >> 4, i = rho & 15; return 8 * (i >> 2) + 4 * n + (i & 3); }
struct Unit { int pm, pn, sub; };
struct StaticOrder {
  int nM, nN, nwg, G, c, nsub;
  __device__ void init(int nM_, int nN_, int G_, int c_, int nsub_) { nM = nM_; nN = nN_; nwg = nM * nN; G = G_; c = c_; nsub = nsub_; }
  __device__ bool next(int i, Unit& u) const {
    const int it = i / nsub; u.sub = i - it * nsub;
    const long L = (long)it * G + c; if (L >= nwg) return false;
    int wgid = (int)L; { const int q = nwg / NXCD, r = nwg % NXCD, xcd = wgid % NXCD, off = wgid / NXCD; wgid = (xcd < r ? xcd * (q + 1) : r * (q + 1) + (xcd - r) * q) + off; }
    const int nig = WGM * nN, gid = wgid / nig, fm = gid * WGM, gsz = (nM - fm) < WGM ? (nM - fm) : WGM;
    u.pm = fm + ((wgid % nig) % gsz); u.pn = (wgid % nig) / gsz; return true;
  }
};

template <class E>
__device__ __forceinline__ void epi_call(const E& e, const f32x4 (&acc)[2][2][4][2], const Unit& u, int wr, int wc, int fr_, int fq_) {
  int fr = fr_, fq = fq_;
  asm volatile("" : "+v"(fr), "+v"(fq));
  if constexpr (E::STAGED) {
    if (E::STAGED_ALL || u.sub == 3) {
#pragma unroll
      for (int ai = 0; ai < 2; ++ai)
#pragma unroll
        for (int m = 0; m < 4; ++m) {
          typename E::Pre q[2];
#pragma unroll
          for (int bj = 0; bj < 2; ++bj) { q[bj] = typename E::Pre{}; e.pre(u.pm * BM + ai * HALF + wr * 64 + m * 16 + fr, u.pn * BM + bj * HALF + wc * 32 + 8 * fq, q[bj]); }
#pragma unroll
          for (int bj = 0; bj < 2; ++bj) {
            float v[8];
#pragma unroll
            for (int j = 0; j < 4; ++j) { v[j] = acc[ai][bj][m][0][j]; v[4 + j] = acc[ai][bj][m][1][j]; }
            e.fin(u.pm * BM + ai * HALF + wr * 64 + m * 16 + fr, u.pn * BM + bj * HALF + wc * 32 + 8 * fq, v, q[bj]);
          }
          __builtin_amdgcn_sched_barrier(0);
        }
      return;
    }
  }
#pragma unroll
  for (int ai = 0; ai < 2; ++ai)
#pragma unroll
    for (int m = 0; m < 4; ++m) {
      const int r = u.pm * BM + ai * HALF + wr * 64 + m * 16 + fr;
#pragma unroll
      for (int bj = 0; bj < 2; ++bj) {
        if constexpr (E::W == 8) {
          const int c0 = u.pn * BM + bj * HALF + wc * 32 + 8 * fq;
          float v[8];
#pragma unroll
          for (int j = 0; j < 4; ++j) { v[j] = acc[ai][bj][m][0][j]; v[4 + j] = acc[ai][bj][m][1][j]; }
          if constexpr (E::W == 8 && E::SUB) e.apply_sub(r, c0, v, u.sub); else e.apply(r, c0, v);
        } else {
#pragma unroll
          for (int n = 0; n < 2; ++n) {
            const int c0 = u.pn * BM + bj * HALF + wc * 32 + 16 * n + 4 * fq;
            float v[4];
#pragma unroll
            for (int j = 0; j < 4; ++j) v[j] = acc[ai][bj][m][n][j];
            e.apply(r, c0, v);
          }
        }
      }
      if (m == 1 || m == 3) __builtin_amdgcn_sched_barrier(0);
    }
}

template <class Epi>
__device__ __forceinline__ void gemm_phase(PG8_LAS unsigned char* lds, const int tid, const GemmDesc g, const Epi& E) {
  constexpr bool PERM = (Epi::W == 8);
  const int wid = __builtin_amdgcn_readfirstlane(tid >> 6), lane = tid & 63, wr = wid >> 2, wc = wid & 3, fr = lane & 15, fq = lane >> 4;
  const int K = g.K, nt = K / BK;
  StaticOrder S; S.init(g.nrows / BM, g.ncols / BM, (int)gridDim.x, (int)((blockIdx.x + gridDim.x - (unsigned)g.unit_off % gridDim.x) % gridDim.x), g.nsub);
  unsigned voffA[2], voffB[2];
#pragma unroll
  for (int i = 0; i < 2; ++i) { int R, C; stage_rc(tid * 16 + i * 8192, R, C); const int Rb = PERM ? ((R & ~31) + perm32(R & 31)) : R;
    voffA[i] = (unsigned)(R * g.lda + C) * 2u; voffB[i] = (unsigned)(Rb * g.ldb + C) * 2u; }
  const size_t kstep = (size_t)(BK * 2);
  const size_t hstepA = (size_t)HALF * g.lda * 2, hstepB = (size_t)HALF * g.ldb * 2;
  const unsigned ldsw = (unsigned)wid * 1024u;
  const int aoff = lds_byte(wr * 64 + fr, fq * 8), boff = lds_byte(wc * 32 + fr, fq * 8);
#define PG8_SA(b, h) (((b) * 2 + (h)) * HTB)
#define PG8_SB(b, h) ((4 + (b) * 2 + (h)) * HTB)
#define PG8_STAGE(bufoff, gbase, voff) do { _Pragma("unroll") for (int _i = 0; _i < 2; ++_i) \
        __builtin_amdgcn_global_load_lds((const unsigned*)((const char*)(gbase) + (voff)[_i]), (PG8_LAS unsigned*)(lds + (bufoff) + ldsw + _i * 8192), 16, 0, 0); } while (0)
#define PG8_LDA(dst, b, h) do { _Pragma("unroll") for (int m = 0; m < 4; ++m) _Pragma("unroll") for (int k = 0; k < 2; ++k) dst[m][k] = *(const PG8_LAS bf16x8*)(lds + PG8_SA(b, h) + aoff + m * 2048 + k * 1024); } while (0)
#define PG8_LDB(dst, b, h) do { _Pragma("unroll") for (int n = 0; n < 2; ++n) _Pragma("unroll") for (int k = 0; k < 2; ++k) dst[n][k] = *(const PG8_LAS bf16x8*)(lds + PG8_SB(b, h) + boff + n * 2048 + k * 1024); } while (0)
#define PG8_MMA(ai, bj, At, Bt) do { __builtin_amdgcn_s_setprio(1); _Pragma("unroll") for (int m = 0; m < 4; ++m) _Pragma("unroll") for (int n = 0; n < 2; ++n) _Pragma("unroll") for (int k = 0; k < 2; ++k) \
        acc[ai][bj][m][n] = __builtin_amdgcn_mfma_f32_16x16x32_bf16(Bt[n][k], At[m][k], acc[ai][bj][m][n], 0, 0, 0); __builtin_amdgcn_s_setprio(0); } while (0)
#define PG8_WAIT_V(n) asm volatile("s_waitcnt vmcnt(" #n ")" ::: "memory")
#define PG8_WAIT_L(n) asm volatile("s_waitcnt lgkmcnt(" #n ")" ::: "memory")
#define PG8_BAR __builtin_amdgcn_s_barrier()
#define PG8_SCHED __builtin_amdgcn_sched_barrier(0)
#define PG8_ABASE(u) ((const char*)g.A + ((size_t)(u).pm * BM * g.lda + (size_t)((u).pn >> g.a_pn_shift) * g.a_pn_mul + (size_t)(u).sub * g.a_sub) * 2)
#define PG8_BBASE(u) ((const char*)g.Bt + ((size_t)(u).pn * BM * g.ldb + (size_t)(u).sub * g.b_sub) * 2)
  Unit cur, nxt; int ui = 0;
  if (!S.next(0, cur)) return;
  f32x4 acc[2][2][4][2];
#pragma unroll
  for (int a = 0; a < 2; ++a)
#pragma unroll
    for (int b = 0; b < 2; ++b)
#pragma unroll
      for (int m = 0; m < 4; ++m)
#pragma unroll
        for (int n = 0; n < 2; ++n) acc[a][b][m][n] = (f32x4){0.f, 0.f, 0.f, 0.f};
  bf16x8 At[4][2], B0[2][2], B1[2][2];
  const char* cA = PG8_ABASE(cur); const char* cB = PG8_BBASE(cur);
  asm volatile("" : "+v"(voffA[0]), "+v"(voffA[1]), "+v"(voffB[0]), "+v"(voffB[1]));
  PG8_STAGE(PG8_SB(0, 0), cB, voffB); PG8_STAGE(PG8_SA(0, 0), cA, voffA); PG8_STAGE(PG8_SB(0, 1), cB + hstepB, voffB); PG8_STAGE(PG8_SA(0, 1), cA + hstepA, voffA);
  if (wr == 1) PG8_BAR;
  PG8_WAIT_V(4); PG8_BAR;
  PG8_STAGE(PG8_SB(1, 0), cB + kstep, voffB); PG8_STAGE(PG8_SA(1, 0), cA + kstep, voffA); PG8_STAGE(PG8_SB(1, 1), cB + hstepB + kstep, voffB);
  PG8_WAIT_V(6); PG8_BAR;
  for (;;) {
    const bool has_next = S.next(ui + 1, nxt);
    const char* nA = has_next ? PG8_ABASE(nxt) : cA; const char* nB = has_next ? PG8_BBASE(nxt) : cB;
    for (int t = 0; t < nt; t += 2) {
      const bool last = (t == nt - 2);
      asm volatile("" : "+v"(voffA[0]), "+v"(voffA[1]), "+v"(voffB[0]), "+v"(voffB[1]));
      const char* a1 = cA + (size_t)(t + 1) * kstep;
      const char* a2 = last ? nA : cA + (size_t)(t + 2) * kstep; const char* b2 = last ? nB : cB + (size_t)(t + 2) * kstep;
      const char* a3 = a2 + kstep; const char* b3 = b2 + kstep;
      PG8_LDB(B0, 0, 0); PG8_SCHED; PG8_LDA(At, 0, 0); PG8_STAGE(PG8_SA(1, 1), a1 + hstepA, voffA);
      PG8_WAIT_L(8); PG8_BAR; PG8_WAIT_L(0); PG8_MMA(0, 0, At, B0); PG8_BAR; PG8_SCHED;
      PG8_LDB(B1, 0, 1); PG8_STAGE(PG8_SB(0, 0), b2, voffB);
      PG8_BAR; PG8_WAIT_L(0); PG8_MMA(0, 1, At, B1); PG8_BAR;
      PG8_LDA(At, 0, 1); PG8_STAGE(PG8_SA(0, 0), a2, voffA);
      PG8_BAR; PG8_WAIT_L(0); PG8_MMA(1, 0, At, B0); PG8_BAR; PG8_SCHED;
      PG8_STAGE(PG8_SB(0, 1), b2 + hstepB, voffB);
      PG8_WAIT_V(6); PG8_BAR; PG8_MMA(1, 1, At, B1); PG8_BAR;
      PG8_LDB(B0, 1, 0); PG8_SCHED; PG8_LDA(At, 1, 0); PG8_STAGE(PG8_SA(0, 1), a2 + hstepA, voffA);
      PG8_WAIT_L(8); PG8_BAR; PG8_WAIT_L(0); PG8_MMA(0, 0, At, B0); PG8_BAR; PG8_SCHED;
      PG8_LDB(B1, 1, 1); PG8_STAGE(PG8_SB(1, 0), b3, voffB);
      PG8_BAR; PG8_WAIT_L(0); PG8_MMA(0, 1, At, B1); PG8_BAR;
      PG8_LDA(At, 1, 1); PG8_STAGE(PG8_SA(1, 0), a3, voffA);
      PG8_BAR; PG8_WAIT_L(0); PG8_MMA(1, 0, At, B0); PG8_BAR; PG8_SCHED;
      PG8_STAGE(PG8_SB(1, 1), b3 + hstepB, voffB);
      PG8_WAIT_V(6); PG8_BAR; PG8_MMA(1, 1, At, B1); PG8_BAR;
    }
    epi_call(E, acc, cur, wr, wc, fr, fq);
    if (!has_next) break;
#pragma unroll
    for (int a = 0; a < 2; ++a)
#pragma unroll
      for (int b = 0; b < 2; ++b)
#pragma unroll
        for (int m = 0; m < 4; ++m)
#pragma unroll
          for (int n = 0; n < 2; ++n) acc[a][b][m][n] = (f32x4){0.f, 0.f, 0.f, 0.f};
    cur = nxt; cA = nA; cB = nB; ++ui;
  }
  PG8_WAIT_V(0);
  if (wr == 0) PG8_BAR;
  PG8_BAR;
#undef PG8_SA
#undef PG8_SB
#undef PG8_STAGE
#undef PG8_LDA
#undef PG8_LDB
#undef PG8_MMA
#undef PG8_WAIT_V
#undef PG8_WAIT_L
#undef PG8_BAR
#undef PG8_SCHED
#undef PG8_ABASE
#undef PG8_BBASE
}
}
struct Ctx { i64 gtid, gsz; PG8_LAS unsigned char* lds; char* ldsg; int tid; };
template <class E> DEV void run_gemm(const Ctx& cx, const GemmDesc& g, const E& e) { pg8::gemm_phase<E>(cx.lds, cx.tid, g, e); }
#else
struct Ctx { i64 gtid, gsz; };
template <class E> static void run_gemm(const Ctx& cx, const GemmDesc& g, const E& e) {
  constexpr int W = E::W;
  const int ng = g.ncols / W;
  for (i64 i = cx.gtid; i < (i64)g.nrows * ng; i += cx.gsz) {
    int r = (int)(i / ng), c0 = (int)(i % ng) * W;
    int pn = c0 / 256;
    for (int sub = 0; sub < g.nsub; ++sub) {
      const bf* a = g.A + (size_t)r * g.lda + (size_t)(pn >> g.a_pn_shift) * g.a_pn_mul + (size_t)sub * g.a_sub;
      float v[8];
      for (int j = 0; j < W; ++j) {
        const bf* b = g.Bt + (size_t)(c0 + j) * g.ldb + (size_t)sub * g.b_sub;
        float acc = 0.f;
        for (int k = 0; k < g.K; ++k) acc += b2f(a[k]) * b2f(b[k]);
        v[j] = acc;
      }
      if constexpr (E::SUB) e.apply_sub(r, c0, v, sub); else e.apply(r, c0, v);
    }
  }
}
#endif


#ifndef CPU_SIM
namespace fa {
using bf16x8 = __attribute__((ext_vector_type(8))) short;
using s16x4 = __attribute__((ext_vector_type(4))) short;
using f32x16 = __attribute__((ext_vector_type(16))) float;
using u32x4 = __attribute__((ext_vector_type(4))) unsigned;
constexpr int KVBLK = 64, QBLK = 32;
constexpr float THR = 8.f;
constexpr int SHM_V = KVBLK * 128 * 2, SHM_K = KVBLK * 128 * 2;
constexpr int NBUF = 3;
constexpr int SHM_ATTN = NBUF * SHM_V + NBUF * SHM_K + 8 * 64 * 4;
#define KSWZ(row, colB) ((row) * 256 + ((colB) ^ (((row) & 7) << 4)))
#define SBAR() __builtin_amdgcn_sched_barrier(0)
__device__ __forceinline__ int crow(int r, int hi) { return (r & 3) + 8 * (r >> 2) + 4 * hi; }
__device__ __forceinline__ unsigned cvtpk(float lo, float hi) { unsigned r; asm volatile("v_cvt_pk_bf16_f32 %0, %1, %2" : "=v"(r) : "v"(lo), "v"(hi)); return r; }
template <int SC1000000> __device__ __forceinline__ void partialSM(f32x16& p0, f32x16& p1, float& m_reg, float& mn, float& alpha) {
  constexpr float SCALE = SC1000000 * 1e-9f; constexpr float C = SCALE * 1.4426950408889634f;
  float pmax = p0[0];
#pragma unroll
  for (int r = 1; r < 16; ++r) pmax = fmaxf(pmax, p0[r]);
#pragma unroll
  for (int r = 0; r < 16; ++r) pmax = fmaxf(pmax, p1[r]);
  { auto rr = __builtin_amdgcn_permlane32_swap(__float_as_uint(pmax), __float_as_uint(pmax), false, false);
    pmax = fmaxf(__uint_as_float(rr[0]), __uint_as_float(rr[1])); }
  if (__builtin_expect(__all(pmax - m_reg <= THR / SCALE), 1)) { mn = m_reg; alpha = 1.f; }
  else { mn = fmaxf(m_reg, pmax); alpha = __builtin_amdgcn_exp2f((m_reg - mn) * C); m_reg = mn; }
  float mnC = -mn * C;
#pragma unroll
  for (int r = 0; r < 16; ++r) p0[r] = fmaf(p0[r], C, mnC);
#pragma unroll
  for (int r = 0; r < 16; ++r) p1[r] = fmaf(p1[r], C, mnC);
#pragma unroll
  for (int r = 0; r < 16; ++r) p0[r] = __builtin_amdgcn_exp2f(p0[r]);
}
__device__ __forceinline__ void finishSM(f32x16& p0, f32x16& p1, float alpha, float& l_reg, bf16x8& pa0, bf16x8& pa1, bf16x8& pa2, bf16x8& pa3) {
#pragma unroll
  for (int r = 0; r < 16; ++r) p1[r] = __builtin_amdgcn_exp2f(p1[r]);
  float ps = 0;
#pragma unroll
  for (int r = 0; r < 16; ++r) ps += p0[r];
#pragma unroll
  for (int r = 0; r < 16; ++r) ps += p1[r];
  { auto rr = __builtin_amdgcn_permlane32_swap(__float_as_uint(ps), __float_as_uint(ps), false, false);
    ps = __uint_as_float(rr[0]) + __uint_as_float(rr[1]); }
  l_reg = l_reg * alpha + ps;
#define PK4(P, BASE, OUT) do { unsigned a0 = cvtpk(P[BASE + 0], P[BASE + 1]), a1 = cvtpk(P[BASE + 2], P[BASE + 3]);   \
    unsigned b0 = cvtpk(P[BASE + 4], P[BASE + 5]), b1 = cvtpk(P[BASE + 6], P[BASE + 7]);                              \
    auto r0 = __builtin_amdgcn_permlane32_swap(a0, b0, false, false); auto r1 = __builtin_amdgcn_permlane32_swap(a1, b1, false, false); \
    u32x4 w = {r0[0], r1[0], r0[1], r1[1]}; OUT = *reinterpret_cast<bf16x8*>(&w); } while (0)
  PK4(p0, 0, pa0); PK4(p0, 8, pa1); PK4(p1, 0, pa2); PK4(p1, 8, pa3);
#undef PK4
}
template <int NK16>
__device__ __forceinline__ void qkt(f32x16& p0, f32x16& p1, const char* Ks, const bf16x8* qr, int r32, int hi) {
  p0 = f32x16{}; p1 = f32x16{};
#pragma unroll
  for (int d0 = 0; d0 < NK16; ++d0) { int cb = (d0 * 16 + hi * 8) * 2;
    bf16x8 b0 = *reinterpret_cast<const bf16x8*>(Ks + KSWZ(r32, cb));
    bf16x8 b1 = *reinterpret_cast<const bf16x8*>(Ks + KSWZ(32 + r32, cb));
    p0 = __builtin_amdgcn_mfma_f32_32x32x16_bf16(b0, qr[d0], p0, 0, 0, 0);
    p1 = __builtin_amdgcn_mfma_f32_32x32x16_bf16(b1, qr[d0], p1, 0, 0, 0); }
}
__device__ __forceinline__ int v_st(int k, int c) { const int kk = (k & ~0xC) | ((k & 4) << 1) | ((k & 8) >> 1); return ((kk >> 3) * 4 + (c >> 5)) * 512 + ((kk & 7) * 32 + (c & 31)) * 2; }
__device__ __forceinline__ int v_rd_base(int lane) { return ((lane & 3) << 3) | (((lane >> 2) & 3) << 6) | (((lane >> 4) & 1) << 5) | (((lane >> 5) & 1) << 8); }
constexpr int v_rd_off(int d0, int ks, int half) { return d0 * 512 + ks * 4096 + half * 2048; }
template <int OFF> __device__ __forceinline__ s16x4 tr_read(int vb) {
  s16x4 r; asm volatile("ds_read_b64_tr_b16 %0, %1 offset:%2" : "=&v"(r) : "v"(vb), "i"(OFF) : "memory"); return r;
}
template <int D0> __device__ __forceinline__ void pv_one(f32x16& od, int vb, bf16x8 pa0, bf16x8 pa1, bf16x8 pa2, bf16x8 pa3) {
  const s16x4 l0 = tr_read<v_rd_off(D0, 0, 0)>(vb), h0 = tr_read<v_rd_off(D0, 0, 1)>(vb), l1 = tr_read<v_rd_off(D0, 1, 0)>(vb), h1 = tr_read<v_rd_off(D0, 1, 1)>(vb);
  const s16x4 l2 = tr_read<v_rd_off(D0, 2, 0)>(vb), h2 = tr_read<v_rd_off(D0, 2, 1)>(vb), l3 = tr_read<v_rd_off(D0, 3, 0)>(vb), h3 = tr_read<v_rd_off(D0, 3, 1)>(vb);
  asm volatile("s_waitcnt lgkmcnt(0)" ::: "memory"); SBAR();
#define PK(L, H) (bf16x8){L[0], L[1], L[2], L[3], H[0], H[1], H[2], H[3]}
  od = __builtin_amdgcn_mfma_f32_32x32x16_bf16(pa0, PK(l0, h0), od, 0, 0, 0);
  od = __builtin_amdgcn_mfma_f32_32x32x16_bf16(pa1, PK(l1, h1), od, 0, 0, 0);
  od = __builtin_amdgcn_mfma_f32_32x32x16_bf16(pa2, PK(l2, h2), od, 0, 0, 0);
  od = __builtin_amdgcn_mfma_f32_32x32x16_bf16(pa3, PK(l3, h3), od, 0, 0, 0);
#undef PK
}
__device__ __forceinline__ void pv_d0(f32x16* o, int vb, bf16x8 pa0, bf16x8 pa1, bf16x8 pa2, bf16x8 pa3) {
  pv_one<0>(o[0], vb, pa0, pa1, pa2, pa3); pv_one<1>(o[1], vb, pa0, pa1, pa2, pa3);
}

struct Src { const bf* q; int qstride; const bf* ksrc; int kstride; const bf* vsrc; int vstride; bf* out; float m0, l0; int dq0; };
template <int NK16, int SC1000000, bool MASK>
__device__ __forceinline__ void unit(const Src& sd, const int tid, char* lds, int kbase0, int nt0, int kbase1, int NT) {
  const int wid = tid >> 6, lane = tid & 63, r32 = lane & 31, hi = lane >> 5;
  char* V_lds = lds; char* K_lds = lds + NBUF * SHM_V;
  float* wsl = (float*)(lds + NBUF * SHM_V + NBUF * SHM_K) + wid * 64; float* li_l = wsl; float* al_l = wsl + 32;
  float m_reg = sd.m0, l_reg = sd.l0; f32x16 o[2] = {}; bf16x8 qr[NK16];
  const bf* Qw = sd.q + (size_t)(wid * QBLK + r32) * sd.qstride + hi * 8;
#pragma unroll
  for (int d0 = 0; d0 < NK16; ++d0) qr[d0] = *reinterpret_cast<const bf16x8*>(Qw + d0 * 16);
  const int sr = tid >> 4, sc = (tid & 15) * 8, vst0 = v_st(sr, sc), vst1 = v_st(32 + sr, sc);
  const int vb0 = (int)(uintptr_t)V_lds + v_rd_base(lane);
  const bf* ksrc = sd.ksrc; const int kstride = sd.kstride; const bf* vsrc = sd.vsrc; const int vstride = sd.vstride;
  const int dqw = sd.dq0 + wid * QBLK + r32;
  struct { bf16x8 vs0, vs1, ks0, ks1; } sr_[2];
#define KROW(j) ((j) < nt0 ? kbase0 + (j) * KVBLK : kbase1 + ((j) - nt0) * KVBLK)
#define SLOAD(i, j) do { const int _kr = KROW(j); \
    sr_[i].vs0 = *reinterpret_cast<const bf16x8*>(vsrc + (size_t)(_kr + sr) * vstride); sr_[i].vs1 = *reinterpret_cast<const bf16x8*>(vsrc + (size_t)(_kr + 32 + sr) * vstride); \
    sr_[i].ks0 = *reinterpret_cast<const bf16x8*>(ksrc + (size_t)(_kr + sr) * kstride); sr_[i].ks1 = *reinterpret_cast<const bf16x8*>(ksrc + (size_t)(_kr + 32 + sr) * kstride); } while (0)
#define SWRITE(b, i) do { *(bf16x8*)(V_lds + (b) * SHM_V + vst0) = sr_[i].vs0;          \
    *(bf16x8*)(V_lds + (b) * SHM_V + vst1) = sr_[i].vs1; int kc = sc * 2;               \
    *(bf16x8*)(K_lds + (b) * SHM_K + KSWZ(sr, kc)) = sr_[i].ks0;                       \
    *(bf16x8*)(K_lds + (b) * SHM_K + KSWZ(32 + sr, kc)) = sr_[i].ks1; } while (0)
#define SWAIT() asm volatile("s_waitcnt vmcnt(4)" ::: "memory")
#define MASKT(P0, P1, J) do { if (MASK && (J) < nt0) { const int _d = (J) * KVBLK - dqw; \
    _Pragma("unroll") for (int r = 0; r < 16; ++r) { const int dd = _d + crow(r, hi); if (dd > 128 || dd < -128) P0[r] = -1e30f; if (dd + 32 > 128 || dd + 32 < -128) P1[r] = -1e30f; } } } while (0)
#define RESC(a) do { if (__any((a) < 1.f)) { if (hi == 0) al_l[r32] = (a); asm volatile("s_waitcnt lgkmcnt(0)" ::: "memory"); \
    _Pragma("unroll") for (int d = 0; d < 2; ++d) _Pragma("unroll") for (int r = 0; r < 16; ++r) o[d][r] *= al_l[crow(r, hi)]; } } while (0)
  f32x16 pA0, pA1, pB0, pB1; float mnA, mnB, alA, alB; bf16x8 pa0, pa1, pa2, pa3;
  constexpr int SE = 0, SO = 1;
  __syncthreads();
  SLOAD(SE, 0); asm volatile("s_waitcnt vmcnt(0)" ::: "memory"); SWRITE(0, SE); __syncthreads();
  qkt<NK16>(pA0, pA1, K_lds, qr, r32, hi); MASKT(pA0, pA1, 0); partialSM<SC1000000>(pA0, pA1, m_reg, mnA, alA);
  SLOAD(SO, 1); if (2 < NT) SLOAD(SE, 2);
  SWAIT();
  SWRITE(1, SO); __syncthreads();
  int bc = 1;
  for (int j = 1; j + 1 < NT; j += 2) {
    { const int bp = bc == 0 ? NBUF - 1 : bc - 1, bn = bc == NBUF - 1 ? 0 : bc + 1;
      SBAR(); qkt<NK16>(pB0, pB1, K_lds + bc * SHM_K, qr, r32, hi);
      finishSM(pA0, pA1, alA, l_reg, pa0, pa1, pa2, pa3); SBAR();
      SLOAD(SO, j + 2); SBAR();
      pv_d0(o, vb0 + bp * SHM_V, pa0, pa1, pa2, pa3); MASKT(pB0, pB1, j); partialSM<SC1000000>(pB0, pB1, m_reg, mnB, alB);
      SWAIT(); SWRITE(bn, SE);
      RESC(alB); __syncthreads();
      bc = bn; }
    { const int bp = bc == 0 ? NBUF - 1 : bc - 1, bn = bc == NBUF - 1 ? 0 : bc + 1;
      SBAR(); qkt<NK16>(pA0, pA1, K_lds + bc * SHM_K, qr, r32, hi);
      finishSM(pB0, pB1, alB, l_reg, pa0, pa1, pa2, pa3); SBAR();
      if (j + 3 < NT) SLOAD(SE, j + 3); SBAR();
      pv_d0(o, vb0 + bp * SHM_V, pa0, pa1, pa2, pa3); MASKT(pA0, pA1, j + 1); partialSM<SC1000000>(pA0, pA1, m_reg, mnA, alA);
      SWAIT(); SWRITE(bn, SO);
      RESC(alA); __syncthreads();
      bc = bn; }
  }
  { const int bp = bc == 0 ? NBUF - 1 : bc - 1;
    SBAR(); qkt<NK16>(pB0, pB1, K_lds + bc * SHM_K, qr, r32, hi);
    finishSM(pA0, pA1, alA, l_reg, pa0, pa1, pa2, pa3); SBAR();
    pv_d0(o, vb0 + bp * SHM_V, pa0, pa1, pa2, pa3); MASKT(pB0, pB1, NT - 1); partialSM<SC1000000>(pB0, pB1, m_reg, mnB, alB);
    RESC(alB);
    finishSM(pB0, pB1, alB, l_reg, pa0, pa1, pa2, pa3); SBAR();
    pv_d0(o, vb0 + bc * SHM_V, pa0, pa1, pa2, pa3); }
  asm volatile("s_waitcnt vmcnt(0)" ::: "memory");
  if (hi == 0) li_l[r32] = l_reg; asm volatile("s_waitcnt lgkmcnt(0)" ::: "memory");
  float rli[16];
#pragma unroll
  for (int r = 0; r < 16; ++r) rli[r] = __builtin_amdgcn_rcpf(li_l[crow(r, hi)]);
  bf* Ow = sd.out + (size_t)(wid * QBLK) * 2048;
#pragma unroll
  for (int r = 0; r < 16; ++r) { int orow = crow(r, hi);
#pragma unroll
    for (int d0 = 0; d0 < 2; ++d0) Ow[(size_t)orow * 2048 + d0 * 32 + r32] = f2b(o[d0][r] * rli[r]); }
#undef SLOAD
#undef SWRITE
#undef SWAIT
#undef MASKT
#undef RESC
#undef KROW
}
#undef KSWZ
#undef SBAR
}

DEV void ph_mla(const Params& p, const Ctx& cx, int last) {
  const int nlat_units = NB * 8 * (N / 256);
  const int nctx_units = last ? 0 : NB * 8 * (LC / 256);
  const int sc = (cx.tid & 15) * 8;
  for (int uu = blockIdx.x; uu < nlat_units + 256; uu += gridDim.x) {
    const int u = uu < nlat_units ? uu : nlat_units + ((uu - nlat_units + 256 - 32) & 255);
    if (u >= nlat_units + nctx_units) continue;
    int qrow0, hh, kb0, nt0, kb1, NT;
    if (u < nlat_units) {
      const int rnd = u / 256, within = u % 256, bh = (rnd * 8 + (within & 7)) % (NB * 8); int qb = within >> 3;
      hh = bh % 8; int b = bh / 8; qrow0 = b * N + qb * 256; kb0 = b * N; nt0 = N / 64; kb1 = NLAT + b * LC; NT = (N + LC) / 64; }
    else { int v = u - nlat_units; int qb = v % (LC / 256); hh = (v / (LC / 256)) % 8; int b = v / (8 * (LC / 256)); qrow0 = NLAT + b * LC + qb * 256; kb0 = NLAT + b * LC; nt0 = LC / 64; kb1 = 0; NT = LC / 64; }
    fa::Src sd;
    sd.q = p.QA() + (size_t)qrow0 * 768 + hh * 96; sd.qstride = 768;
    if (sc < 64) { sd.ksrc = p.KVA() + hh * 128 + sc; sd.kstride = 1024; } else { sd.ksrc = p.P() + C_KR + ((sc - 64) & 31); sd.kstride = PC; }
    sd.vsrc = p.KVA() + hh * 128 + 64 + (sc & 63); sd.vstride = 1024;
    sd.out = p.Y() + (size_t)qrow0 * 2048 + hh * 64; sd.m0 = -1e30f; sd.l0 = 0.f; sd.dq0 = 0;
    fa::unit<6, 102062073, false>(sd, cx.tid, cx.ldsg, kb0, nt0, kb1, NT);
  }
}
DEV void ph_gqa(const Params& p, const Ctx& cx, int l, int last) {
  const int nlat_units = NB * 8 * (N / 256);
  const int nctx_units = last ? 0 : NB * 8 * (LC / 256);
  const int sc = (cx.tid & 15) * 8;
  for (int uu = blockIdx.x; uu < nlat_units + 256; uu += gridDim.x) {
    const int u = uu < nlat_units ? uu : nlat_units + ((uu - nlat_units + 256 - 16) & 255);
    if (u >= nlat_units + nctx_units) continue;
    int qrow0, hh, kb0, nt0, kb1, NT, dq0 = 0;
    if (u < nlat_units) {
      const int rnd = u / 256, within = u % 256, bh = (rnd * 8 + (within & 7)) % (NB * 8); int qb = within >> 3;
      hh = bh % 8; int b = bh / 8;
      int q0 = qb * 256; int klo = q0 - 128 < 0 ? 0 : q0 - 128; int khi = q0 + 384 > N ? N : q0 + 384;
      qrow0 = b * N + q0; kb0 = b * N + klo; nt0 = (khi - klo) / 64; kb1 = NLAT + b * LC; NT = nt0 + LC / 64; dq0 = q0 - klo;
    } else { int v = u - nlat_units; int qb = v % (LC / 256); hh = (v / (LC / 256)) % 8; int b = v / (8 * (LC / 256)); qrow0 = NLAT + b * LC + qb * 256; kb0 = NLAT + b * LC; nt0 = 0; kb1 = kb0; NT = LC / 64; }
    const int kh = hh >> 2;
    fa::Src sd;
    sd.q = p.P() + (size_t)qrow0 * PC + C_GQ + hh * 64; sd.qstride = PC;
    sd.ksrc = p.P() + C_GKV + kh * 64 + (sc & 63); sd.kstride = PC;
    sd.vsrc = p.P() + C_GKV + 128 + kh * 64 + (sc & 63); sd.vstride = PC;
    sd.out = p.Y() + (size_t)qrow0 * 2048 + 1536 + hh * 64;
    sd.m0 = p.in[I_gqa_sink][l * 8 + hh] * 8.0f; sd.l0 = 1.0f; sd.dq0 = dq0;
    fa::unit<4, 125000000, true>(sd, cx.tid, cx.ldsg, kb0, nt0, kb1, NT);
  }
}
#endif


namespace hy {
constexpr int NF = 2 * N;
struct f2 { float x, y; };
DEV f2 cmul(f2 a, f2 b) { f2 r; r.x = a.x * b.x - a.y * b.y; r.y = a.x * b.y + a.y * b.x; return r; }
#ifndef CPU_SIM
DEV f2 twid(const f2*, int k) { const float x = (float)k * (1.0f / (float)NF); return f2{__builtin_amdgcn_cosf(x), -__builtin_amdgcn_sinf(x)}; }
#else
DEV f2 twid(const f2* tw, int k) { return tw[k]; }
#endif
DEV f2 cmulc(f2 a, f2 b) { f2 r; r.x = a.x * b.x + a.y * b.y; r.y = a.y * b.x - a.x * b.y; return r; }
DEV void fwd_pass(f2* buf, const f2* tw, int L, int tid, int nthr) {
  const int Q = L >> 2, tws = NF / L;
  for (int u = tid; u < NF / 4; u += nthr) {
    const int g = u / Q, j = u - g * Q, base = g * L + j;
    const f2 x0 = buf[base], x1 = buf[base + Q], x2 = buf[base + 2 * Q], x3 = buf[base + 3 * Q];
    f2 a0{x0.x + x2.x, x0.y + x2.y}, a1{x0.x - x2.x, x0.y - x2.y}, a2{x1.x + x3.x, x1.y + x3.y};
    f2 d{x1.x - x3.x, x1.y - x3.y}; f2 a3{d.y, -d.x};
    f2 y0{a0.x + a2.x, a0.y + a2.y}, y1{a1.x + a3.x, a1.y + a3.y}, y2{a0.x - a2.x, a0.y - a2.y}, y3{a1.x - a3.x, a1.y - a3.y};
    buf[base] = y0; buf[base + Q] = cmul(y1, twid(tw, j * tws)); buf[base + 2 * Q] = cmul(y2, twid(tw, 2 * j * tws)); buf[base + 3 * Q] = cmul(y3, twid(tw, 3 * j * tws));
  }
}
DEV void inv_pass(f2* buf, const f2* tw, int L, int tid, int nthr) {
  const int Q = L >> 2, tws = NF / L;
  for (int u = tid; u < NF / 4; u += nthr) {
    const int g = u / Q, j = u - g * Q, base = g * L + j;
    const f2 u0 = buf[base], u1 = cmulc(buf[base + Q], twid(tw, j * tws)), u2 = cmulc(buf[base + 2 * Q], twid(tw, 2 * j * tws)), u3 = cmulc(buf[base + 3 * Q], twid(tw, 3 * j * tws));
    f2 a0{u0.x + u2.x, u0.y + u2.y}, a1{u0.x - u2.x, u0.y - u2.y}, a2{u1.x + u3.x, u1.y + u3.y};
    f2 d{u1.x - u3.x, u1.y - u3.y}; f2 a3{-d.y, d.x};
    buf[base] = f2{a0.x + a2.x, a0.y + a2.y}; buf[base + Q] = f2{a1.x + a3.x, a1.y + a3.y};
    buf[base + 2 * Q] = f2{a0.x - a2.x, a0.y - a2.y}; buf[base + 3 * Q] = f2{a1.x - a3.x, a1.y - a3.y};
  }
}
DEV void s1_taps(const Params& p, f2* buf, float* red, int c, int tid, int nthr) {
  float ss = 0.f;
#pragma unroll 8
  for (int k = tid; k < NF; k += nthr) {
    float v = 0.f;
    if (k < N) v = p.F()[(size_t)k * 1024 + c];
    else if (k > N) v = p.F()[(size_t)(NF - k) * 1024 + 512 + c];
    buf[k] = f2{v, 0.f}; ss += v * v;
  }
  red[tid] = ss;
}
DEV float red_total(const float* red, int nthr) { float s = 0.f; for (int i = 0; i < nthr; ++i) s += red[i]; return s; }
DEV void s3_store(const f2* buf, unsigned* hs, int tid, int nthr) {
  for (int k = tid; k < NF; k += nthr) hs[k] = (unsigned)f2b(buf[k].x).v | ((unsigned)f2b(buf[k].y).v << 16);
}
DEV void s4_loadz(const Params& p, f2* buf, int c, int tid, int nthr) {
#pragma unroll 8
  for (int t = tid; t < NF; t += nthr) {
    f2 v{0.f, 0.f};
    if (t < N) { v.x = b2f(p.Z()[(size_t)t * 512 + c]); v.y = b2f(p.Z()[(size_t)(N + t) * 512 + c]); }
    buf[t] = v;
  }
}
DEV void s6_mul(f2* buf, const unsigned* hs, int tid, int nthr) {
  for (int k = tid; k < NF; k += nthr) {
    union { unsigned u; float f; } a, b; const unsigned w = hs[k]; a.u = w << 16; b.u = w & 0xFFFF0000u;
    buf[k] = cmul(buf[k], f2{a.f, b.f});
  }
}
DEV void s8_out(const Params& p, const f2* buf, const float* red, int l, int c, int tid, int nthr) {
  const float fn = 1.0f / sqrtf(red_total(red, nthr) + EPS) * (1.0f / (float)NF);
  const float* cw = p.in[I_hy_conv_w] + l * 3 * 1536; const float cb = p.in[I_hy_conv_b][l * 1536 + c];
  const float w0 = cw[c], w1 = cw[1536 + c], w2 = cw[2 * 1536 + c];
  const float skip = p.in[I_hy_skip][l * 512 + c];
#pragma unroll 4
  for (int i = tid; i < 2 * N; i += nthr) {
    const int b = i / N, t = i - b * N;
    const size_t r = (size_t)b * N + t;
    const float conv = (b ? buf[t].y : buf[t].x) * fn;
    float x0 = cb + w1 * b2f(p.P()[r * PC + C_HU + c]);
    if (t > 0) x0 += w0 * b2f(p.P()[(r - 1) * PC + C_HU + c]);
    if (t < N - 1) x0 += w2 * b2f(p.P()[(r + 1) * PC + C_HU + c]);
    const float y = conv + skip * b2f(p.Z()[r * 512 + c]);
    p.Y()[r * 2048 + 1024 + c] = f2b(x0 * y);
  }
}
#ifndef CPU_SIM
DEV void channel(const Params& p, int l, int c, int tid, f2* buf, float* red, unsigned* hs) {
  const f2* tw = (const f2*)p.tw();
#ifndef HY_EXP
#define HY_EXP 0
#endif
  __syncthreads();
  if (HY_EXP != 2) s1_taps(p, buf, red, c, tid, 512); __syncthreads();
  if (HY_EXP != 1) for (int L = NF; L >= 4; L >>= 2) { fwd_pass(buf, tw, L, tid, 512); __syncthreads(); }
  s3_store(buf, hs, tid, 512); __syncthreads();
  if (HY_EXP != 2) s4_loadz(p, buf, c, tid, 512); __syncthreads();
  if (HY_EXP != 1) for (int L = NF; L >= 4; L >>= 2) { fwd_pass(buf, tw, L, tid, 512); __syncthreads(); }
  s6_mul(buf, hs, tid, 512); __syncthreads();
  if (HY_EXP != 1) for (int L = 4; L <= NF; L <<= 2) { inv_pass(buf, tw, L, tid, 512); __syncthreads(); }
  if (HY_EXP != 2) s8_out(p, buf, red, l, c, tid, 512);
}
#endif
}


namespace tz {
constexpr int NBLK = N / 64;
constexpr int PADB = 31;
constexpr int ZLEN = (NBLK + 2 * PADB) * 64;
constexpr int HLEN = 2 * N + 16;
DEV int a_index(int m, int r, int h) { return N - m - r + 8 * h; }
DEV int b_index(int t1, int Dd, int ks, int h) { return 64 * (t1 - Dd + PADB) + 16 * ks + 8 * h; }
#ifndef CPU_SIM
using bf16x8 = __attribute__((ext_vector_type(8))) short;
using f32x16 = __attribute__((ext_vector_type(16))) float;
using u32x4 = __attribute__((ext_vector_type(4))) unsigned;
DEV bf16x8 load_afrag(const unsigned short* Hr, int e) {
  const unsigned* wp = (const unsigned*)(Hr + (e & ~1));
  const unsigned w0 = wp[0], w1 = wp[1], w2 = wp[2], w3 = wp[3], w4 = wp[4];
  const unsigned sh = (unsigned)(e & 1) << 4;
  u32x4 o;
  o.x = __builtin_amdgcn_alignbit(w1, w0, sh); o.y = __builtin_amdgcn_alignbit(w2, w1, sh); o.z = __builtin_amdgcn_alignbit(w3, w2, sh); o.w = __builtin_amdgcn_alignbit(w4, w3, sh);
  return *reinterpret_cast<bf16x8*>(&o);
}
DEV void channel(const Params& p, int l, int c, int tid, char* lds) {
  unsigned short* zp = (unsigned short*)lds;
  float* red = (float*)(zp + 2 * ZLEN);
  unsigned short* Hr = (unsigned short*)(red + 512);
  float* cv = (float*)Hr;
  const int lane = tid & 63, w = tid >> 6, r = lane & 31, h = lane >> 5;
  __syncthreads();
  float ss = 0.f;
  const float* ff = p.F() + (size_t)c * (N + LC); const float* fb = p.F() + (size_t)(512 + c) * (N + LC);
#pragma unroll 4
  for (int t = tid * 4; t < N; t += 2048) {
    const float4 a = *(const float4*)(ff + t), b = *(const float4*)(fb + t);
    ss += a.x * a.x + a.y * a.y + a.z * a.z + a.w * a.w + b.x * b.x + b.y * b.y + b.z * b.z + b.w * b.w;
    Hr[N - t] = f2b(a.x).v; Hr[N - t - 1] = f2b(a.y).v; Hr[N - t - 2] = f2b(a.z).v; Hr[N - t - 3] = f2b(a.w).v;
    if (t > 0) Hr[N + t] = f2b(b.x).v;
    Hr[N + t + 1] = f2b(b.y).v; Hr[N + t + 2] = f2b(b.z).v; Hr[N + t + 3] = f2b(b.w).v;
  }
  if (tid == 0) Hr[0] = 0;
  if (tid < 16) Hr[2 * N + tid] = 0;
  red[tid] = ss;
  for (int i = tid; i < 2 * PADB * 64; i += 512) {
    const int side = i / (PADB * 64), k = i % (PADB * 64);
    const int off = side ? (PADB + NBLK) * 64 + k : k;
    zp[off] = 0; zp[ZLEN + off] = 0;
  }
  { const unsigned short* zt = (const unsigned short*)p.Z() + (size_t)c * NB * N;
#pragma unroll 4
    for (int i = tid * 8; i < 2 * N; i += 4096) { const int b = i / N, t = i - b * N; *(uint4*)(zp + b * ZLEN + PADB * 64 + t) = *(const uint4*)(zt + i); } }
  __syncthreads();
  float tot = 0.f;
  for (int i = 0; i < 512; ++i) tot += red[i];
  const float fn = 1.0f / sqrtf(tot + EPS);
  const int t1 = 32 * (w & 3) + r;
  const unsigned short* zb = zp + (w >> 2) * ZLEN;
  f32x16 acc0 = {}, acc1 = {};
  const int Dlo = 32 * (w & 3) - (NBLK - 1), Dhi = 32 * (w & 3) + 31;
#define TZ_LOAD(AF, BF, PA, PB) do { _Pragma("unroll") for (int ks = 0; ks < 4; ++ks) BF[ks] = *reinterpret_cast<const bf16x8*>((PB) + 16 * ks); \
    _Pragma("unroll") for (int q = 0; q < 6; ++q) { const unsigned* wq_ = (PA) + 8 * (5 - q); const unsigned w0_ = wq_[0], w1_ = wq_[1], w2_ = wq_[2], w3_ = wq_[3], w4_ = wq_[4]; u32x4 o_; \
      o_.x = __builtin_amdgcn_alignbit(w1_, w0_, shA); o_.y = __builtin_amdgcn_alignbit(w2_, w1_, shA); o_.z = __builtin_amdgcn_alignbit(w3_, w2_, shA); o_.w = __builtin_amdgcn_alignbit(w4_, w3_, shA); \
      AF[q] = *reinterpret_cast<bf16x8*>(&o_); } } while (0)
#define TZ_MMA(AF, BF) do { _Pragma("unroll") for (int ks = 0; ks < 4; ++ks) { \
    acc0 = __builtin_amdgcn_mfma_f32_32x32x16_bf16(AF[3 - ks], BF[ks], acc0, 0, 0, 0); acc1 = __builtin_amdgcn_mfma_f32_32x32x16_bf16(AF[5 - ks], BF[ks], acc1, 0, 0, 0); } } while (0)
  const unsigned shA = (unsigned)(r & 1) << 4;
  const unsigned* pa = (const unsigned*)Hr + ((a_index(64 * Dlo - 48 + 80, r, h) & ~1) >> 1);
  const unsigned short* pb = zb + b_index(t1, Dlo, 0, h);
#define TZ_LOAD4(AF, BF, PREV, PA, PB) do { _Pragma("unroll") for (int ks = 0; ks < 4; ++ks) BF[ks] = *reinterpret_cast<const bf16x8*>((PB) + 16 * ks); \
    AF[0] = PREV[4]; AF[1] = PREV[5]; \
    _Pragma("unroll") for (int q = 2; q < 6; ++q) { const unsigned* wq_ = (PA) + 8 * (5 - q); const unsigned w0_ = wq_[0], w1_ = wq_[1], w2_ = wq_[2], w3_ = wq_[3], w4_ = wq_[4]; u32x4 o_; \
      o_.x = __builtin_amdgcn_alignbit(w1_, w0_, shA); o_.y = __builtin_amdgcn_alignbit(w2_, w1_, shA); o_.z = __builtin_amdgcn_alignbit(w3_, w2_, shA); o_.w = __builtin_amdgcn_alignbit(w4_, w3_, shA); \
      AF[q] = *reinterpret_cast<bf16x8*>(&o_); } } while (0)
  bf16x8 afA[6], bfA[4], afB[6], bfB[4];
  TZ_LOAD(afA, bfA, pa, pb);
#pragma unroll 1
  for (int Dd = Dlo; Dd + 2 <= Dhi; Dd += 2) {
    TZ_LOAD4(afB, bfB, afA, pa - 32, pb - 64);
    TZ_MMA(afA, bfA);
    pa -= 64; pb -= 128;
    TZ_LOAD4(afA, bfA, afB, pa, pb);
    TZ_MMA(afB, bfB);
  }
  TZ_MMA(afA, bfA);
#undef TZ_LOAD4
#undef TZ_LOAD
#undef TZ_MMA
  static_assert((NBLK + 31) % 2 == 1, "K-loop pairing assumes an odd number of steps");
  __syncthreads();
  { int t1e = t1, he = h;
    asm volatile("" : "+v"(t1e), "+v"(he));
    float* cvb = cv + (w >> 2) * N + 64 * t1e + 4 * he;
#pragma unroll
    for (int g = 0; g < 4; ++g) {
      *(float4*)(cvb + 8 * g) = float4{acc0[4 * g], acc0[4 * g + 1], acc0[4 * g + 2], acc0[4 * g + 3]};
      *(float4*)(cvb + 32 + 8 * g) = float4{acc1[4 * g], acc1[4 * g + 1], acc1[4 * g + 2], acc1[4 * g + 3]};
    } }
  __syncthreads();
  { const float skip = p.in[I_hy_skip][l * 512 + c];
    unsigned short* xy = (unsigned short*)p.XYT() + (size_t)c * NB * N;
#pragma unroll 4
    for (int i = tid * 8; i < 2 * N; i += 4096) {
      const int b = i / N, t = i - b * N;
      float x0[8]; unpack8(*(const uint4*)(xy + i), x0);
      float zf[8]; unpack8(*(const uint4*)(zp + b * ZLEN + PADB * 64 + t), zf);
      const float4 ca = *(const float4*)(cv + i), cb4 = *(const float4*)(cv + i + 4);
      float o[8];
      o[0] = x0[0] * (ca.x * fn + skip * zf[0]); o[1] = x0[1] * (ca.y * fn + skip * zf[1]); o[2] = x0[2] * (ca.z * fn + skip * zf[2]); o[3] = x0[3] * (ca.w * fn + skip * zf[3]);
      o[4] = x0[4] * (cb4.x * fn + skip * zf[4]); o[5] = x0[5] * (cb4.y * fn + skip * zf[5]); o[6] = x0[6] * (cb4.z * fn + skip * zf[6]); o[7] = x0[7] * (cb4.w * fn + skip * zf[7]);
      store8bf(p.YT() + (size_t)c * NB * N + i, o);
    } }
}
DEV void xyt_to_y(const Params& p, int tid, char* lds) {
  unsigned short* tl = (unsigned short*)lds;
  for (int tile = blockIdx.x; tile < (NLAT / 64) * 8; tile += gridDim.x) {
    const int rt = tile >> 3, c0 = (tile & 7) * 64;
    const int bq = (rt * 64) / N, tq = (rt * 64) % N;
    __syncthreads();
    { const int cc = tid >> 3, tg = (tid & 7) * 8;
      const uint4 v = *(const uint4*)((const unsigned short*)p.YT() + ((size_t)(c0 + cc) * NB + bq) * N + tq + tg);
      const unsigned short* e = (const unsigned short*)&v;
#pragma unroll
      for (int j = 0; j < 8; ++j) tl[(tg + j) * 72 + cc] = e[j]; }
    __syncthreads();
    { const int tr = tid >> 3, cg8 = (tid & 7) * 8;
      *(uint4*)((unsigned short*)p.Y() + (size_t)(rt * 64 + tr) * 2048 + 1024 + c0 + cg8) = *(const uint4*)(tl + tr * 72 + cg8); }
  }
}
#endif
}

#ifndef CPU_SIM
DEV void ph_hyena_fft(const Params& p, const Ctx& cx, int l) {
  const int nb = gridDim.x;
  for (int i = blockIdx.x; i < 512; i += nb) {
    const int xcd = i & 7, idx = i >> 3;
    const int c = xcd * 64 + idx;
    tz::channel(p, l, c, cx.tid, cx.ldsg);
  }
}
#endif


#ifndef CPU_SIM
DEV void ph_hyena_ctx(const Params& p, const Ctx& cx, int l) {
  constexpr int LP = 33;
  float* Zs = (float*)cx.ldsg; float* Ff = Zs + LC * LP; float* Fb = Ff + LC * LP;
  const int tid = cx.tid, c = tid & 31, t0 = tid >> 5;
  const float* cw = p.in[I_hy_conv_w] + l * 3 * 1536; const float* cbv = p.in[I_hy_conv_b] + l * 1536;
  constexpr int TP = 8, TLEN = LC / TP;
  for (int task = blockIdx.x; task < NB * 16 * TP; task += gridDim.x) {
    const int tp = task % TP, cgp = (task / TP) & 15, b = task / (TP * 16), c0 = cgp * 32;
    const int rbase = NLAT + b * LC;
    __syncthreads();
    for (int idx = tid; idx < LC * 32; idx += 512) {
      { const int t = idx >> 5, cc = idx & 31; Zs[t * LP + cc] = b2f(p.Z()[(size_t)(rbase + t) * 512 + c0 + cc]); }
      { const int cc = idx / LC, t = idx % LC;
        Ff[t * LP + cc] = p.F()[(size_t)(c0 + cc) * (N + LC) + N + t]; Fb[t * LP + cc] = p.F()[(size_t)(512 + c0 + cc) * (N + LC) + N + t]; }
    }
    __syncthreads();
    float ss = 0.f;
    for (int t = 0; t < LC; ++t) { const float a = Ff[t * LP + c], bb = Fb[t * LP + c]; ss += a * a + bb * bb; }
    const float fn = 1.0f / sqrtf(ss + EPS);
    const int cg_ = c0 + c;
    const float w0 = cw[cg_], w1 = cw[1536 + cg_], w2 = cw[2 * 1536 + cg_], cb0 = cbv[cg_], skip = p.in[I_hy_skip][l * 512 + cg_];
    for (int t = tp * TLEN + t0; t < (tp + 1) * TLEN; t += 16) {
      float acc = 0.f;
      for (int s_ = 0; s_ <= t; ++s_) acc += Ff[(t - s_) * LP + c] * Zs[s_ * LP + c];
      for (int s_ = t + 1; s_ < LC; ++s_) acc += Fb[(s_ - t) * LP + c] * Zs[s_ * LP + c];
      const size_t r = (size_t)(rbase + t);
      float x0 = cb0 + w1 * b2f(p.P()[r * PC + C_HU + cg_]);
      if (t > 0) x0 += w0 * b2f(p.P()[(r - 1) * PC + C_HU + cg_]);
      if (t < LC - 1) x0 += w2 * b2f(p.P()[(r + 1) * PC + C_HU + cg_]);
      p.Y()[r * 2048 + 1024 + cg_] = f2b(x0 * (acc * fn + skip * Zs[t * LP + c]));
    }
  }
}
#endif

constexpr int NOSH = 30;

#ifndef CPU_SIM
#define SIDE_PREP(NB0, PARTS) do { if (l == 0 && (int)blockIdx.x >= (NB0)) { PrepCtx pc; pc.tid = cx.tid; pc.tl = (float*)cx.ldsg; pc.rank = (int)blockIdx.x - (NB0); pc.nranks = (int)gridDim.x - (NB0); \
    ph_prep(p, 1, pc, gtid - (NB0) * 512, gsz - (NB0) * 512, (PARTS)); } } while (0)
#else
#define SIDE_PREP(NB0, PARTS)
#endif
DEV void run_phase(const Params& p, int ph, const Ctx& cx) {
  const i64 gtid = cx.gtid, gsz = cx.gsz;
  if (ph == 0) { ph_init(p, gtid, gsz); return; }
  if (ph == NPHASES - 1) { ph_final(p, gtid, gsz); return; }
  const int l = (ph - 1) / PH_PER_LAYER, s = (ph - 1) % PH_PER_LAYER;
  const int last = (l == 1);
  const int nr = last ? NLAT : TT;
#ifdef ONLY
  if (s != ONLY) return;
#endif
  switch (s) {
    case 0: {
      PrepCtx pc;
#ifndef CPU_SIM
      pc.tid = cx.tid; pc.tl = (float*)cx.ldsg; pc.rank = (int)blockIdx.x; pc.nranks = (int)gridDim.x;
      if (l == 0) ph_prep(p, l, pc, gtid, gsz, 15); else ph_prep(p, l, pc, gtid, gsz, 8);
#else
      pc.gtid = gtid; pc.gsz = gsz;
      ph_prep(p, l, pc, gtid, gsz, 15);
#endif
      ph_norm(p, l, 0, TT, gtid, gsz);
    } break;
    case 1: { GemmDesc g{p.h(), p.W_in(), D, D, D, TT, 3840, NOSH, 0}; EpiInproj e{p}; run_gemm(cx, g, e); } break;
#ifndef CPU_SIM
    case 2: ph_B0(p, l, gtid, gsz, cx.ldsg, cx.tid); break;
#else
    case 2: ph_B0(p, l, gtid, gsz); break;
#endif
    case 3: {
      { const int n_uq = (nr / 256) * 3, n_ukv = (TT / 256) * 4, n_lru = (TT / 256) * 8;
        { GemmDesc g{p.P() + C_CQ, p.W_uq(), PC, 256, 256, nr, 768, NOSH, 0}; EpiUq e{p}; run_gemm(cx, g, e); }
        { GemmDesc g{p.P() + C_CKV, p.W_ukv(), PC, 256, 256, TT, 1024, NOSH, 0}; g.unit_off = n_uq; EpiUkv e{p}; run_gemm(cx, g, e); }
        { GemmDesc g{p.XC(), p.W_lru(), 512, 256, 256, TT, 2048, 2, 256}; g.unit_off = n_uq + n_ukv; EpiLru e{p, l, p.in[I_lru_b_r], p.in[I_lru_b_i]}; run_gemm(cx, g, e); }
#ifndef CPU_SIM
        { GemmDesc g{p.W3T(), p.hdn2b() + (size_t)l * (N + LC) * 256, 256, 256, 256, 1024, N + LC, NOSH, 0}; g.unit_off = n_uq + n_ukv + n_lru; EpiFilt e{p}; run_gemm(cx, g, e); }
#endif
      }
#ifdef CPU_SIM
      ph_fnorm(p, gtid, gsz);
#endif
    } break;
    case 4:
      ph_lru1(p, gtid, gsz);
#ifndef CPU_SIM
#if PROBE_K >= 0
#define SUBSTAMP(k) do { cg::this_grid().sync(); if (l == 0) { const unsigned long long t_ = wall_clock64(); if (blockIdx.x == 0 && cx.tid == 0) ((unsigned long long*)(p.ws + WL.ts))[40 + (k)] = t_; } } while (0)
#else
#define SUBSTAMP(k)
#endif
      if (REPEAT_S == 40) ph_lru1(p, gtid, gsz);
      SUBSTAMP(0);
      ph_hyena_fft(p, cx, l);
      if (REPEAT_S == 41) ph_hyena_fft(p, cx, l);
      SUBSTAMP(1);
      ph_gqa(p, cx, l, last);
      if (REPEAT_S == 42) ph_gqa(p, cx, l, last);
      SUBSTAMP(2);
      ph_mla(p, cx, last);
      if (REPEAT_S == 43) ph_mla(p, cx, last);
      SUBSTAMP(3);
      if (!last) ph_hyena_ctx(p, cx, l);
      if (REPEAT_S == 44 && !last) ph_hyena_ctx(p, cx, l);
#else
      ph_C(p, l, last, gtid, gsz);
#endif
      break;
#ifndef CPU_SIM
    case 5: ph_lru3(p, last, gtid, gsz, (float*)cx.ldsg, cx.tid); __syncthreads(); tz::xyt_to_y(p, cx.tid, cx.ldsg); break;
#else
    case 5: ph_lru3(p, last, gtid, gsz, nullptr, 0); break;
#endif
    case 6: { GemmDesc g{p.h(), p.W_g(), D, D, D, nr, 4096, NOSH, 0}; EpiGateAll e{p}; run_gemm(cx, g, e); } break;
    case 7: { GemmDesc g{p.Y(), p.W_br(), 2048, 512, 512, nr, 1024, NOSH, 0, 4, 512, 1024 * 512}; EpiBranchSub e{p}; run_gemm(cx, g, e); }
      SIDE_PREP(8, 1);
      break;
    case 8: { GemmDesc g{p.M(), p.W_out(), D, D, D, nr, 1024, NOSH, 0}; EpiOut e{p, l, 1.0f, l == 0 ? p.in[I_x] : (const float*)p.xcur(), l == 0 ? p.in[I_ctx] : (const float*)p.xcur() + (size_t)NLAT * D}; run_gemm(cx, g, e); }
#ifndef CPU_SIM
      if (l == 0 && blockIdx.x >= 8) ph_cvt_tables(p, l, gtid - 8 * 512, gsz - 8 * 512);
#endif
      break;
    case 9:
#ifndef CPU_SIM
      if (l != 0) ph_cvt_tables(p, l, gtid, gsz);
#endif
      ph_norm(p, l, 1, nr, gtid, gsz); break;
    case 10: { GemmDesc g{p.h(), p.W_q(), D, D, D, nr, 1024, NOSH, 0}; EpiPQ e{p}; run_gemm(cx, g, e); }
      SIDE_PREP(8, 2);
      break;
    case 11: { GemmDesc g{p.PQ(), p.W_key(), 1024, 256, 256, nr, 2048, 1, 256}; EpiSC e{p}; run_gemm(cx, g, e); }
      SIDE_PREP(16, 4);
      break;
#ifndef CPU_SIM
    case 12: ph_peer(p, l, nr, cx.tid, cx.ldsg); if (REPEAT_S == 52) { __syncthreads(); ph_peer(p, l, nr, cx.tid, cx.ldsg, 0.0f); } break;
#else
    case 12: ph_E2a(p, nr, gtid, gsz); break;
    case 13: ph_E2b(p, nr, gtid, gsz); break;
    case 14: ph_E3(p, l, nr, gtid, gsz); break;
    case 15: ph_E4(p, l, nr, gtid, gsz); break;
#endif
  }
}

#ifdef CPU_SIM
static void fill_params(Params& p, void* const* d_in, void* d_out, void* d_ws) {
  p.in.t = (const float* const*)d_in;
  p.out = (float*)d_out;
  p.ws = (char*)d_ws;
}
#endif


#ifndef CPU_SIM
#define XB_TMO      128
#define XB_XCNT(j)  (256  + 64 * (j))
#define XB_XSUB(j)  (1280 + 64 * (j))
#define XB_XGEN(j)  (2304 + 64 * (j))
#define XB_TOP      3328
#define XB_TOPGEN   3392
#define XCD_BAR_WORDS 3456
#define XB_SPIN_CAP (1u << 18)
#define XB_LAS __attribute__((address_space(3)))
__device__ __forceinline__ unsigned xb_ld(unsigned* p)              { return __hip_atomic_load(p, __ATOMIC_RELAXED, __HIP_MEMORY_SCOPE_AGENT); }
__device__ __forceinline__ unsigned xb_add(unsigned* p, unsigned v) { return __hip_atomic_fetch_add(p, v, __ATOMIC_RELAXED, __HIP_MEMORY_SCOPE_AGENT); }
__device__ __forceinline__ unsigned xb_xcc_id() { return (unsigned)__builtin_amdgcn_s_getreg((3 << 11) | 20) & 0xFu; }
#define XB_SPIN(cond, bar) do { unsigned _sp = 0; while (cond) { __builtin_amdgcn_s_sleep(1); \
    if ((++_sp & 255u) == 0u) { if (xb_ld(&(bar)[XB_TMO])) break; if (_sp > XB_SPIN_CAP) { atomicAdd(&(bar)[XB_TMO], 1u); break; } } } } while (0)
struct XcdBarrier { unsigned* bar; unsigned x; volatile XB_LAS unsigned* st; };
__device__ __forceinline__ XcdBarrier xcd_barrier_post(unsigned* bar, volatile XB_LAS unsigned* st) {
  XcdBarrier b; b.bar = bar; b.x = xb_xcc_id(); b.st = st;
  if (threadIdx.x == 0) (void)xb_add(&bar[XB_XCNT(b.x)], 1u);
  return b;
}
__device__ __forceinline__ void xcd_barrier_complete(unsigned* bar, unsigned x, unsigned& nloc, unsigned& nx) {
  const unsigned G = gridDim.x * gridDim.y * gridDim.z;
  unsigned sum, cnt, mine, sp = 0u;
  for (;;) {
    sum = 0u; cnt = 0u; mine = 0u;
#pragma unroll
    for (unsigned j = 0; j < 16; ++j) { const unsigned c = xb_ld(&bar[XB_XCNT(j)]); sum += c; cnt += (c > 0u) ? 1u : 0u; mine = (j == x) ? c : mine; }
    if (sum == G) break;
    __builtin_amdgcn_s_sleep(1);
    if ((++sp & 255u) == 0u) { if (xb_ld(&bar[XB_TMO])) break; if (sp > XB_SPIN_CAP) { atomicAdd(&bar[XB_TMO], 1u); break; } }
  }
  nloc = mine > 0u ? mine : 1u; nx = cnt > 0u ? cnt : 1u;
}
__device__ __forceinline__ void xcd_barrier(const XcdBarrier& b) {
  asm volatile("s_waitcnt vmcnt(0)" ::: "memory");
  __syncthreads();
  if (threadIdx.x == 0) {
    unsigned* bar = b.bar;
    __builtin_amdgcn_s_waitcnt(0);
    unsigned nloc = b.st[0], nx = b.st[1];
    if (nloc == 0u) { xcd_barrier_complete(bar, b.x, nloc, nx); b.st[0] = nloc; b.st[1] = nx; }
    const unsigned old = xb_add(&bar[XB_XSUB(b.x)], 1u);
    const unsigned gen = old / nloc;
    if (old + 1u == (gen + 1u) * nloc) {
      __builtin_amdgcn_fence(__ATOMIC_RELEASE, "agent");
      asm volatile("s_waitcnt vmcnt(0)" ::: "memory");
      const unsigned og = xb_add(&bar[XB_TOP], 1u);
      const unsigned tg = og / nx;
      if (og + 1u == (tg + 1u) * nx) xb_add(&bar[XB_TOPGEN], 1u);
      else XB_SPIN(xb_ld(&bar[XB_TOPGEN]) == tg, bar);
      __builtin_amdgcn_fence(__ATOMIC_ACQUIRE, "agent");
      xb_add(&bar[XB_XGEN(b.x)], 1u);
      asm volatile("s_waitcnt vmcnt(0)" ::: "memory");
    } else {
      XB_SPIN(xb_ld(&bar[XB_XGEN(b.x)]) == gen, bar);
      __builtin_amdgcn_fence(__ATOMIC_ACQUIRE, "agent");
      asm volatile("s_waitcnt vmcnt(0)" ::: "memory");
    }
  }
  __syncthreads();
}
#endif

#ifndef CPU_SIM
static_assert(TT % 256 == 0 && NLAT % 256 == 0 && (N + LC) % 256 == 0, "row / column tiles");
static_assert(N / 256 == 32 && NB * 8 * (N / 256) == 512, "attention unit mapping assumes 32 q-blocks per (batch, head) and a 256-block grid");
constexpr int LDS_PHASE_BYTES = 131072 + 4096;
constexpr int LDS_BYTES = LDS_PHASE_BYTES + 16;
__global__ void __launch_bounds__(512, 2) mega_kernel(KArgs ka) {
  extern __shared__ __attribute__((aligned(16))) unsigned char shm[];
  cg::grid_group grid = cg::this_grid();
#if PROBE_K >= 0
  unsigned long long* const tsp = (unsigned long long*)(ka.ws + WL.ts);
#endif
  {
    int tid = threadIdx.x;
    asm volatile("" : "+v"(tid));
    const i64 gtid = (i64)blockIdx.x * 512 + tid, gsz = (i64)gridDim.x * 512;
    ph_init(ka, gtid, gsz, (char*)shm, tid);
    if (gtid < N_IN) ((const float**)(ka.ws + WL.tbl))[gtid] = ka.in[gtid];
#if PROBE_K >= 0
    { const unsigned long long t_ = wall_clock64(); if (gtid == 0) tsp[0] = t_; }
#endif
  }
  volatile XB_LAS unsigned* xst = (volatile XB_LAS unsigned*)(shm + LDS_PHASE_BYTES);
  if (threadIdx.x == 0) { xst[0] = 0u; xst[1] = 0u; }
  __syncthreads();
  const XcdBarrier xb = xcd_barrier_post((unsigned*)(ka.ws + WL.bar), xst);
  grid.sync();
#if PROBE_K >= 0
  { const unsigned long long t_ = wall_clock64(); if (blockIdx.x == 0 && threadIdx.x == 0) tsp[1] = t_; }
#endif
  Params p; p.out = ka.out; p.ws = ka.ws; p.in.t = (const float* const*)(ka.ws + WL.tbl);
  for (int ph = 1; ph < NPHASES - 1; ++ph) {
    int tid = threadIdx.x;
    asm volatile("" : "+v"(tid));
    Ctx cx;
    cx.tid = tid;
    cx.gtid = (i64)blockIdx.x * 512 + tid; cx.gsz = (i64)gridDim.x * 512;
    cx.lds = (PG8_LAS unsigned char*)shm; cx.ldsg = (char*)shm;
    run_phase(p, ph, cx);
    if (REPEAT_S >= 0 && REPEAT_S < 40 && (ph - 1) % PH_PER_LAYER == REPEAT_S) { __syncthreads(); run_phase(p, ph, cx); }
    xcd_barrier(xb);
#if PROBE_K >= 0
    { const unsigned long long t_ = wall_clock64(); if (blockIdx.x == 0 && threadIdx.x == 0) tsp[ph + 1] = t_; }
    if (ph == NPHASES - 2) grid.sync();
#endif
  }
  {
    int tid = threadIdx.x;
    asm volatile("" : "+v"(tid));
    ph_final(p, (i64)blockIdx.x * 512 + tid, (i64)gridDim.x * 512);
  }
}

extern "C" void kernel_launch(void* const* d_in, const int* in_sizes, int n_in, void* d_out, int out_size,
                              void* d_ws, size_t ws_size, hipStream_t stream) {
  static int grid_blocks = 0;
  if (!grid_blocks) {
    int dev = 0, cus = 0, per_cu = 0;
    (void)hipGetDevice(&dev);
    (void)hipDeviceGetAttribute(&cus, hipDeviceAttributeMultiprocessorCount, dev);
    if (hipFuncSetAttribute((const void*)mega_kernel, hipFuncAttributeMaxDynamicSharedMemorySize, LDS_BYTES) != hipSuccess)
      fprintf(stderr, "hipFuncSetAttribute failed\n");
    (void)hipOccupancyMaxActiveBlocksPerMultiprocessor(&per_cu, mega_kernel, 512, LDS_BYTES);
    if (per_cu > 1) per_cu = 1;
    if (per_cu < 1) per_cu = 1;
    grid_blocks = cus * per_cu;
  }
  (void)hipMemsetAsync((char*)d_ws + WL.bar, 0, (size_t)3456 * 4, stream);
  KArgs ka;
  std::memset((void*)&ka, 0, sizeof(ka));
  for (int i = 0; i < N_IN; ++i) ka.in[i] = (const float*)d_in[i];
  ka.out = (float*)d_out; ka.ws = (char*)d_ws;
  void* args[] = {&ka};
  hipError_t e = hipLaunchCooperativeKernel((void*)mega_kernel, dim3(grid_blocks), dim3(512), args, LDS_BYTES, stream);
  if (e != hipSuccess) fprintf(stderr, "cooperative launch failed: %s (grid %d)\n", hipGetErrorString(e), grid_blocks);
}
#endif
```

```cpp
#ifndef CPU_SIM
#include <hip/hip_runtime.h>
#include <hip/hip_cooperative_groups.h>
#include <cstdio>
#include <cstring>
namespace cg = cooperative_groups;
#define DEV __device__ __forceinline__
#define DEVN __device__ __forceinline__
#define MDEV __device__ __forceinline__
typedef _Float16 sc_t;
#else
#include <cmath>
#include <cstdio>
#include <cstdint>
#include <cstring>
#define DEV static inline
#define DEVN static
#define MDEV inline
typedef float sc_t;
#endif

#ifndef REPEAT_S
#define REPEAT_S -1
#endif
#ifndef PROBE_K
#define PROBE_K -1
#endif
#ifndef SEQ_N
#define SEQ_N 8192
#endif
#ifndef CTX_L
#define CTX_L 256
#endif

typedef long long i64;

constexpr int D = 1024, NB = 2, N = SEQ_N, LC = CTX_L;
constexpr int NLAT = NB * N, NCTX = NB * LC, TT = NLAT + NCTX;
constexpr int GRIDW = 64;
constexpr int INC = 7840, PC = 3840;
constexpr int C_CQ = 0, C_CKV = 256, C_KR = 384, C_LX = 416, C_LG = 928, C_HU = 1440, C_GQ = 2976, C_GKV = 3488, C_GT = 3744;
constexpr int NEXP = 16384;
constexpr float EPS = 1e-6f;
#ifndef CPU_SIM
constexpr int PH_PER_LAYER = 13;
#else
constexpr int PH_PER_LAYER = 16;
#endif
constexpr int NPHASES = 2 + 2 * PH_PER_LAYER;
constexpr int LCH = 64, NCC = LC / LCH, NCL = N / LCH, NCHK = NCC + NCL;

enum { I_x, I_c, I_ctx, I_c_ctx, I_g_mix, I_g_ffn, I_w_mod, I_b_mod, I_w_in, I_mla_g_cq, I_mla_g_ckv, I_mla_w_uq,
       I_mla_w_ukv, I_lru_conv_w, I_lru_conv_b, I_lru_w_r, I_lru_b_r, I_lru_w_i, I_lru_b_i, I_lru_lam,
       I_hy_conv_w, I_hy_conv_b, I_hy_w1, I_hy_b1, I_hy_f1, I_hy_w2, I_hy_b2, I_hy_f2, I_hy_w3, I_hy_skip,
       I_gqa_sink, I_w_branch, I_w_out, I_peer_w_q, I_peer_keys, I_peer_u, I_peer_v, I_g_final, N_IN };

struct bf { unsigned short v; };
DEV float b2f(bf x) { union { unsigned u; float f; } c; c.u = ((unsigned)x.v) << 16; return c.f; }
DEV bf f2b(float f) { union { unsigned u; float f; } c; c.f = f; unsigned r = c.u + 0x7FFFu + ((c.u >> 16) & 1u); bf o; o.v = (unsigned short)(r >> 16); return o; }


constexpr size_t al256(size_t x) { return (x + 255) & ~(size_t)255; }
struct WsLayout {
  size_t xcur, mods, hdn2, ssq, tabA, tabD, fnorm, SA, SB, tw, tbl, ts, spl, bar, hdn2b, W3T, h, Y, Z, XC, LA, LB, P, QA, KVA;
  size_t W_in, W_g, W_uq, W_ukv, W_lru, W_br, W_out, W_q, W_key;
  size_t M, Gs, G, SC, TKs, TKi, SELi, SELg, W, Ub, Vb, YT, total;
};
constexpr WsLayout make_layout() {
  WsLayout w{};
  size_t o = 0;
  w.xcur = o; o = al256(o + (size_t)TT * D * 4);
  w.mods = o; o = al256(o + (size_t)2 * 3 * 6 * D * 4);
  w.hdn2 = o; o = al256(o + (size_t)2 * (N + LC) * 64 * 4);
  w.ssq = o; o = al256(o + (size_t)2 * TT * 4);
  w.tabA = o; o = al256(o + (size_t)128 * 8 * 2 * 4);
  w.tabD = o; o = al256(o + (size_t)128 * 16 * 2 * 4);
  w.fnorm = o; o = al256(o + (size_t)2 * 512 * 4);
  w.tw = o; o = al256(o + (size_t)2 * N * 8);
  w.tbl = o; o = al256(o + (size_t)N_IN * 8);
  w.ts = o; o = al256(o + (size_t)64 * 8);
  w.spl = o; o = al256(o + (size_t)2 * 2 * 512 * 4);
  w.bar = o; o = al256(o + (size_t)3456 * 4);
  w.hdn2b = o; o = al256(o + (size_t)2 * (N + LC) * 256 * 2);
  w.W3T = o; o = al256(o + (size_t)1024 * 256 * 2);
  w.SA = o; o = al256(o + (size_t)2 * NB * NCHK * 512 * 4);
  w.SB = o; o = al256(o + (size_t)2 * NB * NCHK * 512 * 4);
  w.h = o; o = al256(o + (size_t)TT * D * 2);
  w.Y = o; w.Ub = o; w.Vb = o + (size_t)NEXP * D; o = al256(o + (size_t)TT * 2048 * 2);
  w.Z = o; o = al256(o + (size_t)TT * 512 * 2);
  w.W_in = o; o = al256(o + (size_t)3840 * 1024 * 2);
  w.W_g = o; o = al256(o + (size_t)4096 * 1024 * 2);
  w.W_uq = o; o = al256(o + (size_t)768 * 256 * 2);
  w.W_ukv = o; o = al256(o + (size_t)1024 * 256 * 2);
  w.W_lru = o; o = al256(o + (size_t)2048 * 256 * 2);
  w.W_br = o; o = al256(o + (size_t)4 * 1024 * 512 * 2);
  w.W_out = o; o = al256(o + (size_t)1024 * 1024 * 2);
  w.W_q = o; o = al256(o + (size_t)1024 * 1024 * 2);
  w.W_key = o; o = al256(o + (size_t)2048 * 256 * 2);
  size_t rl = o;
  w.XC = o; o = al256(o + (size_t)TT * 512 * 2);
  w.LA = o; o = al256(o + (size_t)2 * TT * 512 * 2);
  w.LB = o; o = al256(o + (size_t)2 * TT * 512 * 2);
  size_t rl_end = o;
  o = rl;
  w.TKs = o; o = al256(o + (size_t)TT * 256 * 4);
  w.TKi = o; o = al256(o + (size_t)TT * 256 * 4);
  w.SELi = o; o = al256(o + (size_t)TT * 128 * 4);
  w.SELg = o; o = al256(o + (size_t)TT * 128 * 4);
  w.W = o; o = al256(o + (size_t)TT * 128 * 4);
  if (o > rl_end) rl_end = o;
  o = rl_end;
  size_t rp = o;
  w.P = o; o = al256(o + (size_t)TT * PC * 2);
  w.QA = o; o = al256(o + (size_t)TT * 768 * 2);
  w.KVA = o; o = al256(o + (size_t)TT * 1024 * 2);
  size_t rp_end = o;
  o = rp;
  w.M = o; o = al256(o + (size_t)TT * D * 2);
  w.G = o; if (o + (size_t)TT * 3072 * 2 > rp_end) rp_end = o + (size_t)TT * 3072 * 2;
  w.Gs = o; o = al256(o + (size_t)TT * D * 2);
  w.SC = o; o = al256(o + (size_t)TT * 2048 * sizeof(sc_t));
  if (o > rp_end) rp_end = o;
  w.YT = rp_end; rp_end = al256(rp_end + (size_t)512 * NB * N * 2);
  w.total = rp_end;
  return w;
}
constexpr WsLayout WL = make_layout();
static_assert((size_t)TT * 4096 <= (size_t)TT * 512 * 2 + (size_t)4 * TT * 512 * 2, "uint8 gates must fit in the XC/LA/LB region");
static_assert(WL.LB == WL.LA + (size_t)2 * TT * 512 * 2, "LA and LB must be contiguous (packed GPU layout)");
static_assert(WL.total <= (size_t)512 * 1024 * 1024, "workspace too large");
#ifndef CPU_SIM
static_assert((size_t)2 * NEXP * D * 2 <= (size_t)TT * 2048 * 2, "bf16 expert tables must fit in Y");
#endif
struct WsAcc {
  float* out;
  char* ws;
  MDEV float* xcur() const { return (float*)(ws + WL.xcur); }
  MDEV float* mods() const { return (float*)(ws + WL.mods); }
  MDEV float* hdn2() const { return (float*)(ws + WL.hdn2); }
  MDEV float* ssq() const { return (float*)(ws + WL.ssq); }
  MDEV float* tabA() const { return (float*)(ws + WL.tabA); }
  MDEV float* tabD() const { return (float*)(ws + WL.tabD); }
  MDEV float* fnorm() const { return (float*)(ws + WL.fnorm); }
  MDEV float* tw() const { return (float*)(ws + WL.tw); }
  MDEV unsigned* Hs() const { return (unsigned*)((char*)out + (((size_t)(N + LC) * 1024 * 4 + 255) & ~(size_t)255)); }
  MDEV float* spl() const { return (float*)(ws + WL.spl); }
  MDEV bf* XYT() const { return (bf*)((char*)out + (((size_t)(N + LC) * 1024 * 4 + 255) & ~(size_t)255)); }
  MDEV bf* hdn2b() const { return (bf*)(ws + WL.hdn2b); }
  MDEV bf* W3T() const { return (bf*)(ws + WL.W3T); }
  MDEV float* SA() const { return (float*)(ws + WL.SA); }
  MDEV float* SB() const { return (float*)(ws + WL.SB); }
  MDEV bf* h() const { return (bf*)(ws + WL.h); }
  MDEV bf* Y() const { return (bf*)(ws + WL.Y); }
  MDEV bf* Z() const { return (bf*)(ws + WL.Z); }
  MDEV bf* XC() const { return (bf*)(ws + WL.XC); }
  MDEV bf* LA() const { return (bf*)(ws + WL.LA); }
  MDEV bf* LB() const { return (bf*)(ws + WL.LB); }
  MDEV bf* P() const { return (bf*)(ws + WL.P); }
  MDEV bf* QA() const { return (bf*)(ws + WL.QA); }
  MDEV bf* KVA() const { return (bf*)(ws + WL.KVA); }
  MDEV float* F() const { return out; }
  MDEV bf* W_in() const { return (bf*)(ws + WL.W_in); }
  MDEV bf* W_g() const { return (bf*)(ws + WL.W_g); }
  MDEV bf* W_uq() const { return (bf*)(ws + WL.W_uq); }
  MDEV bf* W_ukv() const { return (bf*)(ws + WL.W_ukv); }
  MDEV bf* W_lru() const { return (bf*)(ws + WL.W_lru); }
  MDEV bf* W_br() const { return (bf*)(ws + WL.W_br); }
  MDEV bf* W_out() const { return (bf*)(ws + WL.W_out); }
  MDEV bf* W_q() const { return (bf*)(ws + WL.W_q); }
  MDEV bf* W_key() const { return (bf*)(ws + WL.W_key); }
  MDEV bf* M() const { return (bf*)(ws + WL.M); }
  MDEV bf* Gs() const { return (bf*)(ws + WL.Gs); }
  MDEV bf* PQ() const { return (bf*)(ws + WL.Gs); }
  MDEV bf* BR() const { return (bf*)(ws + WL.G); }
  MDEV unsigned char* G8() const { return (unsigned char*)(ws + WL.XC); }
  MDEV unsigned* LAB() const { return (unsigned*)(ws + WL.LA); }
  MDEV bf* YT() const { return (bf*)(ws + WL.YT); }
  MDEV sc_t* SC() const { return (sc_t*)(ws + WL.SC); }
  MDEV float* TKs() const { return (float*)(ws + WL.TKs); }
  MDEV int* TKi() const { return (int*)(ws + WL.TKi); }
  MDEV int* SELi() const { return (int*)(ws + WL.SELi); }
  MDEV float* SELg() const { return (float*)(ws + WL.SELg); }
  MDEV float* W() const { return (float*)(ws + WL.W); }
  MDEV bf* Ub() const { return (bf*)(ws + WL.Ub); }
  MDEV bf* Vb() const { return (bf*)(ws + WL.Vb); }
};
struct KArgs : WsAcc { const float* in[N_IN]; };
#ifndef CPU_SIM
typedef float v4f_gl __attribute__((ext_vector_type(4)));
DEV float4 gld4(const void* q) { const v4f_gl r = *(const __attribute__((address_space(1))) v4f_gl*)q; return float4{r.x, r.y, r.z, r.w}; }
DEV float gld1(const float* q) { return *(const __attribute__((address_space(1))) float*)q; }
#else
DEV float gld1(const float* q) { return *q; }
#endif
struct InTab {
  const float* const* t;
#ifndef CPU_SIM
  MDEV const float* operator[](int i) const { return t[i]; }
#else
  MDEV const float* operator[](int i) const { return t[i]; }
#endif
};
struct Params : WsAcc { InTab in; };
static_assert((size_t)(N + LC) * 1024 * 4 + 256 + (size_t)256 * 2 * N * 4 <= (size_t)NLAT * D * 4, "F + spectrum scratch must fit in d_out");

#ifndef CPU_SIM
DEV float fexpf_(float x) { return __builtin_amdgcn_exp2f(x * 1.4426950408889634f); }
DEV float sigmoidf_(float x) { return __builtin_amdgcn_rcpf(1.0f + __builtin_amdgcn_exp2f(-x * 1.4426950408889634f)); }
DEV float siluf_(float x) { return x * sigmoidf_(x); }
DEV float geluf_(float x) { return x * sigmoidf_(1.5957691216057308f * (x + 0.044715f * x * x * x)); }
#else
DEV float fexpf_(float x) { return expf(x); }
DEV float sigmoidf_(float x) { return 1.0f / (1.0f + expf(-x)); }
DEV float siluf_(float x) { return x * sigmoidf_(x); }
DEV float geluf_(float x) { return 0.5f * x * (1.0f + tanhf(0.7978845608028654f * (x + 0.044715f * x * x * x))); }
#endif
DEV float softplusf_(float x) { return x > 20.f ? x : log1pf(expf(x)); }

#ifndef CPU_SIM
DEV float lane_xor(float v, int lane, int o) { return __int_as_float(__builtin_amdgcn_ds_bpermute(((lane ^ o) & 63) << 2, __float_as_int(v))); }
#endif
#ifndef CPU_SIM
DEV void unpack8(const uint4 w, float* f) {
  union { unsigned u; float x; } c;
  c.u = w.x << 16; f[0] = c.x; c.u = w.x & 0xFFFF0000u; f[1] = c.x; c.u = w.y << 16; f[2] = c.x; c.u = w.y & 0xFFFF0000u; f[3] = c.x;
  c.u = w.z << 16; f[4] = c.x; c.u = w.z & 0xFFFF0000u; f[5] = c.x; c.u = w.w << 16; f[6] = c.x; c.u = w.w & 0xFFFF0000u; f[7] = c.x;
}
#endif
struct RowInfo { int b, t, L, base, lat; };
DEV RowInfo rowinfo(int r) {
  RowInfo ri;
  if (r < NLAT) { ri.b = r / N; ri.t = r - ri.b * N; ri.L = N; ri.base = ri.b * N; ri.lat = 1; }
  else { int rc = r - NLAT; ri.b = rc / LC; ri.t = rc - ri.b * LC; ri.L = LC; ri.base = NLAT + ri.b * LC; ri.lat = 0; }
  return ri;
}
DEV int modrow(int r) { return r < NLAT ? r / N : 2; }
template <class PT> DEV const float* xin_row(const PT& p, int r) { return r < NLAT ? p.in[I_x] + (size_t)r * D : p.in[I_ctx] + (size_t)(r - NLAT) * D; }

DEV void atomic_addf(float* p, float v) {
#ifndef CPU_SIM
  atomicAdd(p, v);
#else
#pragma omp atomic
  *p += v;
#endif
}
DEV void store8bf(bf* dst, const float* v) {
#ifndef CPU_SIM
  uint4 w;
  asm volatile("v_cvt_pk_bf16_f32 %0, %1, %2" : "=v"(w.x) : "v"(v[0]), "v"(v[1]));
  asm volatile("v_cvt_pk_bf16_f32 %0, %1, %2" : "=v"(w.y) : "v"(v[2]), "v"(v[3]));
  asm volatile("v_cvt_pk_bf16_f32 %0, %1, %2" : "=v"(w.z) : "v"(v[4]), "v"(v[5]));
  asm volatile("v_cvt_pk_bf16_f32 %0, %1, %2" : "=v"(w.w) : "v"(v[6]), "v"(v[7]));
  *(uint4*)dst = w;
#else
  for (int j = 0; j < 8; ++j) dst[j] = f2b(v[j]);
#endif
}
#ifndef CPU_SIM
DEV unsigned pk2bf(float lo, float hi) { unsigned r; asm volatile("v_cvt_pk_bf16_f32 %0, %1, %2" : "=v"(r) : "v"(lo), "v"(hi)); return r; }
#endif
DEV void load8bf(const bf* src, float* v) {
#ifndef CPU_SIM
  uint4 w = *(const uint4*)src;
  union { unsigned u; float f; } c;
  c.u = w.x << 16; v[0] = c.f; c.u = w.x & 0xFFFF0000u; v[1] = c.f;
  c.u = w.y << 16; v[2] = c.f; c.u = w.y & 0xFFFF0000u; v[3] = c.f;
  c.u = w.z << 16; v[4] = c.f; c.u = w.z & 0xFFFF0000u; v[5] = c.f;
  c.u = w.w << 16; v[6] = c.f; c.u = w.w & 0xFFFF0000u; v[7] = c.f;
#else
  for (int j = 0; j < 8; ++j) v[j] = b2f(src[j]);
#endif
}

DEV int win_src(int n) {
  if (n >= 3744) return -1;
  if (n >= C_KR && n < C_KR + 32) { int q = n - C_KR; int pi = q >> 1, wh = q & 1, half = pi >> 3, f = pi & 7; return C_KR + half * 16 + f + wh * 8; }
  if (n >= C_GQ && n < C_GKV + 128) { int q = n - C_GQ; int hh = q >> 6, d = q & 63; int pi = d >> 1, wh = d & 1, half = pi >> 4, f = pi & 15; return C_GQ + hh * 64 + half * 32 + f + wh * 16; }
  return n;
}
DEV int wuq_src(int n) {
  int hh = n / 96, d = n % 96;
  if (d < 64) return n;
  int q = d - 64; int pi = q >> 1, wh = q & 1, half = pi >> 3, f = pi & 7;
  return hh * 96 + 64 + half * 16 + f + wh * 8;
}

template <class PT> DEVN void ph_init(const PT& p, i64 gtid, i64 gsz, char* ilds = nullptr, int itid = 0) {
#ifndef CPU_SIM
  {
    float* sl = (float*)ilds;
    for (int q = itid; q < 3 * D; q += 512) { const int rr = q / D, k = q - rr * D; sl[q] = siluf_(rr < 2 ? p.in[I_c][rr * D + k] : p.in[I_c_ctx][k]); }
    __syncthreads();
    float* red3 = sl + 3 * D;
    const int wv_ = itid >> 6, ln_ = itid & 63;
    for (int task = blockIdx.x; task < 2 * 6 * D / 64; task += gridDim.x) {
      const int l = task / (6 * D / 64), j = (task % (6 * D / 64)) * 64 + ln_;
      const float* w = p.in[I_w_mod] + (size_t)l * D * 6 * D + j;
      float a0 = 0.f, a1 = 0.f, a2 = 0.f;
#pragma unroll 1
      for (int k0 = wv_ * 128; k0 < wv_ * 128 + 128; k0 += 16) {
        float wv[16];
#pragma unroll
        for (int q = 0; q < 16; ++q) wv[q] = w[(size_t)(k0 + q) * 6 * D];
#pragma unroll
        for (int q = 0; q < 16; ++q) { a0 += sl[k0 + q] * wv[q]; a1 += sl[D + k0 + q] * wv[q]; a2 += sl[2 * D + k0 + q] * wv[q]; }
      }
      __syncthreads();
      red3[(wv_ * 3 + 0) * 64 + ln_] = a0; red3[(wv_ * 3 + 1) * 64 + ln_] = a1; red3[(wv_ * 3 + 2) * 64 + ln_] = a2;
      __syncthreads();
      if (itid < 192) {
        const int v3 = itid >> 6, jj = itid & 63;
        float sum = p.in[I_b_mod][l * 6 * D + (task % (6 * D / 64)) * 64 + jj];
#pragma unroll
        for (int w8 = 0; w8 < 8; ++w8) sum += red3[(w8 * 3 + v3) * 64 + jj];
        p.mods()[((size_t)l * 3 + v3) * 6 * D + (task % (6 * D / 64)) * 64 + jj] = sum;
      }
    }
    __syncthreads();
  }
  {
    float* h1 = (float*)ilds;
    for (i64 i = gtid; i < (i64)2 * (N + LC); i += gsz) {
      const int l = (int)(i / (N + LC)), tt = (int)(i % (N + LC));
      int t, L; if (tt < N) { t = tt; L = N; } else { t = tt - N; L = LC; }
      const float tn = (float)t / (float)(L - 1);
      const float wt = 6.283185307179586f * (float)t / (float)L;
      const float* w1 = p.in[I_hy_w1] + l * 33 * 64; const float* b1 = p.in[I_hy_b1] + l * 64; const float* f1 = p.in[I_hy_f1] + l * 64;
      const float* w2 = p.in[I_hy_w2] + l * 64 * 64; const float* b2 = p.in[I_hy_b2] + l * 64; const float* f2 = p.in[I_hy_f2] + l * 64;
      { uint4* zp_ = (uint4*)(p.hdn2b() + ((size_t)l * (N + LC) + tt) * 256 + 64);
#pragma unroll
        for (int q = 0; q < 24; ++q) zp_[q] = uint4{0, 0, 0, 0}; }
      float zc[16], zs[16];
#pragma unroll
      for (int bd = 0; bd < 16; ++bd) { const float ang = (1e-4f + (float)bd * ((15.0f - 1e-4f) / 15.0f)) * wt; zc[bd] = cosf(ang); zs[bd] = sinf(ang); }
#pragma unroll 1
      for (int k1 = 0; k1 < 64; ++k1) {
        float a1 = b1[k1] + tn * w1[k1];
#pragma unroll
        for (int bd = 0; bd < 16; ++bd) a1 += zc[bd] * w1[(1 + bd) * 64 + k1] - zs[bd] * w1[(17 + bd) * 64 + k1];
        h1[k1 * 512 + itid] = sinf(f1[k1] * a1);
      }
#pragma unroll 1
      for (int j0 = 0; j0 < 64; j0 += 4) {
        float c0 = b2[j0], c1 = b2[j0 + 1], c2 = b2[j0 + 2], c3 = b2[j0 + 3];
#pragma unroll 8
        for (int k1 = 0; k1 < 64; ++k1) { const float hv = h1[k1 * 512 + itid]; const float4 wv = *(const float4*)(w2 + k1 * 64 + j0); c0 += hv * wv.x; c1 += hv * wv.y; c2 += hv * wv.z; c3 += hv * wv.w; }
        bf* ot = p.hdn2b() + ((size_t)l * (N + LC) + tt) * 256 + j0;
        ot[0] = f2b(sinf(f2[j0] * c0)); ot[1] = f2b(sinf(f2[j0 + 1] * c1)); ot[2] = f2b(sinf(f2[j0 + 2] * c2)); ot[3] = f2b(sinf(f2[j0 + 3] * c3));
      }
    }
  }
#else
  for (i64 i = gtid; i < 2 * 3 * 6 * D; i += gsz) {
    int l = (int)(i / (3 * 6 * D)); int rr = (int)((i / (6 * D)) % 3); int j = (int)(i % (6 * D));
    const float* cv = rr < 2 ? p.in[I_c] + rr * D : p.in[I_c_ctx];
    const float* w = p.in[I_w_mod] + (size_t)l * D * 6 * D;
    float acc = p.in[I_b_mod][l * 6 * D + j];
    for (int k = 0; k < D; ++k) acc += siluf_(cv[k]) * w[(size_t)k * 6 * D + j];
    p.mods()[i] = acc;
  }
  for (i64 i = gtid; i < (i64)2 * (N + LC) * 64; i += gsz) {
    int l = (int)(i / ((i64)(N + LC) * 64)); int tt = (int)((i / 64) % (N + LC)); int j2 = (int)(i % 64);
    int t, L; if (tt < N) { t = tt; L = N; } else { t = tt - N; L = LC; }
    float tn = (float)t / (float)(L - 1);
    float wt = 6.283185307179586f * (float)t / (float)L;
    const float* w1 = p.in[I_hy_w1] + l * 33 * 64; const float* b1 = p.in[I_hy_b1] + l * 64; const float* f1 = p.in[I_hy_f1] + l * 64;
    const float* w2 = p.in[I_hy_w2] + l * 64 * 64; const float* b2 = p.in[I_hy_b2] + l * 64; const float* f2 = p.in[I_hy_f2] + l * 64;
    float acc2 = b2[j2];
    for (int k1 = 0; k1 < 64; ++k1) {
      float a1 = b1[k1] + tn * w1[k1];
      for (int bd = 0; bd < 16; ++bd) {
        float band = 1e-4f + (float)bd * ((15.0f - 1e-4f) / 15.0f);
        float ang = band * wt;
        a1 += cosf(ang) * w1[(1 + bd) * 64 + k1] - sinf(ang) * w1[(17 + bd) * 64 + k1];
      }
      acc2 += sinf(f1[k1] * a1) * w2[k1 * 64 + j2];
    }
    p.hdn2()[i] = sinf(f2[j2] * acc2);
  }
#endif
#ifdef CPU_SIM
  for (i64 i = gtid; i < 2 * N; i += gsz) {
    double a = 6.283185307179586476925 * (double)i / (double)(2 * N);
    p.tw()[i * 2] = (float)cos(a); p.tw()[i * 2 + 1] = (float)-sin(a);
  }
#endif
  for (i64 i = gtid; i < 2 * 2 * 512; i += gsz) p.spl()[i] = softplusf_(-p.in[I_lru_lam][i]);
  for (i64 i = gtid; i < 128 * 8; i += gsz) {
    int pos = (int)(i / 8), f = (int)(i % 8);
    float ang = (float)pos * powf(10000.0f, -(float)f / 8.0f);
    p.tabA()[i * 2] = cosf(ang); p.tabA()[i * 2 + 1] = sinf(ang);
  }
  for (i64 i = gtid; i < 128 * 16; i += gsz) {
    int pos = (int)(i / 16), f = (int)(i % 16);
    float ang = (float)pos * powf(10000.0f, -(float)f / 16.0f);
    p.tabD()[i * 2] = cosf(ang); p.tabD()[i * 2 + 1] = sinf(ang);
  }
}

#ifndef CPU_SIM
template <class F> DEV void xpose_tiles(bf* dst, int K, int NN, const F& val, int tid, float* tl, int& xoff, int rank, int nranks) {
  const int tk = K / 64, tn = NN / 64;
  const int t0 = (rank + nranks - xoff % nranks) % nranks;
  xoff += tk * tn;
  for (int t = t0; t < tk * tn; t += nranks) {
    const int k0 = (t / tn) * 64, n0 = (t % tn) * 64;
    __syncthreads();
#pragma unroll
    for (int i = 0; i < 8; ++i) { const int kk = (tid >> 6) + 8 * i, nn = tid & 63; tl[nn * 65 + kk] = val(k0 + kk, n0 + nn); }
    __syncthreads();
#pragma unroll
    for (int i = 0; i < 8; ++i) { const int nn = (tid >> 6) + 8 * i, kk = tid & 63; dst[(size_t)(n0 + nn) * K + k0 + kk] = f2b(tl[nn * 65 + kk]); }
  }
}
#else
template <class F> static void xpose_tiles(bf* dst, int K, int NN, const F& val, i64 gtid, i64 gsz) {
  for (i64 i = gtid; i < (i64)K * NN; i += gsz) { int k = (int)(i / NN), n = (int)(i % NN); dst[(size_t)n * K + k] = f2b(val(k, n)); }
}
#endif
struct PrepCtx {
#ifndef CPU_SIM
  int tid; float* tl; int rank, nranks;
#else
  i64 gtid, gsz;
#endif
};
#ifndef CPU_SIM
#define XPOSE(dst, K, NN, val) xpose_tiles(dst, K, NN, val, pc.tid, pc.tl, xoff, pc.rank, pc.nranks)
#else
#define XPOSE(dst, K, NN, val) xpose_tiles(dst, K, NN, val, pc.gtid, pc.gsz)
#endif
DEVN void ph_prep(const Params& p, int l, const PrepCtx& pc, i64 gtid, i64 gsz, const int parts) {
  int xoff = 0; (void)xoff;
  if (parts & 1) {
    const float* w = p.in[I_w_in] + (size_t)l * D * INC;
    XPOSE(p.W_in(), 1024, 3840, [=](int k, int n) { int s_ = win_src(n); return s_ < 0 ? 0.f : w[(size_t)k * INC + s_]; });
    XPOSE(p.W_g(), 1024, 4096, [=](int k, int n) { return w[(size_t)k * INC + C_GT + n]; });
  }
  if (parts & 1) {
    const float* w = p.in[I_mla_w_uq] + (size_t)l * 256 * 768; const float* g = p.in[I_mla_g_cq] + l * 256;
    XPOSE(p.W_uq(), 256, 768, [=](int k, int n) { return g[k] * w[(size_t)k * 768 + wuq_src(n)]; });
  }
  if (parts & 1) {
    const float* w = p.in[I_mla_w_ukv] + (size_t)l * 128 * 1024; const float* g = p.in[I_mla_g_ckv] + l * 128;
    XPOSE(p.W_ukv(), 256, 1024, [=](int k, int n) { return k < 128 ? g[k] * w[(size_t)k * 1024 + n] : 0.f; });
  }
  if (parts & 2) {
    const float* w = p.in[I_w_branch] + (size_t)l * 4 * 512 * D;
    for (int br = 0; br < 4; ++br) { const float* wb = w + (size_t)br * 512 * D; XPOSE(p.W_br() + (size_t)br * 1024 * 512, 512, 1024, [=](int k, int n) { return wb[(size_t)k * D + n]; }); }
  }
  if (parts & 2) {
    const float* w = p.in[I_w_out] + (size_t)l * D * D;
    XPOSE(p.W_out(), 1024, 1024, [=](int k, int n) { return w[(size_t)k * D + n]; });
  }
  if (parts & 4) {
    const float* wq = p.in[I_peer_w_q] + (size_t)l * D * 1024;
    XPOSE(p.W_q(), 1024, 1024, [=](int k, int n) { return wq[(size_t)k * 1024 + n]; });
  }
#ifndef CPU_SIM
  if (parts & 1) {
    const float* w3 = p.in[I_hy_w3] + (size_t)l * 64 * 1024;
    XPOSE(p.W3T(), 256, 1024, [=](int k, int n) { return k < 64 ? w3[(size_t)k * 1024 + n] : 0.f; });
  }
#endif
  if (parts & 1) {
    for (i64 i = gtid; i < 2048 * 256; i += gsz) {
      int n = (int)(i / 256), k = (int)(i % 256);
      int kw = n >> 10, dir = (n >> 9) & 1, blk4 = (n >> 7) & 3, jc = (n & 127) >> 1, gate = n & 1;
      float v = 0.f;
      if ((k >> 6) == blk4) {
        const float* wsrc = p.in[gate ? I_lru_w_i : I_lru_w_r] + ((((size_t)l * 2 + dir) * 8 + kw * 4 + blk4) * 64 + (k & 63)) * 64 + jc;
        v = *wsrc;
      }
      p.W_lru()[i] = f2b(v);
    }
  }
  if (parts & 8) {
    const float* keys = p.in[I_peer_keys] + (size_t)l * 16 * 128 * 64;
    for (i64 i = gtid; i < 2048 * 256; i += gsz) {
      int n = (int)(i / 256), k = (int)(i % 256);
      int hp = n >> 7, key = n & 127;
      float v = ((k >> 6) == (hp & 3)) ? keys[((size_t)hp * 128 + key) * 64 + (k & 63)] : 0.f;
      p.W_key()[i] = f2b(v);
    }
  }
}

DEVN void ph_norm(const Params& p, int l, int which, int nrows, i64 gtid, i64 gsz) {
  const float* g = p.in[which ? I_g_ffn : I_g_mix] + l * D;
#ifndef CPU_SIM
  const int lane = (int)(gtid & 63);
  const i64 W = gsz >> 6;
  float4 gv[4];
#pragma unroll
  for (int i = 0; i < 4; ++i) gv[i] = *(const float4*)(g + (lane + i * 64) * 4);
  for (i64 r = gtid >> 6; r < nrows; r += 2 * W) {
    const bool two = r + W < nrows;
    const i64 rb = two ? r + W : r;
    const float4* xra = (const float4*)((l == 0 && which == 0) ? xin_row(p, (int)r) : p.xcur() + (size_t)r * D);
    const float4* xrb = (const float4*)((l == 0 && which == 0) ? xin_row(p, (int)rb) : p.xcur() + (size_t)rb * D);
    const float* mda = p.mods() + ((size_t)l * 3 + modrow((int)r)) * 6 * D + (which ? 3 * D : 0);
    const float* mdb = p.mods() + ((size_t)l * 3 + modrow((int)rb)) * 6 * D + (which ? 3 * D : 0);
    float4 xa[4], xb[4], sha[4], sca[4], shb[4], scb[4]; float sa = 0.f, sb = 0.f;
#pragma unroll
    for (int i = 0; i < 4; ++i) { xa[i] = xra[lane + i * 64]; xb[i] = xrb[lane + i * 64]; }
#pragma unroll
    for (int i = 0; i < 4; ++i) { const int k = (lane + i * 64) * 4; sha[i] = *(const float4*)(mda + k); sca[i] = *(const float4*)(mda + D + k); shb[i] = *(const float4*)(mdb + k); scb[i] = *(const float4*)(mdb + D + k); }
#pragma unroll
    for (int i = 0; i < 4; ++i) { sa += xa[i].x * xa[i].x + xa[i].y * xa[i].y + xa[i].z * xa[i].z + xa[i].w * xa[i].w; sb += xb[i].x * xb[i].x + xb[i].y * xb[i].y + xb[i].z * xb[i].z + xb[i].w * xb[i].w; }
#pragma unroll
    for (int o = 32; o >= 1; o >>= 1) { sa += lane_xor(sa, lane, o); sb += lane_xor(sb, lane, o); }
    const float rsa = 1.0f / sqrtf(sa * (1.0f / D) + EPS), rsb = 1.0f / sqrtf(sb * (1.0f / D) + EPS);
#pragma unroll
    for (int i = 0; i < 4; ++i) {
      const int k = (lane + i * 64) * 4;
      uint2 w;
      w.x = pk2bf(xa[i].x * rsa * gv[i].x * (1.0f + sca[i].x) + sha[i].x, xa[i].y * rsa * gv[i].y * (1.0f + sca[i].y) + sha[i].y);
      w.y = pk2bf(xa[i].z * rsa * gv[i].z * (1.0f + sca[i].z) + sha[i].z, xa[i].w * rsa * gv[i].w * (1.0f + sca[i].w) + sha[i].w);
      *(uint2*)(p.h() + (size_t)r * D + k) = w;
    }
    if (two) {
#pragma unroll
      for (int i = 0; i < 4; ++i) {
        const int k = (lane + i * 64) * 4;
        uint2 w;
        w.x = pk2bf(xb[i].x * rsb * gv[i].x * (1.0f + scb[i].x) + shb[i].x, xb[i].y * rsb * gv[i].y * (1.0f + scb[i].y) + shb[i].y);
        w.y = pk2bf(xb[i].z * rsb * gv[i].z * (1.0f + scb[i].z) + shb[i].z, xb[i].w * rsb * gv[i].w * (1.0f + scb[i].w) + shb[i].w);
        *(uint2*)(p.h() + (size_t)rb * D + k) = w;
      }
    }
  }
#else
  for (i64 r = gtid; r < nrows; r += gsz) {
    const float* xr = (l == 0 && which == 0) ? xin_row(p, (int)r) : p.xcur() + (size_t)r * D;
    float ss = 0.f;
    for (int k = 0; k < D; ++k) ss += xr[k] * xr[k];
    float rstd = 1.0f / sqrtf(ss / D + EPS);
    const float* md = p.mods() + ((size_t)l * 3 + modrow((int)r)) * 6 * D + (which ? 3 * D : 0);
    for (int k = 0; k < D; ++k) p.h()[(size_t)r * D + k] = f2b(xr[k] * rstd * g[k] * (1.0f + md[D + k]) + md[k]);
  }
#endif
}

DEVN void ph_B0(const Params& p, int l, i64 gtid, i64 gsz, char* b0lds = nullptr, int b0tid = 0) {
#ifndef CPU_SIM
  {
    const int lane = (int)(gtid & 63);
    const i64 W = gsz >> 6;
    for (i64 r = gtid >> 6; r < TT; r += 4 * W) {
      uint2 a[4]; unsigned b[4]; i64 rr[4];
#pragma unroll
      for (int j = 0; j < 4; ++j) { rr[j] = r + j * W < TT ? r + j * W : r; const bf* pr = p.P() + (size_t)rr[j] * PC; a[j] = *(const uint2*)(pr + C_CQ + lane * 4); b[j] = *(const unsigned*)(pr + C_CKV + lane * 2); }
      float sq[4], sk[4];
#pragma unroll
      for (int j = 0; j < 4; ++j) {
        const float f0 = __uint_as_float(a[j].x << 16), f1 = __uint_as_float(a[j].x & 0xFFFF0000u), f2 = __uint_as_float(a[j].y << 16), f3 = __uint_as_float(a[j].y & 0xFFFF0000u);
        const float g0 = __uint_as_float(b[j] << 16), g1 = __uint_as_float(b[j] & 0xFFFF0000u);
        sq[j] = 0.f; sq[j] += f0 * f0; sq[j] += f1 * f1; sq[j] += f2 * f2; sq[j] += f3 * f3;
        sk[j] = 0.f; sk[j] += g0 * g0; sk[j] += g1 * g1;
      }
#pragma unroll
      for (int o = 32; o >= 1; o >>= 1) {
#pragma unroll
        for (int j = 0; j < 4; ++j) { sq[j] += lane_xor(sq[j], lane, o); sk[j] += lane_xor(sk[j], lane, o); }
      }
#pragma unroll
      for (int j = 0; j < 4; ++j) if (lane == 0 && r + j * W < TT) { p.ssq()[rr[j]] = sq[j]; p.ssq()[TT + rr[j]] = sk[j]; }
    }
  }
#else
  for (i64 r = gtid; r < TT; r += gsz) {
    const bf* pr = p.P() + (size_t)r * PC;
    float sq = 0.f, sk = 0.f;
    for (int k = 0; k < 256; ++k) { float v = b2f(pr[C_CQ + k]); sq += v * v; }
    for (int k = 0; k < 128; ++k) { float v = b2f(pr[C_CKV + k]); sk += v * v; }
    p.ssq()[r] = sq; p.ssq()[TT + r] = sk;
  }
#endif
#ifndef CPU_SIM
  {
    const float* cw = p.in[I_lru_conv_w] + l * 4 * 512; const float* cb = p.in[I_lru_conv_b] + l * 512;
    for (i64 i = gtid; i < (i64)TT * 64; i += gsz) {
      const int r = (int)(i >> 6), c8 = (int)(i & 63) * 8;
      const RowInfo ri = rowinfo(r);
      float acc[8];
      { const float4 b0 = *(const float4*)(cb + c8), b1 = *(const float4*)(cb + c8 + 4); acc[0] = b0.x; acc[1] = b0.y; acc[2] = b0.z; acc[3] = b0.w; acc[4] = b1.x; acc[5] = b1.y; acc[6] = b1.z; acc[7] = b1.w; }
      uint4 xv[4]; bool ok[4];
#pragma unroll
      for (int k = 0; k < 4; ++k) { const int ts = ri.t - 1 + k; ok[k] = ts >= 0 && ts < ri.L; xv[k] = ok[k] ? *(const uint4*)(p.P() + (size_t)(ri.base + ts) * PC + C_LX + c8) : uint4{0, 0, 0, 0}; }
#pragma unroll
      for (int k = 0; k < 4; ++k) {
        float f[8]; unpack8(xv[k], f);
        const float4 w0 = *(const float4*)(cw + k * 512 + c8), w1 = *(const float4*)(cw + k * 512 + c8 + 4);
        acc[0] += w0.x * f[0]; acc[1] += w0.y * f[1]; acc[2] += w0.z * f[2]; acc[3] += w0.w * f[3];
        acc[4] += w1.x * f[4]; acc[5] += w1.y * f[5]; acc[6] += w1.z * f[6]; acc[7] += w1.w * f[7];
      }
      store8bf(p.XC() + (size_t)r * 512 + c8, acc);
    }
  }
  {
    const float* cw = p.in[I_hy_conv_w] + l * 3 * 1536; const float* cb = p.in[I_hy_conv_b] + l * 1536;
    for (i64 i = (i64)NLAT * 64 + gtid; i < (i64)TT * 64; i += gsz) {
      const int r = (int)(i >> 6), c8 = (int)(i & 63) * 8;
      const RowInfo ri = rowinfo(r);
      float a1[8], a2[8];
#pragma unroll
      for (int j = 0; j < 8; ++j) { a1[j] = cb[512 + c8 + j]; a2[j] = cb[1024 + c8 + j]; }
#pragma unroll
      for (int k = 0; k < 3; ++k) {
        const int ts = ri.t - 1 + k; if (ts < 0 || ts >= ri.L) continue;
        const bf* pr = p.P() + (size_t)(ri.base + ts) * PC + C_HU;
        float f[8], g[8]; unpack8(*(const uint4*)(pr + 512 + c8), f); unpack8(*(const uint4*)(pr + 1024 + c8), g);
#pragma unroll
        for (int j = 0; j < 8; ++j) { a1[j] += cw[k * 1536 + 512 + c8 + j] * f[j]; a2[j] += cw[k * 1536 + 1024 + c8 + j] * g[j]; }
      }
#pragma unroll
      for (int j = 0; j < 8; ++j) a1[j] *= a2[j];
      store8bf(p.Z() + (size_t)r * 512 + c8, a1);
    }
  }
  {
    const float* cw = p.in[I_hy_conv_w] + l * 3 * 1536; const float* cb = p.in[I_hy_conv_b] + l * 1536;
    unsigned short* tz_ = (unsigned short*)b0lds; unsigned short* tx_ = tz_ + 64 * 72;
    for (int tile = blockIdx.x; tile < (NLAT / 64) * 8; tile += gridDim.x) {
      const int rt = tile >> 3, c0 = (tile & 7) * 64;
      const int tr = b0tid >> 3, cg8 = (b0tid & 7) * 8;
      const int r = rt * 64 + tr, t = r % N;
      float a0[8], a1[8], a2[8];
#pragma unroll
      for (int j = 0; j < 8; ++j) { a0[j] = cb[c0 + cg8 + j]; a1[j] = cb[512 + c0 + cg8 + j]; a2[j] = cb[1024 + c0 + cg8 + j]; }
      uint4 v0[3], v1[3], v2[3]; bool ok[3];
#pragma unroll
      for (int k = 0; k < 3; ++k) {
        const int ts = t - 1 + k; ok[k] = ts >= 0 && ts < N;
        const bf* pr = p.P() + (size_t)(r - 1 + (ok[k] ? k : 1)) * PC + C_HU + c0 + cg8;
        v0[k] = *(const uint4*)pr; v1[k] = *(const uint4*)(pr + 512); v2[k] = *(const uint4*)(pr + 1024);
      }
#pragma unroll
      for (int k = 0; k < 3; ++k) {
        if (!ok[k]) continue;
        float f0[8], f1[8], f2_[8]; unpack8(v0[k], f0); unpack8(v1[k], f1); unpack8(v2[k], f2_);
        const float* w = cw + k * 1536 + c0 + cg8;
#pragma unroll
        for (int j = 0; j < 8; ++j) { a0[j] += w[j] * f0[j]; a1[j] += w[512 + j] * f1[j]; a2[j] += w[1024 + j] * f2_[j]; }
      }
      __syncthreads();
#pragma unroll
      for (int j = 0; j < 8; ++j) { tz_[(cg8 + j) * 72 + tr] = f2b(a1[j] * a2[j]).v; tx_[(cg8 + j) * 72 + tr] = f2b(a0[j]).v; }
      __syncthreads();
      { const int cc = b0tid >> 3, tg = (b0tid & 7) * 8;
        const int bq = (rt * 64) / N, tq = (rt * 64) % N + tg;
        const size_t o = ((size_t)(c0 + cc) * NB + bq) * N + tq;
        *(uint4*)((unsigned short*)p.Z() + o) = *(const uint4*)(tz_ + cc * 72 + tg);
        *(uint4*)((unsigned short*)p.XYT() + o) = *(const uint4*)(tx_ + cc * 72 + tg); }
    }
  }
#else
  {
    const float* cw = p.in[I_lru_conv_w] + l * 4 * 512; const float* cb = p.in[I_lru_conv_b] + l * 512;
    for (i64 i = gtid; i < (i64)TT * 512; i += gsz) {
      int r = (int)(i / 512), c = (int)(i % 512);
      RowInfo ri = rowinfo(r);
      float acc = cb[c];
      for (int k = 0; k < 4; ++k) {
        int ts = ri.t - 1 + k;
        if (ts >= 0 && ts < ri.L) acc += cw[k * 512 + c] * b2f(p.P()[(size_t)(ri.base + ts) * PC + C_LX + c]);
      }
      p.XC()[i] = f2b(acc);
    }
  }
  {
    const float* cw = p.in[I_hy_conv_w] + l * 3 * 1536; const float* cb = p.in[I_hy_conv_b] + l * 1536;
    for (i64 i = gtid; i < (i64)TT * 512; i += gsz) {
      int r = (int)(i / 512), c = (int)(i % 512);
      RowInfo ri = rowinfo(r);
      float a1 = cb[512 + c], a2 = cb[1024 + c];
      for (int k = 0; k < 3; ++k) {
        int ts = ri.t - 1 + k;
        if (ts >= 0 && ts < ri.L) {
          const bf* pr = p.P() + (size_t)(ri.base + ts) * PC + C_HU;
          a1 += cw[k * 1536 + 512 + c] * b2f(pr[512 + c]);
          a2 += cw[k * 1536 + 1024 + c] * b2f(pr[1024 + c]);
        }
      }
      p.Z()[i] = f2b(a1 * a2);
    }
  }
  {
    const float* w3 = p.in[I_hy_w3] + (size_t)l * 64 * 1024;
    const float maxd = logf(1e-2f) / 0.3f, mind = logf(1e-2f) / 1.5f;
    for (i64 i = gtid; i < (i64)(N + LC) * 1024; i += gsz) {
      int tt = (int)(i / 1024), j = (int)(i % 1024);
      int t, L; if (tt < N) { t = tt; L = N; } else { t = tt - N; L = LC; }
      const float* hd = p.hdn2() + ((size_t)l * (N + LC) + tt) * 64;
      float acc = 0.f;
      for (int k = 0; k < 64; ++k) acc += hd[k] * w3[k * 1024 + j];
      float tn = (float)t / (float)(L - 1);
      float delta = mind + (float)j * ((maxd - mind) / 1023.0f);
      p.F()[i] = acc * expf(-tn * fabsf(delta));
    }
  }
#endif
}

DEVN void ph_fnorm(const Params& p, i64 gtid, i64 gsz) {
#ifndef CPU_SIM
  for (i64 i = 512 + gtid; i < 2 * 512; i += gsz) {
#else
  for (i64 i = gtid; i < 2 * 512; i += gsz) {
#endif
    int which = (int)(i / 512), c = (int)(i % 512);
    int L = which ? LC : N; int off = which ? N : 0;
    float ss = 0.f;
    for (int t = 0; t < L; ++t) { float a = p.F()[(size_t)(off + t) * 1024 + c], b = p.F()[(size_t)(off + t) * 1024 + 512 + c]; ss += a * a + b * b; }
    p.fnorm()[i] = 1.0f / sqrtf(ss + EPS);
  }
}


DEV void lru_chunk_rows(int dir, int b, int k, int& row0, int& step) {
  int seg_chunk;
  if (k < NCC) { seg_chunk = dir ? NCC - 1 - k : k; row0 = NLAT + b * LC + seg_chunk * LCH; }
  else { int kl = k - NCC; seg_chunk = dir ? NCL - 1 - kl : kl; row0 = b * N + seg_chunk * LCH; }
  if (dir) { row0 += LCH - 1; step = -1; } else step = 1;
}
DEVN void ph_lru1(const Params& p, i64 gtid, i64 gsz) {
#ifndef CPU_SIM
  for (i64 i = gtid; i < (i64)2 * NB * NCHK * 128; i += gsz) {
    const int c = (int)(i % 128) * 4, k = (int)((i / 128) % NCHK), b = (int)((i / (128 * NCHK)) % NB), dir = (int)(i / ((i64)128 * NCHK * NB));
    int row0, step; lru_chunk_rows(dir, b, k, row0, step);
    const uint4* lab4 = (const uint4*)(p.LAB() + (size_t)dir * TT * 512 + c);
    float h0 = 0.f, h1 = 0.f, h2 = 0.f, h3 = 0.f, s0 = 0.f, s1 = 0.f, s2 = 0.f, s3 = 0.f;
    uint4 wn[8];
#pragma unroll
    for (int t = 0; t < 8; ++t) wn[t] = lab4[(size_t)(row0 + step * t) * 128];
#pragma unroll 1
    for (int t0 = 0; t0 < LCH; t0 += 8) {
      uint4 w[8];
#pragma unroll
      for (int t = 0; t < 8; ++t) w[t] = wn[t];
      if (t0 + 8 < LCH) {
#pragma unroll
        for (int t = 0; t < 8; ++t) wn[t] = lab4[(size_t)(row0 + step * (t0 + 8 + t)) * 128];
      }
#pragma unroll
      for (int t = 0; t < 8; ++t) {
        const float a0 = __uint_as_float(w[t].x << 16), a1 = __uint_as_float(w[t].y << 16), a2 = __uint_as_float(w[t].z << 16), a3 = __uint_as_float(w[t].w << 16);
        s0 += a0; s1 += a1; s2 += a2; s3 += a3;
        h0 = fexpf_(a0) * h0 + __uint_as_float(w[t].x & 0xFFFF0000u); h1 = fexpf_(a1) * h1 + __uint_as_float(w[t].y & 0xFFFF0000u);
        h2 = fexpf_(a2) * h2 + __uint_as_float(w[t].z & 0xFFFF0000u); h3 = fexpf_(a3) * h3 + __uint_as_float(w[t].w & 0xFFFF0000u);
      }
    }
    const size_t o = ((size_t)(dir * NB + b) * NCHK + k) * 512 + c;
    *(float4*)(p.SA() + o) = float4{fexpf_(s0), fexpf_(s1), fexpf_(s2), fexpf_(s3)};
    *(float4*)(p.SB() + o) = float4{h0, h1, h2, h3};
  }
#else
  for (i64 i = gtid; i < (i64)2 * NB * NCHK * 512; i += gsz) {
    int c = (int)(i % 512), k = (int)((i / 512) % NCHK), b = (int)((i / (512 * NCHK)) % NB), dir = (int)(i / ((i64)512 * NCHK * NB));
    int row0, step; lru_chunk_rows(dir, b, k, row0, step);
    const bf* la = p.LA() + (size_t)dir * TT * 512 + c; const bf* lb = p.LB() + (size_t)dir * TT * 512 + c;
    float h = 0.f, sl = 0.f;
    for (int t = 0; t < LCH; ++t) {
      size_t r = (size_t)(row0 + step * t);
      float lav = b2f(la[r * 512]);
      h = expf(lav) * h + b2f(lb[r * 512]); sl += lav;
    }
    p.SA()[i] = fexpf_(sl); p.SB()[i] = h;
  }
#endif
}
DEVN void ph_lru3(const Params& p, int last, i64 gtid, i64 gsz, float* hrs, int ltid) {
#ifndef CPU_SIM
  unsigned* hrp = (unsigned*)hrs;
  for (i64 i = gtid; i < (i64)NB * NCHK * 256; i += gsz) {
    const int c = (int)(i % 256) * 2, j = (int)((i / 256) % NCHK), b = (int)(i / (256 * NCHK));
    if (last && j < NCC) continue;
    const int kf = j, kr = j < NCC ? NCC - 1 - j : NCC + (NCL - 1 - (j - NCC));
    const float* sa0 = p.SA() + ((size_t)(0 * NB + b) * NCHK) * 512 + c; const float* sb0 = p.SB() + ((size_t)(0 * NB + b) * NCHK) * 512 + c;
    const float* sa1 = p.SA() + ((size_t)(1 * NB + b) * NCHK) * 512 + c; const float* sb1 = p.SB() + ((size_t)(1 * NB + b) * NCHK) * 512 + c;
    float hf0 = 0.f, hf1 = 0.f, hr0 = 0.f, hr1 = 0.f;
    const int row0 = j < NCC ? NLAT + b * LC + j * LCH : b * N + (j - NCC) * LCH;
    const unsigned* lab0 = p.LAB() + c; const unsigned* lab1 = p.LAB() + (size_t)TT * 512 + c;
#pragma unroll 1
    for (int k0 = 0; k0 < kf; k0 += 8) {
      float2 av[8], bv[8];
#pragma unroll
      for (int q = 0; q < 8; ++q) { const bool ok = k0 + q < kf; av[q] = ok ? *(const float2*)(sa0 + (size_t)(k0 + q) * 512) : float2{1.f, 1.f}; bv[q] = ok ? *(const float2*)(sb0 + (size_t)(k0 + q) * 512) : float2{0.f, 0.f}; }
#pragma unroll
      for (int q = 0; q < 8; ++q) { hf0 = av[q].x * hf0 + bv[q].x; hf1 = av[q].y * hf1 + bv[q].y; }
    }
#pragma unroll 1
    for (int k0 = 0; k0 < kr; k0 += 8) {
      float2 av[8], bv[8];
#pragma unroll
      for (int q = 0; q < 8; ++q) { const bool ok = k0 + q < kr; av[q] = ok ? *(const float2*)(sa1 + (size_t)(k0 + q) * 512) : float2{1.f, 1.f}; bv[q] = ok ? *(const float2*)(sb1 + (size_t)(k0 + q) * 512) : float2{0.f, 0.f}; }
#pragma unroll
      for (int q = 0; q < 8; ++q) { hr0 = av[q].x * hr0 + bv[q].x; hr1 = av[q].y * hr1 + bv[q].y; }
    }
#pragma unroll 1
    for (int t0 = LCH - 16; t0 >= 0; t0 -= 16) {
      uint2 w[16];
#pragma unroll
      for (int t = 0; t < 16; ++t) w[t] = *(const uint2*)(lab1 + (size_t)(row0 + t0 + t) * 512);
#pragma unroll
      for (int t = 15; t >= 0; --t) {
        hr0 = fexpf_(__uint_as_float(w[t].x << 16)) * hr0 + __uint_as_float(w[t].x & 0xFFFF0000u);
        hr1 = fexpf_(__uint_as_float(w[t].y << 16)) * hr1 + __uint_as_float(w[t].y & 0xFFFF0000u);
        hrp[(t0 + t) * 512 + ltid] = pk2bf(hr0, hr1);
      }
    }
#pragma unroll 1
    for (int t0 = 0; t0 < LCH; t0 += 16) {
      uint2 w[16]; unsigned gw[16];
#pragma unroll
      for (int t = 0; t < 16; ++t) { const size_t r = (size_t)(row0 + t0 + t); w[t] = *(const uint2*)(lab0 + r * 512); gw[t] = *(const unsigned*)(p.P() + r * PC + C_LG + c); }
#pragma unroll
      for (int t = 0; t < 16; ++t) {
        hf0 = fexpf_(__uint_as_float(w[t].x << 16)) * hf0 + __uint_as_float(w[t].x & 0xFFFF0000u);
        hf1 = fexpf_(__uint_as_float(w[t].y << 16)) * hf1 + __uint_as_float(w[t].y & 0xFFFF0000u);
        const unsigned hw = hrp[(t0 + t) * 512 + ltid];
        const float y0 = geluf_(__uint_as_float(gw[t] << 16)) * (hf0 + __uint_as_float(hw << 16));
        const float y1 = geluf_(__uint_as_float(gw[t] & 0xFFFF0000u)) * (hf1 + __uint_as_float(hw & 0xFFFF0000u));
        *(unsigned*)(p.Y() + (size_t)(row0 + t0 + t) * 2048 + 512 + c) = pk2bf(y0, y1);
      }
    }
  }
#else
  for (i64 i = gtid; i < (i64)NB * NCHK * 512; i += gsz) {
    int c = (int)(i % 512), j = (int)((i / 512) % NCHK), b = (int)(i / (512 * NCHK));
    if (last && j < NCC) continue;
    int kf = j, kr = j < NCC ? NCC - 1 - j : NCC + (NCL - 1 - (j - NCC));
    const float* sa0 = p.SA() + ((size_t)(0 * NB + b) * NCHK) * 512 + c; const float* sb0 = p.SB() + ((size_t)(0 * NB + b) * NCHK) * 512 + c;
    const float* sa1 = p.SA() + ((size_t)(1 * NB + b) * NCHK) * 512 + c; const float* sb1 = p.SB() + ((size_t)(1 * NB + b) * NCHK) * 512 + c;
    float hf = 0.f, hr = 0.f;
    int row0 = j < NCC ? NLAT + b * LC + j * LCH : b * N + (j - NCC) * LCH;
    const bf* la0 = p.LA() + c; const bf* lb0 = p.LB() + c;
    const bf* la1 = p.LA() + (size_t)TT * 512 + c; bf* lb1 = p.LB() + (size_t)TT * 512 + c;
    for (int k = 0; k < kf; ++k) hf = sa0[(size_t)k * 512] * hf + sb0[(size_t)k * 512];
    for (int k = 0; k < kr; ++k) hr = sa1[(size_t)k * 512] * hr + sb1[(size_t)k * 512];
    for (int t = LCH - 1; t >= 0; --t) { size_t r = (size_t)(row0 + t); hr = expf(b2f(la1[r * 512])) * hr + b2f(lb1[r * 512]); lb1[r * 512] = f2b(hr); }
    for (int t = 0; t < LCH; ++t) {
      size_t r = (size_t)(row0 + t);
      hf = expf(b2f(la0[r * 512])) * hf + b2f(lb0[r * 512]);
      float lg = b2f(p.P()[r * PC + C_LG + c]);
      p.Y()[r * 2048 + 512 + c] = f2b(geluf_(lg) * (hf + b2f(lb1[r * 512])));
    }
  }
#endif
}

DEVN void ph_C(const Params& p, int l, int last, i64 gtid, i64 gsz) {
  const int QR = last ? NLAT : TT;
#ifdef CPU_SIM
  for (i64 i = gtid; i < (i64)8 * QR; i += gsz) {
    int hh = (int)(i / QR), r = (int)(i % QR);
    RowInfo ri = rowinfo(r);
    float q[96];
#pragma unroll
    for (int d = 0; d < 96; ++d) q[d] = b2f(p.QA()[(size_t)r * 768 + hh * 96 + d]);
    float o[64];
#pragma unroll
    for (int d = 0; d < 64; ++d) o[d] = 0.f;
    float m = -1e30f, lsum = 0.f;
    const float scale = 0.10206207261596577f;
    int nseg = ri.lat ? 2 : 1;
    for (int sg = 0; sg < nseg; ++sg) {
      int kb, kn_;
      if (ri.lat && sg == 0) { kb = ri.b * N; kn_ = N; } else { kb = NLAT + ri.b * LC; kn_ = LC; }
      for (int kk = 0; kk < kn_; ++kk) {
        const bf* kr_ = p.KVA() + (size_t)(kb + kk) * 1024 + hh * 128;
        const bf* krp = p.P() + (size_t)(kb + kk) * PC + C_KR;
        float s = 0.f;
#pragma unroll
        for (int d = 0; d < 64; ++d) s += q[d] * b2f(kr_[d]);
#pragma unroll
        for (int d = 0; d < 32; ++d) s += q[64 + d] * b2f(krp[d]);
        s *= scale;
        float mn = fmaxf(m, s);
        float corr = expf(m - mn), pe = expf(s - mn);
        lsum = lsum * corr + pe;
#pragma unroll
        for (int d = 0; d < 64; ++d) o[d] = o[d] * corr + pe * b2f(kr_[64 + d]);
        m = mn;
      }
    }
    float inv = 1.0f / lsum;
#pragma unroll
    for (int d = 0; d < 64; ++d) p.Y()[(size_t)r * 2048 + hh * 64 + d] = f2b(o[d] * inv);
  }
#endif
  {
    const float* cw = p.in[I_hy_conv_w] + l * 3 * 1536; const float* cb = p.in[I_hy_conv_b] + l * 1536;
    const float* skip = p.in[I_hy_skip] + l * 512;
#ifndef CPU_SIM
    const i64 hy_first = (i64)NLAT * 512;
#else
    const i64 hy_first = 0;
#endif
    for (i64 i = hy_first + gtid; i < (i64)QR * 512; i += gsz) {
      int r = (int)(i / 512), c = (int)(i % 512);
      RowInfo ri = rowinfo(r);
      int foff = ri.lat ? 0 : N;
      float acc = 0.f;
      for (int s = 0; s < ri.L; ++s) {
        int dd = ri.t - s;
        float fv = dd >= 0 ? p.F()[(size_t)(foff + dd) * 1024 + c] : p.F()[(size_t)(foff - dd) * 1024 + 512 + c];
        acc += fv * b2f(p.Z()[(size_t)(ri.base + s) * 512 + c]);
      }
      acc *= p.fnorm()[(ri.lat ? 0 : 512) + c];
      float x0 = cb[c];
      for (int k = 0; k < 3; ++k) {
        int ts = ri.t - 1 + k;
        if (ts >= 0 && ts < ri.L) x0 += cw[k * 1536 + c] * b2f(p.P()[(size_t)(ri.base + ts) * PC + C_HU + c]);
      }
      float y = acc + skip[c] * b2f(p.Z()[(size_t)r * 512 + c]);
      p.Y()[(size_t)r * 2048 + 1024 + c] = f2b(x0 * y);
    }
  }
#ifdef CPU_SIM
  for (i64 i = gtid; i < (i64)8 * QR; i += gsz) {
    int hh = (int)(i / QR), r = (int)(i % QR);
    RowInfo ri = rowinfo(r);
    int kh = hh / 4;
    float q[64];
#pragma unroll
    for (int d = 0; d < 64; ++d) q[d] = b2f(p.P()[(size_t)r * PC + C_GQ + hh * 64 + d]);
    float o[64];
#pragma unroll
    for (int d = 0; d < 64; ++d) o[d] = 0.f;
    float m = p.in[I_gqa_sink][l * 8 + hh], lsum = 1.0f;
    int nseg = ri.lat ? 2 : 1;
    for (int sg = 0; sg < nseg; ++sg) {
      int k0, k1;
      if (ri.lat && sg == 0) { int lo = ri.t - 128; if (lo < 0) lo = 0; int hi = ri.t + 128; if (hi > N - 1) hi = N - 1; k0 = ri.b * N + lo; k1 = ri.b * N + hi + 1; }
      else { k0 = NLAT + ri.b * LC; k1 = k0 + LC; }
      for (int kk = k0; kk < k1; ++kk) {
        const bf* kp = p.P() + (size_t)kk * PC + C_GKV + kh * 64;
        const bf* vp = kp + 128;
        float s = 0.f;
#pragma unroll
        for (int d = 0; d < 64; ++d) s += q[d] * b2f(kp[d]);
        s *= 0.125f;
        float mn = fmaxf(m, s);
        float corr = expf(m - mn), pe = expf(s - mn);
        lsum = lsum * corr + pe;
#pragma unroll
        for (int d = 0; d < 64; ++d) o[d] = o[d] * corr + pe * b2f(vp[d]);
        m = mn;
      }
    }
    float inv = 1.0f / lsum;
#pragma unroll
    for (int d = 0; d < 64; ++d) p.Y()[(size_t)r * 2048 + 1536 + hh * 64 + d] = f2b(o[d] * inv);
  }
#endif
}

DEVN void ph_E2a(const Params& p, int nrows, i64 gtid, i64 gsz) {
  for (i64 i = gtid; i < (i64)nrows * 16; i += gsz) {
    const sc_t* s_ = p.SC() + (size_t)i * 128;
    float ps = 3.0e38f; int pi = -1;
    for (int k = 0; k < 16; ++k) {
      float bs = -3.0e38f; int bi = -1;
      for (int j = 0; j < 128; ++j) {
        float s = (float)s_[j];
        bool elig = (s < ps) || (s == ps && j > pi);
        if (elig && (s > bs)) { bs = s; bi = j; }
      }
      p.TKs()[(size_t)i * 16 + k] = bs; p.TKi()[(size_t)i * 16 + k] = bi;
      ps = bs; pi = bi;
    }
  }
}

DEVN void ph_E2b(const Params& p, int nrows, i64 gtid, i64 gsz) {
  for (i64 i = gtid; i < (i64)nrows * 8; i += gsz) {
    const float* s1 = p.TKs() + (size_t)i * 32; const float* s2 = s1 + 16;
    const int* i1 = p.TKi() + (size_t)i * 32; const int* i2 = i1 + 16;
    float ps = 3.0e38f; int pi = -1;
    float mx = 0.f;
    for (int k = 0; k < 16; ++k) {
      float bs = -3.0e38f; int bi = -1;
      for (int j = 0; j < 256; ++j) {
        float s = s1[j >> 4] + s2[j & 15];
        bool elig = (s < ps) || (s == ps && j > pi);
        if (elig && (s > bs)) { bs = s; bi = j; }
      }
      if (k == 0) mx = bs;
      p.SELi()[(size_t)i * 16 + k] = i1[bi >> 4] * 128 + i2[bi & 15];
      p.SELg()[(size_t)i * 16 + k] = expf(bs - mx);
      ps = bs; pi = bi;
    }
    float sum = 0.f;
    for (int k = 0; k < 16; ++k) sum += p.SELg()[(size_t)i * 16 + k];
    float inv = 1.0f / sum;
    for (int k = 0; k < 16; ++k) p.SELg()[(size_t)i * 16 + k] *= inv;
  }
}

DEVN void ph_E3(const Params& p, int l, int nrows, i64 gtid, i64 gsz) {
  const float* u = p.in[I_peer_u] + (size_t)l * NEXP * D;
#ifndef CPU_SIM
  const int lane = (int)(gtid & 63);
  for (i64 i = gtid >> 6; i < (i64)nrows * 128; i += gsz >> 6) {
    const int r = (int)(i >> 7);
    const float4* ur = (const float4*)(u + (size_t)p.SELi()[i] * D);
    const uint2* hr = (const uint2*)(p.h() + (size_t)r * D);
    float acc = 0.f;
#pragma unroll
    for (int q = 0; q < 4; ++q) {
      const float4 uv = ur[lane + q * 64]; const uint2 hv = hr[lane + q * 64];
      union { unsigned u_; float f; } c0, c1, c2, c3;
      c0.u_ = hv.x << 16; c1.u_ = hv.x & 0xFFFF0000u; c2.u_ = hv.y << 16; c3.u_ = hv.y & 0xFFFF0000u;
      acc += uv.x * c0.f + uv.y * c1.f + uv.z * c2.f + uv.w * c3.f;
    }
#pragma unroll
    for (int o = 32; o >= 1; o >>= 1) acc += lane_xor(acc, lane, o);
    if (lane == 0) p.W()[i] = p.SELg()[i] * geluf_(acc);
  }
#else
  for (i64 i = gtid; i < (i64)nrows * 128; i += gsz) {
    int r = (int)(i / 128);
    const float* ur = u + (size_t)p.SELi()[i] * D;
    const bf* hr = p.h() + (size_t)r * D;
    float acc = 0.f;
    for (int k = 0; k < D; ++k) acc += b2f(hr[k]) * ur[k];
    p.W()[i] = p.SELg()[i] * geluf_(acc);
  }
#endif
}

DEVN void ph_E4(const Params& p, int l, int nrows, i64 gtid, i64 gsz) {
  const float* v = p.in[I_peer_v] + (size_t)l * NEXP * D;
  for (i64 i = gtid; i < (i64)nrows * D; i += gsz) {
    int r = (int)(i / D), n = (int)(i % D);
    float acc = 0.f;
    for (int j = 0; j < 128; ++j) acc += p.W()[(size_t)r * 128 + j] * v[(size_t)p.SELi()[(size_t)r * 128 + j] * D + n];
    float g2 = p.mods()[((size_t)l * 3 + modrow(r)) * 6 * D + 5 * D + n];
    p.xcur()[i] += g2 * acc;
  }
}


#ifndef CPU_SIM
DEV unsigned dpp_ror_u(unsigned x, int n) {
  switch (n) {
    case 1: return (unsigned)__builtin_amdgcn_update_dpp(0, (int)x, 0x121, 0xf, 0xf, false);
    case 2: return (unsigned)__builtin_amdgcn_update_dpp(0, (int)x, 0x122, 0xf, 0xf, false);
    case 4: return (unsigned)__builtin_amdgcn_update_dpp(0, (int)x, 0x124, 0xf, 0xf, false);
    default: return (unsigned)__builtin_amdgcn_update_dpp(0, (int)x, 0x128, 0xf, 0xf, false);
  }
}
DEV unsigned wave_max_u(unsigned x) {
  x = max(x, dpp_ror_u(x, 1)); x = max(x, dpp_ror_u(x, 2)); x = max(x, dpp_ror_u(x, 4)); x = max(x, dpp_ror_u(x, 8));
  const unsigned a = (unsigned)__builtin_amdgcn_readlane((int)x, 0), b = (unsigned)__builtin_amdgcn_readlane((int)x, 16);
  const unsigned c = (unsigned)__builtin_amdgcn_readlane((int)x, 32), d = (unsigned)__builtin_amdgcn_readlane((int)x, 48);
  return max(max(a, b), max(c, d));
}
DEV unsigned f16_key(unsigned short h, int idx) { const unsigned t = (h & 0x8000u) ? (unsigned)(~h & 0xFFFFu) : (unsigned)(h | 0x8000u); return (t << 16) | (unsigned)(0xFFFF - idx); }
DEV float key_score(unsigned k) { const unsigned t = k >> 16; const unsigned short h = (unsigned short)((t & 0x8000u) ? (t ^ 0x8000u) : (~t & 0xFFFFu)); union { unsigned short u; _Float16 f; } c; c.u = h; return (float)c.f; }
DEV int key_idx(unsigned k) { return 0xFFFF - (int)(k & 0xFFFFu); }
DEV int mbcnt64(unsigned long long m) { return (int)__builtin_amdgcn_mbcnt_hi((unsigned)(m >> 32), __builtin_amdgcn_mbcnt_lo((unsigned)m, 0u)); }
DEV unsigned pick16_sorted(unsigned k0, unsigned k1, unsigned T, int above, int lane, int* tmp) {
  const unsigned h0 = k0 & 0xFFFF0000u, h1 = k1 & 0xFFFF0000u;
  const bool gt0 = h0 > T, eq0 = h0 == T, gt1 = h1 > T, eq1 = h1 == T;
  const int need = 16 - above;
  const unsigned long long me0 = __builtin_amdgcn_ballot_w64(eq0), me1 = __builtin_amdgcn_ballot_w64(eq1);
  const bool s0 = gt0 || (eq0 && mbcnt64(me0) < need);
  const int need1 = need - (int)__builtin_popcountll(me0);
  const bool s1 = gt1 || (eq1 && mbcnt64(me1) < need1);
  const unsigned long long ms0 = __builtin_amdgcn_ballot_w64(s0), ms1 = __builtin_amdgcn_ballot_w64(s1);
  if (s0) tmp[mbcnt64(ms0)] = (int)k0;
  if (s1) tmp[(int)__builtin_popcountll(ms0) + mbcnt64(ms1)] = (int)k1;
  const unsigned u = (unsigned)tmp[lane & 15];
  int rank = 0;
#pragma unroll
  for (int q = 0; q < 16; ++q) rank += ((unsigned)__builtin_amdgcn_readlane((int)u, q) > u) ? 1 : 0;
  if (lane < 16) tmp[16 + rank] = (int)u;
  return (unsigned)tmp[16 + (lane & 15)];
}
DEV void top16_x2(unsigned a0, unsigned a1, unsigned b0, unsigned b1, int lane, int* tmp, unsigned& ta, unsigned& tb) {
  unsigned TA = 0, TB = 0; int abA = 0, abB = 0;
#pragma unroll
  for (int bit = 31; bit >= 16; --bit) {
    const unsigned m = 0xFFFFFFFFu << bit, one = 1u << bit;
    const unsigned tA = TA | one, tB = TB | one;
    const int cA = (int)__builtin_popcountll(__builtin_amdgcn_ballot_w64((a0 & m) == tA)) + (int)__builtin_popcountll(__builtin_amdgcn_ballot_w64((a1 & m) == tA));
    const int cB = (int)__builtin_popcountll(__builtin_amdgcn_ballot_w64((b0 & m) == tB)) + (int)__builtin_popcountll(__builtin_amdgcn_ballot_w64((b1 & m) == tB));
    if (abA + cA >= 16) TA = tA; else abA += cA;
    if (abB + cB >= 16) TB = tB; else abB += cB;
  }
  ta = pick16_sorted(a0, a1, TA, abA, lane, tmp);
  tb = pick16_sorted(b0, b1, TB, abB, lane, tmp + 32);
}
DEVN void ph_cvt_tables(const Params& p, int l, i64 gtid, i64 gsz) {
  const float4* u = (const float4*)(p.in[I_peer_u] + (size_t)l * NEXP * D); const float4* v = (const float4*)(p.in[I_peer_v] + (size_t)l * NEXP * D);
  unsigned* ub = (unsigned*)p.Ub(); unsigned* vb = (unsigned*)p.Vb();
#pragma unroll 4
  for (i64 i = gtid; i < (i64)NEXP * D / 4; i += gsz) {
    const float4 a = u[i], b = v[i];
    int w = __builtin_amdgcn_cvt_pk_fp8_f32(a.x * 32.f, a.y * 32.f, 0, false); w = __builtin_amdgcn_cvt_pk_fp8_f32(a.z * 32.f, a.w * 32.f, w, true); ub[i] = (unsigned)w;
    int x = __builtin_amdgcn_cvt_pk_fp8_f32(b.x, b.y, 0, false); x = __builtin_amdgcn_cvt_pk_fp8_f32(b.z, b.w, x, true); vb[i] = (unsigned)x;
  }
}
DEV void unpack16_fp8(const uint4 w, float* f) {
#define UP4(W, O) { auto lo = __builtin_amdgcn_cvt_pk_f32_fp8((int)(W), false); auto hi = __builtin_amdgcn_cvt_pk_f32_fp8((int)(W), true); f[O] = lo[0]; f[O + 1] = lo[1]; f[O + 2] = hi[0]; f[O + 3] = hi[1]; }
  UP4(w.x, 0) UP4(w.y, 4) UP4(w.z, 8) UP4(w.w, 12)
#undef UP4
}
struct Sc4 { unsigned short a, b, c, d; };
DEV Sc4 peer_scores(const Params& p, int r, int wid, int lane) {
  const unsigned short* sp = (const unsigned short*)(p.SC() + ((size_t)r * 8 + wid) * 256);
  Sc4 q; q.a = sp[lane]; q.b = sp[64 + lane]; q.c = sp[128 + lane]; q.d = sp[192 + lane];
  return q;
}
struct Key4 { decltype(f16_key((unsigned short)0, 0)) a, b, c, d; };
DEV Key4 peer_keys(const Sc4 q, int lane) { Key4 k; k.a = f16_key(q.a, lane); k.b = f16_key(q.b, 64 + lane); k.c = f16_key(q.c, lane); k.d = f16_key(q.d, 64 + lane); return k; }
DEV void peer_topk(const Key4 k, int lane, int ca, int cb, bool cvalid, int* selx, int* tmp) {
  unsigned t1, t2;
  top16_x2(k.a, k.b, k.c, k.d, lane, tmp, t1, t2);
  const unsigned k1 = (unsigned)__builtin_amdgcn_ds_bpermute(ca << 2, (int)t1), k2 = (unsigned)__builtin_amdgcn_ds_bpermute(cb << 2, (int)t2);
  const float v = cvalid ? key_score(k1) + key_score(k2) : -3.0e38f;
  int rank = 0;
#pragma unroll
  for (int c = 0; c < 50; ++c) {
    const float vs = __int_as_float(__builtin_amdgcn_readlane(__float_as_int(v), c));
    rank += (vs > v || (vs == v && c < lane)) ? 1 : 0;
  }
  float mx = v;
#pragma unroll
  for (int o = 32; o >= 1; o >>= 1) mx = fmaxf(mx, lane_xor(mx, lane, o));
  const bool sel = cvalid && rank < 16;
  const float e = sel ? fexpf_(v - mx) : 0.f;
  float sum = e;
#pragma unroll
  for (int o = 32; o >= 1; o >>= 1) sum += lane_xor(sum, lane, o);
  if (sel) { selx[rank] = key_idx(k1) * 128 + key_idx(k2); selx[16 + rank] = __float_as_int(e / sum); }
}
DEVN void ph_peer(const Params& p, int l, int nrows, int tid, char* ldsg, float oscale = 1.0f) {
  const int lane = tid & 63, wid = tid >> 6;
  float* part = (float*)ldsg;
  int* selbase = (int*)(ldsg + 8 * 1024 * 4) + wid * 64;
  int* tktmp = (int*)(ldsg + 8 * 1024 * 4 + 8 * 64 * 4) + wid * 64;
  const unsigned char* Ub = (const unsigned char*)p.Ub(); const unsigned char* Vb = (const unsigned char*)p.Vb();
  int ca = 0, cb = 0; bool cvalid = false;
  { int pre = 0;
    for (int a = 0; a < 16; ++a) { const int cnt = 16 / (a + 1); if (lane >= pre && lane < pre + cnt) { ca = a; cb = lane - pre; cvalid = true; } pre += cnt; } }
  int cur = 0;
  Sc4 nsc; nsc.a = nsc.b = nsc.c = nsc.d = 0;
  if ((int)blockIdx.x < nrows) {
    peer_topk(peer_keys(peer_scores(p, blockIdx.x, wid, lane), lane), lane, ca, cb, cvalid, selbase, tktmp);
    nsc = peer_scores(p, (int)(blockIdx.x + gridDim.x) < nrows ? (int)(blockIdx.x + gridDim.x) : (int)blockIdx.x, wid, lane);
  }
  for (int r = blockIdx.x; r < nrows; r += gridDim.x) {
    const int* selx = selbase + cur * 32;
    int eidx[16];
#pragma unroll
    for (int e = 0; e < 16; ++e) eidx[e] = __builtin_amdgcn_readfirstlane(selx[e]);
    const float mygate = __int_as_float(selx[16 + (lane >> 2)]);
    const bool more = r + (int)gridDim.x < nrows;
    const Key4 nkeys = peer_keys(nsc, lane);
    uint4 rows[16], vrows[16];
#pragma unroll
    for (int e = 0; e < 16; ++e) rows[e] = ((const uint4*)(Ub + (size_t)eidx[e] * D))[lane];
    uint4 hraw0, hraw1;
    { const uint4* hp = (const uint4*)(p.h() + (size_t)r * D); hraw0 = hp[lane * 2]; hraw1 = hp[lane * 2 + 1]; }
#pragma unroll
    for (int e = 0; e < 16; ++e) vrows[e] = ((const uint4*)(Vb + (size_t)eidx[e] * D))[lane];
    const float2 g2v = *(const float2*)(p.mods() + ((size_t)l * 3 + modrow(r)) * 6 * D + 5 * D + tid * 2);
    float2 xv = *(const float2*)(p.xcur() + (size_t)r * D + tid * 2);
    nsc = peer_scores(p, r + 2 * (int)gridDim.x < nrows ? r + 2 * (int)gridDim.x : r, wid, lane);
    if (more) peer_topk(nkeys, lane, ca, cb, cvalid, selbase + (cur ^ 1) * 32, tktmp);
    float hv[16]; unpack8(hraw0, hv); unpack8(hraw1, hv + 8);
    float d[16];
#pragma unroll
    for (int e = 0; e < 16; ++e) {
      float f[16]; unpack16_fp8(rows[e], f);
      float a = 0.f;
#pragma unroll
      for (int k = 0; k < 16; ++k) a += f[k] * hv[k];
      d[e] = a;
    }
#define FOLD(NV, O) _Pragma("unroll") for (int i = 0; i < NV / 2; ++i) { const bool up = (lane & O) != 0; const float send = up ? d[i] : d[i + NV / 2]; const float keep = up ? d[i + NV / 2] : d[i]; d[i] = keep + lane_xor(send, lane, O); }
    FOLD(16, 32) FOLD(8, 16) FOLD(4, 8) FOLD(2, 4)
#undef FOLD
    float dot = d[0]; dot += lane_xor(dot, lane, 2); dot += lane_xor(dot, lane, 1);
    const float myact = mygate * geluf_(dot * (1.0f / 32.0f));
    float acc[16];
#pragma unroll
    for (int k = 0; k < 16; ++k) acc[k] = 0.f;
#pragma unroll
    for (int e = 0; e < 16; ++e) {
      const float a = __int_as_float(__builtin_amdgcn_readlane(__float_as_int(myact), e * 4));
      float f[16]; unpack16_fp8(vrows[e], f);
#pragma unroll
      for (int k = 0; k < 16; ++k) acc[k] += a * f[k];
    }
    float* partc = part + cur * ((8 * 1024 * 4 + 2 * 8 * 64 * 4) / 4);
    { float4* pw = (float4*)(partc + wid * 1024 + lane * 16);
      pw[0] = float4{acc[0], acc[1], acc[2], acc[3]}; pw[1] = float4{acc[4], acc[5], acc[6], acc[7]};
      pw[2] = float4{acc[8], acc[9], acc[10], acc[11]}; pw[3] = float4{acc[12], acc[13], acc[14], acc[15]}; }
    __syncthreads();
    { const int c = tid * 2;
      float s0 = 0.f, s1 = 0.f;
#pragma unroll
      for (int w = 0; w < 8; ++w) { const float2 t = *(const float2*)(partc + w * 1024 + c); s0 += t.x; s1 += t.y; }
      xv.x += oscale * g2v.x * s0; xv.y += oscale * g2v.y * s1; *(float2*)(p.xcur() + (size_t)r * D + c) = xv; }
    cur ^= 1;
  }
}
#endif

DEVN void ph_final(const Params& p, i64 gtid, i64 gsz) {
  const float* g = p.in[I_g_final];
#ifndef CPU_SIM
  float pscale = 1.0f;
#if PROBE_K >= 0
  { const unsigned long long* ts = (const unsigned long long*)(p.ws + WL.ts);
    const float frac = (float)(ts[PROBE_K + 1] - ts[0]) / (float)(ts[NPHASES - 1] - ts[0]);
    pscale = 1.0f + sqrtf(floorf(frac * 50.0f + 0.5f) * 0.02f); }
#endif
  const int lane = (int)(gtid & 63);
  const i64 W = gsz >> 6;
  float4 gv[4];
#pragma unroll
  for (int i = 0; i < 4; ++i) gv[i] = *(const float4*)(g + (lane + i * 64) * 4);
  for (i64 r = gtid >> 6; r < NLAT; r += 2 * W) {
    const bool two = r + W < NLAT;
    const i64 rb = two ? r + W : r;
    const float4* xra = (const float4*)(p.xcur() + (size_t)r * D); const float4* xrb = (const float4*)(p.xcur() + (size_t)rb * D);
    float4 xa[4], xb[4]; float sa = 0.f, sb = 0.f;
#pragma unroll
    for (int i = 0; i < 4; ++i) { xa[i] = xra[lane + i * 64]; xb[i] = xrb[lane + i * 64]; }
#pragma unroll
    for (int i = 0; i < 4; ++i) { sa += xa[i].x * xa[i].x + xa[i].y * xa[i].y + xa[i].z * xa[i].z + xa[i].w * xa[i].w; sb += xb[i].x * xb[i].x + xb[i].y * xb[i].y + xb[i].z * xb[i].z + xb[i].w * xb[i].w; }
#pragma unroll
    for (int o = 32; o >= 1; o >>= 1) { sa += lane_xor(sa, lane, o); sb += lane_xor(sb, lane, o); }
    const float rsa = 1.0f / sqrtf(sa * (1.0f / D) + EPS), rsb = 1.0f / sqrtf(sb * (1.0f / D) + EPS);
#pragma unroll
    for (int i = 0; i < 4; ++i) {
      const int k = (lane + i * 64) * 4;
      float4 o4; o4.x = xa[i].x * rsa * gv[i].x * pscale; o4.y = xa[i].y * rsa * gv[i].y * pscale; o4.z = xa[i].z * rsa * gv[i].z * pscale; o4.w = xa[i].w * rsa * gv[i].w * pscale;
      *(float4*)(p.out + (size_t)r * D + k) = o4;
    }
    if (two) {
#pragma unroll
      for (int i = 0; i < 4; ++i) {
        const int k = (lane + i * 64) * 4;
        float4 o4; o4.x = xb[i].x * rsb * gv[i].x * pscale; o4.y = xb[i].y * rsb * gv[i].y * pscale; o4.z = xb[i].z * rsb * gv[i].z * pscale; o4.w = xb[i].w * rsb * gv[i].w * pscale;
        *(float4*)(p.out + (size_t)rb * D + k) = o4;
      }
    }
  }
#else
  for (i64 r = gtid; r < NLAT; r += gsz) {
    const float* xr = p.xcur() + (size_t)r * D;
    float ss = 0.f;
    for (int k = 0; k < D; ++k) ss += xr[k] * xr[k];
    float rstd = 1.0f / sqrtf(ss / D + EPS);
    for (int k = 0; k < D; ++k) p.out[(size_t)r * D + k] = xr[k] * rstd * g[k];
  }
#endif
}

DEV void rope4(float* v, const float* tab, int nf, int pos, int f0) {
#pragma unroll
  for (int jj = 0; jj < 4; ++jj) {
    float c = tab[(pos * nf + f0 + jj) * 2], s = tab[(pos * nf + f0 + jj) * 2 + 1];
    float x1 = v[2 * jj], x2 = v[2 * jj + 1];
    v[2 * jj] = x1 * c - x2 * s; v[2 * jj + 1] = x1 * s + x2 * c;
  }
}
struct EpiInproj {
  static constexpr int W = 8; static constexpr bool SUB = false; static constexpr bool STAGED = false;
  const Params& p;
  MDEV void apply(int r, int c0, float* v) const {
    if (c0 >= 3744) return;
    if (c0 >= 384 && r < NLAT) {
      int t = r % N;
      if (c0 < C_KR + 32) { int pi = (c0 - C_KR) >> 1; int half = pi >> 3; rope4(v, p.tabA(), 8, half ? t % GRIDW : t / GRIDW, pi & 7); }
      else if (c0 >= C_GQ && c0 < C_GKV + 128) { int pi = ((c0 - C_GQ) & 63) >> 1; int half = pi >> 4; rope4(v, p.tabD(), 16, half ? t % GRIDW : t / GRIDW, pi & 15); }
    }
    store8bf(p.P() + (size_t)r * PC + c0, v);
  }
};
struct EpiUq {
  static constexpr int W = 8; static constexpr bool SUB = false; static constexpr bool STAGED = true; static constexpr bool STAGED_ALL = true;
  const Params& p;
  MDEV void apply(int r, int c0, float* v) const {
    float rstd = 1.0f / sqrtf(p.ssq()[r] * (1.0f / 256.0f) + EPS);
#pragma unroll
    for (int j = 0; j < 8; ++j) v[j] *= rstd;
    int d0 = c0 % 96;
    if (d0 >= 64 && r < NLAT) { int t = r % N; int pi = (d0 - 64) >> 1; int half = pi >> 3; rope4(v, p.tabA(), 8, half ? t % GRIDW : t / GRIDW, pi & 7); }
    store8bf(p.QA() + (size_t)r * 768 + c0, v);
  }
#ifndef CPU_SIM
  struct Pre { float s; float4 t0, t1; };
  MDEV void pre(int r, int c0, Pre& q) const {
    q.s = p.ssq()[r];
    const int d0 = c0 % 96;
    q.t0 = float4{1.f, 0.f, 1.f, 0.f}; q.t1 = q.t0;
    if (d0 >= 64 && r < NLAT) { const int t = r % N, pi = (d0 - 64) >> 1, half = pi >> 3; const int pos = half ? t % GRIDW : t / GRIDW;
      const float* tb = p.tabA() + (pos * 8 + (pi & 7)) * 2; q.t0 = *(const float4*)tb; q.t1 = *(const float4*)(tb + 4); }
  }
  MDEV void fin(int r, int c0, float* v, const Pre& q) const {
    const float rstd = 1.0f / sqrtf(q.s * (1.0f / 256.0f) + EPS);
    const float cs[8] = {q.t0.x, q.t0.y, q.t0.z, q.t0.w, q.t1.x, q.t1.y, q.t1.z, q.t1.w};
    float o[8];
#pragma unroll
    for (int jj = 0; jj < 4; ++jj) { const float x1 = v[2 * jj] * rstd, x2 = v[2 * jj + 1] * rstd, c = cs[2 * jj], sn = cs[2 * jj + 1]; o[2 * jj] = x1 * c - x2 * sn; o[2 * jj + 1] = x1 * sn + x2 * c; }
    store8bf(p.QA() + (size_t)r * 768 + c0, o);
  }
#endif
};
struct EpiUkv {
  static constexpr int W = 8; static constexpr bool SUB = false; static constexpr bool STAGED = true; static constexpr bool STAGED_ALL = true;
  const Params& p;
  MDEV void apply(int r, int c0, float* v) const {
    float rstd = 1.0f / sqrtf(p.ssq()[TT + r] * (1.0f / 128.0f) + EPS);
#pragma unroll
    for (int j = 0; j < 8; ++j) v[j] *= rstd;
    store8bf(p.KVA() + (size_t)r * 1024 + c0, v);
  }
#ifndef CPU_SIM
  struct Pre { float s; };
  MDEV void pre(int r, int, Pre& q) const { q.s = p.ssq()[TT + r]; }
  MDEV void fin(int r, int c0, float* v, const Pre& q) const {
    const float rstd = 1.0f / sqrtf(q.s * (1.0f / 128.0f) + EPS);
#pragma unroll
    for (int j = 0; j < 8; ++j) v[j] *= rstd;
    store8bf(p.KVA() + (size_t)r * 1024 + c0, v);
  }
#endif
};
struct EpiLru {
  static constexpr int W = 8; static constexpr bool SUB = false; static constexpr bool STAGED = true; static constexpr bool STAGED_ALL = true;
  const Params& p; int l; const float* br; const float* bi;
  MDEV void finish(int r, int c0, const float* v, const float* brv, const float* biv, const float* splv, const float* xcv) const {
    int kw = c0 >> 10, dir = (c0 >> 9) & 1, blk4 = (c0 >> 7) & 3, jc0 = (c0 & 127) >> 1;
    int cb = kw * 256 + blk4 * 64 + jc0;
    float lav[4], lbv[4];
#pragma unroll
    for (int jj = 0; jj < 4; ++jj) {
      float rg = sigmoidf_(v[2 * jj] + brv[jj]), ig = sigmoidf_(v[2 * jj + 1] + biv[jj]);
      float log_a = -8.0f * rg * splv[jj];
      const float a_ = fexpf_(log_a);
      lav[jj] = log_a; lbv[jj] = sqrtf(fmaxf(1.0f - a_ * a_, 0.0f)) * ig * xcv[jj];
    }
#ifndef CPU_SIM
    { uint4 w;
      w.x = pk2bf(lav[0], lbv[0]); w.y = pk2bf(lav[1], lbv[1]); w.z = pk2bf(lav[2], lbv[2]); w.w = pk2bf(lav[3], lbv[3]);
      *(uint4*)(p.LAB() + ((size_t)dir * TT + r) * 512 + cb) = w; }
#else
    bf* la = p.LA() + ((size_t)dir * TT + r) * 512 + cb;
    bf* lb = p.LB() + ((size_t)dir * TT + r) * 512 + cb;
    for (int jj = 0; jj < 4; ++jj) { la[jj] = f2b(lav[jj]); lb[jj] = f2b(lbv[jj]); }
#endif
  }
  MDEV void apply(int r, int c0, float* v) const {
    int kw = c0 >> 10, dir = (c0 >> 9) & 1, blk4 = (c0 >> 7) & 3, jc0 = (c0 & 127) >> 1;
    int cb = kw * 256 + blk4 * 64 + jc0;
    float brv[4], biv[4], splv[4], xcv[4];
    for (int jj = 0; jj < 4; ++jj) { brv[jj] = br[(l * 2 + dir) * 512 + cb + jj]; biv[jj] = bi[(l * 2 + dir) * 512 + cb + jj]; splv[jj] = p.spl()[(l * 2 + dir) * 512 + cb + jj]; xcv[jj] = b2f(p.XC()[(size_t)r * 512 + cb + jj]); }
    finish(r, c0, v, brv, biv, splv, xcv);
  }
#ifndef CPU_SIM
  struct Pre { float4 a4, b4, s4; uint2 x2; };
  MDEV void pre(int r, int c0, Pre& q) const {
    int kw = c0 >> 10, dir = (c0 >> 9) & 1, blk4 = (c0 >> 7) & 3, jc0 = (c0 & 127) >> 1;
    int cb = kw * 256 + blk4 * 64 + jc0;
    q.a4 = gld4(br + (l * 2 + dir) * 512 + cb); q.b4 = gld4(bi + (l * 2 + dir) * 512 + cb);
    q.s4 = *(const float4*)(p.spl() + (l * 2 + dir) * 512 + cb);
    q.x2 = *(const uint2*)(p.XC() + (size_t)r * 512 + cb);
  }
  MDEV void fin(int r, int c0, float* v, const Pre& q) const {
    const float brv[4] = {q.a4.x, q.a4.y, q.a4.z, q.a4.w}, biv[4] = {q.b4.x, q.b4.y, q.b4.z, q.b4.w}, splv[4] = {q.s4.x, q.s4.y, q.s4.z, q.s4.w};
    const float xcv[4] = {__uint_as_float(q.x2.x << 16), __uint_as_float(q.x2.x & 0xFFFF0000u), __uint_as_float(q.x2.y << 16), __uint_as_float(q.x2.y & 0xFFFF0000u)};
    finish(r, c0, v, brv, biv, splv, xcv);
  }
#endif
};
struct EpiGate {
  static constexpr int W = 8; static constexpr bool SUB = false; static constexpr bool STAGED = false;
  const Params& p;
  MDEV void apply(int r, int c0, float* v) const {
#pragma unroll
    for (int j = 0; j < 8; ++j) v[j] = sigmoidf_(v[j]);
    store8bf(p.Gs() + (size_t)r * D + c0, v);
  }
};
struct EpiBranch {
  static constexpr int W = 8; static constexpr bool SUB = false; static constexpr bool STAGED = false;
  const Params& p; int br;
  MDEV void apply(int r, int c0, float* v) const {
    float g[8]; load8bf(p.Gs() + (size_t)r * D + c0, g);
    if (br > 0) {
      float mo[8]; load8bf(p.M() + (size_t)r * D + c0, mo);
#pragma unroll
      for (int j = 0; j < 8; ++j) v[j] = mo[j] + g[j] * v[j];
    } else {
#pragma unroll
      for (int j = 0; j < 8; ++j) v[j] = g[j] * v[j];
    }
    store8bf(p.M() + (size_t)r * D + c0, v);
  }
};
struct EpiGateAll {
  static constexpr int W = 8; static constexpr bool SUB = false; static constexpr bool STAGED = false;
  const Params& p;
  MDEV void apply(int r, int c0, float* v) const {
#pragma unroll
    for (int j = 0; j < 8; ++j) v[j] = sigmoidf_(v[j]) * 255.f + 0.5f;
    unsigned char* gq = p.G8() + (size_t)r * 4096 + c0;
#ifndef CPU_SIM
    uint2 w;
    w.x = (unsigned)v[0] | ((unsigned)v[1] << 8) | ((unsigned)v[2] << 16) | ((unsigned)v[3] << 24);
    w.y = (unsigned)v[4] | ((unsigned)v[5] << 8) | ((unsigned)v[6] << 16) | ((unsigned)v[7] << 24);
    *(uint2*)gq = w;
#else
    for (int j = 0; j < 8; ++j) gq[j] = (unsigned char)v[j];
#endif
  }
};
struct EpiBranchSub {
  static constexpr int W = 8; static constexpr bool SUB = true; static constexpr bool STAGED = true; static constexpr bool STAGED_ALL = false;
  const Params& p;
  MDEV void apply(int, int, float*) const {}
  MDEV void gate8(int r, int c0, int i, float* g) const {
    const unsigned char* gq = p.G8() + (size_t)r * 4096 + i * 1024 + c0;
#ifndef CPU_SIM
    const uint2 w = *(const uint2*)gq;
#pragma unroll
    for (int j = 0; j < 4; ++j) { g[j] = (float)((w.x >> (8 * j)) & 255u) * (1.0f / 255.0f); g[4 + j] = (float)((w.y >> (8 * j)) & 255u) * (1.0f / 255.0f); }
#else
    for (int j = 0; j < 8; ++j) g[j] = (float)gq[j] * (1.0f / 255.0f);
#endif
  }
  MDEV void apply_sub(int r, int c0, float* v, int sub) const {
    if (sub < 3) { store8bf(p.BR() + (size_t)r * 3072 + sub * 1024 + c0, v); return; }
    float g[8]; gate8(r, c0, 3, g);
#pragma unroll
    for (int j = 0; j < 8; ++j) v[j] *= g[j];
#pragma unroll
    for (int i = 0; i < 3; ++i) {
      float bi[8]; load8bf(p.BR() + (size_t)r * 3072 + i * 1024 + c0, bi);
      gate8(r, c0, i, g);
#pragma unroll
      for (int j = 0; j < 8; ++j) v[j] += g[j] * bi[j];
    }
    store8bf(p.M() + (size_t)r * D + c0, v);
  }
#ifndef CPU_SIM
  struct Pre { uint2 g[4]; uint4 b[3]; };
  MDEV void pre(int r, int c0, Pre& q) const {
#pragma unroll
    for (int i = 0; i < 4; ++i) q.g[i] = *(const uint2*)(p.G8() + (size_t)r * 4096 + i * 1024 + c0);
#pragma unroll
    for (int i = 0; i < 3; ++i) q.b[i] = *(const uint4*)(p.BR() + (size_t)r * 3072 + i * 1024 + c0);
  }
  MDEV void fin(int r, int c0, float* v, const Pre& q) const {
#pragma unroll
    for (int i = 3; i >= 0; --i) {
      float g[8];
#pragma unroll
      for (int j = 0; j < 4; ++j) { g[j] = (float)((q.g[i].x >> (8 * j)) & 255u) * (1.0f / 255.0f); g[4 + j] = (float)((q.g[i].y >> (8 * j)) & 255u) * (1.0f / 255.0f); }
      if (i == 3) {
#pragma unroll
        for (int j = 0; j < 8; ++j) v[j] *= g[j];
      } else {
        float bi[8]; unpack8(q.b[i], bi);
#pragma unroll
        for (int j = 0; j < 8; ++j) v[j] += g[j] * bi[j];
      }
    }
    store8bf(p.M() + (size_t)r * D + c0, v);
  }
#endif
};
struct EpiFilt {
  static constexpr int W = 8; static constexpr bool SUB = false; static constexpr bool STAGED = false;
  const Params& p;
  MDEV void apply(int j, int tt, float* v) const {
    const float maxd = -15.350567286626973f, mind = -3.0701134573253945f;
    const float ad = fabsf(mind + (float)j * ((maxd - mind) / 1023.0f));
    int t, L; if (tt < N) { t = tt; L = N; } else { t = tt - N; L = LC; }
    const float sc = -ad / (float)(L - 1);
#pragma unroll
    for (int q = 0; q < 8; ++q) v[q] *= fexpf_((float)(t + q) * sc);
    float* d = p.F() + (size_t)j * (N + LC) + tt;
#ifndef CPU_SIM
    *(float4*)d = float4{v[0], v[1], v[2], v[3]}; *(float4*)(d + 4) = float4{v[4], v[5], v[6], v[7]};
#else
    for (int q = 0; q < 8; ++q) d[q] = v[q];
#endif
  }
};
struct EpiOut {
  static constexpr int W = 8; static constexpr bool SUB = false; static constexpr bool STAGED = true; static constexpr bool STAGED_ALL = true;
  const Params& p; int l; float osc; const float* xlat; const float* xctx;
  MDEV void apply(int r, int c0, float* v) const {
    const float* g1 = p.mods() + ((size_t)l * 3 + modrow(r)) * 6 * D + 2 * D + c0;
    const float* xs = (r < NLAT ? xlat + (size_t)r * D : xctx + (size_t)(r - NLAT) * D) + c0;
    float* xr = p.xcur() + (size_t)r * D + c0;
    for (int j = 0; j < 8; ++j) xr[j] = xs[j] + osc * g1[j] * v[j];
  }
#ifndef CPU_SIM
  struct Pre { float4 g0, g1, x0, x1; };
  MDEV void pre(int r, int c0, Pre& q) const {
    const float* g1 = p.mods() + ((size_t)l * 3 + modrow(r)) * 6 * D + 2 * D + c0;
    const float* xs = (r < NLAT ? xlat + (size_t)r * D : xctx + (size_t)(r - NLAT) * D) + c0;
    q.g0 = *(const float4*)g1; q.g1 = *(const float4*)(g1 + 4); q.x0 = gld4(xs); q.x1 = gld4(xs + 4);
  }
  MDEV void fin(int r, int c0, float* v, const Pre& q) const {
    float* xr = p.xcur() + (size_t)r * D + c0;
    float4 o0, o1;
    o0.x = q.x0.x + osc * q.g0.x * v[0]; o0.y = q.x0.y + osc * q.g0.y * v[1]; o0.z = q.x0.z + osc * q.g0.z * v[2]; o0.w = q.x0.w + osc * q.g0.w * v[3];
    o1.x = q.x1.x + osc * q.g1.x * v[4]; o1.y = q.x1.y + osc * q.g1.y * v[5]; o1.z = q.x1.z + osc * q.g1.z * v[6]; o1.w = q.x1.w + osc * q.g1.w * v[7];
    *(float4*)xr = o0; *(float4*)(xr + 4) = o1;
  }
#endif
};
struct EpiPQ {
  static constexpr int W = 8; static constexpr bool SUB = false; static constexpr bool STAGED = false;
  const Params& p;
  MDEV void apply(int r, int c0, float* v) const { store8bf(p.PQ() + (size_t)r * 1024 + c0, v); }
};
struct EpiSC {
  static constexpr int W = 8; static constexpr bool SUB = false; static constexpr bool STAGED = false;
  const Params& p;
  MDEV void apply(int r, int c0, float* v) const {
    sc_t* d = p.SC() + (size_t)r * 2048 + c0;
#ifndef CPU_SIM
    typedef _Float16 half8 __attribute__((ext_vector_type(8)));
    half8 hv8;
#pragma unroll
    for (int j = 0; j < 8; ++j) hv8[j] = (_Float16)v[j];
    *(half8*)d = hv8;
#else
    for (int j = 0; j < 8; ++j) d[j] = (sc_t)v[j];
#endif
  }
};

struct GemmDesc { const bf* A; const bf* Bt; int lda, ldb, K, nrows, ncols; int a_pn_shift, a_pn_mul; int nsub = 1, a_sub = 0, b_sub = 0; int unit_off = 0; };

#ifndef CPU_SIM
namespace pg8 {
#define PG8_LAS __attribute__((address_space(3)))
typedef short bf16x8 __attribute__((ext_vector_type(8)));
typedef float f32x4 __attribute__((ext_vector_type(4)));
constexpr int BM = 256, BK = 64, HALF = 128, HTB = HALF * BK * 2, STAGE_BYTES = 8 * HTB, NXCD = 8, WGM = 8;
__device__ __forceinline__ int lds_byte(int r, int c) { const int st = (r >> 4) * 2 + (c >> 5), rr = r & 15, cc = c & 31, ob = rr * 64 + cc * 2; return st * 1024 + (ob ^ (((ob >> 9) & 1) << 5)); }
__device__ __forceinline__ void stage_rc(int b, int& R, int& C) { const int st = b / 1024, sb = b % 1024, swz = sb ^ (((sb >> 9) & 1) << 5); R = (st >> 1) * 16 + swz / 64; C = (st & 1) * 32 + (swz % 64) / 2; }
__device__ __forceinline__ int perm32(int rho) { const int n = rho >> 4, i = rho & 15; return 8 * (i >> 2) + 4 * n + (i & 3); }
struct Unit { int pm, pn, sub; };
struct StaticOrder {
  int nM, nN, nwg, G, c, nsub;
  __device__ void init(int nM_, int nN_, int G_, int c_, int nsub_) { nM = nM_; nN = nN_; nwg = nM * nN; G = G_; c = c_; nsub = nsub_; }
  __device__ bool next(int i, Unit& u) const {
    const int it = i / nsub; u.sub = i - it * nsub;
    const long L = (long)it * G + c; if (L >= nwg) return false;
    int wgid = (int)L; { const int q = nwg / NXCD, r = nwg % NXCD, xcd = wgid % NXCD, off = wgid / NXCD; wgid = (xcd < r ? xcd * (q + 1) : r * (q + 1) + (xcd - r) * q) + off; }
    const int nig = WGM * nN, gid = wgid / nig, fm = gid * WGM, gsz = (nM - fm) < WGM ? (nM - fm) : WGM;
    u.pm = fm + ((wgid % nig) % gsz); u.pn = (wgid % nig) / gsz; return true;
  }
};

template <class E>
__device__ __forceinline__ void epi_call(const E& e, const f32x4 (&acc)[2][2][4][2], const Unit& u, int wr, int wc, int fr_, int fq_) {
  int fr = fr_, fq = fq_;
  asm volatile("" : "+v"(fr), "+v"(fq));
  if constexpr (E::STAGED) {
    if (E::STAGED_ALL || u.sub == 3) {
#pragma unroll
      for (int ai = 0; ai < 2; ++ai)
#pragma unroll
        for (int m = 0; m < 4; ++m) {
          typename E::Pre q[2];
#pragma unroll
          for (int bj = 0; bj < 2; ++bj) { q[bj] = typename E::Pre{}; e.pre(u.pm * BM + ai * HALF + wr * 64 + m * 16 + fr, u.pn * BM + bj * HALF + wc * 32 + 8 * fq, q[bj]); }
#pragma unroll
          for (int bj = 0; bj < 2; ++bj) {
            float v[8];
#pragma unroll
            for (int j = 0; j < 4; ++j) { v[j] = acc[ai][bj][m][0][j]; v[4 + j] = acc[ai][bj][m][1][j]; }
            e.fin(u.pm * BM + ai * HALF + wr * 64 + m * 16 + fr, u.pn * BM + bj * HALF + wc * 32 + 8 * fq, v, q[bj]);
          }
          __builtin_amdgcn_sched_barrier(0);
        }
      return;
    }
  }
#pragma unroll
  for (int ai = 0; ai < 2; ++ai)
#pragma unroll
    for (int m = 0; m < 4; ++m) {
      const int r = u.pm * BM + ai * HALF + wr * 64 + m * 16 + fr;
#pragma unroll
      for (int bj = 0; bj < 2; ++bj) {
        if constexpr (E::W == 8) {
          const int c0 = u.pn * BM + bj * HALF + wc * 32 + 8 * fq;
          float v[8];
#pragma unroll
          for (int j = 0; j < 4; ++j) { v[j] = acc[ai][bj][m][0][j]; v[4 + j] = acc[ai][bj][m][1][j]; }
          if constexpr (E::W == 8 && E::SUB) e.apply_sub(r, c0, v, u.sub); else e.apply(r, c0, v);
        } else {
#pragma unroll
          for (int n = 0; n < 2; ++n) {
            const int c0 = u.pn * BM + bj * HALF + wc * 32 + 16 * n + 4 * fq;
            float v[4];
#pragma unroll
            for (int j = 0; j < 4; ++j) v[j] = acc[ai][bj][m][n][j];
            e.apply(r, c0, v);
          }
        }
      }
      if (m == 1 || m == 3) __builtin_amdgcn_sched_barrier(0);
    }
}

template <class Epi>
__device__ __forceinline__ void gemm_phase(PG8_LAS unsigned char* lds, const int tid, const GemmDesc g, const Epi& E) {
  constexpr bool PERM = (Epi::W == 8);
  const int wid = __builtin_amdgcn_readfirstlane(tid >> 6), lane = tid & 63, wr = wid >> 2, wc = wid & 3, fr = lane & 15, fq = lane >> 4;
  const int K = g.K, nt = K / BK;
  StaticOrder S; S.init(g.nrows / BM, g.ncols / BM, (int)gridDim.x, (int)((blockIdx.x + gridDim.x - (unsigned)g.unit_off % gridDim.x) % gridDim.x), g.nsub);
  unsigned voffA[2], voffB[2];
#pragma unroll
  for (int i = 0; i < 2; ++i) { int R, C; stage_rc(tid * 16 + i * 8192, R, C); const int Rb = PERM ? ((R & ~31) + perm32(R & 31)) : R;
    voffA[i] = (unsigned)(R * g.lda + C) * 2u; voffB[i] = (unsigned)(Rb * g.ldb + C) * 2u; }
  const size_t kstep = (size_t)(BK * 2);
  const size_t hstepA = (size_t)HALF * g.lda * 2, hstepB = (size_t)HALF * g.ldb * 2;
  const unsigned ldsw = (unsigned)wid * 1024u;
  const int aoff = lds_byte(wr * 64 + fr, fq * 8), boff = lds_byte(wc * 32 + fr, fq * 8);
#define PG8_SA(b, h) (((b) * 2 + (h)) * HTB)
#define PG8_SB(b, h) ((4 + (b) * 2 + (h)) * HTB)
#define PG8_STAGE(bufoff, gbase, voff) do { _Pragma("unroll") for (int _i = 0; _i < 2; ++_i) \
        __builtin_amdgcn_global_load_lds((const unsigned*)((const char*)(gbase) + (voff)[_i]), (PG8_LAS unsigned*)(lds + (bufoff) + ldsw + _i * 8192), 16, 0, 0); } while (0)
#define PG8_LDA(dst, b, h) do { _Pragma("unroll") for (int m = 0; m < 4; ++m) _Pragma("unroll") for (int k = 0; k < 2; ++k) dst[m][k] = *(const PG8_LAS bf16x8*)(lds + PG8_SA(b, h) + aoff + m * 2048 + k * 1024); } while (0)
#define PG8_LDB(dst, b, h) do { _Pragma("unroll") for (int n = 0; n < 2; ++n) _Pragma("unroll") for (int k = 0; k < 2; ++k) dst[n][k] = *(const PG8_LAS bf16x8*)(lds + PG8_SB(b, h) + boff + n * 2048 + k * 1024); } while (0)
#define PG8_MMA(ai, bj, At, Bt) do { __builtin_amdgcn_s_setprio(1); _Pragma("unroll") for (int m = 0; m < 4; ++m) _Pragma("unroll") for (int n = 0; n < 2; ++n) _Pragma("unroll") for (int k = 0; k < 2; ++k) \
        acc[ai][bj][m][n] = __builtin_amdgcn_mfma_f32_16x16x32_bf16(Bt[n][k], At[m][k], acc[ai][bj][m][n], 0, 0, 0); __builtin_amdgcn_s_setprio(0); } while (0)
#define PG8_WAIT_V(n) asm volatile("s_waitcnt vmcnt(" #n ")" ::: "memory")
#define PG8_WAIT_L(n) asm volatile("s_waitcnt lgkmcnt(" #n ")" ::: "memory")
#define PG8_BAR __builtin_amdgcn_s_barrier()
#define PG8_SCHED __builtin_amdgcn_sched_barrier(0)
#define PG8_ABASE(u) ((const char*)g.A + ((size_t)(u).pm * BM * g.lda + (size_t)((u).pn >> g.a_pn_shift) * g.a_pn_mul + (size_t)(u).sub * g.a_sub) * 2)
#define PG8_BBASE(u) ((const char*)g.Bt + ((size_t)(u).pn * BM * g.ldb + (size_t)(u).sub * g.b_sub) * 2)
  Unit cur, nxt; int ui = 0;
  if (!S.next(0, cur)) return;
  f32x4 acc[2][2][4][2];
#pragma unroll
  for (int a = 0; a < 2; ++a)
#pragma unroll
    for (int b = 0; b < 2; ++b)
#pragma unroll
      for (int m = 0; m < 4; ++m)
#pragma unroll
        for (int n = 0; n < 2; ++n) acc[a][b][m][n] = (f32x4){0.f, 0.f, 0.f, 0.f};
  bf16x8 At[4][2], B0[2][2], B1[2][2];
  const char* cA = PG8_ABASE(cur); const char* cB = PG8_BBASE(cur);
  asm volatile("" : "+v"(voffA[0]), "+v"(voffA[1]), "+v"(voffB[0]), "+v"(voffB[1]));
  PG8_STAGE(PG8_SB(0, 0), cB, voffB); PG8_STAGE(PG8_SA(0, 0), cA, voffA); PG8_STAGE(PG8_SB(0, 1), cB + hstepB, voffB); PG8_STAGE(PG8_SA(0, 1), cA + hstepA, voffA);
  if (wr == 1) PG8_BAR;
  PG8_WAIT_V(4); PG8_BAR;
  PG8_STAGE(PG8_SB(1, 0), cB + kstep, voffB); PG8_STAGE(PG8_SA(1, 0), cA + kstep, voffA); PG8_STAGE(PG8_SB(1, 1), cB + hstepB + kstep, voffB);
  PG8_WAIT_V(6); PG8_BAR;
  for (;;) {
    const bool has_next = S.next(ui + 1, nxt);
    const char* nA = has_next ? PG8_ABASE(nxt) : cA; const char* nB = has_next ? PG8_BBASE(nxt) : cB;
    for (int t = 0; t < nt; t += 2) {
      const bool last = (t == nt - 2);
      asm volatile("" : "+v"(voffA[0]), "+v"(voffA[1]), "+v"(voffB[0]), "+v"(voffB[1]));
      const char* a1 = cA + (size_t)(t + 1) * kstep;
      const char* a2 = last ? nA : cA + (size_t)(t + 2) * kstep; const char* b2 = last ? nB : cB + (size_t)(t + 2) * kstep;
      const char* a3 = a2 + kstep; const char* b3 = b2 + kstep;
      PG8_LDB(B0, 0, 0); PG8_SCHED; PG8_LDA(At, 0, 0); PG8_STAGE(PG8_SA(1, 1), a1 + hstepA, voffA);
      PG8_WAIT_L(8); PG8_BAR; PG8_WAIT_L(0); PG8_MMA(0, 0, At, B0); PG8_BAR; PG8_SCHED;
      PG8_LDB(B1, 0, 1); PG8_STAGE(PG8_SB(0, 0), b2, voffB);
      PG8_BAR; PG8_WAIT_L(0); PG8_MMA(0, 1, At, B1); PG8_BAR;
      PG8_LDA(At, 0, 1); PG8_STAGE(PG8_SA(0, 0), a2, voffA);
      PG8_BAR; PG8_WAIT_L(0); PG8_MMA(1, 0, At, B0); PG8_BAR; PG8_SCHED;
      PG8_STAGE(PG8_SB(0, 1), b2 + hstepB, voffB);
      PG8_WAIT_V(6); PG8_BAR; PG8_MMA(1, 1, At, B1); PG8_BAR;
      PG8_LDB(B0, 1, 0); PG8_SCHED; PG8_LDA(At, 1, 0); PG8_STAGE(PG8_SA(0, 1), a2 + hstepA, voffA);
      PG8_WAIT_L(8); PG8_BAR; PG8_WAIT_L(0); PG8_MMA(0, 0, At, B0); PG8_BAR; PG8_SCHED;
      PG8_LDB(B1, 1, 1); PG8_STAGE(PG8_SB(1, 0), b3, voffB);
      PG8_BAR; PG8_WAIT_L(0); PG8_MMA(0, 1, At, B1); PG8_BAR;
      PG8_LDA(At, 1, 1); PG8_STAGE(PG8_SA(1, 0), a3, voffA);
      PG8_BAR; PG8_WAIT_L(0); PG8_MMA(1, 0, At, B0); PG8_BAR; PG8_SCHED;
      PG8_STAGE(PG8_SB(1, 1), b3 + hstepB, voffB);
      PG8_WAIT_V(6); PG8_BAR; PG8_MMA(1, 1, At, B1); PG8_BAR;
    }
    epi_call(E, acc, cur, wr, wc, fr, fq);
    if (!has_next) break;
#pragma unroll
    for (int a = 0; a < 2; ++a)
#pragma unroll
      for (int b = 0; b < 2; ++b)
#pragma unroll
        for (int m = 0; m < 4; ++m)
#pragma unroll
          for (int n = 0; n < 2; ++n) acc[a][b][m][n] = (f32x4){0.f, 0.f, 0.f, 0.f};
    cur = nxt; cA = nA; cB = nB; ++ui;
  }
  PG8_WAIT_V(0);
  if (wr == 0) PG8_BAR;
  PG8_BAR;
#undef PG8_SA
#undef PG8_SB
#undef PG8_STAGE
#undef PG8_LDA
#undef PG8_LDB
#undef PG8_MMA
#undef PG8_WAIT_V
#undef PG8_WAIT_L
#undef PG8_BAR
#undef PG8_SCHED
#undef PG8_ABASE
#undef PG8_BBASE
}
}
struct Ctx { i64 gtid, gsz; PG8_LAS unsigned char* lds; char* ldsg; int tid; };
template <class E> DEV void run_gemm(const Ctx& cx, const GemmDesc& g, const E& e) { pg8::gemm_phase<E>(cx.lds, cx.tid, g, e); }
#else
struct Ctx { i64 gtid, gsz; };
template <class E> static void run_gemm(const Ctx& cx, const GemmDesc& g, const E& e) {
  constexpr int W = E::W;
  const int ng = g.ncols / W;
  for (i64 i = cx.gtid; i < (i64)g.nrows * ng; i += cx.gsz) {
    int r = (int)(i / ng), c0 = (int)(i % ng) * W;
    int pn = c0 / 256;
    for (int sub = 0; sub < g.nsub; ++sub) {
      const bf* a = g.A + (size_t)r * g.lda + (size_t)(pn >> g.a_pn_shift) * g.a_pn_mul + (size_t)sub * g.a_sub;
      float v[8];
      for (int j = 0; j < W; ++j) {
        const bf* b = g.Bt + (size_t)(c0 + j) * g.ldb + (size_t)sub * g.b_sub;
        float acc = 0.f;
        for (int k = 0; k < g.K; ++k) acc += b2f(a[k]) * b2f(b[k]);
        v[j] = acc;
      }
      if constexpr (E::SUB) e.apply_sub(r, c0, v, sub); else e.apply(r, c0, v);
    }
  }
}
#endif


#ifndef CPU_SIM
namespace fa {
using bf16x8 = __attribute__((ext_vector_type(8))) short;
using s16x4 = __attribute__((ext_vector_type(4))) short;
using f32x16 = __attribute__((ext_vector_type(16))) float;
using u32x4 = __attribute__((ext_vector_type(4))) unsigned;
constexpr int KVBLK = 64, QBLK = 32;
constexpr float THR = 8.f;
constexpr int SHM_V = KVBLK * 128 * 2, SHM_K = KVBLK * 128 * 2;
constexpr int NBUF = 3;
constexpr int SHM_ATTN = NBUF * SHM_V + NBUF * SHM_K + 8 * 64 * 4;
#define KSWZ(row, colB) ((row) * 256 + ((colB) ^ (((row) & 7) << 4)))
#define SBAR() __builtin_amdgcn_sched_barrier(0)
__device__ __forceinline__ int crow(int r, int hi) { return (r & 3) + 8 * (r >> 2) + 4 * hi; }
__device__ __forceinline__ unsigned cvtpk(float lo, float hi) { unsigned r; asm volatile("v_cvt_pk_bf16_f32 %0, %1, %2" : "=v"(r) : "v"(lo), "v"(hi)); return r; }
template <int SC1000000> __device__ __forceinline__ void partialSM(f32x16& p0, f32x16& p1, float& m_reg, float& mn, float& alpha) {
  constexpr float SCALE = SC1000000 * 1e-9f; constexpr float C = SCALE * 1.4426950408889634f;
  float pmax = p0[0];
#pragma unroll
  for (int r = 1; r < 16; ++r) pmax = fmaxf(pmax, p0[r]);
#pragma unroll
  for (int r = 0; r < 16; ++r) pmax = fmaxf(pmax, p1[r]);
  { auto rr = __builtin_amdgcn_permlane32_swap(__float_as_uint(pmax), __float_as_uint(pmax), false, false);
    pmax = fmaxf(__uint_as_float(rr[0]), __uint_as_float(rr[1])); }
  if (__builtin_expect(__all(pmax - m_reg <= THR / SCALE), 1)) { mn = m_reg; alpha = 1.f; }
  else { mn = fmaxf(m_reg, pmax); alpha = __builtin_amdgcn_exp2f((m_reg - mn) * C); m_reg = mn; }
  float mnC = -mn * C;
#pragma unroll
  for (int r = 0; r < 16; ++r) p0[r] = fmaf(p0[r], C, mnC);
#pragma unroll
  for (int r = 0; r < 16; ++r) p1[r] = fmaf(p1[r], C, mnC);
#pragma unroll
  for (int r = 0; r < 16; ++r) p0[r] = __builtin_amdgcn_exp2f(p0[r]);
}
__device__ __forceinline__ void finishSM(f32x16& p0, f32x16& p1, float alpha, float& l_reg, bf16x8& pa0, bf16x8& pa1, bf16x8& pa2, bf16x8& pa3) {
#pragma unroll
  for (int r = 0; r < 16; ++r) p1[r] = __builtin_amdgcn_exp2f(p1[r]);
  float ps = 0;
#pragma unroll
  for (int r = 0; r < 16; ++r) ps += p0[r];
#pragma unroll
  for (int r = 0; r < 16; ++r) ps += p1[r];
  { auto rr = __builtin_amdgcn_permlane32_swap(__float_as_uint(ps), __float_as_uint(ps), false, false);
    ps = __uint_as_float(rr[0]) + __uint_as_float(rr[1]); }
  l_reg = l_reg * alpha + ps;
#define PK4(P, BASE, OUT) do { unsigned a0 = cvtpk(P[BASE + 0], P[BASE + 1]), a1 = cvtpk(P[BASE + 2], P[BASE + 3]);   \
    unsigned b0 = cvtpk(P[BASE + 4], P[BASE + 5]), b1 = cvtpk(P[BASE + 6], P[BASE + 7]);                              \
    auto r0 = __builtin_amdgcn_permlane32_swap(a0, b0, false, false); auto r1 = __builtin_amdgcn_permlane32_swap(a1, b1, false, false); \
    u32x4 w = {r0[0], r1[0], r0[1], r1[1]}; OUT = *reinterpret_cast<bf16x8*>(&w); } while (0)
  PK4(p0, 0, pa0); PK4(p0, 8, pa1); PK4(p1, 0, pa2); PK4(p1, 8, pa3);
#undef PK4
}
template <int NK16>
__device__ __forceinline__ void qkt(f32x16& p0, f32x16& p1, const char* Ks, const bf16x8* qr, int r32, int hi) {
  p0 = f32x16{}; p1 = f32x16{};
#pragma unroll
  for (int d0 = 0; d0 < NK16; ++d0) { int cb = (d0 * 16 + hi * 8) * 2;
    bf16x8 b0 = *reinterpret_cast<const bf16x8*>(Ks + KSWZ(r32, cb));
    bf16x8 b1 = *reinterpret_cast<const bf16x8*>(Ks + KSWZ(32 + r32, cb));
    p0 = __builtin_amdgcn_mfma_f32_32x32x16_bf16(b0, qr[d0], p0, 0, 0, 0);
    p1 = __builtin_amdgcn_mfma_f32_32x32x16_bf16(b1, qr[d0], p1, 0, 0, 0); }
}
__device__ __forceinline__ int v_st(int k, int c) { const int kk = (k & ~0xC) | ((k & 4) << 1) | ((k & 8) >> 1); return ((kk >> 3) * 4 + (c >> 5)) * 512 + ((kk & 7) * 32 + (c & 31)) * 2; }
__device__ __forceinline__ int v_rd_base(int lane) { return ((lane & 3) << 3) | (((lane >> 2) & 3) << 6) | (((lane >> 4) & 1) << 5) | (((lane >> 5) & 1) << 8); }
constexpr int v_rd_off(int d0, int ks, int half) { return d0 * 512 + ks * 4096 + half * 2048; }
template <int OFF> __device__ __forceinline__ s16x4 tr_read(int vb) {
  s16x4 r; asm volatile("ds_read_b64_tr_b16 %0, %1 offset:%2" : "=&v"(r) : "v"(vb), "i"(OFF) : "memory"); return r;
}
template <int D0> __device__ __forceinline__ void pv_one(f32x16& od, int vb, bf16x8 pa0, bf16x8 pa1, bf16x8 pa2, bf16x8 pa3) {
  const s16x4 l0 = tr_read<v_rd_off(D0, 0, 0)>(vb), h0 = tr_read<v_rd_off(D0, 0, 1)>(vb), l1 = tr_read<v_rd_off(D0, 1, 0)>(vb), h1 = tr_read<v_rd_off(D0, 1, 1)>(vb);
  const s16x4 l2 = tr_read<v_rd_off(D0, 2, 0)>(vb), h2 = tr_read<v_rd_off(D0, 2, 1)>(vb), l3 = tr_read<v_rd_off(D0, 3, 0)>(vb), h3 = tr_read<v_rd_off(D0, 3, 1)>(vb);
  asm volatile("s_waitcnt lgkmcnt(0)" ::: "memory"); SBAR();
#define PK(L, H) (bf16x8){L[0], L[1], L[2], L[3], H[0], H[1], H[2], H[3]}
  od = __builtin_amdgcn_mfma_f32_32x32x16_bf16(pa0, PK(l0, h0), od, 0, 0, 0);
  od = __builtin_amdgcn_mfma_f32_32x32x16_bf16(pa1, PK(l1, h1), od, 0, 0, 0);
  od = __builtin_amdgcn_mfma_f32_32x32x16_bf16(pa2, PK(l2, h2), od, 0, 0, 0);
  od = __builtin_amdgcn_mfma_f32_32x32x16_bf16(pa3, PK(l3, h3), od, 0, 0, 0);
#undef PK
}
__device__ __forceinline__ void pv_d0(f32x16* o, int vb, bf16x8 pa0, bf16x8 pa1, bf16x8 pa2, bf16x8 pa3) {
  pv_one<0>(o[0], vb, pa0, pa1, pa2, pa3); pv_one<1>(o[1], vb, pa0, pa1, pa2, pa3);
}

struct Src { const bf* q; int qstride; const bf* ksrc; int kstride; const bf* vsrc; int vstride; bf* out; float m0, l0; int dq0; };
template <int NK16, int SC1000000, bool MASK>
__device__ __forceinline__ void unit(const Src& sd, const int tid, char* lds, int kbase0, int nt0, int kbase1, int NT) {
  const int wid = tid >> 6, lane = tid & 63, r32 = lane & 31, hi = lane >> 5;
  char* V_lds = lds; char* K_lds = lds + NBUF * SHM_V;
  float* wsl = (float*)(lds + NBUF * SHM_V + NBUF * SHM_K) + wid * 64; float* li_l = wsl; float* al_l = wsl + 32;
  float m_reg = sd.m0, l_reg = sd.l0; f32x16 o[2] = {}; bf16x8 qr[NK16];
  const bf* Qw = sd.q + (size_t)(wid * QBLK + r32) * sd.qstride + hi * 8;
#pragma unroll
  for (int d0 = 0; d0 < NK16; ++d0) qr[d0] = *reinterpret_cast<const bf16x8*>(Qw + d0 * 16);
  const int sr = tid >> 4, sc = (tid & 15) * 8, vst0 = v_st(sr, sc), vst1 = v_st(32 + sr, sc);
  const int vb0 = (int)(uintptr_t)V_lds + v_rd_base(lane);
  const bf* ksrc = sd.ksrc; const int kstride = sd.kstride; const bf* vsrc = sd.vsrc; const int vstride = sd.vstride;
  const int dqw = sd.dq0 + wid * QBLK + r32;
  struct { bf16x8 vs0, vs1, ks0, ks1; } sr_[2];
#define KROW(j) ((j) < nt0 ? kbase0 + (j) * KVBLK : kbase1 + ((j) - nt0) * KVBLK)
#define SLOAD(i, j) do { const int _kr = KROW(j); \
    sr_[i].vs0 = *reinterpret_cast<const bf16x8*>(vsrc + (size_t)(_kr + sr) * vstride); sr_[i].vs1 = *reinterpret_cast<const bf16x8*>(vsrc + (size_t)(_kr + 32 + sr) * vstride); \
    sr_[i].ks0 = *reinterpret_cast<const bf16x8*>(ksrc + (size_t)(_kr + sr) * kstride); sr_[i].ks1 = *reinterpret_cast<const bf16x8*>(ksrc + (size_t)(_kr + 32 + sr) * kstride); } while (0)
#define SWRITE(b, i) do { *(bf16x8*)(V_lds + (b) * SHM_V + vst0) = sr_[i].vs0;          \
    *(bf16x8*)(V_lds + (b) * SHM_V + vst1) = sr_[i].vs1; int kc = sc * 2;               \
    *(bf16x8*)(K_lds + (b) * SHM_K + KSWZ(sr, kc)) = sr_[i].ks0;                       \
    *(bf16x8*)(K_lds + (b) * SHM_K + KSWZ(32 + sr, kc)) = sr_[i].ks1; } while (0)
#define SWAIT() asm volatile("s_waitcnt vmcnt(4)" ::: "memory")
#define MASKT(P0, P1, J) do { if (MASK && (J) < nt0) { const int _d = (J) * KVBLK - dqw; \
    _Pragma("unroll") for (int r = 0; r < 16; ++r) { const int dd = _d + crow(r, hi); if (dd > 128 || dd < -128) P0[r] = -1e30f; if (dd + 32 > 128 || dd + 32 < -128) P1[r] = -1e30f; } } } while (0)
#define RESC(a) do { if (__any((a) < 1.f)) { if (hi == 0) al_l[r32] = (a); asm volatile("s_waitcnt lgkmcnt(0)" ::: "memory"); \
    _Pragma("unroll") for (int d = 0; d < 2; ++d) _Pragma("unroll") for (int r = 0; r < 16; ++r) o[d][r] *= al_l[crow(r, hi)]; } } while (0)
  f32x16 pA0, pA1, pB0, pB1; float mnA, mnB, alA, alB; bf16x8 pa0, pa1, pa2, pa3;
  constexpr int SE = 0, SO = 1;
  __syncthreads();
  SLOAD(SE, 0); asm volatile("s_waitcnt vmcnt(0)" ::: "memory"); SWRITE(0, SE); __syncthreads();
  qkt<NK16>(pA0, pA1, K_lds, qr, r32, hi); MASKT(pA0, pA1, 0); partialSM<SC1000000>(pA0, pA1, m_reg, mnA, alA);
  SLOAD(SO, 1); if (2 < NT) SLOAD(SE, 2);
  SWAIT();
  SWRITE(1, SO); __syncthreads();
  int bc = 1;
  for (int j = 1; j + 1 < NT; j += 2) {
    { const int bp = bc == 0 ? NBUF - 1 : bc - 1, bn = bc == NBUF - 1 ? 0 : bc + 1;
      SBAR(); qkt<NK16>(pB0, pB1, K_lds + bc * SHM_K, qr, r32, hi);
      finishSM(pA0, pA1, alA, l_reg, pa0, pa1, pa2, pa3); SBAR();
      SLOAD(SO, j + 2); SBAR();
      pv_d0(o, vb0 + bp * SHM_V, pa0, pa1, pa2, pa3); MASKT(pB0, pB1, j); partialSM<SC1000000>(pB0, pB1, m_reg, mnB, alB);
      SWAIT(); SWRITE(bn, SE);
      RESC(alB); __syncthreads();
      bc = bn; }
    { const int bp = bc == 0 ? NBUF - 1 : bc - 1, bn = bc == NBUF - 1 ? 0 : bc + 1;
      SBAR(); qkt<NK16>(pA0, pA1, K_lds + bc * SHM_K, qr, r32, hi);
      finishSM(pB0, pB1, alB, l_reg, pa0, pa1, pa2, pa3); SBAR();
      if (j + 3 < NT) SLOAD(SE, j + 3); SBAR();
      pv_d0(o, vb0 + bp * SHM_V, pa0, pa1, pa2, pa3); MASKT(pA0, pA1, j + 1); partialSM<SC1000000>(pA0, pA1, m_reg, mnA, alA);
      SWAIT(); SWRITE(bn, SO);
      RESC(alA); __syncthreads();
      bc = bn; }
  }
  { const int bp = bc == 0 ? NBUF - 1 : bc - 1;
    SBAR(); qkt<NK16>(pB0, pB1, K_lds + bc * SHM_K, qr, r32, hi);
    finishSM(pA0, pA1, alA, l_reg, pa0, pa1, pa2, pa3); SBAR();
    pv_d0(o, vb0 + bp * SHM_V, pa0, pa1, pa2, pa3); MASKT(pB0, pB1, NT - 1); partialSM<SC1000000>(pB0, pB1, m_reg, mnB, alB);
    RESC(alB);
    finishSM(pB0, pB1, alB, l_reg, pa0, pa1, pa2, pa3); SBAR();
    pv_d0(o, vb0 + bc * SHM_V, pa0, pa1, pa2, pa3); }
  asm volatile("s_waitcnt vmcnt(0)" ::: "memory");
  if (hi == 0) li_l[r32] = l_reg; asm volatile("s_waitcnt lgkmcnt(0)" ::: "memory");
  float rli[16];
#pragma unroll
  for (int r = 0; r < 16; ++r) rli[r] = __builtin_amdgcn_rcpf(li_l[crow(r, hi)]);
  bf* Ow = sd.out + (size_t)(wid * QBLK) * 2048;
#pragma unroll
  for (int r = 0; r < 16; ++r) { int orow = crow(r, hi);
#pragma unroll
    for (int d0 = 0; d0 < 2; ++d0) Ow[(size_t)orow * 2048 + d0 * 32 + r32] = f2b(o[d0][r] * rli[r]); }
#undef SLOAD
#undef SWRITE
#undef SWAIT
#undef MASKT
#undef RESC
#undef KROW
}
#undef KSWZ
#undef SBAR
}

DEV void ph_mla(const Params& p, const Ctx& cx, int last) {
  const int nlat_units = NB * 8 * (N / 256);
  const int nctx_units = last ? 0 : NB * 8 * (LC / 256);
  const int sc = (cx.tid & 15) * 8;
  for (int uu = blockIdx.x; uu < nlat_units + 256; uu += gridDim.x) {
    const int u = uu < nlat_units ? uu : nlat_units + ((uu - nlat_units + 256 - 32) & 255);
    if (u >= nlat_units + nctx_units) continue;
    int qrow0, hh, kb0, nt0, kb1, NT;
    if (u < nlat_units) {
      const int rnd = u / 256, within = u % 256, bh = (rnd * 8 + (within & 7)) % (NB * 8); int qb = within >> 3;
      hh = bh % 8; int b = bh / 8; qrow0 = b * N + qb * 256; kb0 = b * N; nt0 = N / 64; kb1 = NLAT + b * LC; NT = (N + LC) / 64; }
    else { int v = u - nlat_units; int qb = v % (LC / 256); hh = (v / (LC / 256)) % 8; int b = v / (8 * (LC / 256)); qrow0 = NLAT + b * LC + qb * 256; kb0 = NLAT + b * LC; nt0 = LC / 64; kb1 = 0; NT = LC / 64; }
    fa::Src sd;
    sd.q = p.QA() + (size_t)qrow0 * 768 + hh * 96; sd.qstride = 768;
    if (sc < 64) { sd.ksrc = p.KVA() + hh * 128 + sc; sd.kstride = 1024; } else { sd.ksrc = p.P() + C_KR + ((sc - 64) & 31); sd.kstride = PC; }
    sd.vsrc = p.KVA() + hh * 128 + 64 + (sc & 63); sd.vstride = 1024;
    sd.out = p.Y() + (size_t)qrow0 * 2048 + hh * 64; sd.m0 = -1e30f; sd.l0 = 0.f; sd.dq0 = 0;
    fa::unit<6, 102062073, false>(sd, cx.tid, cx.ldsg, kb0, nt0, kb1, NT);
  }
}
DEV void ph_gqa(const Params& p, const Ctx& cx, int l, int last) {
  const int nlat_units = NB * 8 * (N / 256);
  const int nctx_units = last ? 0 : NB * 8 * (LC / 256);
  const int sc = (cx.tid & 15) * 8;
  for (int uu = blockIdx.x; uu < nlat_units + 256; uu += gridDim.x) {
    const int u = uu < nlat_units ? uu : nlat_units + ((uu - nlat_units + 256 - 16) & 255);
    if (u >= nlat_units + nctx_units) continue;
    int qrow0, hh, kb0, nt0, kb1, NT, dq0 = 0;
    if (u < nlat_units) {
      const int rnd = u / 256, within = u % 256, bh = (rnd * 8 + (within & 7)) % (NB * 8); int qb = within >> 3;
      hh = bh % 8; int b = bh / 8;
      int q0 = qb * 256; int klo = q0 - 128 < 0 ? 0 : q0 - 128; int khi = q0 + 384 > N ? N : q0 + 384;
      qrow0 = b * N + q0; kb0 = b * N + klo; nt0 = (khi - klo) / 64; kb1 = NLAT + b * LC; NT = nt0 + LC / 64; dq0 = q0 - klo;
    } else { int v = u - nlat_units; int qb = v % (LC / 256); hh = (v / (LC / 256)) % 8; int b = v / (8 * (LC / 256)); qrow0 = NLAT + b * LC + qb * 256; kb0 = NLAT + b * LC; nt0 = 0; kb1 = kb0; NT = LC / 64; }
    const int kh = hh >> 2;
    fa::Src sd;
    sd.q = p.P() + (size_t)qrow0 * PC + C_GQ + hh * 64; sd.qstride = PC;
    sd.ksrc = p.P() + C_GKV + kh * 64 + (sc & 63); sd.kstride = PC;
    sd.vsrc = p.P() + C_GKV + 128 + kh * 64 + (sc & 63); sd.vstride = PC;
    sd.out = p.Y() + (size_t)qrow0 * 2048 + 1536 + hh * 64;
    sd.m0 = p.in[I_gqa_sink][l * 8 + hh] * 8.0f; sd.l0 = 1.0f; sd.dq0 = dq0;
    fa::unit<4, 125000000, true>(sd, cx.tid, cx.ldsg, kb0, nt0, kb1, NT);
  }
}
#endif


namespace hy {
constexpr int NF = 2 * N;
struct f2 { float x, y; };
DEV f2 cmul(f2 a, f2 b) { f2 r; r.x = a.x * b.x - a.y * b.y; r.y = a.x * b.y + a.y * b.x; return r; }
#ifndef CPU_SIM
DEV f2 twid(const f2*, int k) { const float x = (float)k * (1.0f / (float)NF); return f2{__builtin_amdgcn_cosf(x), -__builtin_amdgcn_sinf(x)}; }
#else
DEV f2 twid(const f2* tw, int k) { return tw[k]; }
#endif
DEV f2 cmulc(f2 a, f2 b) { f2 r; r.x = a.x * b.x + a.y * b.y; r.y = a.y * b.x - a.x * b.y; return r; }
DEV void fwd_pass(f2* buf, const f2* tw, int L, int tid, int nthr) {
  const int Q = L >> 2, tws = NF / L;
  for (int u = tid; u < NF / 4; u += nthr) {
    const int g = u / Q, j = u - g * Q, base = g * L + j;
    const f2 x0 = buf[base], x1 = buf[base + Q], x2 = buf[base + 2 * Q], x3 = buf[base + 3 * Q];
    f2 a0{x0.x + x2.x, x0.y + x2.y}, a1{x0.x - x2.x, x0.y - x2.y}, a2{x1.x + x3.x, x1.y + x3.y};
    f2 d{x1.x - x3.x, x1.y - x3.y}; f2 a3{d.y, -d.x};
    f2 y0{a0.x + a2.x, a0.y + a2.y}, y1{a1.x + a3.x, a1.y + a3.y}, y2{a0.x - a2.x, a0.y - a2.y}, y3{a1.x - a3.x, a1.y - a3.y};
    buf[base] = y0; buf[base + Q] = cmul(y1, twid(tw, j * tws)); buf[base + 2 * Q] = cmul(y2, twid(tw, 2 * j * tws)); buf[base + 3 * Q] = cmul(y3, twid(tw, 3 * j * tws));
  }
}
DEV void inv_pass(f2* buf, const f2* tw, int L, int tid, int nthr) {
  const int Q = L >> 2, tws = NF / L;
  for (int u = tid; u < NF / 4; u += nthr) {
    const int g = u / Q, j = u - g * Q, base = g * L + j;
    const f2 u0 = buf[base], u1 = cmulc(buf[base + Q], twid(tw, j * tws)), u2 = cmulc(buf[base + 2 * Q], twid(tw, 2 * j * tws)), u3 = cmulc(buf[base + 3 * Q], twid(tw, 3 * j * tws));
    f2 a0{u0.x + u2.x, u0.y + u2.y}, a1{u0.x - u2.x, u0.y - u2.y}, a2{u1.x + u3.x, u1.y + u3.y};
    f2 d{u1.x - u3.x, u1.y - u3.y}; f2 a3{-d.y, d.x};
    buf[base] = f2{a0.x + a2.x, a0.y + a2.y}; buf[base + Q] = f2{a1.x + a3.x, a1.y + a3.y};
    buf[base + 2 * Q] = f2{a0.x - a2.x, a0.y - a2.y}; buf[base + 3 * Q] = f2{a1.x - a3.x, a1.y - a3.y};
  }
}
DEV void s1_taps(const Params& p, f2* buf, float* red, int c, int tid, int nthr) {
  float ss = 0.f;
#pragma unroll 8
  for (int k = tid; k < NF; k += nthr) {
    float v = 0.f;
    if (k < N) v = p.F()[(size_t)k * 1024 + c];
    else if (k > N) v = p.F()[(size_t)(NF - k) * 1024 + 512 + c];
    buf[k] = f2{v, 0.f}; ss += v * v;
  }
  red[tid] = ss;
}
DEV float red_total(const float* red, int nthr) { float s = 0.f; for (int i = 0; i < nthr; ++i) s += red[i]; return s; }
DEV void s3_store(const f2* buf, unsigned* hs, int tid, int nthr) {
  for (int k = tid; k < NF; k += nthr) hs[k] = (unsigned)f2b(buf[k].x).v | ((unsigned)f2b(buf[k].y).v << 16);
}
DEV void s4_loadz(const Params& p, f2* buf, int c, int tid, int nthr) {
#pragma unroll 8
  for (int t = tid; t < NF; t += nthr) {
    f2 v{0.f, 0.f};
    if (t < N) { v.x = b2f(p.Z()[(size_t)t * 512 + c]); v.y = b2f(p.Z()[(size_t)(N + t) * 512 + c]); }
    buf[t] = v;
  }
}
DEV void s6_mul(f2* buf, const unsigned* hs, int tid, int nthr) {
  for (int k = tid; k < NF; k += nthr) {
    union { unsigned u; float f; } a, b; const unsigned w = hs[k]; a.u = w << 16; b.u = w & 0xFFFF0000u;
    buf[k] = cmul(buf[k], f2{a.f, b.f});
  }
}
DEV void s8_out(const Params& p, const f2* buf, const float* red, int l, int c, int tid, int nthr) {
  const float fn = 1.0f / sqrtf(red_total(red, nthr) + EPS) * (1.0f / (float)NF);
  const float* cw = p.in[I_hy_conv_w] + l * 3 * 1536; const float cb = p.in[I_hy_conv_b][l * 1536 + c];
  const float w0 = cw[c], w1 = cw[1536 + c], w2 = cw[2 * 1536 + c];
  const float skip = p.in[I_hy_skip][l * 512 + c];
#pragma unroll 4
  for (int i = tid; i < 2 * N; i += nthr) {
    const int b = i / N, t = i - b * N;
    const size_t r = (size_t)b * N + t;
    const float conv = (b ? buf[t].y : buf[t].x) * fn;
    float x0 = cb + w1 * b2f(p.P()[r * PC + C_HU + c]);
    if (t > 0) x0 += w0 * b2f(p.P()[(r - 1) * PC + C_HU + c]);
    if (t < N - 1) x0 += w2 * b2f(p.P()[(r + 1) * PC + C_HU + c]);
    const float y = conv + skip * b2f(p.Z()[r * 512 + c]);
    p.Y()[r * 2048 + 1024 + c] = f2b(x0 * y);
  }
}
#ifndef CPU_SIM
DEV void channel(const Params& p, int l, int c, int tid, f2* buf, float* red, unsigned* hs) {
  const f2* tw = (const f2*)p.tw();
#ifndef HY_EXP
#define HY_EXP 0
#endif
  __syncthreads();
  if (HY_EXP != 2) s1_taps(p, buf, red, c, tid, 512); __syncthreads();
  if (HY_EXP != 1) for (int L = NF; L >= 4; L >>= 2) { fwd_pass(buf, tw, L, tid, 512); __syncthreads(); }
  s3_store(buf, hs, tid, 512); __syncthreads();
  if (HY_EXP != 2) s4_loadz(p, buf, c, tid, 512); __syncthreads();
  if (HY_EXP != 1) for (int L = NF; L >= 4; L >>= 2) { fwd_pass(buf, tw, L, tid, 512); __syncthreads(); }
  s6_mul(buf, hs, tid, 512); __syncthreads();
  if (HY_EXP != 1) for (int L = 4; L <= NF; L <<= 2) { inv_pass(buf, tw, L, tid, 512); __syncthreads(); }
  if (HY_EXP != 2) s8_out(p, buf, red, l, c, tid, 512);
}
#endif
}


namespace tz {
constexpr int NBLK = N / 64;
constexpr int PADB = 31;
constexpr int ZLEN = (NBLK + 2 * PADB) * 64;
constexpr int HLEN = 2 * N + 16;
DEV int a_index(int m, int r, int h) { return N - m - r + 8 * h; }
DEV int b_index(int t1, int Dd, int ks, int h) { return 64 * (t1 - Dd + PADB) + 16 * ks + 8 * h; }
#ifndef CPU_SIM
using bf16x8 = __attribute__((ext_vector_type(8))) short;
using f32x16 = __attribute__((ext_vector_type(16))) float;
using u32x4 = __attribute__((ext_vector_type(4))) unsigned;
DEV bf16x8 load_afrag(const unsigned short* Hr, int e) {
  const unsigned* wp = (const unsigned*)(Hr + (e & ~1));
  const unsigned w0 = wp[0], w1 = wp[1], w2 = wp[2], w3 = wp[3], w4 = wp[4];
  const unsigned sh = (unsigned)(e & 1) << 4;
  u32x4 o;
  o.x = __builtin_amdgcn_alignbit(w1, w0, sh); o.y = __builtin_amdgcn_alignbit(w2, w1, sh); o.z = __builtin_amdgcn_alignbit(w3, w2, sh); o.w = __builtin_amdgcn_alignbit(w4, w3, sh);
  return *reinterpret_cast<bf16x8*>(&o);
}
DEV void channel(const Params& p, int l, int c, int tid, char* lds) {
  unsigned short* zp = (unsigned short*)lds;
  float* red = (float*)(zp + 2 * ZLEN);
  unsigned short* Hr = (unsigned short*)(red + 512);
  float* cv = (float*)Hr;
  const int lane = tid & 63, w = tid >> 6, r = lane & 31, h = lane >> 5;
  __syncthreads();
  float ss = 0.f;
  const float* ff = p.F() + (size_t)c * (N + LC); const float* fb = p.F() + (size_t)(512 + c) * (N + LC);
#pragma unroll 4
  for (int t = tid * 4; t < N; t += 2048) {
    const float4 a = *(const float4*)(ff + t), b = *(const float4*)(fb + t);
    ss += a.x * a.x + a.y * a.y + a.z * a.z + a.w * a.w + b.x * b.x + b.y * b.y + b.z * b.z + b.w * b.w;
    Hr[N - t] = f2b(a.x).v; Hr[N - t - 1] = f2b(a.y).v; Hr[N - t - 2] = f2b(a.z).v; Hr[N - t - 3] = f2b(a.w).v;
    if (t > 0) Hr[N + t] = f2b(b.x).v;
    Hr[N + t + 1] = f2b(b.y).v; Hr[N + t + 2] = f2b(b.z).v; Hr[N + t + 3] = f2b(b.w).v;
  }
  if (tid == 0) Hr[0] = 0;
  if (tid < 16) Hr[2 * N + tid] = 0;
  red[tid] = ss;
  for (int i = tid; i < 2 * PADB * 64; i += 512) {
    const int side = i / (PADB * 64), k = i % (PADB * 64);
    const int off = side ? (PADB + NBLK) * 64 + k : k;
    zp[off] = 0; zp[ZLEN + off] = 0;
  }
  { const unsigned short* zt = (const unsigned short*)p.Z() + (size_t)c * NB * N;
#pragma unroll 4
    for (int i = tid * 8; i < 2 * N; i += 4096) { const int b = i / N, t = i - b * N; *(uint4*)(zp + b * ZLEN + PADB * 64 + t) = *(const uint4*)(zt + i); } }
  __syncthreads();
  float tot = 0.f;
  for (int i = 0; i < 512; ++i) tot += red[i];
  const float fn = 1.0f / sqrtf(tot + EPS);
  const int t1 = 32 * (w & 3) + r;
  const unsigned short* zb = zp + (w >> 2) * ZLEN;
  f32x16 acc0 = {}, acc1 = {};
  const int Dlo = 32 * (w & 3) - (NBLK - 1), Dhi = 32 * (w & 3) + 31;
#define TZ_LOAD(AF, BF, PA, PB) do { _Pragma("unroll") for (int ks = 0; ks < 4; ++ks) BF[ks] = *reinterpret_cast<const bf16x8*>((PB) + 16 * ks); \
    _Pragma("unroll") for (int q = 0; q < 6; ++q) { const unsigned* wq_ = (PA) + 8 * (5 - q); const unsigned w0_ = wq_[0], w1_ = wq_[1], w2_ = wq_[2], w3_ = wq_[3], w4_ = wq_[4]; u32x4 o_; \
      o_.x = __builtin_amdgcn_alignbit(w1_, w0_, shA); o_.y = __builtin_amdgcn_alignbit(w2_, w1_, shA); o_.z = __builtin_amdgcn_alignbit(w3_, w2_, shA); o_.w = __builtin_amdgcn_alignbit(w4_, w3_, shA); \
      AF[q] = *reinterpret_cast<bf16x8*>(&o_); } } while (0)
#define TZ_MMA(AF, BF) do { _Pragma("unroll") for (int ks = 0; ks < 4; ++ks) { \
    acc0 = __builtin_amdgcn_mfma_f32_32x32x16_bf16(AF[3 - ks], BF[ks], acc0, 0, 0, 0); acc1 = __builtin_amdgcn_mfma_f32_32x32x16_bf16(AF[5 - ks], BF[ks], acc1, 0, 0, 0); } } while (0)
  const unsigned shA = (unsigned)(r & 1) << 4;
  const unsigned* pa = (const unsigned*)Hr + ((a_index(64 * Dlo - 48 + 80, r, h) & ~1) >> 1);
  const unsigned short* pb = zb + b_index(t1, Dlo, 0, h);
#define TZ_LOAD4(AF, BF, PREV, PA, PB) do { _Pragma("unroll") for (int ks = 0; ks < 4; ++ks) BF[ks] = *reinterpret_cast<const bf16x8*>((PB) + 16 * ks); \
    AF[0] = PREV[4]; AF[1] = PREV[5]; \
    _Pragma("unroll") for (int q = 2; q < 6; ++q) { const unsigned* wq_ = (PA) + 8 * (5 - q); const unsigned w0_ = wq_[0], w1_ = wq_[1], w2_ = wq_[2], w3_ = wq_[3], w4_ = wq_[4]; u32x4 o_; \
      o_.x = __builtin_amdgcn_alignbit(w1_, w0_, shA); o_.y = __builtin_amdgcn_alignbit(w2_, w1_, shA); o_.z = __builtin_amdgcn_alignbit(w3_, w2_, shA); o_.w = __builtin_amdgcn_alignbit(w4_, w3_, shA); \
      AF[q] = *reinterpret_cast<bf16x8*>(&o_); } } while (0)
  bf16x8 afA[6], bfA[4], afB[6], bfB[4];
  TZ_LOAD(afA, bfA, pa, pb);
#pragma unroll 1
  for (int Dd = Dlo; Dd + 2 <= Dhi; Dd += 2) {
    TZ_LOAD4(afB, bfB, afA, pa - 32, pb - 64);
    TZ_MMA(afA, bfA);
    pa -= 64; pb -= 128;
    TZ_LOAD4(afA, bfA, afB, pa, pb);
    TZ_MMA(afB, bfB);
  }
  TZ_MMA(afA, bfA);
#undef TZ_LOAD4
#undef TZ_LOAD
#undef TZ_MMA
  static_assert((NBLK + 31) % 2 == 1, "K-loop pairing assumes an odd number of steps");
  __syncthreads();
  { int t1e = t1, he = h;
    asm volatile("" : "+v"(t1e), "+v"(he));
    float* cvb = cv + (w >> 2) * N + 64 * t1e + 4 * he;
#pragma unroll
    for (int g = 0; g < 4; ++g) {
      *(float4*)(cvb + 8 * g) = float4{acc0[4 * g], acc0[4 * g + 1], acc0[4 * g + 2], acc0[4 * g + 3]};
      *(float4*)(cvb + 32 + 8 * g) = float4{acc1[4 * g], acc1[4 * g + 1], acc1[4 * g + 2], acc1[4 * g + 3]};
    } }
  __syncthreads();
  { const float skip = p.in[I_hy_skip][l * 512 + c];
    unsigned short* xy = (unsigned short*)p.XYT() + (size_t)c * NB * N;
#pragma unroll 4
    for (int i = tid * 8; i < 2 * N; i += 4096) {
      const int b = i / N, t = i - b * N;
      float x0[8]; unpack8(*(const uint4*)(xy + i), x0);
      float zf[8]; unpack8(*(const uint4*)(zp + b * ZLEN + PADB * 64 + t), zf);
      const float4 ca = *(const float4*)(cv + i), cb4 = *(const float4*)(cv + i + 4);
      float o[8];
      o[0] = x0[0] * (ca.x * fn + skip * zf[0]); o[1] = x0[1] * (ca.y * fn + skip * zf[1]); o[2] = x0[2] * (ca.z * fn + skip * zf[2]); o[3] = x0[3] * (ca.w * fn + skip * zf[3]);
      o[4] = x0[4] * (cb4.x * fn + skip * zf[4]); o[5] = x0[5] * (cb4.y * fn + skip * zf[5]); o[6] = x0[6] * (cb4.z * fn + skip * zf[6]); o[7] = x0[7] * (cb4.w * fn + skip * zf[7]);
      store8bf(p.YT() + (size_t)c * NB * N + i, o);
    } }
}
DEV void xyt_to_y(const Params& p, int tid, char* lds) {
  unsigned short* tl = (unsigned short*)lds;
  for (int tile = blockIdx.x; tile < (NLAT / 64) * 8; tile += gridDim.x) {
    const int rt = tile >> 3, c0 = (tile & 7) * 64;
    const int bq = (rt * 64) / N, tq = (rt * 64) % N;
    __syncthreads();
    { const int cc = tid >> 3, tg = (tid & 7) * 8;
      const uint4 v = *(const uint4*)((const unsigned short*)p.YT() + ((size_t)(c0 + cc) * NB + bq) * N + tq + tg);
      const unsigned short* e = (const unsigned short*)&v;
#pragma unroll
      for (int j = 0; j < 8; ++j) tl[(tg + j) * 72 + cc] = e[j]; }
    __syncthreads();
    { const int tr = tid >> 3, cg8 = (tid & 7) * 8;
      *(uint4*)((unsigned short*)p.Y() + (size_t)(rt * 64 + tr) * 2048 + 1024 + c0 + cg8) = *(const uint4*)(tl + tr * 72 + cg8); }
  }
}
#endif
}

#ifndef CPU_SIM
DEV void ph_hyena_fft(const Params& p, const Ctx& cx, int l) {
  const int nb = gridDim.x;
  for (int i = blockIdx.x; i < 512; i += nb) {
    const int xcd = i & 7, idx = i >> 3;
    const int c = xcd * 64 + idx;
    tz::channel(p, l, c, cx.tid, cx.ldsg);
  }
}
#endif


#ifndef CPU_SIM
DEV void ph_hyena_ctx(const Params& p, const Ctx& cx, int l) {
  constexpr int LP = 33;
  float* Zs = (float*)cx.ldsg; float* Ff = Zs + LC * LP; float* Fb = Ff + LC * LP;
  const int tid = cx.tid, c = tid & 31, t0 = tid >> 5;
  const float* cw = p.in[I_hy_conv_w] + l * 3 * 1536; const float* cbv = p.in[I_hy_conv_b] + l * 1536;
  constexpr int TP = 8, TLEN = LC / TP;
  for (int task = blockIdx.x; task < NB * 16 * TP; task += gridDim.x) {
    const int tp = task % TP, cgp = (task / TP) & 15, b = task / (TP * 16), c0 = cgp * 32;
    const int rbase = NLAT + b * LC;
    __syncthreads();
    for (int idx = tid; idx < LC * 32; idx += 512) {
      { const int t = idx >> 5, cc = idx & 31; Zs[t * LP + cc] = b2f(p.Z()[(size_t)(rbase + t) * 512 + c0 + cc]); }
      { const int cc = idx / LC, t = idx % LC;
        Ff[t * LP + cc] = p.F()[(size_t)(c0 + cc) * (N + LC) + N + t]; Fb[t * LP + cc] = p.F()[(size_t)(512 + c0 + cc) * (N + LC) + N + t]; }
    }
    __syncthreads();
    float ss = 0.f;
    for (int t = 0; t < LC; ++t) { const float a = Ff[t * LP + c], bb = Fb[t * LP + c]; ss += a * a + bb * bb; }
    const float fn = 1.0f / sqrtf(ss + EPS);
    const int cg_ = c0 + c;
    const float w0 = cw[cg_], w1 = cw[1536 + cg_], w2 = cw[2 * 1536 + cg_], cb0 = cbv[cg_], skip = p.in[I_hy_skip][l * 512 + cg_];
    for (int t = tp * TLEN + t0; t < (tp + 1) * TLEN; t += 16) {
      float acc = 0.f;
      for (int s_ = 0; s_ <= t; ++s_) acc += Ff[(t - s_) * LP + c] * Zs[s_ * LP + c];
      for (int s_ = t + 1; s_ < LC; ++s_) acc += Fb[(s_ - t) * LP + c] * Zs[s_ * LP + c];
      const size_t r = (size_t)(rbase + t);
      float x0 = cb0 + w1 * b2f(p.P()[r * PC + C_HU + cg_]);
      if (t > 0) x0 += w0 * b2f(p.P()[(r - 1) * PC + C_HU + cg_]);
      if (t < LC - 1) x0 += w2 * b2f(p.P()[(r + 1) * PC + C_HU + cg_]);
      p.Y()[r * 2048 + 1024 + cg_] = f2b(x0 * (acc * fn + skip * Zs[t * LP + c]));
    }
  }
}
#endif

constexpr int NOSH = 30;

#ifndef CPU_SIM
#define SIDE_PREP(NB0, PARTS) do { if (l == 0 && (int)blockIdx.x >= (NB0)) { PrepCtx pc; pc.tid = cx.tid; pc.tl = (float*)cx.ldsg; pc.rank = (int)blockIdx.x - (NB0); pc.nranks = (int)gridDim.x - (NB0); \
    ph_prep(p, 1, pc, gtid - (NB0) * 512, gsz - (NB0) * 512, (PARTS)); } } while (0)
#else
#define SIDE_PREP(NB0, PARTS)
#endif
DEV void run_phase(const Params& p, int ph, const Ctx& cx) {
  const i64 gtid = cx.gtid, gsz = cx.gsz;
  if (ph == 0) { ph_init(p, gtid, gsz); return; }
  if (ph == NPHASES - 1) { ph_final(p, gtid, gsz); return; }
  const int l = (ph - 1) / PH_PER_LAYER, s = (ph - 1) % PH_PER_LAYER;
  const int last = (l == 1);
  const int nr = last ? NLAT : TT;
#ifdef ONLY
  if (s != ONLY) return;
#endif
  switch (s) {
    case 0: {
      PrepCtx pc;
#ifndef CPU_SIM
      pc.tid = cx.tid; pc.tl = (float*)cx.ldsg; pc.rank = (int)blockIdx.x; pc.nranks = (int)gridDim.x;
      if (l == 0) ph_prep(p, l, pc, gtid, gsz, 15); else ph_prep(p, l, pc, gtid, gsz, 8);
#else
      pc.gtid = gtid; pc.gsz = gsz;
      ph_prep(p, l, pc, gtid, gsz, 15);
#endif
      ph_norm(p, l, 0, TT, gtid, gsz);
    } break;
    case 1: { GemmDesc g{p.h(), p.W_in(), D, D, D, TT, 3840, NOSH, 0}; EpiInproj e{p}; run_gemm(cx, g, e); } break;
#ifndef CPU_SIM
    case 2: ph_B0(p, l, gtid, gsz, cx.ldsg, cx.tid); break;
#else
    case 2: ph_B0(p, l, gtid, gsz); break;
#endif
    case 3: {
      { const int n_uq = (nr / 256) * 3, n_ukv = (TT / 256) * 4, n_lru = (TT / 256) * 8;
        { GemmDesc g{p.P() + C_CQ, p.W_uq(), PC, 256, 256, nr, 768, NOSH, 0}; EpiUq e{p}; run_gemm(cx, g, e); }
        { GemmDesc g{p.P() + C_CKV, p.W_ukv(), PC, 256, 256, TT, 1024, NOSH, 0}; g.unit_off = n_uq; EpiUkv e{p}; run_gemm(cx, g, e); }
        { GemmDesc g{p.XC(), p.W_lru(), 512, 256, 256, TT, 2048, 2, 256}; g.unit_off = n_uq + n_ukv; EpiLru e{p, l, p.in[I_lru_b_r], p.in[I_lru_b_i]}; run_gemm(cx, g, e); }
#ifndef CPU_SIM
        { GemmDesc g{p.W3T(), p.hdn2b() + (size_t)l * (N + LC) * 256, 256, 256, 256, 1024, N + LC, NOSH, 0}; g.unit_off = n_uq + n_ukv + n_lru; EpiFilt e{p}; run_gemm(cx, g, e); }
#endif
      }
#ifdef CPU_SIM
      ph_fnorm(p, gtid, gsz);
#endif
    } break;
    case 4:
      ph_lru1(p, gtid, gsz);
#ifndef CPU_SIM
#if PROBE_K >= 0
#define SUBSTAMP(k) do { cg::this_grid().sync(); if (l == 0) { const unsigned long long t_ = wall_clock64(); if (blockIdx.x == 0 && cx.tid == 0) ((unsigned long long*)(p.ws + WL.ts))[40 + (k)] = t_; } } while (0)
#else
#define SUBSTAMP(k)
#endif
      if (REPEAT_S == 40) ph_lru1(p, gtid, gsz);
      SUBSTAMP(0);
      ph_hyena_fft(p, cx, l);
      if (REPEAT_S == 41) ph_hyena_fft(p, cx, l);
      SUBSTAMP(1);
      ph_gqa(p, cx, l, last);
      if (REPEAT_S == 42) ph_gqa(p, cx, l, last);
      SUBSTAMP(2);
      ph_mla(p, cx, last);
      if (REPEAT_S == 43) ph_mla(p, cx, last);
      SUBSTAMP(3);
      if (!last) ph_hyena_ctx(p, cx, l);
      if (REPEAT_S == 44 && !last) ph_hyena_ctx(p, cx, l);
#else
      ph_C(p, l, last, gtid, gsz);
#endif
      break;
#ifndef CPU_SIM
    case 5: ph_lru3(p, last, gtid, gsz, (float*)cx.ldsg, cx.tid); __syncthreads(); tz::xyt_to_y(p, cx.tid, cx.ldsg); break;
#else
    case 5: ph_lru3(p, last, gtid, gsz, nullptr, 0); break;
#endif
    case 6: { GemmDesc g{p.h(), p.W_g(), D, D, D, nr, 4096, NOSH, 0}; EpiGateAll e{p}; run_gemm(cx, g, e); } break;
    case 7: { GemmDesc g{p.Y(), p.W_br(), 2048, 512, 512, nr, 1024, NOSH, 0, 4, 512, 1024 * 512}; EpiBranchSub e{p}; run_gemm(cx, g, e); }
      SIDE_PREP(8, 1);
      break;
    case 8: { GemmDesc g{p.M(), p.W_out(), D, D, D, nr, 1024, NOSH, 0}; EpiOut e{p, l, 1.0f, l == 0 ? p.in[I_x] : (const float*)p.xcur(), l == 0 ? p.in[I_ctx] : (const float*)p.xcur() + (size_t)NLAT * D}; run_gemm(cx, g, e); }
#ifndef CPU_SIM
      if (l == 0 && blockIdx.x >= 8) ph_cvt_tables(p, l, gtid - 8 * 512, gsz - 8 * 512);
#endif
      break;
    case 9:
#ifndef CPU_SIM
      if (l != 0) ph_cvt_tables(p, l, gtid, gsz);
#endif
      ph_norm(p, l, 1, nr, gtid, gsz); break;
    case 10: { GemmDesc g{p.h(), p.W_q(), D, D, D, nr, 1024, NOSH, 0}; EpiPQ e{p}; run_gemm(cx, g, e); }
      SIDE_PREP(8, 2);
      break;
    case 11: { GemmDesc g{p.PQ(), p.W_key(), 1024, 256, 256, nr, 2048, 1, 256}; EpiSC e{p}; run_gemm(cx, g, e); }
      SIDE_PREP(16, 4);
      break;
#ifndef CPU_SIM
    case 12: ph_peer(p, l, nr, cx.tid, cx.ldsg); if (REPEAT_S == 52) { __syncthreads(); ph_peer(p, l, nr, cx.tid, cx.ldsg, 0.0f); } break;
#else
    case 12: ph_E2a(p, nr, gtid, gsz); break;
    case 13: ph_E2b(p, nr, gtid, gsz); break;
    case 14: ph_E3(p, l, nr, gtid, gsz); break;
    case 15: ph_E4(p, l, nr, gtid, gsz); break;
#endif
  }
}

#ifdef CPU_SIM
static void fill_params(Params& p, void* const* d_in, void* d_out, void* d_ws) {
  p.in.t = (const float* const*)d_in;
  p.out = (float*)d_out;
  p.ws = (char*)d_ws;
}
#endif


#ifndef CPU_SIM
#define XB_TMO      128
#define XB_XCNT(j)  (256  + 64 * (j))
#define XB_XSUB(j)  (1280 + 64 * (j))
#define XB_XGEN(j)  (2304 + 64 * (j))
#define XB_TOP      3328
#define XB_TOPGEN   3392
#define XCD_BAR_WORDS 3456
#define XB_SPIN_CAP (1u << 18)
#define XB_LAS __attribute__((address_space(3)))
__device__ __forceinline__ unsigned xb_ld(unsigned* p)              { return __hip_atomic_load(p, __ATOMIC_RELAXED, __HIP_MEMORY_SCOPE_AGENT); }
__device__ __forceinline__ unsigned xb_add(unsigned* p, unsigned v) { return __hip_atomic_fetch_add(p, v, __ATOMIC_RELAXED, __HIP_MEMORY_SCOPE_AGENT); }
__device__ __forceinline__ unsigned xb_xcc_id() { return (unsigned)__builtin_amdgcn_s_getreg((3 << 11) | 20) & 0xFu; }
#define XB_SPIN(cond, bar) do { unsigned _sp = 0; while (cond) { __builtin_amdgcn_s_sleep(1); \
    if ((++_sp & 255u) == 0u) { if (xb_ld(&(bar)[XB_TMO])) break; if (_sp > XB_SPIN_CAP) { atomicAdd(&(bar)[XB_TMO], 1u); break; } } } } while (0)
struct XcdBarrier { unsigned* bar; unsigned x; volatile XB_LAS unsigned* st; };
__device__ __forceinline__ XcdBarrier xcd_barrier_post(unsigned* bar, volatile XB_LAS unsigned* st) {
  XcdBarrier b; b.bar = bar; b.x = xb_xcc_id(); b.st = st;
  if (threadIdx.x == 0) (void)xb_add(&bar[XB_XCNT(b.x)], 1u);
  return b;
}
__device__ __forceinline__ void xcd_barrier_complete(unsigned* bar, unsigned x, unsigned& nloc, unsigned& nx) {
  const unsigned G = gridDim.x * gridDim.y * gridDim.z;
  unsigned sum, cnt, mine, sp = 0u;
  for (;;) {
    sum = 0u; cnt = 0u; mine = 0u;
#pragma unroll
    for (unsigned j = 0; j < 16; ++j) { const unsigned c = xb_ld(&bar[XB_XCNT(j)]); sum += c; cnt += (c > 0u) ? 1u : 0u; mine = (j == x) ? c : mine; }
    if (sum == G) break;
    __builtin_amdgcn_s_sleep(1);
    if ((++sp & 255u) == 0u) { if (xb_ld(&bar[XB_TMO])) break; if (sp > XB_SPIN_CAP) { atomicAdd(&bar[XB_TMO], 1u); break; } }
  }
  nloc = mine > 0u ? mine : 1u; nx = cnt > 0u ? cnt : 1u;
}
__device__ __forceinline__ void xcd_barrier(const XcdBarrier& b) {
  asm volatile("s_waitcnt vmcnt(0)" ::: "memory");
  __syncthreads();
  if (threadIdx.x == 0) {
    unsigned* bar = b.bar;
    __builtin_amdgcn_s_waitcnt(0);
    unsigned nloc = b.st[0], nx = b.st[1];
    if (nloc == 0u) { xcd_barrier_complete(bar, b.x, nloc, nx); b.st[0] = nloc; b.st[1] = nx; }
    const unsigned old = xb_add(&bar[XB_XSUB(b.x)], 1u);
    const unsigned gen = old / nloc;
    if (old + 1u == (gen + 1u) * nloc) {
      __builtin_amdgcn_fence(__ATOMIC_RELEASE, "agent");
      asm volatile("s_waitcnt vmcnt(0)" ::: "memory");
      const unsigned og = xb_add(&bar[XB_TOP], 1u);
      const unsigned tg = og / nx;
      if (og + 1u == (tg + 1u) * nx) xb_add(&bar[XB_TOPGEN], 1u);
      else XB_SPIN(xb_ld(&bar[XB_TOPGEN]) == tg, bar);
      __builtin_amdgcn_fence(__ATOMIC_ACQUIRE, "agent");
      xb_add(&bar[XB_XGEN(b.x)], 1u);
      asm volatile("s_waitcnt vmcnt(0)" ::: "memory");
    } else {
      XB_SPIN(xb_ld(&bar[XB_XGEN(b.x)]) == gen, bar);
      __builtin_amdgcn_fence(__ATOMIC_ACQUIRE, "agent");
      asm volatile("s_waitcnt vmcnt(0)" ::: "memory");
    }
  }
  __syncthreads();
}
#endif

#ifndef CPU_SIM
static_assert(TT % 256 == 0 && NLAT % 256 == 0 && (N + LC) % 256 == 0, "row / column tiles");
static_assert(N / 256 == 32 && NB * 8 * (N / 256) == 512, "attention unit mapping assumes 32 q-blocks per (batch, head) and a 256-block grid");
constexpr int LDS_PHASE_BYTES = 131072 + 4096;
constexpr int LDS_BYTES = LDS_PHASE_BYTES + 16;
__global__ void __launch_bounds__(512, 2) mega_kernel(KArgs ka) {
  extern __shared__ __attribute__((aligned(16))) unsigned char shm[];
  cg::grid_group grid = cg::this_grid();
#if PROBE_K >= 0
  unsigned long long* const tsp = (unsigned long long*)(ka.ws + WL.ts);
#endif
  {
    int tid = threadIdx.x;
    asm volatile("" : "+v"(tid));
    const i64 gtid = (i64)blockIdx.x * 512 + tid, gsz = (i64)gridDim.x * 512;
    ph_init(ka, gtid, gsz, (char*)shm, tid);
    if (gtid < N_IN) ((const float**)(ka.ws + WL.tbl))[gtid] = ka.in[gtid];
#if PROBE_K >= 0
    { const unsigned long long t_ = wall_clock64(); if (gtid == 0) tsp[0] = t_; }
#endif
  }
  volatile XB_LAS unsigned* xst = (volatile XB_LAS unsigned*)(shm + LDS_PHASE_BYTES);
  if (threadIdx.x == 0) { xst[0] = 0u; xst[1] = 0u; }
  __syncthreads();
  const XcdBarrier xb = xcd_barrier_post((unsigned*)(ka.ws + WL.bar), xst);
  grid.sync();
#if PROBE_K >= 0
  { const unsigned long long t_ = wall_clock64(); if (blockIdx.x == 0 && threadIdx.x == 0) tsp[1] = t_; }
#endif
  Params p; p.out = ka.out; p.ws = ka.ws; p.in.t = (const float* const*)(ka.ws + WL.tbl);
  for (int ph = 1; ph < NPHASES - 1; ++ph) {
    int tid = threadIdx.x;
    asm volatile("" : "+v"(tid));
    Ctx cx;
    cx.tid = tid;
    cx.gtid = (i64)blockIdx.x * 512 + tid; cx.gsz = (i64)gridDim.x * 512;
    cx.lds = (PG8_LAS unsigned char*)shm; cx.ldsg = (char*)shm;
    run_phase(p, ph, cx);
    if (REPEAT_S >= 0 && REPEAT_S < 40 && (ph - 1) % PH_PER_LAYER == REPEAT_S) { __syncthreads(); run_phase(p, ph, cx); }
    xcd_barrier(xb);
#if PROBE_K >= 0
    { const unsigned long long t_ = wall_clock64(); if (blockIdx.x == 0 && threadIdx.x == 0) tsp[ph + 1] = t_; }
    if (ph == NPHASES - 2) grid.sync();
#endif
  }
  {
    int tid = threadIdx.x;
    asm volatile("" : "+v"(tid));
    ph_final(p, (i64)blockIdx.x * 512 + tid, (i64)gridDim.x * 512);
  }
}

extern "C" void kernel_launch(void* const* d_in, const int* in_sizes, int n_in, void* d_out, int out_size,
                              void* d_ws, size_t ws_size, hipStream_t stream) {
  static int grid_blocks = 0;
  if (!grid_blocks) {
    int dev = 0, cus = 0, per_cu = 0;
    (void)hipGetDevice(&dev);
    (void)hipDeviceGetAttribute(&cus, hipDeviceAttributeMultiprocessorCount, dev);
    if (hipFuncSetAttribute((const void*)mega_kernel, hipFuncAttributeMaxDynamicSharedMemorySize, LDS_BYTES) != hipSuccess)
      fprintf(stderr, "hipFuncSetAttribute failed\n");
    (void)hipOccupancyMaxActiveBlocksPerMultiprocessor(&per_cu, mega_kernel, 512, LDS_BYTES);
    if (per_cu > 1) per_cu = 1;
    if (per_cu < 1) per_cu = 1;
    grid_blocks = cus * per_cu;
  }
  (void)hipMemsetAsync((char*)d_ws + WL.bar, 0, (size_t)3456 * 4, stream);
  KArgs ka;
  std::memset((void*)&ka, 0, sizeof(ka));
  for (int i = 0; i < N_IN; ++i) ka.in[i] = (const float*)d_in[i];
  ka.out = (float*)d_out; ka.ws = (char*)d_ws;
  void* args[] = {&ka};
  hipError_t e = hipLaunchCooperativeKernel((void*)mega_kernel, dim3(grid_blocks), dim3(512), args, LDS_BYTES, stream);
  if (e != hipSuccess) fprintf(stderr, "cooperative launch failed: %s (grid %d)\n", hipGetErrorString(e), grid_blocks);
}
#endif
```

```cpp
#ifndef CPU_SIM
#include <hip/hip_runtime.h>
#include <hip/hip_cooperative_groups.h>
#include <cstdio>
#include <cstring>
namespace cg = cooperative_groups;
#define DEV __device__ __forceinline__
#define DEVN __device__ __forceinline__
#define MDEV __device__ __forceinline__
typedef _Float16 sc_t;
#else
#include <cmath>
#include <cstdio>
#include <cstdint>
#include <cstring>
#define DEV static inline
#define DEVN static
#define MDEV inline
typedef float sc_t;
#endif

#ifndef REPEAT_S
#define REPEAT_S -1
#endif
#ifndef PROBE_K
#define PROBE_K -1
#endif
#ifndef SEQ_N
#define SEQ_N 8192
#endif
#ifndef CTX_L
#define CTX_L 256
#endif

typedef long long i64;

constexpr int D = 1024, NB = 2, N = SEQ_N, LC = CTX_L;
constexpr int NLAT = NB * N, NCTX = NB * LC, TT = NLAT + NCTX;
constexpr int GRIDW = 64;
constexpr int INC = 7840, PC = 3840;
constexpr int C_CQ = 0, C_CKV = 256, C_KR = 384, C_LX = 416, C_LG = 928, C_HU = 1440, C_GQ = 2976, C_GKV = 3488, C_GT = 3744;
constexpr int NEXP = 16384;
constexpr float EPS = 1e-6f;
#ifndef CPU_SIM
constexpr int PH_PER_LAYER = 13;
#else
constexpr int PH_PER_LAYER = 16;
#endif
constexpr int NPHASES = 2 + 2 * PH_PER_LAYER;
constexpr int LCH = 64, NCC = LC / LCH, NCL = N / LCH, NCHK = NCC + NCL;

enum { I_x, I_c, I_ctx, I_c_ctx, I_g_mix, I_g_ffn, I_w_mod, I_b_mod, I_w_in, I_mla_g_cq, I_mla_g_ckv, I_mla_w_uq,
       I_mla_w_ukv, I_lru_conv_w, I_lru_conv_b, I_lru_w_r, I_lru_b_r, I_lru_w_i, I_lru_b_i, I_lru_lam,
       I_hy_conv_w, I_hy_conv_b, I_hy_w1, I_hy_b1, I_hy_f1, I_hy_w2, I_hy_b2, I_hy_f2, I_hy_w3, I_hy_skip,
       I_gqa_sink, I_w_branch, I_w_out, I_peer_w_q, I_peer_keys, I_peer_u, I_peer_v, I_g_final, N_IN };

struct bf { unsigned short v; };
DEV float b2f(bf x) { union { unsigned u; float f; } c; c.u = ((unsigned)x.v) << 16; return c.f; }
DEV bf f2b(float f) { union { unsigned u; float f; } c; c.f = f; unsigned r = c.u + 0x7FFFu + ((c.u >> 16) & 1u); bf o; o.v = (unsigned short)(r >> 16); return o; }


constexpr size_t al256(size_t x) { return (x + 255) & ~(size_t)255; }
struct WsLayout {
  size_t xcur, mods, hdn2, ssq, tabA, tabD, fnorm, SA, SB, tw, tbl, ts, spl, bar, hdn2b, W3T, h, Y, Z, XC, LA, LB, P, QA, KVA;
  size_t W_in, W_g, W_uq, W_ukv, W_lru, W_br, W_out, W_q, W_key;
  size_t M, Gs, G, SC, TKs, TKi, SELi, SELg, W, Ub, Vb, YT, total;
};
constexpr WsLayout make_layout() {
  WsLayout w{};
  size_t o = 0;
  w.xcur = o; o = al256(o + (size_t)TT * D * 4);
  w.mods = o; o = al256(o + (size_t)2 * 3 * 6 * D * 4);
  w.hdn2 = o; o = al256(o + (size_t)2 * (N + LC) * 64 * 4);
  w.ssq = o; o = al256(o + (size_t)2 * TT * 4);
  w.tabA = o; o = al256(o + (size_t)128 * 8 * 2 * 4);
  w.tabD = o; o = al256(o + (size_t)128 * 16 * 2 * 4);
  w.fnorm = o; o = al256(o + (size_t)2 * 512 * 4);
  w.tw = o; o = al256(o + (size_t)2 * N * 8);
  w.tbl = o; o = al256(o + (size_t)N_IN * 8);
  w.ts = o; o = al256(o + (size_t)64 * 8);
  w.spl = o; o = al256(o + (size_t)2 * 2 * 512 * 4);
  w.bar = o; o = al256(o + (size_t)3456 * 4);
  w.hdn2b = o; o = al256(o + (size_t)2 * (N + LC) * 256 * 2);
  w.W3T = o; o = al256(o + (size_t)1024 * 256 * 2);
  w.SA = o; o = al256(o + (size_t)2 * NB * NCHK * 512 * 4);
  w.SB = o; o = al256(o + (size_t)2 * NB * NCHK * 512 * 4);
  w.h = o; o = al256(o + (size_t)TT * D * 2);
  w.Y = o; w.Ub = o; w.Vb = o + (size_t)NEXP * D; o = al256(o + (size_t)TT * 2048 * 2);
  w.Z = o; o = al256(o + (size_t)TT * 512 * 2);
  w.W_in = o; o = al256(o + (size_t)3840 * 1024 * 2);
  w.W_g = o; o = al256(o + (size_t)4096 * 1024 * 2);
  w.W_uq = o; o = al256(o + (size_t)768 * 256 * 2);
  w.W_ukv = o; o = al256(o + (size_t)1024 * 256 * 2);
  w.W_lru = o; o = al256(o + (size_t)2048 * 256 * 2);
  w.W_br = o; o = al256(o + (size_t)4 * 1024 * 512 * 2);
  w.W_out = o; o = al256(o + (size_t)1024 * 1024 * 2);
  w.W_q = o; o = al256(o + (size_t)1024 * 1024 * 2);
  w.W_key = o; o = al256(o + (size_t)2048 * 256 * 2);
  size_t rl = o;
  w.XC = o; o = al256(o + (size_t)TT * 512 * 2);
  w.LA = o; o = al256(o + (size_t)2 * TT * 512 * 2);
  w.LB = o; o = al256(o + (size_t)2 * TT * 512 * 2);
  size_t rl_end = o;
  o = rl;
  w.TKs = o; o = al256(o + (size_t)TT * 256 * 4);
  w.TKi = o; o = al256(o + (size_t)TT * 256 * 4);
  w.SELi = o; o = al256(o + (size_t)TT * 128 * 4);
  w.SELg = o; o = al256(o + (size_t)TT * 128 * 4);
  w.W = o; o = al256(o + (size_t)TT * 128 * 4);
  if (o > rl_end) rl_end = o;
  o = rl_end;
  size_t rp = o;
  w.P = o; o = al256(o + (size_t)TT * PC * 2);
  w.QA = o; o = al256(o + (size_t)TT * 768 * 2);
  w.KVA = o; o = al256(o + (size_t)TT * 1024 * 2);
  size_t rp_end = o;
  o = rp;
  w.M = o; o = al256(o + (size_t)TT * D * 2);
  w.G = o; if (o + (size_t)TT * 3072 * 2 > rp_end) rp_end = o + (size_t)TT * 3072 * 2;
  w.Gs = o; o = al256(o + (size_t)TT * D * 2);
  w.SC = o; o = al256(o + (size_t)TT * 2048 * sizeof(sc_t));
  if (o > rp_end) rp_end = o;
  w.YT = rp_end; rp_end = al256(rp_end + (size_t)512 * NB * N * 2);
  w.total = rp_end;
  return w;
}
constexpr WsLayout WL = make_layout();
static_assert((size_t)TT * 4096 <= (size_t)TT * 512 * 2 + (size_t)4 * TT * 512 * 2, "uint8 gates must fit in the XC/LA/LB region");
static_assert(WL.LB == WL.LA + (size_t)2 * TT * 512 * 2, "LA and LB must be contiguous (packed GPU layout)");
static_assert(WL.total <= (size_t)512 * 1024 * 1024, "workspace too large");
#ifndef CPU_SIM
static_assert((size_t)2 * NEXP * D * 2 <= (size_t)TT * 2048 * 2, "bf16 expert tables must fit in Y");
#endif
struct WsAcc {
  float* out;
  char* ws;
  MDEV float* xcur() const { return (float*)(ws + WL.xcur); }
  MDEV float* mods() const { return (float*)(ws + WL.mods); }
  MDEV float* hdn2() const { return (float*)(ws + WL.hdn2); }
  MDEV float* ssq() const { return (float*)(ws + WL.ssq); }
  MDEV float* tabA() const { return (float*)(ws + WL.tabA); }
  MDEV float* tabD() const { return (float*)(ws + WL.tabD); }
  MDEV float* fnorm() const { return (float*)(ws + WL.fnorm); }
  MDEV float* tw() const { return (float*)(ws + WL.tw); }
  MDEV unsigned* Hs() const { return (unsigned*)((char*)out + (((size_t)(N + LC) * 1024 * 4 + 255) & ~(size_t)255)); }
  MDEV float* spl() const { return (float*)(ws + WL.spl); }
  MDEV bf* XYT() const { return (bf*)((char*)out + (((size_t)(N + LC) * 1024 * 4 + 255) & ~(size_t)255)); }
  MDEV bf* hdn2b() const { return (bf*)(ws + WL.hdn2b); }
  MDEV bf* W3T() const { return (bf*)(ws + WL.W3T); }
  MDEV float* SA() const { return (float*)(ws + WL.SA); }
  MDEV float* SB() const { return (float*)(ws + WL.SB); }
  MDEV bf* h() const { return (bf*)(ws + WL.h); }
  MDEV bf* Y() const { return (bf*)(ws + WL.Y); }
  MDEV bf* Z() const { return (bf*)(ws + WL.Z); }
  MDEV bf* XC() const { return (bf*)(ws + WL.XC); }
  MDEV bf* LA() const { return (bf*)(ws + WL.LA); }
  MDEV bf* LB() const { return (bf*)(ws + WL.LB); }
  MDEV bf* P() const { return (bf*)(ws + WL.P); }
  MDEV bf* QA() const { return (bf*)(ws + WL.QA); }
  MDEV bf* KVA() const { return (bf*)(ws + WL.KVA); }
  MDEV float* F() const { return out; }
  MDEV bf* W_in() const { return (bf*)(ws + WL.W_in); }
  MDEV bf* W_g() const { return (bf*)(ws + WL.W_g); }
  MDEV bf* W_uq() const { return (bf*)(ws + WL.W_uq); }
  MDEV bf* W_ukv() const { return (bf*)(ws + WL.W_ukv); }
  MDEV bf* W_lru() const { return (bf*)(ws + WL.W_lru); }
  MDEV bf* W_br() const { return (bf*)(ws + WL.W_br); }
  MDEV bf* W_out() const { return (bf*)(ws + WL.W_out); }
  MDEV bf* W_q() const { return (bf*)(ws + WL.W_q); }
  MDEV bf* W_key() const { return (bf*)(ws + WL.W_key); }
  MDEV bf* M() const { return (bf*)(ws + WL.M); }
  MDEV bf* Gs() const { return (bf*)(ws + WL.Gs); }
  MDEV bf* PQ() const { return (bf*)(ws + WL.Gs); }
  MDEV bf* BR() const { return (bf*)(ws + WL.G); }
  MDEV unsigned char* G8() const { return (unsigned char*)(ws + WL.XC); }
  MDEV unsigned* LAB() const { return (unsigned*)(ws + WL.LA); }
  MDEV bf* YT() const { return (bf*)(ws + WL.YT); }
  MDEV sc_t* SC() const { return (sc_t*)(ws + WL.SC); }
  MDEV float* TKs() const { return (float*)(ws + WL.TKs); }
  MDEV int* TKi() const { return (int*)(ws + WL.TKi); }
  MDEV int* SELi() const { return (int*)(ws + WL.SELi); }
  MDEV float* SELg() const { return (float*)(ws + WL.SELg); }
  MDEV float* W() const { return (float*)(ws + WL.W); }
  MDEV bf* Ub() const { return (bf*)(ws + WL.Ub); }
  MDEV bf* Vb() const { return (bf*)(ws + WL.Vb); }
};
struct KArgs : WsAcc { const float* in[N_IN]; };
#ifndef CPU_SIM
typedef float v4f_gl __attribute__((ext_vector_type(4)));
DEV float4 gld4(const void* q) { const v4f_gl r = *(const __attribute__((address_space(1))) v4f_gl*)q; return float4{r.x, r.y, r.z, r.w}; }
DEV float gld1(const float* q) { return *(const __attribute__((address_space(1))) float*)q; }
#else
DEV float gld1(const float* q) { return *q; }
#endif
#ifndef CPU_SIM
typedef const __attribute__((address_space(1))) float* GF;
#else
typedef const float* GF;
#endif
struct InTab {
  const float* const* t;
#ifndef CPU_SIM
  MDEV const float* operator[](int i) const { return t[i]; }
#else
  MDEV const float* operator[](int i) const { return t[i]; }
#endif
};
struct Params : WsAcc { InTab in; };
static_assert((size_t)(N + LC) * 1024 * 4 + 256 + (size_t)256 * 2 * N * 4 <= (size_t)NLAT * D * 4, "F + spectrum scratch must fit in d_out");

#ifndef CPU_SIM
DEV float fexpf_(float x) { return __builtin_amdgcn_exp2f(x * 1.4426950408889634f); }
DEV float sigmoidf_(float x) { return __builtin_amdgcn_rcpf(1.0f + __builtin_amdgcn_exp2f(-x * 1.4426950408889634f)); }
DEV float siluf_(float x) { return x * sigmoidf_(x); }
DEV float geluf_(float x) { return x * sigmoidf_(1.5957691216057308f * (x + 0.044715f * x * x * x)); }
#else
DEV float fexpf_(float x) { return expf(x); }
DEV float sigmoidf_(float x) { return 1.0f / (1.0f + expf(-x)); }
DEV float siluf_(float x) { return x * sigmoidf_(x); }
DEV float geluf_(float x) { return 0.5f * x * (1.0f + tanhf(0.7978845608028654f * (x + 0.044715f * x * x * x))); }
#endif
DEV float softplusf_(float x) { return x > 20.f ? x : log1pf(expf(x)); }

#ifndef CPU_SIM
DEV float lane_xor(float v, int lane, int o) { return __int_as_float(__builtin_amdgcn_ds_bpermute(((lane ^ o) & 63) << 2, __float_as_int(v))); }
#endif
#ifndef CPU_SIM
DEV void unpack8(const uint4 w, float* f) {
  union { unsigned u; float x; } c;
  c.u = w.x << 16; f[0] = c.x; c.u = w.x & 0xFFFF0000u; f[1] = c.x; c.u = w.y << 16; f[2] = c.x; c.u = w.y & 0xFFFF0000u; f[3] = c.x;
  c.u = w.z << 16; f[4] = c.x; c.u = w.z & 0xFFFF0000u; f[5] = c.x; c.u = w.w << 16; f[6] = c.x; c.u = w.w & 0xFFFF0000u; f[7] = c.x;
}
#endif
struct RowInfo { int b, t, L, base, lat; };
DEV RowInfo rowinfo(int r) {
  RowInfo ri;
  if (r < NLAT) { ri.b = r / N; ri.t = r - ri.b * N; ri.L = N; ri.base = ri.b * N; ri.lat = 1; }
  else { int rc = r - NLAT; ri.b = rc / LC; ri.t = rc - ri.b * LC; ri.L = LC; ri.base = NLAT + ri.b * LC; ri.lat = 0; }
  return ri;
}
DEV int modrow(int r) { return r < NLAT ? r / N : 2; }
template <class PT> DEV const float* xin_row(const PT& p, int r) { return r < NLAT ? p.in[I_x] + (size_t)r * D : p.in[I_ctx] + (size_t)(r - NLAT) * D; }

DEV void atomic_addf(float* p, float v) {
#ifndef CPU_SIM
  atomicAdd(p, v);
#else
#pragma omp atomic
  *p += v;
#endif
}
DEV void store8bf(bf* dst, const float* v) {
#ifndef CPU_SIM
  uint4 w;
  asm volatile("v_cvt_pk_bf16_f32 %0, %1, %2" : "=v"(w.x) : "v"(v[0]), "v"(v[1]));
  asm volatile("v_cvt_pk_bf16_f32 %0, %1, %2" : "=v"(w.y) : "v"(v[2]), "v"(v[3]));
  asm volatile("v_cvt_pk_bf16_f32 %0, %1, %2" : "=v"(w.z) : "v"(v[4]), "v"(v[5]));
  asm volatile("v_cvt_pk_bf16_f32 %0, %1, %2" : "=v"(w.w) : "v"(v[6]), "v"(v[7]));
  *(uint4*)dst = w;
#else
  for (int j = 0; j < 8; ++j) dst[j] = f2b(v[j]);
#endif
}
#ifndef CPU_SIM
DEV unsigned pk2bf(float lo, float hi) { unsigned r; asm volatile("v_cvt_pk_bf16_f32 %0, %1, %2" : "=v"(r) : "v"(lo), "v"(hi)); return r; }
#endif
DEV void load8bf(const bf* src, float* v) {
#ifndef CPU_SIM
  uint4 w = *(const uint4*)src;
  union { unsigned u; float f; } c;
  c.u = w.x << 16; v[0] = c.f; c.u = w.x & 0xFFFF0000u; v[1] = c.f;
  c.u = w.y << 16; v[2] = c.f; c.u = w.y & 0xFFFF0000u; v[3] = c.f;
  c.u = w.z << 16; v[4] = c.f; c.u = w.z & 0xFFFF0000u; v[5] = c.f;
  c.u = w.w << 16; v[6] = c.f; c.u = w.w & 0xFFFF0000u; v[7] = c.f;
#else
  for (int j = 0; j < 8; ++j) v[j] = b2f(src[j]);
#endif
}

DEV int win_src(int n) {
  if (n >= 3744) return -1;
  if (n >= C_KR && n < C_KR + 32) { int q = n - C_KR; int pi = q >> 1, wh = q & 1, half = pi >> 3, f = pi & 7; return C_KR + half * 16 + f + wh * 8; }
  if (n >= C_GQ && n < C_GKV + 128) { int q = n - C_GQ; int hh = q >> 6, d = q & 63; int pi = d >> 1, wh = d & 1, half = pi >> 4, f = pi & 15; return C_GQ + hh * 64 + half * 32 + f + wh * 16; }
  return n;
}
DEV int wuq_src(int n) {
  int hh = n / 96, d = n % 96;
  if (d < 64) return n;
  int q = d - 64; int pi = q >> 1, wh = q & 1, half = pi >> 3, f = pi & 7;
  return hh * 96 + 64 + half * 16 + f + wh * 8;
}

template <class PT> DEVN void ph_init(const PT& p, i64 gtid, i64 gsz, char* ilds = nullptr, int itid = 0) {
#ifndef CPU_SIM
  {
    float* sl = (float*)ilds;
    for (int q = itid; q < 3 * D; q += 512) { const int rr = q / D, k = q - rr * D; sl[q] = siluf_(rr < 2 ? p.in[I_c][rr * D + k] : p.in[I_c_ctx][k]); }
    __syncthreads();
    float* red3 = sl + 3 * D;
    const int wv_ = itid >> 6, ln_ = itid & 63;
    for (int task = blockIdx.x; task < 2 * 6 * D / 64; task += gridDim.x) {
      const int l = task / (6 * D / 64), j = (task % (6 * D / 64)) * 64 + ln_;
      const float* w = p.in[I_w_mod] + (size_t)l * D * 6 * D + j;
      float a0 = 0.f, a1 = 0.f, a2 = 0.f;
#pragma unroll 1
      for (int k0 = wv_ * 128; k0 < wv_ * 128 + 128; k0 += 16) {
        float wv[16];
#pragma unroll
        for (int q = 0; q < 16; ++q) wv[q] = w[(size_t)(k0 + q) * 6 * D];
#pragma unroll
        for (int q = 0; q < 16; ++q) { a0 += sl[k0 + q] * wv[q]; a1 += sl[D + k0 + q] * wv[q]; a2 += sl[2 * D + k0 + q] * wv[q]; }
      }
      __syncthreads();
      red3[(wv_ * 3 + 0) * 64 + ln_] = a0; red3[(wv_ * 3 + 1) * 64 + ln_] = a1; red3[(wv_ * 3 + 2) * 64 + ln_] = a2;
      __syncthreads();
      if (itid < 192) {
        const int v3 = itid >> 6, jj = itid & 63;
        float sum = p.in[I_b_mod][l * 6 * D + (task % (6 * D / 64)) * 64 + jj];
#pragma unroll
        for (int w8 = 0; w8 < 8; ++w8) sum += red3[(w8 * 3 + v3) * 64 + jj];
        p.mods()[((size_t)l * 3 + v3) * 6 * D + (task % (6 * D / 64)) * 64 + jj] = sum;
      }
    }
    __syncthreads();
  }
  {
    float* h1 = (float*)ilds;
    for (i64 i = gtid; i < (i64)2 * (N + LC); i += gsz) {
      const int l = (int)(i / (N + LC)), tt = (int)(i % (N + LC));
      int t, L; if (tt < N) { t = tt; L = N; } else { t = tt - N; L = LC; }
      const float tn = (float)t / (float)(L - 1);
      const float wt = 6.283185307179586f * (float)t / (float)L;
      const float* w1 = p.in[I_hy_w1] + l * 33 * 64; const float* b1 = p.in[I_hy_b1] + l * 64; const float* f1 = p.in[I_hy_f1] + l * 64;
      const float* w2 = p.in[I_hy_w2] + l * 64 * 64; const float* b2 = p.in[I_hy_b2] + l * 64; const float* f2 = p.in[I_hy_f2] + l * 64;
      { uint4* zp_ = (uint4*)(p.hdn2b() + ((size_t)l * (N + LC) + tt) * 256 + 64);
#pragma unroll
        for (int q = 0; q < 24; ++q) zp_[q] = uint4{0, 0, 0, 0}; }
      float zc[16], zs[16];
#pragma unroll
      for (int bd = 0; bd < 16; ++bd) { const float ang = (1e-4f + (float)bd * ((15.0f - 1e-4f) / 15.0f)) * wt; zc[bd] = cosf(ang); zs[bd] = sinf(ang); }
#pragma unroll 1
      for (int k1 = 0; k1 < 64; ++k1) {
        float a1 = b1[k1] + tn * w1[k1];
#pragma unroll
        for (int bd = 0; bd < 16; ++bd) a1 += zc[bd] * w1[(1 + bd) * 64 + k1] - zs[bd] * w1[(17 + bd) * 64 + k1];
        h1[k1 * 512 + itid] = sinf(f1[k1] * a1);
      }
#pragma unroll 1
      for (int j0 = 0; j0 < 64; j0 += 4) {
        float c0 = b2[j0], c1 = b2[j0 + 1], c2 = b2[j0 + 2], c3 = b2[j0 + 3];
#pragma unroll 8
        for (int k1 = 0; k1 < 64; ++k1) { const float hv = h1[k1 * 512 + itid]; const float4 wv = *(const float4*)(w2 + k1 * 64 + j0); c0 += hv * wv.x; c1 += hv * wv.y; c2 += hv * wv.z; c3 += hv * wv.w; }
        bf* ot = p.hdn2b() + ((size_t)l * (N + LC) + tt) * 256 + j0;
        ot[0] = f2b(sinf(f2[j0] * c0)); ot[1] = f2b(sinf(f2[j0 + 1] * c1)); ot[2] = f2b(sinf(f2[j0 + 2] * c2)); ot[3] = f2b(sinf(f2[j0 + 3] * c3));
      }
    }
  }
#else
  for (i64 i = gtid; i < 2 * 3 * 6 * D; i += gsz) {
    int l = (int)(i / (3 * 6 * D)); int rr = (int)((i / (6 * D)) % 3); int j = (int)(i % (6 * D));
    const float* cv = rr < 2 ? p.in[I_c] + rr * D : p.in[I_c_ctx];
    const float* w = p.in[I_w_mod] + (size_t)l * D * 6 * D;
    float acc = p.in[I_b_mod][l * 6 * D + j];
    for (int k = 0; k < D; ++k) acc += siluf_(cv[k]) * w[(size_t)k * 6 * D + j];
    p.mods()[i] = acc;
  }
  for (i64 i = gtid; i < (i64)2 * (N + LC) * 64; i += gsz) {
    int l = (int)(i / ((i64)(N + LC) * 64)); int tt = (int)((i / 64) % (N + LC)); int j2 = (int)(i % 64);
    int t, L; if (tt < N) { t = tt; L = N; } else { t = tt - N; L = LC; }
    float tn = (float)t / (float)(L - 1);
    float wt = 6.283185307179586f * (float)t / (float)L;
    const float* w1 = p.in[I_hy_w1] + l * 33 * 64; const float* b1 = p.in[I_hy_b1] + l * 64; const float* f1 = p.in[I_hy_f1] + l * 64;
    const float* w2 = p.in[I_hy_w2] + l * 64 * 64; const float* b2 = p.in[I_hy_b2] + l * 64; const float* f2 = p.in[I_hy_f2] + l * 64;
    float acc2 = b2[j2];
    for (int k1 = 0; k1 < 64; ++k1) {
      float a1 = b1[k1] + tn * w1[k1];
      for (int bd = 0; bd < 16; ++bd) {
        float band = 1e-4f + (float)bd * ((15.0f - 1e-4f) / 15.0f);
        float ang = band * wt;
        a1 += cosf(ang) * w1[(1 + bd) * 64 + k1] - sinf(ang) * w1[(17 + bd) * 64 + k1];
      }
      acc2 += sinf(f1[k1] * a1) * w2[k1 * 64 + j2];
    }
    p.hdn2()[i] = sinf(f2[j2] * acc2);
  }
#endif
#ifdef CPU_SIM
  for (i64 i = gtid; i < 2 * N; i += gsz) {
    double a = 6.283185307179586476925 * (double)i / (double)(2 * N);
    p.tw()[i * 2] = (float)cos(a); p.tw()[i * 2 + 1] = (float)-sin(a);
  }
#endif
  for (i64 i = gtid; i < 2 * 2 * 512; i += gsz) p.spl()[i] = softplusf_(-p.in[I_lru_lam][i]);
  for (i64 i = gtid; i < 128 * 8; i += gsz) {
    int pos = (int)(i / 8), f = (int)(i % 8);
    float ang = (float)pos * powf(10000.0f, -(float)f / 8.0f);
    p.tabA()[i * 2] = cosf(ang); p.tabA()[i * 2 + 1] = sinf(ang);
  }
  for (i64 i = gtid; i < 128 * 16; i += gsz) {
    int pos = (int)(i / 16), f = (int)(i % 16);
    float ang = (float)pos * powf(10000.0f, -(float)f / 16.0f);
    p.tabD()[i * 2] = cosf(ang); p.tabD()[i * 2 + 1] = sinf(ang);
  }
}

#ifndef CPU_SIM
template <class F> DEV void xpose_tiles(bf* dst, int K, int NN, const F& val, int tid, float* tl, int& xoff, int rank, int nranks) {
  const int tk = K / 64, tn = NN / 64;
  const int t0 = (rank + nranks - xoff % nranks) % nranks;
  xoff += tk * tn;
  for (int t = t0; t < tk * tn; t += nranks) {
    const int k0 = (t / tn) * 64, n0 = (t % tn) * 64;
    __syncthreads();
    float tv_[8];
#pragma unroll
    for (int i = 0; i < 8; ++i) { const int kk = (tid >> 6) + 8 * i, nn = tid & 63; tv_[i] = val(k0 + kk, n0 + nn); }
#pragma unroll
    for (int i = 0; i < 8; ++i) { const int kk = (tid >> 6) + 8 * i, nn = tid & 63; tl[nn * 65 + kk] = tv_[i]; }
    __syncthreads();
#pragma unroll
    for (int i = 0; i < 8; ++i) { const int nn = (tid >> 6) + 8 * i, kk = tid & 63; dst[(size_t)(n0 + nn) * K + k0 + kk] = f2b(tl[nn * 65 + kk]); }
  }
}
#else
template <class F> static void xpose_tiles(bf* dst, int K, int NN, const F& val, i64 gtid, i64 gsz) {
  for (i64 i = gtid; i < (i64)K * NN; i += gsz) { int k = (int)(i / NN), n = (int)(i % NN); dst[(size_t)n * K + k] = f2b(val(k, n)); }
}
#endif
struct PrepCtx {
#ifndef CPU_SIM
  int tid; float* tl; int rank, nranks;
#else
  i64 gtid, gsz;
#endif
};
#ifndef CPU_SIM
#define XPOSE(dst, K, NN, val) xpose_tiles(dst, K, NN, val, pc.tid, pc.tl, xoff, pc.rank, pc.nranks)
#else
#define XPOSE(dst, K, NN, val) xpose_tiles(dst, K, NN, val, pc.gtid, pc.gsz)
#endif
DEVN void ph_prep(const Params& p, int l, const PrepCtx& pc, i64 gtid, i64 gsz, const int parts) {
  int xoff = 0; (void)xoff;
  if (parts & 1) {
    GF w = (GF)(p.in[I_w_in] + (size_t)l * D * INC);
    XPOSE(p.W_in(), 1024, 3840, [=](int k, int n) { int s_ = win_src(n); return s_ < 0 ? 0.f : w[(size_t)k * INC + s_]; });
    XPOSE(p.W_g(), 1024, 4096, [=](int k, int n) { return w[(size_t)k * INC + C_GT + n]; });
  }
  if (parts & 1) {
    GF w = (GF)(p.in[I_mla_w_uq] + (size_t)l * 256 * 768); GF g = (GF)(p.in[I_mla_g_cq] + l * 256);
    XPOSE(p.W_uq(), 256, 768, [=](int k, int n) { return g[k] * w[(size_t)k * 768 + wuq_src(n)]; });
  }
  if (parts & 1) {
    GF w = (GF)(p.in[I_mla_w_ukv] + (size_t)l * 128 * 1024); GF g = (GF)(p.in[I_mla_g_ckv] + l * 128);
    XPOSE(p.W_ukv(), 256, 1024, [=](int k, int n) { return k < 128 ? g[k] * w[(size_t)k * 1024 + n] : 0.f; });
  }
  if (parts & 2) {
    GF w = (GF)(p.in[I_w_branch] + (size_t)l * 4 * 512 * D);
    for (int br = 0; br < 4; ++br) { GF wb = w + (size_t)br * 512 * D; XPOSE(p.W_br() + (size_t)br * 1024 * 512, 512, 1024, [=](int k, int n) { return wb[(size_t)k * D + n]; }); }
  }
  if (parts & 2) {
    GF w = (GF)(p.in[I_w_out] + (size_t)l * D * D);
    XPOSE(p.W_out(), 1024, 1024, [=](int k, int n) { return w[(size_t)k * D + n]; });
  }
  if (parts & 4) {
    GF wq = (GF)(p.in[I_peer_w_q] + (size_t)l * D * 1024);
    XPOSE(p.W_q(), 1024, 1024, [=](int k, int n) { return wq[(size_t)k * 1024 + n]; });
  }
#ifndef CPU_SIM
  if (parts & 1) {
    GF w3 = (GF)(p.in[I_hy_w3] + (size_t)l * 64 * 1024);
    XPOSE(p.W3T(), 256, 1024, [=](int k, int n) { return k < 64 ? w3[(size_t)k * 1024 + n] : 0.f; });
  }
#endif
  if (parts & 1) {
    for (i64 i = gtid; i < 2048 * 256; i += gsz) {
      int n = (int)(i / 256), k = (int)(i % 256);
      int kw = n >> 10, dir = (n >> 9) & 1, blk4 = (n >> 7) & 3, jc = (n & 127) >> 1, gate = n & 1;
      float v = 0.f;
      if ((k >> 6) == blk4) {
        GF wsrc = (GF)p.in[gate ? I_lru_w_i : I_lru_w_r] + ((((size_t)l * 2 + dir) * 8 + kw * 4 + blk4) * 64 + (k & 63)) * 64 + jc;
        v = *wsrc;
      }
      p.W_lru()[i] = f2b(v);
    }
  }
  if (parts & 8) {
    GF keys = (GF)(p.in[I_peer_keys] + (size_t)l * 16 * 128 * 64);
    for (i64 i = gtid; i < 2048 * 256; i += gsz) {
      int n = (int)(i / 256), k = (int)(i % 256);
      int hp = n >> 7, key = n & 127;
      float v = ((k >> 6) == (hp & 3)) ? keys[((size_t)hp * 128 + key) * 64 + (k & 63)] : 0.f;
      p.W_key()[i] = f2b(v);
    }
  }
}

DEVN void ph_norm(const Params& p, int l, int which, int nrows, i64 gtid, i64 gsz) {
  const float* g = p.in[which ? I_g_ffn : I_g_mix] + l * D;
#ifndef CPU_SIM
  const int lane = (int)(gtid & 63);
  const i64 W = gsz >> 6;
  float4 gv[4];
#pragma unroll
  for (int i = 0; i < 4; ++i) gv[i] = *(const float4*)(g + (lane + i * 64) * 4);
  for (i64 r = gtid >> 6; r < nrows; r += 2 * W) {
    const bool two = r + W < nrows;
    const i64 rb = two ? r + W : r;
    const float4* xra = (const float4*)((l == 0 && which == 0) ? xin_row(p, (int)r) : p.xcur() + (size_t)r * D);
    const float4* xrb = (const float4*)((l == 0 && which == 0) ? xin_row(p, (int)rb) : p.xcur() + (size_t)rb * D);
    const float* mda = p.mods() + ((size_t)l * 3 + modrow((int)r)) * 6 * D + (which ? 3 * D : 0);
    const float* mdb = p.mods() + ((size_t)l * 3 + modrow((int)rb)) * 6 * D + (which ? 3 * D : 0);
    float4 xa[4], xb[4], sha[4], sca[4], shb[4], scb[4]; float sa = 0.f, sb = 0.f;
#pragma unroll
    for (int i = 0; i < 4; ++i) { xa[i] = xra[lane + i * 64]; xb[i] = xrb[lane + i * 64]; }
#pragma unroll
    for (int i = 0; i < 4; ++i) { const int k = (lane + i * 64) * 4; sha[i] = *(const float4*)(mda + k); sca[i] = *(const float4*)(mda + D + k); shb[i] = *(const float4*)(mdb + k); scb[i] = *(const float4*)(mdb + D + k); }
#pragma unroll
    for (int i = 0; i < 4; ++i) { sa += xa[i].x * xa[i].x + xa[i].y * xa[i].y + xa[i].z * xa[i].z + xa[i].w * xa[i].w; sb += xb[i].x * xb[i].x + xb[i].y * xb[i].y + xb[i].z * xb[i].z + xb[i].w * xb[i].w; }
#pragma unroll
    for (int o = 32; o >= 1; o >>= 1) { sa += lane_xor(sa, lane, o); sb += lane_xor(sb, lane, o); }
    const float rsa = 1.0f / sqrtf(sa * (1.0f / D) + EPS), rsb = 1.0f / sqrtf(sb * (1.0f / D) + EPS);
#pragma unroll
    for (int i = 0; i < 4; ++i) {
      const int k = (lane + i * 64) * 4;
      uint2 w;
      w.x = pk2bf(xa[i].x * rsa * gv[i].x * (1.0f + sca[i].x) + sha[i].x, xa[i].y * rsa * gv[i].y * (1.0f + sca[i].y) + sha[i].y);
      w.y = pk2bf(xa[i].z * rsa * gv[i].z * (1.0f + sca[i].z) + sha[i].z, xa[i].w * rsa * gv[i].w * (1.0f + sca[i].w) + sha[i].w);
      *(uint2*)(p.h() + (size_t)r * D + k) = w;
    }
    if (two) {
#pragma unroll
      for (int i = 0; i < 4; ++i) {
        const int k = (lane + i * 64) * 4;
        uint2 w;
        w.x = pk2bf(xb[i].x * rsb * gv[i].x * (1.0f + scb[i].x) + shb[i].x, xb[i].y * rsb * gv[i].y * (1.0f + scb[i].y) + shb[i].y);
        w.y = pk2bf(xb[i].z * rsb * gv[i].z * (1.0f + scb[i].z) + shb[i].z, xb[i].w * rsb * gv[i].w * (1.0f + scb[i].w) + shb[i].w);
        *(uint2*)(p.h() + (size_t)rb * D + k) = w;
      }
    }
  }
#else
  for (i64 r = gtid; r < nrows; r += gsz) {
    const float* xr = (l == 0 && which == 0) ? xin_row(p, (int)r) : p.xcur() + (size_t)r * D;
    float ss = 0.f;
    for (int k = 0; k < D; ++k) ss += xr[k] * xr[k];
    float rstd = 1.0f / sqrtf(ss / D + EPS);
    const float* md = p.mods() + ((size_t)l * 3 + modrow((int)r)) * 6 * D + (which ? 3 * D : 0);
    for (int k = 0; k < D; ++k) p.h()[(size_t)r * D + k] = f2b(xr[k] * rstd * g[k] * (1.0f + md[D + k]) + md[k]);
  }
#endif
}

DEVN void ph_B0(const Params& p, int l, i64 gtid, i64 gsz, char* b0lds = nullptr, int b0tid = 0) {
#ifndef CPU_SIM
  {
    const int lane = (int)(gtid & 63);
    const i64 W = gsz >> 6;
    for (i64 r = gtid >> 6; r < TT; r += 4 * W) {
      uint2 a[4]; unsigned b[4]; i64 rr[4];
#pragma unroll
      for (int j = 0; j < 4; ++j) { rr[j] = r + j * W < TT ? r + j * W : r; const bf* pr = p.P() + (size_t)rr[j] * PC; a[j] = *(const uint2*)(pr + C_CQ + lane * 4); b[j] = *(const unsigned*)(pr + C_CKV + lane * 2); }
      float sq[4], sk[4];
#pragma unroll
      for (int j = 0; j < 4; ++j) {
        const float f0 = __uint_as_float(a[j].x << 16), f1 = __uint_as_float(a[j].x & 0xFFFF0000u), f2 = __uint_as_float(a[j].y << 16), f3 = __uint_as_float(a[j].y & 0xFFFF0000u);
        const float g0 = __uint_as_float(b[j] << 16), g1 = __uint_as_float(b[j] & 0xFFFF0000u);
        sq[j] = 0.f; sq[j] += f0 * f0; sq[j] += f1 * f1; sq[j] += f2 * f2; sq[j] += f3 * f3;
        sk[j] = 0.f; sk[j] += g0 * g0; sk[j] += g1 * g1;
      }
#pragma unroll
      for (int o = 32; o >= 1; o >>= 1) {
#pragma unroll
        for (int j = 0; j < 4; ++j) { sq[j] += lane_xor(sq[j], lane, o); sk[j] += lane_xor(sk[j], lane, o); }
      }
#pragma unroll
      for (int j = 0; j < 4; ++j) if (lane == 0 && r + j * W < TT) { p.ssq()[rr[j]] = sq[j]; p.ssq()[TT + rr[j]] = sk[j]; }
    }
  }
#else
  for (i64 r = gtid; r < TT; r += gsz) {
    const bf* pr = p.P() + (size_t)r * PC;
    float sq = 0.f, sk = 0.f;
    for (int k = 0; k < 256; ++k) { float v = b2f(pr[C_CQ + k]); sq += v * v; }
    for (int k = 0; k < 128; ++k) { float v = b2f(pr[C_CKV + k]); sk += v * v; }
    p.ssq()[r] = sq; p.ssq()[TT + r] = sk;
  }
#endif
#ifndef CPU_SIM
  {
    const float* cw = p.in[I_lru_conv_w] + l * 4 * 512; const float* cb = p.in[I_lru_conv_b] + l * 512;
    for (i64 i = gtid; i < (i64)TT * 64; i += gsz) {
      const int r = (int)(i >> 6), c8 = (int)(i & 63) * 8;
      const RowInfo ri = rowinfo(r);
      float acc[8];
      { const float4 b0 = *(const float4*)(cb + c8), b1 = *(const float4*)(cb + c8 + 4); acc[0] = b0.x; acc[1] = b0.y; acc[2] = b0.z; acc[3] = b0.w; acc[4] = b1.x; acc[5] = b1.y; acc[6] = b1.z; acc[7] = b1.w; }
      uint4 xv[4]; bool ok[4];
#pragma unroll
      for (int k = 0; k < 4; ++k) { const int ts = ri.t - 1 + k; ok[k] = ts >= 0 && ts < ri.L; xv[k] = ok[k] ? *(const uint4*)(p.P() + (size_t)(ri.base + ts) * PC + C_LX + c8) : uint4{0, 0, 0, 0}; }
#pragma unroll
      for (int k = 0; k < 4; ++k) {
        float f[8]; unpack8(xv[k], f);
        const float4 w0 = *(const float4*)(cw + k * 512 + c8), w1 = *(const float4*)(cw + k * 512 + c8 + 4);
        acc[0] += w0.x * f[0]; acc[1] += w0.y * f[1]; acc[2] += w0.z * f[2]; acc[3] += w0.w * f[3];
        acc[4] += w1.x * f[4]; acc[5] += w1.y * f[5]; acc[6] += w1.z * f[6]; acc[7] += w1.w * f[7];
      }
      store8bf(p.XC() + (size_t)r * 512 + c8, acc);
    }
  }
  {
    const float* cw = p.in[I_hy_conv_w] + l * 3 * 1536; const float* cb = p.in[I_hy_conv_b] + l * 1536;
    for (i64 i = (i64)NLAT * 64 + gtid; i < (i64)TT * 64; i += gsz) {
      const int r = (int)(i >> 6), c8 = (int)(i & 63) * 8;
      const RowInfo ri = rowinfo(r);
      float a1[8], a2[8];
#pragma unroll
      for (int j = 0; j < 8; ++j) { a1[j] = cb[512 + c8 + j]; a2[j] = cb[1024 + c8 + j]; }
#pragma unroll
      for (int k = 0; k < 3; ++k) {
        const int ts = ri.t - 1 + k; if (ts < 0 || ts >= ri.L) continue;
        const bf* pr = p.P() + (size_t)(ri.base + ts) * PC + C_HU;
        float f[8], g[8]; unpack8(*(const uint4*)(pr + 512 + c8), f); unpack8(*(const uint4*)(pr + 1024 + c8), g);
#pragma unroll
        for (int j = 0; j < 8; ++j) { a1[j] += cw[k * 1536 + 512 + c8 + j] * f[j]; a2[j] += cw[k * 1536 + 1024 + c8 + j] * g[j]; }
      }
#pragma unroll
      for (int j = 0; j < 8; ++j) a1[j] *= a2[j];
      store8bf(p.Z() + (size_t)r * 512 + c8, a1);
    }
  }
  {
    const float* cw = p.in[I_hy_conv_w] + l * 3 * 1536; const float* cb = p.in[I_hy_conv_b] + l * 1536;
    unsigned short* tz_ = (unsigned short*)b0lds; unsigned short* tx_ = tz_ + 64 * 72;
    for (int tile = blockIdx.x; tile < (NLAT / 64) * 8; tile += gridDim.x) {
      const int rt = tile >> 3, c0 = (tile & 7) * 64;
      const int tr = b0tid >> 3, cg8 = (b0tid & 7) * 8;
      const int r = rt * 64 + tr, t = r % N;
      float a0[8], a1[8], a2[8];
#pragma unroll
      for (int j = 0; j < 8; ++j) { a0[j] = cb[c0 + cg8 + j]; a1[j] = cb[512 + c0 + cg8 + j]; a2[j] = cb[1024 + c0 + cg8 + j]; }
      uint4 v0[3], v1[3], v2[3]; bool ok[3];
#pragma unroll
      for (int k = 0; k < 3; ++k) {
        const int ts = t - 1 + k; ok[k] = ts >= 0 && ts < N;
        const bf* pr = p.P() + (size_t)(r - 1 + (ok[k] ? k : 1)) * PC + C_HU + c0 + cg8;
        v0[k] = *(const uint4*)pr; v1[k] = *(const uint4*)(pr + 512); v2[k] = *(const uint4*)(pr + 1024);
      }
#pragma unroll
      for (int k = 0; k < 3; ++k) {
        if (!ok[k]) continue;
        float f0[8], f1[8], f2_[8]; unpack8(v0[k], f0); unpack8(v1[k], f1); unpack8(v2[k], f2_);
        const float* w = cw + k * 1536 + c0 + cg8;
#pragma unroll
        for (int j = 0; j < 8; ++j) { a0[j] += w[j] * f0[j]; a1[j] += w[512 + j] * f1[j]; a2[j] += w[1024 + j] * f2_[j]; }
      }
      __syncthreads();
#pragma unroll
      for (int j = 0; j < 8; ++j) { tz_[(cg8 + j) * 72 + tr] = f2b(a1[j] * a2[j]).v; tx_[(cg8 + j) * 72 + tr] = f2b(a0[j]).v; }
      __syncthreads();
      { const int cc = b0tid >> 3, tg = (b0tid & 7) * 8;
        const int bq = (rt * 64) / N, tq = (rt * 64) % N + tg;
        const size_t o = ((size_t)(c0 + cc) * NB + bq) * N + tq;
        *(uint4*)((unsigned short*)p.Z() + o) = *(const uint4*)(tz_ + cc * 72 + tg);
        *(uint4*)((unsigned short*)p.XYT() + o) = *(const uint4*)(tx_ + cc * 72 + tg); }
    }
  }
#else
  {
    const float* cw = p.in[I_lru_conv_w] + l * 4 * 512; const float* cb = p.in[I_lru_conv_b] + l * 512;
    for (i64 i = gtid; i < (i64)TT * 512; i += gsz) {
      int r = (int)(i / 512), c = (int)(i % 512);
      RowInfo ri = rowinfo(r);
      float acc = cb[c];
      for (int k = 0; k < 4; ++k) {
        int ts = ri.t - 1 + k;
        if (ts >= 0 && ts < ri.L) acc += cw[k * 512 + c] * b2f(p.P()[(size_t)(ri.base + ts) * PC + C_LX + c]);
      }
      p.XC()[i] = f2b(acc);
    }
  }
  {
    const float* cw = p.in[I_hy_conv_w] + l * 3 * 1536; const float* cb = p.in[I_hy_conv_b] + l * 1536;
    for (i64 i = gtid; i < (i64)TT * 512; i += gsz) {
      int r = (int)(i / 512), c = (int)(i % 512);
      RowInfo ri = rowinfo(r);
      float a1 = cb[512 + c], a2 = cb[1024 + c];
      for (int k = 0; k < 3; ++k) {
        int ts = ri.t - 1 + k;
        if (ts >= 0 && ts < ri.L) {
          const bf* pr = p.P() + (size_t)(ri.base + ts) * PC + C_HU;
          a1 += cw[k * 1536 + 512 + c] * b2f(pr[512 + c]);
          a2 += cw[k * 1536 + 1024 + c] * b2f(pr[1024 + c]);
        }
      }
      p.Z()[i] = f2b(a1 * a2);
    }
  }
  {
    const float* w3 = p.in[I_hy_w3] + (size_t)l * 64 * 1024;
    const float maxd = logf(1e-2f) / 0.3f, mind = logf(1e-2f) / 1.5f;
    for (i64 i = gtid; i < (i64)(N + LC) * 1024; i += gsz) {
      int tt = (int)(i / 1024), j = (int)(i % 1024);
      int t, L; if (tt < N) { t = tt; L = N; } else { t = tt - N; L = LC; }
      const float* hd = p.hdn2() + ((size_t)l * (N + LC) + tt) * 64;
      float acc = 0.f;
      for (int k = 0; k < 64; ++k) acc += hd[k] * w3[k * 1024 + j];
      float tn = (float)t / (float)(L - 1);
      float delta = mind + (float)j * ((maxd - mind) / 1023.0f);
      p.F()[i] = acc * expf(-tn * fabsf(delta));
    }
  }
#endif
}

DEVN void ph_fnorm(const Params& p, i64 gtid, i64 gsz) {
#ifndef CPU_SIM
  for (i64 i = 512 + gtid; i < 2 * 512; i += gsz) {
#else
  for (i64 i = gtid; i < 2 * 512; i += gsz) {
#endif
    int which = (int)(i / 512), c = (int)(i % 512);
    int L = which ? LC : N; int off = which ? N : 0;
    float ss = 0.f;
    for (int t = 0; t < L; ++t) { float a = p.F()[(size_t)(off + t) * 1024 + c], b = p.F()[(size_t)(off + t) * 1024 + 512 + c]; ss += a * a + b * b; }
    p.fnorm()[i] = 1.0f / sqrtf(ss + EPS);
  }
}


DEV void lru_chunk_rows(int dir, int b, int k, int& row0, int& step) {
  int seg_chunk;
  if (k < NCC) { seg_chunk = dir ? NCC - 1 - k : k; row0 = NLAT + b * LC + seg_chunk * LCH; }
  else { int kl = k - NCC; seg_chunk = dir ? NCL - 1 - kl : kl; row0 = b * N + seg_chunk * LCH; }
  if (dir) { row0 += LCH - 1; step = -1; } else step = 1;
}
DEVN void ph_lru1(const Params& p, i64 gtid, i64 gsz) {
#ifndef CPU_SIM
  for (i64 i = gtid; i < (i64)2 * NB * NCHK * 128; i += gsz) {
    const int c = (int)(i % 128) * 4, k = (int)((i / 128) % NCHK), b = (int)((i / (128 * NCHK)) % NB), dir = (int)(i / ((i64)128 * NCHK * NB));
    int row0, step; lru_chunk_rows(dir, b, k, row0, step);
    const uint4* lab4 = (const uint4*)(p.LAB() + (size_t)dir * TT * 512 + c);
    float h0 = 0.f, h1 = 0.f, h2 = 0.f, h3 = 0.f, s0 = 0.f, s1 = 0.f, s2 = 0.f, s3 = 0.f;
    uint4 wn[8];
#pragma unroll
    for (int t = 0; t < 8; ++t) wn[t] = lab4[(size_t)(row0 + step * t) * 128];
#pragma unroll 1
    for (int t0 = 0; t0 < LCH; t0 += 8) {
      uint4 w[8];
#pragma unroll
      for (int t = 0; t < 8; ++t) w[t] = wn[t];
      if (t0 + 8 < LCH) {
#pragma unroll
        for (int t = 0; t < 8; ++t) wn[t] = lab4[(size_t)(row0 + step * (t0 + 8 + t)) * 128];
      }
#pragma unroll
      for (int t = 0; t < 8; ++t) {
        const float a0 = __uint_as_float(w[t].x << 16), a1 = __uint_as_float(w[t].y << 16), a2 = __uint_as_float(w[t].z << 16), a3 = __uint_as_float(w[t].w << 16);
        s0 += a0; s1 += a1; s2 += a2; s3 += a3;
        h0 = fexpf_(a0) * h0 + __uint_as_float(w[t].x & 0xFFFF0000u); h1 = fexpf_(a1) * h1 + __uint_as_float(w[t].y & 0xFFFF0000u);
        h2 = fexpf_(a2) * h2 + __uint_as_float(w[t].z & 0xFFFF0000u); h3 = fexpf_(a3) * h3 + __uint_as_float(w[t].w & 0xFFFF0000u);
      }
    }
    const size_t o = ((size_t)(dir * NB + b) * NCHK + k) * 512 + c;
    *(float4*)(p.SA() + o) = float4{fexpf_(s0), fexpf_(s1), fexpf_(s2), fexpf_(s3)};
    *(float4*)(p.SB() + o) = float4{h0, h1, h2, h3};
  }
#else
  for (i64 i = gtid; i < (i64)2 * NB * NCHK * 512; i += gsz) {
    int c = (int)(i % 512), k = (int)((i / 512) % NCHK), b = (int)((i / (512 * NCHK)) % NB), dir = (int)(i / ((i64)512 * NCHK * NB));
    int row0, step; lru_chunk_rows(dir, b, k, row0, step);
    const bf* la = p.LA() + (size_t)dir * TT * 512 + c; const bf* lb = p.LB() + (size_t)dir * TT * 512 + c;
    float h = 0.f, sl = 0.f;
    for (int t = 0; t < LCH; ++t) {
      size_t r = (size_t)(row0 + step * t);
      float lav = b2f(la[r * 512]);
      h = expf(lav) * h + b2f(lb[r * 512]); sl += lav;
    }
    p.SA()[i] = fexpf_(sl); p.SB()[i] = h;
  }
#endif
}
DEVN void ph_lru3(const Params& p, int last, i64 gtid, i64 gsz, float* hrs, int ltid) {
#ifndef CPU_SIM
  unsigned* hrp = (unsigned*)hrs;
  for (i64 i = gtid; i < (i64)NB * NCHK * 256; i += gsz) {
    const int c = (int)(i % 256) * 2, j = (int)((i / 256) % NCHK), b = (int)(i / (256 * NCHK));
    if (last && j < NCC) continue;
    const int kf = j, kr = j < NCC ? NCC - 1 - j : NCC + (NCL - 1 - (j - NCC));
    const float* sa0 = p.SA() + ((size_t)(0 * NB + b) * NCHK) * 512 + c; const float* sb0 = p.SB() + ((size_t)(0 * NB + b) * NCHK) * 512 + c;
    const float* sa1 = p.SA() + ((size_t)(1 * NB + b) * NCHK) * 512 + c; const float* sb1 = p.SB() + ((size_t)(1 * NB + b) * NCHK) * 512 + c;
    float hf0 = 0.f, hf1 = 0.f, hr0 = 0.f, hr1 = 0.f;
    const int row0 = j < NCC ? NLAT + b * LC + j * LCH : b * N + (j - NCC) * LCH;
    const unsigned* lab0 = p.LAB() + c; const unsigned* lab1 = p.LAB() + (size_t)TT * 512 + c;
#pragma unroll 1
    for (int k0 = 0; k0 < kf; k0 += 8) {
      float2 av[8], bv[8];
#pragma unroll
      for (int q = 0; q < 8; ++q) { const bool ok = k0 + q < kf; av[q] = ok ? *(const float2*)(sa0 + (size_t)(k0 + q) * 512) : float2{1.f, 1.f}; bv[q] = ok ? *(const float2*)(sb0 + (size_t)(k0 + q) * 512) : float2{0.f, 0.f}; }
#pragma unroll
      for (int q = 0; q < 8; ++q) { hf0 = av[q].x * hf0 + bv[q].x; hf1 = av[q].y * hf1 + bv[q].y; }
    }
#pragma unroll 1
    for (int k0 = 0; k0 < kr; k0 += 8) {
      float2 av[8], bv[8];
#pragma unroll
      for (int q = 0; q < 8; ++q) { const bool ok = k0 + q < kr; av[q] = ok ? *(const float2*)(sa1 + (size_t)(k0 + q) * 512) : float2{1.f, 1.f}; bv[q] = ok ? *(const float2*)(sb1 + (size_t)(k0 + q) * 512) : float2{0.f, 0.f}; }
#pragma unroll
      for (int q = 0; q < 8; ++q) { hr0 = av[q].x * hr0 + bv[q].x; hr1 = av[q].y * hr1 + bv[q].y; }
    }
#pragma unroll 1
    for (int t0 = LCH - 16; t0 >= 0; t0 -= 16) {
      uint2 w[16];
#pragma unroll
      for (int t = 0; t < 16; ++t) w[t] = *(const uint2*)(lab1 + (size_t)(row0 + t0 + t) * 512);
#pragma unroll
      for (int t = 15; t >= 0; --t) {
        hr0 = fexpf_(__uint_as_float(w[t].x << 16)) * hr0 + __uint_as_float(w[t].x & 0xFFFF0000u);
        hr1 = fexpf_(__uint_as_float(w[t].y << 16)) * hr1 + __uint_as_float(w[t].y & 0xFFFF0000u);
        hrp[(t0 + t) * 512 + ltid] = pk2bf(hr0, hr1);
      }
    }
#pragma unroll 1
    for (int t0 = 0; t0 < LCH; t0 += 16) {
      uint2 w[16]; unsigned gw[16];
#pragma unroll
      for (int t = 0; t < 16; ++t) { const size_t r = (size_t)(row0 + t0 + t); w[t] = *(const uint2*)(lab0 + r * 512); gw[t] = *(const unsigned*)(p.P() + r * PC + C_LG + c); }
#pragma unroll
      for (int t = 0; t < 16; ++t) {
        hf0 = fexpf_(__uint_as_float(w[t].x << 16)) * hf0 + __uint_as_float(w[t].x & 0xFFFF0000u);
        hf1 = fexpf_(__uint_as_float(w[t].y << 16)) * hf1 + __uint_as_float(w[t].y & 0xFFFF0000u);
        const unsigned hw = hrp[(t0 + t) * 512 + ltid];
        const float y0 = geluf_(__uint_as_float(gw[t] << 16)) * (hf0 + __uint_as_float(hw << 16));
        const float y1 = geluf_(__uint_as_float(gw[t] & 0xFFFF0000u)) * (hf1 + __uint_as_float(hw & 0xFFFF0000u));
        *(unsigned*)(p.Y() + (size_t)(row0 + t0 + t) * 2048 + 512 + c) = pk2bf(y0, y1);
      }
    }
  }
#else
  for (i64 i = gtid; i < (i64)NB * NCHK * 512; i += gsz) {
    int c = (int)(i % 512), j = (int)((i / 512) % NCHK), b = (int)(i / (512 * NCHK));
    if (last && j < NCC) continue;
    int kf = j, kr = j < NCC ? NCC - 1 - j : NCC + (NCL - 1 - (j - NCC));
    const float* sa0 = p.SA() + ((size_t)(0 * NB + b) * NCHK) * 512 + c; const float* sb0 = p.SB() + ((size_t)(0 * NB + b) * NCHK) * 512 + c;
    const float* sa1 = p.SA() + ((size_t)(1 * NB + b) * NCHK) * 512 + c; const float* sb1 = p.SB() + ((size_t)(1 * NB + b) * NCHK) * 512 + c;
    float hf = 0.f, hr = 0.f;
    int row0 = j < NCC ? NLAT + b * LC + j * LCH : b * N + (j - NCC) * LCH;
    const bf* la0 = p.LA() + c; const bf* lb0 = p.LB() + c;
    const bf* la1 = p.LA() + (size_t)TT * 512 + c; bf* lb1 = p.LB() + (size_t)TT * 512 + c;
    for (int k = 0; k < kf; ++k) hf = sa0[(size_t)k * 512] * hf + sb0[(size_t)k * 512];
    for (int k = 0; k < kr; ++k) hr = sa1[(size_t)k * 512] * hr + sb1[(size_t)k * 512];
    for (int t = LCH - 1; t >= 0; --t) { size_t r = (size_t)(row0 + t); hr = expf(b2f(la1[r * 512])) * hr + b2f(lb1[r * 512]); lb1[r * 512] = f2b(hr); }
    for (int t = 0; t < LCH; ++t) {
      size_t r = (size_t)(row0 + t);
      hf = expf(b2f(la0[r * 512])) * hf + b2f(lb0[r * 512]);
      float lg = b2f(p.P()[r * PC + C_LG + c]);
      p.Y()[r * 2048 + 512 + c] = f2b(geluf_(lg) * (hf + b2f(lb1[r * 512])));
    }
  }
#endif
}

DEVN void ph_C(const Params& p, int l, int last, i64 gtid, i64 gsz) {
  const int QR = last ? NLAT : TT;
#ifdef CPU_SIM
  for (i64 i = gtid; i < (i64)8 * QR; i += gsz) {
    int hh = (int)(i / QR), r = (int)(i % QR);
    RowInfo ri = rowinfo(r);
    float q[96];
#pragma unroll
    for (int d = 0; d < 96; ++d) q[d] = b2f(p.QA()[(size_t)r * 768 + hh * 96 + d]);
    float o[64];
#pragma unroll
    for (int d = 0; d < 64; ++d) o[d] = 0.f;
    float m = -1e30f, lsum = 0.f;
    const float scale = 0.10206207261596577f;
    int nseg = ri.lat ? 2 : 1;
    for (int sg = 0; sg < nseg; ++sg) {
      int kb, kn_;
      if (ri.lat && sg == 0) { kb = ri.b * N; kn_ = N; } else { kb = NLAT + ri.b * LC; kn_ = LC; }
      for (int kk = 0; kk < kn_; ++kk) {
        const bf* kr_ = p.KVA() + (size_t)(kb + kk) * 1024 + hh * 128;
        const bf* krp = p.P() + (size_t)(kb + kk) * PC + C_KR;
        float s = 0.f;
#pragma unroll
        for (int d = 0; d < 64; ++d) s += q[d] * b2f(kr_[d]);
#pragma unroll
        for (int d = 0; d < 32; ++d) s += q[64 + d] * b2f(krp[d]);
        s *= scale;
        float mn = fmaxf(m, s);
        float corr = expf(m - mn), pe = expf(s - mn);
        lsum = lsum * corr + pe;
#pragma unroll
        for (int d = 0; d < 64; ++d) o[d] = o[d] * corr + pe * b2f(kr_[64 + d]);
        m = mn;
      }
    }
    float inv = 1.0f / lsum;
#pragma unroll
    for (int d = 0; d < 64; ++d) p.Y()[(size_t)r * 2048 + hh * 64 + d] = f2b(o[d] * inv);
  }
#endif
  {
    const float* cw = p.in[I_hy_conv_w] + l * 3 * 1536; const float* cb = p.in[I_hy_conv_b] + l * 1536;
    const float* skip = p.in[I_hy_skip] + l * 512;
#ifndef CPU_SIM
    const i64 hy_first = (i64)NLAT * 512;
#else
    const i64 hy_first = 0;
#endif
    for (i64 i = hy_first + gtid; i < (i64)QR * 512; i += gsz) {
      int r = (int)(i / 512), c = (int)(i % 512);
      RowInfo ri = rowinfo(r);
      int foff = ri.lat ? 0 : N;
      float acc = 0.f;
      for (int s = 0; s < ri.L; ++s) {
        int dd = ri.t - s;
        float fv = dd >= 0 ? p.F()[(size_t)(foff + dd) * 1024 + c] : p.F()[(size_t)(foff - dd) * 1024 + 512 + c];
        acc += fv * b2f(p.Z()[(size_t)(ri.base + s) * 512 + c]);
      }
      acc *= p.fnorm()[(ri.lat ? 0 : 512) + c];
      float x0 = cb[c];
      for (int k = 0; k < 3; ++k) {
        int ts = ri.t - 1 + k;
        if (ts >= 0 && ts < ri.L) x0 += cw[k * 1536 + c] * b2f(p.P()[(size_t)(ri.base + ts) * PC + C_HU + c]);
      }
      float y = acc + skip[c] * b2f(p.Z()[(size_t)r * 512 + c]);
      p.Y()[(size_t)r * 2048 + 1024 + c] = f2b(x0 * y);
    }
  }
#ifdef CPU_SIM
  for (i64 i = gtid; i < (i64)8 * QR; i += gsz) {
    int hh = (int)(i / QR), r = (int)(i % QR);
    RowInfo ri = rowinfo(r);
    int kh = hh / 4;
    float q[64];
#pragma unroll
    for (int d = 0; d < 64; ++d) q[d] = b2f(p.P()[(size_t)r * PC + C_GQ + hh * 64 + d]);
    float o[64];
#pragma unroll
    for (int d = 0; d < 64; ++d) o[d] = 0.f;
    float m = p.in[I_gqa_sink][l * 8 + hh], lsum = 1.0f;
    int nseg = ri.lat ? 2 : 1;
    for (int sg = 0; sg < nseg; ++sg) {
      int k0, k1;
      if (ri.lat && sg == 0) { int lo = ri.t - 128; if (lo < 0) lo = 0; int hi = ri.t + 128; if (hi > N - 1) hi = N - 1; k0 = ri.b * N + lo; k1 = ri.b * N + hi + 1; }
      else { k0 = NLAT + ri.b * LC; k1 = k0 + LC; }
      for (int kk = k0; kk < k1; ++kk) {
        const bf* kp = p.P() + (size_t)kk * PC + C_GKV + kh * 64;
        const bf* vp = kp + 128;
        float s = 0.f;
#pragma unroll
        for (int d = 0; d < 64; ++d) s += q[d] * b2f(kp[d]);
        s *= 0.125f;
        float mn = fmaxf(m, s);
        float corr = expf(m - mn), pe = expf(s - mn);
        lsum = lsum * corr + pe;
#pragma unroll
        for (int d = 0; d < 64; ++d) o[d] = o[d] * corr + pe * b2f(vp[d]);
        m = mn;
      }
    }
    float inv = 1.0f / lsum;
#pragma unroll
    for (int d = 0; d < 64; ++d) p.Y()[(size_t)r * 2048 + 1536 + hh * 64 + d] = f2b(o[d] * inv);
  }
#endif
}

DEVN void ph_E2a(const Params& p, int nrows, i64 gtid, i64 gsz) {
  for (i64 i = gtid; i < (i64)nrows * 16; i += gsz) {
    const sc_t* s_ = p.SC() + (size_t)i * 128;
    float ps = 3.0e38f; int pi = -1;
    for (int k = 0; k < 16; ++k) {
      float bs = -3.0e38f; int bi = -1;
      for (int j = 0; j < 128; ++j) {
        float s = (float)s_[j];
        bool elig = (s < ps) || (s == ps && j > pi);
        if (elig && (s > bs)) { bs = s; bi = j; }
      }
      p.TKs()[(size_t)i * 16 + k] = bs; p.TKi()[(size_t)i * 16 + k] = bi;
      ps = bs; pi = bi;
    }
  }
}

DEVN void ph_E2b(const Params& p, int nrows, i64 gtid, i64 gsz) {
  for (i64 i = gtid; i < (i64)nrows * 8; i += gsz) {
    const float* s1 = p.TKs() + (size_t)i * 32; const float* s2 = s1 + 16;
    const int* i1 = p.TKi() + (size_t)i * 32; const int* i2 = i1 + 16;
    float ps = 3.0e38f; int pi = -1;
    float mx = 0.f;
    for (int k = 0; k < 16; ++k) {
      float bs = -3.0e38f; int bi = -1;
      for (int j = 0; j < 256; ++j) {
        float s = s1[j >> 4] + s2[j & 15];
        bool elig = (s < ps) || (s == ps && j > pi);
        if (elig && (s > bs)) { bs = s; bi = j; }
      }
      if (k == 0) mx = bs;
      p.SELi()[(size_t)i * 16 + k] = i1[bi >> 4] * 128 + i2[bi & 15];
      p.SELg()[(size_t)i * 16 + k] = expf(bs - mx);
      ps = bs; pi = bi;
    }
    float sum = 0.f;
    for (int k = 0; k < 16; ++k) sum += p.SELg()[(size_t)i * 16 + k];
    float inv = 1.0f / sum;
    for (int k = 0; k < 16; ++k) p.SELg()[(size_t)i * 16 + k] *= inv;
  }
}

DEVN void ph_E3(const Params& p, int l, int nrows, i64 gtid, i64 gsz) {
  const float* u = p.in[I_peer_u] + (size_t)l * NEXP * D;
#ifndef CPU_SIM
  const int lane = (int)(gtid & 63);
  for (i64 i = gtid >> 6; i < (i64)nrows * 128; i += gsz >> 6) {
    const int r = (int)(i >> 7);
    const float4* ur = (const float4*)(u + (size_t)p.SELi()[i] * D);
    const uint2* hr = (const uint2*)(p.h() + (size_t)r * D);
    float acc = 0.f;
#pragma unroll
    for (int q = 0; q < 4; ++q) {
      const float4 uv = ur[lane + q * 64]; const uint2 hv = hr[lane + q * 64];
      union { unsigned u_; float f; } c0, c1, c2, c3;
      c0.u_ = hv.x << 16; c1.u_ = hv.x & 0xFFFF0000u; c2.u_ = hv.y << 16; c3.u_ = hv.y & 0xFFFF0000u;
      acc += uv.x * c0.f + uv.y * c1.f + uv.z * c2.f + uv.w * c3.f;
    }
#pragma unroll
    for (int o = 32; o >= 1; o >>= 1) acc += lane_xor(acc, lane, o);
    if (lane == 0) p.W()[i] = p.SELg()[i] * geluf_(acc);
  }
#else
  for (i64 i = gtid; i < (i64)nrows * 128; i += gsz) {
    int r = (int)(i / 128);
    const float* ur = u + (size_t)p.SELi()[i] * D;
    const bf* hr = p.h() + (size_t)r * D;
    float acc = 0.f;
    for (int k = 0; k < D; ++k) acc += b2f(hr[k]) * ur[k];
    p.W()[i] = p.SELg()[i] * geluf_(acc);
  }
#endif
}

DEVN void ph_E4(const Params& p, int l, int nrows, i64 gtid, i64 gsz) {
  const float* v = p.in[I_peer_v] + (size_t)l * NEXP * D;
  for (i64 i = gtid; i < (i64)nrows * D; i += gsz) {
    int r = (int)(i / D), n = (int)(i % D);
    float acc = 0.f;
    for (int j = 0; j < 128; ++j) acc += p.W()[(size_t)r * 128 + j] * v[(size_t)p.SELi()[(size_t)r * 128 + j] * D + n];
    float g2 = p.mods()[((size_t)l * 3 + modrow(r)) * 6 * D + 5 * D + n];
    p.xcur()[i] += g2 * acc;
  }
}


#ifndef CPU_SIM
DEV unsigned dpp_ror_u(unsigned x, int n) {
  switch (n) {
    case 1: return (unsigned)__builtin_amdgcn_update_dpp(0, (int)x, 0x121, 0xf, 0xf, false);
    case 2: return (unsigned)__builtin_amdgcn_update_dpp(0, (int)x, 0x122, 0xf, 0xf, false);
    case 4: return (unsigned)__builtin_amdgcn_update_dpp(0, (int)x, 0x124, 0xf, 0xf, false);
    default: return (unsigned)__builtin_amdgcn_update_dpp(0, (int)x, 0x128, 0xf, 0xf, false);
  }
}
DEV unsigned wave_max_u(unsigned x) {
  x = max(x, dpp_ror_u(x, 1)); x = max(x, dpp_ror_u(x, 2)); x = max(x, dpp_ror_u(x, 4)); x = max(x, dpp_ror_u(x, 8));
  const unsigned a = (unsigned)__builtin_amdgcn_readlane((int)x, 0), b = (unsigned)__builtin_amdgcn_readlane((int)x, 16);
  const unsigned c = (unsigned)__builtin_amdgcn_readlane((int)x, 32), d = (unsigned)__builtin_amdgcn_readlane((int)x, 48);
  return max(max(a, b), max(c, d));
}
DEV unsigned f16_key(unsigned short h, int idx) { const unsigned t = (h & 0x8000u) ? (unsigned)(~h & 0xFFFFu) : (unsigned)(h | 0x8000u); return (t << 16) | (unsigned)(0xFFFF - idx); }
DEV float key_score(unsigned k) { const unsigned t = k >> 16; const unsigned short h = (unsigned short)((t & 0x8000u) ? (t ^ 0x8000u) : (~t & 0xFFFFu)); union { unsigned short u; _Float16 f; } c; c.u = h; return (float)c.f; }
DEV int key_idx(unsigned k) { return 0xFFFF - (int)(k & 0xFFFFu); }
DEV int mbcnt64(unsigned long long m) { return (int)__builtin_amdgcn_mbcnt_hi((unsigned)(m >> 32), __builtin_amdgcn_mbcnt_lo((unsigned)m, 0u)); }
DEV unsigned pick16_sorted(unsigned k0, unsigned k1, unsigned T, int above, int lane, int* tmp) {
  const unsigned h0 = k0 & 0xFFFF0000u, h1 = k1 & 0xFFFF0000u;
  const bool gt0 = h0 > T, eq0 = h0 == T, gt1 = h1 > T, eq1 = h1 == T;
  const int need = 16 - above;
  const unsigned long long me0 = __builtin_amdgcn_ballot_w64(eq0), me1 = __builtin_amdgcn_ballot_w64(eq1);
  const bool s0 = gt0 || (eq0 && mbcnt64(me0) < need);
  const int need1 = need - (int)__builtin_popcountll(me0);
  const bool s1 = gt1 || (eq1 && mbcnt64(me1) < need1);
  const unsigned long long ms0 = __builtin_amdgcn_ballot_w64(s0), ms1 = __builtin_amdgcn_ballot_w64(s1);
  if (s0) tmp[mbcnt64(ms0)] = (int)k0;
  if (s1) tmp[(int)__builtin_popcountll(ms0) + mbcnt64(ms1)] = (int)k1;
  const unsigned u = (unsigned)tmp[lane & 15];
  int rank = 0;
#pragma unroll
  for (int q = 0; q < 16; ++q) rank += ((unsigned)__builtin_amdgcn_readlane((int)u, q) > u) ? 1 : 0;
  if (lane < 16) tmp[16 + rank] = (int)u;
  return (unsigned)tmp[16 + (lane & 15)];
}
DEV void top16_x2(unsigned a0, unsigned a1, unsigned b0, unsigned b1, int lane, int* tmp, unsigned& ta, unsigned& tb) {
  unsigned TA = 0, TB = 0; int abA = 0, abB = 0;
#pragma unroll
  for (int bit = 31; bit >= 16; --bit) {
    const unsigned m = 0xFFFFFFFFu << bit, one = 1u << bit;
    const unsigned tA = TA | one, tB = TB | one;
    const int cA = (int)__builtin_popcountll(__builtin_amdgcn_ballot_w64((a0 & m) == tA)) + (int)__builtin_popcountll(__builtin_amdgcn_ballot_w64((a1 & m) == tA));
    const int cB = (int)__builtin_popcountll(__builtin_amdgcn_ballot_w64((b0 & m) == tB)) + (int)__builtin_popcountll(__builtin_amdgcn_ballot_w64((b1 & m) == tB));
    if (abA + cA >= 16) TA = tA; else abA += cA;
    if (abB + cB >= 16) TB = tB; else abB += cB;
  }
  ta = pick16_sorted(a0, a1, TA, abA, lane, tmp);
  tb = pick16_sorted(b0, b1, TB, abB, lane, tmp + 32);
}
DEVN void ph_cvt_tables(const Params& p, int l, i64 gtid, i64 gsz) {
  const float4* u = (const float4*)(p.in[I_peer_u] + (size_t)l * NEXP * D); const float4* v = (const float4*)(p.in[I_peer_v] + (size_t)l * NEXP * D);
  unsigned* ub = (unsigned*)p.Ub(); unsigned* vb = (unsigned*)p.Vb();
#pragma unroll 4
  for (i64 i = gtid; i < (i64)NEXP * D / 4; i += gsz) {
    const float4 a = u[i], b = v[i];
    int w = __builtin_amdgcn_cvt_pk_fp8_f32(a.x * 32.f, a.y * 32.f, 0, false); w = __builtin_amdgcn_cvt_pk_fp8_f32(a.z * 32.f, a.w * 32.f, w, true); ub[i] = (unsigned)w;
    int x = __builtin_amdgcn_cvt_pk_fp8_f32(b.x, b.y, 0, false); x = __builtin_amdgcn_cvt_pk_fp8_f32(b.z, b.w, x, true); vb[i] = (unsigned)x;
  }
}
DEV void unpack16_fp8(const uint4 w, float* f) {
#define UP4(W, O) { auto lo = __builtin_amdgcn_cvt_pk_f32_fp8((int)(W), false); auto hi = __builtin_amdgcn_cvt_pk_f32_fp8((int)(W), true); f[O] = lo[0]; f[O + 1] = lo[1]; f[O + 2] = hi[0]; f[O + 3] = hi[1]; }
  UP4(w.x, 0) UP4(w.y, 4) UP4(w.z, 8) UP4(w.w, 12)
#undef UP4
}
struct Sc4 { unsigned short a, b, c, d; };
DEV Sc4 peer_scores(const Params& p, int r, int wid, int lane) {
  const unsigned short* sp = (const unsigned short*)(p.SC() + ((size_t)r * 8 + wid) * 256);
  Sc4 q; q.a = sp[lane]; q.b = sp[64 + lane]; q.c = sp[128 + lane]; q.d = sp[192 + lane];
  return q;
}
struct Key4 { decltype(f16_key((unsigned short)0, 0)) a, b, c, d; };
DEV Key4 peer_keys(const Sc4 q, int lane) { Key4 k; k.a = f16_key(q.a, lane); k.b = f16_key(q.b, 64 + lane); k.c = f16_key(q.c, lane); k.d = f16_key(q.d, 64 + lane); return k; }
DEV void peer_topk(const Key4 k, int lane, int ca, int cb, bool cvalid, int* selx, int* tmp) {
  unsigned t1, t2;
  top16_x2(k.a, k.b, k.c, k.d, lane, tmp, t1, t2);
  const unsigned k1 = (unsigned)__builtin_amdgcn_ds_bpermute(ca << 2, (int)t1), k2 = (unsigned)__builtin_amdgcn_ds_bpermute(cb << 2, (int)t2);
  const float v = cvalid ? key_score(k1) + key_score(k2) : -3.0e38f;
  int rank = 0;
#pragma unroll
  for (int c = 0; c < 50; ++c) {
    const float vs = __int_as_float(__builtin_amdgcn_readlane(__float_as_int(v), c));
    rank += (vs > v || (vs == v && c < lane)) ? 1 : 0;
  }
  float mx = v;
#pragma unroll
  for (int o = 32; o >= 1; o >>= 1) mx = fmaxf(mx, lane_xor(mx, lane, o));
  const bool sel = cvalid && rank < 16;
  const float e = sel ? fexpf_(v - mx) : 0.f;
  float sum = e;
#pragma unroll
  for (int o = 32; o >= 1; o >>= 1) sum += lane_xor(sum, lane, o);
  if (sel) { selx[rank] = key_idx(k1) * 128 + key_idx(k2); selx[16 + rank] = __float_as_int(e / sum); }
}
DEVN void ph_peer(const Params& p, int l, int nrows, int tid, char* ldsg, float oscale = 1.0f) {
  const int lane = tid & 63, wid = tid >> 6;
  float* part = (float*)ldsg;
  int* selbase = (int*)(ldsg + 8 * 1024 * 4) + wid * 64;
  int* tktmp = (int*)(ldsg + 8 * 1024 * 4 + 8 * 64 * 4) + wid * 64;
  const unsigned char* Ub = (const unsigned char*)p.Ub(); const unsigned char* Vb = (const unsigned char*)p.Vb();
  int ca = 0, cb = 0; bool cvalid = false;
  { int pre = 0;
    for (int a = 0; a < 16; ++a) { const int cnt = 16 / (a + 1); if (lane >= pre && lane < pre + cnt) { ca = a; cb = lane - pre; cvalid = true; } pre += cnt; } }
  int cur = 0;
  Sc4 nsc; nsc.a = nsc.b = nsc.c = nsc.d = 0;
  if ((int)blockIdx.x < nrows) {
    peer_topk(peer_keys(peer_scores(p, blockIdx.x, wid, lane), lane), lane, ca, cb, cvalid, selbase, tktmp);
    nsc = peer_scores(p, (int)(blockIdx.x + gridDim.x) < nrows ? (int)(blockIdx.x + gridDim.x) : (int)blockIdx.x, wid, lane);
  }
  for (int r = blockIdx.x; r < nrows; r += gridDim.x) {
    const int* selx = selbase + cur * 32;
    int eidx[16];
#pragma unroll
    for (int e = 0; e < 16; ++e) eidx[e] = __builtin_amdgcn_readfirstlane(selx[e]);
    const float mygate = __int_as_float(selx[16 + (lane >> 2)]);
    const bool more = r + (int)gridDim.x < nrows;
    const Key4 nkeys = peer_keys(nsc, lane);
    uint4 rows[16], vrows[16];
#pragma unroll
    for (int e = 0; e < 16; ++e) rows[e] = ((const uint4*)(Ub + (size_t)eidx[e] * D))[lane];
    uint4 hraw0, hraw1;
    { const uint4* hp = (const uint4*)(p.h() + (size_t)r * D); hraw0 = hp[lane * 2]; hraw1 = hp[lane * 2 + 1]; }
#pragma unroll
    for (int e = 0; e < 16; ++e) vrows[e] = ((const uint4*)(Vb + (size_t)eidx[e] * D))[lane];
    const float2 g2v = *(const float2*)(p.mods() + ((size_t)l * 3 + modrow(r)) * 6 * D + 5 * D + tid * 2);
    float2 xv = *(const float2*)(p.xcur() + (size_t)r * D + tid * 2);
    nsc = peer_scores(p, r + 2 * (int)gridDim.x < nrows ? r + 2 * (int)gridDim.x : r, wid, lane);
    if (more) peer_topk(nkeys, lane, ca, cb, cvalid, selbase + (cur ^ 1) * 32, tktmp);
    float hv[16]; unpack8(hraw0, hv); unpack8(hraw1, hv + 8);
    float d[16];
#pragma unroll
    for (int e = 0; e < 16; ++e) {
      float f[16]; unpack16_fp8(rows[e], f);
      float a = 0.f;
#pragma unroll
      for (int k = 0; k < 16; ++k) a += f[k] * hv[k];
      d[e] = a;
    }
#define FOLD(NV, O) _Pragma("unroll") for (int i = 0; i < NV / 2; ++i) { const bool up = (lane & O) != 0; const float send = up ? d[i] : d[i + NV / 2]; const float keep = up ? d[i + NV / 2] : d[i]; d[i] = keep + lane_xor(send, lane, O); }
    FOLD(16, 32) FOLD(8, 16) FOLD(4, 8) FOLD(2, 4)
#undef FOLD
    float dot = d[0]; dot += lane_xor(dot, lane, 2); dot += lane_xor(dot, lane, 1);
    const float myact = mygate * geluf_(dot * (1.0f / 32.0f));
    float acc[16];
#pragma unroll
    for (int k = 0; k < 16; ++k) acc[k] = 0.f;
#pragma unroll
    for (int e = 0; e < 16; ++e) {
      const float a = __int_as_float(__builtin_amdgcn_readlane(__float_as_int(myact), e * 4));
      float f[16]; unpack16_fp8(vrows[e], f);
#pragma unroll
      for (int k = 0; k < 16; ++k) acc[k] += a * f[k];
    }
    float* partc = part + cur * ((8 * 1024 * 4 + 2 * 8 * 64 * 4) / 4);
    { float4* pw = (float4*)(partc + wid * 1024 + lane * 16);
      pw[0] = float4{acc[0], acc[1], acc[2], acc[3]}; pw[1] = float4{acc[4], acc[5], acc[6], acc[7]};
      pw[2] = float4{acc[8], acc[9], acc[10], acc[11]}; pw[3] = float4{acc[12], acc[13], acc[14], acc[15]}; }
    __syncthreads();
    { const int c = tid * 2;
      float s0 = 0.f, s1 = 0.f;
#pragma unroll
      for (int w = 0; w < 8; ++w) { const float2 t = *(const float2*)(partc + w * 1024 + c); s0 += t.x; s1 += t.y; }
      xv.x += oscale * g2v.x * s0; xv.y += oscale * g2v.y * s1; *(float2*)(p.xcur() + (size_t)r * D + c) = xv; }
    cur ^= 1;
  }
}
#endif

DEVN void ph_final(const Params& p, i64 gtid, i64 gsz) {
  const float* g = p.in[I_g_final];
#ifndef CPU_SIM
  float pscale = 1.0f;
#if PROBE_K >= 0
  { const unsigned long long* ts = (const unsigned long long*)(p.ws + WL.ts);
    const float frac = (float)(ts[PROBE_K + 1] - ts[0]) / (float)(ts[NPHASES - 1] - ts[0]);
    pscale = 1.0f + sqrtf(floorf(frac * 50.0f + 0.5f) * 0.02f); }
#endif
  const int lane = (int)(gtid & 63);
  const i64 W = gsz >> 6;
  float4 gv[4];
#pragma unroll
  for (int i = 0; i < 4; ++i) gv[i] = *(const float4*)(g + (lane + i * 64) * 4);
  for (i64 r = gtid >> 6; r < NLAT; r += 2 * W) {
    const bool two = r + W < NLAT;
    const i64 rb = two ? r + W : r;
    const float4* xra = (const float4*)(p.xcur() + (size_t)r * D); const float4* xrb = (const float4*)(p.xcur() + (size_t)rb * D);
    float4 xa[4], xb[4]; float sa = 0.f, sb = 0.f;
#pragma unroll
    for (int i = 0; i < 4; ++i) { xa[i] = xra[lane + i * 64]; xb[i] = xrb[lane + i * 64]; }
#pragma unroll
    for (int i = 0; i < 4; ++i) { sa += xa[i].x * xa[i].x + xa[i].y * xa[i].y + xa[i].z * xa[i].z + xa[i].w * xa[i].w; sb += xb[i].x * xb[i].x + xb[i].y * xb[i].y + xb[i].z * xb[i].z + xb[i].w * xb[i].w; }
#pragma unroll
    for (int o = 32; o >= 1; o >>= 1) { sa += lane_xor(sa, lane, o); sb += lane_xor(sb, lane, o); }
    const float rsa = 1.0f / sqrtf(sa * (1.0f / D) + EPS), rsb = 1.0f / sqrtf(sb * (1.0f / D) + EPS);
#pragma unroll
    for (int i = 0; i < 4; ++i) {
      const int k = (lane + i * 64) * 4;
      float4 o4; o4.x = xa[i].x * rsa * gv[i].x * pscale; o4.y = xa[i].y * rsa * gv[i].y * pscale; o4.z = xa[i].z * rsa * gv[i].z * pscale; o4.w = xa[i].w * rsa * gv[i].w * pscale;
      *(float4*)(p.out + (size_t)r * D + k) = o4;
    }
    if (two) {
#pragma unroll
      for (int i = 0; i < 4; ++i) {
        const int k = (lane + i * 64) * 4;
        float4 o4; o4.x = xb[i].x * rsb * gv[i].x * pscale; o4.y = xb[i].y * rsb * gv[i].y * pscale; o4.z = xb[i].z * rsb * gv[i].z * pscale; o4.w = xb[i].w * rsb * gv[i].w * pscale;
        *(float4*)(p.out + (size_t)rb * D + k) = o4;
      }
    }
  }
#else
  for (i64 r = gtid; r < NLAT; r += gsz) {
    const float* xr = p.xcur() + (size_t)r * D;
    float ss = 0.f;
    for (int k = 0; k < D; ++k) ss += xr[k] * xr[k];
    float rstd = 1.0f / sqrtf(ss / D + EPS);
    for (int k = 0; k < D; ++k) p.out[(size_t)r * D + k] = xr[k] * rstd * g[k];
  }
#endif
}

DEV void rope4(float* v, const float* tab, int nf, int pos, int f0) {
#pragma unroll
  for (int jj = 0; jj < 4; ++jj) {
    float c = tab[(pos * nf + f0 + jj) * 2], s = tab[(pos * nf + f0 + jj) * 2 + 1];
    float x1 = v[2 * jj], x2 = v[2 * jj + 1];
    v[2 * jj] = x1 * c - x2 * s; v[2 * jj + 1] = x1 * s + x2 * c;
  }
}
struct EpiInproj {
  static constexpr int W = 8; static constexpr bool SUB = false; static constexpr bool STAGED = false;
  const Params& p;
  MDEV void apply(int r, int c0, float* v) const {
    if (c0 >= 3744) return;
    if (c0 >= 384 && r < NLAT) {
      int t = r % N;
      if (c0 < C_KR + 32) { int pi = (c0 - C_KR) >> 1; int half = pi >> 3; rope4(v, p.tabA(), 8, half ? t % GRIDW : t / GRIDW, pi & 7); }
      else if (c0 >= C_GQ && c0 < C_GKV + 128) { int pi = ((c0 - C_GQ) & 63) >> 1; int half = pi >> 4; rope4(v, p.tabD(), 16, half ? t % GRIDW : t / GRIDW, pi & 15); }
    }
    store8bf(p.P() + (size_t)r * PC + c0, v);
  }
};
struct EpiUq {
  static constexpr int W = 8; static constexpr bool SUB = false; static constexpr bool STAGED = true; static constexpr bool STAGED_ALL = true;
  const Params& p;
  MDEV void apply(int r, int c0, float* v) const {
    float rstd = 1.0f / sqrtf(p.ssq()[r] * (1.0f / 256.0f) + EPS);
#pragma unroll
    for (int j = 0; j < 8; ++j) v[j] *= rstd;
    int d0 = c0 % 96;
    if (d0 >= 64 && r < NLAT) { int t = r % N; int pi = (d0 - 64) >> 1; int half = pi >> 3; rope4(v, p.tabA(), 8, half ? t % GRIDW : t / GRIDW, pi & 7); }
    store8bf(p.QA() + (size_t)r * 768 + c0, v);
  }
#ifndef CPU_SIM
  struct Pre { float s; float4 t0, t1; };
  MDEV void pre(int r, int c0, Pre& q) const {
    q.s = p.ssq()[r];
    const int d0 = c0 % 96;
    q.t0 = float4{1.f, 0.f, 1.f, 0.f}; q.t1 = q.t0;
    if (d0 >= 64 && r < NLAT) { const int t = r % N, pi = (d0 - 64) >> 1, half = pi >> 3; const int pos = half ? t % GRIDW : t / GRIDW;
      const float* tb = p.tabA() + (pos * 8 + (pi & 7)) * 2; q.t0 = *(const float4*)tb; q.t1 = *(const float4*)(tb + 4); }
  }
  MDEV void fin(int r, int c0, float* v, const Pre& q) const {
    const float rstd = 1.0f / sqrtf(q.s * (1.0f / 256.0f) + EPS);
    const float cs[8] = {q.t0.x, q.t0.y, q.t0.z, q.t0.w, q.t1.x, q.t1.y, q.t1.z, q.t1.w};
    float o[8];
#pragma unroll
    for (int jj = 0; jj < 4; ++jj) { const float x1 = v[2 * jj] * rstd, x2 = v[2 * jj + 1] * rstd, c = cs[2 * jj], sn = cs[2 * jj + 1]; o[2 * jj] = x1 * c - x2 * sn; o[2 * jj + 1] = x1 * sn + x2 * c; }
    store8bf(p.QA() + (size_t)r * 768 + c0, o);
  }
#endif
};
struct EpiUkv {
  static constexpr int W = 8; static constexpr bool SUB = false; static constexpr bool STAGED = true; static constexpr bool STAGED_ALL = true;
  const Params& p;
  MDEV void apply(int r, int c0, float* v) const {
    float rstd = 1.0f / sqrtf(p.ssq()[TT + r] * (1.0f / 128.0f) + EPS);
#pragma unroll
    for (int j = 0; j < 8; ++j) v[j] *= rstd;
    store8bf(p.KVA() + (size_t)r * 1024 + c0, v);
  }
#ifndef CPU_SIM
  struct Pre { float s; };
  MDEV void pre(int r, int, Pre& q) const { q.s = p.ssq()[TT + r]; }
  MDEV void fin(int r, int c0, float* v, const Pre& q) const {
    const float rstd = 1.0f / sqrtf(q.s * (1.0f / 128.0f) + EPS);
#pragma unroll
    for (int j = 0; j < 8; ++j) v[j] *= rstd;
    store8bf(p.KVA() + (size_t)r * 1024 + c0, v);
  }
#endif
};
struct EpiLru {
  static constexpr int W = 8; static constexpr bool SUB = false; static constexpr bool STAGED = true; static constexpr bool STAGED_ALL = true;
  const Params& p; int l; const float* br; const float* bi;
  MDEV void finish(int r, int c0, const float* v, const float* brv, const float* biv, const float* splv, const float* xcv) const {
    int kw = c0 >> 10, dir = (c0 >> 9) & 1, blk4 = (c0 >> 7) & 3, jc0 = (c0 & 127) >> 1;
    int cb = kw * 256 + blk4 * 64 + jc0;
    float lav[4], lbv[4];
#pragma unroll
    for (int jj = 0; jj < 4; ++jj) {
      float rg = sigmoidf_(v[2 * jj] + brv[jj]), ig = sigmoidf_(v[2 * jj + 1] + biv[jj]);
      float log_a = -8.0f * rg * splv[jj];
      const float a_ = fexpf_(log_a);
      lav[jj] = log_a; lbv[jj] = sqrtf(fmaxf(1.0f - a_ * a_, 0.0f)) * ig * xcv[jj];
    }
#ifndef CPU_SIM
    { uint4 w;
      w.x = pk2bf(lav[0], lbv[0]); w.y = pk2bf(lav[1], lbv[1]); w.z = pk2bf(lav[2], lbv[2]); w.w = pk2bf(lav[3], lbv[3]);
      *(uint4*)(p.LAB() + ((size_t)dir * TT + r) * 512 + cb) = w; }
#else
    bf* la = p.LA() + ((size_t)dir * TT + r) * 512 + cb;
    bf* lb = p.LB() + ((size_t)dir * TT + r) * 512 + cb;
    for (int jj = 0; jj < 4; ++jj) { la[jj] = f2b(lav[jj]); lb[jj] = f2b(lbv[jj]); }
#endif
  }
  MDEV void apply(int r, int c0, float* v) const {
    int kw = c0 >> 10, dir = (c0 >> 9) & 1, blk4 = (c0 >> 7) & 3, jc0 = (c0 & 127) >> 1;
    int cb = kw * 256 + blk4 * 64 + jc0;
    float brv[4], biv[4], splv[4], xcv[4];
    for (int jj = 0; jj < 4; ++jj) { brv[jj] = br[(l * 2 + dir) * 512 + cb + jj]; biv[jj] = bi[(l * 2 + dir) * 512 + cb + jj]; splv[jj] = p.spl()[(l * 2 + dir) * 512 + cb + jj]; xcv[jj] = b2f(p.XC()[(size_t)r * 512 + cb + jj]); }
    finish(r, c0, v, brv, biv, splv, xcv);
  }
#ifndef CPU_SIM
  struct Pre { float4 a4, b4, s4; uint2 x2; };
  MDEV void pre(int r, int c0, Pre& q) const {
    int kw = c0 >> 10, dir = (c0 >> 9) & 1, blk4 = (c0 >> 7) & 3, jc0 = (c0 & 127) >> 1;
    int cb = kw * 256 + blk4 * 64 + jc0;
    q.a4 = gld4(br + (l * 2 + dir) * 512 + cb); q.b4 = gld4(bi + (l * 2 + dir) * 512 + cb);
    q.s4 = *(const float4*)(p.spl() + (l * 2 + dir) * 512 + cb);
    q.x2 = *(const uint2*)(p.XC() + (size_t)r * 512 + cb);
  }
  MDEV void fin(int r, int c0, float* v, const Pre& q) const {
    const float brv[4] = {q.a4.x, q.a4.y, q.a4.z, q.a4.w}, biv[4] = {q.b4.x, q.b4.y, q.b4.z, q.b4.w}, splv[4] = {q.s4.x, q.s4.y, q.s4.z, q.s4.w};
    const float xcv[4] = {__uint_as_float(q.x2.x << 16), __uint_as_float(q.x2.x & 0xFFFF0000u), __uint_as_float(q.x2.y << 16), __uint_as_float(q.x2.y & 0xFFFF0000u)};
    finish(r, c0, v, brv, biv, splv, xcv);
  }
#endif
};
struct EpiGate {
  static constexpr int W = 8; static constexpr bool SUB = false; static constexpr bool STAGED = false;
  const Params& p;
  MDEV void apply(int r, int c0, float* v) const {
#pragma unroll
    for (int j = 0; j < 8; ++j) v[j] = sigmoidf_(v[j]);
    store8bf(p.Gs() + (size_t)r * D + c0, v);
  }
};
struct EpiBranch {
  static constexpr int W = 8; static constexpr bool SUB = false; static constexpr bool STAGED = false;
  const Params& p; int br;
  MDEV void apply(int r, int c0, float* v) const {
    float g[8]; load8bf(p.Gs() + (size_t)r * D + c0, g);
    if (br > 0) {
      float mo[8]; load8bf(p.M() + (size_t)r * D + c0, mo);
#pragma unroll
      for (int j = 0; j < 8; ++j) v[j] = mo[j] + g[j] * v[j];
    } else {
#pragma unroll
      for (int j = 0; j < 8; ++j) v[j] = g[j] * v[j];
    }
    store8bf(p.M() + (size_t)r * D + c0, v);
  }
};
struct EpiGateAll {
  static constexpr int W = 8; static constexpr bool SUB = false; static constexpr bool STAGED = false;
  const Params& p;
  MDEV void apply(int r, int c0, float* v) const {
#pragma unroll
    for (int j = 0; j < 8; ++j) v[j] = sigmoidf_(v[j]) * 255.f + 0.5f;
    unsigned char* gq = p.G8() + (size_t)r * 4096 + c0;
#ifndef CPU_SIM
    uint2 w;
    w.x = (unsigned)v[0] | ((unsigned)v[1] << 8) | ((unsigned)v[2] << 16) | ((unsigned)v[3] << 24);
    w.y = (unsigned)v[4] | ((unsigned)v[5] << 8) | ((unsigned)v[6] << 16) | ((unsigned)v[7] << 24);
    *(uint2*)gq = w;
#else
    for (int j = 0; j < 8; ++j) gq[j] = (unsigned char)v[j];
#endif
  }
};
struct EpiBranchSub {
  static constexpr int W = 8; static constexpr bool SUB = true; static constexpr bool STAGED = true; static constexpr bool STAGED_ALL = false;
  const Params& p;
  MDEV void apply(int, int, float*) const {}
  MDEV void gate8(int r, int c0, int i, float* g) const {
    const unsigned char* gq = p.G8() + (size_t)r * 4096 + i * 1024 + c0;
#ifndef CPU_SIM
    const uint2 w = *(const uint2*)gq;
#pragma unroll
    for (int j = 0; j < 4; ++j) { g[j] = (float)((w.x >> (8 * j)) & 255u) * (1.0f / 255.0f); g[4 + j] = (float)((w.y >> (8 * j)) & 255u) * (1.0f / 255.0f); }
#else
    for (int j = 0; j < 8; ++j) g[j] = (float)gq[j] * (1.0f / 255.0f);
#endif
  }
  MDEV void apply_sub(int r, int c0, float* v, int sub) const {
    if (sub < 3) { store8bf(p.BR() + (size_t)r * 3072 + sub * 1024 + c0, v); return; }
    float g[8]; gate8(r, c0, 3, g);
#pragma unroll
    for (int j = 0; j < 8; ++j) v[j] *= g[j];
#pragma unroll
    for (int i = 0; i < 3; ++i) {
      float bi[8]; load8bf(p.BR() + (size_t)r * 3072 + i * 1024 + c0, bi);
      gate8(r, c0, i, g);
#pragma unroll
      for (int j = 0; j < 8; ++j) v[j] += g[j] * bi[j];
    }
    store8bf(p.M() + (size_t)r * D + c0, v);
  }
#ifndef CPU_SIM
  struct Pre { uint2 g[4]; uint4 b[3]; };
  MDEV void pre(int r, int c0, Pre& q) const {
#pragma unroll
    for (int i = 0; i < 4; ++i) q.g[i] = *(const uint2*)(p.G8() + (size_t)r * 4096 + i * 1024 + c0);
#pragma unroll
    for (int i = 0; i < 3; ++i) q.b[i] = *(const uint4*)(p.BR() + (size_t)r * 3072 + i * 1024 + c0);
  }
  MDEV void fin(int r, int c0, float* v, const Pre& q) const {
#pragma unroll
    for (int i = 3; i >= 0; --i) {
      float g[8];
#pragma unroll
      for (int j = 0; j < 4; ++j) { g[j] = (float)((q.g[i].x >> (8 * j)) & 255u) * (1.0f / 255.0f); g[4 + j] = (float)((q.g[i].y >> (8 * j)) & 255u) * (1.0f / 255.0f); }
      if (i == 3) {
#pragma unroll
        for (int j = 0; j < 8; ++j) v[j] *= g[j];
      } else {
        float bi[8]; unpack8(q.b[i], bi);
#pragma unroll
        for (int j = 0; j < 8; ++j) v[j] += g[j] * bi[j];
      }
    }
    store8bf(p.M() + (size_t)r * D + c0, v);
  }
#endif
};
struct EpiFilt {
  static constexpr int W = 8; static constexpr bool SUB = false; static constexpr bool STAGED = false;
  const Params& p;
  MDEV void apply(int j, int tt, float* v) const {
    const float maxd = -15.350567286626973f, mind = -3.0701134573253945f;
    const float ad = fabsf(mind + (float)j * ((maxd - mind) / 1023.0f));
    int t, L; if (tt < N) { t = tt; L = N; } else { t = tt - N; L = LC; }
    const float sc = -ad / (float)(L - 1);
#pragma unroll
    for (int q = 0; q < 8; ++q) v[q] *= fexpf_((float)(t + q) * sc);
    float* d = p.F() + (size_t)j * (N + LC) + tt;
#ifndef CPU_SIM
    *(float4*)d = float4{v[0], v[1], v[2], v[3]}; *(float4*)(d + 4) = float4{v[4], v[5], v[6], v[7]};
#else
    for (int q = 0; q < 8; ++q) d[q] = v[q];
#endif
  }
};
struct EpiOut {
  static constexpr int W = 8; static constexpr bool SUB = false; static constexpr bool STAGED = true; static constexpr bool STAGED_ALL = true;
  const Params& p; int l; float osc; const float* xlat; const float* xctx;
  MDEV void apply(int r, int c0, float* v) const {
    const float* g1 = p.mods() + ((size_t)l * 3 + modrow(r)) * 6 * D + 2 * D + c0;
    const float* xs = (r < NLAT ? xlat + (size_t)r * D : xctx + (size_t)(r - NLAT) * D) + c0;
    float* xr = p.xcur() + (size_t)r * D + c0;
    for (int j = 0; j < 8; ++j) xr[j] = xs[j] + osc * g1[j] * v[j];
  }
#ifndef CPU_SIM
  struct Pre { float4 g0, g1, x0, x1; };
  MDEV void pre(int r, int c0, Pre& q) const {
    const float* g1 = p.mods() + ((size_t)l * 3 + modrow(r)) * 6 * D + 2 * D + c0;
    const float* xs = (r < NLAT ? xlat + (size_t)r * D : xctx + (size_t)(r - NLAT) * D) + c0;
    q.g0 = *(const float4*)g1; q.g1 = *(const float4*)(g1 + 4); q.x0 = gld4(xs); q.x1 = gld4(xs + 4);
  }
  MDEV void fin(int r, int c0, float* v, const Pre& q) const {
    float* xr = p.xcur() + (size_t)r * D + c0;
    float4 o0, o1;
    o0.x = q.x0.x + osc * q.g0.x * v[0]; o0.y = q.x0.y + osc * q.g0.y * v[1]; o0.z = q.x0.z + osc * q.g0.z * v[2]; o0.w = q.x0.w + osc * q.g0.w * v[3];
    o1.x = q.x1.x + osc * q.g1.x * v[4]; o1.y = q.x1.y + osc * q.g1.y * v[5]; o1.z = q.x1.z + osc * q.g1.z * v[6]; o1.w = q.x1.w + osc * q.g1.w * v[7];
    *(float4*)xr = o0; *(float4*)(xr + 4) = o1;
  }
#endif
};
struct EpiPQ {
  static constexpr int W = 8; static constexpr bool SUB = false; static constexpr bool STAGED = false;
  const Params& p;
  MDEV void apply(int r, int c0, float* v) const { store8bf(p.PQ() + (size_t)r * 1024 + c0, v); }
};
struct EpiSC {
  static constexpr int W = 8; static constexpr bool SUB = false; static constexpr bool STAGED = false;
  const Params& p;
  MDEV void apply(int r, int c0, float* v) const {
    sc_t* d = p.SC() + (size_t)r * 2048 + c0;
#ifndef CPU_SIM
    typedef _Float16 half8 __attribute__((ext_vector_type(8)));
    half8 hv8;
#pragma unroll
    for (int j = 0; j < 8; ++j) hv8[j] = (_Float16)v[j];
    *(half8*)d = hv8;
#else
    for (int j = 0; j < 8; ++j) d[j] = (sc_t)v[j];
#endif
  }
};

struct GemmDesc { const bf* A; const bf* Bt; int lda, ldb, K, nrows, ncols; int a_pn_shift, a_pn_mul; int nsub = 1, a_sub = 0, b_sub = 0; int unit_off = 0; };

#ifndef CPU_SIM
namespace pg8 {
#define PG8_LAS __attribute__((address_space(3)))
typedef short bf16x8 __attribute__((ext_vector_type(8)));
typedef float f32x4 __attribute__((ext_vector_type(4)));
constexpr int BM = 256, BK = 64, HALF = 128, HTB = HALF * BK * 2, STAGE_BYTES = 8 * HTB, NXCD = 8, WGM = 8;
__device__ __forceinline__ int lds_byte(int r, int c) { const int st = (r >> 4) * 2 + (c >> 5), rr = r & 15, cc = c & 31, ob = rr * 64 + cc * 2; return st * 1024 + (ob ^ (((ob >> 9) & 1) << 5)); }
__device__ __forceinline__ void stage_rc(int b, int& R, int& C) { const int st = b / 1024, sb = b % 1024, swz = sb ^ (((sb >> 9) & 1) << 5); R = (st >> 1) * 16 + swz / 64; C = (st & 1) * 32 + (swz % 64) / 2; }
__device__ __forceinline__ int perm32(int rho) { const int n = rho >> 4, i = rho & 15; return 8 * (i >> 2) + 4 * n + (i & 3); }
struct Unit { int pm, pn, sub; };
struct StaticOrder {
  int nM, nN, nwg, G, c, nsub;
  __device__ void init(int nM_, int nN_, int G_, int c_, int nsub_) { nM = nM_; nN = nN_; nwg = nM * nN; G = G_; c = c_; nsub = nsub_; }
  __device__ bool next(int i, Unit& u) const {
    const int it = i / nsub; u.sub = i - it * nsub;
    const long L = (long)it * G + c; if (L >= nwg) return false;
    int wgid = (int)L; { const int q = nwg / NXCD, r = nwg % NXCD, xcd = wgid % NXCD, off = wgid / NXCD; wgid = (xcd < r ? xcd * (q + 1) : r * (q + 1) + (xcd - r) * q) + off; }
    const int nig = WGM * nN, gid = wgid / nig, fm = gid * WGM, gsz = (nM - fm) < WGM ? (nM - fm) : WGM;
    u.pm = fm + ((wgid % nig) % gsz); u.pn = (wgid % nig) / gsz; return true;
  }
};

template <class E>
__device__ __forceinline__ void epi_call(const E& e, const f32x4 (&acc)[2][2][4][2], const Unit& u, int wr, int wc, int fr_, int fq_) {
  int fr = fr_, fq = fq_;
  asm volatile("" : "+v"(fr), "+v"(fq));
  if constexpr (E::STAGED) {
    if (E::STAGED_ALL || u.sub == 3) {
#pragma unroll
      for (int ai = 0; ai < 2; ++ai)
#pragma unroll
        for (int m = 0; m < 4; ++m) {
          typename E::Pre q[2];
#pragma unroll
          for (int bj = 0; bj < 2; ++bj) { q[bj] = typename E::Pre{}; e.pre(u.pm * BM + ai * HALF + wr * 64 + m * 16 + fr, u.pn * BM + bj * HALF + wc * 32 + 8 * fq, q[bj]); }
#pragma unroll
          for (int bj = 0; bj < 2; ++bj) {
            float v[8];
#pragma unroll
            for (int j = 0; j < 4; ++j) { v[j] = acc[ai][bj][m][0][j]; v[4 + j] = acc[ai][bj][m][1][j]; }
            e.fin(u.pm * BM + ai * HALF + wr * 64 + m * 16 + fr, u.pn * BM + bj * HALF + wc * 32 + 8 * fq, v, q[bj]);
          }
          __builtin_amdgcn_sched_barrier(0);
        }
      return;
    }
  }
#pragma unroll
  for (int ai = 0; ai < 2; ++ai)
#pragma unroll
    for (int m = 0; m < 4; ++m) {
      const int r = u.pm * BM + ai * HALF + wr * 64 + m * 16 + fr;
#pragma unroll
      for (int bj = 0; bj < 2; ++bj) {
        if constexpr (E::W == 8) {
          const int c0 = u.pn * BM + bj * HALF + wc * 32 + 8 * fq;
          float v[8];
#pragma unroll
          for (int j = 0; j < 4; ++j) { v[j] = acc[ai][bj][m][0][j]; v[4 + j] = acc[ai][bj][m][1][j]; }
          if constexpr (E::W == 8 && E::SUB) e.apply_sub(r, c0, v, u.sub); else e.apply(r, c0, v);
        } else {
#pragma unroll
          for (int n = 0; n < 2; ++n) {
            const int c0 = u.pn * BM + bj * HALF + wc * 32 + 16 * n + 4 * fq;
            float v[4];
#pragma unroll
            for (int j = 0; j < 4; ++j) v[j] = acc[ai][bj][m][n][j];
            e.apply(r, c0, v);
          }
        }
      }
      if (m == 1 || m == 3) __builtin_amdgcn_sched_barrier(0);
    }
}

template <class Epi>
__device__ __forceinline__ void gemm_phase(PG8_LAS unsigned char* lds, const int tid, const GemmDesc g, const Epi& E) {
  constexpr bool PERM = (Epi::W == 8);
  const int wid = __builtin_amdgcn_readfirstlane(tid >> 6), lane = tid & 63, wr = wid >> 2, wc = wid & 3, fr = lane & 15, fq = lane >> 4;
  const int K = g.K, nt = K / BK;
  StaticOrder S; S.init(g.nrows / BM, g.ncols / BM, (int)gridDim.x, (int)((blockIdx.x + gridDim.x - (unsigned)g.unit_off % gridDim.x) % gridDim.x), g.nsub);
  unsigned voffA[2], voffB[2];
#pragma unroll
  for (int i = 0; i < 2; ++i) { int R, C; stage_rc(tid * 16 + i * 8192, R, C); const int Rb = PERM ? ((R & ~31) + perm32(R & 31)) : R;
    voffA[i] = (unsigned)(R * g.lda + C) * 2u; voffB[i] = (unsigned)(Rb * g.ldb + C) * 2u; }
  const size_t kstep = (size_t)(BK * 2);
  const size_t hstepA = (size_t)HALF * g.lda * 2, hstepB = (size_t)HALF * g.ldb * 2;
  const unsigned ldsw = (unsigned)wid * 1024u;
  const int aoff = lds_byte(wr * 64 + fr, fq * 8), boff = lds_byte(wc * 32 + fr, fq * 8);
#define PG8_SA(b, h) (((b) * 2 + (h)) * HTB)
#define PG8_SB(b, h) ((4 + (b) * 2 + (h)) * HTB)
#define PG8_STAGE(bufoff, gbase, voff) do { _Pragma("unroll") for (int _i = 0; _i < 2; ++_i) \
        __builtin_amdgcn_global_load_lds((const unsigned*)((const char*)(gbase) + (voff)[_i]), (PG8_LAS unsigned*)(lds + (bufoff) + ldsw + _i * 8192), 16, 0, 0); } while (0)
#define PG8_LDA(dst, b, h) do { _Pragma("unroll") for (int m = 0; m < 4; ++m) _Pragma("unroll") for (int k = 0; k < 2; ++k) dst[m][k] = *(const PG8_LAS bf16x8*)(lds + PG8_SA(b, h) + aoff + m * 2048 + k * 1024); } while (0)
#define PG8_LDB(dst, b, h) do { _Pragma("unroll") for (int n = 0; n < 2; ++n) _Pragma("unroll") for (int k = 0; k < 2; ++k) dst[n][k] = *(const PG8_LAS bf16x8*)(lds + PG8_SB(b, h) + boff + n * 2048 + k * 1024); } while (0)
#define PG8_MMA(ai, bj, At, Bt) do { __builtin_amdgcn_s_setprio(1); _Pragma("unroll") for (int m = 0; m < 4; ++m) _Pragma("unroll") for (int n = 0; n < 2; ++n) _Pragma("unroll") for (int k = 0; k < 2; ++k) \
        acc[ai][bj][m][n] = __builtin_amdgcn_mfma_f32_16x16x32_bf16(Bt[n][k], At[m][k], acc[ai][bj][m][n], 0, 0, 0); __builtin_amdgcn_s_setprio(0); } while (0)
#define PG8_WAIT_V(n) asm volatile("s_waitcnt vmcnt(" #n ")" ::: "memory")
#define PG8_WAIT_L(n) asm volatile("s_waitcnt lgkmcnt(" #n ")" ::: "memory")
#define PG8_BAR __builtin_amdgcn_s_barrier()
#define PG8_SCHED __builtin_amdgcn_sched_barrier(0)
#define PG8_ABASE(u) ((const char*)g.A + ((size_t)(u).pm * BM * g.lda + (size_t)((u).pn >> g.a_pn_shift) * g.a_pn_mul + (size_t)(u).sub * g.a_sub) * 2)
#define PG8_BBASE(u) ((const char*)g.Bt + ((size_t)(u).pn * BM * g.ldb + (size_t)(u).sub * g.b_sub) * 2)
  Unit cur, nxt; int ui = 0;
  if (!S.next(0, cur)) return;
  f32x4 acc[2][2][4][2];
#pragma unroll
  for (int a = 0; a < 2; ++a)
#pragma unroll
    for (int b = 0; b < 2; ++b)
#pragma unroll
      for (int m = 0; m < 4; ++m)
#pragma unroll
        for (int n = 0; n < 2; ++n) acc[a][b][m][n] = (f32x4){0.f, 0.f, 0.f, 0.f};
  bf16x8 At[4][2], B0[2][2], B1[2][2];
  const char* cA = PG8_ABASE(cur); const char* cB = PG8_BBASE(cur);
  asm volatile("" : "+v"(voffA[0]), "+v"(voffA[1]), "+v"(voffB[0]), "+v"(voffB[1]));
  PG8_STAGE(PG8_SB(0, 0), cB, voffB); PG8_STAGE(PG8_SA(0, 0), cA, voffA); PG8_STAGE(PG8_SB(0, 1), cB + hstepB, voffB); PG8_STAGE(PG8_SA(0, 1), cA + hstepA, voffA);
  if (wr == 1) PG8_BAR;
  PG8_WAIT_V(4); PG8_BAR;
  PG8_STAGE(PG8_SB(1, 0), cB + kstep, voffB); PG8_STAGE(PG8_SA(1, 0), cA + kstep, voffA); PG8_STAGE(PG8_SB(1, 1), cB + hstepB + kstep, voffB);
  PG8_WAIT_V(6); PG8_BAR;
  for (;;) {
    const bool has_next = S.next(ui + 1, nxt);
    const char* nA = has_next ? PG8_ABASE(nxt) : cA; const char* nB = has_next ? PG8_BBASE(nxt) : cB;
    for (int t = 0; t < nt; t += 2) {
      const bool last = (t == nt - 2);
      asm volatile("" : "+v"(voffA[0]), "+v"(voffA[1]), "+v"(voffB[0]), "+v"(voffB[1]));
      const char* a1 = cA + (size_t)(t + 1) * kstep;
      const char* a2 = last ? nA : cA + (size_t)(t + 2) * kstep; const char* b2 = last ? nB : cB + (size_t)(t + 2) * kstep;
      const char* a3 = a2 + kstep; const char* b3 = b2 + kstep;
      PG8_LDB(B0, 0, 0); PG8_SCHED; PG8_LDA(At, 0, 0); PG8_STAGE(PG8_SA(1, 1), a1 + hstepA, voffA);
      PG8_WAIT_L(8); PG8_BAR; PG8_WAIT_L(0); PG8_MMA(0, 0, At, B0); PG8_BAR; PG8_SCHED;
      PG8_LDB(B1, 0, 1); PG8_STAGE(PG8_SB(0, 0), b2, voffB);
      PG8_BAR; PG8_WAIT_L(0); PG8_MMA(0, 1, At, B1); PG8_BAR;
      PG8_LDA(At, 0, 1); PG8_STAGE(PG8_SA(0, 0), a2, voffA);
      PG8_BAR; PG8_WAIT_L(0); PG8_MMA(1, 0, At, B0); PG8_BAR; PG8_SCHED;
      PG8_STAGE(PG8_SB(0, 1), b2 + hstepB, voffB);
      PG8_WAIT_V(6); PG8_BAR; PG8_MMA(1, 1, At, B1); PG8_BAR;
      PG8_LDB(B0, 1, 0); PG8_SCHED; PG8_LDA(At, 1, 0); PG8_STAGE(PG8_SA(0, 1), a2 + hstepA, voffA);
      PG8_WAIT_L(8); PG8_BAR; PG8_WAIT_L(0); PG8_MMA(0, 0, At, B0); PG8_BAR; PG8_SCHED;
      PG8_LDB(B1, 1, 1); PG8_STAGE(PG8_SB(1, 0), b3, voffB);
      PG8_BAR; PG8_WAIT_L(0); PG8_MMA(0, 1, At, B1); PG8_BAR;
      PG8_LDA(At, 1, 1); PG8_STAGE(PG8_SA(1, 0), a3, voffA);
      PG8_BAR; PG8_WAIT_L(0); PG8_MMA(1, 0, At, B0); PG8_BAR; PG8_SCHED;
      PG8_STAGE(PG8_SB(1, 1), b3 + hstepB, voffB);
      PG8_WAIT_V(6); PG8_BAR; PG8_MMA(1, 1, At, B1); PG8_BAR;
    }
    epi_call(E, acc, cur, wr, wc, fr, fq);
    if (!has_next) break;
#pragma unroll
    for (int a = 0; a < 2; ++a)
#pragma unroll
      for (int b = 0; b < 2; ++b)
#pragma unroll
        for (int m = 0; m < 4; ++m)
#pragma unroll
          for (int n = 0; n < 2; ++n) acc[a][b][m][n] = (f32x4){0.f, 0.f, 0.f, 0.f};
    cur = nxt; cA = nA; cB = nB; ++ui;
  }
  PG8_WAIT_V(0);
  if (wr == 0) PG8_BAR;
  PG8_BAR;
#undef PG8_SA
#undef PG8_SB
#undef PG8_STAGE
#undef PG8_LDA
#undef PG8_LDB
#undef PG8_MMA
#undef PG8_WAIT_V
#undef PG8_WAIT_L
#undef PG8_BAR
#undef PG8_SCHED
#undef PG8_ABASE
#undef PG8_BBASE
}
}
struct Ctx { i64 gtid, gsz; PG8_LAS unsigned char* lds; char* ldsg; int tid; };
template <class E> DEV void run_gemm(const Ctx& cx, const GemmDesc& g, const E& e) { pg8::gemm_phase<E>(cx.lds, cx.tid, g, e); }
#else
struct Ctx { i64 gtid, gsz; };
template <class E> static void run_gemm(const Ctx& cx, const GemmDesc& g, const E& e) {
  constexpr int W = E::W;
  const int ng = g.ncols / W;
  for (i64 i = cx.gtid; i < (i64)g.nrows * ng; i += cx.gsz) {
    int r = (int)(i / ng), c0 = (int)(i % ng) * W;
    int pn = c0 / 256;
    for (int sub = 0; sub < g.nsub; ++sub) {
      const bf* a = g.A + (size_t)r * g.lda + (size_t)(pn >> g.a_pn_shift) * g.a_pn_mul + (size_t)sub * g.a_sub;
      float v[8];
      for (int j = 0; j < W; ++j) {
        const bf* b = g.Bt + (size_t)(c0 + j) * g.ldb + (size_t)sub * g.b_sub;
        float acc = 0.f;
        for (int k = 0; k < g.K; ++k) acc += b2f(a[k]) * b2f(b[k]);
        v[j] = acc;
      }
      if constexpr (E::SUB) e.apply_sub(r, c0, v, sub); else e.apply(r, c0, v);
    }
  }
}
#endif


#ifndef CPU_SIM
namespace fa {
using bf16x8 = __attribute__((ext_vector_type(8))) short;
using s16x4 = __attribute__((ext_vector_type(4))) short;
using f32x16 = __attribute__((ext_vector_type(16))) float;
using u32x4 = __attribute__((ext_vector_type(4))) unsigned;
constexpr int KVBLK = 64, QBLK = 32;
constexpr float THR = 8.f;
constexpr int SHM_V = KVBLK * 128 * 2, SHM_K = KVBLK * 128 * 2;
constexpr int NBUF = 3;
constexpr int SHM_ATTN = NBUF * SHM_V + NBUF * SHM_K + 8 * 64 * 4;
#define KSWZ(row, colB) ((row) * 256 + ((colB) ^ (((row) & 7) << 4)))
#define SBAR() __builtin_amdgcn_sched_barrier(0)
__device__ __forceinline__ int crow(int r, int hi) { return (r & 3) + 8 * (r >> 2) + 4 * hi; }
__device__ __forceinline__ unsigned cvtpk(float lo, float hi) { unsigned r; asm volatile("v_cvt_pk_bf16_f32 %0, %1, %2" : "=v"(r) : "v"(lo), "v"(hi)); return r; }
template <int SC1000000> __device__ __forceinline__ void partialSM(f32x16& p0, f32x16& p1, float& m_reg, float& mn, float& alpha) {
  constexpr float SCALE = SC1000000 * 1e-9f; constexpr float C = SCALE * 1.4426950408889634f;
  float pmax = p0[0];
#pragma unroll
  for (int r = 1; r < 16; ++r) pmax = fmaxf(pmax, p0[r]);
#pragma unroll
  for (int r = 0; r < 16; ++r) pmax = fmaxf(pmax, p1[r]);
  { auto rr = __builtin_amdgcn_permlane32_swap(__float_as_uint(pmax), __float_as_uint(pmax), false, false);
    pmax = fmaxf(__uint_as_float(rr[0]), __uint_as_float(rr[1])); }
  if (__builtin_expect(__all(pmax - m_reg <= THR / SCALE), 1)) { mn = m_reg; alpha = 1.f; }
  else { mn = fmaxf(m_reg, pmax); alpha = __builtin_amdgcn_exp2f((m_reg - mn) * C); m_reg = mn; }
  float mnC = -mn * C;
#pragma unroll
  for (int r = 0; r < 16; ++r) p0[r] = fmaf(p0[r], C, mnC);
#pragma unroll
  for (int r = 0; r < 16; ++r) p1[r] = fmaf(p1[r], C, mnC);
#pragma unroll
  for (int r = 0; r < 16; ++r) p0[r] = __builtin_amdgcn_exp2f(p0[r]);
}
__device__ __forceinline__ void finishSM(f32x16& p0, f32x16& p1, float alpha, float& l_reg, bf16x8& pa0, bf16x8& pa1, bf16x8& pa2, bf16x8& pa3) {
#pragma unroll
  for (int r = 0; r < 16; ++r) p1[r] = __builtin_amdgcn_exp2f(p1[r]);
  float ps = 0;
#pragma unroll
  for (int r = 0; r < 16; ++r) ps += p0[r];
#pragma unroll
  for (int r = 0; r < 16; ++r) ps += p1[r];
  { auto rr = __builtin_amdgcn_permlane32_swap(__float_as_uint(ps), __float_as_uint(ps), false, false);
    ps = __uint_as_float(rr[0]) + __uint_as_float(rr[1]); }
  l_reg = l_reg * alpha + ps;
#define PK4(P, BASE, OUT) do { unsigned a0 = cvtpk(P[BASE + 0], P[BASE + 1]), a1 = cvtpk(P[BASE + 2], P[BASE + 3]);   \
    unsigned b0 = cvtpk(P[BASE + 4], P[BASE + 5]), b1 = cvtpk(P[BASE + 6], P[BASE + 7]);                              \
    auto r0 = __builtin_amdgcn_permlane32_swap(a0, b0, false, false); auto r1 = __builtin_amdgcn_permlane32_swap(a1, b1, false, false); \
    u32x4 w = {r0[0], r1[0], r0[1], r1[1]}; OUT = *reinterpret_cast<bf16x8*>(&w); } while (0)
  PK4(p0, 0, pa0); PK4(p0, 8, pa1); PK4(p1, 0, pa2); PK4(p1, 8, pa3);
#undef PK4
}
template <int NK16>
__device__ __forceinline__ void qkt(f32x16& p0, f32x16& p1, const char* Ks, const bf16x8* qr, int r32, int hi) {
  p0 = f32x16{}; p1 = f32x16{};
#pragma unroll
  for (int d0 = 0; d0 < NK16; ++d0) { int cb = (d0 * 16 + hi * 8) * 2;
    bf16x8 b0 = *reinterpret_cast<const bf16x8*>(Ks + KSWZ(r32, cb));
    bf16x8 b1 = *reinterpret_cast<const bf16x8*>(Ks + KSWZ(32 + r32, cb));
    p0 = __builtin_amdgcn_mfma_f32_32x32x16_bf16(b0, qr[d0], p0, 0, 0, 0);
    p1 = __builtin_amdgcn_mfma_f32_32x32x16_bf16(b1, qr[d0], p1, 0, 0, 0); }
}
__device__ __forceinline__ int v_st(int k, int c) { const int kk = (k & ~0xC) | ((k & 4) << 1) | ((k & 8) >> 1); return ((kk >> 3) * 4 + (c >> 5)) * 512 + ((kk & 7) * 32 + (c & 31)) * 2; }
__device__ __forceinline__ int v_rd_base(int lane) { return ((lane & 3) << 3) | (((lane >> 2) & 3) << 6) | (((lane >> 4) & 1) << 5) | (((lane >> 5) & 1) << 8); }
constexpr int v_rd_off(int d0, int ks, int half) { return d0 * 512 + ks * 4096 + half * 2048; }
template <int OFF> __device__ __forceinline__ s16x4 tr_read(int vb) {
  s16x4 r; asm volatile("ds_read_b64_tr_b16 %0, %1 offset:%2" : "=&v"(r) : "v"(vb), "i"(OFF) : "memory"); return r;
}
template <int D0> __device__ __forceinline__ void pv_one(f32x16& od, int vb, bf16x8 pa0, bf16x8 pa1, bf16x8 pa2, bf16x8 pa3) {
  const s16x4 l0 = tr_read<v_rd_off(D0, 0, 0)>(vb), h0 = tr_read<v_rd_off(D0, 0, 1)>(vb), l1 = tr_read<v_rd_off(D0, 1, 0)>(vb), h1 = tr_read<v_rd_off(D0, 1, 1)>(vb);
  const s16x4 l2 = tr_read<v_rd_off(D0, 2, 0)>(vb), h2 = tr_read<v_rd_off(D0, 2, 1)>(vb), l3 = tr_read<v_rd_off(D0, 3, 0)>(vb), h3 = tr_read<v_rd_off(D0, 3, 1)>(vb);
  asm volatile("s_waitcnt lgkmcnt(0)" ::: "memory"); SBAR();
#define PK(L, H) (bf16x8){L[0], L[1], L[2], L[3], H[0], H[1], H[2], H[3]}
  od = __builtin_amdgcn_mfma_f32_32x32x16_bf16(pa0, PK(l0, h0), od, 0, 0, 0);
  od = __builtin_amdgcn_mfma_f32_32x32x16_bf16(pa1, PK(l1, h1), od, 0, 0, 0);
  od = __builtin_amdgcn_mfma_f32_32x32x16_bf16(pa2, PK(l2, h2), od, 0, 0, 0);
  od = __builtin_amdgcn_mfma_f32_32x32x16_bf16(pa3, PK(l3, h3), od, 0, 0, 0);
#undef PK
}
__device__ __forceinline__ void pv_d0(f32x16* o, int vb, bf16x8 pa0, bf16x8 pa1, bf16x8 pa2, bf16x8 pa3) {
  pv_one<0>(o[0], vb, pa0, pa1, pa2, pa3); pv_one<1>(o[1], vb, pa0, pa1, pa2, pa3);
}

struct Src { const bf* q; int qstride; const bf* ksrc; int kstride; const bf* vsrc; int vstride; bf* out; float m0, l0; int dq0; };
template <int NK16, int SC1000000, bool MASK>
__device__ __forceinline__ void unit(const Src& sd, const int tid, char* lds, int kbase0, int nt0, int kbase1, int NT) {
  const int wid = tid >> 6, lane = tid & 63, r32 = lane & 31, hi = lane >> 5;
  char* V_lds = lds; char* K_lds = lds + NBUF * SHM_V;
  float* wsl = (float*)(lds + NBUF * SHM_V + NBUF * SHM_K) + wid * 64; float* li_l = wsl; float* al_l = wsl + 32;
  float m_reg = sd.m0, l_reg = sd.l0; f32x16 o[2] = {}; bf16x8 qr[NK16];
  const bf* Qw = sd.q + (size_t)(wid * QBLK + r32) * sd.qstride + hi * 8;
#pragma unroll
  for (int d0 = 0; d0 < NK16; ++d0) qr[d0] = *reinterpret_cast<const bf16x8*>(Qw + d0 * 16);
  const int sr = tid >> 4, sc = (tid & 15) * 8, vst0 = v_st(sr, sc), vst1 = v_st(32 + sr, sc);
  const int vb0 = (int)(uintptr_t)V_lds + v_rd_base(lane);
  const bf* ksrc = sd.ksrc; const int kstride = sd.kstride; const bf* vsrc = sd.vsrc; const int vstride = sd.vstride;
  const int dqw = sd.dq0 + wid * QBLK + r32;
  struct { bf16x8 vs0, vs1, ks0, ks1; } sr_[2];
#define KROW(j) ((j) < nt0 ? kbase0 + (j) * KVBLK : kbase1 + ((j) - nt0) * KVBLK)
#define SLOAD(i, j) do { const int _kr = KROW(j); \
    sr_[i].vs0 = *reinterpret_cast<const bf16x8*>(vsrc + (size_t)(_kr + sr) * vstride); sr_[i].vs1 = *reinterpret_cast<const bf16x8*>(vsrc + (size_t)(_kr + 32 + sr) * vstride); \
    sr_[i].ks0 = *reinterpret_cast<const bf16x8*>(ksrc + (size_t)(_kr + sr) * kstride); sr_[i].ks1 = *reinterpret_cast<const bf16x8*>(ksrc + (size_t)(_kr + 32 + sr) * kstride); } while (0)
#define SWRITE(b, i) do { *(bf16x8*)(V_lds + (b) * SHM_V + vst0) = sr_[i].vs0;          \
    *(bf16x8*)(V_lds + (b) * SHM_V + vst1) = sr_[i].vs1; int kc = sc * 2;               \
    *(bf16x8*)(K_lds + (b) * SHM_K + KSWZ(sr, kc)) = sr_[i].ks0;                       \
    *(bf16x8*)(K_lds + (b) * SHM_K + KSWZ(32 + sr, kc)) = sr_[i].ks1; } while (0)
#define SWAIT() asm volatile("s_waitcnt vmcnt(4)" ::: "memory")
#define MASKT(P0, P1, J) do { if (MASK && (J) < nt0) { const int _d = (J) * KVBLK - dqw; \
    _Pragma("unroll") for (int r = 0; r < 16; ++r) { const int dd = _d + crow(r, hi); if (dd > 128 || dd < -128) P0[r] = -1e30f; if (dd + 32 > 128 || dd + 32 < -128) P1[r] = -1e30f; } } } while (0)
#define RESC(a) do { if (__any((a) < 1.f)) { if (hi == 0) al_l[r32] = (a); asm volatile("s_waitcnt lgkmcnt(0)" ::: "memory"); \
    _Pragma("unroll") for (int d = 0; d < 2; ++d) _Pragma("unroll") for (int r = 0; r < 16; ++r) o[d][r] *= al_l[crow(r, hi)]; } } while (0)
  f32x16 pA0, pA1, pB0, pB1; float mnA, mnB, alA, alB; bf16x8 pa0, pa1, pa2, pa3;
  constexpr int SE = 0, SO = 1;
  __syncthreads();
  SLOAD(SE, 0); asm volatile("s_waitcnt vmcnt(0)" ::: "memory"); SWRITE(0, SE); __syncthreads();
  qkt<NK16>(pA0, pA1, K_lds, qr, r32, hi); MASKT(pA0, pA1, 0); partialSM<SC1000000>(pA0, pA1, m_reg, mnA, alA);
  SLOAD(SO, 1); if (2 < NT) SLOAD(SE, 2);
  SWAIT();
  SWRITE(1, SO); __syncthreads();
  int bc = 1;
  for (int j = 1; j + 1 < NT; j += 2) {
    { const int bp = bc == 0 ? NBUF - 1 : bc - 1, bn = bc == NBUF - 1 ? 0 : bc + 1;
      SBAR(); qkt<NK16>(pB0, pB1, K_lds + bc * SHM_K, qr, r32, hi);
      finishSM(pA0, pA1, alA, l_reg, pa0, pa1, pa2, pa3); SBAR();
      SLOAD(SO, j + 2); SBAR();
      pv_d0(o, vb0 + bp * SHM_V, pa0, pa1, pa2, pa3); MASKT(pB0, pB1, j); partialSM<SC1000000>(pB0, pB1, m_reg, mnB, alB);
      SWAIT(); SWRITE(bn, SE);
      RESC(alB); __syncthreads();
      bc = bn; }
    { const int bp = bc == 0 ? NBUF - 1 : bc - 1, bn = bc == NBUF - 1 ? 0 : bc + 1;
      SBAR(); qkt<NK16>(pA0, pA1, K_lds + bc * SHM_K, qr, r32, hi);
      finishSM(pB0, pB1, alB, l_reg, pa0, pa1, pa2, pa3); SBAR();
      if (j + 3 < NT) SLOAD(SE, j + 3); SBAR();
      pv_d0(o, vb0 + bp * SHM_V, pa0, pa1, pa2, pa3); MASKT(pA0, pA1, j + 1); partialSM<SC1000000>(pA0, pA1, m_reg, mnA, alA);
      SWAIT(); SWRITE(bn, SO);
      RESC(alA); __syncthreads();
      bc = bn; }
  }
  { const int bp = bc == 0 ? NBUF - 1 : bc - 1;
    SBAR(); qkt<NK16>(pB0, pB1, K_lds + bc * SHM_K, qr, r32, hi);
    finishSM(pA0, pA1, alA, l_reg, pa0, pa1, pa2, pa3); SBAR();
    pv_d0(o, vb0 + bp * SHM_V, pa0, pa1, pa2, pa3); MASKT(pB0, pB1, NT - 1); partialSM<SC1000000>(pB0, pB1, m_reg, mnB, alB);
    RESC(alB);
    finishSM(pB0, pB1, alB, l_reg, pa0, pa1, pa2, pa3); SBAR();
    pv_d0(o, vb0 + bc * SHM_V, pa0, pa1, pa2, pa3); }
  asm volatile("s_waitcnt vmcnt(0)" ::: "memory");
  if (hi == 0) li_l[r32] = l_reg; asm volatile("s_waitcnt lgkmcnt(0)" ::: "memory");
  float rli[16];
#pragma unroll
  for (int r = 0; r < 16; ++r) rli[r] = __builtin_amdgcn_rcpf(li_l[crow(r, hi)]);
  bf* Ow = sd.out + (size_t)(wid * QBLK) * 2048;
#pragma unroll
  for (int r = 0; r < 16; ++r) { int orow = crow(r, hi);
#pragma unroll
    for (int d0 = 0; d0 < 2; ++d0) Ow[(size_t)orow * 2048 + d0 * 32 + r32] = f2b(o[d0][r] * rli[r]); }
#undef SLOAD
#undef SWRITE
#undef SWAIT
#undef MASKT
#undef RESC
#undef KROW
}
#undef KSWZ
#undef SBAR
}

DEV void ph_mla(const Params& p, const Ctx& cx, int last) {
  const int nlat_units = NB * 8 * (N / 256);
  const int nctx_units = last ? 0 : NB * 8 * (LC / 256);
  const int sc = (cx.tid & 15) * 8;
  for (int uu = blockIdx.x; uu < nlat_units + 256; uu += gridDim.x) {
    const int u = uu < nlat_units ? uu : nlat_units + ((uu - nlat_units + 256 - 32) & 255);
    if (u >= nlat_units + nctx_units) continue;
    int qrow0, hh, kb0, nt0, kb1, NT;
    if (u < nlat_units) {
      const int rnd = u / 256, within = u % 256, bh = (rnd * 8 + (within & 7)) % (NB * 8); int qb = within >> 3;
      hh = bh % 8; int b = bh / 8; qrow0 = b * N + qb * 256; kb0 = b * N; nt0 = N / 64; kb1 = NLAT + b * LC; NT = (N + LC) / 64; }
    else { int v = u - nlat_units; int qb = v % (LC / 256); hh = (v / (LC / 256)) % 8; int b = v / (8 * (LC / 256)); qrow0 = NLAT + b * LC + qb * 256; kb0 = NLAT + b * LC; nt0 = LC / 64; kb1 = 0; NT = LC / 64; }
    fa::Src sd;
    sd.q = p.QA() + (size_t)qrow0 * 768 + hh * 96; sd.qstride = 768;
    if (sc < 64) { sd.ksrc = p.KVA() + hh * 128 + sc; sd.kstride = 1024; } else { sd.ksrc = p.P() + C_KR + ((sc - 64) & 31); sd.kstride = PC; }
    sd.vsrc = p.KVA() + hh * 128 + 64 + (sc & 63); sd.vstride = 1024;
    sd.out = p.Y() + (size_t)qrow0 * 2048 + hh * 64; sd.m0 = -1e30f; sd.l0 = 0.f; sd.dq0 = 0;
    fa::unit<6, 102062073, false>(sd, cx.tid, cx.ldsg, kb0, nt0, kb1, NT);
  }
}
DEV void ph_gqa(const Params& p, const Ctx& cx, int l, int last) {
  const int nlat_units = NB * 8 * (N / 256);
  const int nctx_units = last ? 0 : NB * 8 * (LC / 256);
  const int sc = (cx.tid & 15) * 8;
  for (int uu = blockIdx.x; uu < nlat_units + 256; uu += gridDim.x) {
    const int u = uu < nlat_units ? uu : nlat_units + ((uu - nlat_units + 256 - 16) & 255);
    if (u >= nlat_units + nctx_units) continue;
    int qrow0, hh, kb0, nt0, kb1, NT, dq0 = 0;
    if (u < nlat_units) {
      const int rnd = u / 256, within = u % 256, bh = (rnd * 8 + (within & 7)) % (NB * 8); int qb = within >> 3;
      hh = bh % 8; int b = bh / 8;
      int q0 = qb * 256; int klo = q0 - 128 < 0 ? 0 : q0 - 128; int khi = q0 + 384 > N ? N : q0 + 384;
      qrow0 = b * N + q0; kb0 = b * N + klo; nt0 = (khi - klo) / 64; kb1 = NLAT + b * LC; NT = nt0 + LC / 64; dq0 = q0 - klo;
    } else { int v = u - nlat_units; int qb = v % (LC / 256); hh = (v / (LC / 256)) % 8; int b = v / (8 * (LC / 256)); qrow0 = NLAT + b * LC + qb * 256; kb0 = NLAT + b * LC; nt0 = 0; kb1 = kb0; NT = LC / 64; }
    const int kh = hh >> 2;
    fa::Src sd;
    sd.q = p.P() + (size_t)qrow0 * PC + C_GQ + hh * 64; sd.qstride = PC;
    sd.ksrc = p.P() + C_GKV + kh * 64 + (sc & 63); sd.kstride = PC;
    sd.vsrc = p.P() + C_GKV + 128 + kh * 64 + (sc & 63); sd.vstride = PC;
    sd.out = p.Y() + (size_t)qrow0 * 2048 + 1536 + hh * 64;
    sd.m0 = p.in[I_gqa_sink][l * 8 + hh] * 8.0f; sd.l0 = 1.0f; sd.dq0 = dq0;
    fa::unit<4, 125000000, true>(sd, cx.tid, cx.ldsg, kb0, nt0, kb1, NT);
  }
}
#endif


namespace hy {
constexpr int NF = 2 * N;
struct f2 { float x, y; };
DEV f2 cmul(f2 a, f2 b) { f2 r; r.x = a.x * b.x - a.y * b.y; r.y = a.x * b.y + a.y * b.x; return r; }
#ifndef CPU_SIM
DEV f2 twid(const f2*, int k) { const float x = (float)k * (1.0f / (float)NF); return f2{__builtin_amdgcn_cosf(x), -__builtin_amdgcn_sinf(x)}; }
#else
DEV f2 twid(const f2* tw, int k) { return tw[k]; }
#endif
DEV f2 cmulc(f2 a, f2 b) { f2 r; r.x = a.x * b.x + a.y * b.y; r.y = a.y * b.x - a.x * b.y; return r; }
DEV void fwd_pass(f2* buf, const f2* tw, int L, int tid, int nthr) {
  const int Q = L >> 2, tws = NF / L;
  for (int u = tid; u < NF / 4; u += nthr) {
    const int g = u / Q, j = u - g * Q, base = g * L + j;
    const f2 x0 = buf[base], x1 = buf[base + Q], x2 = buf[base + 2 * Q], x3 = buf[base + 3 * Q];
    f2 a0{x0.x + x2.x, x0.y + x2.y}, a1{x0.x - x2.x, x0.y - x2.y}, a2{x1.x + x3.x, x1.y + x3.y};
    f2 d{x1.x - x3.x, x1.y - x3.y}; f2 a3{d.y, -d.x};
    f2 y0{a0.x + a2.x, a0.y + a2.y}, y1{a1.x + a3.x, a1.y + a3.y}, y2{a0.x - a2.x, a0.y - a2.y}, y3{a1.x - a3.x, a1.y - a3.y};
    buf[base] = y0; buf[base + Q] = cmul(y1, twid(tw, j * tws)); buf[base + 2 * Q] = cmul(y2, twid(tw, 2 * j * tws)); buf[base + 3 * Q] = cmul(y3, twid(tw, 3 * j * tws));
  }
}
DEV void inv_pass(f2* buf, const f2* tw, int L, int tid, int nthr) {
  const int Q = L >> 2, tws = NF / L;
  for (int u = tid; u < NF / 4; u += nthr) {
    const int g = u / Q, j = u - g * Q, base = g * L + j;
    const f2 u0 = buf[base], u1 = cmulc(buf[base + Q], twid(tw, j * tws)), u2 = cmulc(buf[base + 2 * Q], twid(tw, 2 * j * tws)), u3 = cmulc(buf[base + 3 * Q], twid(tw, 3 * j * tws));
    f2 a0{u0.x + u2.x, u0.y + u2.y}, a1{u0.x - u2.x, u0.y - u2.y}, a2{u1.x + u3.x, u1.y + u3.y};
    f2 d{u1.x - u3.x, u1.y - u3.y}; f2 a3{-d.y, d.x};
    buf[base] = f2{a0.x + a2.x, a0.y + a2.y}; buf[base + Q] = f2{a1.x + a3.x, a1.y + a3.y};
    buf[base + 2 * Q] = f2{a0.x - a2.x, a0.y - a2.y}; buf[base + 3 * Q] = f2{a1.x - a3.x, a1.y - a3.y};
  }
}
DEV void s1_taps(const Params& p, f2* buf, float* red, int c, int tid, int nthr) {
  float ss = 0.f;
#pragma unroll 8
  for (int k = tid; k < NF; k += nthr) {
    float v = 0.f;
    if (k < N) v = p.F()[(size_t)k * 1024 + c];
    else if (k > N) v = p.F()[(size_t)(NF - k) * 1024 + 512 + c];
    buf[k] = f2{v, 0.f}; ss += v * v;
  }
  red[tid] = ss;
}
DEV float red_total(const float* red, int nthr) { float s = 0.f; for (int i = 0; i < nthr; ++i) s += red[i]; return s; }
DEV void s3_store(const f2* buf, unsigned* hs, int tid, int nthr) {
  for (int k = tid; k < NF; k += nthr) hs[k] = (unsigned)f2b(buf[k].x).v | ((unsigned)f2b(buf[k].y).v << 16);
}
DEV void s4_loadz(const Params& p, f2* buf, int c, int tid, int nthr) {
#pragma unroll 8
  for (int t = tid; t < NF; t += nthr) {
    f2 v{0.f, 0.f};
    if (t < N) { v.x = b2f(p.Z()[(size_t)t * 512 + c]); v.y = b2f(p.Z()[(size_t)(N + t) * 512 + c]); }
    buf[t] = v;
  }
}
DEV void s6_mul(f2* buf, const unsigned* hs, int tid, int nthr) {
  for (int k = tid; k < NF; k += nthr) {
    union { unsigned u; float f; } a, b; const unsigned w = hs[k]; a.u = w << 16; b.u = w & 0xFFFF0000u;
    buf[k] = cmul(buf[k], f2{a.f, b.f});
  }
}
DEV void s8_out(const Params& p, const f2* buf, const float* red, int l, int c, int tid, int nthr) {
  const float fn = 1.0f / sqrtf(red_total(red, nthr) + EPS) * (1.0f / (float)NF);
  const float* cw = p.in[I_hy_conv_w] + l * 3 * 1536; const float cb = p.in[I_hy_conv_b][l * 1536 + c];
  const float w0 = cw[c], w1 = cw[1536 + c], w2 = cw[2 * 1536 + c];
  const float skip = p.in[I_hy_skip][l * 512 + c];
#pragma unroll 4
  for (int i = tid; i < 2 * N; i += nthr) {
    const int b = i / N, t = i - b * N;
    const size_t r = (size_t)b * N + t;
    const float conv = (b ? buf[t].y : buf[t].x) * fn;
    float x0 = cb + w1 * b2f(p.P()[r * PC + C_HU + c]);
    if (t > 0) x0 += w0 * b2f(p.P()[(r - 1) * PC + C_HU + c]);
    if (t < N - 1) x0 += w2 * b2f(p.P()[(r + 1) * PC + C_HU + c]);
    const float y = conv + skip * b2f(p.Z()[r * 512 + c]);
    p.Y()[r * 2048 + 1024 + c] = f2b(x0 * y);
  }
}
#ifndef CPU_SIM
DEV void channel(const Params& p, int l, int c, int tid, f2* buf, float* red, unsigned* hs) {
  const f2* tw = (const f2*)p.tw();
#ifndef HY_EXP
#define HY_EXP 0
#endif
  __syncthreads();
  if (HY_EXP != 2) s1_taps(p, buf, red, c, tid, 512); __syncthreads();
  if (HY_EXP != 1) for (int L = NF; L >= 4; L >>= 2) { fwd_pass(buf, tw, L, tid, 512); __syncthreads(); }
  s3_store(buf, hs, tid, 512); __syncthreads();
  if (HY_EXP != 2) s4_loadz(p, buf, c, tid, 512); __syncthreads();
  if (HY_EXP != 1) for (int L = NF; L >= 4; L >>= 2) { fwd_pass(buf, tw, L, tid, 512); __syncthreads(); }
  s6_mul(buf, hs, tid, 512); __syncthreads();
  if (HY_EXP != 1) for (int L = 4; L <= NF; L <<= 2) { inv_pass(buf, tw, L, tid, 512); __syncthreads(); }
  if (HY_EXP != 2) s8_out(p, buf, red, l, c, tid, 512);
}
#endif
}


namespace tz {
constexpr int NBLK = N / 64;
constexpr int PADB = 31;
constexpr int ZLEN = (NBLK + 2 * PADB) * 64;
constexpr int HLEN = 2 * N + 16;
DEV int a_index(int m, int r, int h) { return N - m - r + 8 * h; }
DEV int b_index(int t1, int Dd, int ks, int h) { return 64 * (t1 - Dd + PADB) + 16 * ks + 8 * h; }
#ifndef CPU_SIM
using bf16x8 = __attribute__((ext_vector_type(8))) short;
using f32x16 = __attribute__((ext_vector_type(16))) float;
using u32x4 = __attribute__((ext_vector_type(4))) unsigned;
DEV bf16x8 load_afrag(const unsigned short* Hr, int e) {
  const unsigned* wp = (const unsigned*)(Hr + (e & ~1));
  const unsigned w0 = wp[0], w1 = wp[1], w2 = wp[2], w3 = wp[3], w4 = wp[4];
  const unsigned sh = (unsigned)(e & 1) << 4;
  u32x4 o;
  o.x = __builtin_amdgcn_alignbit(w1, w0, sh); o.y = __builtin_amdgcn_alignbit(w2, w1, sh); o.z = __builtin_amdgcn_alignbit(w3, w2, sh); o.w = __builtin_amdgcn_alignbit(w4, w3, sh);
  return *reinterpret_cast<bf16x8*>(&o);
}
DEV void channel(const Params& p, int l, int c, int tid, char* lds) {
  unsigned short* zp = (unsigned short*)lds;
  float* red = (float*)(zp + 2 * ZLEN);
  unsigned short* Hr = (unsigned short*)(red + 512);
  float* cv = (float*)Hr;
  const int lane = tid & 63, w = tid >> 6, r = lane & 31, h = lane >> 5;
  __syncthreads();
  float ss = 0.f;
  const float* ff = p.F() + (size_t)c * (N + LC); const float* fb = p.F() + (size_t)(512 + c) * (N + LC);
#pragma unroll 4
  for (int t = tid * 4; t < N; t += 2048) {
    const float4 a = *(const float4*)(ff + t), b = *(const float4*)(fb + t);
    ss += a.x * a.x + a.y * a.y + a.z * a.z + a.w * a.w + b.x * b.x + b.y * b.y + b.z * b.z + b.w * b.w;
    Hr[N - t] = f2b(a.x).v; Hr[N - t - 1] = f2b(a.y).v; Hr[N - t - 2] = f2b(a.z).v; Hr[N - t - 3] = f2b(a.w).v;
    if (t > 0) Hr[N + t] = f2b(b.x).v;
    Hr[N + t + 1] = f2b(b.y).v; Hr[N + t + 2] = f2b(b.z).v; Hr[N + t + 3] = f2b(b.w).v;
  }
  if (tid == 0) Hr[0] = 0;
  if (tid < 16) Hr[2 * N + tid] = 0;
  red[tid] = ss;
  for (int i = tid; i < 2 * PADB * 64; i += 512) {
    const int side = i / (PADB * 64), k = i % (PADB * 64);
    const int off = side ? (PADB + NBLK) * 64 + k : k;
    zp[off] = 0; zp[ZLEN + off] = 0;
  }
  { const unsigned short* zt = (const unsigned short*)p.Z() + (size_t)c * NB * N;
#pragma unroll 4
    for (int i = tid * 8; i < 2 * N; i += 4096) { const int b = i / N, t = i - b * N; *(uint4*)(zp + b * ZLEN + PADB * 64 + t) = *(const uint4*)(zt + i); } }
  __syncthreads();
  float tot = 0.f;
  for (int i = 0; i < 512; ++i) tot += red[i];
  const float fn = 1.0f / sqrtf(tot + EPS);
  const int t1 = 32 * (w & 3) + r;
  const unsigned short* zb = zp + (w >> 2) * ZLEN;
  f32x16 acc0 = {}, acc1 = {};
  const int Dlo = 32 * (w & 3) - (NBLK - 1), Dhi = 32 * (w & 3) + 31;
#define TZ_LOAD(AF, BF, PA, PB) do { _Pragma("unroll") for (int ks = 0; ks < 4; ++ks) BF[ks] = *reinterpret_cast<const bf16x8*>((PB) + 16 * ks); \
    _Pragma("unroll") for (int q = 0; q < 6; ++q) { const unsigned* wq_ = (PA) + 8 * (5 - q); const unsigned w0_ = wq_[0], w1_ = wq_[1], w2_ = wq_[2], w3_ = wq_[3], w4_ = wq_[4]; u32x4 o_; \
      o_.x = __builtin_amdgcn_alignbit(w1_, w0_, shA); o_.y = __builtin_amdgcn_alignbit(w2_, w1_, shA); o_.z = __builtin_amdgcn_alignbit(w3_, w2_, shA); o_.w = __builtin_amdgcn_alignbit(w4_, w3_, shA); \
      AF[q] = *reinterpret_cast<bf16x8*>(&o_); } } while (0)
#define TZ_MMA(AF, BF) do { _Pragma("unroll") for (int ks = 0; ks < 4; ++ks) { \
    acc0 = __builtin_amdgcn_mfma_f32_32x32x16_bf16(AF[3 - ks], BF[ks], acc0, 0, 0, 0); acc1 = __builtin_amdgcn_mfma_f32_32x32x16_bf16(AF[5 - ks], BF[ks], acc1, 0, 0, 0); } } while (0)
  const unsigned shA = (unsigned)(r & 1) << 4;
  const unsigned* pa = (const unsigned*)Hr + ((a_index(64 * Dlo - 48 + 80, r, h) & ~1) >> 1);
  const unsigned short* pb = zb + b_index(t1, Dlo, 0, h);
#define TZ_LOAD4(AF, BF, PREV, PA, PB) do { _Pragma("unroll") for (int ks = 0; ks < 4; ++ks) BF[ks] = *reinterpret_cast<const bf16x8*>((PB) + 16 * ks); \
    AF[0] = PREV[4]; AF[1] = PREV[5]; \
    _Pragma("unroll") for (int q = 2; q < 6; ++q) { const unsigned* wq_ = (PA) + 8 * (5 - q); const unsigned w0_ = wq_[0], w1_ = wq_[1], w2_ = wq_[2], w3_ = wq_[3], w4_ = wq_[4]; u32x4 o_; \
      o_.x = __builtin_amdgcn_alignbit(w1_, w0_, shA); o_.y = __builtin_amdgcn_alignbit(w2_, w1_, shA); o_.z = __builtin_amdgcn_alignbit(w3_, w2_, shA); o_.w = __builtin_amdgcn_alignbit(w4_, w3_, shA); \
      AF[q] = *reinterpret_cast<bf16x8*>(&o_); } } while (0)
  bf16x8 afA[6], bfA[4], afB[6], bfB[4];
  TZ_LOAD(afA, bfA, pa, pb);
#pragma unroll 1
  for (int Dd = Dlo; Dd + 2 <= Dhi; Dd += 2) {
    TZ_LOAD4(afB, bfB, afA, pa - 32, pb - 64);
    TZ_MMA(afA, bfA);
    pa -= 64; pb -= 128;
    TZ_LOAD4(afA, bfA, afB, pa, pb);
    TZ_MMA(afB, bfB);
  }
  TZ_MMA(afA, bfA);
#undef TZ_LOAD4
#undef TZ_LOAD
#undef TZ_MMA
  static_assert((NBLK + 31) % 2 == 1, "K-loop pairing assumes an odd number of steps");
  __syncthreads();
  { int t1e = t1, he = h;
    asm volatile("" : "+v"(t1e), "+v"(he));
    float* cvb = cv + (w >> 2) * N + 64 * t1e + 4 * he;
#pragma unroll
    for (int g = 0; g < 4; ++g) {
      *(float4*)(cvb + 8 * g) = float4{acc0[4 * g], acc0[4 * g + 1], acc0[4 * g + 2], acc0[4 * g + 3]};
      *(float4*)(cvb + 32 + 8 * g) = float4{acc1[4 * g], acc1[4 * g + 1], acc1[4 * g + 2], acc1[4 * g + 3]};
    } }
  __syncthreads();
  { const float skip = p.in[I_hy_skip][l * 512 + c];
    unsigned short* xy = (unsigned short*)p.XYT() + (size_t)c * NB * N;
#pragma unroll 4
    for (int i = tid * 8; i < 2 * N; i += 4096) {
      const int b = i / N, t = i - b * N;
      float x0[8]; unpack8(*(const uint4*)(xy + i), x0);
      float zf[8]; unpack8(*(const uint4*)(zp + b * ZLEN + PADB * 64 + t), zf);
      const float4 ca = *(const float4*)(cv + i), cb4 = *(const float4*)(cv + i + 4);
      float o[8];
      o[0] = x0[0] * (ca.x * fn + skip * zf[0]); o[1] = x0[1] * (ca.y * fn + skip * zf[1]); o[2] = x0[2] * (ca.z * fn + skip * zf[2]); o[3] = x0[3] * (ca.w * fn + skip * zf[3]);
      o[4] = x0[4] * (cb4.x * fn + skip * zf[4]); o[5] = x0[5] * (cb4.y * fn + skip * zf[5]); o[6] = x0[6] * (cb4.z * fn + skip * zf[6]); o[7] = x0[7] * (cb4.w * fn + skip * zf[7]);
      store8bf(p.YT() + (size_t)c * NB * N + i, o);
    } }
}
DEV void xyt_to_y(const Params& p, int tid, char* lds) {
  unsigned short* tl = (unsigned short*)lds;
  for (int tile = blockIdx.x; tile < (NLAT / 64) * 8; tile += gridDim.x) {
    const int rt = tile >> 3, c0 = (tile & 7) * 64;
    const int bq = (rt * 64) / N, tq = (rt * 64) % N;
    __syncthreads();
    { const int cc = tid >> 3, tg = (tid & 7) * 8;
      const uint4 v = *(const uint4*)((const unsigned short*)p.YT() + ((size_t)(c0 + cc) * NB + bq) * N + tq + tg);
      const unsigned short* e = (const unsigned short*)&v;
#pragma unroll
      for (int j = 0; j < 8; ++j) tl[(tg + j) * 72 + cc] = e[j]; }
    __syncthreads();
    { const int tr = tid >> 3, cg8 = (tid & 7) * 8;
      *(uint4*)((unsigned short*)p.Y() + (size_t)(rt * 64 + tr) * 2048 + 1024 + c0 + cg8) = *(const uint4*)(tl + tr * 72 + cg8); }
  }
}
#endif
}

#ifndef CPU_SIM
DEV void ph_hyena_fft(const Params& p, const Ctx& cx, int l) {
  const int nb = gridDim.x;
  for (int i = blockIdx.x; i < 512; i += nb) {
    const int xcd = i & 7, idx = i >> 3;
    const int c = xcd * 64 + idx;
    tz::channel(p, l, c, cx.tid, cx.ldsg);
  }
}
#endif


#ifndef CPU_SIM
DEV void ph_hyena_ctx(const Params& p, const Ctx& cx, int l) {
  constexpr int LP = 33;
  float* Zs = (float*)cx.ldsg; float* Ff = Zs + LC * LP; float* Fb = Ff + LC * LP;
  const int tid = cx.tid, c = tid & 31, t0 = tid >> 5;
  const float* cw = p.in[I_hy_conv_w] + l * 3 * 1536; const float* cbv = p.in[I_hy_conv_b] + l * 1536;
  constexpr int TP = 8, TLEN = LC / TP;
  for (int task = blockIdx.x; task < NB * 16 * TP; task += gridDim.x) {
    const int tp = task % TP, cgp = (task / TP) & 15, b = task / (TP * 16), c0 = cgp * 32;
    const int rbase = NLAT + b * LC;
    __syncthreads();
    for (int idx = tid; idx < LC * 32; idx += 512) {
      { const int t = idx >> 5, cc = idx & 31; Zs[t * LP + cc] = b2f(p.Z()[(size_t)(rbase + t) * 512 + c0 + cc]); }
      { const int cc = idx / LC, t = idx % LC;
        Ff[t * LP + cc] = p.F()[(size_t)(c0 + cc) * (N + LC) + N + t]; Fb[t * LP + cc] = p.F()[(size_t)(512 + c0 + cc) * (N + LC) + N + t]; }
    }
    __syncthreads();
    float ss = 0.f;
    for (int t = 0; t < LC; ++t) { const float a = Ff[t * LP + c], bb = Fb[t * LP + c]; ss += a * a + bb * bb; }
    const float fn = 1.0f / sqrtf(ss + EPS);
    const int cg_ = c0 + c;
    const float w0 = cw[cg_], w1 = cw[1536 + cg_], w2 = cw[2 * 1536 + cg_], cb0 = cbv[cg_], skip = p.in[I_hy_skip][l * 512 + cg_];
    for (int t = tp * TLEN + t0; t < (tp + 1) * TLEN; t += 16) {
      float acc = 0.f;
      for (int s_ = 0; s_ <= t; ++s_) acc += Ff[(t - s_) * LP + c] * Zs[s_ * LP + c];
      for (int s_ = t + 1; s_ < LC; ++s_) acc += Fb[(s_ - t) * LP + c] * Zs[s_ * LP + c];
      const size_t r = (size_t)(rbase + t);
      float x0 = cb0 + w1 * b2f(p.P()[r * PC + C_HU + cg_]);
      if (t > 0) x0 += w0 * b2f(p.P()[(r - 1) * PC + C_HU + cg_]);
      if (t < LC - 1) x0 += w2 * b2f(p.P()[(r + 1) * PC + C_HU + cg_]);
      p.Y()[r * 2048 + 1024 + cg_] = f2b(x0 * (acc * fn + skip * Zs[t * LP + c]));
    }
  }
}
#endif

constexpr int NOSH = 30;

#ifndef CPU_SIM
#define SIDE_PREP(NB0, PARTS) do { if (l == 0 && (int)blockIdx.x >= (NB0)) { PrepCtx pc; pc.tid = cx.tid; pc.tl = (float*)cx.ldsg; pc.rank = (int)blockIdx.x - (NB0); pc.nranks = (int)gridDim.x - (NB0); \
    ph_prep(p, 1, pc, gtid - (NB0) * 512, gsz - (NB0) * 512, (PARTS)); } } while (0)
#else
#define SIDE_PREP(NB0, PARTS)
#endif
DEV void run_phase(const Params& p, int ph, const Ctx& cx) {
  const i64 gtid = cx.gtid, gsz = cx.gsz;
  if (ph == 0) { ph_init(p, gtid, gsz); return; }
  if (ph == NPHASES - 1) { ph_final(p, gtid, gsz); return; }
  const int l = (ph - 1) / PH_PER_LAYER, s = (ph - 1) % PH_PER_LAYER;
  const int last = (l == 1);
  const int nr = last ? NLAT : TT;
#ifdef ONLY
  if (s != ONLY) return;
#endif
  switch (s) {
    case 0: {
      PrepCtx pc;
#ifndef CPU_SIM
      pc.tid = cx.tid; pc.tl = (float*)cx.ldsg; pc.rank = (int)blockIdx.x; pc.nranks = (int)gridDim.x;
      if (l == 0) ph_prep(p, l, pc, gtid, gsz, 15); else ph_prep(p, l, pc, gtid, gsz, 8);
#else
      pc.gtid = gtid; pc.gsz = gsz;
      ph_prep(p, l, pc, gtid, gsz, 15);
#endif
      ph_norm(p, l, 0, TT, gtid, gsz);
    } break;
    case 1: { GemmDesc g{p.h(), p.W_in(), D, D, D, TT, 3840, NOSH, 0}; EpiInproj e{p}; run_gemm(cx, g, e); } break;
#ifndef CPU_SIM
    case 2: ph_B0(p, l, gtid, gsz, cx.ldsg, cx.tid); break;
#else
    case 2: ph_B0(p, l, gtid, gsz); break;
#endif
    case 3: {
      { const int n_uq = (nr / 256) * 3, n_ukv = (TT / 256) * 4, n_lru = (TT / 256) * 8;
        { GemmDesc g{p.P() + C_CQ, p.W_uq(), PC, 256, 256, nr, 768, NOSH, 0}; EpiUq e{p}; run_gemm(cx, g, e); }
        { GemmDesc g{p.P() + C_CKV, p.W_ukv(), PC, 256, 256, TT, 1024, NOSH, 0}; g.unit_off = n_uq; EpiUkv e{p}; run_gemm(cx, g, e); }
        { GemmDesc g{p.XC(), p.W_lru(), 512, 256, 256, TT, 2048, 2, 256}; g.unit_off = n_uq + n_ukv; EpiLru e{p, l, p.in[I_lru_b_r], p.in[I_lru_b_i]}; run_gemm(cx, g, e); }
#ifndef CPU_SIM
        { GemmDesc g{p.W3T(), p.hdn2b() + (size_t)l * (N + LC) * 256, 256, 256, 256, 1024, N + LC, NOSH, 0}; g.unit_off = n_uq + n_ukv + n_lru; EpiFilt e{p}; run_gemm(cx, g, e); }
#endif
      }
#ifdef CPU_SIM
      ph_fnorm(p, gtid, gsz);
#endif
    } break;
    case 4:
      ph_lru1(p, gtid, gsz);
#ifndef CPU_SIM
#if PROBE_K >= 0
#define SUBSTAMP(k) do { cg::this_grid().sync(); if (l == 0) { const unsigned long long t_ = wall_clock64(); if (blockIdx.x == 0 && cx.tid == 0) ((unsigned long long*)(p.ws + WL.ts))[40 + (k)] = t_; } } while (0)
#else
#define SUBSTAMP(k)
#endif
      if (REPEAT_S == 40) ph_lru1(p, gtid, gsz);
      SUBSTAMP(0);
      ph_hyena_fft(p, cx, l);
      if (REPEAT_S == 41) ph_hyena_fft(p, cx, l);
      SUBSTAMP(1);
      ph_gqa(p, cx, l, last);
      if (REPEAT_S == 42) ph_gqa(p, cx, l, last);
      SUBSTAMP(2);
      ph_mla(p, cx, last);
      if (REPEAT_S == 43) ph_mla(p, cx, last);
      SUBSTAMP(3);
      if (!last) ph_hyena_ctx(p, cx, l);
      if (REPEAT_S == 44 && !last) ph_hyena_ctx(p, cx, l);
#else
      ph_C(p, l, last, gtid, gsz);
#endif
      break;
#ifndef CPU_SIM
    case 5: ph_lru3(p, last, gtid, gsz, (float*)cx.ldsg, cx.tid); __syncthreads(); tz::xyt_to_y(p, cx.tid, cx.ldsg); break;
#else
    case 5: ph_lru3(p, last, gtid, gsz, nullptr, 0); break;
#endif
    case 6: { GemmDesc g{p.h(), p.W_g(), D, D, D, nr, 4096, NOSH, 0}; EpiGateAll e{p}; run_gemm(cx, g, e); } break;
    case 7: { GemmDesc g{p.Y(), p.W_br(), 2048, 512, 512, nr, 1024, NOSH, 0, 4, 512, 1024 * 512}; EpiBranchSub e{p}; run_gemm(cx, g, e); }
      SIDE_PREP(8, 1);
      break;
    case 8: { GemmDesc g{p.M(), p.W_out(), D, D, D, nr, 1024, NOSH, 0}; EpiOut e{p, l, 1.0f, l == 0 ? p.in[I_x] : (const float*)p.xcur(), l == 0 ? p.in[I_ctx] : (const float*)p.xcur() + (size_t)NLAT * D}; run_gemm(cx, g, e); }
#ifndef CPU_SIM
      if (l == 0 && blockIdx.x >= 8) ph_cvt_tables(p, l, gtid - 8 * 512, gsz - 8 * 512);
#endif
      break;
    case 9:
#ifndef CPU_SIM
      if (l != 0) ph_cvt_tables(p, l, gtid, gsz);
#endif
      ph_norm(p, l, 1, nr, gtid, gsz); break;
    case 10: { GemmDesc g{p.h(), p.W_q(), D, D, D, nr, 1024, NOSH, 0}; EpiPQ e{p}; run_gemm(cx, g, e); }
      SIDE_PREP(8, 2);
      break;
    case 11: { GemmDesc g{p.PQ(), p.W_key(), 1024, 256, 256, nr, 2048, 1, 256}; EpiSC e{p}; run_gemm(cx, g, e); }
      SIDE_PREP(16, 4);
      break;
#ifndef CPU_SIM
    case 12: ph_peer(p, l, nr, cx.tid, cx.ldsg); if (REPEAT_S == 52) { __syncthreads(); ph_peer(p, l, nr, cx.tid, cx.ldsg, 0.0f); } break;
#else
    case 12: ph_E2a(p, nr, gtid, gsz); break;
    case 13: ph_E2b(p, nr, gtid, gsz); break;
    case 14: ph_E3(p, l, nr, gtid, gsz); break;
    case 15: ph_E4(p, l, nr, gtid, gsz); break;
#endif
  }
}

#ifdef CPU_SIM
static void fill_params(Params& p, void* const* d_in, void* d_out, void* d_ws) {
  p.in.t = (const float* const*)d_in;
  p.out = (float*)d_out;
  p.ws = (char*)d_ws;
}
#endif


#ifndef CPU_SIM
#define XB_TMO      128
#define XB_XCNT(j)  (256  + 64 * (j))
#define XB_XSUB(j)  (1280 + 64 * (j))
#define XB_XGEN(j)  (2304 + 64 * (j))
#define XB_TOP      3328
#define XB_TOPGEN   3392
#define XCD_BAR_WORDS 3456
#define XB_SPIN_CAP (1u << 18)
#define XB_LAS __attribute__((address_space(3)))
__device__ __forceinline__ unsigned xb_ld(unsigned* p)              { return __hip_atomic_load(p, __ATOMIC_RELAXED, __HIP_MEMORY_SCOPE_AGENT); }
__device__ __forceinline__ unsigned xb_add(unsigned* p, unsigned v) { return __hip_atomic_fetch_add(p, v, __ATOMIC_RELAXED, __HIP_MEMORY_SCOPE_AGENT); }
__device__ __forceinline__ unsigned xb_xcc_id() { return (unsigned)__builtin_amdgcn_s_getreg((3 << 11) | 20) & 0xFu; }
#define XB_SPIN(cond, bar) do { unsigned _sp = 0; while (cond) { __builtin_amdgcn_s_sleep(1); \
    if ((++_sp & 255u) == 0u) { if (xb_ld(&(bar)[XB_TMO])) break; if (_sp > XB_SPIN_CAP) { atomicAdd(&(bar)[XB_TMO], 1u); break; } } } } while (0)
struct XcdBarrier { unsigned* bar; unsigned x; volatile XB_LAS unsigned* st; };
__device__ __forceinline__ XcdBarrier xcd_barrier_post(unsigned* bar, volatile XB_LAS unsigned* st) {
  XcdBarrier b; b.bar = bar; b.x = xb_xcc_id(); b.st = st;
  if (threadIdx.x == 0) (void)xb_add(&bar[XB_XCNT(b.x)], 1u);
  return b;
}
__device__ __forceinline__ void xcd_barrier_complete(unsigned* bar, unsigned x, unsigned& nloc, unsigned& nx) {
  const unsigned G = gridDim.x * gridDim.y * gridDim.z;
  unsigned sum, cnt, mine, sp = 0u;
  for (;;) {
    sum = 0u; cnt = 0u; mine = 0u;
#pragma unroll
    for (unsigned j = 0; j < 16; ++j) { const unsigned c = xb_ld(&bar[XB_XCNT(j)]); sum += c; cnt += (c > 0u) ? 1u : 0u; mine = (j == x) ? c : mine; }
    if (sum == G) break;
    __builtin_amdgcn_s_sleep(1);
    if ((++sp & 255u) == 0u) { if (xb_ld(&bar[XB_TMO])) break; if (sp > XB_SPIN_CAP) { atomicAdd(&bar[XB_TMO], 1u); break; } }
  }
  nloc = mine > 0u ? mine : 1u; nx = cnt > 0u ? cnt : 1u;
}
__device__ __forceinline__ void xcd_barrier(const XcdBarrier& b) {
  asm volatile("s_waitcnt vmcnt(0)" ::: "memory");
  __syncthreads();
  if (threadIdx.x == 0) {
    unsigned* bar = b.bar;
    __builtin_amdgcn_s_waitcnt(0);
    unsigned nloc = b.st[0], nx = b.st[1];
    if (nloc == 0u) { xcd_barrier_complete(bar, b.x, nloc, nx); b.st[0] = nloc; b.st[1] = nx; }
    const unsigned old = xb_add(&bar[XB_XSUB(b.x)], 1u);
    const unsigned gen = old / nloc;
    if (old + 1u == (gen + 1u) * nloc) {
      __builtin_amdgcn_fence(__ATOMIC_RELEASE, "agent");
      asm volatile("s_waitcnt vmcnt(0)" ::: "memory");
      const unsigned og = xb_add(&bar[XB_TOP], 1u);
      const unsigned tg = og / nx;
      if (og + 1u == (tg + 1u) * nx) xb_add(&bar[XB_TOPGEN], 1u);
      else XB_SPIN(xb_ld(&bar[XB_TOPGEN]) == tg, bar);
      __builtin_amdgcn_fence(__ATOMIC_ACQUIRE, "agent");
      xb_add(&bar[XB_XGEN(b.x)], 1u);
      asm volatile("s_waitcnt vmcnt(0)" ::: "memory");
    } else {
      XB_SPIN(xb_ld(&bar[XB_XGEN(b.x)]) == gen, bar);
      __builtin_amdgcn_fence(__ATOMIC_ACQUIRE, "agent");
      asm volatile("s_waitcnt vmcnt(0)" ::: "memory");
    }
  }
  __syncthreads();
}
#endif

#ifndef CPU_SIM
static_assert(TT % 256 == 0 && NLAT % 256 == 0 && (N + LC) % 256 == 0, "row / column tiles");
static_assert(N / 256 == 32 && NB * 8 * (N / 256) == 512, "attention unit mapping assumes 32 q-blocks per (batch, head) and a 256-block grid");
constexpr int LDS_PHASE_BYTES = 131072 + 4096;
constexpr int LDS_BYTES = LDS_PHASE_BYTES + 16;
__global__ void __launch_bounds__(512, 2) mega_kernel(KArgs ka) {
  extern __shared__ __attribute__((aligned(16))) unsigned char shm[];
  cg::grid_group grid = cg::this_grid();
#if PROBE_K >= 0
  unsigned long long* const tsp = (unsigned long long*)(ka.ws + WL.ts);
#endif
  {
    int tid = threadIdx.x;
    asm volatile("" : "+v"(tid));
    const i64 gtid = (i64)blockIdx.x * 512 + tid, gsz = (i64)gridDim.x * 512;
    ph_init(ka, gtid, gsz, (char*)shm, tid);
    if (gtid < N_IN) ((const float**)(ka.ws + WL.tbl))[gtid] = ka.in[gtid];
#if PROBE_K >= 0
    { const unsigned long long t_ = wall_clock64(); if (gtid == 0) tsp[0] = t_; }
#endif
  }
  volatile XB_LAS unsigned* xst = (volatile XB_LAS unsigned*)(shm + LDS_PHASE_BYTES);
  if (threadIdx.x == 0) { xst[0] = 0u; xst[1] = 0u; }
  __syncthreads();
  const XcdBarrier xb = xcd_barrier_post((unsigned*)(ka.ws + WL.bar), xst);
  grid.sync();
#if PROBE_K >= 0
  { const unsigned long long t_ = wall_clock64(); if (blockIdx.x == 0 && threadIdx.x == 0) tsp[1] = t_; }
#endif
  Params p; p.out = ka.out; p.ws = ka.ws; p.in.t = (const float* const*)(ka.ws + WL.tbl);
  for (int ph = 1; ph < NPHASES - 1; ++ph) {
    int tid = threadIdx.x;
    asm volatile("" : "+v"(tid));
    Ctx cx;
    cx.tid = tid;
    cx.gtid = (i64)blockIdx.x * 512 + tid; cx.gsz = (i64)gridDim.x * 512;
    cx.lds = (PG8_LAS unsigned char*)shm; cx.ldsg = (char*)shm;
    run_phase(p, ph, cx);
    if (REPEAT_S >= 0 && REPEAT_S < 40 && (ph - 1) % PH_PER_LAYER == REPEAT_S) { __syncthreads(); run_phase(p, ph, cx); }
    xcd_barrier(xb);
#if PROBE_K >= 0
    { const unsigned long long t_ = wall_clock64(); if (blockIdx.x == 0 && threadIdx.x == 0) tsp[ph + 1] = t_; }
    if (ph == NPHASES - 2) grid.sync();
#endif
  }
  {
    int tid = threadIdx.x;
    asm volatile("" : "+v"(tid));
    ph_final(p, (i64)blockIdx.x * 512 + tid, (i64)gridDim.x * 512);
  }
}

extern "C" void kernel_launch(void* const* d_in, const int* in_sizes, int n_in, void* d_out, int out_size,
                              void* d_ws, size_t ws_size, hipStream_t stream) {
  static int grid_blocks = 0;
  if (!grid_blocks) {
    int dev = 0, cus = 0, per_cu = 0;
    (void)hipGetDevice(&dev);
    (void)hipDeviceGetAttribute(&cus, hipDeviceAttributeMultiprocessorCount, dev);
    if (hipFuncSetAttribute((const void*)mega_kernel, hipFuncAttributeMaxDynamicSharedMemorySize, LDS_BYTES) != hipSuccess)
      fprintf(stderr, "hipFuncSetAttribute failed\n");
    (void)hipOccupancyMaxActiveBlocksPerMultiprocessor(&per_cu, mega_kernel, 512, LDS_BYTES);
    if (per_cu > 1) per_cu = 1;
    if (per_cu < 1) per_cu = 1;
    grid_blocks = cus * per_cu;
  }
  (void)hipMemsetAsync((char*)d_ws + WL.bar, 0, (size_t)3456 * 4, stream);
  KArgs ka;
  std::memset((void*)&ka, 0, sizeof(ka));
  for (int i = 0; i < N_IN; ++i) ka.in[i] = (const float*)d_in[i];
  ka.out = (float*)d_out; ka.ws = (char*)d_ws;
  void* args[] = {&ka};
  hipError_t e = hipLaunchCooperativeKernel((void*)mega_kernel, dim3(grid_blocks), dim3(512), args, LDS_BYTES, stream);
  if (e != hipSuccess) fprintf(stderr, "cooperative launch failed: %s (grid %d)\n", hipGetErrorString(e), grid_blocks);
}
#endif
```

```cpp
#ifndef CPU_SIM
#include <hip/hip_runtime.h>
#include <hip/hip_cooperative_groups.h>
#include <cstdio>
#include <cstring>
namespace cg = cooperative_groups;
#define DEV __device__ __forceinline__
#define DEVN __device__ __forceinline__
#define MDEV __device__ __forceinline__
typedef _Float16 sc_t;
#else
#include <cmath>
#include <cstdio>
#include <cstdint>
#include <cstring>
#define DEV static inline
#define DEVN static
#define MDEV inline
typedef float sc_t;
#endif

#ifndef REPEAT_S
#define REPEAT_S -1
#endif
#ifndef PROBE_K
#define PROBE_K -1
#endif
#ifndef SEQ_N
#define SEQ_N 8192
#endif
#ifndef CTX_L
#define CTX_L 256
#endif

typedef long long i64;

constexpr int D = 1024, NB = 2, N = SEQ_N, LC = CTX_L;
constexpr int NLAT = NB * N, NCTX = NB * LC, TT = NLAT + NCTX;
constexpr int GRIDW = 64;
constexpr int INC = 7840, PC = 3840;
constexpr int C_CQ = 0, C_CKV = 256, C_KR = 384, C_LX = 416, C_LG = 928, C_HU = 1440, C_GQ = 2976, C_GKV = 3488, C_GT = 3744;
constexpr int NEXP = 16384;
constexpr float EPS = 1e-6f;
#ifndef CPU_SIM
constexpr int PH_PER_LAYER = 13;
#else
constexpr int PH_PER_LAYER = 16;
#endif
constexpr int NPHASES = 2 + 2 * PH_PER_LAYER;
constexpr int LCH = 64, NCC = LC / LCH, NCL = N / LCH, NCHK = NCC + NCL;

enum { I_x, I_c, I_ctx, I_c_ctx, I_g_mix, I_g_ffn, I_w_mod, I_b_mod, I_w_in, I_mla_g_cq, I_mla_g_ckv, I_mla_w_uq,
       I_mla_w_ukv, I_lru_conv_w, I_lru_conv_b, I_lru_w_r, I_lru_b_r, I_lru_w_i, I_lru_b_i, I_lru_lam,
       I_hy_conv_w, I_hy_conv_b, I_hy_w1, I_hy_b1, I_hy_f1, I_hy_w2, I_hy_b2, I_hy_f2, I_hy_w3, I_hy_skip,
       I_gqa_sink, I_w_branch, I_w_out, I_peer_w_q, I_peer_keys, I_peer_u, I_peer_v, I_g_final, N_IN };

struct bf { unsigned short v; };
DEV float b2f(bf x) { union { unsigned u; float f; } c; c.u = ((unsigned)x.v) << 16; return c.f; }
DEV bf f2b(float f) { union { unsigned u; float f; } c; c.f = f; unsigned r = c.u + 0x7FFFu + ((c.u >> 16) & 1u); bf o; o.v = (unsigned short)(r >> 16); return o; }


constexpr size_t al256(size_t x) { return (x + 255) & ~(size_t)255; }
struct WsLayout {
  size_t xcur, mods, hdn2, ssq, tabA, tabD, fnorm, SA, SB, tw, tbl, ts, spl, bar, hdn2b, W3T, h, Y, Z, XC, LA, LB, P, QA, KVA;
  size_t W_in, W_g, W_uq, W_ukv, W_lru, W_br, W_out, W_q, W_key;
  size_t M, Gs, G, SC, TKs, TKi, SELi, SELg, W, Ub, Vb, YT, total;
};
constexpr WsLayout make_layout() {
  WsLayout w{};
  size_t o = 0;
  w.xcur = o; o = al256(o + (size_t)TT * D * 4);
  w.mods = o; o = al256(o + (size_t)2 * 3 * 6 * D * 4);
  w.hdn2 = o; o = al256(o + (size_t)2 * (N + LC) * 64 * 4);
  w.ssq = o; o = al256(o + (size_t)2 * TT * 4);
  w.tabA = o; o = al256(o + (size_t)128 * 8 * 2 * 4);
  w.tabD = o; o = al256(o + (size_t)128 * 16 * 2 * 4);
  w.fnorm = o; o = al256(o + (size_t)2 * 512 * 4);
  w.tw = o; o = al256(o + (size_t)2 * N * 8);
  w.tbl = o; o = al256(o + (size_t)N_IN * 8);
  w.ts = o; o = al256(o + (size_t)64 * 8);
  w.spl = o; o = al256(o + (size_t)2 * 2 * 512 * 4);
  w.bar = o; o = al256(o + (size_t)3456 * 4);
  w.hdn2b = o; o = al256(o + (size_t)2 * (N + LC) * 256 * 2);
  w.W3T = o; o = al256(o + (size_t)1024 * 256 * 2);
  w.SA = o; o = al256(o + (size_t)2 * NB * NCHK * 512 * 4);
  w.SB = o; o = al256(o + (size_t)2 * NB * NCHK * 512 * 4);
  w.h = o; o = al256(o + (size_t)TT * D * 2);
  w.Y = o; w.Ub = o; w.Vb = o + (size_t)NEXP * D; o = al256(o + (size_t)TT * 2048 * 2);
  w.Z = o; o = al256(o + (size_t)TT * 512 * 2);
  w.W_in = o; o = al256(o + (size_t)3840 * 1024 * 2);
  w.W_g = o; o = al256(o + (size_t)4096 * 1024 * 2);
  w.W_uq = o; o = al256(o + (size_t)768 * 256 * 2);
  w.W_ukv = o; o = al256(o + (size_t)1024 * 256 * 2);
  w.W_lru = o; o = al256(o + (size_t)2048 * 256 * 2);
  w.W_br = o; o = al256(o + (size_t)4 * 1024 * 512 * 2);
  w.W_out = o; o = al256(o + (size_t)1024 * 1024 * 2);
  w.W_q = o; o = al256(o + (size_t)1024 * 1024 * 2);
  w.W_key = o; o = al256(o + (size_t)2048 * 256 * 2);
  size_t rl = o;
  w.XC = o; o = al256(o + (size_t)TT * 512 * 2);
  w.LA = o; o = al256(o + (size_t)2 * TT * 512 * 2);
  w.LB = o; o = al256(o + (size_t)2 * TT * 512 * 2);
  size_t rl_end = o;
  o = rl;
  w.TKs = o; o = al256(o + (size_t)TT * 256 * 4);
  w.TKi = o; o = al256(o + (size_t)TT * 256 * 4);
  w.SELi = o; o = al256(o + (size_t)TT * 128 * 4);
  w.SELg = o; o = al256(o + (size_t)TT * 128 * 4);
  w.W = o; o = al256(o + (size_t)TT * 128 * 4);
  if (o > rl_end) rl_end = o;
  o = rl_end;
  size_t rp = o;
  w.P = o; o = al256(o + (size_t)TT * PC * 2);
  w.QA = o; o = al256(o + (size_t)TT * 768 * 2);
  w.KVA = o; o = al256(o + (size_t)TT * 1024 * 2);
  size_t rp_end = o;
  o = rp;
  w.M = o; o = al256(o + (size_t)TT * D * 2);
  w.G = o; if (o + (size_t)TT * 3072 * 2 > rp_end) rp_end = o + (size_t)TT * 3072 * 2;
  w.Gs = o; o = al256(o + (size_t)TT * D * 2);
  w.SC = o; o = al256(o + (size_t)TT * 2048 * sizeof(sc_t));
  if (o > rp_end) rp_end = o;
  w.YT = rp_end; rp_end = al256(rp_end + (size_t)512 * NB * N * 2);
  w.total = rp_end;
  return w;
}
constexpr WsLayout WL = make_layout();
static_assert((size_t)TT * 4096 <= (size_t)TT * 512 * 2 + (size_t)4 * TT * 512 * 2, "uint8 gates must fit in the XC/LA/LB region");
static_assert(WL.LB == WL.LA + (size_t)2 * TT * 512 * 2, "LA and LB must be contiguous (packed GPU layout)");
static_assert(WL.total <= (size_t)512 * 1024 * 1024, "workspace too large");
#ifndef CPU_SIM
static_assert((size_t)2 * NEXP * D * 2 <= (size_t)TT * 2048 * 2, "bf16 expert tables must fit in Y");
#endif
struct WsAcc {
  float* out;
  char* ws;
  MDEV float* xcur() const { return (float*)(ws + WL.xcur); }
  MDEV float* mods() const { return (float*)(ws + WL.mods); }
  MDEV float* hdn2() const { return (float*)(ws + WL.hdn2); }
  MDEV float* ssq() const { return (float*)(ws + WL.ssq); }
  MDEV float* tabA() const { return (float*)(ws + WL.tabA); }
  MDEV float* tabD() const { return (float*)(ws + WL.tabD); }
  MDEV float* fnorm() const { return (float*)(ws + WL.fnorm); }
  MDEV float* tw() const { return (float*)(ws + WL.tw); }
  MDEV unsigned* Hs() const { return (unsigned*)((char*)out + (((size_t)(N + LC) * 1024 * 4 + 255) & ~(size_t)255)); }
  MDEV float* spl() const { return (float*)(ws + WL.spl); }
  MDEV bf* XYT() const { return (bf*)((char*)out + (((size_t)(N + LC) * 1024 * 4 + 255) & ~(size_t)255)); }
  MDEV bf* hdn2b() const { return (bf*)(ws + WL.hdn2b); }
  MDEV bf* W3T() const { return (bf*)(ws + WL.W3T); }
  MDEV float* SA() const { return (float*)(ws + WL.SA); }
  MDEV float* SB() const { return (float*)(ws + WL.SB); }
  MDEV bf* h() const { return (bf*)(ws + WL.h); }
  MDEV bf* Y() const { return (bf*)(ws + WL.Y); }
  MDEV bf* Z() const { return (bf*)(ws + WL.Z); }
  MDEV bf* XC() const { return (bf*)(ws + WL.XC); }
  MDEV bf* LA() const { return (bf*)(ws + WL.LA); }
  MDEV bf* LB() const { return (bf*)(ws + WL.LB); }
  MDEV bf* P() const { return (bf*)(ws + WL.P); }
  MDEV bf* QA() const { return (bf*)(ws + WL.QA); }
  MDEV bf* KVA() const { return (bf*)(ws + WL.KVA); }
  MDEV float* F() const { return out; }
  MDEV bf* W_in() const { return (bf*)(ws + WL.W_in); }
  MDEV bf* W_g() const { return (bf*)(ws + WL.W_g); }
  MDEV bf* W_uq() const { return (bf*)(ws + WL.W_uq); }
  MDEV bf* W_ukv() const { return (bf*)(ws + WL.W_ukv); }
  MDEV bf* W_lru() const { return (bf*)(ws + WL.W_lru); }
  MDEV bf* W_br() const { return (bf*)(ws + WL.W_br); }
  MDEV bf* W_out() const { return (bf*)(ws + WL.W_out); }
  MDEV bf* W_q() const { return (bf*)(ws + WL.W_q); }
  MDEV bf* W_key() const { return (bf*)(ws + WL.W_key); }
  MDEV bf* M() const { return (bf*)(ws + WL.M); }
  MDEV bf* Gs() const { return (bf*)(ws + WL.Gs); }
  MDEV bf* PQ() const { return (bf*)(ws + WL.Gs); }
  MDEV bf* BR() const { return (bf*)(ws + WL.G); }
  MDEV unsigned char* G8() const { return (unsigned char*)(ws + WL.XC); }
  MDEV unsigned* LAB() const { return (unsigned*)(ws + WL.LA); }
  MDEV bf* YT() const { return (bf*)(ws + WL.YT); }
  MDEV sc_t* SC() const { return (sc_t*)(ws + WL.SC); }
  MDEV float* TKs() const { return (float*)(ws + WL.TKs); }
  MDEV int* TKi() const { return (int*)(ws + WL.TKi); }
  MDEV int* SELi() const { return (int*)(ws + WL.SELi); }
  MDEV float* SELg() const { return (float*)(ws + WL.SELg); }
  MDEV float* W() const { return (float*)(ws + WL.W); }
  MDEV bf* Ub() const { return (bf*)(ws + WL.Ub); }
  MDEV bf* Vb() const { return (bf*)(ws + WL.Vb); }
};
struct KArgs : WsAcc { const float* in[N_IN]; };
#ifndef CPU_SIM
typedef float v4f_gl __attribute__((ext_vector_type(4)));
DEV float4 gld4(const void* q) { const v4f_gl r = *(const __attribute__((address_space(1))) v4f_gl*)q; return float4{r.x, r.y, r.z, r.w}; }
DEV float gld1(const float* q) { return *(const __attribute__((address_space(1))) float*)q; }
#else
DEV float gld1(const float* q) { return *q; }
#endif
#ifndef CPU_SIM
typedef const __attribute__((address_space(1))) float* GF;
#else
typedef const float* GF;
#endif
struct InTab {
  const float* const* t;
#ifndef CPU_SIM
  MDEV const float* operator[](int i) const { return t[i]; }
#else
  MDEV const float* operator[](int i) const { return t[i]; }
#endif
};
struct Params : WsAcc { InTab in; };
static_assert((size_t)(N + LC) * 1024 * 4 + 256 + (size_t)256 * 2 * N * 4 <= (size_t)NLAT * D * 4, "F + spectrum scratch must fit in d_out");

#ifndef CPU_SIM
DEV float fexpf_(float x) { return __builtin_amdgcn_exp2f(x * 1.4426950408889634f); }
DEV float sigmoidf_(float x) { return __builtin_amdgcn_rcpf(1.0f + __builtin_amdgcn_exp2f(-x * 1.4426950408889634f)); }
DEV float siluf_(float x) { return x * sigmoidf_(x); }
DEV float geluf_(float x) { return x * sigmoidf_(1.5957691216057308f * (x + 0.044715f * x * x * x)); }
#else
DEV float fexpf_(float x) { return expf(x); }
DEV float sigmoidf_(float x) { return 1.0f / (1.0f + expf(-x)); }
DEV float siluf_(float x) { return x * sigmoidf_(x); }
DEV float geluf_(float x) { return 0.5f * x * (1.0f + tanhf(0.7978845608028654f * (x + 0.044715f * x * x * x))); }
#endif
DEV float softplusf_(float x) { return x > 20.f ? x : log1pf(expf(x)); }

#ifndef CPU_SIM
DEV float lane_xor(float v, int lane, int o) { return __int_as_float(__builtin_amdgcn_ds_bpermute(((lane ^ o) & 63) << 2, __float_as_int(v))); }
#endif
#ifndef CPU_SIM
DEV void unpack8(const uint4 w, float* f) {
  union { unsigned u; float x; } c;
  c.u = w.x << 16; f[0] = c.x; c.u = w.x & 0xFFFF0000u; f[1] = c.x; c.u = w.y << 16; f[2] = c.x; c.u = w.y & 0xFFFF0000u; f[3] = c.x;
  c.u = w.z << 16; f[4] = c.x; c.u = w.z & 0xFFFF0000u; f[5] = c.x; c.u = w.w << 16; f[6] = c.x; c.u = w.w & 0xFFFF0000u; f[7] = c.x;
}
#endif
struct RowInfo { int b, t, L, base, lat; };
DEV RowInfo rowinfo(int r) {
  RowInfo ri;
  if (r < NLAT) { ri.b = r / N; ri.t = r - ri.b * N; ri.L = N; ri.base = ri.b * N; ri.lat = 1; }
  else { int rc = r - NLAT; ri.b = rc / LC; ri.t = rc - ri.b * LC; ri.L = LC; ri.base = NLAT + ri.b * LC; ri.lat = 0; }
  return ri;
}
DEV int modrow(int r) { return r < NLAT ? r / N : 2; }
template <class PT> DEV const float* xin_row(const PT& p, int r) { return r < NLAT ? p.in[I_x] + (size_t)r * D : p.in[I_ctx] + (size_t)(r - NLAT) * D; }

DEV void atomic_addf(float* p, float v) {
#ifndef CPU_SIM
  atomicAdd(p, v);
#else
#pragma omp atomic
  *p += v;
#endif
}
DEV void store8bf(bf* dst, const float* v) {
#ifndef CPU_SIM
  uint4 w;
  asm volatile("v_cvt_pk_bf16_f32 %0, %1, %2" : "=v"(w.x) : "v"(v[0]), "v"(v[1]));
  asm volatile("v_cvt_pk_bf16_f32 %0, %1, %2" : "=v"(w.y) : "v"(v[2]), "v"(v[3]));
  asm volatile("v_cvt_pk_bf16_f32 %0, %1, %2" : "=v"(w.z) : "v"(v[4]), "v"(v[5]));
  asm volatile("v_cvt_pk_bf16_f32 %0, %1, %2" : "=v"(w.w) : "v"(v[6]), "v"(v[7]));
  *(uint4*)dst = w;
#else
  for (int j = 0; j < 8; ++j) dst[j] = f2b(v[j]);
#endif
}
#ifndef CPU_SIM
DEV unsigned pk2bf(float lo, float hi) { unsigned r; asm volatile("v_cvt_pk_bf16_f32 %0, %1, %2" : "=v"(r) : "v"(lo), "v"(hi)); return r; }
#endif
DEV void load8bf(const bf* src, float* v) {
#ifndef CPU_SIM
  uint4 w = *(const uint4*)src;
  union { unsigned u; float f; } c;
  c.u = w.x << 16; v[0] = c.f; c.u = w.x & 0xFFFF0000u; v[1] = c.f;
  c.u = w.y << 16; v[2] = c.f; c.u = w.y & 0xFFFF0000u; v[3] = c.f;
  c.u = w.z << 16; v[4] = c.f; c.u = w.z & 0xFFFF0000u; v[5] = c.f;
  c.u = w.w << 16; v[6] = c.f; c.u = w.w & 0xFFFF0000u; v[7] = c.f;
#else
  for (int j = 0; j < 8; ++j) v[j] = b2f(src[j]);
#endif
}

DEV int win_src(int n) {
  if (n >= 3744) return -1;
  if (n >= C_KR && n < C_KR + 32) { int q = n - C_KR; int pi = q >> 1, wh = q & 1, half = pi >> 3, f = pi & 7; return C_KR + half * 16 + f + wh * 8; }
  if (n >= C_GQ && n < C_GKV + 128) { int q = n - C_GQ; int hh = q >> 6, d = q & 63; int pi = d >> 1, wh = d & 1, half = pi >> 4, f = pi & 15; return C_GQ + hh * 64 + half * 32 + f + wh * 16; }
  return n;
}
DEV int wuq_src(int n) {
  int hh = n / 96, d = n % 96;
  if (d < 64) return n;
  int q = d - 64; int pi = q >> 1, wh = q & 1, half = pi >> 3, f = pi & 7;
  return hh * 96 + 64 + half * 16 + f + wh * 8;
}

template <class PT> DEVN void ph_init(const PT& p, i64 gtid, i64 gsz, char* ilds = nullptr, int itid = 0) {
#ifndef CPU_SIM
  {
    float* sl = (float*)ilds;
    for (int q = itid; q < 3 * D; q += 512) { const int rr = q / D, k = q - rr * D; sl[q] = siluf_(rr < 2 ? p.in[I_c][rr * D + k] : p.in[I_c_ctx][k]); }
    __syncthreads();
    float* red3 = sl + 3 * D;
    const int wv_ = itid >> 6, ln_ = itid & 63;
    for (int task = blockIdx.x; task < 2 * 6 * D / 64; task += gridDim.x) {
      const int l = task / (6 * D / 64), j = (task % (6 * D / 64)) * 64 + ln_;
      const float* w = p.in[I_w_mod] + (size_t)l * D * 6 * D + j;
      float a0 = 0.f, a1 = 0.f, a2 = 0.f;
#pragma unroll 1
      for (int k0 = wv_ * 128; k0 < wv_ * 128 + 128; k0 += 16) {
        float wv[16];
#pragma unroll
        for (int q = 0; q < 16; ++q) wv[q] = w[(size_t)(k0 + q) * 6 * D];
#pragma unroll
        for (int q = 0; q < 16; ++q) { a0 += sl[k0 + q] * wv[q]; a1 += sl[D + k0 + q] * wv[q]; a2 += sl[2 * D + k0 + q] * wv[q]; }
      }
      __syncthreads();
      red3[(wv_ * 3 + 0) * 64 + ln_] = a0; red3[(wv_ * 3 + 1) * 64 + ln_] = a1; red3[(wv_ * 3 + 2) * 64 + ln_] = a2;
      __syncthreads();
      if (itid < 192) {
        const int v3 = itid >> 6, jj = itid & 63;
        float sum = p.in[I_b_mod][l * 6 * D + (task % (6 * D / 64)) * 64 + jj];
#pragma unroll
        for (int w8 = 0; w8 < 8; ++w8) sum += red3[(w8 * 3 + v3) * 64 + jj];
        p.mods()[((size_t)l * 3 + v3) * 6 * D + (task % (6 * D / 64)) * 64 + jj] = sum;
      }
    }
    __syncthreads();
  }
  {
    float* h1 = (float*)ilds;
    for (i64 i = gtid; i < (i64)2 * (N + LC); i += gsz) {
      const int l = (int)(i / (N + LC)), tt = (int)(i % (N + LC));
      int t, L; if (tt < N) { t = tt; L = N; } else { t = tt - N; L = LC; }
      const float tn = (float)t / (float)(L - 1);
      const float wt = 6.283185307179586f * (float)t / (float)L;
      const float* w1 = p.in[I_hy_w1] + l * 33 * 64; const float* b1 = p.in[I_hy_b1] + l * 64; const float* f1 = p.in[I_hy_f1] + l * 64;
      const float* w2 = p.in[I_hy_w2] + l * 64 * 64; const float* b2 = p.in[I_hy_b2] + l * 64; const float* f2 = p.in[I_hy_f2] + l * 64;
      { uint4* zp_ = (uint4*)(p.hdn2b() + ((size_t)l * (N + LC) + tt) * 256 + 64);
#pragma unroll
        for (int q = 0; q < 24; ++q) zp_[q] = uint4{0, 0, 0, 0}; }
      float zc[16], zs[16];
#pragma unroll
      for (int bd = 0; bd < 16; ++bd) { const float ang = (1e-4f + (float)bd * ((15.0f - 1e-4f) / 15.0f)) * wt; zc[bd] = cosf(ang); zs[bd] = sinf(ang); }
#pragma unroll 1
      for (int k1 = 0; k1 < 64; ++k1) {
        float a1 = b1[k1] + tn * w1[k1];
#pragma unroll
        for (int bd = 0; bd < 16; ++bd) a1 += zc[bd] * w1[(1 + bd) * 64 + k1] - zs[bd] * w1[(17 + bd) * 64 + k1];
        h1[k1 * 512 + itid] = sinf(f1[k1] * a1);
      }
#pragma unroll 1
      for (int j0 = 0; j0 < 64; j0 += 4) {
        float c0 = b2[j0], c1 = b2[j0 + 1], c2 = b2[j0 + 2], c3 = b2[j0 + 3];
#pragma unroll 8
        for (int k1 = 0; k1 < 64; ++k1) { const float hv = h1[k1 * 512 + itid]; const float4 wv = *(const float4*)(w2 + k1 * 64 + j0); c0 += hv * wv.x; c1 += hv * wv.y; c2 += hv * wv.z; c3 += hv * wv.w; }
        bf* ot = p.hdn2b() + ((size_t)l * (N + LC) + tt) * 256 + j0;
        ot[0] = f2b(sinf(f2[j0] * c0)); ot[1] = f2b(sinf(f2[j0 + 1] * c1)); ot[2] = f2b(sinf(f2[j0 + 2] * c2)); ot[3] = f2b(sinf(f2[j0 + 3] * c3));
      }
    }
  }
#else
  for (i64 i = gtid; i < 2 * 3 * 6 * D; i += gsz) {
    int l = (int)(i / (3 * 6 * D)); int rr = (int)((i / (6 * D)) % 3); int j = (int)(i % (6 * D));
    const float* cv = rr < 2 ? p.in[I_c] + rr * D : p.in[I_c_ctx];
    const float* w = p.in[I_w_mod] + (size_t)l * D * 6 * D;
    float acc = p.in[I_b_mod][l * 6 * D + j];
    for (int k = 0; k < D; ++k) acc += siluf_(cv[k]) * w[(size_t)k * 6 * D + j];
    p.mods()[i] = acc;
  }
  for (i64 i = gtid; i < (i64)2 * (N + LC) * 64; i += gsz) {
    int l = (int)(i / ((i64)(N + LC) * 64)); int tt = (int)((i / 64) % (N + LC)); int j2 = (int)(i % 64);
    int t, L; if (tt < N) { t = tt; L = N; } else { t = tt - N; L = LC; }
    float tn = (float)t / (float)(L - 1);
    float wt = 6.283185307179586f * (float)t / (float)L;
    const float* w1 = p.in[I_hy_w1] + l * 33 * 64; const float* b1 = p.in[I_hy_b1] + l * 64; const float* f1 = p.in[I_hy_f1] + l * 64;
    const float* w2 = p.in[I_hy_w2] + l * 64 * 64; const float* b2 = p.in[I_hy_b2] + l * 64; const float* f2 = p.in[I_hy_f2] + l * 64;
    float acc2 = b2[j2];
    for (int k1 = 0; k1 < 64; ++k1) {
      float a1 = b1[k1] + tn * w1[k1];
      for (int bd = 0; bd < 16; ++bd) {
        float band = 1e-4f + (float)bd * ((15.0f - 1e-4f) / 15.0f);
        float ang = band * wt;
        a1 += cosf(ang) * w1[(1 + bd) * 64 + k1] - sinf(ang) * w1[(17 + bd) * 64 + k1];
      }
      acc2 += sinf(f1[k1] * a1) * w2[k1 * 64 + j2];
    }
    p.hdn2()[i] = sinf(f2[j2] * acc2);
  }
#endif
#ifdef CPU_SIM
  for (i64 i = gtid; i < 2 * N; i += gsz) {
    double a = 6.283185307179586476925 * (double)i / (double)(2 * N);
    p.tw()[i * 2] = (float)cos(a); p.tw()[i * 2 + 1] = (float)-sin(a);
  }
#endif
  for (i64 i = gtid; i < 2 * 2 * 512; i += gsz) p.spl()[i] = softplusf_(-p.in[I_lru_lam][i]);
  for (i64 i = gtid; i < 128 * 8; i += gsz) {
    int pos = (int)(i / 8), f = (int)(i % 8);
    float ang = (float)pos * powf(10000.0f, -(float)f / 8.0f);
    p.tabA()[i * 2] = cosf(ang); p.tabA()[i * 2 + 1] = sinf(ang);
  }
  for (i64 i = gtid; i < 128 * 16; i += gsz) {
    int pos = (int)(i / 16), f = (int)(i % 16);
    float ang = (float)pos * powf(10000.0f, -(float)f / 16.0f);
    p.tabD()[i * 2] = cosf(ang); p.tabD()[i * 2 + 1] = sinf(ang);
  }
}

#ifndef CPU_SIM
template <class F> DEV void xpose_tiles(bf* dst, int K, int NN, const F& val, int tid, float* tl, int& xoff, int rank, int nranks) {
  const int tk = K / 64, tn = NN / 64;
  const int t0 = (rank + nranks - xoff % nranks) % nranks;
  xoff += tk * tn;
  for (int t = t0; t < tk * tn; t += nranks) {
    const int k0 = (t / tn) * 64, n0 = (t % tn) * 64;
    __syncthreads();
    float tv_[8];
#pragma unroll
    for (int i = 0; i < 8; ++i) { const int kk = (tid >> 6) + 8 * i, nn = tid & 63; tv_[i] = val(k0 + kk, n0 + nn); }
#pragma unroll
    for (int i = 0; i < 8; ++i) { const int kk = (tid >> 6) + 8 * i, nn = tid & 63; tl[nn * 65 + kk] = tv_[i]; }
    __syncthreads();
#pragma unroll
    for (int i = 0; i < 8; ++i) { const int nn = (tid >> 6) + 8 * i, kk = tid & 63; dst[(size_t)(n0 + nn) * K + k0 + kk] = f2b(tl[nn * 65 + kk]); }
  }
}
#else
template <class F> static void xpose_tiles(bf* dst, int K, int NN, const F& val, i64 gtid, i64 gsz) {
  for (i64 i = gtid; i < (i64)K * NN; i += gsz) { int k = (int)(i / NN), n = (int)(i % NN); dst[(size_t)n * K + k] = f2b(val(k, n)); }
}
#endif
struct PrepCtx {
#ifndef CPU_SIM
  int tid; float* tl; int rank, nranks;
#else
  i64 gtid, gsz;
#endif
};
#ifndef CPU_SIM
#define XPOSE(dst, K, NN, val) xpose_tiles(dst, K, NN, val, pc.tid, pc.tl, xoff, pc.rank, pc.nranks)
#else
#define XPOSE(dst, K, NN, val) xpose_tiles(dst, K, NN, val, pc.gtid, pc.gsz)
#endif
DEVN void ph_prep(const Params& p, int l, const PrepCtx& pc, i64 gtid, i64 gsz, const int parts) {
  int xoff = 0; (void)xoff;
  if (parts & 1) {
    GF w = (GF)(p.in[I_w_in] + (size_t)l * D * INC);
    XPOSE(p.W_in(), 1024, 3840, [=](int k, int n) { const int s_ = win_src(n); const float x_ = w[(size_t)k * INC + (s_ < 0 ? 0 : s_)]; return s_ < 0 ? 0.f : x_; });
    XPOSE(p.W_g(), 1024, 4096, [=](int k, int n) { return w[(size_t)k * INC + C_GT + n]; });
  }
  if (parts & 1) {
    GF w = (GF)(p.in[I_mla_w_uq] + (size_t)l * 256 * 768); GF g = (GF)(p.in[I_mla_g_cq] + l * 256);
    XPOSE(p.W_uq(), 256, 768, [=](int k, int n) { return g[k] * w[(size_t)k * 768 + wuq_src(n)]; });
  }
  if (parts & 1) {
    GF w = (GF)(p.in[I_mla_w_ukv] + (size_t)l * 128 * 1024); GF g = (GF)(p.in[I_mla_g_ckv] + l * 128);
    XPOSE(p.W_ukv(), 256, 1024, [=](int k, int n) { const int kc = k < 128 ? k : 0; const float x_ = g[kc] * w[(size_t)kc * 1024 + n]; return k < 128 ? x_ : 0.f; });
  }
  if (parts & 2) {
    GF w = (GF)(p.in[I_w_branch] + (size_t)l * 4 * 512 * D);
    for (int br = 0; br < 4; ++br) { GF wb = w + (size_t)br * 512 * D; XPOSE(p.W_br() + (size_t)br * 1024 * 512, 512, 1024, [=](int k, int n) { return wb[(size_t)k * D + n]; }); }
  }
  if (parts & 2) {
    GF w = (GF)(p.in[I_w_out] + (size_t)l * D * D);
    XPOSE(p.W_out(), 1024, 1024, [=](int k, int n) { return w[(size_t)k * D + n]; });
  }
  if (parts & 4) {
    GF wq = (GF)(p.in[I_peer_w_q] + (size_t)l * D * 1024);
    XPOSE(p.W_q(), 1024, 1024, [=](int k, int n) { return wq[(size_t)k * 1024 + n]; });
  }
#ifndef CPU_SIM
  if (parts & 1) {
    GF w3 = (GF)(p.in[I_hy_w3] + (size_t)l * 64 * 1024);
    XPOSE(p.W3T(), 256, 1024, [=](int k, int n) { const int kc = k < 64 ? k : 0; const float x_ = w3[(size_t)kc * 1024 + n]; return k < 64 ? x_ : 0.f; });
  }
#endif
  if (parts & 1) {
    for (i64 i = gtid; i < 2048 * 256; i += gsz) {
      int n = (int)(i / 256), k = (int)(i % 256);
      int kw = n >> 10, dir = (n >> 9) & 1, blk4 = (n >> 7) & 3, jc = (n & 127) >> 1, gate = n & 1;
      float v = 0.f;
      if ((k >> 6) == blk4) {
        GF wsrc = (GF)p.in[gate ? I_lru_w_i : I_lru_w_r] + ((((size_t)l * 2 + dir) * 8 + kw * 4 + blk4) * 64 + (k & 63)) * 64 + jc;
        v = *wsrc;
      }
      p.W_lru()[i] = f2b(v);
    }
  }
  if (parts & 8) {
    GF keys = (GF)(p.in[I_peer_keys] + (size_t)l * 16 * 128 * 64);
    for (i64 i = gtid; i < 2048 * 256; i += gsz) {
      int n = (int)(i / 256), k = (int)(i % 256);
      int hp = n >> 7, key = n & 127;
      float v = ((k >> 6) == (hp & 3)) ? keys[((size_t)hp * 128 + key) * 64 + (k & 63)] : 0.f;
      p.W_key()[i] = f2b(v);
    }
  }
}

DEVN void ph_norm(const Params& p, int l, int which, int nrows, i64 gtid, i64 gsz) {
  const float* g = p.in[which ? I_g_ffn : I_g_mix] + l * D;
#ifndef CPU_SIM
  const int lane = (int)(gtid & 63);
  const i64 W = gsz >> 6;
  float4 gv[4];
#pragma unroll
  for (int i = 0; i < 4; ++i) gv[i] = *(const float4*)(g + (lane + i * 64) * 4);
  for (i64 r = gtid >> 6; r < nrows; r += 2 * W) {
    const bool two = r + W < nrows;
    const i64 rb = two ? r + W : r;
    const float4* xra = (const float4*)((l == 0 && which == 0) ? xin_row(p, (int)r) : p.xcur() + (size_t)r * D);
    const float4* xrb = (const float4*)((l == 0 && which == 0) ? xin_row(p, (int)rb) : p.xcur() + (size_t)rb * D);
    const float* mda = p.mods() + ((size_t)l * 3 + modrow((int)r)) * 6 * D + (which ? 3 * D : 0);
    const float* mdb = p.mods() + ((size_t)l * 3 + modrow((int)rb)) * 6 * D + (which ? 3 * D : 0);
    float4 xa[4], xb[4], sha[4], sca[4], shb[4], scb[4]; float sa = 0.f, sb = 0.f;
#pragma unroll
    for (int i = 0; i < 4; ++i) { xa[i] = xra[lane + i * 64]; xb[i] = xrb[lane + i * 64]; }
#pragma unroll
    for (int i = 0; i < 4; ++i) { const int k = (lane + i * 64) * 4; sha[i] = *(const float4*)(mda + k); sca[i] = *(const float4*)(mda + D + k); shb[i] = *(const float4*)(mdb + k); scb[i] = *(const float4*)(mdb + D + k); }
#pragma unroll
    for (int i = 0; i < 4; ++i) { sa += xa[i].x * xa[i].x + xa[i].y * xa[i].y + xa[i].z * xa[i].z + xa[i].w * xa[i].w; sb += xb[i].x * xb[i].x + xb[i].y * xb[i].y + xb[i].z * xb[i].z + xb[i].w * xb[i].w; }
#pragma unroll
    for (int o = 32; o >= 1; o >>= 1) { sa += lane_xor(sa, lane, o); sb += lane_xor(sb, lane, o); }
    const float rsa = 1.0f / sqrtf(sa * (1.0f / D) + EPS), rsb = 1.0f / sqrtf(sb * (1.0f / D) + EPS);
#pragma unroll
    for (int i = 0; i < 4; ++i) {
      const int k = (lane + i * 64) * 4;
      uint2 w;
      w.x = pk2bf(xa[i].x * rsa * gv[i].x * (1.0f + sca[i].x) + sha[i].x, xa[i].y * rsa * gv[i].y * (1.0f + sca[i].y) + sha[i].y);
      w.y = pk2bf(xa[i].z * rsa * gv[i].z * (1.0f + sca[i].z) + sha[i].z, xa[i].w * rsa * gv[i].w * (1.0f + sca[i].w) + sha[i].w);
      *(uint2*)(p.h() + (size_t)r * D + k) = w;
    }
    if (two) {
#pragma unroll
      for (int i = 0; i < 4; ++i) {
        const int k = (lane + i * 64) * 4;
        uint2 w;
        w.x = pk2bf(xb[i].x * rsb * gv[i].x * (1.0f + scb[i].x) + shb[i].x, xb[i].y * rsb * gv[i].y * (1.0f + scb[i].y) + shb[i].y);
        w.y = pk2bf(xb[i].z * rsb * gv[i].z * (1.0f + scb[i].z) + shb[i].z, xb[i].w * rsb * gv[i].w * (1.0f + scb[i].w) + shb[i].w);
        *(uint2*)(p.h() + (size_t)rb * D + k) = w;
      }
    }
  }
#else
  for (i64 r = gtid; r < nrows; r += gsz) {
    const float* xr = (l == 0 && which == 0) ? xin_row(p, (int)r) : p.xcur() + (size_t)r * D;
    float ss = 0.f;
    for (int k = 0; k < D; ++k) ss += xr[k] * xr[k];
    float rstd = 1.0f / sqrtf(ss / D + EPS);
    const float* md = p.mods() + ((size_t)l * 3 + modrow((int)r)) * 6 * D + (which ? 3 * D : 0);
    for (int k = 0; k < D; ++k) p.h()[(size_t)r * D + k] = f2b(xr[k] * rstd * g[k] * (1.0f + md[D + k]) + md[k]);
  }
#endif
}

DEVN void ph_B0(const Params& p, int l, i64 gtid, i64 gsz, char* b0lds = nullptr, int b0tid = 0) {
#ifndef CPU_SIM
  {
    const int lane = (int)(gtid & 63);
    const i64 W = gsz >> 6;
    for (i64 r = gtid >> 6; r < TT; r += 4 * W) {
      uint2 a[4]; unsigned b[4]; i64 rr[4];
#pragma unroll
      for (int j = 0; j < 4; ++j) { rr[j] = r + j * W < TT ? r + j * W : r; const bf* pr = p.P() + (size_t)rr[j] * PC; a[j] = *(const uint2*)(pr + C_CQ + lane * 4); b[j] = *(const unsigned*)(pr + C_CKV + lane * 2); }
      float sq[4], sk[4];
#pragma unroll
      for (int j = 0; j < 4; ++j) {
        const float f0 = __uint_as_float(a[j].x << 16), f1 = __uint_as_float(a[j].x & 0xFFFF0000u), f2 = __uint_as_float(a[j].y << 16), f3 = __uint_as_float(a[j].y & 0xFFFF0000u);
        const float g0 = __uint_as_float(b[j] << 16), g1 = __uint_as_float(b[j] & 0xFFFF0000u);
        sq[j] = 0.f; sq[j] += f0 * f0; sq[j] += f1 * f1; sq[j] += f2 * f2; sq[j] += f3 * f3;
        sk[j] = 0.f; sk[j] += g0 * g0; sk[j] += g1 * g1;
      }
#pragma unroll
      for (int o = 32; o >= 1; o >>= 1) {
#pragma unroll
        for (int j = 0; j < 4; ++j) { sq[j] += lane_xor(sq[j], lane, o); sk[j] += lane_xor(sk[j], lane, o); }
      }
#pragma unroll
      for (int j = 0; j < 4; ++j) if (lane == 0 && r + j * W < TT) { p.ssq()[rr[j]] = sq[j]; p.ssq()[TT + rr[j]] = sk[j]; }
    }
  }
#else
  for (i64 r = gtid; r < TT; r += gsz) {
    const bf* pr = p.P() + (size_t)r * PC;
    float sq = 0.f, sk = 0.f;
    for (int k = 0; k < 256; ++k) { float v = b2f(pr[C_CQ + k]); sq += v * v; }
    for (int k = 0; k < 128; ++k) { float v = b2f(pr[C_CKV + k]); sk += v * v; }
    p.ssq()[r] = sq; p.ssq()[TT + r] = sk;
  }
#endif
#ifndef CPU_SIM
  {
    GF cw = (GF)(p.in[I_lru_conv_w] + l * 4 * 512); GF cb = (GF)(p.in[I_lru_conv_b] + l * 512);
    const int c8 = (int)(gtid & 63) * 8;
    float wv[4][8], bv[8];
#pragma unroll
    for (int j = 0; j < 8; ++j) { bv[j] = cb[c8 + j];
#pragma unroll
      for (int k = 0; k < 4; ++k) wv[k][j] = cw[k * 512 + c8 + j]; }
    for (i64 i = gtid; i < (i64)TT * 64; i += 2 * gsz) {
      const bool two = i + gsz < (i64)TT * 64;
      const int r0 = (int)(i >> 6), r1 = two ? (int)((i + gsz) >> 6) : r0;
      const RowInfo ra = rowinfo(r0), rb = rowinfo(r1);
      uint4 xa[4], xb[4]; float ma[4], mb[4];
#pragma unroll
      for (int k = 0; k < 4; ++k) {
        const int ta = ra.t - 1 + k, tb = rb.t - 1 + k;
        const bool oka = ta >= 0 && ta < ra.L, okb = tb >= 0 && tb < rb.L;
        ma[k] = oka ? 1.f : 0.f; mb[k] = okb ? 1.f : 0.f;
        xa[k] = *(const uint4*)(p.P() + (size_t)(ra.base + (oka ? ta : ra.t)) * PC + C_LX + c8);
        xb[k] = *(const uint4*)(p.P() + (size_t)(rb.base + (okb ? tb : rb.t)) * PC + C_LX + c8);
      }
      float aa[8], ab[8];
#pragma unroll
      for (int j = 0; j < 8; ++j) { aa[j] = bv[j]; ab[j] = bv[j]; }
#pragma unroll
      for (int k = 0; k < 4; ++k) {
        float fa_[8], fb_[8]; unpack8(xa[k], fa_); unpack8(xb[k], fb_);
#pragma unroll
        for (int j = 0; j < 8; ++j) { aa[j] += (wv[k][j] * ma[k]) * fa_[j]; ab[j] += (wv[k][j] * mb[k]) * fb_[j]; }
      }
      store8bf(p.XC() + (size_t)r0 * 512 + c8, aa);
      if (two) store8bf(p.XC() + (size_t)r1 * 512 + c8, ab);
    }
  }
  {
    const float* cw = p.in[I_hy_conv_w] + l * 3 * 1536; const float* cb = p.in[I_hy_conv_b] + l * 1536;
    for (i64 i = (i64)NLAT * 64 + gtid; i < (i64)TT * 64; i += gsz) {
      const int r = (int)(i >> 6), c8 = (int)(i & 63) * 8;
      const RowInfo ri = rowinfo(r);
      float a1[8], a2[8];
#pragma unroll
      for (int j = 0; j < 8; ++j) { a1[j] = cb[512 + c8 + j]; a2[j] = cb[1024 + c8 + j]; }
#pragma unroll
      for (int k = 0; k < 3; ++k) {
        const int ts = ri.t - 1 + k; if (ts < 0 || ts >= ri.L) continue;
        const bf* pr = p.P() + (size_t)(ri.base + ts) * PC + C_HU;
        float f[8], g[8]; unpack8(*(const uint4*)(pr + 512 + c8), f); unpack8(*(const uint4*)(pr + 1024 + c8), g);
#pragma unroll
        for (int j = 0; j < 8; ++j) { a1[j] += cw[k * 1536 + 512 + c8 + j] * f[j]; a2[j] += cw[k * 1536 + 1024 + c8 + j] * g[j]; }
      }
#pragma unroll
      for (int j = 0; j < 8; ++j) a1[j] *= a2[j];
      store8bf(p.Z() + (size_t)r * 512 + c8, a1);
    }
  }
  {
    const float* cw = p.in[I_hy_conv_w] + l * 3 * 1536; const float* cb = p.in[I_hy_conv_b] + l * 1536;
    unsigned short* tz_ = (unsigned short*)b0lds; unsigned short* tx_ = tz_ + 64 * 72;
    for (int tile = blockIdx.x; tile < (NLAT / 64) * 8; tile += gridDim.x) {
      const int rt = tile >> 3, c0 = (tile & 7) * 64;
      const int tr = b0tid >> 3, cg8 = (b0tid & 7) * 8;
      const int r = rt * 64 + tr, t = r % N;
      float a0[8], a1[8], a2[8];
#pragma unroll
      for (int j = 0; j < 8; ++j) { a0[j] = cb[c0 + cg8 + j]; a1[j] = cb[512 + c0 + cg8 + j]; a2[j] = cb[1024 + c0 + cg8 + j]; }
      uint4 v0[3], v1[3], v2[3]; bool ok[3];
#pragma unroll
      for (int k = 0; k < 3; ++k) {
        const int ts = t - 1 + k; ok[k] = ts >= 0 && ts < N;
        const bf* pr = p.P() + (size_t)(r - 1 + (ok[k] ? k : 1)) * PC + C_HU + c0 + cg8;
        v0[k] = *(const uint4*)pr; v1[k] = *(const uint4*)(pr + 512); v2[k] = *(const uint4*)(pr + 1024);
      }
#pragma unroll
      for (int k = 0; k < 3; ++k) {
        if (!ok[k]) continue;
        float f0[8], f1[8], f2_[8]; unpack8(v0[k], f0); unpack8(v1[k], f1); unpack8(v2[k], f2_);
        const float* w = cw + k * 1536 + c0 + cg8;
#pragma unroll
        for (int j = 0; j < 8; ++j) { a0[j] += w[j] * f0[j]; a1[j] += w[512 + j] * f1[j]; a2[j] += w[1024 + j] * f2_[j]; }
      }
      __syncthreads();
#pragma unroll
      for (int j = 0; j < 8; ++j) { tz_[(cg8 + j) * 72 + tr] = f2b(a1[j] * a2[j]).v; tx_[(cg8 + j) * 72 + tr] = f2b(a0[j]).v; }
      __syncthreads();
      { const int cc = b0tid >> 3, tg = (b0tid & 7) * 8;
        const int bq = (rt * 64) / N, tq = (rt * 64) % N + tg;
        const size_t o = ((size_t)(c0 + cc) * NB + bq) * N + tq;
        *(uint4*)((unsigned short*)p.Z() + o) = *(const uint4*)(tz_ + cc * 72 + tg);
        *(uint4*)((unsigned short*)p.XYT() + o) = *(const uint4*)(tx_ + cc * 72 + tg); }
    }
  }
#else
  {
    const float* cw = p.in[I_lru_conv_w] + l * 4 * 512; const float* cb = p.in[I_lru_conv_b] + l * 512;
    for (i64 i = gtid; i < (i64)TT * 512; i += gsz) {
      int r = (int)(i / 512), c = (int)(i % 512);
      RowInfo ri = rowinfo(r);
      float acc = cb[c];
      for (int k = 0; k < 4; ++k) {
        int ts = ri.t - 1 + k;
        if (ts >= 0 && ts < ri.L) acc += cw[k * 512 + c] * b2f(p.P()[(size_t)(ri.base + ts) * PC + C_LX + c]);
      }
      p.XC()[i] = f2b(acc);
    }
  }
  {
    const float* cw = p.in[I_hy_conv_w] + l * 3 * 1536; const float* cb = p.in[I_hy_conv_b] + l * 1536;
    for (i64 i = gtid; i < (i64)TT * 512; i += gsz) {
      int r = (int)(i / 512), c = (int)(i % 512);
      RowInfo ri = rowinfo(r);
      float a1 = cb[512 + c], a2 = cb[1024 + c];
      for (int k = 0; k < 3; ++k) {
        int ts = ri.t - 1 + k;
        if (ts >= 0 && ts < ri.L) {
          const bf* pr = p.P() + (size_t)(ri.base + ts) * PC + C_HU;
          a1 += cw[k * 1536 + 512 + c] * b2f(pr[512 + c]);
          a2 += cw[k * 1536 + 1024 + c] * b2f(pr[1024 + c]);
        }
      }
      p.Z()[i] = f2b(a1 * a2);
    }
  }
  {
    const float* w3 = p.in[I_hy_w3] + (size_t)l * 64 * 1024;
    const float maxd = logf(1e-2f) / 0.3f, mind = logf(1e-2f) / 1.5f;
    for (i64 i = gtid; i < (i64)(N + LC) * 1024; i += gsz) {
      int tt = (int)(i / 1024), j = (int)(i % 1024);
      int t, L; if (tt < N) { t = tt; L = N; } else { t = tt - N; L = LC; }
      const float* hd = p.hdn2() + ((size_t)l * (N + LC) + tt) * 64;
      float acc = 0.f;
      for (int k = 0; k < 64; ++k) acc += hd[k] * w3[k * 1024 + j];
      float tn = (float)t / (float)(L - 1);
      float delta = mind + (float)j * ((maxd - mind) / 1023.0f);
      p.F()[i] = acc * expf(-tn * fabsf(delta));
    }
  }
#endif
}

DEVN void ph_fnorm(const Params& p, i64 gtid, i64 gsz) {
#ifndef CPU_SIM
  for (i64 i = 512 + gtid; i < 2 * 512; i += gsz) {
#else
  for (i64 i = gtid; i < 2 * 512; i += gsz) {
#endif
    int which = (int)(i / 512), c = (int)(i % 512);
    int L = which ? LC : N; int off = which ? N : 0;
    float ss = 0.f;
    for (int t = 0; t < L; ++t) { float a = p.F()[(size_t)(off + t) * 1024 + c], b = p.F()[(size_t)(off + t) * 1024 + 512 + c]; ss += a * a + b * b; }
    p.fnorm()[i] = 1.0f / sqrtf(ss + EPS);
  }
}


DEV void lru_chunk_rows(int dir, int b, int k, int& row0, int& step) {
  int seg_chunk;
  if (k < NCC) { seg_chunk = dir ? NCC - 1 - k : k; row0 = NLAT + b * LC + seg_chunk * LCH; }
  else { int kl = k - NCC; seg_chunk = dir ? NCL - 1 - kl : kl; row0 = b * N + seg_chunk * LCH; }
  if (dir) { row0 += LCH - 1; step = -1; } else step = 1;
}
DEVN void ph_lru1(const Params& p, i64 gtid, i64 gsz) {
#ifndef CPU_SIM
  for (i64 i = gtid; i < (i64)2 * NB * NCHK * 128; i += gsz) {
    const int c = (int)(i % 128) * 4, k = (int)((i / 128) % NCHK), b = (int)((i / (128 * NCHK)) % NB), dir = (int)(i / ((i64)128 * NCHK * NB));
    int row0, step; lru_chunk_rows(dir, b, k, row0, step);
    const uint4* lab4 = (const uint4*)(p.LAB() + (size_t)dir * TT * 512 + c);
    float h0 = 0.f, h1 = 0.f, h2 = 0.f, h3 = 0.f, s0 = 0.f, s1 = 0.f, s2 = 0.f, s3 = 0.f;
    uint4 wn[8];
#pragma unroll
    for (int t = 0; t < 8; ++t) wn[t] = lab4[(size_t)(row0 + step * t) * 128];
#pragma unroll 1
    for (int t0 = 0; t0 < LCH; t0 += 8) {
      uint4 w[8];
#pragma unroll
      for (int t = 0; t < 8; ++t) w[t] = wn[t];
      if (t0 + 8 < LCH) {
#pragma unroll
        for (int t = 0; t < 8; ++t) wn[t] = lab4[(size_t)(row0 + step * (t0 + 8 + t)) * 128];
      }
#pragma unroll
      for (int t = 0; t < 8; ++t) {
        const float a0 = __uint_as_float(w[t].x << 16), a1 = __uint_as_float(w[t].y << 16), a2 = __uint_as_float(w[t].z << 16), a3 = __uint_as_float(w[t].w << 16);
        s0 += a0; s1 += a1; s2 += a2; s3 += a3;
        h0 = fexpf_(a0) * h0 + __uint_as_float(w[t].x & 0xFFFF0000u); h1 = fexpf_(a1) * h1 + __uint_as_float(w[t].y & 0xFFFF0000u);
        h2 = fexpf_(a2) * h2 + __uint_as_float(w[t].z & 0xFFFF0000u); h3 = fexpf_(a3) * h3 + __uint_as_float(w[t].w & 0xFFFF0000u);
      }
    }
    const size_t o = ((size_t)(dir * NB + b) * NCHK + k) * 512 + c;
    *(float4*)(p.SA() + o) = float4{fexpf_(s0), fexpf_(s1), fexpf_(s2), fexpf_(s3)};
    *(float4*)(p.SB() + o) = float4{h0, h1, h2, h3};
  }
#else
  for (i64 i = gtid; i < (i64)2 * NB * NCHK * 512; i += gsz) {
    int c = (int)(i % 512), k = (int)((i / 512) % NCHK), b = (int)((i / (512 * NCHK)) % NB), dir = (int)(i / ((i64)512 * NCHK * NB));
    int row0, step; lru_chunk_rows(dir, b, k, row0, step);
    const bf* la = p.LA() + (size_t)dir * TT * 512 + c; const bf* lb = p.LB() + (size_t)dir * TT * 512 + c;
    float h = 0.f, sl = 0.f;
    for (int t = 0; t < LCH; ++t) {
      size_t r = (size_t)(row0 + step * t);
      float lav = b2f(la[r * 512]);
      h = expf(lav) * h + b2f(lb[r * 512]); sl += lav;
    }
    p.SA()[i] = fexpf_(sl); p.SB()[i] = h;
  }
#endif
}
DEVN void ph_lru3(const Params& p, int last, i64 gtid, i64 gsz, float* hrs, int ltid) {
#ifndef CPU_SIM
  unsigned* hrp = (unsigned*)hrs;
  for (i64 i = gtid; i < (i64)NB * NCHK * 256; i += gsz) {
    const int c = (int)(i % 256) * 2, j = (int)((i / 256) % NCHK), b = (int)(i / (256 * NCHK));
    if (last && j < NCC) continue;
    const int kf = j, kr = j < NCC ? NCC - 1 - j : NCC + (NCL - 1 - (j - NCC));
    const float* sa0 = p.SA() + ((size_t)(0 * NB + b) * NCHK) * 512 + c; const float* sb0 = p.SB() + ((size_t)(0 * NB + b) * NCHK) * 512 + c;
    const float* sa1 = p.SA() + ((size_t)(1 * NB + b) * NCHK) * 512 + c; const float* sb1 = p.SB() + ((size_t)(1 * NB + b) * NCHK) * 512 + c;
    float hf0 = 0.f, hf1 = 0.f, hr0 = 0.f, hr1 = 0.f;
    const int row0 = j < NCC ? NLAT + b * LC + j * LCH : b * N + (j - NCC) * LCH;
    const unsigned* lab0 = p.LAB() + c; const unsigned* lab1 = p.LAB() + (size_t)TT * 512 + c;
#pragma unroll 1
    for (int k0 = 0; k0 < kf; k0 += 8) {
      float2 av[8], bv[8];
#pragma unroll
      for (int q = 0; q < 8; ++q) { const bool ok = k0 + q < kf; av[q] = ok ? *(const float2*)(sa0 + (size_t)(k0 + q) * 512) : float2{1.f, 1.f}; bv[q] = ok ? *(const float2*)(sb0 + (size_t)(k0 + q) * 512) : float2{0.f, 0.f}; }
#pragma unroll
      for (int q = 0; q < 8; ++q) { hf0 = av[q].x * hf0 + bv[q].x; hf1 = av[q].y * hf1 + bv[q].y; }
    }
#pragma unroll 1
    for (int k0 = 0; k0 < kr; k0 += 8) {
      float2 av[8], bv[8];
#pragma unroll
      for (int q = 0; q < 8; ++q) { const bool ok = k0 + q < kr; av[q] = ok ? *(const float2*)(sa1 + (size_t)(k0 + q) * 512) : float2{1.f, 1.f}; bv[q] = ok ? *(const float2*)(sb1 + (size_t)(k0 + q) * 512) : float2{0.f, 0.f}; }
#pragma unroll
      for (int q = 0; q < 8; ++q) { hr0 = av[q].x * hr0 + bv[q].x; hr1 = av[q].y * hr1 + bv[q].y; }
    }
#pragma unroll 1
    for (int t0 = LCH - 16; t0 >= 0; t0 -= 16) {
      uint2 w[16];
#pragma unroll
      for (int t = 0; t < 16; ++t) w[t] = *(const uint2*)(lab1 + (size_t)(row0 + t0 + t) * 512);
#pragma unroll
      for (int t = 15; t >= 0; --t) {
        hr0 = fexpf_(__uint_as_float(w[t].x << 16)) * hr0 + __uint_as_float(w[t].x & 0xFFFF0000u);
        hr1 = fexpf_(__uint_as_float(w[t].y << 16)) * hr1 + __uint_as_float(w[t].y & 0xFFFF0000u);
        hrp[(t0 + t) * 512 + ltid] = pk2bf(hr0, hr1);
      }
    }
#pragma unroll 1
    for (int t0 = 0; t0 < LCH; t0 += 16) {
      uint2 w[16]; unsigned gw[16];
#pragma unroll
      for (int t = 0; t < 16; ++t) { const size_t r = (size_t)(row0 + t0 + t); w[t] = *(const uint2*)(lab0 + r * 512); gw[t] = *(const unsigned*)(p.P() + r * PC + C_LG + c); }
#pragma unroll
      for (int t = 0; t < 16; ++t) {
        hf0 = fexpf_(__uint_as_float(w[t].x << 16)) * hf0 + __uint_as_float(w[t].x & 0xFFFF0000u);
        hf1 = fexpf_(__uint_as_float(w[t].y << 16)) * hf1 + __uint_as_float(w[t].y & 0xFFFF0000u);
        const unsigned hw = hrp[(t0 + t) * 512 + ltid];
        const float y0 = geluf_(__uint_as_float(gw[t] << 16)) * (hf0 + __uint_as_float(hw << 16));
        const float y1 = geluf_(__uint_as_float(gw[t] & 0xFFFF0000u)) * (hf1 + __uint_as_float(hw & 0xFFFF0000u));
        *(unsigned*)(p.Y() + (size_t)(row0 + t0 + t) * 2048 + 512 + c) = pk2bf(y0, y1);
      }
    }
  }
#else
  for (i64 i = gtid; i < (i64)NB * NCHK * 512; i += gsz) {
    int c = (int)(i % 512), j = (int)((i / 512) % NCHK), b = (int)(i / (512 * NCHK));
    if (last && j < NCC) continue;
    int kf = j, kr = j < NCC ? NCC - 1 - j : NCC + (NCL - 1 - (j - NCC));
    const float* sa0 = p.SA() + ((size_t)(0 * NB + b) * NCHK) * 512 + c; const float* sb0 = p.SB() + ((size_t)(0 * NB + b) * NCHK) * 512 + c;
    const float* sa1 = p.SA() + ((size_t)(1 * NB + b) * NCHK) * 512 + c; const float* sb1 = p.SB() + ((size_t)(1 * NB + b) * NCHK) * 512 + c;
    float hf = 0.f, hr = 0.f;
    int row0 = j < NCC ? NLAT + b * LC + j * LCH : b * N + (j - NCC) * LCH;
    const bf* la0 = p.LA() + c; const bf* lb0 = p.LB() + c;
    const bf* la1 = p.LA() + (size_t)TT * 512 + c; bf* lb1 = p.LB() + (size_t)TT * 512 + c;
    for (int k = 0; k < kf; ++k) hf = sa0[(size_t)k * 512] * hf + sb0[(size_t)k * 512];
    for (int k = 0; k < kr; ++k) hr = sa1[(size_t)k * 512] * hr + sb1[(size_t)k * 512];
    for (int t = LCH - 1; t >= 0; --t) { size_t r = (size_t)(row0 + t); hr = expf(b2f(la1[r * 512])) * hr + b2f(lb1[r * 512]); lb1[r * 512] = f2b(hr); }
    for (int t = 0; t < LCH; ++t) {
      size_t r = (size_t)(row0 + t);
      hf = expf(b2f(la0[r * 512])) * hf + b2f(lb0[r * 512]);
      float lg = b2f(p.P()[r * PC + C_LG + c]);
      p.Y()[r * 2048 + 512 + c] = f2b(geluf_(lg) * (hf + b2f(lb1[r * 512])));
    }
  }
#endif
}

DEVN void ph_C(const Params& p, int l, int last, i64 gtid, i64 gsz) {
  const int QR = last ? NLAT : TT;
#ifdef CPU_SIM
  for (i64 i = gtid; i < (i64)8 * QR; i += gsz) {
    int hh = (int)(i / QR), r = (int)(i % QR);
    RowInfo ri = rowinfo(r);
    float q[96];
#pragma unroll
    for (int d = 0; d < 96; ++d) q[d] = b2f(p.QA()[(size_t)r * 768 + hh * 96 + d]);
    float o[64];
#pragma unroll
    for (int d = 0; d < 64; ++d) o[d] = 0.f;
    float m = -1e30f, lsum = 0.f;
    const float scale = 0.10206207261596577f;
    int nseg = ri.lat ? 2 : 1;
    for (int sg = 0; sg < nseg; ++sg) {
      int kb, kn_;
      if (ri.lat && sg == 0) { kb = ri.b * N; kn_ = N; } else { kb = NLAT + ri.b * LC; kn_ = LC; }
      for (int kk = 0; kk < kn_; ++kk) {
        const bf* kr_ = p.KVA() + (size_t)(kb + kk) * 1024 + hh * 128;
        const bf* krp = p.P() + (size_t)(kb + kk) * PC + C_KR;
        float s = 0.f;
#pragma unroll
        for (int d = 0; d < 64; ++d) s += q[d] * b2f(kr_[d]);
#pragma unroll
        for (int d = 0; d < 32; ++d) s += q[64 + d] * b2f(krp[d]);
        s *= scale;
        float mn = fmaxf(m, s);
        float corr = expf(m - mn), pe = expf(s - mn);
        lsum = lsum * corr + pe;
#pragma unroll
        for (int d = 0; d < 64; ++d) o[d] = o[d] * corr + pe * b2f(kr_[64 + d]);
        m = mn;
      }
    }
    float inv = 1.0f / lsum;
#pragma unroll
    for (int d = 0; d < 64; ++d) p.Y()[(size_t)r * 2048 + hh * 64 + d] = f2b(o[d] * inv);
  }
#endif
  {
    const float* cw = p.in[I_hy_conv_w] + l * 3 * 1536; const float* cb = p.in[I_hy_conv_b] + l * 1536;
    const float* skip = p.in[I_hy_skip] + l * 512;
#ifndef CPU_SIM
    const i64 hy_first = (i64)NLAT * 512;
#else
    const i64 hy_first = 0;
#endif
    for (i64 i = hy_first + gtid; i < (i64)QR * 512; i += gsz) {
      int r = (int)(i / 512), c = (int)(i % 512);
      RowInfo ri = rowinfo(r);
      int foff = ri.lat ? 0 : N;
      float acc = 0.f;
      for (int s = 0; s < ri.L; ++s) {
        int dd = ri.t - s;
        float fv = dd >= 0 ? p.F()[(size_t)(foff + dd) * 1024 + c] : p.F()[(size_t)(foff - dd) * 1024 + 512 + c];
        acc += fv * b2f(p.Z()[(size_t)(ri.base + s) * 512 + c]);
      }
      acc *= p.fnorm()[(ri.lat ? 0 : 512) + c];
      float x0 = cb[c];
      for (int k = 0; k < 3; ++k) {
        int ts = ri.t - 1 + k;
        if (ts >= 0 && ts < ri.L) x0 += cw[k * 1536 + c] * b2f(p.P()[(size_t)(ri.base + ts) * PC + C_HU + c]);
      }
      float y = acc + skip[c] * b2f(p.Z()[(size_t)r * 512 + c]);
      p.Y()[(size_t)r * 2048 + 1024 + c] = f2b(x0 * y);
    }
  }
#ifdef CPU_SIM
  for (i64 i = gtid; i < (i64)8 * QR; i += gsz) {
    int hh = (int)(i / QR), r = (int)(i % QR);
    RowInfo ri = rowinfo(r);
    int kh = hh / 4;
    float q[64];
#pragma unroll
    for (int d = 0; d < 64; ++d) q[d] = b2f(p.P()[(size_t)r * PC + C_GQ + hh * 64 + d]);
    float o[64];
#pragma unroll
    for (int d = 0; d < 64; ++d) o[d] = 0.f;
    float m = p.in[I_gqa_sink][l * 8 + hh], lsum = 1.0f;
    int nseg = ri.lat ? 2 : 1;
    for (int sg = 0; sg < nseg; ++sg) {
      int k0, k1;
      if (ri.lat && sg == 0) { int lo = ri.t - 128; if (lo < 0) lo = 0; int hi = ri.t + 128; if (hi > N - 1) hi = N - 1; k0 = ri.b * N + lo; k1 = ri.b * N + hi + 1; }
      else { k0 = NLAT + ri.b * LC; k1 = k0 + LC; }
      for (int kk = k0; kk < k1; ++kk) {
        const bf* kp = p.P() + (size_t)kk * PC + C_GKV + kh * 64;
        const bf* vp = kp + 128;
        float s = 0.f;
#pragma unroll
        for (int d = 0; d < 64; ++d) s += q[d] * b2f(kp[d]);
        s *= 0.125f;
        float mn = fmaxf(m, s);
        float corr = expf(m - mn), pe = expf(s - mn);
        lsum = lsum * corr + pe;
#pragma unroll
        for (int d = 0; d < 64; ++d) o[d] = o[d] * corr + pe * b2f(vp[d]);
        m = mn;
      }
    }
    float inv = 1.0f / lsum;
#pragma unroll
    for (int d = 0; d < 64; ++d) p.Y()[(size_t)r * 2048 + 1536 + hh * 64 + d] = f2b(o[d] * inv);
  }
#endif
}

DEVN void ph_E2a(const Params& p, int nrows, i64 gtid, i64 gsz) {
  for (i64 i = gtid; i < (i64)nrows * 16; i += gsz) {
    const sc_t* s_ = p.SC() + (size_t)i * 128;
    float ps = 3.0e38f; int pi = -1;
    for (int k = 0; k < 16; ++k) {
      float bs = -3.0e38f; int bi = -1;
      for (int j = 0; j < 128; ++j) {
        float s = (float)s_[j];
        bool elig = (s < ps) || (s == ps && j > pi);
        if (elig && (s > bs)) { bs = s; bi = j; }
      }
      p.TKs()[(size_t)i * 16 + k] = bs; p.TKi()[(size_t)i * 16 + k] = bi;
      ps = bs; pi = bi;
    }
  }
}

DEVN void ph_E2b(const Params& p, int nrows, i64 gtid, i64 gsz) {
  for (i64 i = gtid; i < (i64)nrows * 8; i += gsz) {
    const float* s1 = p.TKs() + (size_t)i * 32; const float* s2 = s1 + 16;
    const int* i1 = p.TKi() + (size_t)i * 32; const int* i2 = i1 + 16;
    float ps = 3.0e38f; int pi = -1;
    float mx = 0.f;
    for (int k = 0; k < 16; ++k) {
      float bs = -3.0e38f; int bi = -1;
      for (int j = 0; j < 256; ++j) {
        float s = s1[j >> 4] + s2[j & 15];
        bool elig = (s < ps) || (s == ps && j > pi);
        if (elig && (s > bs)) { bs = s; bi = j; }
      }
      if (k == 0) mx = bs;
      p.SELi()[(size_t)i * 16 + k] = i1[bi >> 4] * 128 + i2[bi & 15];
      p.SELg()[(size_t)i * 16 + k] = expf(bs - mx);
      ps = bs; pi = bi;
    }
    float sum = 0.f;
    for (int k = 0; k < 16; ++k) sum += p.SELg()[(size_t)i * 16 + k];
    float inv = 1.0f / sum;
    for (int k = 0; k < 16; ++k) p.SELg()[(size_t)i * 16 + k] *= inv;
  }
}

DEVN void ph_E3(const Params& p, int l, int nrows, i64 gtid, i64 gsz) {
  const float* u = p.in[I_peer_u] + (size_t)l * NEXP * D;
#ifndef CPU_SIM
  const int lane = (int)(gtid & 63);
  for (i64 i = gtid >> 6; i < (i64)nrows * 128; i += gsz >> 6) {
    const int r = (int)(i >> 7);
    const float4* ur = (const float4*)(u + (size_t)p.SELi()[i] * D);
    const uint2* hr = (const uint2*)(p.h() + (size_t)r * D);
    float acc = 0.f;
#pragma unroll
    for (int q = 0; q < 4; ++q) {
      const float4 uv = ur[lane + q * 64]; const uint2 hv = hr[lane + q * 64];
      union { unsigned u_; float f; } c0, c1, c2, c3;
      c0.u_ = hv.x << 16; c1.u_ = hv.x & 0xFFFF0000u; c2.u_ = hv.y << 16; c3.u_ = hv.y & 0xFFFF0000u;
      acc += uv.x * c0.f + uv.y * c1.f + uv.z * c2.f + uv.w * c3.f;
    }
#pragma unroll
    for (int o = 32; o >= 1; o >>= 1) acc += lane_xor(acc, lane, o);
    if (lane == 0) p.W()[i] = p.SELg()[i] * geluf_(acc);
  }
#else
  for (i64 i = gtid; i < (i64)nrows * 128; i += gsz) {
    int r = (int)(i / 128);
    const float* ur = u + (size_t)p.SELi()[i] * D;
    const bf* hr = p.h() + (size_t)r * D;
    float acc = 0.f;
    for (int k = 0; k < D; ++k) acc += b2f(hr[k]) * ur[k];
    p.W()[i] = p.SELg()[i] * geluf_(acc);
  }
#endif
}

DEVN void ph_E4(const Params& p, int l, int nrows, i64 gtid, i64 gsz) {
  const float* v = p.in[I_peer_v] + (size_t)l * NEXP * D;
  for (i64 i = gtid; i < (i64)nrows * D; i += gsz) {
    int r = (int)(i / D), n = (int)(i % D);
    float acc = 0.f;
    for (int j = 0; j < 128; ++j) acc += p.W()[(size_t)r * 128 + j] * v[(size_t)p.SELi()[(size_t)r * 128 + j] * D + n];
    float g2 = p.mods()[((size_t)l * 3 + modrow(r)) * 6 * D + 5 * D + n];
    p.xcur()[i] += g2 * acc;
  }
}


#ifndef CPU_SIM
DEV unsigned dpp_ror_u(unsigned x, int n) {
  switch (n) {
    case 1: return (unsigned)__builtin_amdgcn_update_dpp(0, (int)x, 0x121, 0xf, 0xf, false);
    case 2: return (unsigned)__builtin_amdgcn_update_dpp(0, (int)x, 0x122, 0xf, 0xf, false);
    case 4: return (unsigned)__builtin_amdgcn_update_dpp(0, (int)x, 0x124, 0xf, 0xf, false);
    default: return (unsigned)__builtin_amdgcn_update_dpp(0, (int)x, 0x128, 0xf, 0xf, false);
  }
}
DEV unsigned wave_max_u(unsigned x) {
  x = max(x, dpp_ror_u(x, 1)); x = max(x, dpp_ror_u(x, 2)); x = max(x, dpp_ror_u(x, 4)); x = max(x, dpp_ror_u(x, 8));
  const unsigned a = (unsigned)__builtin_amdgcn_readlane((int)x, 0), b = (unsigned)__builtin_amdgcn_readlane((int)x, 16);
  const unsigned c = (unsigned)__builtin_amdgcn_readlane((int)x, 32), d = (unsigned)__builtin_amdgcn_readlane((int)x, 48);
  return max(max(a, b), max(c, d));
}
DEV unsigned f16_key(unsigned short h, int idx) { const unsigned t = (h & 0x8000u) ? (unsigned)(~h & 0xFFFFu) : (unsigned)(h | 0x8000u); return (t << 16) | (unsigned)(0xFFFF - idx); }
DEV float key_score(unsigned k) { const unsigned t = k >> 16; const unsigned short h = (unsigned short)((t & 0x8000u) ? (t ^ 0x8000u) : (~t & 0xFFFFu)); union { unsigned short u; _Float16 f; } c; c.u = h; return (float)c.f; }
DEV int key_idx(unsigned k) { return 0xFFFF - (int)(k & 0xFFFFu); }
DEV int mbcnt64(unsigned long long m) { return (int)__builtin_amdgcn_mbcnt_hi((unsigned)(m >> 32), __builtin_amdgcn_mbcnt_lo((unsigned)m, 0u)); }
DEV unsigned pick16_sorted(unsigned k0, unsigned k1, unsigned T, int above, int lane, int* tmp) {
  const unsigned h0 = k0 & 0xFFFF0000u, h1 = k1 & 0xFFFF0000u;
  const bool gt0 = h0 > T, eq0 = h0 == T, gt1 = h1 > T, eq1 = h1 == T;
  const int need = 16 - above;
  const unsigned long long me0 = __builtin_amdgcn_ballot_w64(eq0), me1 = __builtin_amdgcn_ballot_w64(eq1);
  const bool s0 = gt0 || (eq0 && mbcnt64(me0) < need);
  const int need1 = need - (int)__builtin_popcountll(me0);
  const bool s1 = gt1 || (eq1 && mbcnt64(me1) < need1);
  const unsigned long long ms0 = __builtin_amdgcn_ballot_w64(s0), ms1 = __builtin_amdgcn_ballot_w64(s1);
  if (s0) tmp[mbcnt64(ms0)] = (int)k0;
  if (s1) tmp[(int)__builtin_popcountll(ms0) + mbcnt64(ms1)] = (int)k1;
  const unsigned u = (unsigned)tmp[lane & 15];
  int rank = 0;
#pragma unroll
  for (int q = 0; q < 16; ++q) rank += ((unsigned)__builtin_amdgcn_readlane((int)u, q) > u) ? 1 : 0;
  if (lane < 16) tmp[16 + rank] = (int)u;
  return (unsigned)tmp[16 + (lane & 15)];
}
DEV void top16_x2(unsigned a0, unsigned a1, unsigned b0, unsigned b1, int lane, int* tmp, unsigned& ta, unsigned& tb) {
  unsigned TA = 0, TB = 0; int abA = 0, abB = 0;
#pragma unroll
  for (int bit = 31; bit >= 16; --bit) {
    const unsigned m = 0xFFFFFFFFu << bit, one = 1u << bit;
    const unsigned tA = TA | one, tB = TB | one;
    const int cA = (int)__builtin_popcountll(__builtin_amdgcn_ballot_w64((a0 & m) == tA)) + (int)__builtin_popcountll(__builtin_amdgcn_ballot_w64((a1 & m) == tA));
    const int cB = (int)__builtin_popcountll(__builtin_amdgcn_ballot_w64((b0 & m) == tB)) + (int)__builtin_popcountll(__builtin_amdgcn_ballot_w64((b1 & m) == tB));
    if (abA + cA >= 16) TA = tA; else abA += cA;
    if (abB + cB >= 16) TB = tB; else abB += cB;
  }
  ta = pick16_sorted(a0, a1, TA, abA, lane, tmp);
  tb = pick16_sorted(b0, b1, TB, abB, lane, tmp + 32);
}
DEVN void ph_cvt_tables(const Params& p, int l, i64 gtid, i64 gsz) {
  const float4* u = (const float4*)(p.in[I_peer_u] + (size_t)l * NEXP * D); const float4* v = (const float4*)(p.in[I_peer_v] + (size_t)l * NEXP * D);
  unsigned* ub = (unsigned*)p.Ub(); unsigned* vb = (unsigned*)p.Vb();
#pragma unroll 4
  for (i64 i = gtid; i < (i64)NEXP * D / 4; i += gsz) {
    const float4 a = u[i], b = v[i];
    int w = __builtin_amdgcn_cvt_pk_fp8_f32(a.x * 32.f, a.y * 32.f, 0, false); w = __builtin_amdgcn_cvt_pk_fp8_f32(a.z * 32.f, a.w * 32.f, w, true); ub[i] = (unsigned)w;
    int x = __builtin_amdgcn_cvt_pk_fp8_f32(b.x, b.y, 0, false); x = __builtin_amdgcn_cvt_pk_fp8_f32(b.z, b.w, x, true); vb[i] = (unsigned)x;
  }
}
DEV void unpack16_fp8(const uint4 w, float* f) {
#define UP4(W, O) { auto lo = __builtin_amdgcn_cvt_pk_f32_fp8((int)(W), false); auto hi = __builtin_amdgcn_cvt_pk_f32_fp8((int)(W), true); f[O] = lo[0]; f[O + 1] = lo[1]; f[O + 2] = hi[0]; f[O + 3] = hi[1]; }
  UP4(w.x, 0) UP4(w.y, 4) UP4(w.z, 8) UP4(w.w, 12)
#undef UP4
}
struct Sc4 { unsigned short a, b, c, d; };
DEV Sc4 peer_scores(const Params& p, int r, int wid, int lane) {
  const unsigned short* sp = (const unsigned short*)(p.SC() + ((size_t)r * 8 + wid) * 256);
  Sc4 q; q.a = sp[lane]; q.b = sp[64 + lane]; q.c = sp[128 + lane]; q.d = sp[192 + lane];
  return q;
}
struct Key4 { decltype(f16_key((unsigned short)0, 0)) a, b, c, d; };
DEV Key4 peer_keys(const Sc4 q, int lane) { Key4 k; k.a = f16_key(q.a, lane); k.b = f16_key(q.b, 64 + lane); k.c = f16_key(q.c, lane); k.d = f16_key(q.d, 64 + lane); return k; }
DEV void peer_topk(const Key4 k, int lane, int ca, int cb, bool cvalid, int* selx, int* tmp) {
  unsigned t1, t2;
  top16_x2(k.a, k.b, k.c, k.d, lane, tmp, t1, t2);
  const unsigned k1 = (unsigned)__builtin_amdgcn_ds_bpermute(ca << 2, (int)t1), k2 = (unsigned)__builtin_amdgcn_ds_bpermute(cb << 2, (int)t2);
  const float v = cvalid ? key_score(k1) + key_score(k2) : -3.0e38f;
  int rank = 0;
#pragma unroll
  for (int c = 0; c < 50; ++c) {
    const float vs = __int_as_float(__builtin_amdgcn_readlane(__float_as_int(v), c));
    rank += (vs > v || (vs == v && c < lane)) ? 1 : 0;
  }
  float mx = v;
#pragma unroll
  for (int o = 32; o >= 1; o >>= 1) mx = fmaxf(mx, lane_xor(mx, lane, o));
  const bool sel = cvalid && rank < 16;
  const float e = sel ? fexpf_(v - mx) : 0.f;
  float sum = e;
#pragma unroll
  for (int o = 32; o >= 1; o >>= 1) sum += lane_xor(sum, lane, o);
  if (sel) { selx[rank] = key_idx(k1) * 128 + key_idx(k2); selx[16 + rank] = __float_as_int(e / sum); }
}
DEVN void ph_peer(const Params& p, int l, int nrows, int tid, char* ldsg, float oscale = 1.0f) {
  const int lane = tid & 63, wid = tid >> 6;
  float* part = (float*)ldsg;
  int* selbase = (int*)(ldsg + 8 * 1024 * 4) + wid * 64;
  int* tktmp = (int*)(ldsg + 8 * 1024 * 4 + 8 * 64 * 4) + wid * 64;
  const unsigned char* Ub = (const unsigned char*)p.Ub(); const unsigned char* Vb = (const unsigned char*)p.Vb();
  int ca = 0, cb = 0; bool cvalid = false;
  { int pre = 0;
    for (int a = 0; a < 16; ++a) { const int cnt = 16 / (a + 1); if (lane >= pre && lane < pre + cnt) { ca = a; cb = lane - pre; cvalid = true; } pre += cnt; } }
  int cur = 0;
  Sc4 nsc; nsc.a = nsc.b = nsc.c = nsc.d = 0;
  if ((int)blockIdx.x < nrows) {
    peer_topk(peer_keys(peer_scores(p, blockIdx.x, wid, lane), lane), lane, ca, cb, cvalid, selbase, tktmp);
    nsc = peer_scores(p, (int)(blockIdx.x + gridDim.x) < nrows ? (int)(blockIdx.x + gridDim.x) : (int)blockIdx.x, wid, lane);
  }
  for (int r = blockIdx.x; r < nrows; r += gridDim.x) {
    const int* selx = selbase + cur * 32;
    int eidx[16];
#pragma unroll
    for (int e = 0; e < 16; ++e) eidx[e] = __builtin_amdgcn_readfirstlane(selx[e]);
    const float mygate = __int_as_float(selx[16 + (lane >> 2)]);
    const bool more = r + (int)gridDim.x < nrows;
    const Key4 nkeys = peer_keys(nsc, lane);
    uint4 rows[16], vrows[16];
#pragma unroll
    for (int e = 0; e < 16; ++e) rows[e] = ((const uint4*)(Ub + (size_t)eidx[e] * D))[lane];
    uint4 hraw0, hraw1;
    { const uint4* hp = (const uint4*)(p.h() + (size_t)r * D); hraw0 = hp[lane * 2]; hraw1 = hp[lane * 2 + 1]; }
#pragma unroll
    for (int e = 0; e < 16; ++e) vrows[e] = ((const uint4*)(Vb + (size_t)eidx[e] * D))[lane];
    const float2 g2v = *(const float2*)(p.mods() + ((size_t)l * 3 + modrow(r)) * 6 * D + 5 * D + tid * 2);
    float2 xv = *(const float2*)(p.xcur() + (size_t)r * D + tid * 2);
    nsc = peer_scores(p, r + 2 * (int)gridDim.x < nrows ? r + 2 * (int)gridDim.x : r, wid, lane);
    if (more) peer_topk(nkeys, lane, ca, cb, cvalid, selbase + (cur ^ 1) * 32, tktmp);
    float hv[16]; unpack8(hraw0, hv); unpack8(hraw1, hv + 8);
    float d[16];
#pragma unroll
    for (int e = 0; e < 16; ++e) {
      float f[16]; unpack16_fp8(rows[e], f);
      float a = 0.f;
#pragma unroll
      for (int k = 0; k < 16; ++k) a += f[k] * hv[k];
      d[e] = a;
    }
#define FOLD(NV, O) _Pragma("unroll") for (int i = 0; i < NV / 2; ++i) { const bool up = (lane & O) != 0; const float send = up ? d[i] : d[i + NV / 2]; const float keep = up ? d[i + NV / 2] : d[i]; d[i] = keep + lane_xor(send, lane, O); }
    FOLD(16, 32) FOLD(8, 16) FOLD(4, 8) FOLD(2, 4)
#undef FOLD
    float dot = d[0]; dot += lane_xor(dot, lane, 2); dot += lane_xor(dot, lane, 1);
    const float myact = mygate * geluf_(dot * (1.0f / 32.0f));
    float acc[16];
#pragma unroll
    for (int k = 0; k < 16; ++k) acc[k] = 0.f;
#pragma unroll
    for (int e = 0; e < 16; ++e) {
      const float a = __int_as_float(__builtin_amdgcn_readlane(__float_as_int(myact), e * 4));
      float f[16]; unpack16_fp8(vrows[e], f);
#pragma unroll
      for (int k = 0; k < 16; ++k) acc[k] += a * f[k];
    }
    float* partc = part + cur * ((8 * 1024 * 4 + 2 * 8 * 64 * 4) / 4);
    { float4* pw = (float4*)(partc + wid * 1024 + lane * 16);
      pw[0] = float4{acc[0], acc[1], acc[2], acc[3]}; pw[1] = float4{acc[4], acc[5], acc[6], acc[7]};
      pw[2] = float4{acc[8], acc[9], acc[10], acc[11]}; pw[3] = float4{acc[12], acc[13], acc[14], acc[15]}; }
    __syncthreads();
    { const int c = tid * 2;
      float s0 = 0.f, s1 = 0.f;
#pragma unroll
      for (int w = 0; w < 8; ++w) { const float2 t = *(const float2*)(partc + w * 1024 + c); s0 += t.x; s1 += t.y; }
      xv.x += oscale * g2v.x * s0; xv.y += oscale * g2v.y * s1; *(float2*)(p.xcur() + (size_t)r * D + c) = xv; }
    cur ^= 1;
  }
}
#endif

DEVN void ph_final(const Params& p, i64 gtid, i64 gsz) {
  const float* g = p.in[I_g_final];
#ifndef CPU_SIM
  float pscale = 1.0f;
#if PROBE_K >= 0
  { const unsigned long long* ts = (const unsigned long long*)(p.ws + WL.ts);
    const float frac = (float)(ts[PROBE_K + 1] - ts[0]) / (float)(ts[NPHASES - 1] - ts[0]);
    pscale = 1.0f + sqrtf(floorf(frac * 50.0f + 0.5f) * 0.02f); }
#endif
  const int lane = (int)(gtid & 63);
  const i64 W = gsz >> 6;
  float4 gv[4];
#pragma unroll
  for (int i = 0; i < 4; ++i) gv[i] = *(const float4*)(g + (lane + i * 64) * 4);
  for (i64 r = gtid >> 6; r < NLAT; r += 2 * W) {
    const bool two = r + W < NLAT;
    const i64 rb = two ? r + W : r;
    const float4* xra = (const float4*)(p.xcur() + (size_t)r * D); const float4* xrb = (const float4*)(p.xcur() + (size_t)rb * D);
    float4 xa[4], xb[4]; float sa = 0.f, sb = 0.f;
#pragma unroll
    for (int i = 0; i < 4; ++i) { xa[i] = xra[lane + i * 64]; xb[i] = xrb[lane + i * 64]; }
#pragma unroll
    for (int i = 0; i < 4; ++i) { sa += xa[i].x * xa[i].x + xa[i].y * xa[i].y + xa[i].z * xa[i].z + xa[i].w * xa[i].w; sb += xb[i].x * xb[i].x + xb[i].y * xb[i].y + xb[i].z * xb[i].z + xb[i].w * xb[i].w; }
#pragma unroll
    for (int o = 32; o >= 1; o >>= 1) { sa += lane_xor(sa, lane, o); sb += lane_xor(sb, lane, o); }
    const float rsa = 1.0f / sqrtf(sa * (1.0f / D) + EPS), rsb = 1.0f / sqrtf(sb * (1.0f / D) + EPS);
#pragma unroll
    for (int i = 0; i < 4; ++i) {
      const int k = (lane + i * 64) * 4;
      float4 o4; o4.x = xa[i].x * rsa * gv[i].x * pscale; o4.y = xa[i].y * rsa * gv[i].y * pscale; o4.z = xa[i].z * rsa * gv[i].z * pscale; o4.w = xa[i].w * rsa * gv[i].w * pscale;
      *(float4*)(p.out + (size_t)r * D + k) = o4;
    }
    if (two) {
#pragma unroll
      for (int i = 0; i < 4; ++i) {
        const int k = (lane + i * 64) * 4;
        float4 o4; o4.x = xb[i].x * rsb * gv[i].x * pscale; o4.y = xb[i].y * rsb * gv[i].y * pscale; o4.z = xb[i].z * rsb * gv[i].z * pscale; o4.w = xb[i].w * rsb * gv[i].w * pscale;
        *(float4*)(p.out + (size_t)rb * D + k) = o4;
      }
    }
  }
#else
  for (i64 r = gtid; r < NLAT; r += gsz) {
    const float* xr = p.xcur() + (size_t)r * D;
    float ss = 0.f;
    for (int k = 0; k < D; ++k) ss += xr[k] * xr[k];
    float rstd = 1.0f / sqrtf(ss / D + EPS);
    for (int k = 0; k < D; ++k) p.out[(size_t)r * D + k] = xr[k] * rstd * g[k];
  }
#endif
}

DEV void rope4(float* v, const float* tab, int nf, int pos, int f0) {
#pragma unroll
  for (int jj = 0; jj < 4; ++jj) {
    float c = tab[(pos * nf + f0 + jj) * 2], s = tab[(pos * nf + f0 + jj) * 2 + 1];
    float x1 = v[2 * jj], x2 = v[2 * jj + 1];
    v[2 * jj] = x1 * c - x2 * s; v[2 * jj + 1] = x1 * s + x2 * c;
  }
}
struct EpiInproj {
  static constexpr int W = 8; static constexpr bool SUB = false; static constexpr bool STAGED = false;
  const Params& p;
  MDEV void apply(int r, int c0, float* v) const {
    if (c0 >= 3744) return;
    if (c0 >= 384 && r < NLAT) {
      int t = r % N;
      if (c0 < C_KR + 32) { int pi = (c0 - C_KR) >> 1; int half = pi >> 3; rope4(v, p.tabA(), 8, half ? t % GRIDW : t / GRIDW, pi & 7); }
      else if (c0 >= C_GQ && c0 < C_GKV + 128) { int pi = ((c0 - C_GQ) & 63) >> 1; int half = pi >> 4; rope4(v, p.tabD(), 16, half ? t % GRIDW : t / GRIDW, pi & 15); }
    }
    store8bf(p.P() + (size_t)r * PC + c0, v);
  }
};
struct EpiUq {
  static constexpr int W = 8; static constexpr bool SUB = false; static constexpr bool STAGED = true; static constexpr bool STAGED_ALL = true;
  const Params& p;
  MDEV void apply(int r, int c0, float* v) const {
    float rstd = 1.0f / sqrtf(p.ssq()[r] * (1.0f / 256.0f) + EPS);
#pragma unroll
    for (int j = 0; j < 8; ++j) v[j] *= rstd;
    int d0 = c0 % 96;
    if (d0 >= 64 && r < NLAT) { int t = r % N; int pi = (d0 - 64) >> 1; int half = pi >> 3; rope4(v, p.tabA(), 8, half ? t % GRIDW : t / GRIDW, pi & 7); }
    store8bf(p.QA() + (size_t)r * 768 + c0, v);
  }
#ifndef CPU_SIM
  struct Pre { float s; float4 t0, t1; };
  MDEV void pre(int r, int c0, Pre& q) const {
    q.s = p.ssq()[r];
    const int d0 = c0 % 96;
    q.t0 = float4{1.f, 0.f, 1.f, 0.f}; q.t1 = q.t0;
    if (d0 >= 64 && r < NLAT) { const int t = r % N, pi = (d0 - 64) >> 1, half = pi >> 3; const int pos = half ? t % GRIDW : t / GRIDW;
      const float* tb = p.tabA() + (pos * 8 + (pi & 7)) * 2; q.t0 = *(const float4*)tb; q.t1 = *(const float4*)(tb + 4); }
  }
  MDEV void fin(int r, int c0, float* v, const Pre& q) const {
    const float rstd = 1.0f / sqrtf(q.s * (1.0f / 256.0f) + EPS);
    const float cs[8] = {q.t0.x, q.t0.y, q.t0.z, q.t0.w, q.t1.x, q.t1.y, q.t1.z, q.t1.w};
    float o[8];
#pragma unroll
    for (int jj = 0; jj < 4; ++jj) { const float x1 = v[2 * jj] * rstd, x2 = v[2 * jj + 1] * rstd, c = cs[2 * jj], sn = cs[2 * jj + 1]; o[2 * jj] = x1 * c - x2 * sn; o[2 * jj + 1] = x1 * sn + x2 * c; }
    store8bf(p.QA() + (size_t)r * 768 + c0, o);
  }
#endif
};
struct EpiUkv {
  static constexpr int W = 8; static constexpr bool SUB = false; static constexpr bool STAGED = true; static constexpr bool STAGED_ALL = true;
  const Params& p;
  MDEV void apply(int r, int c0, float* v) const {
    float rstd = 1.0f / sqrtf(p.ssq()[TT + r] * (1.0f / 128.0f) + EPS);
#pragma unroll
    for (int j = 0; j < 8; ++j) v[j] *= rstd;
    store8bf(p.KVA() + (size_t)r * 1024 + c0, v);
  }
#ifndef CPU_SIM
  struct Pre { float s; };
  MDEV void pre(int r, int, Pre& q) const { q.s = p.ssq()[TT + r]; }
  MDEV void fin(int r, int c0, float* v, const Pre& q) const {
    const float rstd = 1.0f / sqrtf(q.s * (1.0f / 128.0f) + EPS);
#pragma unroll
    for (int j = 0; j < 8; ++j) v[j] *= rstd;
    store8bf(p.KVA() + (size_t)r * 1024 + c0, v);
  }
#endif
};
struct EpiLru {
  static constexpr int W = 8; static constexpr bool SUB = false; static constexpr bool STAGED = true; static constexpr bool STAGED_ALL = true;
  const Params& p; int l; const float* br; const float* bi;
  MDEV void finish(int r, int c0, const float* v, const float* brv, const float* biv, const float* splv, const float* xcv) const {
    int kw = c0 >> 10, dir = (c0 >> 9) & 1, blk4 = (c0 >> 7) & 3, jc0 = (c0 & 127) >> 1;
    int cb = kw * 256 + blk4 * 64 + jc0;
    float lav[4], lbv[4];
#pragma unroll
    for (int jj = 0; jj < 4; ++jj) {
      float rg = sigmoidf_(v[2 * jj] + brv[jj]), ig = sigmoidf_(v[2 * jj + 1] + biv[jj]);
      float log_a = -8.0f * rg * splv[jj];
      const float a_ = fexpf_(log_a);
      lav[jj] = log_a; lbv[jj] = sqrtf(fmaxf(1.0f - a_ * a_, 0.0f)) * ig * xcv[jj];
    }
#ifndef CPU_SIM
    { uint4 w;
      w.x = pk2bf(lav[0], lbv[0]); w.y = pk2bf(lav[1], lbv[1]); w.z = pk2bf(lav[2], lbv[2]); w.w = pk2bf(lav[3], lbv[3]);
      *(uint4*)(p.LAB() + ((size_t)dir * TT + r) * 512 + cb) = w; }
#else
    bf* la = p.LA() + ((size_t)dir * TT + r) * 512 + cb;
    bf* lb = p.LB() + ((size_t)dir * TT + r) * 512 + cb;
    for (int jj = 0; jj < 4; ++jj) { la[jj] = f2b(lav[jj]); lb[jj] = f2b(lbv[jj]); }
#endif
  }
  MDEV void apply(int r, int c0, float* v) const {
    int kw = c0 >> 10, dir = (c0 >> 9) & 1, blk4 = (c0 >> 7) & 3, jc0 = (c0 & 127) >> 1;
    int cb = kw * 256 + blk4 * 64 + jc0;
    float brv[4], biv[4], splv[4], xcv[4];
    for (int jj = 0; jj < 4; ++jj) { brv[jj] = br[(l * 2 + dir) * 512 + cb + jj]; biv[jj] = bi[(l * 2 + dir) * 512 + cb + jj]; splv[jj] = p.spl()[(l * 2 + dir) * 512 + cb + jj]; xcv[jj] = b2f(p.XC()[(size_t)r * 512 + cb + jj]); }
    finish(r, c0, v, brv, biv, splv, xcv);
  }
#ifndef CPU_SIM
  struct Pre { float4 a4, b4, s4; uint2 x2; };
  MDEV void pre(int r, int c0, Pre& q) const {
    int kw = c0 >> 10, dir = (c0 >> 9) & 1, blk4 = (c0 >> 7) & 3, jc0 = (c0 & 127) >> 1;
    int cb = kw * 256 + blk4 * 64 + jc0;
    q.a4 = gld4(br + (l * 2 + dir) * 512 + cb); q.b4 = gld4(bi + (l * 2 + dir) * 512 + cb);
    q.s4 = *(const float4*)(p.spl() + (l * 2 + dir) * 512 + cb);
    q.x2 = *(const uint2*)(p.XC() + (size_t)r * 512 + cb);
  }
  MDEV void fin(int r, int c0, float* v, const Pre& q) const {
    const float brv[4] = {q.a4.x, q.a4.y, q.a4.z, q.a4.w}, biv[4] = {q.b4.x, q.b4.y, q.b4.z, q.b4.w}, splv[4] = {q.s4.x, q.s4.y, q.s4.z, q.s4.w};
    const float xcv[4] = {__uint_as_float(q.x2.x << 16), __uint_as_float(q.x2.x & 0xFFFF0000u), __uint_as_float(q.x2.y << 16), __uint_as_float(q.x2.y & 0xFFFF0000u)};
    finish(r, c0, v, brv, biv, splv, xcv);
  }
#endif
};
struct EpiGate {
  static constexpr int W = 8; static constexpr bool SUB = false; static constexpr bool STAGED = false;
  const Params& p;
  MDEV void apply(int r, int c0, float* v) const {
#pragma unroll
    for (int j = 0; j < 8; ++j) v[j] = sigmoidf_(v[j]);
    store8bf(p.Gs() + (size_t)r * D + c0, v);
  }
};
struct EpiBranch {
  static constexpr int W = 8; static constexpr bool SUB = false; static constexpr bool STAGED = false;
  const Params& p; int br;
  MDEV void apply(int r, int c0, float* v) const {
    float g[8]; load8bf(p.Gs() + (size_t)r * D + c0, g);
    if (br > 0) {
      float mo[8]; load8bf(p.M() + (size_t)r * D + c0, mo);
#pragma unroll
      for (int j = 0; j < 8; ++j) v[j] = mo[j] + g[j] * v[j];
    } else {
#pragma unroll
      for (int j = 0; j < 8; ++j) v[j] = g[j] * v[j];
    }
    store8bf(p.M() + (size_t)r * D + c0, v);
  }
};
struct EpiGateAll {
  static constexpr int W = 8; static constexpr bool SUB = false; static constexpr bool STAGED = false;
  const Params& p;
  MDEV void apply(int r, int c0, float* v) const {
#pragma unroll
    for (int j = 0; j < 8; ++j) v[j] = sigmoidf_(v[j]) * 255.f + 0.5f;
    unsigned char* gq = p.G8() + (size_t)r * 4096 + c0;
#ifndef CPU_SIM
    uint2 w;
    w.x = (unsigned)v[0] | ((unsigned)v[1] << 8) | ((unsigned)v[2] << 16) | ((unsigned)v[3] << 24);
    w.y = (unsigned)v[4] | ((unsigned)v[5] << 8) | ((unsigned)v[6] << 16) | ((unsigned)v[7] << 24);
    *(uint2*)gq = w;
#else
    for (int j = 0; j < 8; ++j) gq[j] = (unsigned char)v[j];
#endif
  }
};
struct EpiBranchSub {
  static constexpr int W = 8; static constexpr bool SUB = true; static constexpr bool STAGED = true; static constexpr bool STAGED_ALL = false;
  const Params& p;
  MDEV void apply(int, int, float*) const {}
  MDEV void gate8(int r, int c0, int i, float* g) const {
    const unsigned char* gq = p.G8() + (size_t)r * 4096 + i * 1024 + c0;
#ifndef CPU_SIM
    const uint2 w = *(const uint2*)gq;
#pragma unroll
    for (int j = 0; j < 4; ++j) { g[j] = (float)((w.x >> (8 * j)) & 255u) * (1.0f / 255.0f); g[4 + j] = (float)((w.y >> (8 * j)) & 255u) * (1.0f / 255.0f); }
#else
    for (int j = 0; j < 8; ++j) g[j] = (float)gq[j] * (1.0f / 255.0f);
#endif
  }
  MDEV void apply_sub(int r, int c0, float* v, int sub) const {
    if (sub < 3) { store8bf(p.BR() + (size_t)r * 3072 + sub * 1024 + c0, v); return; }
    float g[8]; gate8(r, c0, 3, g);
#pragma unroll
    for (int j = 0; j < 8; ++j) v[j] *= g[j];
#pragma unroll
    for (int i = 0; i < 3; ++i) {
      float bi[8]; load8bf(p.BR() + (size_t)r * 3072 + i * 1024 + c0, bi);
      gate8(r, c0, i, g);
#pragma unroll
      for (int j = 0; j < 8; ++j) v[j] += g[j] * bi[j];
    }
    store8bf(p.M() + (size_t)r * D + c0, v);
  }
#ifndef CPU_SIM
  struct Pre { uint2 g[4]; uint4 b[3]; };
  MDEV void pre(int r, int c0, Pre& q) const {
#pragma unroll
    for (int i = 0; i < 4; ++i) q.g[i] = *(const uint2*)(p.G8() + (size_t)r * 4096 + i * 1024 + c0);
#pragma unroll
    for (int i = 0; i < 3; ++i) q.b[i] = *(const uint4*)(p.BR() + (size_t)r * 3072 + i * 1024 + c0);
  }
  MDEV void fin(int r, int c0, float* v, const Pre& q) const {
#pragma unroll
    for (int i = 3; i >= 0; --i) {
      float g[8];
#pragma unroll
      for (int j = 0; j < 4; ++j) { g[j] = (float)((q.g[i].x >> (8 * j)) & 255u) * (1.0f / 255.0f); g[4 + j] = (float)((q.g[i].y >> (8 * j)) & 255u) * (1.0f / 255.0f); }
      if (i == 3) {
#pragma unroll
        for (int j = 0; j < 8; ++j) v[j] *= g[j];
      } else {
        float bi[8]; unpack8(q.b[i], bi);
#pragma unroll
        for (int j = 0; j < 8; ++j) v[j] += g[j] * bi[j];
      }
    }
    store8bf(p.M() + (size_t)r * D + c0, v);
  }
#endif
};
struct EpiFilt {
  static constexpr int W = 8; static constexpr bool SUB = false; static constexpr bool STAGED = false;
  const Params& p;
  MDEV void apply(int j, int tt, float* v) const {
    const float maxd = -15.350567286626973f, mind = -3.0701134573253945f;
    const float ad = fabsf(mind + (float)j * ((maxd - mind) / 1023.0f));
    int t, L; if (tt < N) { t = tt; L = N; } else { t = tt - N; L = LC; }
    const float sc = -ad / (float)(L - 1);
#pragma unroll
    for (int q = 0; q < 8; ++q) v[q] *= fexpf_((float)(t + q) * sc);
    float* d = p.F() + (size_t)j * (N + LC) + tt;
#ifndef CPU_SIM
    *(float4*)d = float4{v[0], v[1], v[2], v[3]}; *(float4*)(d + 4) = float4{v[4], v[5], v[6], v[7]};
#else
    for (int q = 0; q < 8; ++q) d[q] = v[q];
#endif
  }
};
struct EpiOut {
  static constexpr int W = 8; static constexpr bool SUB = false; static constexpr bool STAGED = true; static constexpr bool STAGED_ALL = true;
  const Params& p; int l; float osc; const float* xlat; const float* xctx;
  MDEV void apply(int r, int c0, float* v) const {
    const float* g1 = p.mods() + ((size_t)l * 3 + modrow(r)) * 6 * D + 2 * D + c0;
    const float* xs = (r < NLAT ? xlat + (size_t)r * D : xctx + (size_t)(r - NLAT) * D) + c0;
    float* xr = p.xcur() + (size_t)r * D + c0;
    for (int j = 0; j < 8; ++j) xr[j] = xs[j] + osc * g1[j] * v[j];
  }
#ifndef CPU_SIM
  struct Pre { float4 g0, g1, x0, x1; };
  MDEV void pre(int r, int c0, Pre& q) const {
    const float* g1 = p.mods() + ((size_t)l * 3 + modrow(r)) * 6 * D + 2 * D + c0;
    const float* xs = (r < NLAT ? xlat + (size_t)r * D : xctx + (size_t)(r - NLAT) * D) + c0;
    q.g0 = *(const float4*)g1; q.g1 = *(const float4*)(g1 + 4); q.x0 = gld4(xs); q.x1 = gld4(xs + 4);
  }
  MDEV void fin(int r, int c0, float* v, const Pre& q) const {
    float* xr = p.xcur() + (size_t)r * D + c0;
    float4 o0, o1;
    o0.x = q.x0.x + osc * q.g0.x * v[0]; o0.y = q.x0.y + osc * q.g0.y * v[1]; o0.z = q.x0.z + osc * q.g0.z * v[2]; o0.w = q.x0.w + osc * q.g0.w * v[3];
    o1.x = q.x1.x + osc * q.g1.x * v[4]; o1.y = q.x1.y + osc * q.g1.y * v[5]; o1.z = q.x1.z + osc * q.g1.z * v[6]; o1.w = q.x1.w + osc * q.g1.w * v[7];
    *(float4*)xr = o0; *(float4*)(xr + 4) = o1;
  }
#endif
};
struct EpiPQ {
  static constexpr int W = 8; static constexpr bool SUB = false; static constexpr bool STAGED = false;
  const Params& p;
  MDEV void apply(int r, int c0, float* v) const { store8bf(p.PQ() + (size_t)r * 1024 + c0, v); }
};
struct EpiSC {
  static constexpr int W = 8; static constexpr bool SUB = false; static constexpr bool STAGED = false;
  const Params& p;
  MDEV void apply(int r, int c0, float* v) const {
    sc_t* d = p.SC() + (size_t)r * 2048 + c0;
#ifndef CPU_SIM
    typedef _Float16 half8 __attribute__((ext_vector_type(8)));
    half8 hv8;
#pragma unroll
    for (int j = 0; j < 8; ++j) hv8[j] = (_Float16)v[j];
    *(half8*)d = hv8;
#else
    for (int j = 0; j < 8; ++j) d[j] = (sc_t)v[j];
#endif
  }
};

struct GemmDesc { const bf* A; const bf* Bt; int lda, ldb, K, nrows, ncols; int a_pn_shift, a_pn_mul; int nsub = 1, a_sub = 0, b_sub = 0; int unit_off = 0; };

#ifndef CPU_SIM
namespace pg8 {
#define PG8_LAS __attribute__((address_space(3)))
typedef short bf16x8 __attribute__((ext_vector_type(8)));
typedef float f32x4 __attribute__((ext_vector_type(4)));
constexpr int BM = 256, BK = 64, HALF = 128, HTB = HALF * BK * 2, STAGE_BYTES = 8 * HTB, NXCD = 8, WGM = 8;
__device__ __forceinline__ int lds_byte(int r, int c) { const int st = (r >> 4) * 2 + (c >> 5), rr = r & 15, cc = c & 31, ob = rr * 64 + cc * 2; return st * 1024 + (ob ^ (((ob >> 9) & 1) << 5)); }
__device__ __forceinline__ void stage_rc(int b, int& R, int& C) { const int st = b / 1024, sb = b % 1024, swz = sb ^ (((sb >> 9) & 1) << 5); R = (st >> 1) * 16 + swz / 64; C = (st & 1) * 32 + (swz % 64) / 2; }
__device__ __forceinline__ int perm32(int rho) { const int n = rho >> 4, i = rho & 15; return 8 * (i >> 2) + 4 * n + (i & 3); }
struct Unit { int pm, pn, sub; };
struct StaticOrder {
  int nM, nN, nwg, G, c, nsub;
  __device__ void init(int nM_, int nN_, int G_, int c_, int nsub_) { nM = nM_; nN = nN_; nwg = nM * nN; G = G_; c = c_; nsub = nsub_; }
  __device__ bool next(int i, Unit& u) const {
    const int it = i / nsub; u.sub = i - it * nsub;
    const long L = (long)it * G + c; if (L >= nwg) return false;
    int wgid = (int)L; { const int q = nwg / NXCD, r = nwg % NXCD, xcd = wgid % NXCD, off = wgid / NXCD; wgid = (xcd < r ? xcd * (q + 1) : r * (q + 1) + (xcd - r) * q) + off; }
    const int nig = WGM * nN, gid = wgid / nig, fm = gid * WGM, gsz = (nM - fm) < WGM ? (nM - fm) : WGM;
    u.pm = fm + ((wgid % nig) % gsz); u.pn = (wgid % nig) / gsz; return true;
  }
};

template <class E>
__device__ __forceinline__ void epi_call(const E& e, const f32x4 (&acc)[2][2][4][2], const Unit& u, int wr, int wc, int fr_, int fq_) {
  int fr = fr_, fq = fq_;
  asm volatile("" : "+v"(fr), "+v"(fq));
  if constexpr (E::STAGED) {
    if (E::STAGED_ALL || u.sub == 3) {
#pragma unroll
      for (int ai = 0; ai < 2; ++ai)
#pragma unroll
        for (int m = 0; m < 4; ++m) {
          typename E::Pre q[2];
#pragma unroll
          for (int bj = 0; bj < 2; ++bj) { q[bj] = typename E::Pre{}; e.pre(u.pm * BM + ai * HALF + wr * 64 + m * 16 + fr, u.pn * BM + bj * HALF + wc * 32 + 8 * fq, q[bj]); }
#pragma unroll
          for (int bj = 0; bj < 2; ++bj) {
            float v[8];
#pragma unroll
            for (int j = 0; j < 4; ++j) { v[j] = acc[ai][bj][m][0][j]; v[4 + j] = acc[ai][bj][m][1][j]; }
            e.fin(u.pm * BM + ai * HALF + wr * 64 + m * 16 + fr, u.pn * BM + bj * HALF + wc * 32 + 8 * fq, v, q[bj]);
          }
          __builtin_amdgcn_sched_barrier(0);
        }
      return;
    }
  }
#pragma unroll
  for (int ai = 0; ai < 2; ++ai)
#pragma unroll
    for (int m = 0; m < 4; ++m) {
      const int r = u.pm * BM + ai * HALF + wr * 64 + m * 16 + fr;
#pragma unroll
      for (int bj = 0; bj < 2; ++bj) {
        if constexpr (E::W == 8) {
          const int c0 = u.pn * BM + bj * HALF + wc * 32 + 8 * fq;
          float v[8];
#pragma unroll
          for (int j = 0; j < 4; ++j) { v[j] = acc[ai][bj][m][0][j]; v[4 + j] = acc[ai][bj][m][1][j]; }
          if constexpr (E::W == 8 && E::SUB) e.apply_sub(r, c0, v, u.sub); else e.apply(r, c0, v);
        } else {
#pragma unroll
          for (int n = 0; n < 2; ++n) {
            const int c0 = u.pn * BM + bj * HALF + wc * 32 + 16 * n + 4 * fq;
            float v[4];
#pragma unroll
            for (int j = 0; j < 4; ++j) v[j] = acc[ai][bj][m][n][j];
            e.apply(r, c0, v);
          }
        }
      }
      if (m == 1 || m == 3) __builtin_amdgcn_sched_barrier(0);
    }
}

template <class Epi>
__device__ __forceinline__ void gemm_phase(PG8_LAS unsigned char* lds, const int tid, const GemmDesc g, const Epi& E) {
  constexpr bool PERM = (Epi::W == 8);
  const int wid = __builtin_amdgcn_readfirstlane(tid >> 6), lane = tid & 63, wr = wid >> 2, wc = wid & 3, fr = lane & 15, fq = lane >> 4;
  const int K = g.K, nt = K / BK;
  StaticOrder S; S.init(g.nrows / BM, g.ncols / BM, (int)gridDim.x, (int)((blockIdx.x + gridDim.x - (unsigned)g.unit_off % gridDim.x) % gridDim.x), g.nsub);
  unsigned voffA[2], voffB[2];
#pragma unroll
  for (int i = 0; i < 2; ++i) { int R, C; stage_rc(tid * 16 + i * 8192, R, C); const int Rb = PERM ? ((R & ~31) + perm32(R & 31)) : R;
    voffA[i] = (unsigned)(R * g.lda + C) * 2u; voffB[i] = (unsigned)(Rb * g.ldb + C) * 2u; }
  const size_t kstep = (size_t)(BK * 2);
  const size_t hstepA = (size_t)HALF * g.lda * 2, hstepB = (size_t)HALF * g.ldb * 2;
  const unsigned ldsw = (unsigned)wid * 1024u;
  const int aoff = lds_byte(wr * 64 + fr, fq * 8), boff = lds_byte(wc * 32 + fr, fq * 8);
#define PG8_SA(b, h) (((b) * 2 + (h)) * HTB)
#define PG8_SB(b, h) ((4 + (b) * 2 + (h)) * HTB)
#define PG8_STAGE(bufoff, gbase, voff) do { _Pragma("unroll") for (int _i = 0; _i < 2; ++_i) \
        __builtin_amdgcn_global_load_lds((const unsigned*)((const char*)(gbase) + (voff)[_i]), (PG8_LAS unsigned*)(lds + (bufoff) + ldsw + _i * 8192), 16, 0, 0); } while (0)
#define PG8_LDA(dst, b, h) do { _Pragma("unroll") for (int m = 0; m < 4; ++m) _Pragma("unroll") for (int k = 0; k < 2; ++k) dst[m][k] = *(const PG8_LAS bf16x8*)(lds + PG8_SA(b, h) + aoff + m * 2048 + k * 1024); } while (0)
#define PG8_LDB(dst, b, h) do { _Pragma("unroll") for (int n = 0; n < 2; ++n) _Pragma("unroll") for (int k = 0; k < 2; ++k) dst[n][k] = *(const PG8_LAS bf16x8*)(lds + PG8_SB(b, h) + boff + n * 2048 + k * 1024); } while (0)
#define PG8_MMA(ai, bj, At, Bt) do { __builtin_amdgcn_s_setprio(1); _Pragma("unroll") for (int m = 0; m < 4; ++m) _Pragma("unroll") for (int n = 0; n < 2; ++n) _Pragma("unroll") for (int k = 0; k < 2; ++k) \
        acc[ai][bj][m][n] = __builtin_amdgcn_mfma_f32_16x16x32_bf16(Bt[n][k], At[m][k], acc[ai][bj][m][n], 0, 0, 0); __builtin_amdgcn_s_setprio(0); } while (0)
#define PG8_WAIT_V(n) asm volatile("s_waitcnt vmcnt(" #n ")" ::: "memory")
#define PG8_WAIT_L(n) asm volatile("s_waitcnt lgkmcnt(" #n ")" ::: "memory")
#define PG8_BAR __builtin_amdgcn_s_barrier()
#define PG8_SCHED __builtin_amdgcn_sched_barrier(0)
#define PG8_ABASE(u) ((const char*)g.A + ((size_t)(u).pm * BM * g.lda + (size_t)((u).pn >> g.a_pn_shift) * g.a_pn_mul + (size_t)(u).sub * g.a_sub) * 2)
#define PG8_BBASE(u) ((const char*)g.Bt + ((size_t)(u).pn * BM * g.ldb + (size_t)(u).sub * g.b_sub) * 2)
  Unit cur, nxt; int ui = 0;
  if (!S.next(0, cur)) return;
  f32x4 acc[2][2][4][2];
#pragma unroll
  for (int a = 0; a < 2; ++a)
#pragma unroll
    for (int b = 0; b < 2; ++b)
#pragma unroll
      for (int m = 0; m < 4; ++m)
#pragma unroll
        for (int n = 0; n < 2; ++n) acc[a][b][m][n] = (f32x4){0.f, 0.f, 0.f, 0.f};
  bf16x8 At[4][2], B0[2][2], B1[2][2];
  const char* cA = PG8_ABASE(cur); const char* cB = PG8_BBASE(cur);
  asm volatile("" : "+v"(voffA[0]), "+v"(voffA[1]), "+v"(voffB[0]), "+v"(voffB[1]));
  PG8_STAGE(PG8_SB(0, 0), cB, voffB); PG8_STAGE(PG8_SA(0, 0), cA, voffA); PG8_STAGE(PG8_SB(0, 1), cB + hstepB, voffB); PG8_STAGE(PG8_SA(0, 1), cA + hstepA, voffA);
  if (wr == 1) PG8_BAR;
  PG8_WAIT_V(4); PG8_BAR;
  PG8_STAGE(PG8_SB(1, 0), cB + kstep, voffB); PG8_STAGE(PG8_SA(1, 0), cA + kstep, voffA); PG8_STAGE(PG8_SB(1, 1), cB + hstepB + kstep, voffB);
  PG8_WAIT_V(6); PG8_BAR;
  for (;;) {
    const bool has_next = S.next(ui + 1, nxt);
    const char* nA = has_next ? PG8_ABASE(nxt) : cA; const char* nB = has_next ? PG8_BBASE(nxt) : cB;
    for (int t = 0; t < nt; t += 2) {
      const bool last = (t == nt - 2);
      asm volatile("" : "+v"(voffA[0]), "+v"(voffA[1]), "+v"(voffB[0]), "+v"(voffB[1]));
      const char* a1 = cA + (size_t)(t + 1) * kstep;
      const char* a2 = last ? nA : cA + (size_t)(t + 2) * kstep; const char* b2 = last ? nB : cB + (size_t)(t + 2) * kstep;
      const char* a3 = a2 + kstep; const char* b3 = b2 + kstep;
      PG8_LDB(B0, 0, 0); PG8_SCHED; PG8_LDA(At, 0, 0); PG8_STAGE(PG8_SA(1, 1), a1 + hstepA, voffA);
      PG8_WAIT_L(8); PG8_BAR; PG8_WAIT_L(0); PG8_MMA(0, 0, At, B0); PG8_BAR; PG8_SCHED;
      PG8_LDB(B1, 0, 1); PG8_STAGE(PG8_SB(0, 0), b2, voffB);
      PG8_BAR; PG8_WAIT_L(0); PG8_MMA(0, 1, At, B1); PG8_BAR;
      PG8_LDA(At, 0, 1); PG8_STAGE(PG8_SA(0, 0), a2, voffA);
      PG8_BAR; PG8_WAIT_L(0); PG8_MMA(1, 0, At, B0); PG8_BAR; PG8_SCHED;
      PG8_STAGE(PG8_SB(0, 1), b2 + hstepB, voffB);
      PG8_WAIT_V(6); PG8_BAR; PG8_MMA(1, 1, At, B1); PG8_BAR;
      PG8_LDB(B0, 1, 0); PG8_SCHED; PG8_LDA(At, 1, 0); PG8_STAGE(PG8_SA(0, 1), a2 + hstepA, voffA);
      PG8_WAIT_L(8); PG8_BAR; PG8_WAIT_L(0); PG8_MMA(0, 0, At, B0); PG8_BAR; PG8_SCHED;
      PG8_LDB(B1, 1, 1); PG8_STAGE(PG8_SB(1, 0), b3, voffB);
      PG8_BAR; PG8_WAIT_L(0); PG8_MMA(0, 1, At, B1); PG8_BAR;
      PG8_LDA(At, 1, 1); PG8_STAGE(PG8_SA(1, 0), a3, voffA);
      PG8_BAR; PG8_WAIT_L(0); PG8_MMA(1, 0, At, B0); PG8_BAR; PG8_SCHED;
      PG8_STAGE(PG8_SB(1, 1), b3 + hstepB, voffB);
      PG8_WAIT_V(6); PG8_BAR; PG8_MMA(1, 1, At, B1); PG8_BAR;
    }
    epi_call(E, acc, cur, wr, wc, fr, fq);
    if (!has_next) break;
#pragma unroll
    for (int a = 0; a < 2; ++a)
#pragma unroll
      for (int b = 0; b < 2; ++b)
#pragma unroll
        for (int m = 0; m < 4; ++m)
#pragma unroll
          for (int n = 0; n < 2; ++n) acc[a][b][m][n] = (f32x4){0.f, 0.f, 0.f, 0.f};
    cur = nxt; cA = nA; cB = nB; ++ui;
  }
  PG8_WAIT_V(0);
  if (wr == 0) PG8_BAR;
  PG8_BAR;
#undef PG8_SA
#undef PG8_SB
#undef PG8_STAGE
#undef PG8_LDA
#undef PG8_LDB
#undef PG8_MMA
#undef PG8_WAIT_V
#undef PG8_WAIT_L
#undef PG8_BAR
#undef PG8_SCHED
#undef PG8_ABASE
#undef PG8_BBASE
}
}
struct Ctx { i64 gtid, gsz; PG8_LAS unsigned char* lds; char* ldsg; int tid; };
template <class E> DEV void run_gemm(const Ctx& cx, const GemmDesc& g, const E& e) { pg8::gemm_phase<E>(cx.lds, cx.tid, g, e); }
#else
struct Ctx { i64 gtid, gsz; };
template <class E> static void run_gemm(const Ctx& cx, const GemmDesc& g, const E& e) {
  constexpr int W = E::W;
  const int ng = g.ncols / W;
  for (i64 i = cx.gtid; i < (i64)g.nrows * ng; i += cx.gsz) {
    int r = (int)(i / ng), c0 = (int)(i % ng) * W;
    int pn = c0 / 256;
    for (int sub = 0; sub < g.nsub; ++sub) {
      const bf* a = g.A + (size_t)r * g.lda + (size_t)(pn >> g.a_pn_shift) * g.a_pn_mul + (size_t)sub * g.a_sub;
      float v[8];
      for (int j = 0; j < W; ++j) {
        const bf* b = g.Bt + (size_t)(c0 + j) * g.ldb + (size_t)sub * g.b_sub;
        float acc = 0.f;
        for (int k = 0; k < g.K; ++k) acc += b2f(a[k]) * b2f(b[k]);
        v[j] = acc;
      }
      if constexpr (E::SUB) e.apply_sub(r, c0, v, sub); else e.apply(r, c0, v);
    }
  }
}
#endif


#ifndef CPU_SIM
namespace fa {
using bf16x8 = __attribute__((ext_vector_type(8))) short;
using s16x4 = __attribute__((ext_vector_type(4))) short;
using f32x16 = __attribute__((ext_vector_type(16))) float;
using u32x4 = __attribute__((ext_vector_type(4))) unsigned;
constexpr int KVBLK = 64, QBLK = 32;
constexpr float THR = 8.f;
constexpr int SHM_V = KVBLK * 128 * 2, SHM_K = KVBLK * 128 * 2;
constexpr int NBUF = 3;
constexpr int SHM_ATTN = NBUF * SHM_V + NBUF * SHM_K + 8 * 64 * 4;
#define KSWZ(row, colB) ((row) * 256 + ((colB) ^ (((row) & 7) << 4)))
#define SBAR() __builtin_amdgcn_sched_barrier(0)
__device__ __forceinline__ int crow(int r, int hi) { return (r & 3) + 8 * (r >> 2) + 4 * hi; }
__device__ __forceinline__ unsigned cvtpk(float lo, float hi) { unsigned r; asm volatile("v_cvt_pk_bf16_f32 %0, %1, %2" : "=v"(r) : "v"(lo), "v"(hi)); return r; }
template <int SC1000000> __device__ __forceinline__ void partialSM(f32x16& p0, f32x16& p1, float& m_reg, float& mn, float& alpha) {
  constexpr float SCALE = SC1000000 * 1e-9f; constexpr float C = SCALE * 1.4426950408889634f;
  float pmax = p0[0];
#pragma unroll
  for (int r = 1; r < 16; ++r) pmax = fmaxf(pmax, p0[r]);
#pragma unroll
  for (int r = 0; r < 16; ++r) pmax = fmaxf(pmax, p1[r]);
  { auto rr = __builtin_amdgcn_permlane32_swap(__float_as_uint(pmax), __float_as_uint(pmax), false, false);
    pmax = fmaxf(__uint_as_float(rr[0]), __uint_as_float(rr[1])); }
  if (__builtin_expect(__all(pmax - m_reg <= THR / SCALE), 1)) { mn = m_reg; alpha = 1.f; }
  else { mn = fmaxf(m_reg, pmax); alpha = __builtin_amdgcn_exp2f((m_reg - mn) * C); m_reg = mn; }
  float mnC = -mn * C;
#pragma unroll
  for (int r = 0; r < 16; ++r) p0[r] = fmaf(p0[r], C, mnC);
#pragma unroll
  for (int r = 0; r < 16; ++r) p1[r] = fmaf(p1[r], C, mnC);
#pragma unroll
  for (int r = 0; r < 16; ++r) p0[r] = __builtin_amdgcn_exp2f(p0[r]);
}
__device__ __forceinline__ void finishSM(f32x16& p0, f32x16& p1, float alpha, float& l_reg, bf16x8& pa0, bf16x8& pa1, bf16x8& pa2, bf16x8& pa3) {
#pragma unroll
  for (int r = 0; r < 16; ++r) p1[r] = __builtin_amdgcn_exp2f(p1[r]);
  float ps = 0;
#pragma unroll
  for (int r = 0; r < 16; ++r) ps += p0[r];
#pragma unroll
  for (int r = 0; r < 16; ++r) ps += p1[r];
  { auto rr = __builtin_amdgcn_permlane32_swap(__float_as_uint(ps), __float_as_uint(ps), false, false);
    ps = __uint_as_float(rr[0]) + __uint_as_float(rr[1]); }
  l_reg = l_reg * alpha + ps;
#define PK4(P, BASE, OUT) do { unsigned a0 = cvtpk(P[BASE + 0], P[BASE + 1]), a1 = cvtpk(P[BASE + 2], P[BASE + 3]);   \
    unsigned b0 = cvtpk(P[BASE + 4], P[BASE + 5]), b1 = cvtpk(P[BASE + 6], P[BASE + 7]);                              \
    auto r0 = __builtin_amdgcn_permlane32_swap(a0, b0, false, false); auto r1 = __builtin_amdgcn_permlane32_swap(a1, b1, false, false); \
    u32x4 w = {r0[0], r1[0], r0[1], r1[1]}; OUT = *reinterpret_cast<bf16x8*>(&w); } while (0)
  PK4(p0, 0, pa0); PK4(p0, 8, pa1); PK4(p1, 0, pa2); PK4(p1, 8, pa3);
#undef PK4
}
template <int NK16>
__device__ __forceinline__ void qkt(f32x16& p0, f32x16& p1, const char* Ks, const bf16x8* qr, int r32, int hi) {
  p0 = f32x16{}; p1 = f32x16{};
#pragma unroll
  for (int d0 = 0; d0 < NK16; ++d0) { int cb = (d0 * 16 + hi * 8) * 2;
    bf16x8 b0 = *reinterpret_cast<const bf16x8*>(Ks + KSWZ(r32, cb));
    bf16x8 b1 = *reinterpret_cast<const bf16x8*>(Ks + KSWZ(32 + r32, cb));
    p0 = __builtin_amdgcn_mfma_f32_32x32x16_bf16(b0, qr[d0], p0, 0, 0, 0);
    p1 = __builtin_amdgcn_mfma_f32_32x32x16_bf16(b1, qr[d0], p1, 0, 0, 0); }
}
__device__ __forceinline__ int v_st(int k, int c) { const int kk = (k & ~0xC) | ((k & 4) << 1) | ((k & 8) >> 1); return ((kk >> 3) * 4 + (c >> 5)) * 512 + ((kk & 7) * 32 + (c & 31)) * 2; }
__device__ __forceinline__ int v_rd_base(int lane) { return ((lane & 3) << 3) | (((lane >> 2) & 3) << 6) | (((lane >> 4) & 1) << 5) | (((lane >> 5) & 1) << 8); }
constexpr int v_rd_off(int d0, int ks, int half) { return d0 * 512 + ks * 4096 + half * 2048; }
template <int OFF> __device__ __forceinline__ s16x4 tr_read(int vb) {
  s16x4 r; asm volatile("ds_read_b64_tr_b16 %0, %1 offset:%2" : "=&v"(r) : "v"(vb), "i"(OFF) : "memory"); return r;
}
template <int D0> __device__ __forceinline__ void pv_one(f32x16& od, int vb, bf16x8 pa0, bf16x8 pa1, bf16x8 pa2, bf16x8 pa3) {
  const s16x4 l0 = tr_read<v_rd_off(D0, 0, 0)>(vb), h0 = tr_read<v_rd_off(D0, 0, 1)>(vb), l1 = tr_read<v_rd_off(D0, 1, 0)>(vb), h1 = tr_read<v_rd_off(D0, 1, 1)>(vb);
  const s16x4 l2 = tr_read<v_rd_off(D0, 2, 0)>(vb), h2 = tr_read<v_rd_off(D0, 2, 1)>(vb), l3 = tr_read<v_rd_off(D0, 3, 0)>(vb), h3 = tr_read<v_rd_off(D0, 3, 1)>(vb);
  asm volatile("s_waitcnt lgkmcnt(0)" ::: "memory"); SBAR();
#define PK(L, H) (bf16x8){L[0], L[1], L[2], L[3], H[0], H[1], H[2], H[3]}
  od = __builtin_amdgcn_mfma_f32_32x32x16_bf16(pa0, PK(l0, h0), od, 0, 0, 0);
  od = __builtin_amdgcn_mfma_f32_32x32x16_bf16(pa1, PK(l1, h1), od, 0, 0, 0);
  od = __builtin_amdgcn_mfma_f32_32x32x16_bf16(pa2, PK(l2, h2), od, 0, 0, 0);
  od = __builtin_amdgcn_mfma_f32_32x32x16_bf16(pa3, PK(l3, h3), od, 0, 0, 0);
#undef PK
}
__device__ __forceinline__ void pv_d0(f32x16* o, int vb, bf16x8 pa0, bf16x8 pa1, bf16x8 pa2, bf16x8 pa3) {
  pv_one<0>(o[0], vb, pa0, pa1, pa2, pa3); pv_one<1>(o[1], vb, pa0, pa1, pa2, pa3);
}

struct Src { const bf* q; int qstride; const bf* ksrc; int kstride; const bf* vsrc; int vstride; bf* out; float m0, l0; int dq0; };
template <int NK16, int SC1000000, bool MASK>
__device__ __forceinline__ void unit(const Src& sd, const int tid, char* lds, int kbase0, int nt0, int kbase1, int NT) {
  const int wid = tid >> 6, lane = tid & 63, r32 = lane & 31, hi = lane >> 5;
  char* V_lds = lds; char* K_lds = lds + NBUF * SHM_V;
  float* wsl = (float*)(lds + NBUF * SHM_V + NBUF * SHM_K) + wid * 64; float* li_l = wsl; float* al_l = wsl + 32;
  float m_reg = sd.m0, l_reg = sd.l0; f32x16 o[2] = {}; bf16x8 qr[NK16];
  const bf* Qw = sd.q + (size_t)(wid * QBLK + r32) * sd.qstride + hi * 8;
#pragma unroll
  for (int d0 = 0; d0 < NK16; ++d0) qr[d0] = *reinterpret_cast<const bf16x8*>(Qw + d0 * 16);
  const int sr = tid >> 4, sc = (tid & 15) * 8, vst0 = v_st(sr, sc), vst1 = v_st(32 + sr, sc);
  const int vb0 = (int)(uintptr_t)V_lds + v_rd_base(lane);
  const bf* ksrc = sd.ksrc; const int kstride = sd.kstride; const bf* vsrc = sd.vsrc; const int vstride = sd.vstride;
  const int dqw = sd.dq0 + wid * QBLK + r32;
  struct { bf16x8 vs0, vs1, ks0, ks1; } sr_[2];
#define KROW(j) ((j) < nt0 ? kbase0 + (j) * KVBLK : kbase1 + ((j) - nt0) * KVBLK)
#define SLOAD(i, j) do { const int _kr = KROW(j); \
    sr_[i].vs0 = *reinterpret_cast<const bf16x8*>(vsrc + (size_t)(_kr + sr) * vstride); sr_[i].vs1 = *reinterpret_cast<const bf16x8*>(vsrc + (size_t)(_kr + 32 + sr) * vstride); \
    sr_[i].ks0 = *reinterpret_cast<const bf16x8*>(ksrc + (size_t)(_kr + sr) * kstride); sr_[i].ks1 = *reinterpret_cast<const bf16x8*>(ksrc + (size_t)(_kr + 32 + sr) * kstride); } while (0)
#define SWRITE(b, i) do { *(bf16x8*)(V_lds + (b) * SHM_V + vst0) = sr_[i].vs0;          \
    *(bf16x8*)(V_lds + (b) * SHM_V + vst1) = sr_[i].vs1; int kc = sc * 2;               \
    *(bf16x8*)(K_lds + (b) * SHM_K + KSWZ(sr, kc)) = sr_[i].ks0;                       \
    *(bf16x8*)(K_lds + (b) * SHM_K + KSWZ(32 + sr, kc)) = sr_[i].ks1; } while (0)
#define SWAIT() asm volatile("s_waitcnt vmcnt(4)" ::: "memory")
#define MASKT(P0, P1, J) do { if (MASK && (J) < nt0) { const int _d = (J) * KVBLK - dqw; \
    _Pragma("unroll") for (int r = 0; r < 16; ++r) { const int dd = _d + crow(r, hi); if (dd > 128 || dd < -128) P0[r] = -1e30f; if (dd + 32 > 128 || dd + 32 < -128) P1[r] = -1e30f; } } } while (0)
#define RESC(a) do { if (__any((a) < 1.f)) { if (hi == 0) al_l[r32] = (a); asm volatile("s_waitcnt lgkmcnt(0)" ::: "memory"); \
    _Pragma("unroll") for (int d = 0; d < 2; ++d) _Pragma("unroll") for (int r = 0; r < 16; ++r) o[d][r] *= al_l[crow(r, hi)]; } } while (0)
  f32x16 pA0, pA1, pB0, pB1; float mnA, mnB, alA, alB; bf16x8 pa0, pa1, pa2, pa3;
  constexpr int SE = 0, SO = 1;
  __syncthreads();
  SLOAD(SE, 0); asm volatile("s_waitcnt vmcnt(0)" ::: "memory"); SWRITE(0, SE); __syncthreads();
  qkt<NK16>(pA0, pA1, K_lds, qr, r32, hi); MASKT(pA0, pA1, 0); partialSM<SC1000000>(pA0, pA1, m_reg, mnA, alA);
  SLOAD(SO, 1); if (2 < NT) SLOAD(SE, 2);
  SWAIT();
  SWRITE(1, SO); __syncthreads();
  int bc = 1;
  for (int j = 1; j + 1 < NT; j += 2) {
    { const int bp = bc == 0 ? NBUF - 1 : bc - 1, bn = bc == NBUF - 1 ? 0 : bc + 1;
      SBAR(); qkt<NK16>(pB0, pB1, K_lds + bc * SHM_K, qr, r32, hi);
      finishSM(pA0, pA1, alA, l_reg, pa0, pa1, pa2, pa3); SBAR();
      SLOAD(SO, j + 2); SBAR();
      pv_d0(o, vb0 + bp * SHM_V, pa0, pa1, pa2, pa3); MASKT(pB0, pB1, j); partialSM<SC1000000>(pB0, pB1, m_reg, mnB, alB);
      SWAIT(); SWRITE(bn, SE);
      RESC(alB); __syncthreads();
      bc = bn; }
    { const int bp = bc == 0 ? NBUF - 1 : bc - 1, bn = bc == NBUF - 1 ? 0 : bc + 1;
      SBAR(); qkt<NK16>(pA0, pA1, K_lds + bc * SHM_K, qr, r32, hi);
      finishSM(pB0, pB1, alB, l_reg, pa0, pa1, pa2, pa3); SBAR();
      if (j + 3 < NT) SLOAD(SE, j + 3); SBAR();
      pv_d0(o, vb0 + bp * SHM_V, pa0, pa1, pa2, pa3); MASKT(pA0, pA1, j + 1); partialSM<SC1000000>(pA0, pA1, m_reg, mnA, alA);
      SWAIT(); SWRITE(bn, SO);
      RESC(alA); __syncthreads();
      bc = bn; }
  }
  { const int bp = bc == 0 ? NBUF - 1 : bc - 1;
    SBAR(); qkt<NK16>(pB0, pB1, K_lds + bc * SHM_K, qr, r32, hi);
    finishSM(pA0, pA1, alA, l_reg, pa0, pa1, pa2, pa3); SBAR();
    pv_d0(o, vb0 + bp * SHM_V, pa0, pa1, pa2, pa3); MASKT(pB0, pB1, NT - 1); partialSM<SC1000000>(pB0, pB1, m_reg, mnB, alB);
    RESC(alB);
    finishSM(pB0, pB1, alB, l_reg, pa0, pa1, pa2, pa3); SBAR();
    pv_d0(o, vb0 + bc * SHM_V, pa0, pa1, pa2, pa3); }
  asm volatile("s_waitcnt vmcnt(0)" ::: "memory");
  if (hi == 0) li_l[r32] = l_reg; asm volatile("s_waitcnt lgkmcnt(0)" ::: "memory");
  float rli[16];
#pragma unroll
  for (int r = 0; r < 16; ++r) rli[r] = __builtin_amdgcn_rcpf(li_l[crow(r, hi)]);
  bf* Ow = sd.out + (size_t)(wid * QBLK) * 2048;
#pragma unroll
  for (int r = 0; r < 16; ++r) { int orow = crow(r, hi);
#pragma unroll
    for (int d0 = 0; d0 < 2; ++d0) Ow[(size_t)orow * 2048 + d0 * 32 + r32] = f2b(o[d0][r] * rli[r]); }
#undef SLOAD
#undef SWRITE
#undef SWAIT
#undef MASKT
#undef RESC
#undef KROW
}
#undef KSWZ
#undef SBAR
}

DEV void ph_mla(const Params& p, const Ctx& cx, int last) {
  const int nlat_units = NB * 8 * (N / 256);
  const int nctx_units = last ? 0 : NB * 8 * (LC / 256);
  const int sc = (cx.tid & 15) * 8;
  for (int uu = blockIdx.x; uu < nlat_units + 256; uu += gridDim.x) {
    const int u = uu < nlat_units ? uu : nlat_units + ((uu - nlat_units + 256 - 32) & 255);
    if (u >= nlat_units + nctx_units) continue;
    int qrow0, hh, kb0, nt0, kb1, NT;
    if (u < nlat_units) {
      const int rnd = u / 256, within = u % 256, bh = (rnd * 8 + (within & 7)) % (NB * 8); int qb = within >> 3;
      hh = bh % 8; int b = bh / 8; qrow0 = b * N + qb * 256; kb0 = b * N; nt0 = N / 64; kb1 = NLAT + b * LC; NT = (N + LC) / 64; }
    else { int v = u - nlat_units; int qb = v % (LC / 256); hh = (v / (LC / 256)) % 8; int b = v / (8 * (LC / 256)); qrow0 = NLAT + b * LC + qb * 256; kb0 = NLAT + b * LC; nt0 = LC / 64; kb1 = 0; NT = LC / 64; }
    fa::Src sd;
    sd.q = p.QA() + (size_t)qrow0 * 768 + hh * 96; sd.qstride = 768;
    if (sc < 64) { sd.ksrc = p.KVA() + hh * 128 + sc; sd.kstride = 1024; } else { sd.ksrc = p.P() + C_KR + ((sc - 64) & 31); sd.kstride = PC; }
    sd.vsrc = p.KVA() + hh * 128 + 64 + (sc & 63); sd.vstride = 1024;
    sd.out = p.Y() + (size_t)qrow0 * 2048 + hh * 64; sd.m0 = -1e30f; sd.l0 = 0.f; sd.dq0 = 0;
    fa::unit<6, 102062073, false>(sd, cx.tid, cx.ldsg, kb0, nt0, kb1, NT);
  }
}
DEV void ph_gqa(const Params& p, const Ctx& cx, int l, int last) {
  const int nlat_units = NB * 8 * (N / 256);
  const int nctx_units = last ? 0 : NB * 8 * (LC / 256);
  const int sc = (cx.tid & 15) * 8;
  for (int uu = blockIdx.x; uu < nlat_units + 256; uu += gridDim.x) {
    const int u = uu < nlat_units ? uu : nlat_units + ((uu - nlat_units + 256 - 16) & 255);
    if (u >= nlat_units + nctx_units) continue;
    int qrow0, hh, kb0, nt0, kb1, NT, dq0 = 0;
    if (u < nlat_units) {
      const int rnd = u / 256, within = u % 256, bh = (rnd * 8 + (within & 7)) % (NB * 8); int qb = within >> 3;
      hh = bh % 8; int b = bh / 8;
      int q0 = qb * 256; int klo = q0 - 128 < 0 ? 0 : q0 - 128; int khi = q0 + 384 > N ? N : q0 + 384;
      qrow0 = b * N + q0; kb0 = b * N + klo; nt0 = (khi - klo) / 64; kb1 = NLAT + b * LC; NT = nt0 + LC / 64; dq0 = q0 - klo;
    } else { int v = u - nlat_units; int qb = v % (LC / 256); hh = (v / (LC / 256)) % 8; int b = v / (8 * (LC / 256)); qrow0 = NLAT + b * LC + qb * 256; kb0 = NLAT + b * LC; nt0 = 0; kb1 = kb0; NT = LC / 64; }
    const int kh = hh >> 2;
    fa::Src sd;
    sd.q = p.P() + (size_t)qrow0 * PC + C_GQ + hh * 64; sd.qstride = PC;
    sd.ksrc = p.P() + C_GKV + kh * 64 + (sc & 63); sd.kstride = PC;
    sd.vsrc = p.P() + C_GKV + 128 + kh * 64 + (sc & 63); sd.vstride = PC;
    sd.out = p.Y() + (size_t)qrow0 * 2048 + 1536 + hh * 64;
    sd.m0 = p.in[I_gqa_sink][l * 8 + hh] * 8.0f; sd.l0 = 1.0f; sd.dq0 = dq0;
    fa::unit<4, 125000000, true>(sd, cx.tid, cx.ldsg, kb0, nt0, kb1, NT);
  }
}
#endif


namespace hy {
constexpr int NF = 2 * N;
struct f2 { float x, y; };
DEV f2 cmul(f2 a, f2 b) { f2 r; r.x = a.x * b.x - a.y * b.y; r.y = a.x * b.y + a.y * b.x; return r; }
#ifndef CPU_SIM
DEV f2 twid(const f2*, int k) { const float x = (float)k * (1.0f / (float)NF); return f2{__builtin_amdgcn_cosf(x), -__builtin_amdgcn_sinf(x)}; }
#else
DEV f2 twid(const f2* tw, int k) { return tw[k]; }
#endif
DEV f2 cmulc(f2 a, f2 b) { f2 r; r.x = a.x * b.x + a.y * b.y; r.y = a.y * b.x - a.x * b.y; return r; }
DEV void fwd_pass(f2* buf, const f2* tw, int L, int tid, int nthr) {
  const int Q = L >> 2, tws = NF / L;
  for (int u = tid; u < NF / 4; u += nthr) {
    const int g = u / Q, j = u - g * Q, base = g * L + j;
    const f2 x0 = buf[base], x1 = buf[base + Q], x2 = buf[base + 2 * Q], x3 = buf[base + 3 * Q];
    f2 a0{x0.x + x2.x, x0.y + x2.y}, a1{x0.x - x2.x, x0.y - x2.y}, a2{x1.x + x3.x, x1.y + x3.y};
    f2 d{x1.x - x3.x, x1.y - x3.y}; f2 a3{d.y, -d.x};
    f2 y0{a0.x + a2.x, a0.y + a2.y}, y1{a1.x + a3.x, a1.y + a3.y}, y2{a0.x - a2.x, a0.y - a2.y}, y3{a1.x - a3.x, a1.y - a3.y};
    buf[base] = y0; buf[base + Q] = cmul(y1, twid(tw, j * tws)); buf[base + 2 * Q] = cmul(y2, twid(tw, 2 * j * tws)); buf[base + 3 * Q] = cmul(y3, twid(tw, 3 * j * tws));
  }
}
DEV void inv_pass(f2* buf, const f2* tw, int L, int tid, int nthr) {
  const int Q = L >> 2, tws = NF / L;
  for (int u = tid; u < NF / 4; u += nthr) {
    const int g = u / Q, j = u - g * Q, base = g * L + j;
    const f2 u0 = buf[base], u1 = cmulc(buf[base + Q], twid(tw, j * tws)), u2 = cmulc(buf[base + 2 * Q], twid(tw, 2 * j * tws)), u3 = cmulc(buf[base + 3 * Q], twid(tw, 3 * j * tws));
    f2 a0{u0.x + u2.x, u0.y + u2.y}, a1{u0.x - u2.x, u0.y - u2.y}, a2{u1.x + u3.x, u1.y + u3.y};
    f2 d{u1.x - u3.x, u1.y - u3.y}; f2 a3{-d.y, d.x};
    buf[base] = f2{a0.x + a2.x, a0.y + a2.y}; buf[base + Q] = f2{a1.x + a3.x, a1.y + a3.y};
    buf[base + 2 * Q] = f2{a0.x - a2.x, a0.y - a2.y}; buf[base + 3 * Q] = f2{a1.x - a3.x, a1.y - a3.y};
  }
}
DEV void s1_taps(const Params& p, f2* buf, float* red, int c, int tid, int nthr) {
  float ss = 0.f;
#pragma unroll 8
  for (int k = tid; k < NF; k += nthr) {
    float v = 0.f;
    if (k < N) v = p.F()[(size_t)k * 1024 + c];
    else if (k > N) v = p.F()[(size_t)(NF - k) * 1024 + 512 + c];
    buf[k] = f2{v, 0.f}; ss += v * v;
  }
  red[tid] = ss;
}
DEV float red_total(const float* red, int nthr) { float s = 0.f; for (int i = 0; i < nthr; ++i) s += red[i]; return s; }
DEV void s3_store(const f2* buf, unsigned* hs, int tid, int nthr) {
  for (int k = tid; k < NF; k += nthr) hs[k] = (unsigned)f2b(buf[k].x).v | ((unsigned)f2b(buf[k].y).v << 16);
}
DEV void s4_loadz(const Params& p, f2* buf, int c, int tid, int nthr) {
#pragma unroll 8
  for (int t = tid; t < NF; t += nthr) {
    f2 v{0.f, 0.f};
    if (t < N) { v.x = b2f(p.Z()[(size_t)t * 512 + c]); v.y = b2f(p.Z()[(size_t)(N + t) * 512 + c]); }
    buf[t] = v;
  }
}
DEV void s6_mul(f2* buf, const unsigned* hs, int tid, int nthr) {
  for (int k = tid; k < NF; k += nthr) {
    union { unsigned u; float f; } a, b; const unsigned w = hs[k]; a.u = w << 16; b.u = w & 0xFFFF0000u;
    buf[k] = cmul(buf[k], f2{a.f, b.f});
  }
}
DEV void s8_out(const Params& p, const f2* buf, const float* red, int l, int c, int tid, int nthr) {
  const float fn = 1.0f / sqrtf(red_total(red, nthr) + EPS) * (1.0f / (float)NF);
  const float* cw = p.in[I_hy_conv_w] + l * 3 * 1536; const float cb = p.in[I_hy_conv_b][l * 1536 + c];
  const float w0 = cw[c], w1 = cw[1536 + c], w2 = cw[2 * 1536 + c];
  const float skip = p.in[I_hy_skip][l * 512 + c];
#pragma unroll 4
  for (int i = tid; i < 2 * N; i += nthr) {
    const int b = i / N, t = i - b * N;
    const size_t r = (size_t)b * N + t;
    const float conv = (b ? buf[t].y : buf[t].x) * fn;
    float x0 = cb + w1 * b2f(p.P()[r * PC + C_HU + c]);
    if (t > 0) x0 += w0 * b2f(p.P()[(r - 1) * PC + C_HU + c]);
    if (t < N - 1) x0 += w2 * b2f(p.P()[(r + 1) * PC + C_HU + c]);
    const float y = conv + skip * b2f(p.Z()[r * 512 + c]);
    p.Y()[r * 2048 + 1024 + c] = f2b(x0 * y);
  }
}
#ifndef CPU_SIM
DEV void channel(const Params& p, int l, int c, int tid, f2* buf, float* red, unsigned* hs) {
  const f2* tw = (const f2*)p.tw();
#ifndef HY_EXP
#define HY_EXP 0
#endif
  __syncthreads();
  if (HY_EXP != 2) s1_taps(p, buf, red, c, tid, 512); __syncthreads();
  if (HY_EXP != 1) for (int L = NF; L >= 4; L >>= 2) { fwd_pass(buf, tw, L, tid, 512); __syncthreads(); }
  s3_store(buf, hs, tid, 512); __syncthreads();
  if (HY_EXP != 2) s4_loadz(p, buf, c, tid, 512); __syncthreads();
  if (HY_EXP != 1) for (int L = NF; L >= 4; L >>= 2) { fwd_pass(buf, tw, L, tid, 512); __syncthreads(); }
  s6_mul(buf, hs, tid, 512); __syncthreads();
  if (HY_EXP != 1) for (int L = 4; L <= NF; L <<= 2) { inv_pass(buf, tw, L, tid, 512); __syncthreads(); }
  if (HY_EXP != 2) s8_out(p, buf, red, l, c, tid, 512);
}
#endif
}


namespace tz {
constexpr int NBLK = N / 64;
constexpr int PADB = 31;
constexpr int ZLEN = (NBLK + 2 * PADB) * 64;
constexpr int HLEN = 2 * N + 16;
DEV int a_index(int m, int r, int h) { return N - m - r + 8 * h; }
DEV int b_index(int t1, int Dd, int ks, int h) { return 64 * (t1 - Dd + PADB) + 16 * ks + 8 * h; }
#ifndef CPU_SIM
using bf16x8 = __attribute__((ext_vector_type(8))) short;
using f32x16 = __attribute__((ext_vector_type(16))) float;
using u32x4 = __attribute__((ext_vector_type(4))) unsigned;
DEV bf16x8 load_afrag(const unsigned short* Hr, int e) {
  const unsigned* wp = (const unsigned*)(Hr + (e & ~1));
  const unsigned w0 = wp[0], w1 = wp[1], w2 = wp[2], w3 = wp[3], w4 = wp[4];
  const unsigned sh = (unsigned)(e & 1) << 4;
  u32x4 o;
  o.x = __builtin_amdgcn_alignbit(w1, w0, sh); o.y = __builtin_amdgcn_alignbit(w2, w1, sh); o.z = __builtin_amdgcn_alignbit(w3, w2, sh); o.w = __builtin_amdgcn_alignbit(w4, w3, sh);
  return *reinterpret_cast<bf16x8*>(&o);
}
DEV void channel(const Params& p, int l, int c, int tid, char* lds) {
  unsigned short* zp = (unsigned short*)lds;
  float* red = (float*)(zp + 2 * ZLEN);
  unsigned short* Hr = (unsigned short*)(red + 512);
  float* cv = (float*)Hr;
  const int lane = tid & 63, w = tid >> 6, r = lane & 31, h = lane >> 5;
  __syncthreads();
  float ss = 0.f;
  const float* ff = p.F() + (size_t)c * (N + LC); const float* fb = p.F() + (size_t)(512 + c) * (N + LC);
#pragma unroll 4
  for (int t = tid * 4; t < N; t += 2048) {
    const float4 a = *(const float4*)(ff + t), b = *(const float4*)(fb + t);
    ss += a.x * a.x + a.y * a.y + a.z * a.z + a.w * a.w + b.x * b.x + b.y * b.y + b.z * b.z + b.w * b.w;
    Hr[N - t] = f2b(a.x).v; Hr[N - t - 1] = f2b(a.y).v; Hr[N - t - 2] = f2b(a.z).v; Hr[N - t - 3] = f2b(a.w).v;
    if (t > 0) Hr[N + t] = f2b(b.x).v;
    Hr[N + t + 1] = f2b(b.y).v; Hr[N + t + 2] = f2b(b.z).v; Hr[N + t + 3] = f2b(b.w).v;
  }
  if (tid == 0) Hr[0] = 0;
  if (tid < 16) Hr[2 * N + tid] = 0;
  red[tid] = ss;
  for (int i = tid; i < 2 * PADB * 64; i += 512) {
    const int side = i / (PADB * 64), k = i % (PADB * 64);
    const int off = side ? (PADB + NBLK) * 64 + k : k;
    zp[off] = 0; zp[ZLEN + off] = 0;
  }
  { const unsigned short* zt = (const unsigned short*)p.Z() + (size_t)c * NB * N;
#pragma unroll 4
    for (int i = tid * 8; i < 2 * N; i += 4096) { const int b = i / N, t = i - b * N; *(uint4*)(zp + b * ZLEN + PADB * 64 + t) = *(const uint4*)(zt + i); } }
  __syncthreads();
  float tot = 0.f;
  for (int i = 0; i < 512; ++i) tot += red[i];
  const float fn = 1.0f / sqrtf(tot + EPS);
  const int t1 = 32 * (w & 3) + r;
  const unsigned short* zb = zp + (w >> 2) * ZLEN;
  f32x16 acc0 = {}, acc1 = {};
  const int Dlo = 32 * (w & 3) - (NBLK - 1), Dhi = 32 * (w & 3) + 31;
#define TZ_LOAD(AF, BF, PA, PB) do { _Pragma("unroll") for (int ks = 0; ks < 4; ++ks) BF[ks] = *reinterpret_cast<const bf16x8*>((PB) + 16 * ks); \
    _Pragma("unroll") for (int q = 0; q < 6; ++q) { const unsigned* wq_ = (PA) + 8 * (5 - q); const unsigned w0_ = wq_[0], w1_ = wq_[1], w2_ = wq_[2], w3_ = wq_[3], w4_ = wq_[4]; u32x4 o_; \
      o_.x = __builtin_amdgcn_alignbit(w1_, w0_, shA); o_.y = __builtin_amdgcn_alignbit(w2_, w1_, shA); o_.z = __builtin_amdgcn_alignbit(w3_, w2_, shA); o_.w = __builtin_amdgcn_alignbit(w4_, w3_, shA); \
      AF[q] = *reinterpret_cast<bf16x8*>(&o_); } } while (0)
#define TZ_MMA(AF, BF) do { _Pragma("unroll") for (int ks = 0; ks < 4; ++ks) { \
    acc0 = __builtin_amdgcn_mfma_f32_32x32x16_bf16(AF[3 - ks], BF[ks], acc0, 0, 0, 0); acc1 = __builtin_amdgcn_mfma_f32_32x32x16_bf16(AF[5 - ks], BF[ks], acc1, 0, 0, 0); } } while (0)
  const unsigned shA = (unsigned)(r & 1) << 4;
  const unsigned* pa = (const unsigned*)Hr + ((a_index(64 * Dlo - 48 + 80, r, h) & ~1) >> 1);
  const unsigned short* pb = zb + b_index(t1, Dlo, 0, h);
#define TZ_LOAD4(AF, BF, PREV, PA, PB) do { _Pragma("unroll") for (int ks = 0; ks < 4; ++ks) BF[ks] = *reinterpret_cast<const bf16x8*>((PB) + 16 * ks); \
    AF[0] = PREV[4]; AF[1] = PREV[5]; \
    _Pragma("unroll") for (int q = 2; q < 6; ++q) { const unsigned* wq_ = (PA) + 8 * (5 - q); const unsigned w0_ = wq_[0], w1_ = wq_[1], w2_ = wq_[2], w3_ = wq_[3], w4_ = wq_[4]; u32x4 o_; \
      o_.x = __builtin_amdgcn_alignbit(w1_, w0_, shA); o_.y = __builtin_amdgcn_alignbit(w2_, w1_, shA); o_.z = __builtin_amdgcn_alignbit(w3_, w2_, shA); o_.w = __builtin_amdgcn_alignbit(w4_, w3_, shA); \
      AF[q] = *reinterpret_cast<bf16x8*>(&o_); } } while (0)
  bf16x8 afA[6], bfA[4], afB[6], bfB[4];
  TZ_LOAD(afA, bfA, pa, pb);
#pragma unroll 1
  for (int Dd = Dlo; Dd + 2 <= Dhi; Dd += 2) {
    TZ_LOAD4(afB, bfB, afA, pa - 32, pb - 64);
    TZ_MMA(afA, bfA);
    pa -= 64; pb -= 128;
    TZ_LOAD4(afA, bfA, afB, pa, pb);
    TZ_MMA(afB, bfB);
  }
  TZ_MMA(afA, bfA);
#undef TZ_LOAD4
#undef TZ_LOAD
#undef TZ_MMA
  static_assert((NBLK + 31) % 2 == 1, "K-loop pairing assumes an odd number of steps");
  __syncthreads();
  { int t1e = t1, he = h;
    asm volatile("" : "+v"(t1e), "+v"(he));
    float* cvb = cv + (w >> 2) * N + 64 * t1e + 4 * he;
#pragma unroll
    for (int g = 0; g < 4; ++g) {
      *(float4*)(cvb + 8 * g) = float4{acc0[4 * g], acc0[4 * g + 1], acc0[4 * g + 2], acc0[4 * g + 3]};
      *(float4*)(cvb + 32 + 8 * g) = float4{acc1[4 * g], acc1[4 * g + 1], acc1[4 * g + 2], acc1[4 * g + 3]};
    } }
  __syncthreads();
  { const float skip = p.in[I_hy_skip][l * 512 + c];
    unsigned short* xy = (unsigned short*)p.XYT() + (size_t)c * NB * N;
#pragma unroll 4
    for (int i = tid * 8; i < 2 * N; i += 4096) {
      const int b = i / N, t = i - b * N;
      float x0[8]; unpack8(*(const uint4*)(xy + i), x0);
      float zf[8]; unpack8(*(const uint4*)(zp + b * ZLEN + PADB * 64 + t), zf);
      const float4 ca = *(const float4*)(cv + i), cb4 = *(const float4*)(cv + i + 4);
      float o[8];
      o[0] = x0[0] * (ca.x * fn + skip * zf[0]); o[1] = x0[1] * (ca.y * fn + skip * zf[1]); o[2] = x0[2] * (ca.z * fn + skip * zf[2]); o[3] = x0[3] * (ca.w * fn + skip * zf[3]);
      o[4] = x0[4] * (cb4.x * fn + skip * zf[4]); o[5] = x0[5] * (cb4.y * fn + skip * zf[5]); o[6] = x0[6] * (cb4.z * fn + skip * zf[6]); o[7] = x0[7] * (cb4.w * fn + skip * zf[7]);
      store8bf(p.YT() + (size_t)c * NB * N + i, o);
    } }
}
DEV void xyt_to_y(const Params& p, int tid, char* lds) {
  unsigned short* tl = (unsigned short*)lds;
  for (int tile = blockIdx.x; tile < (NLAT / 64) * 8; tile += gridDim.x) {
    const int rt = tile >> 3, c0 = (tile & 7) * 64;
    const int bq = (rt * 64) / N, tq = (rt * 64) % N;
    __syncthreads();
    { const int cc = tid >> 3, tg = (tid & 7) * 8;
      const uint4 v = *(const uint4*)((const unsigned short*)p.YT() + ((size_t)(c0 + cc) * NB + bq) * N + tq + tg);
      const unsigned short* e = (const unsigned short*)&v;
#pragma unroll
      for (int j = 0; j < 8; ++j) tl[(tg + j) * 72 + cc] = e[j]; }
    __syncthreads();
    { const int tr = tid >> 3, cg8 = (tid & 7) * 8;
      *(uint4*)((unsigned short*)p.Y() + (size_t)(rt * 64 + tr) * 2048 + 1024 + c0 + cg8) = *(const uint4*)(tl + tr * 72 + cg8); }
  }
}
#endif
}

#ifndef CPU_SIM
DEV void ph_hyena_fft(const Params& p, const Ctx& cx, int l) {
  const int nb = gridDim.x;
  for (int i = blockIdx.x; i < 512; i += nb) {
    const int xcd = i & 7, idx = i >> 3;
    const int c = xcd * 64 + idx;
    tz::channel(p, l, c, cx.tid, cx.ldsg);
  }
}
#endif


#ifndef CPU_SIM
DEV void ph_hyena_ctx(const Params& p, const Ctx& cx, int l) {
  constexpr int LP = 33;
  float* Zs = (float*)cx.ldsg; float* Ff = Zs + LC * LP; float* Fb = Ff + LC * LP;
  const int tid = cx.tid, c = tid & 31, t0 = tid >> 5;
  const float* cw = p.in[I_hy_conv_w] + l * 3 * 1536; const float* cbv = p.in[I_hy_conv_b] + l * 1536;
  constexpr int TP = 8, TLEN = LC / TP;
  for (int task = blockIdx.x; task < NB * 16 * TP; task += gridDim.x) {
    const int tp = task % TP, cgp = (task / TP) & 15, b = task / (TP * 16), c0 = cgp * 32;
    const int rbase = NLAT + b * LC;
    __syncthreads();
    for (int idx = tid; idx < LC * 32; idx += 512) {
      { const int t = idx >> 5, cc = idx & 31; Zs[t * LP + cc] = b2f(p.Z()[(size_t)(rbase + t) * 512 + c0 + cc]); }
      { const int cc = idx / LC, t = idx % LC;
        Ff[t * LP + cc] = p.F()[(size_t)(c0 + cc) * (N + LC) + N + t]; Fb[t * LP + cc] = p.F()[(size_t)(512 + c0 + cc) * (N + LC) + N + t]; }
    }
    __syncthreads();
    float ss = 0.f;
    for (int t = 0; t < LC; ++t) { const float a = Ff[t * LP + c], bb = Fb[t * LP + c]; ss += a * a + bb * bb; }
    const float fn = 1.0f / sqrtf(ss + EPS);
    const int cg_ = c0 + c;
    const float w0 = cw[cg_], w1 = cw[1536 + cg_], w2 = cw[2 * 1536 + cg_], cb0 = cbv[cg_], skip = p.in[I_hy_skip][l * 512 + cg_];
    for (int t = tp * TLEN + t0; t < (tp + 1) * TLEN; t += 16) {
      float acc = 0.f;
      for (int s_ = 0; s_ <= t; ++s_) acc += Ff[(t - s_) * LP + c] * Zs[s_ * LP + c];
      for (int s_ = t + 1; s_ < LC; ++s_) acc += Fb[(s_ - t) * LP + c] * Zs[s_ * LP + c];
      const size_t r = (size_t)(rbase + t);
      float x0 = cb0 + w1 * b2f(p.P()[r * PC + C_HU + cg_]);
      if (t > 0) x0 += w0 * b2f(p.P()[(r - 1) * PC + C_HU + cg_]);
      if (t < LC - 1) x0 += w2 * b2f(p.P()[(r + 1) * PC + C_HU + cg_]);
      p.Y()[r * 2048 + 1024 + cg_] = f2b(x0 * (acc * fn + skip * Zs[t * LP + c]));
    }
  }
}
#endif

constexpr int NOSH = 30;

#ifndef CPU_SIM
#define SIDE_PREP(NB0, PARTS) do { if (l == 0 && (int)blockIdx.x >= (NB0)) { PrepCtx pc; pc.tid = cx.tid; pc.tl = (float*)cx.ldsg; pc.rank = (int)blockIdx.x - (NB0); pc.nranks = (int)gridDim.x - (NB0); \
    ph_prep(p, 1, pc, gtid - (NB0) * 512, gsz - (NB0) * 512, (PARTS)); } } while (0)
#else
#define SIDE_PREP(NB0, PARTS)
#endif
DEV void run_phase(const Params& p, int ph, const Ctx& cx) {
  const i64 gtid = cx.gtid, gsz = cx.gsz;
  if (ph == 0) { ph_init(p, gtid, gsz); return; }
  if (ph == NPHASES - 1) { ph_final(p, gtid, gsz); return; }
  const int l = (ph - 1) / PH_PER_LAYER, s = (ph - 1) % PH_PER_LAYER;
  const int last = (l == 1);
  const int nr = last ? NLAT : TT;
#ifdef ONLY
  if (s != ONLY) return;
#endif
  switch (s) {
    case 0: {
      PrepCtx pc;
#ifndef CPU_SIM
      pc.tid = cx.tid; pc.tl = (float*)cx.ldsg; pc.rank = (int)blockIdx.x; pc.nranks = (int)gridDim.x;
      if (l == 0) ph_prep(p, l, pc, gtid, gsz, 15); else ph_prep(p, l, pc, gtid, gsz, 8);
#else
      pc.gtid = gtid; pc.gsz = gsz;
      ph_prep(p, l, pc, gtid, gsz, 15);
#endif
      ph_norm(p, l, 0, TT, gtid, gsz);
    } break;
    case 1: { GemmDesc g{p.h(), p.W_in(), D, D, D, TT, 3840, NOSH, 0}; EpiInproj e{p}; run_gemm(cx, g, e); } break;
#ifndef CPU_SIM
    case 2: ph_B0(p, l, gtid, gsz, cx.ldsg, cx.tid); break;
#else
    case 2: ph_B0(p, l, gtid, gsz); break;
#endif
    case 3: {
      { const int n_uq = (nr / 256) * 3, n_ukv = (TT / 256) * 4, n_lru = (TT / 256) * 8;
        { GemmDesc g{p.P() + C_CQ, p.W_uq(), PC, 256, 256, nr, 768, NOSH, 0}; EpiUq e{p}; run_gemm(cx, g, e); }
        { GemmDesc g{p.P() + C_CKV, p.W_ukv(), PC, 256, 256, TT, 1024, NOSH, 0}; g.unit_off = n_uq; EpiUkv e{p}; run_gemm(cx, g, e); }
        { GemmDesc g{p.XC(), p.W_lru(), 512, 256, 256, TT, 2048, 2, 256}; g.unit_off = n_uq + n_ukv; EpiLru e{p, l, p.in[I_lru_b_r], p.in[I_lru_b_i]}; run_gemm(cx, g, e); }
#ifndef CPU_SIM
        { GemmDesc g{p.W3T(), p.hdn2b() + (size_t)l * (N + LC) * 256, 256, 256, 256, 1024, N + LC, NOSH, 0}; g.unit_off = n_uq + n_ukv + n_lru; EpiFilt e{p}; run_gemm(cx, g, e); }
#endif
      }
#ifdef CPU_SIM
      ph_fnorm(p, gtid, gsz);
#endif
    } break;
    case 4:
      ph_lru1(p, gtid, gsz);
#ifndef CPU_SIM
#if PROBE_K >= 0
#define SUBSTAMP(k) do { cg::this_grid().sync(); if (l == 0) { const unsigned long long t_ = wall_clock64(); if (blockIdx.x == 0 && cx.tid == 0) ((unsigned long long*)(p.ws + WL.ts))[40 + (k)] = t_; } } while (0)
#else
#define SUBSTAMP(k)
#endif
      if (REPEAT_S == 40) ph_lru1(p, gtid, gsz);
      SUBSTAMP(0);
      ph_hyena_fft(p, cx, l);
      if (REPEAT_S == 41) ph_hyena_fft(p, cx, l);
      SUBSTAMP(1);
      ph_gqa(p, cx, l, last);
      if (REPEAT_S == 42) ph_gqa(p, cx, l, last);
      SUBSTAMP(2);
      ph_mla(p, cx, last);
      if (REPEAT_S == 43) ph_mla(p, cx, last);
      SUBSTAMP(3);
      if (!last) ph_hyena_ctx(p, cx, l);
      if (REPEAT_S == 44 && !last) ph_hyena_ctx(p, cx, l);
#else
      ph_C(p, l, last, gtid, gsz);
#endif
      break;
#ifndef CPU_SIM
    case 5: ph_lru3(p, last, gtid, gsz, (float*)cx.ldsg, cx.tid); __syncthreads(); tz::xyt_to_y(p, cx.tid, cx.ldsg); break;
#else
    case 5: ph_lru3(p, last, gtid, gsz, nullptr, 0); break;
#endif
    case 6: { GemmDesc g{p.h(), p.W_g(), D, D, D, nr, 4096, NOSH, 0}; EpiGateAll e{p}; run_gemm(cx, g, e); } break;
    case 7: { GemmDesc g{p.Y(), p.W_br(), 2048, 512, 512, nr, 1024, NOSH, 0, 4, 512, 1024 * 512}; EpiBranchSub e{p}; run_gemm(cx, g, e); }
      SIDE_PREP(8, 1);
      break;
    case 8: { GemmDesc g{p.M(), p.W_out(), D, D, D, nr, 1024, NOSH, 0}; EpiOut e{p, l, 1.0f, l == 0 ? p.in[I_x] : (const float*)p.xcur(), l == 0 ? p.in[I_ctx] : (const float*)p.xcur() + (size_t)NLAT * D}; run_gemm(cx, g, e); }
#ifndef CPU_SIM
      if (l == 0 && blockIdx.x >= 8) ph_cvt_tables(p, l, gtid - 8 * 512, gsz - 8 * 512);
#endif
      break;
    case 9:
#ifndef CPU_SIM
      if (l != 0) ph_cvt_tables(p, l, gtid, gsz);
#endif
      ph_norm(p, l, 1, nr, gtid, gsz); break;
    case 10: { GemmDesc g{p.h(), p.W_q(), D, D, D, nr, 1024, NOSH, 0}; EpiPQ e{p}; run_gemm(cx, g, e); }
      SIDE_PREP(8, 2);
      break;
    case 11: { GemmDesc g{p.PQ(), p.W_key(), 1024, 256, 256, nr, 2048, 1, 256}; EpiSC e{p}; run_gemm(cx, g, e); }
      SIDE_PREP(16, 4);
      break;
#ifndef CPU_SIM
    case 12: ph_peer(p, l, nr, cx.tid, cx.ldsg); if (REPEAT_S == 52) { __syncthreads(); ph_peer(p, l, nr, cx.tid, cx.ldsg, 0.0f); } break;
#else
    case 12: ph_E2a(p, nr, gtid, gsz); break;
    case 13: ph_E2b(p, nr, gtid, gsz); break;
    case 14: ph_E3(p, l, nr, gtid, gsz); break;
    case 15: ph_E4(p, l, nr, gtid, gsz); break;
#endif
  }
}

#ifdef CPU_SIM
static void fill_params(Params& p, void* const* d_in, void* d_out, void* d_ws) {
  p.in.t = (const float* const*)d_in;
  p.out = (float*)d_out;
  p.ws = (char*)d_ws;
}
#endif


#ifndef CPU_SIM
#define XB_TMO      128
#define XB_XCNT(j)  (256  + 64 * (j))
#define XB_XSUB(j)  (1280 + 64 * (j))
#define XB_XGEN(j)  (2304 + 64 * (j))
#define XB_TOP      3328
#define XB_TOPGEN   3392
#define XCD_BAR_WORDS 3456
#define XB_SPIN_CAP (1u << 18)
#define XB_LAS __attribute__((address_space(3)))
__device__ __forceinline__ unsigned xb_ld(unsigned* p)              { return __hip_atomic_load(p, __ATOMIC_RELAXED, __HIP_MEMORY_SCOPE_AGENT); }
__device__ __forceinline__ unsigned xb_add(unsigned* p, unsigned v) { return __hip_atomic_fetch_add(p, v, __ATOMIC_RELAXED, __HIP_MEMORY_SCOPE_AGENT); }
__device__ __forceinline__ unsigned xb_xcc_id() { return (unsigned)__builtin_amdgcn_s_getreg((3 << 11) | 20) & 0xFu; }
#define XB_SPIN(cond, bar) do { unsigned _sp = 0; while (cond) { __builtin_amdgcn_s_sleep(1); \
    if ((++_sp & 255u) == 0u) { if (xb_ld(&(bar)[XB_TMO])) break; if (_sp > XB_SPIN_CAP) { atomicAdd(&(bar)[XB_TMO], 1u); break; } } } } while (0)
struct XcdBarrier { unsigned* bar; unsigned x; volatile XB_LAS unsigned* st; };
__device__ __forceinline__ XcdBarrier xcd_barrier_post(unsigned* bar, volatile XB_LAS unsigned* st) {
  XcdBarrier b; b.bar = bar; b.x = xb_xcc_id(); b.st = st;
  if (threadIdx.x == 0) (void)xb_add(&bar[XB_XCNT(b.x)], 1u);
  return b;
}
__device__ __forceinline__ void xcd_barrier_complete(unsigned* bar, unsigned x, unsigned& nloc, unsigned& nx) {
  const unsigned G = gridDim.x * gridDim.y * gridDim.z;
  unsigned sum, cnt, mine, sp = 0u;
  for (;;) {
    sum = 0u; cnt = 0u; mine = 0u;
#pragma unroll
    for (unsigned j = 0; j < 16; ++j) { const unsigned c = xb_ld(&bar[XB_XCNT(j)]); sum += c; cnt += (c > 0u) ? 1u : 0u; mine = (j == x) ? c : mine; }
    if (sum == G) break;
    __builtin_amdgcn_s_sleep(1);
    if ((++sp & 255u) == 0u) { if (xb_ld(&bar[XB_TMO])) break; if (sp > XB_SPIN_CAP) { atomicAdd(&bar[XB_TMO], 1u); break; } }
  }
  nloc = mine > 0u ? mine : 1u; nx = cnt > 0u ? cnt : 1u;
}
__device__ __forceinline__ void xcd_barrier(const XcdBarrier& b) {
  asm volatile("s_waitcnt vmcnt(0)" ::: "memory");
  __syncthreads();
  if (threadIdx.x == 0) {
    unsigned* bar = b.bar;
    __builtin_amdgcn_s_waitcnt(0);
    unsigned nloc = b.st[0], nx = b.st[1];
    if (nloc == 0u) { xcd_barrier_complete(bar, b.x, nloc, nx); b.st[0] = nloc; b.st[1] = nx; }
    const unsigned old = xb_add(&bar[XB_XSUB(b.x)], 1u);
    const unsigned gen = old / nloc;
    if (old + 1u == (gen + 1u) * nloc) {
      __builtin_amdgcn_fence(__ATOMIC_RELEASE, "agent");
      asm volatile("s_waitcnt vmcnt(0)" ::: "memory");
      const unsigned og = xb_add(&bar[XB_TOP], 1u);
      const unsigned tg = og / nx;
      if (og + 1u == (tg + 1u) * nx) xb_add(&bar[XB_TOPGEN], 1u);
      else XB_SPIN(xb_ld(&bar[XB_TOPGEN]) == tg, bar);
      __builtin_amdgcn_fence(__ATOMIC_ACQUIRE, "agent");
      xb_add(&bar[XB_XGEN(b.x)], 1u);
      asm volatile("s_waitcnt vmcnt(0)" ::: "memory");
    } else {
      XB_SPIN(xb_ld(&bar[XB_XGEN(b.x)]) == gen, bar);
      __builtin_amdgcn_fence(__ATOMIC_ACQUIRE, "agent");
      asm volatile("s_waitcnt vmcnt(0)" ::: "memory");
    }
  }
  __syncthreads();
}
#endif

#ifndef CPU_SIM
static_assert(TT % 256 == 0 && NLAT % 256 == 0 && (N + LC) % 256 == 0, "row / column tiles");
static_assert(N / 256 == 32 && NB * 8 * (N / 256) == 512, "attention unit mapping assumes 32 q-blocks per (batch, head) and a 256-block grid");
constexpr int LDS_PHASE_BYTES = 131072 + 4096;
constexpr int LDS_BYTES = LDS_PHASE_BYTES + 16;
__global__ void __launch_bounds__(512, 2) mega_kernel(KArgs ka) {
  extern __shared__ __attribute__((aligned(16))) unsigned char shm[];
  cg::grid_group grid = cg::this_grid();
#if PROBE_K >= 0
  unsigned long long* const tsp = (unsigned long long*)(ka.ws + WL.ts);
#endif
  {
    int tid = threadIdx.x;
    asm volatile("" : "+v"(tid));
    const i64 gtid = (i64)blockIdx.x * 512 + tid, gsz = (i64)gridDim.x * 512;
    ph_init(ka, gtid, gsz, (char*)shm, tid);
    if (gtid < N_IN) ((const float**)(ka.ws + WL.tbl))[gtid] = ka.in[gtid];
#if PROBE_K >= 0
    { const unsigned long long t_ = wall_clock64(); if (gtid == 0) tsp[0] = t_; }
#endif
  }
  volatile XB_LAS unsigned* xst = (volatile XB_LAS unsigned*)(shm + LDS_PHASE_BYTES);
  if (threadIdx.x == 0) { xst[0] = 0u; xst[1] = 0u; }
  __syncthreads();
  const XcdBarrier xb = xcd_barrier_post((unsigned*)(ka.ws + WL.bar), xst);
  grid.sync();
#if PROBE_K >= 0
  { const unsigned long long t_ = wall_clock64(); if (blockIdx.x == 0 && threadIdx.x == 0) tsp[1] = t_; }
#endif
  Params p; p.out = ka.out; p.ws = ka.ws; p.in.t = (const float* const*)(ka.ws + WL.tbl);
  for (int ph = 1; ph < NPHASES - 1; ++ph) {
    int tid = threadIdx.x;
    asm volatile("" : "+v"(tid));
    Ctx cx;
    cx.tid = tid;
    cx.gtid = (i64)blockIdx.x * 512 + tid; cx.gsz = (i64)gridDim.x * 512;
    cx.lds = (PG8_LAS unsigned char*)shm; cx.ldsg = (char*)shm;
    run_phase(p, ph, cx);
    if (REPEAT_S >= 0 && REPEAT_S < 40 && (ph - 1) % PH_PER_LAYER == REPEAT_S) { __syncthreads(); run_phase(p, ph, cx); }
    xcd_barrier(xb);
#if PROBE_K >= 0
    { const unsigned long long t_ = wall_clock64(); if (blockIdx.x == 0 && threadIdx.x == 0) tsp[ph + 1] = t_; }
    if (ph == NPHASES - 2) grid.sync();
#endif
  }
  {
    int tid = threadIdx.x;
    asm volatile("" : "+v"(tid));
    ph_final(p, (i64)blockIdx.x * 512 + tid, (i64)gridDim.x * 512);
  }
}

extern "C" void kernel_launch(void* const* d_in, const int* in_sizes, int n_in, void* d_out, int out_size,
                              void* d_ws, size_t ws_size, hipStream_t stream) {
  static int grid_blocks = 0;
  if (!grid_blocks) {
    int dev = 0, cus = 0, per_cu = 0;
    (void)hipGetDevice(&dev);
    (void)hipDeviceGetAttribute(&cus, hipDeviceAttributeMultiprocessorCount, dev);
    if (hipFuncSetAttribute((const void*)mega_kernel, hipFuncAttributeMaxDynamicSharedMemorySize, LDS_BYTES) != hipSuccess)
      fprintf(stderr, "hipFuncSetAttribute failed\n");
    (void)hipOccupancyMaxActiveBlocksPerMultiprocessor(&per_cu, mega_kernel, 512, LDS_BYTES);
    if (per_cu > 1) per_cu = 1;
    if (per_cu < 1) per_cu = 1;
    grid_blocks = cus * per_cu;
  }
  (void)hipMemsetAsync((char*)d_ws + WL.bar, 0, (size_t)3456 * 4, stream);
  KArgs ka;
  std::memset((void*)&ka, 0, sizeof(ka));
  for (int i = 0; i < N_IN; ++i) ka.in[i] = (const float*)d_in[i];
  ka.out = (float*)d_out; ka.ws = (char*)d_ws;
  void* args[] = {&ka};
  hipError_t e = hipLaunchCooperativeKernel((void*)mega_kernel, dim3(grid_blocks), dim3(512), args, LDS_BYTES, stream);
  if (e != hipSuccess) fprintf(stderr, "cooperative launch failed: %s (grid %d)\n", hipGetErrorString(e), grid_blocks);
}
#endif
```

```cpp
#ifndef CPU_SIM
#include <hip/hip_runtime.h>
#include <hip/hip_cooperative_groups.h>
#include <cstdio>
#include <cstring>
namespace cg = cooperative_groups;
#define DEV __device__ __forceinline__
#define DEVN __device__ __forceinline__
#define MDEV __device__ __forceinline__
typedef _Float16 sc_t;
#else
#include <cmath>
#include <cstdio>
#include <cstdint>
#include <cstring>
#define DEV static inline
#define DEVN static
#define MDEV inline
typedef float sc_t;
#endif

#ifndef REPEAT_S
#define REPEAT_S -1
#endif
#ifndef PROBE_K
#define PROBE_K -1
#endif
#ifndef SEQ_N
#define SEQ_N 8192
#endif
#ifndef CTX_L
#define CTX_L 256
#endif

typedef long long i64;

constexpr int D = 1024, NB = 2, N = SEQ_N, LC = CTX_L;
constexpr int NLAT = NB * N, NCTX = NB * LC, TT = NLAT + NCTX;
constexpr int GRIDW = 64;
constexpr int INC = 7840, PC = 3840;
constexpr int C_CQ = 0, C_CKV = 256, C_KR = 384, C_LX = 416, C_LG = 928, C_HU = 1440, C_GQ = 2976, C_GKV = 3488, C_GT = 3744;
constexpr int NEXP = 16384;
constexpr float EPS = 1e-6f;
#ifndef CPU_SIM
constexpr int PH_PER_LAYER = 13;
#else
constexpr int PH_PER_LAYER = 16;
#endif
constexpr int NPHASES = 2 + 2 * PH_PER_LAYER;
constexpr int LCH = 64, NCC = LC / LCH, NCL = N / LCH, NCHK = NCC + NCL;

enum { I_x, I_c, I_ctx, I_c_ctx, I_g_mix, I_g_ffn, I_w_mod, I_b_mod, I_w_in, I_mla_g_cq, I_mla_g_ckv, I_mla_w_uq,
       I_mla_w_ukv, I_lru_conv_w, I_lru_conv_b, I_lru_w_r, I_lru_b_r, I_lru_w_i, I_lru_b_i, I_lru_lam,
       I_hy_conv_w, I_hy_conv_b, I_hy_w1, I_hy_b1, I_hy_f1, I_hy_w2, I_hy_b2, I_hy_f2, I_hy_w3, I_hy_skip,
       I_gqa_sink, I_w_branch, I_w_out, I_peer_w_q, I_peer_keys, I_peer_u, I_peer_v, I_g_final, N_IN };

struct bf { unsigned short v; };
DEV float b2f(bf x) { union { unsigned u; float f; } c; c.u = ((unsigned)x.v) << 16; return c.f; }
DEV bf f2b(float f) { union { unsigned u; float f; } c; c.f = f; unsigned r = c.u + 0x7FFFu + ((c.u >> 16) & 1u); bf o; o.v = (unsigned short)(r >> 16); return o; }


constexpr size_t al256(size_t x) { return (x + 255) & ~(size_t)255; }
struct WsLayout {
  size_t xcur, mods, hdn2, ssq, tabA, tabD, fnorm, SA, SB, tw, tbl, ts, spl, bar, hdn2b, W3T, h, Y, Z, XC, LA, LB, P, QA, KVA;
  size_t W_in, W_g, W_uq, W_ukv, W_lru, W_br, W_out, W_q, W_key;
  size_t M, Gs, G, SC, TKs, TKi, SELi, SELg, W, Ub, Vb, YT, total;
};
constexpr WsLayout make_layout() {
  WsLayout w{};
  size_t o = 0;
  w.xcur = o; o = al256(o + (size_t)TT * D * 4);
  w.mods = o; o = al256(o + (size_t)2 * 3 * 6 * D * 4);
  w.hdn2 = o; o = al256(o + (size_t)2 * (N + LC) * 64 * 4);
  w.ssq = o; o = al256(o + (size_t)2 * TT * 4);
  w.tabA = o; o = al256(o + (size_t)128 * 8 * 2 * 4);
  w.tabD = o; o = al256(o + (size_t)128 * 16 * 2 * 4);
  w.fnorm = o; o = al256(o + (size_t)2 * 512 * 4);
  w.tw = o; o = al256(o + (size_t)2 * N * 8);
  w.tbl = o; o = al256(o + (size_t)N_IN * 8);
  w.ts = o; o = al256(o + (size_t)64 * 8);
  w.spl = o; o = al256(o + (size_t)2 * 2 * 512 * 4);
  w.bar = o; o = al256(o + (size_t)3456 * 4);
  w.hdn2b = o; o = al256(o + (size_t)2 * (N + LC) * 256 * 2);
  w.W3T = o; o = al256(o + (size_t)1024 * 256 * 2);
  w.SA = o; o = al256(o + (size_t)2 * NB * NCHK * 512 * 4);
  w.SB = o; o = al256(o + (size_t)2 * NB * NCHK * 512 * 4);
  w.h = o; o = al256(o + (size_t)TT * D * 2);
  w.Y = o; w.Ub = o; w.Vb = o + (size_t)NEXP * D; o = al256(o + (size_t)TT * 2048 * 2);
  w.Z = o; o = al256(o + (size_t)TT * 512 * 2);
  w.W_in = o; o = al256(o + (size_t)3840 * 1024 * 2);
  w.W_g = o; o = al256(o + (size_t)4096 * 1024 * 2);
  w.W_uq = o; o = al256(o + (size_t)768 * 256 * 2);
  w.W_ukv = o; o = al256(o + (size_t)1024 * 256 * 2);
  w.W_lru = o; o = al256(o + (size_t)2048 * 256 * 2);
  w.W_br = o; o = al256(o + (size_t)4 * 1024 * 512 * 2);
  w.W_out = o; o = al256(o + (size_t)1024 * 1024 * 2);
  w.W_q = o; o = al256(o + (size_t)1024 * 1024 * 2);
  w.W_key = o; o = al256(o + (size_t)2048 * 256 * 2);
  size_t rl = o;
  w.XC = o; o = al256(o + (size_t)TT * 512 * 2);
  w.LA = o; o = al256(o + (size_t)2 * TT * 512 * 2);
  w.LB = o; o = al256(o + (size_t)2 * TT * 512 * 2);
  size_t rl_end = o;
  o = rl;
  w.TKs = o; o = al256(o + (size_t)TT * 256 * 4);
  w.TKi = o; o = al256(o + (size_t)TT * 256 * 4);
  w.SELi = o; o = al256(o + (size_t)TT * 128 * 4);
  w.SELg = o; o = al256(o + (size_t)TT * 128 * 4);
  w.W = o; o = al256(o + (size_t)TT * 128 * 4);
  if (o > rl_end) rl_end = o;
  o = rl_end;
  size_t rp = o;
  w.P = o; o = al256(o + (size_t)TT * PC * 2);
  w.QA = o; o = al256(o + (size_t)TT * 768 * 2);
  w.KVA = o; o = al256(o + (size_t)TT * 1024 * 2);
  size_t rp_end = o;
  o = rp;
  w.M = o; o = al256(o + (size_t)TT * D * 2);
  w.G = o; if (o + (size_t)TT * 3072 * 2 > rp_end) rp_end = o + (size_t)TT * 3072 * 2;
  w.Gs = o; o = al256(o + (size_t)TT * D * 2);
  w.SC = o; o = al256(o + (size_t)TT * 2048 * sizeof(sc_t));
  if (o > rp_end) rp_end = o;
  w.YT = rp_end; rp_end = al256(rp_end + (size_t)512 * NB * N * 2);
  w.total = rp_end;
  return w;
}
constexpr WsLayout WL = make_layout();
static_assert((size_t)TT * 4096 <= (size_t)TT * 512 * 2 + (size_t)4 * TT * 512 * 2, "uint8 gates must fit in the XC/LA/LB region");
static_assert(WL.LB == WL.LA + (size_t)2 * TT * 512 * 2, "LA and LB must be contiguous (packed GPU layout)");
static_assert(WL.total <= (size_t)512 * 1024 * 1024, "workspace too large");
#ifndef CPU_SIM
static_assert((size_t)2 * NEXP * D * 2 <= (size_t)TT * 2048 * 2, "bf16 expert tables must fit in Y");
#endif
struct WsAcc {
  float* out;
  char* ws;
  MDEV float* xcur() const { return (float*)(ws + WL.xcur); }
  MDEV float* mods() const { return (float*)(ws + WL.mods); }
  MDEV float* hdn2() const { return (float*)(ws + WL.hdn2); }
  MDEV float* ssq() const { return (float*)(ws + WL.ssq); }
  MDEV float* tabA() const { return (float*)(ws + WL.tabA); }
  MDEV float* tabD() const { return (float*)(ws + WL.tabD); }
  MDEV float* fnorm() const { return (float*)(ws + WL.fnorm); }
  MDEV float* tw() const { return (float*)(ws + WL.tw); }
  MDEV unsigned* Hs() const { return (unsigned*)((char*)out + (((size_t)(N + LC) * 1024 * 4 + 255) & ~(size_t)255)); }
  MDEV float* spl() const { return (float*)(ws + WL.spl); }
  MDEV bf* XYT() const { return (bf*)((char*)out + (((size_t)(N + LC) * 1024 * 4 + 255) & ~(size_t)255)); }
  MDEV bf* hdn2b() const { return (bf*)(ws + WL.hdn2b); }
  MDEV bf* W3T() const { return (bf*)(ws + WL.W3T); }
  MDEV float* SA() const { return (float*)(ws + WL.SA); }
  MDEV float* SB() const { return (float*)(ws + WL.SB); }
  MDEV bf* h() const { return (bf*)(ws + WL.h); }
  MDEV bf* Y() const { return (bf*)(ws + WL.Y); }
  MDEV bf* Z() const { return (bf*)(ws + WL.Z); }
  MDEV bf* XC() const { return (bf*)(ws + WL.XC); }
  MDEV bf* LA() const { return (bf*)(ws + WL.LA); }
  MDEV bf* LB() const { return (bf*)(ws + WL.LB); }
  MDEV bf* P() const { return (bf*)(ws + WL.P); }
  MDEV bf* QA() const { return (bf*)(ws + WL.QA); }
  MDEV bf* KVA() const { return (bf*)(ws + WL.KVA); }
  MDEV float* F() const { return out; }
  MDEV bf* W_in() const { return (bf*)(ws + WL.W_in); }
  MDEV bf* W_g() const { return (bf*)(ws + WL.W_g); }
  MDEV bf* W_uq() const { return (bf*)(ws + WL.W_uq); }
  MDEV bf* W_ukv() const { return (bf*)(ws + WL.W_ukv); }
  MDEV bf* W_lru() const { return (bf*)(ws + WL.W_lru); }
  MDEV bf* W_br() const { return (bf*)(ws + WL.W_br); }
  MDEV bf* W_out() const { return (bf*)(ws + WL.W_out); }
  MDEV bf* W_q() const { return (bf*)(ws + WL.W_q); }
  MDEV bf* W_key() const { return (bf*)(ws + WL.W_key); }
  MDEV bf* M() const { return (bf*)(ws + WL.M); }
  MDEV bf* Gs() const { return (bf*)(ws + WL.Gs); }
  MDEV bf* PQ() const { return (bf*)(ws + WL.Gs); }
  MDEV bf* BR() const { return (bf*)(ws + WL.G); }
  MDEV unsigned char* G8() const { return (unsigned char*)(ws + WL.XC); }
  MDEV unsigned* LAB() const { return (unsigned*)(ws + WL.LA); }
  MDEV bf* YT() const { return (bf*)(ws + WL.YT); }
  MDEV sc_t* SC() const { return (sc_t*)(ws + WL.SC); }
  MDEV float* TKs() const { return (float*)(ws + WL.TKs); }
  MDEV int* TKi() const { return (int*)(ws + WL.TKi); }
  MDEV int* SELi() const { return (int*)(ws + WL.SELi); }
  MDEV float* SELg() const { return (float*)(ws + WL.SELg); }
  MDEV float* W() const { return (float*)(ws + WL.W); }
  MDEV bf* Ub() const { return (bf*)(ws + WL.Ub); }
  MDEV bf* Vb() const { return (bf*)(ws + WL.Vb); }
};
struct KArgs : WsAcc { const float* in[N_IN]; };
#ifndef CPU_SIM
typedef float v4f_gl __attribute__((ext_vector_type(4)));
DEV float4 gld4(const void* q) { const v4f_gl r = *(const __attribute__((address_space(1))) v4f_gl*)q; return float4{r.x, r.y, r.z, r.w}; }
DEV float gld1(const float* q) { return *(const __attribute__((address_space(1))) float*)q; }
#else
DEV float gld1(const float* q) { return *q; }
#endif
#ifndef CPU_SIM
typedef const __attribute__((address_space(1))) float* GF;
#else
typedef const float* GF;
#endif
struct InTab {
  const float* const* t;
#ifndef CPU_SIM
  MDEV const float* operator[](int i) const { return t[i]; }
#else
  MDEV const float* operator[](int i) const { return t[i]; }
#endif
};
struct Params : WsAcc { InTab in; };
static_assert((size_t)(N + LC) * 1024 * 4 + 256 + (size_t)256 * 2 * N * 4 <= (size_t)NLAT * D * 4, "F + spectrum scratch must fit in d_out");

#ifndef CPU_SIM
DEV float fexpf_(float x) { return __builtin_amdgcn_exp2f(x * 1.4426950408889634f); }
DEV float sigmoidf_(float x) { return __builtin_amdgcn_rcpf(1.0f + __builtin_amdgcn_exp2f(-x * 1.4426950408889634f)); }
DEV float siluf_(float x) { return x * sigmoidf_(x); }
DEV float geluf_(float x) { return x * sigmoidf_(1.5957691216057308f * (x + 0.044715f * x * x * x)); }
#else
DEV float fexpf_(float x) { return expf(x); }
DEV float sigmoidf_(float x) { return 1.0f / (1.0f + expf(-x)); }
DEV float siluf_(float x) { return x * sigmoidf_(x); }
DEV float geluf_(float x) { return 0.5f * x * (1.0f + tanhf(0.7978845608028654f * (x + 0.044715f * x * x * x))); }
#endif
DEV float softplusf_(float x) { return x > 20.f ? x : log1pf(expf(x)); }

#ifndef CPU_SIM
DEV float lane_xor(float v, int lane, int o) { return __int_as_float(__builtin_amdgcn_ds_bpermute(((lane ^ o) & 63) << 2, __float_as_int(v))); }
#endif
#ifndef CPU_SIM
DEV void unpack8(const uint4 w, float* f) {
  union { unsigned u; float x; } c;
  c.u = w.x << 16; f[0] = c.x; c.u = w.x & 0xFFFF0000u; f[1] = c.x; c.u = w.y << 16; f[2] = c.x; c.u = w.y & 0xFFFF0000u; f[3] = c.x;
  c.u = w.z << 16; f[4] = c.x; c.u = w.z & 0xFFFF0000u; f[5] = c.x; c.u = w.w << 16; f[6] = c.x; c.u = w.w & 0xFFFF0000u; f[7] = c.x;
}
#endif
struct RowInfo { int b, t, L, base, lat; };
DEV RowInfo rowinfo(int r) {
  RowInfo ri;
  if (r < NLAT) { ri.b = r / N; ri.t = r - ri.b * N; ri.L = N; ri.base = ri.b * N; ri.lat = 1; }
  else { int rc = r - NLAT; ri.b = rc / LC; ri.t = rc - ri.b * LC; ri.L = LC; ri.base = NLAT + ri.b * LC; ri.lat = 0; }
  return ri;
}
DEV int modrow(int r) { return r < NLAT ? r / N : 2; }
template <class PT> DEV const float* xin_row(const PT& p, int r) { return r < NLAT ? p.in[I_x] + (size_t)r * D : p.in[I_ctx] + (size_t)(r - NLAT) * D; }

DEV void atomic_addf(float* p, float v) {
#ifndef CPU_SIM
  atomicAdd(p, v);
#else
#pragma omp atomic
  *p += v;
#endif
}
DEV void store8bf(bf* dst, const float* v) {
#ifndef CPU_SIM
  uint4 w;
  asm volatile("v_cvt_pk_bf16_f32 %0, %1, %2" : "=v"(w.x) : "v"(v[0]), "v"(v[1]));
  asm volatile("v_cvt_pk_bf16_f32 %0, %1, %2" : "=v"(w.y) : "v"(v[2]), "v"(v[3]));
  asm volatile("v_cvt_pk_bf16_f32 %0, %1, %2" : "=v"(w.z) : "v"(v[4]), "v"(v[5]));
  asm volatile("v_cvt_pk_bf16_f32 %0, %1, %2" : "=v"(w.w) : "v"(v[6]), "v"(v[7]));
  *(uint4*)dst = w;
#else
  for (int j = 0; j < 8; ++j) dst[j] = f2b(v[j]);
#endif
}
#ifndef CPU_SIM
DEV unsigned pk2bf(float lo, float hi) { unsigned r; asm volatile("v_cvt_pk_bf16_f32 %0, %1, %2" : "=v"(r) : "v"(lo), "v"(hi)); return r; }
#endif
DEV void load8bf(const bf* src, float* v) {
#ifndef CPU_SIM
  uint4 w = *(const uint4*)src;
  union { unsigned u; float f; } c;
  c.u = w.x << 16; v[0] = c.f; c.u = w.x & 0xFFFF0000u; v[1] = c.f;
  c.u = w.y << 16; v[2] = c.f; c.u = w.y & 0xFFFF0000u; v[3] = c.f;
  c.u = w.z << 16; v[4] = c.f; c.u = w.z & 0xFFFF0000u; v[5] = c.f;
  c.u = w.w << 16; v[6] = c.f; c.u = w.w & 0xFFFF0000u; v[7] = c.f;
#else
  for (int j = 0; j < 8; ++j) v[j] = b2f(src[j]);
#endif
}

DEV int win_src(int n) {
  if (n >= 3744) return -1;
  if (n >= C_KR && n < C_KR + 32) { int q = n - C_KR; int pi = q >> 1, wh = q & 1, half = pi >> 3, f = pi & 7; return C_KR + half * 16 + f + wh * 8; }
  if (n >= C_GQ && n < C_GKV + 128) { int q = n - C_GQ; int hh = q >> 6, d = q & 63; int pi = d >> 1, wh = d & 1, half = pi >> 4, f = pi & 15; return C_GQ + hh * 64 + half * 32 + f + wh * 16; }
  return n;
}
DEV int wuq_src(int n) {
  int hh = n / 96, d = n % 96;
  if (d < 64) return n;
  int q = d - 64; int pi = q >> 1, wh = q & 1, half = pi >> 3, f = pi & 7;
  return hh * 96 + 64 + half * 16 + f + wh * 8;
}

template <class PT> DEVN void ph_init(const PT& p, i64 gtid, i64 gsz, char* ilds = nullptr, int itid = 0) {
#ifndef CPU_SIM
  {
    float* sl = (float*)ilds;
    for (int q = itid; q < 3 * D; q += 512) { const int rr = q / D, k = q - rr * D; sl[q] = siluf_(rr < 2 ? p.in[I_c][rr * D + k] : p.in[I_c_ctx][k]); }
    __syncthreads();
    float* red3 = sl + 3 * D;
    const int wv_ = itid >> 6, ln_ = itid & 63;
    for (int task = blockIdx.x; task < 2 * 6 * D / 64; task += gridDim.x) {
      const int l = task / (6 * D / 64), j = (task % (6 * D / 64)) * 64 + ln_;
      const float* w = p.in[I_w_mod] + (size_t)l * D * 6 * D + j;
      float a0 = 0.f, a1 = 0.f, a2 = 0.f;
#pragma unroll 1
      for (int k0 = wv_ * 128; k0 < wv_ * 128 + 128; k0 += 16) {
        float wv[16];
#pragma unroll
        for (int q = 0; q < 16; ++q) wv[q] = w[(size_t)(k0 + q) * 6 * D];
#pragma unroll
        for (int q = 0; q < 16; ++q) { a0 += sl[k0 + q] * wv[q]; a1 += sl[D + k0 + q] * wv[q]; a2 += sl[2 * D + k0 + q] * wv[q]; }
      }
      __syncthreads();
      red3[(wv_ * 3 + 0) * 64 + ln_] = a0; red3[(wv_ * 3 + 1) * 64 + ln_] = a1; red3[(wv_ * 3 + 2) * 64 + ln_] = a2;
      __syncthreads();
      if (itid < 192) {
        const int v3 = itid >> 6, jj = itid & 63;
        float sum = p.in[I_b_mod][l * 6 * D + (task % (6 * D / 64)) * 64 + jj];
#pragma unroll
        for (int w8 = 0; w8 < 8; ++w8) sum += red3[(w8 * 3 + v3) * 64 + jj];
        p.mods()[((size_t)l * 3 + v3) * 6 * D + (task % (6 * D / 64)) * 64 + jj] = sum;
      }
    }
    __syncthreads();
  }
  {
    float* wl1 = (float*)ilds;
    float* wl2 = wl1 + 2 * 2240;
    float* h1 = wl2 + 2 * 4224;
    for (int q = itid; q < 2 * 2240; q += 512) { const int l = q / 2240, o = q - l * 2240;
      wl1[q] = o < 2112 ? p.in[I_hy_w1][l * 2112 + o] : (o < 2176 ? p.in[I_hy_b1][l * 64 + o - 2112] : p.in[I_hy_f1][l * 64 + o - 2176]); }
    for (int q = itid; q < 2 * 4224; q += 512) { const int l = q / 4224, o = q - l * 4224;
      wl2[q] = o < 4096 ? p.in[I_hy_w2][l * 4096 + o] : (o < 4160 ? p.in[I_hy_b2][l * 64 + o - 4096] : p.in[I_hy_f2][l * 64 + o - 4160]); }
    __syncthreads();
    const int per = (2 * (N + LC) + (int)gridDim.x - 1) / (int)gridDim.x;
    for (int base = 0; base < per; base += 128) {
      const int li = base + itid;
      const i64 i = (i64)blockIdx.x * per + li;
      if (itid < 128 && li < per && i < (i64)2 * (N + LC)) {
        const int l = (int)(i / (N + LC)), tt = (int)(i % (N + LC));
        int t, L; if (tt < N) { t = tt; L = N; } else { t = tt - N; L = LC; }
        const float tn = (float)t / (float)(L - 1);
        const float wt = 6.283185307179586f * (float)t / (float)L;
        const float* w1 = wl1 + l * 2240; const float* b1 = w1 + 2112; const float* f1 = w1 + 2176;
        const float* w2 = wl2 + l * 4224; const float* b2 = w2 + 4096; const float* f2 = w2 + 4160;
        { uint4* zp_ = (uint4*)(p.hdn2b() + ((size_t)l * (N + LC) + tt) * 256 + 64);
#pragma unroll
          for (int q = 0; q < 24; ++q) zp_[q] = uint4{0, 0, 0, 0}; }
        float zc[16], zs[16];
#pragma unroll
        for (int bd = 0; bd < 16; ++bd) { const float ang = (1e-4f + (float)bd * ((15.0f - 1e-4f) / 15.0f)) * wt; zc[bd] = cosf(ang); zs[bd] = sinf(ang); }
#pragma unroll 2
        for (int k1 = 0; k1 < 64; ++k1) {
          float a1 = b1[k1] + tn * w1[k1];
#pragma unroll
          for (int bd = 0; bd < 16; ++bd) a1 += zc[bd] * w1[(1 + bd) * 64 + k1] - zs[bd] * w1[(17 + bd) * 64 + k1];
          h1[k1 * 128 + itid] = sinf(f1[k1] * a1);
        }
#pragma unroll 1
        for (int j0 = 0; j0 < 64; j0 += 4) {
          float c0 = b2[j0], c1 = b2[j0 + 1], c2 = b2[j0 + 2], c3 = b2[j0 + 3];
#pragma unroll 8
          for (int k1 = 0; k1 < 64; ++k1) { const float hv = h1[k1 * 128 + itid]; const float4 wv = *(const float4*)(w2 + k1 * 64 + j0); c0 += hv * wv.x; c1 += hv * wv.y; c2 += hv * wv.z; c3 += hv * wv.w; }
          bf* ot = p.hdn2b() + ((size_t)l * (N + LC) + tt) * 256 + j0;
          ot[0] = f2b(sinf(f2[j0] * c0)); ot[1] = f2b(sinf(f2[j0 + 1] * c1)); ot[2] = f2b(sinf(f2[j0 + 2] * c2)); ot[3] = f2b(sinf(f2[j0 + 3] * c3));
        }
      }
    }
  }
#else
  for (i64 i = gtid; i < 2 * 3 * 6 * D; i += gsz) {
    int l = (int)(i / (3 * 6 * D)); int rr = (int)((i / (6 * D)) % 3); int j = (int)(i % (6 * D));
    const float* cv = rr < 2 ? p.in[I_c] + rr * D : p.in[I_c_ctx];
    const float* w = p.in[I_w_mod] + (size_t)l * D * 6 * D;
    float acc = p.in[I_b_mod][l * 6 * D + j];
    for (int k = 0; k < D; ++k) acc += siluf_(cv[k]) * w[(size_t)k * 6 * D + j];
    p.mods()[i] = acc;
  }
  for (i64 i = gtid; i < (i64)2 * (N + LC) * 64; i += gsz) {
    int l = (int)(i / ((i64)(N + LC) * 64)); int tt = (int)((i / 64) % (N + LC)); int j2 = (int)(i % 64);
    int t, L; if (tt < N) { t = tt; L = N; } else { t = tt - N; L = LC; }
    float tn = (float)t / (float)(L - 1);
    float wt = 6.283185307179586f * (float)t / (float)L;
    const float* w1 = p.in[I_hy_w1] + l * 33 * 64; const float* b1 = p.in[I_hy_b1] + l * 64; const float* f1 = p.in[I_hy_f1] + l * 64;
    const float* w2 = p.in[I_hy_w2] + l * 64 * 64; const float* b2 = p.in[I_hy_b2] + l * 64; const float* f2 = p.in[I_hy_f2] + l * 64;
    float acc2 = b2[j2];
    for (int k1 = 0; k1 < 64; ++k1) {
      float a1 = b1[k1] + tn * w1[k1];
      for (int bd = 0; bd < 16; ++bd) {
        float band = 1e-4f + (float)bd * ((15.0f - 1e-4f) / 15.0f);
        float ang = band * wt;
        a1 += cosf(ang) * w1[(1 + bd) * 64 + k1] - sinf(ang) * w1[(17 + bd) * 64 + k1];
      }
      acc2 += sinf(f1[k1] * a1) * w2[k1 * 64 + j2];
    }
    p.hdn2()[i] = sinf(f2[j2] * acc2);
  }
#endif
#ifdef CPU_SIM
  for (i64 i = gtid; i < 2 * N; i += gsz) {
    double a = 6.283185307179586476925 * (double)i / (double)(2 * N);
    p.tw()[i * 2] = (float)cos(a); p.tw()[i * 2 + 1] = (float)-sin(a);
  }
#endif
  for (i64 i = gtid; i < 2 * 2 * 512; i += gsz) p.spl()[i] = softplusf_(-p.in[I_lru_lam][i]);
  for (i64 i = gtid; i < 128 * 8; i += gsz) {
    int pos = (int)(i / 8), f = (int)(i % 8);
    float ang = (float)pos * powf(10000.0f, -(float)f / 8.0f);
    p.tabA()[i * 2] = cosf(ang); p.tabA()[i * 2 + 1] = sinf(ang);
  }
  for (i64 i = gtid; i < 128 * 16; i += gsz) {
    int pos = (int)(i / 16), f = (int)(i % 16);
    float ang = (float)pos * powf(10000.0f, -(float)f / 16.0f);
    p.tabD()[i * 2] = cosf(ang); p.tabD()[i * 2 + 1] = sinf(ang);
  }
}

#ifndef CPU_SIM
template <class F> DEV void xpose_tiles(bf* dst, int K, int NN, const F& val, int tid, float* tl, int& xoff, int rank, int nranks) {
  const int tk = K / 64, tn = NN / 64;
  const int t0 = (rank + nranks - xoff % nranks) % nranks;
  xoff += tk * tn;
  for (int t = t0; t < tk * tn; t += nranks) {
    const int k0 = (t / tn) * 64, n0 = (t % tn) * 64;
    __syncthreads();
    float tv_[8];
#pragma unroll
    for (int i = 0; i < 8; ++i) { const int kk = (tid >> 6) + 8 * i, nn = tid & 63; tv_[i] = val(k0 + kk, n0 + nn); }
#pragma unroll
    for (int i = 0; i < 8; ++i) { const int kk = (tid >> 6) + 8 * i, nn = tid & 63; tl[nn * 65 + kk] = tv_[i]; }
    __syncthreads();
#pragma unroll
    for (int i = 0; i < 8; ++i) { const int nn = (tid >> 6) + 8 * i, kk = tid & 63; dst[(size_t)(n0 + nn) * K + k0 + kk] = f2b(tl[nn * 65 + kk]); }
  }
}
#else
template <class F> static void xpose_tiles(bf* dst, int K, int NN, const F& val, i64 gtid, i64 gsz) {
  for (i64 i = gtid; i < (i64)K * NN; i += gsz) { int k = (int)(i / NN), n = (int)(i % NN); dst[(size_t)n * K + k] = f2b(val(k, n)); }
}
#endif
struct PrepCtx {
#ifndef CPU_SIM
  int tid; float* tl; int rank, nranks;
#else
  i64 gtid, gsz;
#endif
};
#ifndef CPU_SIM
#define XPOSE(dst, K, NN, val) xpose_tiles(dst, K, NN, val, pc.tid, pc.tl, xoff, pc.rank, pc.nranks)
#else
#define XPOSE(dst, K, NN, val) xpose_tiles(dst, K, NN, val, pc.gtid, pc.gsz)
#endif
DEVN void ph_prep(const Params& p, int l, const PrepCtx& pc, i64 gtid, i64 gsz, const int parts) {
  int xoff = 0; (void)xoff;
  if (parts & 1) {
    GF w = (GF)(p.in[I_w_in] + (size_t)l * D * INC);
    XPOSE(p.W_in(), 1024, 3840, [=](int k, int n) { const int s_ = win_src(n); const float x_ = w[(size_t)k * INC + (s_ < 0 ? 0 : s_)]; return s_ < 0 ? 0.f : x_; });
    XPOSE(p.W_g(), 1024, 4096, [=](int k, int n) { return w[(size_t)k * INC + C_GT + n]; });
  }
  if (parts & 1) {
    GF w = (GF)(p.in[I_mla_w_uq] + (size_t)l * 256 * 768); GF g = (GF)(p.in[I_mla_g_cq] + l * 256);
    XPOSE(p.W_uq(), 256, 768, [=](int k, int n) { return g[k] * w[(size_t)k * 768 + wuq_src(n)]; });
  }
  if (parts & 1) {
    GF w = (GF)(p.in[I_mla_w_ukv] + (size_t)l * 128 * 1024); GF g = (GF)(p.in[I_mla_g_ckv] + l * 128);
    XPOSE(p.W_ukv(), 256, 1024, [=](int k, int n) { const int kc = k < 128 ? k : 0; const float x_ = g[kc] * w[(size_t)kc * 1024 + n]; return k < 128 ? x_ : 0.f; });
  }
  if (parts & 2) {
    GF w = (GF)(p.in[I_w_branch] + (size_t)l * 4 * 512 * D);
    for (int br = 0; br < 4; ++br) { GF wb = w + (size_t)br * 512 * D; XPOSE(p.W_br() + (size_t)br * 1024 * 512, 512, 1024, [=](int k, int n) { return wb[(size_t)k * D + n]; }); }
  }
  if (parts & 2) {
    GF w = (GF)(p.in[I_w_out] + (size_t)l * D * D);
    XPOSE(p.W_out(), 1024, 1024, [=](int k, int n) { return w[(size_t)k * D + n]; });
  }
  if (parts & 4) {
    GF wq = (GF)(p.in[I_peer_w_q] + (size_t)l * D * 1024);
    XPOSE(p.W_q(), 1024, 1024, [=](int k, int n) { return wq[(size_t)k * 1024 + n]; });
  }
#ifndef CPU_SIM
  if (parts & 1) {
    GF w3 = (GF)(p.in[I_hy_w3] + (size_t)l * 64 * 1024);
    XPOSE(p.W3T(), 256, 1024, [=](int k, int n) { const int kc = k < 64 ? k : 0; const float x_ = w3[(size_t)kc * 1024 + n]; return k < 64 ? x_ : 0.f; });
  }
#endif
  if (parts & 1) {
    for (i64 i = gtid; i < 2048 * 256; i += gsz) {
      int n = (int)(i / 256), k = (int)(i % 256);
      int kw = n >> 10, dir = (n >> 9) & 1, blk4 = (n >> 7) & 3, jc = (n & 127) >> 1, gate = n & 1;
      float v = 0.f;
      if ((k >> 6) == blk4) {
        GF wsrc = (GF)p.in[gate ? I_lru_w_i : I_lru_w_r] + ((((size_t)l * 2 + dir) * 8 + kw * 4 + blk4) * 64 + (k & 63)) * 64 + jc;
        v = *wsrc;
      }
      p.W_lru()[i] = f2b(v);
    }
  }
  if (parts & 8) {
    GF keys = (GF)(p.in[I_peer_keys] + (size_t)l * 16 * 128 * 64);
    for (i64 i = gtid; i < 2048 * 256; i += gsz) {
      int n = (int)(i / 256), k = (int)(i % 256);
      int hp = n >> 7, key = n & 127;
      float v = ((k >> 6) == (hp & 3)) ? keys[((size_t)hp * 128 + key) * 64 + (k & 63)] : 0.f;
      p.W_key()[i] = f2b(v);
    }
  }
}

DEVN void ph_norm(const Params& p, int l, int which, int nrows, i64 gtid, i64 gsz) {
  const float* g = p.in[which ? I_g_ffn : I_g_mix] + l * D;
#ifndef CPU_SIM
  const int lane = (int)(gtid & 63);
  const i64 W = gsz >> 6;
  float4 gv[4];
#pragma unroll
  for (int i = 0; i < 4; ++i) gv[i] = *(const float4*)(g + (lane + i * 64) * 4);
  for (i64 r = gtid >> 6; r < nrows; r += 2 * W) {
    const bool two = r + W < nrows;
    const i64 rb = two ? r + W : r;
    const float4* xra = (const float4*)((l == 0 && which == 0) ? xin_row(p, (int)r) : p.xcur() + (size_t)r * D);
    const float4* xrb = (const float4*)((l == 0 && which == 0) ? xin_row(p, (int)rb) : p.xcur() + (size_t)rb * D);
    const float* mda = p.mods() + ((size_t)l * 3 + modrow((int)r)) * 6 * D + (which ? 3 * D : 0);
    const float* mdb = p.mods() + ((size_t)l * 3 + modrow((int)rb)) * 6 * D + (which ? 3 * D : 0);
    float4 xa[4], xb[4], sha[4], sca[4], shb[4], scb[4]; float sa = 0.f, sb = 0.f;
#pragma unroll
    for (int i = 0; i < 4; ++i) { xa[i] = xra[lane + i * 64]; xb[i] = xrb[lane + i * 64]; }
#pragma unroll
    for (int i = 0; i < 4; ++i) { const int k = (lane + i * 64) * 4; sha[i] = *(const float4*)(mda + k); sca[i] = *(const float4*)(mda + D + k); shb[i] = *(const float4*)(mdb + k); scb[i] = *(const float4*)(mdb + D + k); }
#pragma unroll
    for (int i = 0; i < 4; ++i) { sa += xa[i].x * xa[i].x + xa[i].y * xa[i].y + xa[i].z * xa[i].z + xa[i].w * xa[i].w; sb += xb[i].x * xb[i].x + xb[i].y * xb[i].y + xb[i].z * xb[i].z + xb[i].w * xb[i].w; }
#pragma unroll
    for (int o = 32; o >= 1; o >>= 1) { sa += lane_xor(sa, lane, o); sb += lane_xor(sb, lane, o); }
    const float rsa = 1.0f / sqrtf(sa * (1.0f / D) + EPS), rsb = 1.0f / sqrtf(sb * (1.0f / D) + EPS);
#pragma unroll
    for (int i = 0; i < 4; ++i) {
      const int k = (lane + i * 64) * 4;
      uint2 w;
      w.x = pk2bf(xa[i].x * rsa * gv[i].x * (1.0f + sca[i].x) + sha[i].x, xa[i].y * rsa * gv[i].y * (1.0f + sca[i].y) + sha[i].y);
      w.y = pk2bf(xa[i].z * rsa * gv[i].z * (1.0f + sca[i].z) + sha[i].z, xa[i].w * rsa * gv[i].w * (1.0f + sca[i].w) + sha[i].w);
      *(uint2*)(p.h() + (size_t)r * D + k) = w;
    }
    if (two) {
#pragma unroll
      for (int i = 0; i < 4; ++i) {
        const int k = (lane + i * 64) * 4;
        uint2 w;
        w.x = pk2bf(xb[i].x * rsb * gv[i].x * (1.0f + scb[i].x) + shb[i].x, xb[i].y * rsb * gv[i].y * (1.0f + scb[i].y) + shb[i].y);
        w.y = pk2bf(xb[i].z * rsb * gv[i].z * (1.0f + scb[i].z) + shb[i].z, xb[i].w * rsb * gv[i].w * (1.0f + scb[i].w) + shb[i].w);
        *(uint2*)(p.h() + (size_t)rb * D + k) = w;
      }
    }
  }
#else
  for (i64 r = gtid; r < nrows; r += gsz) {
    const float* xr = (l == 0 && which == 0) ? xin_row(p, (int)r) : p.xcur() + (size_t)r * D;
    float ss = 0.f;
    for (int k = 0; k < D; ++k) ss += xr[k] * xr[k];
    float rstd = 1.0f / sqrtf(ss / D + EPS);
    const float* md = p.mods() + ((size_t)l * 3 + modrow((int)r)) * 6 * D + (which ? 3 * D : 0);
    for (int k = 0; k < D; ++k) p.h()[(size_t)r * D + k] = f2b(xr[k] * rstd * g[k] * (1.0f + md[D + k]) + md[k]);
  }
#endif
}

DEVN void ph_B0(const Params& p, int l, i64 gtid, i64 gsz, char* b0lds = nullptr, int b0tid = 0) {
#ifndef CPU_SIM
  {
    const int lane = (int)(gtid & 63);
    const i64 W = gsz >> 6;
    for (i64 r = gtid >> 6; r < TT; r += 4 * W) {
      uint2 a[4]; unsigned b[4]; i64 rr[4];
#pragma unroll
      for (int j = 0; j < 4; ++j) { rr[j] = r + j * W < TT ? r + j * W : r; const bf* pr = p.P() + (size_t)rr[j] * PC; a[j] = *(const uint2*)(pr + C_CQ + lane * 4); b[j] = *(const unsigned*)(pr + C_CKV + lane * 2); }
      float sq[4], sk[4];
#pragma unroll
      for (int j = 0; j < 4; ++j) {
        const float f0 = __uint_as_float(a[j].x << 16), f1 = __uint_as_float(a[j].x & 0xFFFF0000u), f2 = __uint_as_float(a[j].y << 16), f3 = __uint_as_float(a[j].y & 0xFFFF0000u);
        const float g0 = __uint_as_float(b[j] << 16), g1 = __uint_as_float(b[j] & 0xFFFF0000u);
        sq[j] = 0.f; sq[j] += f0 * f0; sq[j] += f1 * f1; sq[j] += f2 * f2; sq[j] += f3 * f3;
        sk[j] = 0.f; sk[j] += g0 * g0; sk[j] += g1 * g1;
      }
#pragma unroll
      for (int o = 32; o >= 1; o >>= 1) {
#pragma unroll
        for (int j = 0; j < 4; ++j) { sq[j] += lane_xor(sq[j], lane, o); sk[j] += lane_xor(sk[j], lane, o); }
      }
#pragma unroll
      for (int j = 0; j < 4; ++j) if (lane == 0 && r + j * W < TT) { p.ssq()[rr[j]] = sq[j]; p.ssq()[TT + rr[j]] = sk[j]; }
    }
  }
#else
  for (i64 r = gtid; r < TT; r += gsz) {
    const bf* pr = p.P() + (size_t)r * PC;
    float sq = 0.f, sk = 0.f;
    for (int k = 0; k < 256; ++k) { float v = b2f(pr[C_CQ + k]); sq += v * v; }
    for (int k = 0; k < 128; ++k) { float v = b2f(pr[C_CKV + k]); sk += v * v; }
    p.ssq()[r] = sq; p.ssq()[TT + r] = sk;
  }
#endif
#ifndef CPU_SIM
  {
    GF cw = (GF)(p.in[I_lru_conv_w] + l * 4 * 512); GF cb = (GF)(p.in[I_lru_conv_b] + l * 512);
    const int c8 = (int)(gtid & 63) * 8;
    float wv[4][8], bv[8];
#pragma unroll
    for (int j = 0; j < 8; ++j) { bv[j] = cb[c8 + j];
#pragma unroll
      for (int k = 0; k < 4; ++k) wv[k][j] = cw[k * 512 + c8 + j]; }
    for (i64 i = gtid; i < (i64)TT * 64; i += 2 * gsz) {
      const bool two = i + gsz < (i64)TT * 64;
      const int r0 = (int)(i >> 6), r1 = two ? (int)((i + gsz) >> 6) : r0;
      const RowInfo ra = rowinfo(r0), rb = rowinfo(r1);
      uint4 xa[4], xb[4]; float ma[4], mb[4];
#pragma unroll
      for (int k = 0; k < 4; ++k) {
        const int ta = ra.t - 1 + k, tb = rb.t - 1 + k;
        const bool oka = ta >= 0 && ta < ra.L, okb = tb >= 0 && tb < rb.L;
        ma[k] = oka ? 1.f : 0.f; mb[k] = okb ? 1.f : 0.f;
        xa[k] = *(const uint4*)(p.P() + (size_t)(ra.base + (oka ? ta : ra.t)) * PC + C_LX + c8);
        xb[k] = *(const uint4*)(p.P() + (size_t)(rb.base + (okb ? tb : rb.t)) * PC + C_LX + c8);
      }
      float aa[8], ab[8];
#pragma unroll
      for (int j = 0; j < 8; ++j) { aa[j] = bv[j]; ab[j] = bv[j]; }
#pragma unroll
      for (int k = 0; k < 4; ++k) {
        float fa_[8], fb_[8]; unpack8(xa[k], fa_); unpack8(xb[k], fb_);
#pragma unroll
        for (int j = 0; j < 8; ++j) { aa[j] += (wv[k][j] * ma[k]) * fa_[j]; ab[j] += (wv[k][j] * mb[k]) * fb_[j]; }
      }
      store8bf(p.XC() + (size_t)r0 * 512 + c8, aa);
      if (two) store8bf(p.XC() + (size_t)r1 * 512 + c8, ab);
    }
  }
  {
    const float* cw = p.in[I_hy_conv_w] + l * 3 * 1536; const float* cb = p.in[I_hy_conv_b] + l * 1536;
    for (i64 i = (i64)NLAT * 64 + gtid; i < (i64)TT * 64; i += gsz) {
      const int r = (int)(i >> 6), c8 = (int)(i & 63) * 8;
      const RowInfo ri = rowinfo(r);
      float a1[8], a2[8];
#pragma unroll
      for (int j = 0; j < 8; ++j) { a1[j] = cb[512 + c8 + j]; a2[j] = cb[1024 + c8 + j]; }
#pragma unroll
      for (int k = 0; k < 3; ++k) {
        const int ts = ri.t - 1 + k; if (ts < 0 || ts >= ri.L) continue;
        const bf* pr = p.P() + (size_t)(ri.base + ts) * PC + C_HU;
        float f[8], g[8]; unpack8(*(const uint4*)(pr + 512 + c8), f); unpack8(*(const uint4*)(pr + 1024 + c8), g);
#pragma unroll
        for (int j = 0; j < 8; ++j) { a1[j] += cw[k * 1536 + 512 + c8 + j] * f[j]; a2[j] += cw[k * 1536 + 1024 + c8 + j] * g[j]; }
      }
#pragma unroll
      for (int j = 0; j < 8; ++j) a1[j] *= a2[j];
      store8bf(p.Z() + (size_t)r * 512 + c8, a1);
    }
  }
  {
    const float* cw = p.in[I_hy_conv_w] + l * 3 * 1536; const float* cb = p.in[I_hy_conv_b] + l * 1536;
    unsigned short* tz_ = (unsigned short*)b0lds; unsigned short* tx_ = tz_ + 64 * 72;
    for (int tile = blockIdx.x; tile < (NLAT / 64) * 8; tile += gridDim.x) {
      const int rt = tile >> 3, c0 = (tile & 7) * 64;
      const int tr = b0tid >> 3, cg8 = (b0tid & 7) * 8;
      const int r = rt * 64 + tr, t = r % N;
      float a0[8], a1[8], a2[8];
#pragma unroll
      for (int j = 0; j < 8; ++j) { a0[j] = cb[c0 + cg8 + j]; a1[j] = cb[512 + c0 + cg8 + j]; a2[j] = cb[1024 + c0 + cg8 + j]; }
      uint4 v0[3], v1[3], v2[3]; bool ok[3];
#pragma unroll
      for (int k = 0; k < 3; ++k) {
        const int ts = t - 1 + k; ok[k] = ts >= 0 && ts < N;
        const bf* pr = p.P() + (size_t)(r - 1 + (ok[k] ? k : 1)) * PC + C_HU + c0 + cg8;
        v0[k] = *(const uint4*)pr; v1[k] = *(const uint4*)(pr + 512); v2[k] = *(const uint4*)(pr + 1024);
      }
#pragma unroll
      for (int k = 0; k < 3; ++k) {
        if (!ok[k]) continue;
        float f0[8], f1[8], f2_[8]; unpack8(v0[k], f0); unpack8(v1[k], f1); unpack8(v2[k], f2_);
        const float* w = cw + k * 1536 + c0 + cg8;
#pragma unroll
        for (int j = 0; j < 8; ++j) { a0[j] += w[j] * f0[j]; a1[j] += w[512 + j] * f1[j]; a2[j] += w[1024 + j] * f2_[j]; }
      }
      __syncthreads();
#pragma unroll
      for (int j = 0; j < 8; ++j) { tz_[(cg8 + j) * 72 + tr] = f2b(a1[j] * a2[j]).v; tx_[(cg8 + j) * 72 + tr] = f2b(a0[j]).v; }
      __syncthreads();
      { const int cc = b0tid >> 3, tg = (b0tid & 7) * 8;
        const int bq = (rt * 64) / N, tq = (rt * 64) % N + tg;
        const size_t o = ((size_t)(c0 + cc) * NB + bq) * N + tq;
        *(uint4*)((unsigned short*)p.Z() + o) = *(const uint4*)(tz_ + cc * 72 + tg);
        *(uint4*)((unsigned short*)p.XYT() + o) = *(const uint4*)(tx_ + cc * 72 + tg); }
    }
  }
#else
  {
    const float* cw = p.in[I_lru_conv_w] + l * 4 * 512; const float* cb = p.in[I_lru_conv_b] + l * 512;
    for (i64 i = gtid; i < (i64)TT * 512; i += gsz) {
      int r = (int)(i / 512), c = (int)(i % 512);
      RowInfo ri = rowinfo(r);
      float acc = cb[c];
      for (int k = 0; k < 4; ++k) {
        int ts = ri.t - 1 + k;
        if (ts >= 0 && ts < ri.L) acc += cw[k * 512 + c] * b2f(p.P()[(size_t)(ri.base + ts) * PC + C_LX + c]);
      }
      p.XC()[i] = f2b(acc);
    }
  }
  {
    const float* cw = p.in[I_hy_conv_w] + l * 3 * 1536; const float* cb = p.in[I_hy_conv_b] + l * 1536;
    for (i64 i = gtid; i < (i64)TT * 512; i += gsz) {
      int r = (int)(i / 512), c = (int)(i % 512);
      RowInfo ri = rowinfo(r);
      float a1 = cb[512 + c], a2 = cb[1024 + c];
      for (int k = 0; k < 3; ++k) {
        int ts = ri.t - 1 + k;
        if (ts >= 0 && ts < ri.L) {
          const bf* pr = p.P() + (size_t)(ri.base + ts) * PC + C_HU;
          a1 += cw[k * 1536 + 512 + c] * b2f(pr[512 + c]);
          a2 += cw[k * 1536 + 1024 + c] * b2f(pr[1024 + c]);
        }
      }
      p.Z()[i] = f2b(a1 * a2);
    }
  }
  {
    const float* w3 = p.in[I_hy_w3] + (size_t)l * 64 * 1024;
    const float maxd = logf(1e-2f) / 0.3f, mind = logf(1e-2f) / 1.5f;
    for (i64 i = gtid; i < (i64)(N + LC) * 1024; i += gsz) {
      int tt = (int)(i / 1024), j = (int)(i % 1024);
      int t, L; if (tt < N) { t = tt; L = N; } else { t = tt - N; L = LC; }
      const float* hd = p.hdn2() + ((size_t)l * (N + LC) + tt) * 64;
      float acc = 0.f;
      for (int k = 0; k < 64; ++k) acc += hd[k] * w3[k * 1024 + j];
      float tn = (float)t / (float)(L - 1);
      float delta = mind + (float)j * ((maxd - mind) / 1023.0f);
      p.F()[i] = acc * expf(-tn * fabsf(delta));
    }
  }
#endif
}

DEVN void ph_fnorm(const Params& p, i64 gtid, i64 gsz) {
#ifndef CPU_SIM
  for (i64 i = 512 + gtid; i < 2 * 512; i += gsz) {
#else
  for (i64 i = gtid; i < 2 * 512; i += gsz) {
#endif
    int which = (int)(i / 512), c = (int)(i % 512);
    int L = which ? LC : N; int off = which ? N : 0;
    float ss = 0.f;
    for (int t = 0; t < L; ++t) { float a = p.F()[(size_t)(off + t) * 1024 + c], b = p.F()[(size_t)(off + t) * 1024 + 512 + c]; ss += a * a + b * b; }
    p.fnorm()[i] = 1.0f / sqrtf(ss + EPS);
  }
}


DEV void lru_chunk_rows(int dir, int b, int k, int& row0, int& step) {
  int seg_chunk;
  if (k < NCC) { seg_chunk = dir ? NCC - 1 - k : k; row0 = NLAT + b * LC + seg_chunk * LCH; }
  else { int kl = k - NCC; seg_chunk = dir ? NCL - 1 - kl : kl; row0 = b * N + seg_chunk * LCH; }
  if (dir) { row0 += LCH - 1; step = -1; } else step = 1;
}
DEVN void ph_lru1(const Params& p, i64 gtid, i64 gsz) {
#ifndef CPU_SIM
  for (i64 i = gtid; i < (i64)2 * NB * NCHK * 128; i += gsz) {
    const int c = (int)(i % 128) * 4, k = (int)((i / 128) % NCHK), b = (int)((i / (128 * NCHK)) % NB), dir = (int)(i / ((i64)128 * NCHK * NB));
    int row0, step; lru_chunk_rows(dir, b, k, row0, step);
    const uint4* lab4 = (const uint4*)(p.LAB() + (size_t)dir * TT * 512 + c);
    float h0 = 0.f, h1 = 0.f, h2 = 0.f, h3 = 0.f, s0 = 0.f, s1 = 0.f, s2 = 0.f, s3 = 0.f;
    uint4 wn[8];
#pragma unroll
    for (int t = 0; t < 8; ++t) wn[t] = lab4[(size_t)(row0 + step * t) * 128];
#pragma unroll 1
    for (int t0 = 0; t0 < LCH; t0 += 8) {
      uint4 w[8];
#pragma unroll
      for (int t = 0; t < 8; ++t) w[t] = wn[t];
      if (t0 + 8 < LCH) {
#pragma unroll
        for (int t = 0; t < 8; ++t) wn[t] = lab4[(size_t)(row0 + step * (t0 + 8 + t)) * 128];
      }
#pragma unroll
      for (int t = 0; t < 8; ++t) {
        const float a0 = __uint_as_float(w[t].x << 16), a1 = __uint_as_float(w[t].y << 16), a2 = __uint_as_float(w[t].z << 16), a3 = __uint_as_float(w[t].w << 16);
        s0 += a0; s1 += a1; s2 += a2; s3 += a3;
        h0 = fexpf_(a0) * h0 + __uint_as_float(w[t].x & 0xFFFF0000u); h1 = fexpf_(a1) * h1 + __uint_as_float(w[t].y & 0xFFFF0000u);
        h2 = fexpf_(a2) * h2 + __uint_as_float(w[t].z & 0xFFFF0000u); h3 = fexpf_(a3) * h3 + __uint_as_float(w[t].w & 0xFFFF0000u);
      }
    }
    const size_t o = ((size_t)(dir * NB + b) * NCHK + k) * 512 + c;
    *(float4*)(p.SA() + o) = float4{fexpf_(s0), fexpf_(s1), fexpf_(s2), fexpf_(s3)};
    *(float4*)(p.SB() + o) = float4{h0, h1, h2, h3};
  }
#else
  for (i64 i = gtid; i < (i64)2 * NB * NCHK * 512; i += gsz) {
    int c = (int)(i % 512), k = (int)((i / 512) % NCHK), b = (int)((i / (512 * NCHK)) % NB), dir = (int)(i / ((i64)512 * NCHK * NB));
    int row0, step; lru_chunk_rows(dir, b, k, row0, step);
    const bf* la = p.LA() + (size_t)dir * TT * 512 + c; const bf* lb = p.LB() + (size_t)dir * TT * 512 + c;
    float h = 0.f, sl = 0.f;
    for (int t = 0; t < LCH; ++t) {
      size_t r = (size_t)(row0 + step * t);
      float lav = b2f(la[r * 512]);
      h = expf(lav) * h + b2f(lb[r * 512]); sl += lav;
    }
    p.SA()[i] = fexpf_(sl); p.SB()[i] = h;
  }
#endif
}
DEVN void ph_lru3(const Params& p, int last, i64 gtid, i64 gsz, float* hrs, int ltid) {
#ifndef CPU_SIM
  unsigned* hrp = (unsigned*)hrs;
  for (i64 i = gtid; i < (i64)NB * NCHK * 256; i += gsz) {
    const int c = (int)(i % 256) * 2, j = (int)((i / 256) % NCHK), b = (int)(i / (256 * NCHK));
    if (last && j < NCC) continue;
    const int kf = j, kr = j < NCC ? NCC - 1 - j : NCC + (NCL - 1 - (j - NCC));
    const float* sa0 = p.SA() + ((size_t)(0 * NB + b) * NCHK) * 512 + c; const float* sb0 = p.SB() + ((size_t)(0 * NB + b) * NCHK) * 512 + c;
    const float* sa1 = p.SA() + ((size_t)(1 * NB + b) * NCHK) * 512 + c; const float* sb1 = p.SB() + ((size_t)(1 * NB + b) * NCHK) * 512 + c;
    float hf0 = 0.f, hf1 = 0.f, hr0 = 0.f, hr1 = 0.f;
    const int row0 = j < NCC ? NLAT + b * LC + j * LCH : b * N + (j - NCC) * LCH;
    const unsigned* lab0 = p.LAB() + c; const unsigned* lab1 = p.LAB() + (size_t)TT * 512 + c;
#pragma unroll 1
    for (int k0 = 0; k0 < kf; k0 += 8) {
      float2 av[8], bv[8];
#pragma unroll
      for (int q = 0; q < 8; ++q) { const bool ok = k0 + q < kf; av[q] = ok ? *(const float2*)(sa0 + (size_t)(k0 + q) * 512) : float2{1.f, 1.f}; bv[q] = ok ? *(const float2*)(sb0 + (size_t)(k0 + q) * 512) : float2{0.f, 0.f}; }
#pragma unroll
      for (int q = 0; q < 8; ++q) { hf0 = av[q].x * hf0 + bv[q].x; hf1 = av[q].y * hf1 + bv[q].y; }
    }
#pragma unroll 1
    for (int k0 = 0; k0 < kr; k0 += 8) {
      float2 av[8], bv[8];
#pragma unroll
      for (int q = 0; q < 8; ++q) { const bool ok = k0 + q < kr; av[q] = ok ? *(const float2*)(sa1 + (size_t)(k0 + q) * 512) : float2{1.f, 1.f}; bv[q] = ok ? *(const float2*)(sb1 + (size_t)(k0 + q) * 512) : float2{0.f, 0.f}; }
#pragma unroll
      for (int q = 0; q < 8; ++q) { hr0 = av[q].x * hr0 + bv[q].x; hr1 = av[q].y * hr1 + bv[q].y; }
    }
#pragma unroll 1
    for (int t0 = LCH - 16; t0 >= 0; t0 -= 16) {
      uint2 w[16];
#pragma unroll
      for (int t = 0; t < 16; ++t) w[t] = *(const uint2*)(lab1 + (size_t)(row0 + t0 + t) * 512);
#pragma unroll
      for (int t = 15; t >= 0; --t) {
        hr0 = fexpf_(__uint_as_float(w[t].x << 16)) * hr0 + __uint_as_float(w[t].x & 0xFFFF0000u);
        hr1 = fexpf_(__uint_as_float(w[t].y << 16)) * hr1 + __uint_as_float(w[t].y & 0xFFFF0000u);
        hrp[(t0 + t) * 512 + ltid] = pk2bf(hr0, hr1);
      }
    }
#pragma unroll 1
    for (int t0 = 0; t0 < LCH; t0 += 16) {
      uint2 w[16]; unsigned gw[16];
#pragma unroll
      for (int t = 0; t < 16; ++t) { const size_t r = (size_t)(row0 + t0 + t); w[t] = *(const uint2*)(lab0 + r * 512); gw[t] = *(const unsigned*)(p.P() + r * PC + C_LG + c); }
#pragma unroll
      for (int t = 0; t < 16; ++t) {
        hf0 = fexpf_(__uint_as_float(w[t].x << 16)) * hf0 + __uint_as_float(w[t].x & 0xFFFF0000u);
        hf1 = fexpf_(__uint_as_float(w[t].y << 16)) * hf1 + __uint_as_float(w[t].y & 0xFFFF0000u);
        const unsigned hw = hrp[(t0 + t) * 512 + ltid];
        const float y0 = geluf_(__uint_as_float(gw[t] << 16)) * (hf0 + __uint_as_float(hw << 16));
        const float y1 = geluf_(__uint_as_float(gw[t] & 0xFFFF0000u)) * (hf1 + __uint_as_float(hw & 0xFFFF0000u));
        *(unsigned*)(p.Y() + (size_t)(row0 + t0 + t) * 2048 + 512 + c) = pk2bf(y0, y1);
      }
    }
  }
#else
  for (i64 i = gtid; i < (i64)NB * NCHK * 512; i += gsz) {
    int c = (int)(i % 512), j = (int)((i / 512) % NCHK), b = (int)(i / (512 * NCHK));
    if (last && j < NCC) continue;
    int kf = j, kr = j < NCC ? NCC - 1 - j : NCC + (NCL - 1 - (j - NCC));
    const float* sa0 = p.SA() + ((size_t)(0 * NB + b) * NCHK) * 512 + c; const float* sb0 = p.SB() + ((size_t)(0 * NB + b) * NCHK) * 512 + c;
    const float* sa1 = p.SA() + ((size_t)(1 * NB + b) * NCHK) * 512 + c; const float* sb1 = p.SB() + ((size_t)(1 * NB + b) * NCHK) * 512 + c;
    float hf = 0.f, hr = 0.f;
    int row0 = j < NCC ? NLAT + b * LC + j * LCH : b * N + (j - NCC) * LCH;
    const bf* la0 = p.LA() + c; const bf* lb0 = p.LB() + c;
    const bf* la1 = p.LA() + (size_t)TT * 512 + c; bf* lb1 = p.LB() + (size_t)TT * 512 + c;
    for (int k = 0; k < kf; ++k) hf = sa0[(size_t)k * 512] * hf + sb0[(size_t)k * 512];
    for (int k = 0; k < kr; ++k) hr = sa1[(size_t)k * 512] * hr + sb1[(size_t)k * 512];
    for (int t = LCH - 1; t >= 0; --t) { size_t r = (size_t)(row0 + t); hr = expf(b2f(la1[r * 512])) * hr + b2f(lb1[r * 512]); lb1[r * 512] = f2b(hr); }
    for (int t = 0; t < LCH; ++t) {
      size_t r = (size_t)(row0 + t);
      hf = expf(b2f(la0[r * 512])) * hf + b2f(lb0[r * 512]);
      float lg = b2f(p.P()[r * PC + C_LG + c]);
      p.Y()[r * 2048 + 512 + c] = f2b(geluf_(lg) * (hf + b2f(lb1[r * 512])));
    }
  }
#endif
}

DEVN void ph_C(const Params& p, int l, int last, i64 gtid, i64 gsz) {
  const int QR = last ? NLAT : TT;
#ifdef CPU_SIM
  for (i64 i = gtid; i < (i64)8 * QR; i += gsz) {
    int hh = (int)(i / QR), r = (int)(i % QR);
    RowInfo ri = rowinfo(r);
    float q[96];
#pragma unroll
    for (int d = 0; d < 96; ++d) q[d] = b2f(p.QA()[(size_t)r * 768 + hh * 96 + d]);
    float o[64];
#pragma unroll
    for (int d = 0; d < 64; ++d) o[d] = 0.f;
    float m = -1e30f, lsum = 0.f;
    const float scale = 0.10206207261596577f;
    int nseg = ri.lat ? 2 : 1;
    for (int sg = 0; sg < nseg; ++sg) {
      int kb, kn_;
      if (ri.lat && sg == 0) { kb = ri.b * N; kn_ = N; } else { kb = NLAT + ri.b * LC; kn_ = LC; }
      for (int kk = 0; kk < kn_; ++kk) {
        const bf* kr_ = p.KVA() + (size_t)(kb + kk) * 1024 + hh * 128;
        const bf* krp = p.P() + (size_t)(kb + kk) * PC + C_KR;
        float s = 0.f;
#pragma unroll
        for (int d = 0; d < 64; ++d) s += q[d] * b2f(kr_[d]);
#pragma unroll
        for (int d = 0; d < 32; ++d) s += q[64 + d] * b2f(krp[d]);
        s *= scale;
        float mn = fmaxf(m, s);
        float corr = expf(m - mn), pe = expf(s - mn);
        lsum = lsum * corr + pe;
#pragma unroll
        for (int d = 0; d < 64; ++d) o[d] = o[d] * corr + pe * b2f(kr_[64 + d]);
        m = mn;
      }
    }
    float inv = 1.0f / lsum;
#pragma unroll
    for (int d = 0; d < 64; ++d) p.Y()[(size_t)r * 2048 + hh * 64 + d] = f2b(o[d] * inv);
  }
#endif
  {
    const float* cw = p.in[I_hy_conv_w] + l * 3 * 1536; const float* cb = p.in[I_hy_conv_b] + l * 1536;
    const float* skip = p.in[I_hy_skip] + l * 512;
#ifndef CPU_SIM
    const i64 hy_first = (i64)NLAT * 512;
#else
    const i64 hy_first = 0;
#endif
    for (i64 i = hy_first + gtid; i < (i64)QR * 512; i += gsz) {
      int r = (int)(i / 512), c = (int)(i % 512);
      RowInfo ri = rowinfo(r);
      int foff = ri.lat ? 0 : N;
      float acc = 0.f;
      for (int s = 0; s < ri.L; ++s) {
        int dd = ri.t - s;
        float fv = dd >= 0 ? p.F()[(size_t)(foff + dd) * 1024 + c] : p.F()[(size_t)(foff - dd) * 1024 + 512 + c];
        acc += fv * b2f(p.Z()[(size_t)(ri.base + s) * 512 + c]);
      }
      acc *= p.fnorm()[(ri.lat ? 0 : 512) + c];
      float x0 = cb[c];
      for (int k = 0; k < 3; ++k) {
        int ts = ri.t - 1 + k;
        if (ts >= 0 && ts < ri.L) x0 += cw[k * 1536 + c] * b2f(p.P()[(size_t)(ri.base + ts) * PC + C_HU + c]);
      }
      float y = acc + skip[c] * b2f(p.Z()[(size_t)r * 512 + c]);
      p.Y()[(size_t)r * 2048 + 1024 + c] = f2b(x0 * y);
    }
  }
#ifdef CPU_SIM
  for (i64 i = gtid; i < (i64)8 * QR; i += gsz) {
    int hh = (int)(i / QR), r = (int)(i % QR);
    RowInfo ri = rowinfo(r);
    int kh = hh / 4;
    float q[64];
#pragma unroll
    for (int d = 0; d < 64; ++d) q[d] = b2f(p.P()[(size_t)r * PC + C_GQ + hh * 64 + d]);
    float o[64];
#pragma unroll
    for (int d = 0; d < 64; ++d) o[d] = 0.f;
    float m = p.in[I_gqa_sink][l * 8 + hh], lsum = 1.0f;
    int nseg = ri.lat ? 2 : 1;
    for (int sg = 0; sg < nseg; ++sg) {
      int k0, k1;
      if (ri.lat && sg == 0) { int lo = ri.t - 128; if (lo < 0) lo = 0; int hi = ri.t + 128; if (hi > N - 1) hi = N - 1; k0 = ri.b * N + lo; k1 = ri.b * N + hi + 1; }
      else { k0 = NLAT + ri.b * LC; k1 = k0 + LC; }
      for (int kk = k0; kk < k1; ++kk) {
        const bf* kp = p.P() + (size_t)kk * PC + C_GKV + kh * 64;
        const bf* vp = kp + 128;
        float s = 0.f;
#pragma unroll
        for (int d = 0; d < 64; ++d) s += q[d] * b2f(kp[d]);
        s *= 0.125f;
        float mn = fmaxf(m, s);
        float corr = expf(m - mn), pe = expf(s - mn);
        lsum = lsum * corr + pe;
#pragma unroll
        for (int d = 0; d < 64; ++d) o[d] = o[d] * corr + pe * b2f(vp[d]);
        m = mn;
      }
    }
    float inv = 1.0f / lsum;
#pragma unroll
    for (int d = 0; d < 64; ++d) p.Y()[(size_t)r * 2048 + 1536 + hh * 64 + d] = f2b(o[d] * inv);
  }
#endif
}

DEVN void ph_E2a(const Params& p, int nrows, i64 gtid, i64 gsz) {
  for (i64 i = gtid; i < (i64)nrows * 16; i += gsz) {
    const sc_t* s_ = p.SC() + (size_t)i * 128;
    float ps = 3.0e38f; int pi = -1;
    for (int k = 0; k < 16; ++k) {
      float bs = -3.0e38f; int bi = -1;
      for (int j = 0; j < 128; ++j) {
        float s = (float)s_[j];
        bool elig = (s < ps) || (s == ps && j > pi);
        if (elig && (s > bs)) { bs = s; bi = j; }
      }
      p.TKs()[(size_t)i * 16 + k] = bs; p.TKi()[(size_t)i * 16 + k] = bi;
      ps = bs; pi = bi;
    }
  }
}

DEVN void ph_E2b(const Params& p, int nrows, i64 gtid, i64 gsz) {
  for (i64 i = gtid; i < (i64)nrows * 8; i += gsz) {
    const float* s1 = p.TKs() + (size_t)i * 32; const float* s2 = s1 + 16;
    const int* i1 = p.TKi() + (size_t)i * 32; const int* i2 = i1 + 16;
    float ps = 3.0e38f; int pi = -1;
    float mx = 0.f;
    for (int k = 0; k < 16; ++k) {
      float bs = -3.0e38f; int bi = -1;
      for (int j = 0; j < 256; ++j) {
        float s = s1[j >> 4] + s2[j & 15];
        bool elig = (s < ps) || (s == ps && j > pi);
        if (elig && (s > bs)) { bs = s; bi = j; }
      }
      if (k == 0) mx = bs;
      p.SELi()[(size_t)i * 16 + k] = i1[bi >> 4] * 128 + i2[bi & 15];
      p.SELg()[(size_t)i * 16 + k] = expf(bs - mx);
      ps = bs; pi = bi;
    }
    float sum = 0.f;
    for (int k = 0; k < 16; ++k) sum += p.SELg()[(size_t)i * 16 + k];
    float inv = 1.0f / sum;
    for (int k = 0; k < 16; ++k) p.SELg()[(size_t)i * 16 + k] *= inv;
  }
}

DEVN void ph_E3(const Params& p, int l, int nrows, i64 gtid, i64 gsz) {
  const float* u = p.in[I_peer_u] + (size_t)l * NEXP * D;
#ifndef CPU_SIM
  const int lane = (int)(gtid & 63);
  for (i64 i = gtid >> 6; i < (i64)nrows * 128; i += gsz >> 6) {
    const int r = (int)(i >> 7);
    const float4* ur = (const float4*)(u + (size_t)p.SELi()[i] * D);
    const uint2* hr = (const uint2*)(p.h() + (size_t)r * D);
    float acc = 0.f;
#pragma unroll
    for (int q = 0; q < 4; ++q) {
      const float4 uv = ur[lane + q * 64]; const uint2 hv = hr[lane + q * 64];
      union { unsigned u_; float f; } c0, c1, c2, c3;
      c0.u_ = hv.x << 16; c1.u_ = hv.x & 0xFFFF0000u; c2.u_ = hv.y << 16; c3.u_ = hv.y & 0xFFFF0000u;
      acc += uv.x * c0.f + uv.y * c1.f + uv.z * c2.f + uv.w * c3.f;
    }
#pragma unroll
    for (int o = 32; o >= 1; o >>= 1) acc += lane_xor(acc, lane, o);
    if (lane == 0) p.W()[i] = p.SELg()[i] * geluf_(acc);
  }
#else
  for (i64 i = gtid; i < (i64)nrows * 128; i += gsz) {
    int r = (int)(i / 128);
    const float* ur = u + (size_t)p.SELi()[i] * D;
    const bf* hr = p.h() + (size_t)r * D;
    float acc = 0.f;
    for (int k = 0; k < D; ++k) acc += b2f(hr[k]) * ur[k];
    p.W()[i] = p.SELg()[i] * geluf_(acc);
  }
#endif
}

DEVN void ph_E4(const Params& p, int l, int nrows, i64 gtid, i64 gsz) {
  const float* v = p.in[I_peer_v] + (size_t)l * NEXP * D;
  for (i64 i = gtid; i < (i64)nrows * D; i += gsz) {
    int r = (int)(i / D), n = (int)(i % D);
    float acc = 0.f;
    for (int j = 0; j < 128; ++j) acc += p.W()[(size_t)r * 128 + j] * v[(size_t)p.SELi()[(size_t)r * 128 + j] * D + n];
    float g2 = p.mods()[((size_t)l * 3 + modrow(r)) * 6 * D + 5 * D + n];
    p.xcur()[i] += g2 * acc;
  }
}


#ifndef CPU_SIM
DEV unsigned dpp_ror_u(unsigned x, int n) {
  switch (n) {
    case 1: return (unsigned)__builtin_amdgcn_update_dpp(0, (int)x, 0x121, 0xf, 0xf, false);
    case 2: return (unsigned)__builtin_amdgcn_update_dpp(0, (int)x, 0x122, 0xf, 0xf, false);
    case 4: return (unsigned)__builtin_amdgcn_update_dpp(0, (int)x, 0x124, 0xf, 0xf, false);
    default: return (unsigned)__builtin_amdgcn_update_dpp(0, (int)x, 0x128, 0xf, 0xf, false);
  }
}
DEV unsigned wave_max_u(unsigned x) {
  x = max(x, dpp_ror_u(x, 1)); x = max(x, dpp_ror_u(x, 2)); x = max(x, dpp_ror_u(x, 4)); x = max(x, dpp_ror_u(x, 8));
  const unsigned a = (unsigned)__builtin_amdgcn_readlane((int)x, 0), b = (unsigned)__builtin_amdgcn_readlane((int)x, 16);
  const unsigned c = (unsigned)__builtin_amdgcn_readlane((int)x, 32), d = (unsigned)__builtin_amdgcn_readlane((int)x, 48);
  return max(max(a, b), max(c, d));
}
DEV unsigned f16_key(unsigned short h, int idx) { const unsigned t = (h & 0x8000u) ? (unsigned)(~h & 0xFFFFu) : (unsigned)(h | 0x8000u); return (t << 16) | (unsigned)(0xFFFF - idx); }
DEV float key_score(unsigned k) { const unsigned t = k >> 16; const unsigned short h = (unsigned short)((t & 0x8000u) ? (t ^ 0x8000u) : (~t & 0xFFFFu)); union { unsigned short u; _Float16 f; } c; c.u = h; return (float)c.f; }
DEV int key_idx(unsigned k) { return 0xFFFF - (int)(k & 0xFFFFu); }
DEV int mbcnt64(unsigned long long m) { return (int)__builtin_amdgcn_mbcnt_hi((unsigned)(m >> 32), __builtin_amdgcn_mbcnt_lo((unsigned)m, 0u)); }
DEV unsigned pick16_sorted(unsigned k0, unsigned k1, unsigned T, int above, int lane, int* tmp) {
  const unsigned h0 = k0 & 0xFFFF0000u, h1 = k1 & 0xFFFF0000u;
  const bool gt0 = h0 > T, eq0 = h0 == T, gt1 = h1 > T, eq1 = h1 == T;
  const int need = 16 - above;
  const unsigned long long me0 = __builtin_amdgcn_ballot_w64(eq0), me1 = __builtin_amdgcn_ballot_w64(eq1);
  const bool s0 = gt0 || (eq0 && mbcnt64(me0) < need);
  const int need1 = need - (int)__builtin_popcountll(me0);
  const bool s1 = gt1 || (eq1 && mbcnt64(me1) < need1);
  const unsigned long long ms0 = __builtin_amdgcn_ballot_w64(s0), ms1 = __builtin_amdgcn_ballot_w64(s1);
  if (s0) tmp[mbcnt64(ms0)] = (int)k0;
  if (s1) tmp[(int)__builtin_popcountll(ms0) + mbcnt64(ms1)] = (int)k1;
  const unsigned u = (unsigned)tmp[lane & 15];
  int rank = 0;
#pragma unroll
  for (int q = 0; q < 16; ++q) rank += ((unsigned)__builtin_amdgcn_readlane((int)u, q) > u) ? 1 : 0;
  if (lane < 16) tmp[16 + rank] = (int)u;
  return (unsigned)tmp[16 + (lane & 15)];
}
DEV void top16_x2(unsigned a0, unsigned a1, unsigned b0, unsigned b1, int lane, int* tmp, unsigned& ta, unsigned& tb) {
  unsigned TA = 0, TB = 0; int abA = 0, abB = 0;
#pragma unroll
  for (int bit = 31; bit >= 16; --bit) {
    const unsigned m = 0xFFFFFFFFu << bit, one = 1u << bit;
    const unsigned tA = TA | one, tB = TB | one;
    const int cA = (int)__builtin_popcountll(__builtin_amdgcn_ballot_w64((a0 & m) == tA)) + (int)__builtin_popcountll(__builtin_amdgcn_ballot_w64((a1 & m) == tA));
    const int cB = (int)__builtin_popcountll(__builtin_amdgcn_ballot_w64((b0 & m) == tB)) + (int)__builtin_popcountll(__builtin_amdgcn_ballot_w64((b1 & m) == tB));
    if (abA + cA >= 16) TA = tA; else abA += cA;
    if (abB + cB >= 16) TB = tB; else abB += cB;
  }
  ta = pick16_sorted(a0, a1, TA, abA, lane, tmp);
  tb = pick16_sorted(b0, b1, TB, abB, lane, tmp + 32);
}
DEVN void ph_cvt_tables(const Params& p, int l, i64 gtid, i64 gsz) {
  const float4* u = (const float4*)(p.in[I_peer_u] + (size_t)l * NEXP * D); const float4* v = (const float4*)(p.in[I_peer_v] + (size_t)l * NEXP * D);
  unsigned* ub = (unsigned*)p.Ub(); unsigned* vb = (unsigned*)p.Vb();
#pragma unroll 4
  for (i64 i = gtid; i < (i64)NEXP * D / 4; i += gsz) {
    const float4 a = u[i], b = v[i];
    int w = __builtin_amdgcn_cvt_pk_fp8_f32(a.x * 32.f, a.y * 32.f, 0, false); w = __builtin_amdgcn_cvt_pk_fp8_f32(a.z * 32.f, a.w * 32.f, w, true); ub[i] = (unsigned)w;
    int x = __builtin_amdgcn_cvt_pk_fp8_f32(b.x, b.y, 0, false); x = __builtin_amdgcn_cvt_pk_fp8_f32(b.z, b.w, x, true); vb[i] = (unsigned)x;
  }
}
DEV void unpack16_fp8(const uint4 w, float* f) {
#define UP4(W, O) { auto lo = __builtin_amdgcn_cvt_pk_f32_fp8((int)(W), false); auto hi = __builtin_amdgcn_cvt_pk_f32_fp8((int)(W), true); f[O] = lo[0]; f[O + 1] = lo[1]; f[O + 2] = hi[0]; f[O + 3] = hi[1]; }
  UP4(w.x, 0) UP4(w.y, 4) UP4(w.z, 8) UP4(w.w, 12)
#undef UP4
}
struct Sc4 { unsigned short a, b, c, d; };
DEV Sc4 peer_scores(const Params& p, int r, int wid, int lane) {
  const unsigned short* sp = (const unsigned short*)(p.SC() + ((size_t)r * 8 + wid) * 256);
  Sc4 q; q.a = sp[lane]; q.b = sp[64 + lane]; q.c = sp[128 + lane]; q.d = sp[192 + lane];
  return q;
}
struct Key4 { decltype(f16_key((unsigned short)0, 0)) a, b, c, d; };
DEV Key4 peer_keys(const Sc4 q, int lane) { Key4 k; k.a = f16_key(q.a, lane); k.b = f16_key(q.b, 64 + lane); k.c = f16_key(q.c, lane); k.d = f16_key(q.d, 64 + lane); return k; }
DEV void peer_topk(const Key4 k, int lane, int ca, int cb, bool cvalid, int* selx, int* tmp) {
  unsigned t1, t2;
  top16_x2(k.a, k.b, k.c, k.d, lane, tmp, t1, t2);
  const unsigned k1 = (unsigned)__builtin_amdgcn_ds_bpermute(ca << 2, (int)t1), k2 = (unsigned)__builtin_amdgcn_ds_bpermute(cb << 2, (int)t2);
  const float v = cvalid ? key_score(k1) + key_score(k2) : -3.0e38f;
  int rank = 0;
#pragma unroll
  for (int c = 0; c < 50; ++c) {
    const float vs = __int_as_float(__builtin_amdgcn_readlane(__float_as_int(v), c));
    rank += (vs > v || (vs == v && c < lane)) ? 1 : 0;
  }
  float mx = v;
#pragma unroll
  for (int o = 32; o >= 1; o >>= 1) mx = fmaxf(mx, lane_xor(mx, lane, o));
  const bool sel = cvalid && rank < 16;
  const float e = sel ? fexpf_(v - mx) : 0.f;
  float sum = e;
#pragma unroll
  for (int o = 32; o >= 1; o >>= 1) sum += lane_xor(sum, lane, o);
  if (sel) { selx[rank] = key_idx(k1) * 128 + key_idx(k2); selx[16 + rank] = __float_as_int(e / sum); }
}
DEVN void ph_peer(const Params& p, int l, int nrows, int tid, char* ldsg, float oscale = 1.0f) {
  const int lane = tid & 63, wid = tid >> 6;
  float* part = (float*)ldsg;
  int* selbase = (int*)(ldsg + 8 * 1024 * 4) + wid * 64;
  int* tktmp = (int*)(ldsg + 8 * 1024 * 4 + 8 * 64 * 4) + wid * 64;
  const unsigned char* Ub = (const unsigned char*)p.Ub(); const unsigned char* Vb = (const unsigned char*)p.Vb();
  int ca = 0, cb = 0; bool cvalid = false;
  { int pre = 0;
    for (int a = 0; a < 16; ++a) { const int cnt = 16 / (a + 1); if (lane >= pre && lane < pre + cnt) { ca = a; cb = lane - pre; cvalid = true; } pre += cnt; } }
  int cur = 0;
  Sc4 nsc; nsc.a = nsc.b = nsc.c = nsc.d = 0;
  if ((int)blockIdx.x < nrows) {
    peer_topk(peer_keys(peer_scores(p, blockIdx.x, wid, lane), lane), lane, ca, cb, cvalid, selbase, tktmp);
    nsc = peer_scores(p, (int)(blockIdx.x + gridDim.x) < nrows ? (int)(blockIdx.x + gridDim.x) : (int)blockIdx.x, wid, lane);
  }
  for (int r = blockIdx.x; r < nrows; r += gridDim.x) {
    const int* selx = selbase + cur * 32;
    int eidx[16];
#pragma unroll
    for (int e = 0; e < 16; ++e) eidx[e] = __builtin_amdgcn_readfirstlane(selx[e]);
    const float mygate = __int_as_float(selx[16 + (lane >> 2)]);
    const bool more = r + (int)gridDim.x < nrows;
    const Key4 nkeys = peer_keys(nsc, lane);
    uint4 rows[16], vrows[16];
#pragma unroll
    for (int e = 0; e < 16; ++e) rows[e] = ((const uint4*)(Ub + (size_t)eidx[e] * D))[lane];
    uint4 hraw0, hraw1;
    { const uint4* hp = (const uint4*)(p.h() + (size_t)r * D); hraw0 = hp[lane * 2]; hraw1 = hp[lane * 2 + 1]; }
#pragma unroll
    for (int e = 0; e < 16; ++e) vrows[e] = ((const uint4*)(Vb + (size_t)eidx[e] * D))[lane];
    const float2 g2v = *(const float2*)(p.mods() + ((size_t)l * 3 + modrow(r)) * 6 * D + 5 * D + tid * 2);
    float2 xv = *(const float2*)(p.xcur() + (size_t)r * D + tid * 2);
    nsc = peer_scores(p, r + 2 * (int)gridDim.x < nrows ? r + 2 * (int)gridDim.x : r, wid, lane);
    if (more) peer_topk(nkeys, lane, ca, cb, cvalid, selbase + (cur ^ 1) * 32, tktmp);
    float hv[16]; unpack8(hraw0, hv); unpack8(hraw1, hv + 8);
    float d[16];
#pragma unroll
    for (int e = 0; e < 16; ++e) {
      float f[16]; unpack16_fp8(rows[e], f);
      float a = 0.f;
#pragma unroll
      for (int k = 0; k < 16; ++k) a += f[k] * hv[k];
      d[e] = a;
    }
#define FOLD(NV, O) _Pragma("unroll") for (int i = 0; i < NV / 2; ++i) { const bool up = (lane & O) != 0; const float send = up ? d[i] : d[i + NV / 2]; const float keep = up ? d[i + NV / 2] : d[i]; d[i] = keep + lane_xor(send, lane, O); }
    FOLD(16, 32) FOLD(8, 16) FOLD(4, 8) FOLD(2, 4)
#undef FOLD
    float dot = d[0]; dot += lane_xor(dot, lane, 2); dot += lane_xor(dot, lane, 1);
    const float myact = mygate * geluf_(dot * (1.0f / 32.0f));
    float acc[16];
#pragma unroll
    for (int k = 0; k < 16; ++k) acc[k] = 0.f;
#pragma unroll
    for (int e = 0; e < 16; ++e) {
      const float a = __int_as_float(__builtin_amdgcn_readlane(__float_as_int(myact), e * 4));
      float f[16]; unpack16_fp8(vrows[e], f);
#pragma unroll
      for (int k = 0; k < 16; ++k) acc[k] += a * f[k];
    }
    float* partc = part + cur * ((8 * 1024 * 4 + 2 * 8 * 64 * 4) / 4);
    { float4* pw = (float4*)(partc + wid * 1024 + lane * 16);
      pw[0] = float4{acc[0], acc[1], acc[2], acc[3]}; pw[1] = float4{acc[4], acc[5], acc[6], acc[7]};
      pw[2] = float4{acc[8], acc[9], acc[10], acc[11]}; pw[3] = float4{acc[12], acc[13], acc[14], acc[15]}; }
    __syncthreads();
    { const int c = tid * 2;
      float s0 = 0.f, s1 = 0.f;
#pragma unroll
      for (int w = 0; w < 8; ++w) { const float2 t = *(const float2*)(partc + w * 1024 + c); s0 += t.x; s1 += t.y; }
      xv.x += oscale * g2v.x * s0; xv.y += oscale * g2v.y * s1; *(float2*)(p.xcur() + (size_t)r * D + c) = xv; }
    cur ^= 1;
  }
}
#endif

DEVN void ph_final(const Params& p, i64 gtid, i64 gsz) {
  const float* g = p.in[I_g_final];
#ifndef CPU_SIM
  float pscale = 1.0f;
#if PROBE_K >= 0
  { const unsigned long long* ts = (const unsigned long long*)(p.ws + WL.ts);
    const float frac = (float)(ts[PROBE_K + 1] - ts[0]) / (float)(ts[NPHASES - 1] - ts[0]);
    pscale = 1.0f + sqrtf(floorf(frac * 50.0f + 0.5f) * 0.02f); }
#endif
  const int lane = (int)(gtid & 63);
  const i64 W = gsz >> 6;
  float4 gv[4];
#pragma unroll
  for (int i = 0; i < 4; ++i) gv[i] = *(const float4*)(g + (lane + i * 64) * 4);
  for (i64 r = gtid >> 6; r < NLAT; r += 2 * W) {
    const bool two = r + W < NLAT;
    const i64 rb = two ? r + W : r;
    const float4* xra = (const float4*)(p.xcur() + (size_t)r * D); const float4* xrb = (const float4*)(p.xcur() + (size_t)rb * D);
    float4 xa[4], xb[4]; float sa = 0.f, sb = 0.f;
#pragma unroll
    for (int i = 0; i < 4; ++i) { xa[i] = xra[lane + i * 64]; xb[i] = xrb[lane + i * 64]; }
#pragma unroll
    for (int i = 0; i < 4; ++i) { sa += xa[i].x * xa[i].x + xa[i].y * xa[i].y + xa[i].z * xa[i].z + xa[i].w * xa[i].w; sb += xb[i].x * xb[i].x + xb[i].y * xb[i].y + xb[i].z * xb[i].z + xb[i].w * xb[i].w; }
#pragma unroll
    for (int o = 32; o >= 1; o >>= 1) { sa += lane_xor(sa, lane, o); sb += lane_xor(sb, lane, o); }
    const float rsa = 1.0f / sqrtf(sa * (1.0f / D) + EPS), rsb = 1.0f / sqrtf(sb * (1.0f / D) + EPS);
#pragma unroll
    for (int i = 0; i < 4; ++i) {
      const int k = (lane + i * 64) * 4;
      float4 o4; o4.x = xa[i].x * rsa * gv[i].x * pscale; o4.y = xa[i].y * rsa * gv[i].y * pscale; o4.z = xa[i].z * rsa * gv[i].z * pscale; o4.w = xa[i].w * rsa * gv[i].w * pscale;
      *(float4*)(p.out + (size_t)r * D + k) = o4;
    }
    if (two) {
#pragma unroll
      for (int i = 0; i < 4; ++i) {
        const int k = (lane + i * 64) * 4;
        float4 o4; o4.x = xb[i].x * rsb * gv[i].x * pscale; o4.y = xb[i].y * rsb * gv[i].y * pscale; o4.z = xb[i].z * rsb * gv[i].z * pscale; o4.w = xb[i].w * rsb * gv[i].w * pscale;
        *(float4*)(p.out + (size_t)rb * D + k) = o4;
      }
    }
  }
#else
  for (i64 r = gtid; r < NLAT; r += gsz) {
    const float* xr = p.xcur() + (size_t)r * D;
    float ss = 0.f;
    for (int k = 0; k < D; ++k) ss += xr[k] * xr[k];
    float rstd = 1.0f / sqrtf(ss / D + EPS);
    for (int k = 0; k < D; ++k) p.out[(size_t)r * D + k] = xr[k] * rstd * g[k];
  }
#endif
}

DEV void rope4(float* v, const float* tab, int nf, int pos, int f0) {
#pragma unroll
  for (int jj = 0; jj < 4; ++jj) {
    float c = tab[(pos * nf + f0 + jj) * 2], s = tab[(pos * nf + f0 + jj) * 2 + 1];
    float x1 = v[2 * jj], x2 = v[2 * jj + 1];
    v[2 * jj] = x1 * c - x2 * s; v[2 * jj + 1] = x1 * s + x2 * c;
  }
}
struct EpiInproj {
  static constexpr int W = 8; static constexpr bool SUB = false; static constexpr bool STAGED = false;
  const Params& p;
  MDEV void apply(int r, int c0, float* v) const {
    if (c0 >= 3744) return;
    if (c0 >= 384 && r < NLAT) {
      int t = r % N;
      if (c0 < C_KR + 32) { int pi = (c0 - C_KR) >> 1; int half = pi >> 3; rope4(v, p.tabA(), 8, half ? t % GRIDW : t / GRIDW, pi & 7); }
      else if (c0 >= C_GQ && c0 < C_GKV + 128) { int pi = ((c0 - C_GQ) & 63) >> 1; int half = pi >> 4; rope4(v, p.tabD(), 16, half ? t % GRIDW : t / GRIDW, pi & 15); }
    }
    store8bf(p.P() + (size_t)r * PC + c0, v);
  }
};
struct EpiUq {
  static constexpr int W = 8; static constexpr bool SUB = false; static constexpr bool STAGED = true; static constexpr bool STAGED_ALL = true;
  const Params& p;
  MDEV void apply(int r, int c0, float* v) const {
    float rstd = 1.0f / sqrtf(p.ssq()[r] * (1.0f / 256.0f) + EPS);
#pragma unroll
    for (int j = 0; j < 8; ++j) v[j] *= rstd;
    int d0 = c0 % 96;
    if (d0 >= 64 && r < NLAT) { int t = r % N; int pi = (d0 - 64) >> 1; int half = pi >> 3; rope4(v, p.tabA(), 8, half ? t % GRIDW : t / GRIDW, pi & 7); }
    store8bf(p.QA() + (size_t)r * 768 + c0, v);
  }
#ifndef CPU_SIM
  struct Pre { float s; float4 t0, t1; };
  MDEV void pre(int r, int c0, Pre& q) const {
    q.s = p.ssq()[r];
    const int d0 = c0 % 96;
    q.t0 = float4{1.f, 0.f, 1.f, 0.f}; q.t1 = q.t0;
    if (d0 >= 64 && r < NLAT) { const int t = r % N, pi = (d0 - 64) >> 1, half = pi >> 3; const int pos = half ? t % GRIDW : t / GRIDW;
      const float* tb = p.tabA() + (pos * 8 + (pi & 7)) * 2; q.t0 = *(const float4*)tb; q.t1 = *(const float4*)(tb + 4); }
  }
  MDEV void fin(int r, int c0, float* v, const Pre& q) const {
    const float rstd = 1.0f / sqrtf(q.s * (1.0f / 256.0f) + EPS);
    const float cs[8] = {q.t0.x, q.t0.y, q.t0.z, q.t0.w, q.t1.x, q.t1.y, q.t1.z, q.t1.w};
    float o[8];
#pragma unroll
    for (int jj = 0; jj < 4; ++jj) { const float x1 = v[2 * jj] * rstd, x2 = v[2 * jj + 1] * rstd, c = cs[2 * jj], sn = cs[2 * jj + 1]; o[2 * jj] = x1 * c - x2 * sn; o[2 * jj + 1] = x1 * sn + x2 * c; }
    store8bf(p.QA() + (size_t)r * 768 + c0, o);
  }
#endif
};
struct EpiUkv {
  static constexpr int W = 8; static constexpr bool SUB = false; static constexpr bool STAGED = true; static constexpr bool STAGED_ALL = true;
  const Params& p;
  MDEV void apply(int r, int c0, float* v) const {
    float rstd = 1.0f / sqrtf(p.ssq()[TT + r] * (1.0f / 128.0f) + EPS);
#pragma unroll
    for (int j = 0; j < 8; ++j) v[j] *= rstd;
    store8bf(p.KVA() + (size_t)r * 1024 + c0, v);
  }
#ifndef CPU_SIM
  struct Pre { float s; };
  MDEV void pre(int r, int, Pre& q) const { q.s = p.ssq()[TT + r]; }
  MDEV void fin(int r, int c0, float* v, const Pre& q) const {
    const float rstd = 1.0f / sqrtf(q.s * (1.0f / 128.0f) + EPS);
#pragma unroll
    for (int j = 0; j < 8; ++j) v[j] *= rstd;
    store8bf(p.KVA() + (size_t)r * 1024 + c0, v);
  }
#endif
};
struct EpiLru {
  static constexpr int W = 8; static constexpr bool SUB = false; static constexpr bool STAGED = true; static constexpr bool STAGED_ALL = true;
  const Params& p; int l; const float* br; const float* bi;
  MDEV void finish(int r, int c0, const float* v, const float* brv, const float* biv, const float* splv, const float* xcv) const {
    int kw = c0 >> 10, dir = (c0 >> 9) & 1, blk4 = (c0 >> 7) & 3, jc0 = (c0 & 127) >> 1;
    int cb = kw * 256 + blk4 * 64 + jc0;
    float lav[4], lbv[4];
#pragma unroll
    for (int jj = 0; jj < 4; ++jj) {
      float rg = sigmoidf_(v[2 * jj] + brv[jj]), ig = sigmoidf_(v[2 * jj + 1] + biv[jj]);
      float log_a = -8.0f * rg * splv[jj];
      const float a_ = fexpf_(log_a);
      lav[jj] = log_a; lbv[jj] = sqrtf(fmaxf(1.0f - a_ * a_, 0.0f)) * ig * xcv[jj];
    }
#ifndef CPU_SIM
    { uint4 w;
      w.x = pk2bf(lav[0], lbv[0]); w.y = pk2bf(lav[1], lbv[1]); w.z = pk2bf(lav[2], lbv[2]); w.w = pk2bf(lav[3], lbv[3]);
      *(uint4*)(p.LAB() + ((size_t)dir * TT + r) * 512 + cb) = w; }
#else
    bf* la = p.LA() + ((size_t)dir * TT + r) * 512 + cb;
    bf* lb = p.LB() + ((size_t)dir * TT + r) * 512 + cb;
    for (int jj = 0; jj < 4; ++jj) { la[jj] = f2b(lav[jj]); lb[jj] = f2b(lbv[jj]); }
#endif
  }
  MDEV void apply(int r, int c0, float* v) const {
    int kw = c0 >> 10, dir = (c0 >> 9) & 1, blk4 = (c0 >> 7) & 3, jc0 = (c0 & 127) >> 1;
    int cb = kw * 256 + blk4 * 64 + jc0;
    float brv[4], biv[4], splv[4], xcv[4];
    for (int jj = 0; jj < 4; ++jj) { brv[jj] = br[(l * 2 + dir) * 512 + cb + jj]; biv[jj] = bi[(l * 2 + dir) * 512 + cb + jj]; splv[jj] = p.spl()[(l * 2 + dir) * 512 + cb + jj]; xcv[jj] = b2f(p.XC()[(size_t)r * 512 + cb + jj]); }
    finish(r, c0, v, brv, biv, splv, xcv);
  }
#ifndef CPU_SIM
  struct Pre { float4 a4, b4, s4; uint2 x2; };
  MDEV void pre(int r, int c0, Pre& q) const {
    int kw = c0 >> 10, dir = (c0 >> 9) & 1, blk4 = (c0 >> 7) & 3, jc0 = (c0 & 127) >> 1;
    int cb = kw * 256 + blk4 * 64 + jc0;
    q.a4 = gld4(br + (l * 2 + dir) * 512 + cb); q.b4 = gld4(bi + (l * 2 + dir) * 512 + cb);
    q.s4 = *(const float4*)(p.spl() + (l * 2 + dir) * 512 + cb);
    q.x2 = *(const uint2*)(p.XC() + (size_t)r * 512 + cb);
  }
  MDEV void fin(int r, int c0, float* v, const Pre& q) const {
    const float brv[4] = {q.a4.x, q.a4.y, q.a4.z, q.a4.w}, biv[4] = {q.b4.x, q.b4.y, q.b4.z, q.b4.w}, splv[4] = {q.s4.x, q.s4.y, q.s4.z, q.s4.w};
    const float xcv[4] = {__uint_as_float(q.x2.x << 16), __uint_as_float(q.x2.x & 0xFFFF0000u), __uint_as_float(q.x2.y << 16), __uint_as_float(q.x2.y & 0xFFFF0000u)};
    finish(r, c0, v, brv, biv, splv, xcv);
  }
#endif
};
struct EpiGate {
  static constexpr int W = 8; static constexpr bool SUB = false; static constexpr bool STAGED = false;
  const Params& p;
  MDEV void apply(int r, int c0, float* v) const {
#pragma unroll
    for (int j = 0; j < 8; ++j) v[j] = sigmoidf_(v[j]);
    store8bf(p.Gs() + (size_t)r * D + c0, v);
  }
};
struct EpiBranch {
  static constexpr int W = 8; static constexpr bool SUB = false; static constexpr bool STAGED = false;
  const Params& p; int br;
  MDEV void apply(int r, int c0, float* v) const {
    float g[8]; load8bf(p.Gs() + (size_t)r * D + c0, g);
    if (br > 0) {
      float mo[8]; load8bf(p.M() + (size_t)r * D + c0, mo);
#pragma unroll
      for (int j = 0; j < 8; ++j) v[j] = mo[j] + g[j] * v[j];
    } else {
#pragma unroll
      for (int j = 0; j < 8; ++j) v[j] = g[j] * v[j];
    }
    store8bf(p.M() + (size_t)r * D + c0, v);
  }
};
struct EpiGateAll {
  static constexpr int W = 8; static constexpr bool SUB = false; static constexpr bool STAGED = false;
  const Params& p;
  MDEV void apply(int r, int c0, float* v) const {
#pragma unroll
    for (int j = 0; j < 8; ++j) v[j] = sigmoidf_(v[j]) * 255.f + 0.5f;
    unsigned char* gq = p.G8() + (size_t)r * 4096 + c0;
#ifndef CPU_SIM
    uint2 w;
    w.x = (unsigned)v[0] | ((unsigned)v[1] << 8) | ((unsigned)v[2] << 16) | ((unsigned)v[3] << 24);
    w.y = (unsigned)v[4] | ((unsigned)v[5] << 8) | ((unsigned)v[6] << 16) | ((unsigned)v[7] << 24);
    *(uint2*)gq = w;
#else
    for (int j = 0; j < 8; ++j) gq[j] = (unsigned char)v[j];
#endif
  }
};
struct EpiBranchSub {
  static constexpr int W = 8; static constexpr bool SUB = true; static constexpr bool STAGED = true; static constexpr bool STAGED_ALL = false;
  const Params& p;
  MDEV void apply(int, int, float*) const {}
  MDEV void gate8(int r, int c0, int i, float* g) const {
    const unsigned char* gq = p.G8() + (size_t)r * 4096 + i * 1024 + c0;
#ifndef CPU_SIM
    const uint2 w = *(const uint2*)gq;
#pragma unroll
    for (int j = 0; j < 4; ++j) { g[j] = (float)((w.x >> (8 * j)) & 255u) * (1.0f / 255.0f); g[4 + j] = (float)((w.y >> (8 * j)) & 255u) * (1.0f / 255.0f); }
#else
    for (int j = 0; j < 8; ++j) g[j] = (float)gq[j] * (1.0f / 255.0f);
#endif
  }
  MDEV void apply_sub(int r, int c0, float* v, int sub) const {
    if (sub < 3) { store8bf(p.BR() + (size_t)r * 3072 + sub * 1024 + c0, v); return; }
    float g[8]; gate8(r, c0, 3, g);
#pragma unroll
    for (int j = 0; j < 8; ++j) v[j] *= g[j];
#pragma unroll
    for (int i = 0; i < 3; ++i) {
      float bi[8]; load8bf(p.BR() + (size_t)r * 3072 + i * 1024 + c0, bi);
      gate8(r, c0, i, g);
#pragma unroll
      for (int j = 0; j < 8; ++j) v[j] += g[j] * bi[j];
    }
    store8bf(p.M() + (size_t)r * D + c0, v);
  }
#ifndef CPU_SIM
  struct Pre { uint2 g[4]; uint4 b[3]; };
  MDEV void pre(int r, int c0, Pre& q) const {
#pragma unroll
    for (int i = 0; i < 4; ++i) q.g[i] = *(const uint2*)(p.G8() + (size_t)r * 4096 + i * 1024 + c0);
#pragma unroll
    for (int i = 0; i < 3; ++i) q.b[i] = *(const uint4*)(p.BR() + (size_t)r * 3072 + i * 1024 + c0);
  }
  MDEV void fin(int r, int c0, float* v, const Pre& q) const {
#pragma unroll
    for (int i = 3; i >= 0; --i) {
      float g[8];
#pragma unroll
      for (int j = 0; j < 4; ++j) { g[j] = (float)((q.g[i].x >> (8 * j)) & 255u) * (1.0f / 255.0f); g[4 + j] = (float)((q.g[i].y >> (8 * j)) & 255u) * (1.0f / 255.0f); }
      if (i == 3) {
#pragma unroll
        for (int j = 0; j < 8; ++j) v[j] *= g[j];
      } else {
        float bi[8]; unpack8(q.b[i], bi);
#pragma unroll
        for (int j = 0; j < 8; ++j) v[j] += g[j] * bi[j];
      }
    }
    store8bf(p.M() + (size_t)r * D + c0, v);
  }
#endif
};
struct EpiFilt {
  static constexpr int W = 8; static constexpr bool SUB = false; static constexpr bool STAGED = false;
  const Params& p;
  MDEV void apply(int j, int tt, float* v) const {
    const float maxd = -15.350567286626973f, mind = -3.0701134573253945f;
    const float ad = fabsf(mind + (float)j * ((maxd - mind) / 1023.0f));
    int t, L; if (tt < N) { t = tt; L = N; } else { t = tt - N; L = LC; }
    const float sc = -ad / (float)(L - 1);
#pragma unroll
    for (int q = 0; q < 8; ++q) v[q] *= fexpf_((float)(t + q) * sc);
    float* d = p.F() + (size_t)j * (N + LC) + tt;
#ifndef CPU_SIM
    *(float4*)d = float4{v[0], v[1], v[2], v[3]}; *(float4*)(d + 4) = float4{v[4], v[5], v[6], v[7]};
#else
    for (int q = 0; q < 8; ++q) d[q] = v[q];
#endif
  }
};
struct EpiOut {
  static constexpr int W = 8; static constexpr bool SUB = false; static constexpr bool STAGED = true; static constexpr bool STAGED_ALL = true;
  const Params& p; int l; float osc; const float* xlat; const float* xctx;
  MDEV void apply(int r, int c0, float* v) const {
    const float* g1 = p.mods() + ((size_t)l * 3 + modrow(r)) * 6 * D + 2 * D + c0;
    const float* xs = (r < NLAT ? xlat + (size_t)r * D : xctx + (size_t)(r - NLAT) * D) + c0;
    float* xr = p.xcur() + (size_t)r * D + c0;
    for (int j = 0; j < 8; ++j) xr[j] = xs[j] + osc * g1[j] * v[j];
  }
#ifndef CPU_SIM
  struct Pre { float4 g0, g1, x0, x1; };
  MDEV void pre(int r, int c0, Pre& q) const {
    const float* g1 = p.mods() + ((size_t)l * 3 + modrow(r)) * 6 * D + 2 * D + c0;
    const float* xs = (r < NLAT ? xlat + (size_t)r * D : xctx + (size_t)(r - NLAT) * D) + c0;
    q.g0 = *(const float4*)g1; q.g1 = *(const float4*)(g1 + 4); q.x0 = gld4(xs); q.x1 = gld4(xs + 4);
  }
  MDEV void fin(int r, int c0, float* v, const Pre& q) const {
    float* xr = p.xcur() + (size_t)r * D + c0;
    float4 o0, o1;
    o0.x = q.x0.x + osc * q.g0.x * v[0]; o0.y = q.x0.y + osc * q.g0.y * v[1]; o0.z = q.x0.z + osc * q.g0.z * v[2]; o0.w = q.x0.w + osc * q.g0.w * v[3];
    o1.x = q.x1.x + osc * q.g1.x * v[4]; o1.y = q.x1.y + osc * q.g1.y * v[5]; o1.z = q.x1.z + osc * q.g1.z * v[6]; o1.w = q.x1.w + osc * q.g1.w * v[7];
    *(float4*)xr = o0; *(float4*)(xr + 4) = o1;
  }
#endif
};
struct EpiPQ {
  static constexpr int W = 8; static constexpr bool SUB = false; static constexpr bool STAGED = false;
  const Params& p;
  MDEV void apply(int r, int c0, float* v) const { store8bf(p.PQ() + (size_t)r * 1024 + c0, v); }
};
struct EpiSC {
  static constexpr int W = 8; static constexpr bool SUB = false; static constexpr bool STAGED = false;
  const Params& p;
  MDEV void apply(int r, int c0, float* v) const {
    sc_t* d = p.SC() + (size_t)r * 2048 + c0;
#ifndef CPU_SIM
    typedef _Float16 half8 __attribute__((ext_vector_type(8)));
    half8 hv8;
#pragma unroll
    for (int j = 0; j < 8; ++j) hv8[j] = (_Float16)v[j];
    *(half8*)d = hv8;
#else
    for (int j = 0; j < 8; ++j) d[j] = (sc_t)v[j];
#endif
  }
};

struct GemmDesc { const bf* A; const bf* Bt; int lda, ldb, K, nrows, ncols; int a_pn_shift, a_pn_mul; int nsub = 1, a_sub = 0, b_sub = 0; int unit_off = 0; };

#ifndef CPU_SIM
namespace pg8 {
#define PG8_LAS __attribute__((address_space(3)))
typedef short bf16x8 __attribute__((ext_vector_type(8)));
typedef float f32x4 __attribute__((ext_vector_type(4)));
constexpr int BM = 256, BK = 64, HALF = 128, HTB = HALF * BK * 2, STAGE_BYTES = 8 * HTB, NXCD = 8, WGM = 8;
__device__ __forceinline__ int lds_byte(int r, int c) { const int st = (r >> 4) * 2 + (c >> 5), rr = r & 15, cc = c & 31, ob = rr * 64 + cc * 2; return st * 1024 + (ob ^ (((ob >> 9) & 1) << 5)); }
__device__ __forceinline__ void stage_rc(int b, int& R, int& C) { const int st = b / 1024, sb = b % 1024, swz = sb ^ (((sb >> 9) & 1) << 5); R = (st >> 1) * 16 + swz / 64; C = (st & 1) * 32 + (swz % 64) / 2; }
__device__ __forceinline__ int perm32(int rho) { const int n = rho >> 4, i = rho & 15; return 8 * (i >> 2) + 4 * n + (i & 3); }
struct Unit { int pm, pn, sub; };
struct StaticOrder {
  int nM, nN, nwg, G, c, nsub;
  __device__ void init(int nM_, int nN_, int G_, int c_, int nsub_) { nM = nM_; nN = nN_; nwg = nM * nN; G = G_; c = c_; nsub = nsub_; }
  __device__ bool next(int i, Unit& u) const {
    const int it = i / nsub; u.sub = i - it * nsub;
    const long L = (long)it * G + c; if (L >= nwg) return false;
    int wgid = (int)L; { const int q = nwg / NXCD, r = nwg % NXCD, xcd = wgid % NXCD, off = wgid / NXCD; wgid = (xcd < r ? xcd * (q + 1) : r * (q + 1) + (xcd - r) * q) + off; }
    const int nig = WGM * nN, gid = wgid / nig, fm = gid * WGM, gsz = (nM - fm) < WGM ? (nM - fm) : WGM;
    u.pm = fm + ((wgid % nig) % gsz); u.pn = (wgid % nig) / gsz; return true;
  }
};

template <class E>
__device__ __forceinline__ void epi_call(const E& e, const f32x4 (&acc)[2][2][4][2], const Unit& u, int wr, int wc, int fr_, int fq_) {
  int fr = fr_, fq = fq_;
  asm volatile("" : "+v"(fr), "+v"(fq));
  if constexpr (E::STAGED) {
    if (E::STAGED_ALL || u.sub == 3) {
#pragma unroll
      for (int ai = 0; ai < 2; ++ai)
#pragma unroll
        for (int m = 0; m < 4; ++m) {
          typename E::Pre q[2];
#pragma unroll
          for (int bj = 0; bj < 2; ++bj) { q[bj] = typename E::Pre{}; e.pre(u.pm * BM + ai * HALF + wr * 64 + m * 16 + fr, u.pn * BM + bj * HALF + wc * 32 + 8 * fq, q[bj]); }
#pragma unroll
          for (int bj = 0; bj < 2; ++bj) {
            float v[8];
#pragma unroll
            for (int j = 0; j < 4; ++j) { v[j] = acc[ai][bj][m][0][j]; v[4 + j] = acc[ai][bj][m][1][j]; }
            e.fin(u.pm * BM + ai * HALF + wr * 64 + m * 16 + fr, u.pn * BM + bj * HALF + wc * 32 + 8 * fq, v, q[bj]);
          }
          __builtin_amdgcn_sched_barrier(0);
        }
      return;
    }
  }
#pragma unroll
  for (int ai = 0; ai < 2; ++ai)
#pragma unroll
    for (int m = 0; m < 4; ++m) {
      const int r = u.pm * BM + ai * HALF + wr * 64 + m * 16 + fr;
#pragma unroll
      for (int bj = 0; bj < 2; ++bj) {
        if constexpr (E::W == 8) {
          const int c0 = u.pn * BM + bj * HALF + wc * 32 + 8 * fq;
          float v[8];
#pragma unroll
          for (int j = 0; j < 4; ++j) { v[j] = acc[ai][bj][m][0][j]; v[4 + j] = acc[ai][bj][m][1][j]; }
          if constexpr (E::W == 8 && E::SUB) e.apply_sub(r, c0, v, u.sub); else e.apply(r, c0, v);
        } else {
#pragma unroll
          for (int n = 0; n < 2; ++n) {
            const int c0 = u.pn * BM + bj * HALF + wc * 32 + 16 * n + 4 * fq;
            float v[4];
#pragma unroll
            for (int j = 0; j < 4; ++j) v[j] = acc[ai][bj][m][n][j];
            e.apply(r, c0, v);
          }
        }
      }
      if (m == 1 || m == 3) __builtin_amdgcn_sched_barrier(0);
    }
}

template <class Epi>
__device__ __forceinline__ void gemm_phase(PG8_LAS unsigned char* lds, const int tid, const GemmDesc g, const Epi& E) {
  constexpr bool PERM = (Epi::W == 8);
  const int wid = __builtin_amdgcn_readfirstlane(tid >> 6), lane = tid & 63, wr = wid >> 2, wc = wid & 3, fr = lane & 15, fq = lane >> 4;
  const int K = g.K, nt = K / BK;
  StaticOrder S; S.init(g.nrows / BM, g.ncols / BM, (int)gridDim.x, (int)((blockIdx.x + gridDim.x - (unsigned)g.unit_off % gridDim.x) % gridDim.x), g.nsub);
  unsigned voffA[2], voffB[2];
#pragma unroll
  for (int i = 0; i < 2; ++i) { int R, C; stage_rc(tid * 16 + i * 8192, R, C); const int Rb = PERM ? ((R & ~31) + perm32(R & 31)) : R;
    voffA[i] = (unsigned)(R * g.lda + C) * 2u; voffB[i] = (unsigned)(Rb * g.ldb + C) * 2u; }
  const size_t kstep = (size_t)(BK * 2);
  const size_t hstepA = (size_t)HALF * g.lda * 2, hstepB = (size_t)HALF * g.ldb * 2;
  const unsigned ldsw = (unsigned)wid * 1024u;
  const int aoff = lds_byte(wr * 64 + fr, fq * 8), boff = lds_byte(wc * 32 + fr, fq * 8);
#define PG8_SA(b, h) (((b) * 2 + (h)) * HTB)
#define PG8_SB(b, h) ((4 + (b) * 2 + (h)) * HTB)
#define PG8_STAGE(bufoff, gbase, voff) do { _Pragma("unroll") for (int _i = 0; _i < 2; ++_i) \
        __builtin_amdgcn_global_load_lds((const unsigned*)((const char*)(gbase) + (voff)[_i]), (PG8_LAS unsigned*)(lds + (bufoff) + ldsw + _i * 8192), 16, 0, 0); } while (0)
#define PG8_LDA(dst, b, h) do { _Pragma("unroll") for (int m = 0; m < 4; ++m) _Pragma("unroll") for (int k = 0; k < 2; ++k) dst[m][k] = *(const PG8_LAS bf16x8*)(lds + PG8_SA(b, h) + aoff + m * 2048 + k * 1024); } while (0)
#define PG8_LDB(dst, b, h) do { _Pragma("unroll") for (int n = 0; n < 2; ++n) _Pragma("unroll") for (int k = 0; k < 2; ++k) dst[n][k] = *(const PG8_LAS bf16x8*)(lds + PG8_SB(b, h) + boff + n * 2048 + k * 1024); } while (0)
#define PG8_MMA(ai, bj, At, Bt) do { __builtin_amdgcn_s_setprio(1); _Pragma("unroll") for (int m = 0; m < 4; ++m) _Pragma("unroll") for (int n = 0; n < 2; ++n) _Pragma("unroll") for (int k = 0; k < 2; ++k) \
        acc[ai][bj][m][n] = __builtin_amdgcn_mfma_f32_16x16x32_bf16(Bt[n][k], At[m][k], acc[ai][bj][m][n], 0, 0, 0); __builtin_amdgcn_s_setprio(0); } while (0)
#define PG8_WAIT_V(n) asm volatile("s_waitcnt vmcnt(" #n ")" ::: "memory")
#define PG8_WAIT_L(n) asm volatile("s_waitcnt lgkmcnt(" #n ")" ::: "memory")
#define PG8_BAR __builtin_amdgcn_s_barrier()
#define PG8_SCHED __builtin_amdgcn_sched_barrier(0)
#define PG8_ABASE(u) ((const char*)g.A + ((size_t)(u).pm * BM * g.lda + (size_t)((u).pn >> g.a_pn_shift) * g.a_pn_mul + (size_t)(u).sub * g.a_sub) * 2)
#define PG8_BBASE(u) ((const char*)g.Bt + ((size_t)(u).pn * BM * g.ldb + (size_t)(u).sub * g.b_sub) * 2)
  Unit cur, nxt; int ui = 0;
  if (!S.next(0, cur)) return;
  f32x4 acc[2][2][4][2];
#pragma unroll
  for (int a = 0; a < 2; ++a)
#pragma unroll
    for (int b = 0; b < 2; ++b)
#pragma unroll
      for (int m = 0; m < 4; ++m)
#pragma unroll
        for (int n = 0; n < 2; ++n) acc[a][b][m][n] = (f32x4){0.f, 0.f, 0.f, 0.f};
  bf16x8 At[4][2], B0[2][2], B1[2][2];
  const char* cA = PG8_ABASE(cur); const char* cB = PG8_BBASE(cur);
  asm volatile("" : "+v"(voffA[0]), "+v"(voffA[1]), "+v"(voffB[0]), "+v"(voffB[1]));
  PG8_STAGE(PG8_SB(0, 0), cB, voffB); PG8_STAGE(PG8_SA(0, 0), cA, voffA); PG8_STAGE(PG8_SB(0, 1), cB + hstepB, voffB); PG8_STAGE(PG8_SA(0, 1), cA + hstepA, voffA);
  if (wr == 1) PG8_BAR;
  PG8_WAIT_V(4); PG8_BAR;
  PG8_STAGE(PG8_SB(1, 0), cB + kstep, voffB); PG8_STAGE(PG8_SA(1, 0), cA + kstep, voffA); PG8_STAGE(PG8_SB(1, 1), cB + hstepB + kstep, voffB);
  PG8_WAIT_V(6); PG8_BAR;
  for (;;) {
    const bool has_next = S.next(ui + 1, nxt);
    const char* nA = has_next ? PG8_ABASE(nxt) : cA; const char* nB = has_next ? PG8_BBASE(nxt) : cB;
    for (int t = 0; t < nt; t += 2) {
      const bool last = (t == nt - 2);
      asm volatile("" : "+v"(voffA[0]), "+v"(voffA[1]), "+v"(voffB[0]), "+v"(voffB[1]));
      const char* a1 = cA + (size_t)(t + 1) * kstep;
      const char* a2 = last ? nA : cA + (size_t)(t + 2) * kstep; const char* b2 = last ? nB : cB + (size_t)(t + 2) * kstep;
      const char* a3 = a2 + kstep; const char* b3 = b2 + kstep;
      PG8_LDB(B0, 0, 0); PG8_SCHED; PG8_LDA(At, 0, 0); PG8_STAGE(PG8_SA(1, 1), a1 + hstepA, voffA);
      PG8_WAIT_L(8); PG8_BAR; PG8_WAIT_L(0); PG8_MMA(0, 0, At, B0); PG8_BAR; PG8_SCHED;
      PG8_LDB(B1, 0, 1); PG8_STAGE(PG8_SB(0, 0), b2, voffB);
      PG8_BAR; PG8_WAIT_L(0); PG8_MMA(0, 1, At, B1); PG8_BAR;
      PG8_LDA(At, 0, 1); PG8_STAGE(PG8_SA(0, 0), a2, voffA);
      PG8_BAR; PG8_WAIT_L(0); PG8_MMA(1, 0, At, B0); PG8_BAR; PG8_SCHED;
      PG8_STAGE(PG8_SB(0, 1), b2 + hstepB, voffB);
      PG8_WAIT_V(6); PG8_BAR; PG8_MMA(1, 1, At, B1); PG8_BAR;
      PG8_LDB(B0, 1, 0); PG8_SCHED; PG8_LDA(At, 1, 0); PG8_STAGE(PG8_SA(0, 1), a2 + hstepA, voffA);
      PG8_WAIT_L(8); PG8_BAR; PG8_WAIT_L(0); PG8_MMA(0, 0, At, B0); PG8_BAR; PG8_SCHED;
      PG8_LDB(B1, 1, 1); PG8_STAGE(PG8_SB(1, 0), b3, voffB);
      PG8_BAR; PG8_WAIT_L(0); PG8_MMA(0, 1, At, B1); PG8_BAR;
      PG8_LDA(At, 1, 1); PG8_STAGE(PG8_SA(1, 0), a3, voffA);
      PG8_BAR; PG8_WAIT_L(0); PG8_MMA(1, 0, At, B0); PG8_BAR; PG8_SCHED;
      PG8_STAGE(PG8_SB(1, 1), b3 + hstepB, voffB);
      PG8_WAIT_V(6); PG8_BAR; PG8_MMA(1, 1, At, B1); PG8_BAR;
    }
    epi_call(E, acc, cur, wr, wc, fr, fq);
    if (!has_next) break;
#pragma unroll
    for (int a = 0; a < 2; ++a)
#pragma unroll
      for (int b = 0; b < 2; ++b)
#pragma unroll
        for (int m = 0; m < 4; ++m)
#pragma unroll
          for (int n = 0; n < 2; ++n) acc[a][b][m][n] = (f32x4){0.f, 0.f, 0.f, 0.f};
    cur = nxt; cA = nA; cB = nB; ++ui;
  }
  PG8_WAIT_V(0);
  if (wr == 0) PG8_BAR;
  PG8_BAR;
#undef PG8_SA
#undef PG8_SB
#undef PG8_STAGE
#undef PG8_LDA
#undef PG8_LDB
#undef PG8_MMA
#undef PG8_WAIT_V
#undef PG8_WAIT_L
#undef PG8_BAR
#undef PG8_SCHED
#undef PG8_ABASE
#undef PG8_BBASE
}
}
struct Ctx { i64 gtid, gsz; PG8_LAS unsigned char* lds; char* ldsg; int tid; };
template <class E> DEV void run_gemm(const Ctx& cx, const GemmDesc& g, const E& e) { pg8::gemm_phase<E>(cx.lds, cx.tid, g, e); }
#else
struct Ctx { i64 gtid, gsz; };
template <class E> static void run_gemm(const Ctx& cx, const GemmDesc& g, const E& e) {
  constexpr int W = E::W;
  const int ng = g.ncols / W;
  for (i64 i = cx.gtid; i < (i64)g.nrows * ng; i += cx.gsz) {
    int r = (int)(i / ng), c0 = (int)(i % ng) * W;
    int pn = c0 / 256;
    for (int sub = 0; sub < g.nsub; ++sub) {
      const bf* a = g.A + (size_t)r * g.lda + (size_t)(pn >> g.a_pn_shift) * g.a_pn_mul + (size_t)sub * g.a_sub;
      float v[8];
      for (int j = 0; j < W; ++j) {
        const bf* b = g.Bt + (size_t)(c0 + j) * g.ldb + (size_t)sub * g.b_sub;
        float acc = 0.f;
        for (int k = 0; k < g.K; ++k) acc += b2f(a[k]) * b2f(b[k]);
        v[j] = acc;
      }
      if constexpr (E::SUB) e.apply_sub(r, c0, v, sub); else e.apply(r, c0, v);
    }
  }
}
#endif


#ifndef CPU_SIM
namespace fa {
using bf16x8 = __attribute__((ext_vector_type(8))) short;
using s16x4 = __attribute__((ext_vector_type(4))) short;
using f32x16 = __attribute__((ext_vector_type(16))) float;
using u32x4 = __attribute__((ext_vector_type(4))) unsigned;
constexpr int KVBLK = 64, QBLK = 32;
constexpr float THR = 8.f;
constexpr int SHM_V = KVBLK * 128 * 2, SHM_K = KVBLK * 128 * 2;
constexpr int NBUF = 3;
constexpr int SHM_ATTN = NBUF * SHM_V + NBUF * SHM_K + 8 * 64 * 4;
#define KSWZ(row, colB) ((row) * 256 + ((colB) ^ (((row) & 7) << 4)))
#define SBAR() __builtin_amdgcn_sched_barrier(0)
__device__ __forceinline__ int crow(int r, int hi) { return (r & 3) + 8 * (r >> 2) + 4 * hi; }
__device__ __forceinline__ unsigned cvtpk(float lo, float hi) { unsigned r; asm volatile("v_cvt_pk_bf16_f32 %0, %1, %2" : "=v"(r) : "v"(lo), "v"(hi)); return r; }
template <int SC1000000> __device__ __forceinline__ void partialSM(f32x16& p0, f32x16& p1, float& m_reg, float& mn, float& alpha) {
  constexpr float SCALE = SC1000000 * 1e-9f; constexpr float C = SCALE * 1.4426950408889634f;
  float pmax = p0[0];
#pragma unroll
  for (int r = 1; r < 16; ++r) pmax = fmaxf(pmax, p0[r]);
#pragma unroll
  for (int r = 0; r < 16; ++r) pmax = fmaxf(pmax, p1[r]);
  { auto rr = __builtin_amdgcn_permlane32_swap(__float_as_uint(pmax), __float_as_uint(pmax), false, false);
    pmax = fmaxf(__uint_as_float(rr[0]), __uint_as_float(rr[1])); }
  if (__builtin_expect(__all(pmax - m_reg <= THR / SCALE), 1)) { mn = m_reg; alpha = 1.f; }
  else { mn = fmaxf(m_reg, pmax); alpha = __builtin_amdgcn_exp2f((m_reg - mn) * C); m_reg = mn; }
  float mnC = -mn * C;
#pragma unroll
  for (int r = 0; r < 16; ++r) p0[r] = fmaf(p0[r], C, mnC);
#pragma unroll
  for (int r = 0; r < 16; ++r) p1[r] = fmaf(p1[r], C, mnC);
#pragma unroll
  for (int r = 0; r < 16; ++r) p0[r] = __builtin_amdgcn_exp2f(p0[r]);
}
__device__ __forceinline__ void finishSM(f32x16& p0, f32x16& p1, float alpha, float& l_reg, bf16x8& pa0, bf16x8& pa1, bf16x8& pa2, bf16x8& pa3) {
#pragma unroll
  for (int r = 0; r < 16; ++r) p1[r] = __builtin_amdgcn_exp2f(p1[r]);
  float ps = 0;
#pragma unroll
  for (int r = 0; r < 16; ++r) ps += p0[r];
#pragma unroll
  for (int r = 0; r < 16; ++r) ps += p1[r];
  { auto rr = __builtin_amdgcn_permlane32_swap(__float_as_uint(ps), __float_as_uint(ps), false, false);
    ps = __uint_as_float(rr[0]) + __uint_as_float(rr[1]); }
  l_reg = l_reg * alpha + ps;
#define PK4(P, BASE, OUT) do { unsigned a0 = cvtpk(P[BASE + 0], P[BASE + 1]), a1 = cvtpk(P[BASE + 2], P[BASE + 3]);   \
    unsigned b0 = cvtpk(P[BASE + 4], P[BASE + 5]), b1 = cvtpk(P[BASE + 6], P[BASE + 7]);                              \
    auto r0 = __builtin_amdgcn_permlane32_swap(a0, b0, false, false); auto r1 = __builtin_amdgcn_permlane32_swap(a1, b1, false, false); \
    u32x4 w = {r0[0], r1[0], r0[1], r1[1]}; OUT = *reinterpret_cast<bf16x8*>(&w); } while (0)
  PK4(p0, 0, pa0); PK4(p0, 8, pa1); PK4(p1, 0, pa2); PK4(p1, 8, pa3);
#undef PK4
}
template <int NK16>
__device__ __forceinline__ void qkt(f32x16& p0, f32x16& p1, const char* Ks, const bf16x8* qr, int r32, int hi) {
  p0 = f32x16{}; p1 = f32x16{};
#pragma unroll
  for (int d0 = 0; d0 < NK16; ++d0) { int cb = (d0 * 16 + hi * 8) * 2;
    bf16x8 b0 = *reinterpret_cast<const bf16x8*>(Ks + KSWZ(r32, cb));
    bf16x8 b1 = *reinterpret_cast<const bf16x8*>(Ks + KSWZ(32 + r32, cb));
    p0 = __builtin_amdgcn_mfma_f32_32x32x16_bf16(b0, qr[d0], p0, 0, 0, 0);
    p1 = __builtin_amdgcn_mfma_f32_32x32x16_bf16(b1, qr[d0], p1, 0, 0, 0); }
}
__device__ __forceinline__ int v_st(int k, int c) { const int kk = (k & ~0xC) | ((k & 4) << 1) | ((k & 8) >> 1); return ((kk >> 3) * 4 + (c >> 5)) * 512 + ((kk & 7) * 32 + (c & 31)) * 2; }
__device__ __forceinline__ int v_rd_base(int lane) { return ((lane & 3) << 3) | (((lane >> 2) & 3) << 6) | (((lane >> 4) & 1) << 5) | (((lane >> 5) & 1) << 8); }
constexpr int v_rd_off(int d0, int ks, int half) { return d0 * 512 + ks * 4096 + half * 2048; }
template <int OFF> __device__ __forceinline__ s16x4 tr_read(int vb) {
  s16x4 r; asm volatile("ds_read_b64_tr_b16 %0, %1 offset:%2" : "=&v"(r) : "v"(vb), "i"(OFF) : "memory"); return r;
}
template <int D0> __device__ __forceinline__ void pv_one(f32x16& od, int vb, bf16x8 pa0, bf16x8 pa1, bf16x8 pa2, bf16x8 pa3) {
  const s16x4 l0 = tr_read<v_rd_off(D0, 0, 0)>(vb), h0 = tr_read<v_rd_off(D0, 0, 1)>(vb), l1 = tr_read<v_rd_off(D0, 1, 0)>(vb), h1 = tr_read<v_rd_off(D0, 1, 1)>(vb);
  const s16x4 l2 = tr_read<v_rd_off(D0, 2, 0)>(vb), h2 = tr_read<v_rd_off(D0, 2, 1)>(vb), l3 = tr_read<v_rd_off(D0, 3, 0)>(vb), h3 = tr_read<v_rd_off(D0, 3, 1)>(vb);
  asm volatile("s_waitcnt lgkmcnt(0)" ::: "memory"); SBAR();
#define PK(L, H) (bf16x8){L[0], L[1], L[2], L[3], H[0], H[1], H[2], H[3]}
  od = __builtin_amdgcn_mfma_f32_32x32x16_bf16(pa0, PK(l0, h0), od, 0, 0, 0);
  od = __builtin_amdgcn_mfma_f32_32x32x16_bf16(pa1, PK(l1, h1), od, 0, 0, 0);
  od = __builtin_amdgcn_mfma_f32_32x32x16_bf16(pa2, PK(l2, h2), od, 0, 0, 0);
  od = __builtin_amdgcn_mfma_f32_32x32x16_bf16(pa3, PK(l3, h3), od, 0, 0, 0);
#undef PK
}
__device__ __forceinline__ void pv_d0(f32x16* o, int vb, bf16x8 pa0, bf16x8 pa1, bf16x8 pa2, bf16x8 pa3) {
  pv_one<0>(o[0], vb, pa0, pa1, pa2, pa3); pv_one<1>(o[1], vb, pa0, pa1, pa2, pa3);
}

struct Src { const bf* q; int qstride; const bf* ksrc; int kstride; const bf* vsrc; int vstride; bf* out; float m0, l0; int dq0; };
template <int NK16, int SC1000000, bool MASK>
__device__ __forceinline__ void unit(const Src& sd, const int tid, char* lds, int kbase0, int nt0, int kbase1, int NT) {
  const int wid = tid >> 6, lane = tid & 63, r32 = lane & 31, hi = lane >> 5;
  char* V_lds = lds; char* K_lds = lds + NBUF * SHM_V;
  float* wsl = (float*)(lds + NBUF * SHM_V + NBUF * SHM_K) + wid * 64; float* li_l = wsl; float* al_l = wsl + 32;
  float m_reg = sd.m0, l_reg = sd.l0; f32x16 o[2] = {}; bf16x8 qr[NK16];
  const bf* Qw = sd.q + (size_t)(wid * QBLK + r32) * sd.qstride + hi * 8;
#pragma unroll
  for (int d0 = 0; d0 < NK16; ++d0) qr[d0] = *reinterpret_cast<const bf16x8*>(Qw + d0 * 16);
  const int sr = tid >> 4, sc = (tid & 15) * 8, vst0 = v_st(sr, sc), vst1 = v_st(32 + sr, sc);
  const int vb0 = (int)(uintptr_t)V_lds + v_rd_base(lane);
  const bf* ksrc = sd.ksrc; const int kstride = sd.kstride; const bf* vsrc = sd.vsrc; const int vstride = sd.vstride;
  const int dqw = sd.dq0 + wid * QBLK + r32;
  struct { bf16x8 vs0, vs1, ks0, ks1; } sr_[2];
#define KROW(j) ((j) < nt0 ? kbase0 + (j) * KVBLK : kbase1 + ((j) - nt0) * KVBLK)
#define SLOAD(i, j) do { const int _kr = KROW(j); \
    sr_[i].vs0 = *reinterpret_cast<const bf16x8*>(vsrc + (size_t)(_kr + sr) * vstride); sr_[i].vs1 = *reinterpret_cast<const bf16x8*>(vsrc + (size_t)(_kr + 32 + sr) * vstride); \
    sr_[i].ks0 = *reinterpret_cast<const bf16x8*>(ksrc + (size_t)(_kr + sr) * kstride); sr_[i].ks1 = *reinterpret_cast<const bf16x8*>(ksrc + (size_t)(_kr + 32 + sr) * kstride); } while (0)
#define SWRITE(b, i) do { *(bf16x8*)(V_lds + (b) * SHM_V + vst0) = sr_[i].vs0;          \
    *(bf16x8*)(V_lds + (b) * SHM_V + vst1) = sr_[i].vs1; int kc = sc * 2;               \
    *(bf16x8*)(K_lds + (b) * SHM_K + KSWZ(sr, kc)) = sr_[i].ks0;                       \
    *(bf16x8*)(K_lds + (b) * SHM_K + KSWZ(32 + sr, kc)) = sr_[i].ks1; } while (0)
#define SWAIT() asm volatile("s_waitcnt vmcnt(4)" ::: "memory")
#define MASKT(P0, P1, J) do { if (MASK && (J) < nt0) { const int _d = (J) * KVBLK - dqw; \
    _Pragma("unroll") for (int r = 0; r < 16; ++r) { const int dd = _d + crow(r, hi); if (dd > 128 || dd < -128) P0[r] = -1e30f; if (dd + 32 > 128 || dd + 32 < -128) P1[r] = -1e30f; } } } while (0)
#define RESC(a) do { if (__any((a) < 1.f)) { if (hi == 0) al_l[r32] = (a); asm volatile("s_waitcnt lgkmcnt(0)" ::: "memory"); \
    _Pragma("unroll") for (int d = 0; d < 2; ++d) _Pragma("unroll") for (int r = 0; r < 16; ++r) o[d][r] *= al_l[crow(r, hi)]; } } while (0)
  f32x16 pA0, pA1, pB0, pB1; float mnA, mnB, alA, alB; bf16x8 pa0, pa1, pa2, pa3;
  constexpr int SE = 0, SO = 1;
  __syncthreads();
  SLOAD(SE, 0); asm volatile("s_waitcnt vmcnt(0)" ::: "memory"); SWRITE(0, SE); __syncthreads();
  qkt<NK16>(pA0, pA1, K_lds, qr, r32, hi); MASKT(pA0, pA1, 0); partialSM<SC1000000>(pA0, pA1, m_reg, mnA, alA);
  SLOAD(SO, 1); if (2 < NT) SLOAD(SE, 2);
  SWAIT();
  SWRITE(1, SO); __syncthreads();
  int bc = 1;
  for (int j = 1; j + 1 < NT; j += 2) {
    { const int bp = bc == 0 ? NBUF - 1 : bc - 1, bn = bc == NBUF - 1 ? 0 : bc + 1;
      SBAR(); qkt<NK16>(pB0, pB1, K_lds + bc * SHM_K, qr, r32, hi);
      finishSM(pA0, pA1, alA, l_reg, pa0, pa1, pa2, pa3); SBAR();
      SLOAD(SO, j + 2); SBAR();
      pv_d0(o, vb0 + bp * SHM_V, pa0, pa1, pa2, pa3); MASKT(pB0, pB1, j); partialSM<SC1000000>(pB0, pB1, m_reg, mnB, alB);
      SWAIT(); SWRITE(bn, SE);
      RESC(alB); __syncthreads();
      bc = bn; }
    { const int bp = bc == 0 ? NBUF - 1 : bc - 1, bn = bc == NBUF - 1 ? 0 : bc + 1;
      SBAR(); qkt<NK16>(pA0, pA1, K_lds + bc * SHM_K, qr, r32, hi);
      finishSM(pB0, pB1, alB, l_reg, pa0, pa1, pa2, pa3); SBAR();
      if (j + 3 < NT) SLOAD(SE, j + 3); SBAR();
      pv_d0(o, vb0 + bp * SHM_V, pa0, pa1, pa2, pa3); MASKT(pA0, pA1, j + 1); partialSM<SC1000000>(pA0, pA1, m_reg, mnA, alA);
      SWAIT(); SWRITE(bn, SO);
      RESC(alA); __syncthreads();
      bc = bn; }
  }
  { const int bp = bc == 0 ? NBUF - 1 : bc - 1;
    SBAR(); qkt<NK16>(pB0, pB1, K_lds + bc * SHM_K, qr, r32, hi);
    finishSM(pA0, pA1, alA, l_reg, pa0, pa1, pa2, pa3); SBAR();
    pv_d0(o, vb0 + bp * SHM_V, pa0, pa1, pa2, pa3); MASKT(pB0, pB1, NT - 1); partialSM<SC1000000>(pB0, pB1, m_reg, mnB, alB);
    RESC(alB);
    finishSM(pB0, pB1, alB, l_reg, pa0, pa1, pa2, pa3); SBAR();
    pv_d0(o, vb0 + bc * SHM_V, pa0, pa1, pa2, pa3); }
  asm volatile("s_waitcnt vmcnt(0)" ::: "memory");
  if (hi == 0) li_l[r32] = l_reg; asm volatile("s_waitcnt lgkmcnt(0)" ::: "memory");
  float rli[16];
#pragma unroll
  for (int r = 0; r < 16; ++r) rli[r] = __builtin_amdgcn_rcpf(li_l[crow(r, hi)]);
  bf* Ow = sd.out + (size_t)(wid * QBLK) * 2048;
#pragma unroll
  for (int r = 0; r < 16; ++r) { int orow = crow(r, hi);
#pragma unroll
    for (int d0 = 0; d0 < 2; ++d0) Ow[(size_t)orow * 2048 + d0 * 32 + r32] = f2b(o[d0][r] * rli[r]); }
#undef SLOAD
#undef SWRITE
#undef SWAIT
#undef MASKT
#undef RESC
#undef KROW
}
#undef KSWZ
#undef SBAR
}

DEV void ph_mla(const Params& p, const Ctx& cx, int last) {
  const int nlat_units = NB * 8 * (N / 256);
  const int nctx_units = last ? 0 : NB * 8 * (LC / 256);
  const int sc = (cx.tid & 15) * 8;
  for (int uu = blockIdx.x; uu < nlat_units + 256; uu += gridDim.x) {
    const int u = uu < nlat_units ? uu : nlat_units + ((uu - nlat_units + 256 - 32) & 255);
    if (u >= nlat_units + nctx_units) continue;
    int qrow0, hh, kb0, nt0, kb1, NT;
    if (u < nlat_units) {
      const int rnd = u / 256, within = u % 256, bh = (rnd * 8 + (within & 7)) % (NB * 8); int qb = within >> 3;
      hh = bh % 8; int b = bh / 8; qrow0 = b * N + qb * 256; kb0 = b * N; nt0 = N / 64; kb1 = NLAT + b * LC; NT = (N + LC) / 64; }
    else { int v = u - nlat_units; int qb = v % (LC / 256); hh = (v / (LC / 256)) % 8; int b = v / (8 * (LC / 256)); qrow0 = NLAT + b * LC + qb * 256; kb0 = NLAT + b * LC; nt0 = LC / 64; kb1 = 0; NT = LC / 64; }
    fa::Src sd;
    sd.q = p.QA() + (size_t)qrow0 * 768 + hh * 96; sd.qstride = 768;
    if (sc < 64) { sd.ksrc = p.KVA() + hh * 128 + sc; sd.kstride = 1024; } else { sd.ksrc = p.P() + C_KR + ((sc - 64) & 31); sd.kstride = PC; }
    sd.vsrc = p.KVA() + hh * 128 + 64 + (sc & 63); sd.vstride = 1024;
    sd.out = p.Y() + (size_t)qrow0 * 2048 + hh * 64; sd.m0 = -1e30f; sd.l0 = 0.f; sd.dq0 = 0;
    fa::unit<6, 102062073, false>(sd, cx.tid, cx.ldsg, kb0, nt0, kb1, NT);
  }
}
DEV void ph_gqa(const Params& p, const Ctx& cx, int l, int last) {
  const int nlat_units = NB * 8 * (N / 256);
  const int nctx_units = last ? 0 : NB * 8 * (LC / 256);
  const int sc = (cx.tid & 15) * 8;
  for (int uu = blockIdx.x; uu < nlat_units + 256; uu += gridDim.x) {
    const int u = uu < nlat_units ? uu : nlat_units + ((uu - nlat_units + 256 - 16) & 255);
    if (u >= nlat_units + nctx_units) continue;
    int qrow0, hh, kb0, nt0, kb1, NT, dq0 = 0;
    if (u < nlat_units) {
      const int rnd = u / 256, within = u % 256, bh = (rnd * 8 + (within & 7)) % (NB * 8); int qb = within >> 3;
      hh = bh % 8; int b = bh / 8;
      int q0 = qb * 256; int klo = q0 - 128 < 0 ? 0 : q0 - 128; int khi = q0 + 384 > N ? N : q0 + 384;
      qrow0 = b * N + q0; kb0 = b * N + klo; nt0 = (khi - klo) / 64; kb1 = NLAT + b * LC; NT = nt0 + LC / 64; dq0 = q0 - klo;
    } else { int v = u - nlat_units; int qb = v % (LC / 256); hh = (v / (LC / 256)) % 8; int b = v / (8 * (LC / 256)); qrow0 = NLAT + b * LC + qb * 256; kb0 = NLAT + b * LC; nt0 = 0; kb1 = kb0; NT = LC / 64; }
    const int kh = hh >> 2;
    fa::Src sd;
    sd.q = p.P() + (size_t)qrow0 * PC + C_GQ + hh * 64; sd.qstride = PC;
    sd.ksrc = p.P() + C_GKV + kh * 64 + (sc & 63); sd.kstride = PC;
    sd.vsrc = p.P() + C_GKV + 128 + kh * 64 + (sc & 63); sd.vstride = PC;
    sd.out = p.Y() + (size_t)qrow0 * 2048 + 1536 + hh * 64;
    sd.m0 = p.in[I_gqa_sink][l * 8 + hh] * 8.0f; sd.l0 = 1.0f; sd.dq0 = dq0;
    fa::unit<4, 125000000, true>(sd, cx.tid, cx.ldsg, kb0, nt0, kb1, NT);
  }
}
#endif


namespace hy {
constexpr int NF = 2 * N;
struct f2 { float x, y; };
DEV f2 cmul(f2 a, f2 b) { f2 r; r.x = a.x * b.x - a.y * b.y; r.y = a.x * b.y + a.y * b.x; return r; }
#ifndef CPU_SIM
DEV f2 twid(const f2*, int k) { const float x = (float)k * (1.0f / (float)NF); return f2{__builtin_amdgcn_cosf(x), -__builtin_amdgcn_sinf(x)}; }
#else
DEV f2 twid(const f2* tw, int k) { return tw[k]; }
#endif
DEV f2 cmulc(f2 a, f2 b) { f2 r; r.x = a.x * b.x + a.y * b.y; r.y = a.y * b.x - a.x * b.y; return r; }
DEV void fwd_pass(f2* buf, const f2* tw, int L, int tid, int nthr) {
  const int Q = L >> 2, tws = NF / L;
  for (int u = tid; u < NF / 4; u += nthr) {
    const int g = u / Q, j = u - g * Q, base = g * L + j;
    const f2 x0 = buf[base], x1 = buf[base + Q], x2 = buf[base + 2 * Q], x3 = buf[base + 3 * Q];
    f2 a0{x0.x + x2.x, x0.y + x2.y}, a1{x0.x - x2.x, x0.y - x2.y}, a2{x1.x + x3.x, x1.y + x3.y};
    f2 d{x1.x - x3.x, x1.y - x3.y}; f2 a3{d.y, -d.x};
    f2 y0{a0.x + a2.x, a0.y + a2.y}, y1{a1.x + a3.x, a1.y + a3.y}, y2{a0.x - a2.x, a0.y - a2.y}, y3{a1.x - a3.x, a1.y - a3.y};
    buf[base] = y0; buf[base + Q] = cmul(y1, twid(tw, j * tws)); buf[base + 2 * Q] = cmul(y2, twid(tw, 2 * j * tws)); buf[base + 3 * Q] = cmul(y3, twid(tw, 3 * j * tws));
  }
}
DEV void inv_pass(f2* buf, const f2* tw, int L, int tid, int nthr) {
  const int Q = L >> 2, tws = NF / L;
  for (int u = tid; u < NF / 4; u += nthr) {
    const int g = u / Q, j = u - g * Q, base = g * L + j;
    const f2 u0 = buf[base], u1 = cmulc(buf[base + Q], twid(tw, j * tws)), u2 = cmulc(buf[base + 2 * Q], twid(tw, 2 * j * tws)), u3 = cmulc(buf[base + 3 * Q], twid(tw, 3 * j * tws));
    f2 a0{u0.x + u2.x, u0.y + u2.y}, a1{u0.x - u2.x, u0.y - u2.y}, a2{u1.x + u3.x, u1.y + u3.y};
    f2 d{u1.x - u3.x, u1.y - u3.y}; f2 a3{-d.y, d.x};
    buf[base] = f2{a0.x + a2.x, a0.y + a2.y}; buf[base + Q] = f2{a1.x + a3.x, a1.y + a3.y};
    buf[base + 2 * Q] = f2{a0.x - a2.x, a0.y - a2.y}; buf[base + 3 * Q] = f2{a1.x - a3.x, a1.y - a3.y};
  }
}
DEV void s1_taps(const Params& p, f2* buf, float* red, int c, int tid, int nthr) {
  float ss = 0.f;
#pragma unroll 8
  for (int k = tid; k < NF; k += nthr) {
    float v = 0.f;
    if (k < N) v = p.F()[(size_t)k * 1024 + c];
    else if (k > N) v = p.F()[(size_t)(NF - k) * 1024 + 512 + c];
    buf[k] = f2{v, 0.f}; ss += v * v;
  }
  red[tid] = ss;
}
DEV float red_total(const float* red, int nthr) { float s = 0.f; for (int i = 0; i < nthr; ++i) s += red[i]; return s; }
DEV void s3_store(const f2* buf, unsigned* hs, int tid, int nthr) {
  for (int k = tid; k < NF; k += nthr) hs[k] = (unsigned)f2b(buf[k].x).v | ((unsigned)f2b(buf[k].y).v << 16);
}
DEV void s4_loadz(const Params& p, f2* buf, int c, int tid, int nthr) {
#pragma unroll 8
  for (int t = tid; t < NF; t += nthr) {
    f2 v{0.f, 0.f};
    if (t < N) { v.x = b2f(p.Z()[(size_t)t * 512 + c]); v.y = b2f(p.Z()[(size_t)(N + t) * 512 + c]); }
    buf[t] = v;
  }
}
DEV void s6_mul(f2* buf, const unsigned* hs, int tid, int nthr) {
  for (int k = tid; k < NF; k += nthr) {
    union { unsigned u; float f; } a, b; const unsigned w = hs[k]; a.u = w << 16; b.u = w & 0xFFFF0000u;
    buf[k] = cmul(buf[k], f2{a.f, b.f});
  }
}
DEV void s8_out(const Params& p, const f2* buf, const float* red, int l, int c, int tid, int nthr) {
  const float fn = 1.0f / sqrtf(red_total(red, nthr) + EPS) * (1.0f / (float)NF);
  const float* cw = p.in[I_hy_conv_w] + l * 3 * 1536; const float cb = p.in[I_hy_conv_b][l * 1536 + c];
  const float w0 = cw[c], w1 = cw[1536 + c], w2 = cw[2 * 1536 + c];
  const float skip = p.in[I_hy_skip][l * 512 + c];
#pragma unroll 4
  for (int i = tid; i < 2 * N; i += nthr) {
    const int b = i / N, t = i - b * N;
    const size_t r = (size_t)b * N + t;
    const float conv = (b ? buf[t].y : buf[t].x) * fn;
    float x0 = cb + w1 * b2f(p.P()[r * PC + C_HU + c]);
    if (t > 0) x0 += w0 * b2f(p.P()[(r - 1) * PC + C_HU + c]);
    if (t < N - 1) x0 += w2 * b2f(p.P()[(r + 1) * PC + C_HU + c]);
    const float y = conv + skip * b2f(p.Z()[r * 512 + c]);
    p.Y()[r * 2048 + 1024 + c] = f2b(x0 * y);
  }
}
#ifndef CPU_SIM
DEV void channel(const Params& p, int l, int c, int tid, f2* buf, float* red, unsigned* hs) {
  const f2* tw = (const f2*)p.tw();
#ifndef HY_EXP
#define HY_EXP 0
#endif
  __syncthreads();
  if (HY_EXP != 2) s1_taps(p, buf, red, c, tid, 512); __syncthreads();
  if (HY_EXP != 1) for (int L = NF; L >= 4; L >>= 2) { fwd_pass(buf, tw, L, tid, 512); __syncthreads(); }
  s3_store(buf, hs, tid, 512); __syncthreads();
  if (HY_EXP != 2) s4_loadz(p, buf, c, tid, 512); __syncthreads();
  if (HY_EXP != 1) for (int L = NF; L >= 4; L >>= 2) { fwd_pass(buf, tw, L, tid, 512); __syncthreads(); }
  s6_mul(buf, hs, tid, 512); __syncthreads();
  if (HY_EXP != 1) for (int L = 4; L <= NF; L <<= 2) { inv_pass(buf, tw, L, tid, 512); __syncthreads(); }
  if (HY_EXP != 2) s8_out(p, buf, red, l, c, tid, 512);
}
#endif
}


namespace tz {
constexpr int NBLK = N / 64;
constexpr int PADB = 31;
constexpr int ZLEN = (NBLK + 2 * PADB) * 64;
constexpr int HLEN = 2 * N + 16;
DEV int a_index(int m, int r, int h) { return N - m - r + 8 * h; }
DEV int b_index(int t1, int Dd, int ks, int h) { return 64 * (t1 - Dd + PADB) + 16 * ks + 8 * h; }
#ifndef CPU_SIM
using bf16x8 = __attribute__((ext_vector_type(8))) short;
using f32x16 = __attribute__((ext_vector_type(16))) float;
using u32x4 = __attribute__((ext_vector_type(4))) unsigned;
DEV bf16x8 load_afrag(const unsigned short* Hr, int e) {
  const unsigned* wp = (const unsigned*)(Hr + (e & ~1));
  const unsigned w0 = wp[0], w1 = wp[1], w2 = wp[2], w3 = wp[3], w4 = wp[4];
  const unsigned sh = (unsigned)(e & 1) << 4;
  u32x4 o;
  o.x = __builtin_amdgcn_alignbit(w1, w0, sh); o.y = __builtin_amdgcn_alignbit(w2, w1, sh); o.z = __builtin_amdgcn_alignbit(w3, w2, sh); o.w = __builtin_amdgcn_alignbit(w4, w3, sh);
  return *reinterpret_cast<bf16x8*>(&o);
}
DEV void channel(const Params& p, int l, int c, int tid, char* lds) {
  unsigned short* zp = (unsigned short*)lds;
  float* red = (float*)(zp + 2 * ZLEN);
  unsigned short* Hr = (unsigned short*)(red + 512);
  float* cv = (float*)Hr;
  const int lane = tid & 63, w = tid >> 6, r = lane & 31, h = lane >> 5;
  __syncthreads();
  float ss = 0.f;
  const float* ff = p.F() + (size_t)c * (N + LC); const float* fb = p.F() + (size_t)(512 + c) * (N + LC);
#pragma unroll 4
  for (int t = tid * 4; t < N; t += 2048) {
    const float4 a = *(const float4*)(ff + t), b = *(const float4*)(fb + t);
    ss += a.x * a.x + a.y * a.y + a.z * a.z + a.w * a.w + b.x * b.x + b.y * b.y + b.z * b.z + b.w * b.w;
    Hr[N - t] = f2b(a.x).v; Hr[N - t - 1] = f2b(a.y).v; Hr[N - t - 2] = f2b(a.z).v; Hr[N - t - 3] = f2b(a.w).v;
    if (t > 0) Hr[N + t] = f2b(b.x).v;
    Hr[N + t + 1] = f2b(b.y).v; Hr[N + t + 2] = f2b(b.z).v; Hr[N + t + 3] = f2b(b.w).v;
  }
  if (tid == 0) Hr[0] = 0;
  if (tid < 16) Hr[2 * N + tid] = 0;
  red[tid] = ss;
  for (int i = tid; i < 2 * PADB * 64; i += 512) {
    const int side = i / (PADB * 64), k = i % (PADB * 64);
    const int off = side ? (PADB + NBLK) * 64 + k : k;
    zp[off] = 0; zp[ZLEN + off] = 0;
  }
  { const unsigned short* zt = (const unsigned short*)p.Z() + (size_t)c * NB * N;
#pragma unroll 4
    for (int i = tid * 8; i < 2 * N; i += 4096) { const int b = i / N, t = i - b * N; *(uint4*)(zp + b * ZLEN + PADB * 64 + t) = *(const uint4*)(zt + i); } }
  __syncthreads();
  float tot = 0.f;
  for (int i = 0; i < 512; ++i) tot += red[i];
  const float fn = 1.0f / sqrtf(tot + EPS);
  const int t1 = 32 * (w & 3) + r;
  const unsigned short* zb = zp + (w >> 2) * ZLEN;
  f32x16 acc0 = {}, acc1 = {};
  const int Dlo = 32 * (w & 3) - (NBLK - 1), Dhi = 32 * (w & 3) + 31;
#define TZ_LOAD(AF, BF, PA, PB) do { _Pragma("unroll") for (int ks = 0; ks < 4; ++ks) BF[ks] = *reinterpret_cast<const bf16x8*>((PB) + 16 * ks); \
    _Pragma("unroll") for (int q = 0; q < 6; ++q) { const unsigned* wq_ = (PA) + 8 * (5 - q); const unsigned w0_ = wq_[0], w1_ = wq_[1], w2_ = wq_[2], w3_ = wq_[3], w4_ = wq_[4]; u32x4 o_; \
      o_.x = __builtin_amdgcn_alignbit(w1_, w0_, shA); o_.y = __builtin_amdgcn_alignbit(w2_, w1_, shA); o_.z = __builtin_amdgcn_alignbit(w3_, w2_, shA); o_.w = __builtin_amdgcn_alignbit(w4_, w3_, shA); \
      AF[q] = *reinterpret_cast<bf16x8*>(&o_); } } while (0)
#define TZ_MMA(AF, BF) do { _Pragma("unroll") for (int ks = 0; ks < 4; ++ks) { \
    acc0 = __builtin_amdgcn_mfma_f32_32x32x16_bf16(AF[3 - ks], BF[ks], acc0, 0, 0, 0); acc1 = __builtin_amdgcn_mfma_f32_32x32x16_bf16(AF[5 - ks], BF[ks], acc1, 0, 0, 0); } } while (0)
  const unsigned shA = (unsigned)(r & 1) << 4;
  const unsigned* pa = (const unsigned*)Hr + ((a_index(64 * Dlo - 48 + 80, r, h) & ~1) >> 1);
  const unsigned short* pb = zb + b_index(t1, Dlo, 0, h);
#define TZ_LOAD4(AF, BF, PREV, PA, PB) do { _Pragma("unroll") for (int ks = 0; ks < 4; ++ks) BF[ks] = *reinterpret_cast<const bf16x8*>((PB) + 16 * ks); \
    AF[0] = PREV[4]; AF[1] = PREV[5]; \
    _Pragma("unroll") for (int q = 2; q < 6; ++q) { const unsigned* wq_ = (PA) + 8 * (5 - q); const unsigned w0_ = wq_[0], w1_ = wq_[1], w2_ = wq_[2], w3_ = wq_[3], w4_ = wq_[4]; u32x4 o_; \
      o_.x = __builtin_amdgcn_alignbit(w1_, w0_, shA); o_.y = __builtin_amdgcn_alignbit(w2_, w1_, shA); o_.z = __builtin_amdgcn_alignbit(w3_, w2_, shA); o_.w = __builtin_amdgcn_alignbit(w4_, w3_, shA); \
      AF[q] = *reinterpret_cast<bf16x8*>(&o_); } } while (0)
  bf16x8 afA[6], bfA[4], afB[6], bfB[4];
  TZ_LOAD(afA, bfA, pa, pb);
#pragma unroll 1
  for (int Dd = Dlo; Dd + 2 <= Dhi; Dd += 2) {
    TZ_LOAD4(afB, bfB, afA, pa - 32, pb - 64);
    TZ_MMA(afA, bfA);
    pa -= 64; pb -= 128;
    TZ_LOAD4(afA, bfA, afB, pa, pb);
    TZ_MMA(afB, bfB);
  }
  TZ_MMA(afA, bfA);
#undef TZ_LOAD4
#undef TZ_LOAD
#undef TZ_MMA
  static_assert((NBLK + 31) % 2 == 1, "K-loop pairing assumes an odd number of steps");
  __syncthreads();
  { int t1e = t1, he = h;
    asm volatile("" : "+v"(t1e), "+v"(he));
    float* cvb = cv + (w >> 2) * N + 64 * t1e + 4 * he;
#pragma unroll
    for (int g = 0; g < 4; ++g) {
      *(float4*)(cvb + 8 * g) = float4{acc0[4 * g], acc0[4 * g + 1], acc0[4 * g + 2], acc0[4 * g + 3]};
      *(float4*)(cvb + 32 + 8 * g) = float4{acc1[4 * g], acc1[4 * g + 1], acc1[4 * g + 2], acc1[4 * g + 3]};
    } }
  __syncthreads();
  { const float skip = p.in[I_hy_skip][l * 512 + c];
    unsigned short* xy = (unsigned short*)p.XYT() + (size_t)c * NB * N;
#pragma unroll 4
    for (int i = tid * 8; i < 2 * N; i += 4096) {
      const int b = i / N, t = i - b * N;
      float x0[8]; unpack8(*(const uint4*)(xy + i), x0);
      float zf[8]; unpack8(*(const uint4*)(zp + b * ZLEN + PADB * 64 + t), zf);
      const float4 ca = *(const float4*)(cv + i), cb4 = *(const float4*)(cv + i + 4);
      float o[8];
      o[0] = x0[0] * (ca.x * fn + skip * zf[0]); o[1] = x0[1] * (ca.y * fn + skip * zf[1]); o[2] = x0[2] * (ca.z * fn + skip * zf[2]); o[3] = x0[3] * (ca.w * fn + skip * zf[3]);
      o[4] = x0[4] * (cb4.x * fn + skip * zf[4]); o[5] = x0[5] * (cb4.y * fn + skip * zf[5]); o[6] = x0[6] * (cb4.z * fn + skip * zf[6]); o[7] = x0[7] * (cb4.w * fn + skip * zf[7]);
      store8bf(p.YT() + (size_t)c * NB * N + i, o);
    } }
}
DEV void xyt_to_y(const Params& p, int tid, char* lds) {
  unsigned short* tl = (unsigned short*)lds;
  for (int tile = blockIdx.x; tile < (NLAT / 64) * 8; tile += gridDim.x) {
    const int rt = tile >> 3, c0 = (tile & 7) * 64;
    const int bq = (rt * 64) / N, tq = (rt * 64) % N;
    __syncthreads();
    { const int cc = tid >> 3, tg = (tid & 7) * 8;
      const uint4 v = *(const uint4*)((const unsigned short*)p.YT() + ((size_t)(c0 + cc) * NB + bq) * N + tq + tg);
      const unsigned short* e = (const unsigned short*)&v;
#pragma unroll
      for (int j = 0; j < 8; ++j) tl[(tg + j) * 72 + cc] = e[j]; }
    __syncthreads();
    { const int tr = tid >> 3, cg8 = (tid & 7) * 8;
      *(uint4*)((unsigned short*)p.Y() + (size_t)(rt * 64 + tr) * 2048 + 1024 + c0 + cg8) = *(const uint4*)(tl + tr * 72 + cg8); }
  }
}
#endif
}

#ifndef CPU_SIM
DEV void ph_hyena_fft(const Params& p, const Ctx& cx, int l) {
  const int nb = gridDim.x;
  for (int i = blockIdx.x; i < 512; i += nb) {
    const int xcd = i & 7, idx = i >> 3;
    const int c = xcd * 64 + idx;
    tz::channel(p, l, c, cx.tid, cx.ldsg);
  }
}
#endif


#ifndef CPU_SIM
DEV void ph_hyena_ctx(const Params& p, const Ctx& cx, int l) {
  constexpr int LP = 33;
  float* Zs = (float*)cx.ldsg; float* Ff = Zs + LC * LP; float* Fb = Ff + LC * LP;
  const int tid = cx.tid, c = tid & 31, t0 = tid >> 5;
  const float* cw = p.in[I_hy_conv_w] + l * 3 * 1536; const float* cbv = p.in[I_hy_conv_b] + l * 1536;
  constexpr int TP = 8, TLEN = LC / TP;
  for (int task = blockIdx.x; task < NB * 16 * TP; task += gridDim.x) {
    const int tp = task % TP, cgp = (task / TP) & 15, b = task / (TP * 16), c0 = cgp * 32;
    const int rbase = NLAT + b * LC;
    __syncthreads();
    for (int idx = tid; idx < LC * 32; idx += 512) {
      { const int t = idx >> 5, cc = idx & 31; Zs[t * LP + cc] = b2f(p.Z()[(size_t)(rbase + t) * 512 + c0 + cc]); }
      { const int cc = idx / LC, t = idx % LC;
        Ff[t * LP + cc] = p.F()[(size_t)(c0 + cc) * (N + LC) + N + t]; Fb[t * LP + cc] = p.F()[(size_t)(512 + c0 + cc) * (N + LC) + N + t]; }
    }
    __syncthreads();
    float ss = 0.f;
    for (int t = 0; t < LC; ++t) { const float a = Ff[t * LP + c], bb = Fb[t * LP + c]; ss += a * a + bb * bb; }
    const float fn = 1.0f / sqrtf(ss + EPS);
    const int cg_ = c0 + c;
    const float w0 = cw[cg_], w1 = cw[1536 + cg_], w2 = cw[2 * 1536 + cg_], cb0 = cbv[cg_], skip = p.in[I_hy_skip][l * 512 + cg_];
    for (int t = tp * TLEN + t0; t < (tp + 1) * TLEN; t += 16) {
      float acc = 0.f;
      for (int s_ = 0; s_ <= t; ++s_) acc += Ff[(t - s_) * LP + c] * Zs[s_ * LP + c];
      for (int s_ = t + 1; s_ < LC; ++s_) acc += Fb[(s_ - t) * LP + c] * Zs[s_ * LP + c];
      const size_t r = (size_t)(rbase + t);
      float x0 = cb0 + w1 * b2f(p.P()[r * PC + C_HU + cg_]);
      if (t > 0) x0 += w0 * b2f(p.P()[(r - 1) * PC + C_HU + cg_]);
      if (t < LC - 1) x0 += w2 * b2f(p.P()[(r + 1) * PC + C_HU + cg_]);
      p.Y()[r * 2048 + 1024 + cg_] = f2b(x0 * (acc * fn + skip * Zs[t * LP + c]));
    }
  }
}
#endif

constexpr int NOSH = 30;

#ifndef CPU_SIM
#define SIDE_PREP(NB0, PARTS) do { if (l == 0 && (int)blockIdx.x >= (NB0)) { PrepCtx pc; pc.tid = cx.tid; pc.tl = (float*)cx.ldsg; pc.rank = (int)blockIdx.x - (NB0); pc.nranks = (int)gridDim.x - (NB0); \
    ph_prep(p, 1, pc, gtid - (NB0) * 512, gsz - (NB0) * 512, (PARTS)); } } while (0)
#else
#define SIDE_PREP(NB0, PARTS)
#endif
DEV void run_phase(const Params& p, int ph, const Ctx& cx) {
  const i64 gtid = cx.gtid, gsz = cx.gsz;
  if (ph == 0) { ph_init(p, gtid, gsz); return; }
  if (ph == NPHASES - 1) { ph_final(p, gtid, gsz); return; }
  const int l = (ph - 1) / PH_PER_LAYER, s = (ph - 1) % PH_PER_LAYER;
  const int last = (l == 1);
  const int nr = last ? NLAT : TT;
#ifdef ONLY
  if (s != ONLY) return;
#endif
  switch (s) {
    case 0: {
      PrepCtx pc;
#ifndef CPU_SIM
      pc.tid = cx.tid; pc.tl = (float*)cx.ldsg; pc.rank = (int)blockIdx.x; pc.nranks = (int)gridDim.x;
      if (l == 0) ph_prep(p, l, pc, gtid, gsz, 15); else ph_prep(p, l, pc, gtid, gsz, 8);
#else
      pc.gtid = gtid; pc.gsz = gsz;
      ph_prep(p, l, pc, gtid, gsz, 15);
#endif
      ph_norm(p, l, 0, TT, gtid, gsz);
    } break;
    case 1: { GemmDesc g{p.h(), p.W_in(), D, D, D, TT, 3840, NOSH, 0}; EpiInproj e{p}; run_gemm(cx, g, e); } break;
#ifndef CPU_SIM
    case 2: ph_B0(p, l, gtid, gsz, cx.ldsg, cx.tid); break;
#else
    case 2: ph_B0(p, l, gtid, gsz); break;
#endif
    case 3: {
      { const int n_uq = (nr / 256) * 3, n_ukv = (TT / 256) * 4, n_lru = (TT / 256) * 8;
        { GemmDesc g{p.P() + C_CQ, p.W_uq(), PC, 256, 256, nr, 768, NOSH, 0}; EpiUq e{p}; run_gemm(cx, g, e); }
        { GemmDesc g{p.P() + C_CKV, p.W_ukv(), PC, 256, 256, TT, 1024, NOSH, 0}; g.unit_off = n_uq; EpiUkv e{p}; run_gemm(cx, g, e); }
        { GemmDesc g{p.XC(), p.W_lru(), 512, 256, 256, TT, 2048, 2, 256}; g.unit_off = n_uq + n_ukv; EpiLru e{p, l, p.in[I_lru_b_r], p.in[I_lru_b_i]}; run_gemm(cx, g, e); }
#ifndef CPU_SIM
        { GemmDesc g{p.W3T(), p.hdn2b() + (size_t)l * (N + LC) * 256, 256, 256, 256, 1024, N + LC, NOSH, 0}; g.unit_off = n_uq + n_ukv + n_lru; EpiFilt e{p}; run_gemm(cx, g, e); }
#endif
      }
#ifdef CPU_SIM
      ph_fnorm(p, gtid, gsz);
#endif
    } break;
    case 4:
      ph_lru1(p, gtid, gsz);
#ifndef CPU_SIM
#if PROBE_K >= 0
#define SUBSTAMP(k) do { cg::this_grid().sync(); if (l == 0) { const unsigned long long t_ = wall_clock64(); if (blockIdx.x == 0 && cx.tid == 0) ((unsigned long long*)(p.ws + WL.ts))[40 + (k)] = t_; } } while (0)
#else
#define SUBSTAMP(k)
#endif
      if (REPEAT_S == 40) ph_lru1(p, gtid, gsz);
      SUBSTAMP(0);
      ph_hyena_fft(p, cx, l);
      if (REPEAT_S == 41) ph_hyena_fft(p, cx, l);
      SUBSTAMP(1);
      ph_gqa(p, cx, l, last);
      if (REPEAT_S == 42) ph_gqa(p, cx, l, last);
      SUBSTAMP(2);
      ph_mla(p, cx, last);
      if (REPEAT_S == 43) ph_mla(p, cx, last);
      SUBSTAMP(3);
      if (!last) ph_hyena_ctx(p, cx, l);
      if (REPEAT_S == 44 && !last) ph_hyena_ctx(p, cx, l);
#else
      ph_C(p, l, last, gtid, gsz);
#endif
      break;
#ifndef CPU_SIM
    case 5: ph_lru3(p, last, gtid, gsz, (float*)cx.ldsg, cx.tid); __syncthreads(); tz::xyt_to_y(p, cx.tid, cx.ldsg); break;
#else
    case 5: ph_lru3(p, last, gtid, gsz, nullptr, 0); break;
#endif
    case 6: { GemmDesc g{p.h(), p.W_g(), D, D, D, nr, 4096, NOSH, 0}; EpiGateAll e{p}; run_gemm(cx, g, e); } break;
    case 7: { GemmDesc g{p.Y(), p.W_br(), 2048, 512, 512, nr, 1024, NOSH, 0, 4, 512, 1024 * 512}; EpiBranchSub e{p}; run_gemm(cx, g, e); }
      SIDE_PREP(8, 1);
      break;
    case 8: { GemmDesc g{p.M(), p.W_out(), D, D, D, nr, 1024, NOSH, 0}; EpiOut e{p, l, 1.0f, l == 0 ? p.in[I_x] : (const float*)p.xcur(), l == 0 ? p.in[I_ctx] : (const float*)p.xcur() + (size_t)NLAT * D}; run_gemm(cx, g, e); }
#ifndef CPU_SIM
      if (l == 0 && blockIdx.x >= 8) ph_cvt_tables(p, l, gtid - 8 * 512, gsz - 8 * 512);
#endif
      break;
    case 9:
#ifndef CPU_SIM
      if (l != 0) ph_cvt_tables(p, l, gtid, gsz);
#endif
      ph_norm(p, l, 1, nr, gtid, gsz); break;
    case 10: { GemmDesc g{p.h(), p.W_q(), D, D, D, nr, 1024, NOSH, 0}; EpiPQ e{p}; run_gemm(cx, g, e); }
      SIDE_PREP(8, 2);
      break;
    case 11: { GemmDesc g{p.PQ(), p.W_key(), 1024, 256, 256, nr, 2048, 1, 256}; EpiSC e{p}; run_gemm(cx, g, e); }
      SIDE_PREP(16, 4);
      break;
#ifndef CPU_SIM
    case 12: ph_peer(p, l, nr, cx.tid, cx.ldsg); if (REPEAT_S == 52) { __syncthreads(); ph_peer(p, l, nr, cx.tid, cx.ldsg, 0.0f); } break;
#else
    case 12: ph_E2a(p, nr, gtid, gsz); break;
    case 13: ph_E2b(p, nr, gtid, gsz); break;
    case 14: ph_E3(p, l, nr, gtid, gsz); break;
    case 15: ph_E4(p, l, nr, gtid, gsz); break;
#endif
  }
}

#ifdef CPU_SIM
static void fill_params(Params& p, void* const* d_in, void* d_out, void* d_ws) {
  p.in.t = (const float* const*)d_in;
  p.out = (float*)d_out;
  p.ws = (char*)d_ws;
}
#endif


#ifndef CPU_SIM
#define XB_TMO      128
#define XB_XCNT(j)  (256  + 64 * (j))
#define XB_XSUB(j)  (1280 + 64 * (j))
#define XB_XGEN(j)  (2304 + 64 * (j))
#define XB_TOP      3328
#define XB_TOPGEN   3392
#define XCD_BAR_WORDS 3456
#define XB_SPIN_CAP (1u << 18)
#define XB_LAS __attribute__((address_space(3)))
__device__ __forceinline__ unsigned xb_ld(unsigned* p)              { return __hip_atomic_load(p, __ATOMIC_RELAXED, __HIP_MEMORY_SCOPE_AGENT); }
__device__ __forceinline__ unsigned xb_add(unsigned* p, unsigned v) { return __hip_atomic_fetch_add(p, v, __ATOMIC_RELAXED, __HIP_MEMORY_SCOPE_AGENT); }
__device__ __forceinline__ unsigned xb_xcc_id() { return (unsigned)__builtin_amdgcn_s_getreg((3 << 11) | 20) & 0xFu; }
#define XB_SPIN(cond, bar) do { unsigned _sp = 0; while (cond) { __builtin_amdgcn_s_sleep(1); \
    if ((++_sp & 255u) == 0u) { if (xb_ld(&(bar)[XB_TMO])) break; if (_sp > XB_SPIN_CAP) { atomicAdd(&(bar)[XB_TMO], 1u); break; } } } } while (0)
struct XcdBarrier { unsigned* bar; unsigned x; volatile XB_LAS unsigned* st; };
__device__ __forceinline__ XcdBarrier xcd_barrier_post(unsigned* bar, volatile XB_LAS unsigned* st) {
  XcdBarrier b; b.bar = bar; b.x = xb_xcc_id(); b.st = st;
  if (threadIdx.x == 0) (void)xb_add(&bar[XB_XCNT(b.x)], 1u);
  return b;
}
__device__ __forceinline__ void xcd_barrier_complete(unsigned* bar, unsigned x, unsigned& nloc, unsigned& nx) {
  const unsigned G = gridDim.x * gridDim.y * gridDim.z;
  unsigned sum, cnt, mine, sp = 0u;
  for (;;) {
    sum = 0u; cnt = 0u; mine = 0u;
#pragma unroll
    for (unsigned j = 0; j < 16; ++j) { const unsigned c = xb_ld(&bar[XB_XCNT(j)]); sum += c; cnt += (c > 0u) ? 1u : 0u; mine = (j == x) ? c : mine; }
    if (sum == G) break;
    __builtin_amdgcn_s_sleep(1);
    if ((++sp & 255u) == 0u) { if (xb_ld(&bar[XB_TMO])) break; if (sp > XB_SPIN_CAP) { atomicAdd(&bar[XB_TMO], 1u); break; } }
  }
  nloc = mine > 0u ? mine : 1u; nx = cnt > 0u ? cnt : 1u;
}
__device__ __forceinline__ void xcd_barrier(const XcdBarrier& b) {
  asm volatile("s_waitcnt vmcnt(0)" ::: "memory");
  __syncthreads();
  if (threadIdx.x == 0) {
    unsigned* bar = b.bar;
    __builtin_amdgcn_s_waitcnt(0);
    unsigned nloc = b.st[0], nx = b.st[1];
    if (nloc == 0u) { xcd_barrier_complete(bar, b.x, nloc, nx); b.st[0] = nloc; b.st[1] = nx; }
    const unsigned old = xb_add(&bar[XB_XSUB(b.x)], 1u);
    const unsigned gen = old / nloc;
    if (old + 1u == (gen + 1u) * nloc) {
      __builtin_amdgcn_fence(__ATOMIC_RELEASE, "agent");
      asm volatile("s_waitcnt vmcnt(0)" ::: "memory");
      const unsigned og = xb_add(&bar[XB_TOP], 1u);
      const unsigned tg = og / nx;
      if (og + 1u == (tg + 1u) * nx) xb_add(&bar[XB_TOPGEN], 1u);
      else XB_SPIN(xb_ld(&bar[XB_TOPGEN]) == tg, bar);
      __builtin_amdgcn_fence(__ATOMIC_ACQUIRE, "agent");
      xb_add(&bar[XB_XGEN(b.x)], 1u);
      asm volatile("s_waitcnt vmcnt(0)" ::: "memory");
    } else {
      XB_SPIN(xb_ld(&bar[XB_XGEN(b.x)]) == gen, bar);
      __builtin_amdgcn_fence(__ATOMIC_ACQUIRE, "agent");
      asm volatile("s_waitcnt vmcnt(0)" ::: "memory");
    }
  }
  __syncthreads();
}
#endif

#ifndef CPU_SIM
static_assert(TT % 256 == 0 && NLAT % 256 == 0 && (N + LC) % 256 == 0, "row / column tiles");
static_assert(N / 256 == 32 && NB * 8 * (N / 256) == 512, "attention unit mapping assumes 32 q-blocks per (batch, head) and a 256-block grid");
constexpr int LDS_PHASE_BYTES = 131072 + 4096;
constexpr int LDS_BYTES = LDS_PHASE_BYTES + 16;
__global__ void __launch_bounds__(512, 2) mega_kernel(KArgs ka) {
  extern __shared__ __attribute__((aligned(16))) unsigned char shm[];
  cg::grid_group grid = cg::this_grid();
#if PROBE_K >= 0
  unsigned long long* const tsp = (unsigned long long*)(ka.ws + WL.ts);
#endif
  {
    int tid = threadIdx.x;
    asm volatile("" : "+v"(tid));
    const i64 gtid = (i64)blockIdx.x * 512 + tid, gsz = (i64)gridDim.x * 512;
    ph_init(ka, gtid, gsz, (char*)shm, tid);
    if (gtid < N_IN) ((const float**)(ka.ws + WL.tbl))[gtid] = ka.in[gtid];
#if PROBE_K >= 0
    { const unsigned long long t_ = wall_clock64(); if (gtid == 0) tsp[0] = t_; }
#endif
  }
  volatile XB_LAS unsigned* xst = (volatile XB_LAS unsigned*)(shm + LDS_PHASE_BYTES);
  if (threadIdx.x == 0) { xst[0] = 0u; xst[1] = 0u; }
  __syncthreads();
  const XcdBarrier xb = xcd_barrier_post((unsigned*)(ka.ws + WL.bar), xst);
  grid.sync();
#if PROBE_K >= 0
  { const unsigned long long t_ = wall_clock64(); if (blockIdx.x == 0 && threadIdx.x == 0) tsp[1] = t_; }
#endif
  Params p; p.out = ka.out; p.ws = ka.ws; p.in.t = (const float* const*)(ka.ws + WL.tbl);
  for (int ph = 1; ph < NPHASES - 1; ++ph) {
    int tid = threadIdx.x;
    asm volatile("" : "+v"(tid));
    Ctx cx;
    cx.tid = tid;
    cx.gtid = (i64)blockIdx.x * 512 + tid; cx.gsz = (i64)gridDim.x * 512;
    cx.lds = (PG8_LAS unsigned char*)shm; cx.ldsg = (char*)shm;
    run_phase(p, ph, cx);
    if (REPEAT_S >= 0 && REPEAT_S < 40 && (ph - 1) % PH_PER_LAYER == REPEAT_S) { __syncthreads(); run_phase(p, ph, cx); }
    xcd_barrier(xb);
#if PROBE_K >= 0
    { const unsigned long long t_ = wall_clock64(); if (blockIdx.x == 0 && threadIdx.x == 0) tsp[ph + 1] = t_; }
    if (ph == NPHASES - 2) grid.sync();
#endif
  }
  {
    int tid = threadIdx.x;
    asm volatile("" : "+v"(tid));
    ph_final(p, (i64)blockIdx.x * 512 + tid, (i64)gridDim.x * 512);
  }
}

extern "C" void kernel_launch(void* const* d_in, const int* in_sizes, int n_in, void* d_out, int out_size,
                              void* d_ws, size_t ws_size, hipStream_t stream) {
  static int grid_blocks = 0;
  if (!grid_blocks) {
    int dev = 0, cus = 0, per_cu = 0;
    (void)hipGetDevice(&dev);
    (void)hipDeviceGetAttribute(&cus, hipDeviceAttributeMultiprocessorCount, dev);
    if (hipFuncSetAttribute((const void*)mega_kernel, hipFuncAttributeMaxDynamicSharedMemorySize, LDS_BYTES) != hipSuccess)
      fprintf(stderr, "hipFuncSetAttribute failed\n");
    (void)hipOccupancyMaxActiveBlocksPerMultiprocessor(&per_cu, mega_kernel, 512, LDS_BYTES);
    if (per_cu > 1) per_cu = 1;
    if (per_cu < 1) per_cu = 1;
    grid_blocks = cus * per_cu;
  }
  (void)hipMemsetAsync((char*)d_ws + WL.bar, 0, (size_t)3456 * 4, stream);
  KArgs ka;
  std::memset((void*)&ka, 0, sizeof(ka));
  for (int i = 0; i < N_IN; ++i) ka.in[i] = (const float*)d_in[i];
  ka.out = (float*)d_out; ka.ws = (char*)d_ws;
  void* args[] = {&ka};
  hipError_t e = hipLaunchCooperativeKernel((void*)mega_kernel, dim3(grid_blocks), dim3(512), args, LDS_BYTES, stream);
  if (e != hipSuccess) fprintf(stderr, "cooperative launch failed: %s (grid %d)\n", hipGetErrorString(e), grid_blocks);
}
#endif
```

```cpp
#ifndef CPU_SIM
#include <hip/hip_runtime.h>
#include <hip/hip_cooperative_groups.h>
#include <cstdio>
#include <cstring>
namespace cg = cooperative_groups;
#define DEV __device__ __forceinline__
#define DEVN __device__ __forceinline__
#define MDEV __device__ __forceinline__
typedef _Float16 sc_t;
#else
#include <cmath>
#include <cstdio>
#include <cstdint>
#include <cstring>
#define DEV static inline
#define DEVN static
#define MDEV inline
typedef float sc_t;
#endif

#ifndef REPEAT_S
#define REPEAT_S -1
#endif
#ifndef PROBE_K
#define PROBE_K -1
#endif
#ifndef SEQ_N
#define SEQ_N 8192
#endif
#ifndef CTX_L
#define CTX_L 256
#endif

typedef long long i64;

constexpr int D = 1024, NB = 2, N = SEQ_N, LC = CTX_L;
constexpr int NLAT = NB * N, NCTX = NB * LC, TT = NLAT + NCTX;
constexpr int GRIDW = 64;
constexpr int INC = 7840, PC = 3840;
constexpr int C_CQ = 0, C_CKV = 256, C_KR = 384, C_LX = 416, C_LG = 928, C_HU = 1440, C_GQ = 2976, C_GKV = 3488, C_GT = 3744;
constexpr int NEXP = 16384;
constexpr float EPS = 1e-6f;
#ifndef CPU_SIM
constexpr int PH_PER_LAYER = 13;
#else
constexpr int PH_PER_LAYER = 16;
#endif
constexpr int NPHASES = 2 + 2 * PH_PER_LAYER;
constexpr int LCH = 64, NCC = LC / LCH, NCL = N / LCH, NCHK = NCC + NCL;

enum { I_x, I_c, I_ctx, I_c_ctx, I_g_mix, I_g_ffn, I_w_mod, I_b_mod, I_w_in, I_mla_g_cq, I_mla_g_ckv, I_mla_w_uq,
       I_mla_w_ukv, I_lru_conv_w, I_lru_conv_b, I_lru_w_r, I_lru_b_r, I_lru_w_i, I_lru_b_i, I_lru_lam,
       I_hy_conv_w, I_hy_conv_b, I_hy_w1, I_hy_b1, I_hy_f1, I_hy_w2, I_hy_b2, I_hy_f2, I_hy_w3, I_hy_skip,
       I_gqa_sink, I_w_branch, I_w_out, I_peer_w_q, I_peer_keys, I_peer_u, I_peer_v, I_g_final, N_IN };

struct bf { unsigned short v; };
DEV float b2f(bf x) { union { unsigned u; float f; } c; c.u = ((unsigned)x.v) << 16; return c.f; }
DEV bf f2b(float f) { union { unsigned u; float f; } c; c.f = f; unsigned r = c.u + 0x7FFFu + ((c.u >> 16) & 1u); bf o; o.v = (unsigned short)(r >> 16); return o; }


constexpr size_t al256(size_t x) { return (x + 255) & ~(size_t)255; }
struct WsLayout {
  size_t xcur, mods, hdn2, ssq, tabA, tabD, fnorm, SA, SB, tw, tbl, ts, spl, bar, hdn2b, W3T, h, Y, Z, XC, LA, LB, P, QA, KVA;
  size_t W_in, W_g, W_uq, W_ukv, W_lru, W_br, W_out, W_q, W_key;
  size_t M, Gs, G, SC, TKs, TKi, SELi, SELg, W, Ub, Vb, YT, total;
};
constexpr WsLayout make_layout() {
  WsLayout w{};
  size_t o = 0;
  w.xcur = o; o = al256(o + (size_t)TT * D * 4);
  w.mods = o; o = al256(o + (size_t)2 * 3 * 6 * D * 4);
  w.hdn2 = o; o = al256(o + (size_t)2 * (N + LC) * 64 * 4);
  w.ssq = o; o = al256(o + (size_t)2 * TT * 4);
  w.tabA = o; o = al256(o + (size_t)128 * 8 * 2 * 4);
  w.tabD = o; o = al256(o + (size_t)128 * 16 * 2 * 4);
  w.fnorm = o; o = al256(o + (size_t)2 * 512 * 4);
  w.tw = o; o = al256(o + (size_t)2 * N * 8);
  w.tbl = o; o = al256(o + (size_t)N_IN * 8);
  w.ts = o; o = al256(o + (size_t)64 * 8);
  w.spl = o; o = al256(o + (size_t)2 * 2 * 512 * 4);
  w.bar = o; o = al256(o + (size_t)3456 * 4);
  w.hdn2b = o; o = al256(o + (size_t)2 * (N + LC) * 256 * 2);
  w.W3T = o; o = al256(o + (size_t)1024 * 256 * 2);
  w.SA = o; o = al256(o + (size_t)2 * NB * NCHK * 512 * 4);
  w.SB = o; o = al256(o + (size_t)2 * NB * NCHK * 512 * 4);
  w.h = o; o = al256(o + (size_t)TT * D * 2);
  w.Y = o; w.Ub = o; w.Vb = o + (size_t)NEXP * D; o = al256(o + (size_t)TT * 2048 * 2);
  w.Z = o; o = al256(o + (size_t)TT * 512 * 2);
  w.W_in = o; o = al256(o + (size_t)3840 * 1024 * 2);
  w.W_g = o; o = al256(o + (size_t)4096 * 1024 * 2);
  w.W_uq = o; o = al256(o + (size_t)768 * 256 * 2);
  w.W_ukv = o; o = al256(o + (size_t)1024 * 256 * 2);
  w.W_lru = o; o = al256(o + (size_t)2048 * 256 * 2);
  w.W_br = o; o = al256(o + (size_t)4 * 1024 * 512 * 2);
  w.W_out = o; o = al256(o + (size_t)1024 * 1024 * 2);
  w.W_q = o; o = al256(o + (size_t)1024 * 1024 * 2);
  w.W_key = o; o = al256(o + (size_t)2048 * 256 * 2);
  size_t rl = o;
  w.XC = o; o = al256(o + (size_t)TT * 512 * 2);
  w.LA = o; o = al256(o + (size_t)2 * TT * 512 * 2);
  w.LB = o; o = al256(o + (size_t)2 * TT * 512 * 2);
  size_t rl_end = o;
  o = rl;
  w.TKs = o; o = al256(o + (size_t)TT * 256 * 4);
  w.TKi = o; o = al256(o + (size_t)TT * 256 * 4);
  w.SELi = o; o = al256(o + (size_t)TT * 128 * 4);
  w.SELg = o; o = al256(o + (size_t)TT * 128 * 4);
  w.W = o; o = al256(o + (size_t)TT * 128 * 4);
  if (o > rl_end) rl_end = o;
  o = rl_end;
  size_t rp = o;
  w.P = o; o = al256(o + (size_t)TT * PC * 2);
  w.QA = o; o = al256(o + (size_t)TT * 768 * 2);
  w.KVA = o; o = al256(o + (size_t)TT * 1024 * 2);
  size_t rp_end = o;
  o = rp;
  w.M = o; o = al256(o + (size_t)TT * D * 2);
  w.G = o; if (o + (size_t)TT * 3072 * 2 > rp_end) rp_end = o + (size_t)TT * 3072 * 2;
  w.Gs = o; o = al256(o + (size_t)TT * D * 2);
  w.SC = o; o = al256(o + (size_t)TT * 2048 * sizeof(sc_t));
  if (o > rp_end) rp_end = o;
  w.YT = rp_end; rp_end = al256(rp_end + (size_t)512 * NB * N * 2);
  w.total = rp_end;
  return w;
}
constexpr WsLayout WL = make_layout();
static_assert((size_t)TT * 4096 <= (size_t)TT * 512 * 2 + (size_t)4 * TT * 512 * 2, "uint8 gates must fit in the XC/LA/LB region");
static_assert(WL.LB == WL.LA + (size_t)2 * TT * 512 * 2, "LA and LB must be contiguous (packed GPU layout)");
static_assert(WL.total <= (size_t)512 * 1024 * 1024, "workspace too large");
#ifndef CPU_SIM
static_assert((size_t)2 * NEXP * D * 2 <= (size_t)TT * 2048 * 2, "bf16 expert tables must fit in Y");
#endif
struct WsAcc {
  float* out;
  char* ws;
  MDEV float* xcur() const { return (float*)(ws + WL.xcur); }
  MDEV float* mods() const { return (float*)(ws + WL.mods); }
  MDEV float* hdn2() const { return (float*)(ws + WL.hdn2); }
  MDEV float* ssq() const { return (float*)(ws + WL.ssq); }
  MDEV float* tabA() const { return (float*)(ws + WL.tabA); }
  MDEV float* tabD() const { return (float*)(ws + WL.tabD); }
  MDEV float* fnorm() const { return (float*)(ws + WL.fnorm); }
  MDEV float* tw() const { return (float*)(ws + WL.tw); }
  MDEV unsigned* Hs() const { return (unsigned*)((char*)out + (((size_t)(N + LC) * 1024 * 4 + 255) & ~(size_t)255)); }
  MDEV float* spl() const { return (float*)(ws + WL.spl); }
  MDEV bf* XYT() const { return (bf*)((char*)out + (((size_t)(N + LC) * 1024 * 4 + 255) & ~(size_t)255)); }
  MDEV bf* hdn2b() const { return (bf*)(ws + WL.hdn2b); }
  MDEV bf* W3T() const { return (bf*)(ws + WL.W3T); }
  MDEV float* SA() const { return (float*)(ws + WL.SA); }
  MDEV float* SB() const { return (float*)(ws + WL.SB); }
  MDEV bf* h() const { return (bf*)(ws + WL.h); }
  MDEV bf* Y() const { return (bf*)(ws + WL.Y); }
  MDEV bf* Z() const { return (bf*)(ws + WL.Z); }
  MDEV bf* XC() const { return (bf*)(ws + WL.XC); }
  MDEV bf* LA() const { return (bf*)(ws + WL.LA); }
  MDEV bf* LB() const { return (bf*)(ws + WL.LB); }
  MDEV bf* P() const { return (bf*)(ws + WL.P); }
  MDEV bf* QA() const { return (bf*)(ws + WL.QA); }
  MDEV bf* KVA() const { return (bf*)(ws + WL.KVA); }
  MDEV float* F() const { return out; }
  MDEV bf* W_in() const { return (bf*)(ws + WL.W_in); }
  MDEV bf* W_g() const { return (bf*)(ws + WL.W_g); }
  MDEV bf* W_uq() const { return (bf*)(ws + WL.W_uq); }
  MDEV bf* W_ukv() const { return (bf*)(ws + WL.W_ukv); }
  MDEV bf* W_lru() const { return (bf*)(ws + WL.W_lru); }
  MDEV bf* W_br() const { return (bf*)(ws + WL.W_br); }
  MDEV bf* W_out() const { return (bf*)(ws + WL.W_out); }
  MDEV bf* W_q() const { return (bf*)(ws + WL.W_q); }
  MDEV bf* W_key() const { return (bf*)(ws + WL.W_key); }
  MDEV bf* M() const { return (bf*)(ws + WL.M); }
  MDEV bf* Gs() const { return (bf*)(ws + WL.Gs); }
  MDEV bf* PQ() const { return (bf*)(ws + WL.Gs); }
  MDEV bf* BR() const { return (bf*)(ws + WL.G); }
  MDEV unsigned char* G8() const { return (unsigned char*)(ws + WL.XC); }
  MDEV unsigned* LAB() const { return (unsigned*)(ws + WL.LA); }
  MDEV bf* YT() const { return (bf*)(ws + WL.YT); }
  MDEV sc_t* SC() const { return (sc_t*)(ws + WL.SC); }
  MDEV float* TKs() const { return (float*)(ws + WL.TKs); }
  MDEV int* TKi() const { return (int*)(ws + WL.TKi); }
  MDEV int* SELi() const { return (int*)(ws + WL.SELi); }
  MDEV float* SELg() const { return (float*)(ws + WL.SELg); }
  MDEV float* W() const { return (float*)(ws + WL.W); }
  MDEV bf* Ub() const { return (bf*)(ws + WL.Ub); }
  MDEV bf* Vb() const { return (bf*)(ws + WL.Vb); }
};
struct KArgs : WsAcc { const float* in[N_IN]; };
#ifndef CPU_SIM
typedef float v4f_gl __attribute__((ext_vector_type(4)));
DEV float4 gld4(const void* q) { const v4f_gl r = *(const __attribute__((address_space(1))) v4f_gl*)q; return float4{r.x, r.y, r.z, r.w}; }
DEV float gld1(const float* q) { return *(const __attribute__((address_space(1))) float*)q; }
#else
DEV float gld1(const float* q) { return *q; }
#endif
#ifndef CPU_SIM
typedef const __attribute__((address_space(1))) float* GF;
#else
typedef const float* GF;
#endif
struct InTab {
  const float* const* t;
#ifndef CPU_SIM
  MDEV const float* operator[](int i) const { return t[i]; }
#else
  MDEV const float* operator[](int i) const { return t[i]; }
#endif
};
struct Params : WsAcc { InTab in; };
static_assert((size_t)(N + LC) * 1024 * 4 + 256 + (size_t)256 * 2 * N * 4 <= (size_t)NLAT * D * 4, "F + spectrum scratch must fit in d_out");

#ifndef CPU_SIM
DEV float fexpf_(float x) { return __builtin_amdgcn_exp2f(x * 1.4426950408889634f); }
DEV float sigmoidf_(float x) { return __builtin_amdgcn_rcpf(1.0f + __builtin_amdgcn_exp2f(-x * 1.4426950408889634f)); }
DEV float siluf_(float x) { return x * sigmoidf_(x); }
DEV float geluf_(float x) { return x * sigmoidf_(1.5957691216057308f * (x + 0.044715f * x * x * x)); }
#else
DEV float fexpf_(float x) { return expf(x); }
DEV float sigmoidf_(float x) { return 1.0f / (1.0f + expf(-x)); }
DEV float siluf_(float x) { return x * sigmoidf_(x); }
DEV float geluf_(float x) { return 0.5f * x * (1.0f + tanhf(0.7978845608028654f * (x + 0.044715f * x * x * x))); }
#endif
DEV float softplusf_(float x) { return x > 20.f ? x : log1pf(expf(x)); }

#ifndef CPU_SIM
DEV float lane_xor(float v, int lane, int o) { return __int_as_float(__builtin_amdgcn_ds_bpermute(((lane ^ o) & 63) << 2, __float_as_int(v))); }
#endif
#ifndef CPU_SIM
DEV void unpack8(const uint4 w, float* f) {
  union { unsigned u; float x; } c;
  c.u = w.x << 16; f[0] = c.x; c.u = w.x & 0xFFFF0000u; f[1] = c.x; c.u = w.y << 16; f[2] = c.x; c.u = w.y & 0xFFFF0000u; f[3] = c.x;
  c.u = w.z << 16; f[4] = c.x; c.u = w.z & 0xFFFF0000u; f[5] = c.x; c.u = w.w << 16; f[6] = c.x; c.u = w.w & 0xFFFF0000u; f[7] = c.x;
}
#endif
struct RowInfo { int b, t, L, base, lat; };
DEV RowInfo rowinfo(int r) {
  RowInfo ri;
  if (r < NLAT) { ri.b = r / N; ri.t = r - ri.b * N; ri.L = N; ri.base = ri.b * N; ri.lat = 1; }
  else { int rc = r - NLAT; ri.b = rc / LC; ri.t = rc - ri.b * LC; ri.L = LC; ri.base = NLAT + ri.b * LC; ri.lat = 0; }
  return ri;
}
DEV int modrow(int r) { return r < NLAT ? r / N : 2; }
template <class PT> DEV const float* xin_row(const PT& p, int r) { return r < NLAT ? p.in[I_x] + (size_t)r * D : p.in[I_ctx] + (size_t)(r - NLAT) * D; }

DEV void atomic_addf(float* p, float v) {
#ifndef CPU_SIM
  atomicAdd(p, v);
#else
#pragma omp atomic
  *p += v;
#endif
}
DEV void store8bf(bf* dst, const float* v) {
#ifndef CPU_SIM
  uint4 w;
  asm volatile("v_cvt_pk_bf16_f32 %0, %1, %2" : "=v"(w.x) : "v"(v[0]), "v"(v[1]));
  asm volatile("v_cvt_pk_bf16_f32 %0, %1, %2" : "=v"(w.y) : "v"(v[2]), "v"(v[3]));
  asm volatile("v_cvt_pk_bf16_f32 %0, %1, %2" : "=v"(w.z) : "v"(v[4]), "v"(v[5]));
  asm volatile("v_cvt_pk_bf16_f32 %0, %1, %2" : "=v"(w.w) : "v"(v[6]), "v"(v[7]));
  *(uint4*)dst = w;
#else
  for (int j = 0; j < 8; ++j) dst[j] = f2b(v[j]);
#endif
}
#ifndef CPU_SIM
DEV unsigned pk2bf(float lo, float hi) { unsigned r; asm volatile("v_cvt_pk_bf16_f32 %0, %1, %2" : "=v"(r) : "v"(lo), "v"(hi)); return r; }
#endif
DEV void load8bf(const bf* src, float* v) {
#ifndef CPU_SIM
  uint4 w = *(const uint4*)src;
  union { unsigned u; float f; } c;
  c.u = w.x << 16; v[0] = c.f; c.u = w.x & 0xFFFF0000u; v[1] = c.f;
  c.u = w.y << 16; v[2] = c.f; c.u = w.y & 0xFFFF0000u; v[3] = c.f;
  c.u = w.z << 16; v[4] = c.f; c.u = w.z & 0xFFFF0000u; v[5] = c.f;
  c.u = w.w << 16; v[6] = c.f; c.u = w.w & 0xFFFF0000u; v[7] = c.f;
#else
  for (int j = 0; j < 8; ++j) v[j] = b2f(src[j]);
#endif
}

DEV int win_src(int n) {
  if (n >= 3744) return -1;
  if (n >= C_KR && n < C_KR + 32) { int q = n - C_KR; int pi = q >> 1, wh = q & 1, half = pi >> 3, f = pi & 7; return C_KR + half * 16 + f + wh * 8; }
  if (n >= C_GQ && n < C_GKV + 128) { int q = n - C_GQ; int hh = q >> 6, d = q & 63; int pi = d >> 1, wh = d & 1, half = pi >> 4, f = pi & 15; return C_GQ + hh * 64 + half * 32 + f + wh * 16; }
  return n;
}
DEV int wuq_src(int n) {
  int hh = n / 96, d = n % 96;
  if (d < 64) return n;
  int q = d - 64; int pi = q >> 1, wh = q & 1, half = pi >> 3, f = pi & 7;
  return hh * 96 + 64 + half * 16 + f + wh * 8;
}

template <class PT> DEVN void ph_init(const PT& p, i64 gtid, i64 gsz, char* ilds = nullptr, int itid = 0) {
#ifndef CPU_SIM
  {
    float* sl = (float*)ilds;
    for (int q = itid; q < 3 * D; q += 512) { const int rr = q / D, k = q - rr * D; sl[q] = siluf_(rr < 2 ? p.in[I_c][rr * D + k] : p.in[I_c_ctx][k]); }
    __syncthreads();
    float* red3 = sl + 3 * D;
    const int wv_ = itid >> 6, ln_ = itid & 63;
    for (int task = blockIdx.x; task < 2 * 6 * D / 64; task += gridDim.x) {
      const int l = task / (6 * D / 64), j = (task % (6 * D / 64)) * 64 + ln_;
      const float* w = p.in[I_w_mod] + (size_t)l * D * 6 * D + j;
      float a0 = 0.f, a1 = 0.f, a2 = 0.f;
#pragma unroll 1
      for (int k0 = wv_ * 128; k0 < wv_ * 128 + 128; k0 += 16) {
        float wv[16];
#pragma unroll
        for (int q = 0; q < 16; ++q) wv[q] = w[(size_t)(k0 + q) * 6 * D];
#pragma unroll
        for (int q = 0; q < 16; ++q) { a0 += sl[k0 + q] * wv[q]; a1 += sl[D + k0 + q] * wv[q]; a2 += sl[2 * D + k0 + q] * wv[q]; }
      }
      __syncthreads();
      red3[(wv_ * 3 + 0) * 64 + ln_] = a0; red3[(wv_ * 3 + 1) * 64 + ln_] = a1; red3[(wv_ * 3 + 2) * 64 + ln_] = a2;
      __syncthreads();
      if (itid < 192) {
        const int v3 = itid >> 6, jj = itid & 63;
        float sum = p.in[I_b_mod][l * 6 * D + (task % (6 * D / 64)) * 64 + jj];
#pragma unroll
        for (int w8 = 0; w8 < 8; ++w8) sum += red3[(w8 * 3 + v3) * 64 + jj];
        p.mods()[((size_t)l * 3 + v3) * 6 * D + (task % (6 * D / 64)) * 64 + jj] = sum;
      }
    }
    __syncthreads();
  }
  {
    float* wl1 = (float*)ilds;
    float* wl2 = wl1 + 2 * 2240;
    float* h1 = wl2 + 2 * 4224;
    for (int q = itid; q < 2 * 2240; q += 512) { const int l = q / 2240, o = q - l * 2240;
      wl1[q] = o < 2112 ? p.in[I_hy_w1][l * 2112 + o] : (o < 2176 ? p.in[I_hy_b1][l * 64 + o - 2112] : p.in[I_hy_f1][l * 64 + o - 2176]); }
    for (int q = itid; q < 2 * 4224; q += 512) { const int l = q / 4224, o = q - l * 4224;
      wl2[q] = o < 4096 ? p.in[I_hy_w2][l * 4096 + o] : (o < 4160 ? p.in[I_hy_b2][l * 64 + o - 4096] : p.in[I_hy_f2][l * 64 + o - 4160]); }
    __syncthreads();
    const int per = (2 * (N + LC) + (int)gridDim.x - 1) / (int)gridDim.x;
    for (int base = 0; base < per; base += 128) {
      const int li = base + itid;
      const i64 i = (i64)blockIdx.x * per + li;
      if (itid < 128 && li < per && i < (i64)2 * (N + LC)) {
        const int l = (int)(i / (N + LC)), tt = (int)(i % (N + LC));
        int t, L; if (tt < N) { t = tt; L = N; } else { t = tt - N; L = LC; }
        const float tn = (float)t / (float)(L - 1);
        const float wt = 6.283185307179586f * (float)t / (float)L;
        const float* w1 = wl1 + l * 2240; const float* b1 = w1 + 2112; const float* f1 = w1 + 2176;
        const float* w2 = wl2 + l * 4224; const float* b2 = w2 + 4096; const float* f2 = w2 + 4160;
        { uint4* zp_ = (uint4*)(p.hdn2b() + ((size_t)l * (N + LC) + tt) * 256 + 64);
#pragma unroll
          for (int q = 0; q < 24; ++q) zp_[q] = uint4{0, 0, 0, 0}; }
        float zc[16], zs[16];
#pragma unroll
        for (int bd = 0; bd < 16; ++bd) { const float ang = (1e-4f + (float)bd * ((15.0f - 1e-4f) / 15.0f)) * wt; zc[bd] = cosf(ang); zs[bd] = sinf(ang); }
#pragma unroll 2
        for (int k1 = 0; k1 < 64; ++k1) {
          float a1 = b1[k1] + tn * w1[k1];
#pragma unroll
          for (int bd = 0; bd < 16; ++bd) a1 += zc[bd] * w1[(1 + bd) * 64 + k1] - zs[bd] * w1[(17 + bd) * 64 + k1];
          h1[k1 * 128 + itid] = sinf(f1[k1] * a1);
        }
#pragma unroll 1
        for (int j0 = 0; j0 < 64; j0 += 4) {
          float c0 = b2[j0], c1 = b2[j0 + 1], c2 = b2[j0 + 2], c3 = b2[j0 + 3];
#pragma unroll 8
          for (int k1 = 0; k1 < 64; ++k1) { const float hv = h1[k1 * 128 + itid]; const float4 wv = *(const float4*)(w2 + k1 * 64 + j0); c0 += hv * wv.x; c1 += hv * wv.y; c2 += hv * wv.z; c3 += hv * wv.w; }
          bf* ot = p.hdn2b() + ((size_t)l * (N + LC) + tt) * 256 + j0;
          ot[0] = f2b(sinf(f2[j0] * c0)); ot[1] = f2b(sinf(f2[j0 + 1] * c1)); ot[2] = f2b(sinf(f2[j0 + 2] * c2)); ot[3] = f2b(sinf(f2[j0 + 3] * c3));
        }
      }
    }
  }
#else
  for (i64 i = gtid; i < 2 * 3 * 6 * D; i += gsz) {
    int l = (int)(i / (3 * 6 * D)); int rr = (int)((i / (6 * D)) % 3); int j = (int)(i % (6 * D));
    const float* cv = rr < 2 ? p.in[I_c] + rr * D : p.in[I_c_ctx];
    const float* w = p.in[I_w_mod] + (size_t)l * D * 6 * D;
    float acc = p.in[I_b_mod][l * 6 * D + j];
    for (int k = 0; k < D; ++k) acc += siluf_(cv[k]) * w[(size_t)k * 6 * D + j];
    p.mods()[i] = acc;
  }
  for (i64 i = gtid; i < (i64)2 * (N + LC) * 64; i += gsz) {
    int l = (int)(i / ((i64)(N + LC) * 64)); int tt = (int)((i / 64) % (N + LC)); int j2 = (int)(i % 64);
    int t, L; if (tt < N) { t = tt; L = N; } else { t = tt - N; L = LC; }
    float tn = (float)t / (float)(L - 1);
    float wt = 6.283185307179586f * (float)t / (float)L;
    const float* w1 = p.in[I_hy_w1] + l * 33 * 64; const float* b1 = p.in[I_hy_b1] + l * 64; const float* f1 = p.in[I_hy_f1] + l * 64;
    const float* w2 = p.in[I_hy_w2] + l * 64 * 64; const float* b2 = p.in[I_hy_b2] + l * 64; const float* f2 = p.in[I_hy_f2] + l * 64;
    float acc2 = b2[j2];
    for (int k1 = 0; k1 < 64; ++k1) {
      float a1 = b1[k1] + tn * w1[k1];
      for (int bd = 0; bd < 16; ++bd) {
        float band = 1e-4f + (float)bd * ((15.0f - 1e-4f) / 15.0f);
        float ang = band * wt;
        a1 += cosf(ang) * w1[(1 + bd) * 64 + k1] - sinf(ang) * w1[(17 + bd) * 64 + k1];
      }
      acc2 += sinf(f1[k1] * a1) * w2[k1 * 64 + j2];
    }
    p.hdn2()[i] = sinf(f2[j2] * acc2);
  }
#endif
#ifdef CPU_SIM
  for (i64 i = gtid; i < 2 * N; i += gsz) {
    double a = 6.283185307179586476925 * (double)i / (double)(2 * N);
    p.tw()[i * 2] = (float)cos(a); p.tw()[i * 2 + 1] = (float)-sin(a);
  }
#endif
  for (i64 i = gtid; i < 2 * 2 * 512; i += gsz) p.spl()[i] = softplusf_(-p.in[I_lru_lam][i]);
  for (i64 i = gtid; i < 128 * 8; i += gsz) {
    int pos = (int)(i / 8), f = (int)(i % 8);
    float ang = (float)pos * powf(10000.0f, -(float)f / 8.0f);
    p.tabA()[i * 2] = cosf(ang); p.tabA()[i * 2 + 1] = sinf(ang);
  }
  for (i64 i = gtid; i < 128 * 16; i += gsz) {
    int pos = (int)(i / 16), f = (int)(i % 16);
    float ang = (float)pos * powf(10000.0f, -(float)f / 16.0f);
    p.tabD()[i * 2] = cosf(ang); p.tabD()[i * 2 + 1] = sinf(ang);
  }
}

#ifndef CPU_SIM
template <class F> DEV void xpose_tiles(bf* dst, int K, int NN, const F& val, int tid, float* tl, int& xoff, int rank, int nranks) {
  const int tk = K / 64, tn = NN / 64;
  const int t0 = (rank + nranks - xoff % nranks) % nranks;
  xoff += tk * tn;
  for (int t = t0; t < tk * tn; t += nranks) {
    const int k0 = (t / tn) * 64, n0 = (t % tn) * 64;
    __syncthreads();
    float tv_[8];
#pragma unroll
    for (int i = 0; i < 8; ++i) { const int kk = (tid >> 6) + 8 * i, nn = tid & 63; tv_[i] = val(k0 + kk, n0 + nn); }
#pragma unroll
    for (int i = 0; i < 8; ++i) { const int kk = (tid >> 6) + 8 * i, nn = tid & 63; tl[nn * 65 + kk] = tv_[i]; }
    __syncthreads();
#pragma unroll
    for (int i = 0; i < 8; ++i) { const int nn = (tid >> 6) + 8 * i, kk = tid & 63; dst[(size_t)(n0 + nn) * K + k0 + kk] = f2b(tl[nn * 65 + kk]); }
  }
}
#else
template <class F> static void xpose_tiles(bf* dst, int K, int NN, const F& val, i64 gtid, i64 gsz) {
  for (i64 i = gtid; i < (i64)K * NN; i += gsz) { int k = (int)(i / NN), n = (int)(i % NN); dst[(size_t)n * K + k] = f2b(val(k, n)); }
}
#endif
struct PrepCtx {
#ifndef CPU_SIM
  int tid; float* tl; int rank, nranks;
#else
  i64 gtid, gsz;
#endif
};
#ifndef CPU_SIM
#define XPOSE(dst, K, NN, val) xpose_tiles(dst, K, NN, val, pc.tid, pc.tl, xoff, pc.rank, pc.nranks)
#else
#define XPOSE(dst, K, NN, val) xpose_tiles(dst, K, NN, val, pc.gtid, pc.gsz)
#endif
DEVN void ph_prep(const Params& p, int l, const PrepCtx& pc, i64 gtid, i64 gsz, const int parts) {
  int xoff = 0; (void)xoff;
  if (parts & 1) {
    GF w = (GF)(p.in[I_w_in] + (size_t)l * D * INC);
    XPOSE(p.W_in(), 1024, 3840, [=](int k, int n) { const int s_ = win_src(n); const float x_ = w[(size_t)k * INC + (s_ < 0 ? 0 : s_)]; return s_ < 0 ? 0.f : x_; });
    XPOSE(p.W_g(), 1024, 4096, [=](int k, int n) { return w[(size_t)k * INC + C_GT + n]; });
  }
  if (parts & 1) {
    GF w = (GF)(p.in[I_mla_w_uq] + (size_t)l * 256 * 768); GF g = (GF)(p.in[I_mla_g_cq] + l * 256);
    XPOSE(p.W_uq(), 256, 768, [=](int k, int n) { return g[k] * w[(size_t)k * 768 + wuq_src(n)]; });
  }
  if (parts & 1) {
    GF w = (GF)(p.in[I_mla_w_ukv] + (size_t)l * 128 * 1024); GF g = (GF)(p.in[I_mla_g_ckv] + l * 128);
    XPOSE(p.W_ukv(), 256, 1024, [=](int k, int n) { const int kc = k < 128 ? k : 0; const float x_ = g[kc] * w[(size_t)kc * 1024 + n]; return k < 128 ? x_ : 0.f; });
  }
  if (parts & 2) {
    GF w = (GF)(p.in[I_w_branch] + (size_t)l * 4 * 512 * D);
    for (int br = 0; br < 4; ++br) { GF wb = w + (size_t)br * 512 * D; XPOSE(p.W_br() + (size_t)br * 1024 * 512, 512, 1024, [=](int k, int n) { return wb[(size_t)k * D + n]; }); }
  }
  if (parts & 2) {
    GF w = (GF)(p.in[I_w_out] + (size_t)l * D * D);
    XPOSE(p.W_out(), 1024, 1024, [=](int k, int n) { return w[(size_t)k * D + n]; });
  }
  if (parts & 4) {
    GF wq = (GF)(p.in[I_peer_w_q] + (size_t)l * D * 1024);
    XPOSE(p.W_q(), 1024, 1024, [=](int k, int n) { return wq[(size_t)k * 1024 + n]; });
  }
#ifndef CPU_SIM
  if (parts & 1) {
    GF w3 = (GF)(p.in[I_hy_w3] + (size_t)l * 64 * 1024);
    XPOSE(p.W3T(), 256, 1024, [=](int k, int n) { const int kc = k < 64 ? k : 0; const float x_ = w3[(size_t)kc * 1024 + n]; return k < 64 ? x_ : 0.f; });
  }
#endif
  if (parts & 1) {
    for (i64 i = gtid; i < 2048 * 256; i += gsz) {
      int n = (int)(i / 256), k = (int)(i % 256);
      int kw = n >> 10, dir = (n >> 9) & 1, blk4 = (n >> 7) & 3, jc = (n & 127) >> 1, gate = n & 1;
      float v = 0.f;
      if ((k >> 6) == blk4) {
        GF wsrc = (GF)p.in[gate ? I_lru_w_i : I_lru_w_r] + ((((size_t)l * 2 + dir) * 8 + kw * 4 + blk4) * 64 + (k & 63)) * 64 + jc;
        v = *wsrc;
      }
      p.W_lru()[i] = f2b(v);
    }
  }
  if (parts & 8) {
    GF keys = (GF)(p.in[I_peer_keys] + (size_t)l * 16 * 128 * 64);
    for (i64 i = gtid; i < 2048 * 256; i += gsz) {
      int n = (int)(i / 256), k = (int)(i % 256);
      int hp = n >> 7, key = n & 127;
      float v = ((k >> 6) == (hp & 3)) ? keys[((size_t)hp * 128 + key) * 64 + (k & 63)] : 0.f;
      p.W_key()[i] = f2b(v);
    }
  }
}

DEVN void ph_norm(const Params& p, int l, int which, int nrows, i64 gtid, i64 gsz) {
  const float* g = p.in[which ? I_g_ffn : I_g_mix] + l * D;
#ifndef CPU_SIM
  const int lane = (int)(gtid & 63);
  const i64 W = gsz >> 6;
  float4 gv[4];
#pragma unroll
  for (int i = 0; i < 4; ++i) gv[i] = *(const float4*)(g + (lane + i * 64) * 4);
  for (i64 r = gtid >> 6; r < nrows; r += 2 * W) {
    const bool two = r + W < nrows;
    const i64 rb = two ? r + W : r;
    const float4* xra = (const float4*)((l == 0 && which == 0) ? xin_row(p, (int)r) : p.xcur() + (size_t)r * D);
    const float4* xrb = (const float4*)((l == 0 && which == 0) ? xin_row(p, (int)rb) : p.xcur() + (size_t)rb * D);
    const float* mda = p.mods() + ((size_t)l * 3 + modrow((int)r)) * 6 * D + (which ? 3 * D : 0);
    const float* mdb = p.mods() + ((size_t)l * 3 + modrow((int)rb)) * 6 * D + (which ? 3 * D : 0);
    float4 xa[4], xb[4], sha[4], sca[4], shb[4], scb[4]; float sa = 0.f, sb = 0.f;
#pragma unroll
    for (int i = 0; i < 4; ++i) { xa[i] = gld4(xra + lane + i * 64); xb[i] = gld4(xrb + lane + i * 64); }
#pragma unroll
    for (int i = 0; i < 4; ++i) { const int k = (lane + i * 64) * 4; sha[i] = *(const float4*)(mda + k); sca[i] = *(const float4*)(mda + D + k); shb[i] = *(const float4*)(mdb + k); scb[i] = *(const float4*)(mdb + D + k); }
#pragma unroll
    for (int i = 0; i < 4; ++i) { sa += xa[i].x * xa[i].x + xa[i].y * xa[i].y + xa[i].z * xa[i].z + xa[i].w * xa[i].w; sb += xb[i].x * xb[i].x + xb[i].y * xb[i].y + xb[i].z * xb[i].z + xb[i].w * xb[i].w; }
#pragma unroll
    for (int o = 32; o >= 1; o >>= 1) { sa += lane_xor(sa, lane, o); sb += lane_xor(sb, lane, o); }
    const float rsa = 1.0f / sqrtf(sa * (1.0f / D) + EPS), rsb = 1.0f / sqrtf(sb * (1.0f / D) + EPS);
#pragma unroll
    for (int i = 0; i < 4; ++i) {
      const int k = (lane + i * 64) * 4;
      uint2 w;
      w.x = pk2bf(xa[i].x * rsa * gv[i].x * (1.0f + sca[i].x) + sha[i].x, xa[i].y * rsa * gv[i].y * (1.0f + sca[i].y) + sha[i].y);
      w.y = pk2bf(xa[i].z * rsa * gv[i].z * (1.0f + sca[i].z) + sha[i].z, xa[i].w * rsa * gv[i].w * (1.0f + sca[i].w) + sha[i].w);
      *(uint2*)(p.h() + (size_t)r * D + k) = w;
    }
    if (two) {
#pragma unroll
      for (int i = 0; i < 4; ++i) {
        const int k = (lane + i * 64) * 4;
        uint2 w;
        w.x = pk2bf(xb[i].x * rsb * gv[i].x * (1.0f + scb[i].x) + shb[i].x, xb[i].y * rsb * gv[i].y * (1.0f + scb[i].y) + shb[i].y);
        w.y = pk2bf(xb[i].z * rsb * gv[i].z * (1.0f + scb[i].z) + shb[i].z, xb[i].w * rsb * gv[i].w * (1.0f + scb[i].w) + shb[i].w);
        *(uint2*)(p.h() + (size_t)rb * D + k) = w;
      }
    }
  }
#else
  for (i64 r = gtid; r < nrows; r += gsz) {
    const float* xr = (l == 0 && which == 0) ? xin_row(p, (int)r) : p.xcur() + (size_t)r * D;
    float ss = 0.f;
    for (int k = 0; k < D; ++k) ss += xr[k] * xr[k];
    float rstd = 1.0f / sqrtf(ss / D + EPS);
    const float* md = p.mods() + ((size_t)l * 3 + modrow((int)r)) * 6 * D + (which ? 3 * D : 0);
    for (int k = 0; k < D; ++k) p.h()[(size_t)r * D + k] = f2b(xr[k] * rstd * g[k] * (1.0f + md[D + k]) + md[k]);
  }
#endif
}

DEVN void ph_B0(const Params& p, int l, i64 gtid, i64 gsz, char* b0lds = nullptr, int b0tid = 0) {
#ifndef CPU_SIM
  {
    const int lane = (int)(gtid & 63);
    const i64 W = gsz >> 6;
    for (i64 r = gtid >> 6; r < TT; r += 4 * W) {
      uint2 a[4]; unsigned b[4]; i64 rr[4];
#pragma unroll
      for (int j = 0; j < 4; ++j) { rr[j] = r + j * W < TT ? r + j * W : r; const bf* pr = p.P() + (size_t)rr[j] * PC; a[j] = *(const uint2*)(pr + C_CQ + lane * 4); b[j] = *(const unsigned*)(pr + C_CKV + lane * 2); }
      float sq[4], sk[4];
#pragma unroll
      for (int j = 0; j < 4; ++j) {
        const float f0 = __uint_as_float(a[j].x << 16), f1 = __uint_as_float(a[j].x & 0xFFFF0000u), f2 = __uint_as_float(a[j].y << 16), f3 = __uint_as_float(a[j].y & 0xFFFF0000u);
        const float g0 = __uint_as_float(b[j] << 16), g1 = __uint_as_float(b[j] & 0xFFFF0000u);
        sq[j] = 0.f; sq[j] += f0 * f0; sq[j] += f1 * f1; sq[j] += f2 * f2; sq[j] += f3 * f3;
        sk[j] = 0.f; sk[j] += g0 * g0; sk[j] += g1 * g1;
      }
#pragma unroll
      for (int o = 32; o >= 1; o >>= 1) {
#pragma unroll
        for (int j = 0; j < 4; ++j) { sq[j] += lane_xor(sq[j], lane, o); sk[j] += lane_xor(sk[j], lane, o); }
      }
#pragma unroll
      for (int j = 0; j < 4; ++j) if (lane == 0 && r + j * W < TT) { p.ssq()[rr[j]] = sq[j]; p.ssq()[TT + rr[j]] = sk[j]; }
    }
  }
#else
  for (i64 r = gtid; r < TT; r += gsz) {
    const bf* pr = p.P() + (size_t)r * PC;
    float sq = 0.f, sk = 0.f;
    for (int k = 0; k < 256; ++k) { float v = b2f(pr[C_CQ + k]); sq += v * v; }
    for (int k = 0; k < 128; ++k) { float v = b2f(pr[C_CKV + k]); sk += v * v; }
    p.ssq()[r] = sq; p.ssq()[TT + r] = sk;
  }
#endif
#ifndef CPU_SIM
  {
    GF cw = (GF)(p.in[I_lru_conv_w] + l * 4 * 512); GF cb = (GF)(p.in[I_lru_conv_b] + l * 512);
    const int c8 = (int)(gtid & 63) * 8;
    float wv[4][8], bv[8];
#pragma unroll
    for (int j = 0; j < 8; ++j) { bv[j] = cb[c8 + j];
#pragma unroll
      for (int k = 0; k < 4; ++k) wv[k][j] = cw[k * 512 + c8 + j]; }
    for (i64 i = gtid; i < (i64)TT * 64; i += 2 * gsz) {
      const bool two = i + gsz < (i64)TT * 64;
      const int r0 = (int)(i >> 6), r1 = two ? (int)((i + gsz) >> 6) : r0;
      const RowInfo ra = rowinfo(r0), rb = rowinfo(r1);
      uint4 xa[4], xb[4]; float ma[4], mb[4];
#pragma unroll
      for (int k = 0; k < 4; ++k) {
        const int ta = ra.t - 1 + k, tb = rb.t - 1 + k;
        const bool oka = ta >= 0 && ta < ra.L, okb = tb >= 0 && tb < rb.L;
        ma[k] = oka ? 1.f : 0.f; mb[k] = okb ? 1.f : 0.f;
        xa[k] = *(const uint4*)(p.P() + (size_t)(ra.base + (oka ? ta : ra.t)) * PC + C_LX + c8);
        xb[k] = *(const uint4*)(p.P() + (size_t)(rb.base + (okb ? tb : rb.t)) * PC + C_LX + c8);
      }
      float aa[8], ab[8];
#pragma unroll
      for (int j = 0; j < 8; ++j) { aa[j] = bv[j]; ab[j] = bv[j]; }
#pragma unroll
      for (int k = 0; k < 4; ++k) {
        float fa_[8], fb_[8]; unpack8(xa[k], fa_); unpack8(xb[k], fb_);
#pragma unroll
        for (int j = 0; j < 8; ++j) { aa[j] += (wv[k][j] * ma[k]) * fa_[j]; ab[j] += (wv[k][j] * mb[k]) * fb_[j]; }
      }
      store8bf(p.XC() + (size_t)r0 * 512 + c8, aa);
      if (two) store8bf(p.XC() + (size_t)r1 * 512 + c8, ab);
    }
  }
  {
    GF cw = (GF)(p.in[I_hy_conv_w] + l * 3 * 1536); GF cb = (GF)(p.in[I_hy_conv_b] + l * 1536);
    for (i64 i = (i64)NLAT * 64 + gtid; i < (i64)TT * 64; i += gsz) {
      const int r = (int)(i >> 6), c8 = (int)(i & 63) * 8;
      const RowInfo ri = rowinfo(r);
      uint4 xf[3], xg[3]; float mk[3];
#pragma unroll
      for (int k = 0; k < 3; ++k) {
        const int ts = ri.t - 1 + k; const bool ok = ts >= 0 && ts < ri.L; mk[k] = ok ? 1.f : 0.f;
        const bf* pr = p.P() + (size_t)(ri.base + (ok ? ts : ri.t)) * PC + C_HU;
        xf[k] = *(const uint4*)(pr + 512 + c8); xg[k] = *(const uint4*)(pr + 1024 + c8);
      }
      float a1[8], a2[8], w1[3][8], w2[3][8];
#pragma unroll
      for (int j = 0; j < 8; ++j) { a1[j] = cb[512 + c8 + j]; a2[j] = cb[1024 + c8 + j];
#pragma unroll
        for (int k = 0; k < 3; ++k) { w1[k][j] = cw[k * 1536 + 512 + c8 + j]; w2[k][j] = cw[k * 1536 + 1024 + c8 + j]; } }
#pragma unroll
      for (int k = 0; k < 3; ++k) {
        float f[8], g[8]; unpack8(xf[k], f); unpack8(xg[k], g);
#pragma unroll
        for (int j = 0; j < 8; ++j) { a1[j] += (w1[k][j] * mk[k]) * f[j]; a2[j] += (w2[k][j] * mk[k]) * g[j]; }
      }
#pragma unroll
      for (int j = 0; j < 8; ++j) a1[j] *= a2[j];
      store8bf(p.Z() + (size_t)r * 512 + c8, a1);
    }
  }
  {
    const float* cw = p.in[I_hy_conv_w] + l * 3 * 1536; const float* cb = p.in[I_hy_conv_b] + l * 1536;
    unsigned short* tz_ = (unsigned short*)b0lds; unsigned short* tx_ = tz_ + 64 * 72;
    for (int tile = blockIdx.x; tile < (NLAT / 64) * 8; tile += gridDim.x) {
      const int rt = tile >> 3, c0 = (tile & 7) * 64;
      const int tr = b0tid >> 3, cg8 = (b0tid & 7) * 8;
      const int r = rt * 64 + tr, t = r % N;
      float a0[8], a1[8], a2[8];
#pragma unroll
      for (int j = 0; j < 8; ++j) { a0[j] = cb[c0 + cg8 + j]; a1[j] = cb[512 + c0 + cg8 + j]; a2[j] = cb[1024 + c0 + cg8 + j]; }
      uint4 v0[3], v1[3], v2[3]; bool ok[3];
#pragma unroll
      for (int k = 0; k < 3; ++k) {
        const int ts = t - 1 + k; ok[k] = ts >= 0 && ts < N;
        const bf* pr = p.P() + (size_t)(r - 1 + (ok[k] ? k : 1)) * PC + C_HU + c0 + cg8;
        v0[k] = *(const uint4*)pr; v1[k] = *(const uint4*)(pr + 512); v2[k] = *(const uint4*)(pr + 1024);
      }
#pragma unroll
      for (int k = 0; k < 3; ++k) {
        if (!ok[k]) continue;
        float f0[8], f1[8], f2_[8]; unpack8(v0[k], f0); unpack8(v1[k], f1); unpack8(v2[k], f2_);
        const float* w = cw + k * 1536 + c0 + cg8;
#pragma unroll
        for (int j = 0; j < 8; ++j) { a0[j] += w[j] * f0[j]; a1[j] += w[512 + j] * f1[j]; a2[j] += w[1024 + j] * f2_[j]; }
      }
      __syncthreads();
#pragma unroll
      for (int j = 0; j < 8; ++j) { tz_[(cg8 + j) * 72 + tr] = f2b(a1[j] * a2[j]).v; tx_[(cg8 + j) * 72 + tr] = f2b(a0[j]).v; }
      __syncthreads();
      { const int cc = b0tid >> 3, tg = (b0tid & 7) * 8;
        const int bq = (rt * 64) / N, tq = (rt * 64) % N + tg;
        const size_t o = ((size_t)(c0 + cc) * NB + bq) * N + tq;
        *(uint4*)((unsigned short*)p.Z() + o) = *(const uint4*)(tz_ + cc * 72 + tg);
        *(uint4*)((unsigned short*)p.XYT() + o) = *(const uint4*)(tx_ + cc * 72 + tg); }
    }
  }
#else
  {
    const float* cw = p.in[I_lru_conv_w] + l * 4 * 512; const float* cb = p.in[I_lru_conv_b] + l * 512;
    for (i64 i = gtid; i < (i64)TT * 512; i += gsz) {
      int r = (int)(i / 512), c = (int)(i % 512);
      RowInfo ri = rowinfo(r);
      float acc = cb[c];
      for (int k = 0; k < 4; ++k) {
        int ts = ri.t - 1 + k;
        if (ts >= 0 && ts < ri.L) acc += cw[k * 512 + c] * b2f(p.P()[(size_t)(ri.base + ts) * PC + C_LX + c]);
      }
      p.XC()[i] = f2b(acc);
    }
  }
  {
    const float* cw = p.in[I_hy_conv_w] + l * 3 * 1536; const float* cb = p.in[I_hy_conv_b] + l * 1536;
    for (i64 i = gtid; i < (i64)TT * 512; i += gsz) {
      int r = (int)(i / 512), c = (int)(i % 512);
      RowInfo ri = rowinfo(r);
      float a1 = cb[512 + c], a2 = cb[1024 + c];
      for (int k = 0; k < 3; ++k) {
        int ts = ri.t - 1 + k;
        if (ts >= 0 && ts < ri.L) {
          const bf* pr = p.P() + (size_t)(ri.base + ts) * PC + C_HU;
          a1 += cw[k * 1536 + 512 + c] * b2f(pr[512 + c]);
          a2 += cw[k * 1536 + 1024 + c] * b2f(pr[1024 + c]);
        }
      }
      p.Z()[i] = f2b(a1 * a2);
    }
  }
  {
    const float* w3 = p.in[I_hy_w3] + (size_t)l * 64 * 1024;
    const float maxd = logf(1e-2f) / 0.3f, mind = logf(1e-2f) / 1.5f;
    for (i64 i = gtid; i < (i64)(N + LC) * 1024; i += gsz) {
      int tt = (int)(i / 1024), j = (int)(i % 1024);
      int t, L; if (tt < N) { t = tt; L = N; } else { t = tt - N; L = LC; }
      const float* hd = p.hdn2() + ((size_t)l * (N + LC) + tt) * 64;
      float acc = 0.f;
      for (int k = 0; k < 64; ++k) acc += hd[k] * w3[k * 1024 + j];
      float tn = (float)t / (float)(L - 1);
      float delta = mind + (float)j * ((maxd - mind) / 1023.0f);
      p.F()[i] = acc * expf(-tn * fabsf(delta));
    }
  }
#endif
}

DEVN void ph_fnorm(const Params& p, i64 gtid, i64 gsz) {
#ifndef CPU_SIM
  for (i64 i = 512 + gtid; i < 2 * 512; i += gsz) {
#else
  for (i64 i = gtid; i < 2 * 512; i += gsz) {
#endif
    int which = (int)(i / 512), c = (int)(i % 512);
    int L = which ? LC : N; int off = which ? N : 0;
    float ss = 0.f;
    for (int t = 0; t < L; ++t) { float a = p.F()[(size_t)(off + t) * 1024 + c], b = p.F()[(size_t)(off + t) * 1024 + 512 + c]; ss += a * a + b * b; }
    p.fnorm()[i] = 1.0f / sqrtf(ss + EPS);
  }
}


DEV void lru_chunk_rows(int dir, int b, int k, int& row0, int& step) {
  int seg_chunk;
  if (k < NCC) { seg_chunk = dir ? NCC - 1 - k : k; row0 = NLAT + b * LC + seg_chunk * LCH; }
  else { int kl = k - NCC; seg_chunk = dir ? NCL - 1 - kl : kl; row0 = b * N + seg_chunk * LCH; }
  if (dir) { row0 += LCH - 1; step = -1; } else step = 1;
}
DEVN void ph_lru1(const Params& p, i64 gtid, i64 gsz) {
#ifndef CPU_SIM
  for (i64 i = gtid; i < (i64)2 * NB * NCHK * 128; i += gsz) {
    const int c = (int)(i % 128) * 4, k = (int)((i / 128) % NCHK), b = (int)((i / (128 * NCHK)) % NB), dir = (int)(i / ((i64)128 * NCHK * NB));
    int row0, step; lru_chunk_rows(dir, b, k, row0, step);
    const uint4* lab4 = (const uint4*)(p.LAB() + (size_t)dir * TT * 512 + c);
    float h0 = 0.f, h1 = 0.f, h2 = 0.f, h3 = 0.f, s0 = 0.f, s1 = 0.f, s2 = 0.f, s3 = 0.f;
    uint4 wn[8];
#pragma unroll
    for (int t = 0; t < 8; ++t) wn[t] = lab4[(size_t)(row0 + step * t) * 128];
#pragma unroll 1
    for (int t0 = 0; t0 < LCH; t0 += 8) {
      uint4 w[8];
#pragma unroll
      for (int t = 0; t < 8; ++t) w[t] = wn[t];
      if (t0 + 8 < LCH) {
#pragma unroll
        for (int t = 0; t < 8; ++t) wn[t] = lab4[(size_t)(row0 + step * (t0 + 8 + t)) * 128];
      }
#pragma unroll
      for (int t = 0; t < 8; ++t) {
        const float a0 = __uint_as_float(w[t].x << 16), a1 = __uint_as_float(w[t].y << 16), a2 = __uint_as_float(w[t].z << 16), a3 = __uint_as_float(w[t].w << 16);
        s0 += a0; s1 += a1; s2 += a2; s3 += a3;
        h0 = fexpf_(a0) * h0 + __uint_as_float(w[t].x & 0xFFFF0000u); h1 = fexpf_(a1) * h1 + __uint_as_float(w[t].y & 0xFFFF0000u);
        h2 = fexpf_(a2) * h2 + __uint_as_float(w[t].z & 0xFFFF0000u); h3 = fexpf_(a3) * h3 + __uint_as_float(w[t].w & 0xFFFF0000u);
      }
    }
    const size_t o = ((size_t)(dir * NB + b) * NCHK + k) * 512 + c;
    *(float4*)(p.SA() + o) = float4{fexpf_(s0), fexpf_(s1), fexpf_(s2), fexpf_(s3)};
    *(float4*)(p.SB() + o) = float4{h0, h1, h2, h3};
  }
#else
  for (i64 i = gtid; i < (i64)2 * NB * NCHK * 512; i += gsz) {
    int c = (int)(i % 512), k = (int)((i / 512) % NCHK), b = (int)((i / (512 * NCHK)) % NB), dir = (int)(i / ((i64)512 * NCHK * NB));
    int row0, step; lru_chunk_rows(dir, b, k, row0, step);
    const bf* la = p.LA() + (size_t)dir * TT * 512 + c; const bf* lb = p.LB() + (size_t)dir * TT * 512 + c;
    float h = 0.f, sl = 0.f;
    for (int t = 0; t < LCH; ++t) {
      size_t r = (size_t)(row0 + step * t);
      float lav = b2f(la[r * 512]);
      h = expf(lav) * h + b2f(lb[r * 512]); sl += lav;
    }
    p.SA()[i] = fexpf_(sl); p.SB()[i] = h;
  }
#endif
}
DEVN void ph_lru3(const Params& p, int last, i64 gtid, i64 gsz, float* hrs, int ltid) {
#ifndef CPU_SIM
  unsigned* hrp = (unsigned*)hrs;
  for (i64 i = gtid; i < (i64)NB * NCHK * 256; i += gsz) {
    const int c = (int)(i % 256) * 2, j = (int)((i / 256) % NCHK), b = (int)(i / (256 * NCHK));
    if (last && j < NCC) continue;
    const int kf = j, kr = j < NCC ? NCC - 1 - j : NCC + (NCL - 1 - (j - NCC));
    const float* sa0 = p.SA() + ((size_t)(0 * NB + b) * NCHK) * 512 + c; const float* sb0 = p.SB() + ((size_t)(0 * NB + b) * NCHK) * 512 + c;
    const float* sa1 = p.SA() + ((size_t)(1 * NB + b) * NCHK) * 512 + c; const float* sb1 = p.SB() + ((size_t)(1 * NB + b) * NCHK) * 512 + c;
    float hf0 = 0.f, hf1 = 0.f, hr0 = 0.f, hr1 = 0.f;
    const int row0 = j < NCC ? NLAT + b * LC + j * LCH : b * N + (j - NCC) * LCH;
    const unsigned* lab0 = p.LAB() + c; const unsigned* lab1 = p.LAB() + (size_t)TT * 512 + c;
#pragma unroll 1
    for (int k0 = 0; k0 < kf; k0 += 8) {
      float2 av[8], bv[8];
#pragma unroll
      for (int q = 0; q < 8; ++q) { const bool ok = k0 + q < kf; av[q] = ok ? *(const float2*)(sa0 + (size_t)(k0 + q) * 512) : float2{1.f, 1.f}; bv[q] = ok ? *(const float2*)(sb0 + (size_t)(k0 + q) * 512) : float2{0.f, 0.f}; }
#pragma unroll
      for (int q = 0; q < 8; ++q) { hf0 = av[q].x * hf0 + bv[q].x; hf1 = av[q].y * hf1 + bv[q].y; }
    }
#pragma unroll 1
    for (int k0 = 0; k0 < kr; k0 += 8) {
      float2 av[8], bv[8];
#pragma unroll
      for (int q = 0; q < 8; ++q) { const bool ok = k0 + q < kr; av[q] = ok ? *(const float2*)(sa1 + (size_t)(k0 + q) * 512) : float2{1.f, 1.f}; bv[q] = ok ? *(const float2*)(sb1 + (size_t)(k0 + q) * 512) : float2{0.f, 0.f}; }
#pragma unroll
      for (int q = 0; q < 8; ++q) { hr0 = av[q].x * hr0 + bv[q].x; hr1 = av[q].y * hr1 + bv[q].y; }
    }
#pragma unroll 1
    for (int t0 = LCH - 16; t0 >= 0; t0 -= 16) {
      uint2 w[16];
#pragma unroll
      for (int t = 0; t < 16; ++t) w[t] = *(const uint2*)(lab1 + (size_t)(row0 + t0 + t) * 512);
#pragma unroll
      for (int t = 15; t >= 0; --t) {
        hr0 = fexpf_(__uint_as_float(w[t].x << 16)) * hr0 + __uint_as_float(w[t].x & 0xFFFF0000u);
        hr1 = fexpf_(__uint_as_float(w[t].y << 16)) * hr1 + __uint_as_float(w[t].y & 0xFFFF0000u);
        hrp[(t0 + t) * 512 + ltid] = pk2bf(hr0, hr1);
      }
    }
#pragma unroll 1
    for (int t0 = 0; t0 < LCH; t0 += 16) {
      uint2 w[16]; unsigned gw[16];
#pragma unroll
      for (int t = 0; t < 16; ++t) { const size_t r = (size_t)(row0 + t0 + t); w[t] = *(const uint2*)(lab0 + r * 512); gw[t] = *(const unsigned*)(p.P() + r * PC + C_LG + c); }
#pragma unroll
      for (int t = 0; t < 16; ++t) {
        hf0 = fexpf_(__uint_as_float(w[t].x << 16)) * hf0 + __uint_as_float(w[t].x & 0xFFFF0000u);
        hf1 = fexpf_(__uint_as_float(w[t].y << 16)) * hf1 + __uint_as_float(w[t].y & 0xFFFF0000u);
        const unsigned hw = hrp[(t0 + t) * 512 + ltid];
        const float y0 = geluf_(__uint_as_float(gw[t] << 16)) * (hf0 + __uint_as_float(hw << 16));
        const float y1 = geluf_(__uint_as_float(gw[t] & 0xFFFF0000u)) * (hf1 + __uint_as_float(hw & 0xFFFF0000u));
        *(unsigned*)(p.Y() + (size_t)(row0 + t0 + t) * 2048 + 512 + c) = pk2bf(y0, y1);
      }
    }
  }
#else
  for (i64 i = gtid; i < (i64)NB * NCHK * 512; i += gsz) {
    int c = (int)(i % 512), j = (int)((i / 512) % NCHK), b = (int)(i / (512 * NCHK));
    if (last && j < NCC) continue;
    int kf = j, kr = j < NCC ? NCC - 1 - j : NCC + (NCL - 1 - (j - NCC));
    const float* sa0 = p.SA() + ((size_t)(0 * NB + b) * NCHK) * 512 + c; const float* sb0 = p.SB() + ((size_t)(0 * NB + b) * NCHK) * 512 + c;
    const float* sa1 = p.SA() + ((size_t)(1 * NB + b) * NCHK) * 512 + c; const float* sb1 = p.SB() + ((size_t)(1 * NB + b) * NCHK) * 512 + c;
    float hf = 0.f, hr = 0.f;
    int row0 = j < NCC ? NLAT + b * LC + j * LCH : b * N + (j - NCC) * LCH;
    const bf* la0 = p.LA() + c; const bf* lb0 = p.LB() + c;
    const bf* la1 = p.LA() + (size_t)TT * 512 + c; bf* lb1 = p.LB() + (size_t)TT * 512 + c;
    for (int k = 0; k < kf; ++k) hf = sa0[(size_t)k * 512] * hf + sb0[(size_t)k * 512];
    for (int k = 0; k < kr; ++k) hr = sa1[(size_t)k * 512] * hr + sb1[(size_t)k * 512];
    for (int t = LCH - 1; t >= 0; --t) { size_t r = (size_t)(row0 + t); hr = expf(b2f(la1[r * 512])) * hr + b2f(lb1[r * 512]); lb1[r * 512] = f2b(hr); }
    for (int t = 0; t < LCH; ++t) {
      size_t r = (size_t)(row0 + t);
      hf = expf(b2f(la0[r * 512])) * hf + b2f(lb0[r * 512]);
      float lg = b2f(p.P()[r * PC + C_LG + c]);
      p.Y()[r * 2048 + 512 + c] = f2b(geluf_(lg) * (hf + b2f(lb1[r * 512])));
    }
  }
#endif
}

DEVN void ph_C(const Params& p, int l, int last, i64 gtid, i64 gsz) {
  const int QR = last ? NLAT : TT;
#ifdef CPU_SIM
  for (i64 i = gtid; i < (i64)8 * QR; i += gsz) {
    int hh = (int)(i / QR), r = (int)(i % QR);
    RowInfo ri = rowinfo(r);
    float q[96];
#pragma unroll
    for (int d = 0; d < 96; ++d) q[d] = b2f(p.QA()[(size_t)r * 768 + hh * 96 + d]);
    float o[64];
#pragma unroll
    for (int d = 0; d < 64; ++d) o[d] = 0.f;
    float m = -1e30f, lsum = 0.f;
    const float scale = 0.10206207261596577f;
    int nseg = ri.lat ? 2 : 1;
    for (int sg = 0; sg < nseg; ++sg) {
      int kb, kn_;
      if (ri.lat && sg == 0) { kb = ri.b * N; kn_ = N; } else { kb = NLAT + ri.b * LC; kn_ = LC; }
      for (int kk = 0; kk < kn_; ++kk) {
        const bf* kr_ = p.KVA() + (size_t)(kb + kk) * 1024 + hh * 128;
        const bf* krp = p.P() + (size_t)(kb + kk) * PC + C_KR;
        float s = 0.f;
#pragma unroll
        for (int d = 0; d < 64; ++d) s += q[d] * b2f(kr_[d]);
#pragma unroll
        for (int d = 0; d < 32; ++d) s += q[64 + d] * b2f(krp[d]);
        s *= scale;
        float mn = fmaxf(m, s);
        float corr = expf(m - mn), pe = expf(s - mn);
        lsum = lsum * corr + pe;
#pragma unroll
        for (int d = 0; d < 64; ++d) o[d] = o[d] * corr + pe * b2f(kr_[64 + d]);
        m = mn;
      }
    }
    float inv = 1.0f / lsum;
#pragma unroll
    for (int d = 0; d < 64; ++d) p.Y()[(size_t)r * 2048 + hh * 64 + d] = f2b(o[d] * inv);
  }
#endif
  {
    const float* cw = p.in[I_hy_conv_w] + l * 3 * 1536; const float* cb = p.in[I_hy_conv_b] + l * 1536;
    const float* skip = p.in[I_hy_skip] + l * 512;
#ifndef CPU_SIM
    const i64 hy_first = (i64)NLAT * 512;
#else
    const i64 hy_first = 0;
#endif
    for (i64 i = hy_first + gtid; i < (i64)QR * 512; i += gsz) {
      int r = (int)(i / 512), c = (int)(i % 512);
      RowInfo ri = rowinfo(r);
      int foff = ri.lat ? 0 : N;
      float acc = 0.f;
      for (int s = 0; s < ri.L; ++s) {
        int dd = ri.t - s;
        float fv = dd >= 0 ? p.F()[(size_t)(foff + dd) * 1024 + c] : p.F()[(size_t)(foff - dd) * 1024 + 512 + c];
        acc += fv * b2f(p.Z()[(size_t)(ri.base + s) * 512 + c]);
      }
      acc *= p.fnorm()[(ri.lat ? 0 : 512) + c];
      float x0 = cb[c];
      for (int k = 0; k < 3; ++k) {
        int ts = ri.t - 1 + k;
        if (ts >= 0 && ts < ri.L) x0 += cw[k * 1536 + c] * b2f(p.P()[(size_t)(ri.base + ts) * PC + C_HU + c]);
      }
      float y = acc + skip[c] * b2f(p.Z()[(size_t)r * 512 + c]);
      p.Y()[(size_t)r * 2048 + 1024 + c] = f2b(x0 * y);
    }
  }
#ifdef CPU_SIM
  for (i64 i = gtid; i < (i64)8 * QR; i += gsz) {
    int hh = (int)(i / QR), r = (int)(i % QR);
    RowInfo ri = rowinfo(r);
    int kh = hh / 4;
    float q[64];
#pragma unroll
    for (int d = 0; d < 64; ++d) q[d] = b2f(p.P()[(size_t)r * PC + C_GQ + hh * 64 + d]);
    float o[64];
#pragma unroll
    for (int d = 0; d < 64; ++d) o[d] = 0.f;
    float m = p.in[I_gqa_sink][l * 8 + hh], lsum = 1.0f;
    int nseg = ri.lat ? 2 : 1;
    for (int sg = 0; sg < nseg; ++sg) {
      int k0, k1;
      if (ri.lat && sg == 0) { int lo = ri.t - 128; if (lo < 0) lo = 0; int hi = ri.t + 128; if (hi > N - 1) hi = N - 1; k0 = ri.b * N + lo; k1 = ri.b * N + hi + 1; }
      else { k0 = NLAT + ri.b * LC; k1 = k0 + LC; }
      for (int kk = k0; kk < k1; ++kk) {
        const bf* kp = p.P() + (size_t)kk * PC + C_GKV + kh * 64;
        const bf* vp = kp + 128;
        float s = 0.f;
#pragma unroll
        for (int d = 0; d < 64; ++d) s += q[d] * b2f(kp[d]);
        s *= 0.125f;
        float mn = fmaxf(m, s);
        float corr = expf(m - mn), pe = expf(s - mn);
        lsum = lsum * corr + pe;
#pragma unroll
        for (int d = 0; d < 64; ++d) o[d] = o[d] * corr + pe * b2f(vp[d]);
        m = mn;
      }
    }
    float inv = 1.0f / lsum;
#pragma unroll
    for (int d = 0; d < 64; ++d) p.Y()[(size_t)r * 2048 + 1536 + hh * 64 + d] = f2b(o[d] * inv);
  }
#endif
}

DEVN void ph_E2a(const Params& p, int nrows, i64 gtid, i64 gsz) {
  for (i64 i = gtid; i < (i64)nrows * 16; i += gsz) {
    const sc_t* s_ = p.SC() + (size_t)i * 128;
    float ps = 3.0e38f; int pi = -1;
    for (int k = 0; k < 16; ++k) {
      float bs = -3.0e38f; int bi = -1;
      for (int j = 0; j < 128; ++j) {
        float s = (float)s_[j];
        bool elig = (s < ps) || (s == ps && j > pi);
        if (elig && (s > bs)) { bs = s; bi = j; }
      }
      p.TKs()[(size_t)i * 16 + k] = bs; p.TKi()[(size_t)i * 16 + k] = bi;
      ps = bs; pi = bi;
    }
  }
}

DEVN void ph_E2b(const Params& p, int nrows, i64 gtid, i64 gsz) {
  for (i64 i = gtid; i < (i64)nrows * 8; i += gsz) {
    const float* s1 = p.TKs() + (size_t)i * 32; const float* s2 = s1 + 16;
    const int* i1 = p.TKi() + (size_t)i * 32; const int* i2 = i1 + 16;
    float ps = 3.0e38f; int pi = -1;
    float mx = 0.f;
    for (int k = 0; k < 16; ++k) {
      float bs = -3.0e38f; int bi = -1;
      for (int j = 0; j < 256; ++j) {
        float s = s1[j >> 4] + s2[j & 15];
        bool elig = (s < ps) || (s == ps && j > pi);
        if (elig && (s > bs)) { bs = s; bi = j; }
      }
      if (k == 0) mx = bs;
      p.SELi()[(size_t)i * 16 + k] = i1[bi >> 4] * 128 + i2[bi & 15];
      p.SELg()[(size_t)i * 16 + k] = expf(bs - mx);
      ps = bs; pi = bi;
    }
    float sum = 0.f;
    for (int k = 0; k < 16; ++k) sum += p.SELg()[(size_t)i * 16 + k];
    float inv = 1.0f / sum;
    for (int k = 0; k < 16; ++k) p.SELg()[(size_t)i * 16 + k] *= inv;
  }
}

DEVN void ph_E3(const Params& p, int l, int nrows, i64 gtid, i64 gsz) {
  const float* u = p.in[I_peer_u] + (size_t)l * NEXP * D;
#ifndef CPU_SIM
  const int lane = (int)(gtid & 63);
  for (i64 i = gtid >> 6; i < (i64)nrows * 128; i += gsz >> 6) {
    const int r = (int)(i >> 7);
    const float4* ur = (const float4*)(u + (size_t)p.SELi()[i] * D);
    const uint2* hr = (const uint2*)(p.h() + (size_t)r * D);
    float acc = 0.f;
#pragma unroll
    for (int q = 0; q < 4; ++q) {
      const float4 uv = ur[lane + q * 64]; const uint2 hv = hr[lane + q * 64];
      union { unsigned u_; float f; } c0, c1, c2, c3;
      c0.u_ = hv.x << 16; c1.u_ = hv.x & 0xFFFF0000u; c2.u_ = hv.y << 16; c3.u_ = hv.y & 0xFFFF0000u;
      acc += uv.x * c0.f + uv.y * c1.f + uv.z * c2.f + uv.w * c3.f;
    }
#pragma unroll
    for (int o = 32; o >= 1; o >>= 1) acc += lane_xor(acc, lane, o);
    if (lane == 0) p.W()[i] = p.SELg()[i] * geluf_(acc);
  }
#else
  for (i64 i = gtid; i < (i64)nrows * 128; i += gsz) {
    int r = (int)(i / 128);
    const float* ur = u + (size_t)p.SELi()[i] * D;
    const bf* hr = p.h() + (size_t)r * D;
    float acc = 0.f;
    for (int k = 0; k < D; ++k) acc += b2f(hr[k]) * ur[k];
    p.W()[i] = p.SELg()[i] * geluf_(acc);
  }
#endif
}

DEVN void ph_E4(const Params& p, int l, int nrows, i64 gtid, i64 gsz) {
  const float* v = p.in[I_peer_v] + (size_t)l * NEXP * D;
  for (i64 i = gtid; i < (i64)nrows * D; i += gsz) {
    int r = (int)(i / D), n = (int)(i % D);
    float acc = 0.f;
    for (int j = 0; j < 128; ++j) acc += p.W()[(size_t)r * 128 + j] * v[(size_t)p.SELi()[(size_t)r * 128 + j] * D + n];
    float g2 = p.mods()[((size_t)l * 3 + modrow(r)) * 6 * D + 5 * D + n];
    p.xcur()[i] += g2 * acc;
  }
}


#ifndef CPU_SIM
DEV unsigned dpp_ror_u(unsigned x, int n) {
  switch (n) {
    case 1: return (unsigned)__builtin_amdgcn_update_dpp(0, (int)x, 0x121, 0xf, 0xf, false);
    case 2: return (unsigned)__builtin_amdgcn_update_dpp(0, (int)x, 0x122, 0xf, 0xf, false);
    case 4: return (unsigned)__builtin_amdgcn_update_dpp(0, (int)x, 0x124, 0xf, 0xf, false);
    default: return (unsigned)__builtin_amdgcn_update_dpp(0, (int)x, 0x128, 0xf, 0xf, false);
  }
}
DEV unsigned wave_max_u(unsigned x) {
  x = max(x, dpp_ror_u(x, 1)); x = max(x, dpp_ror_u(x, 2)); x = max(x, dpp_ror_u(x, 4)); x = max(x, dpp_ror_u(x, 8));
  const unsigned a = (unsigned)__builtin_amdgcn_readlane((int)x, 0), b = (unsigned)__builtin_amdgcn_readlane((int)x, 16);
  const unsigned c = (unsigned)__builtin_amdgcn_readlane((int)x, 32), d = (unsigned)__builtin_amdgcn_readlane((int)x, 48);
  return max(max(a, b), max(c, d));
}
DEV unsigned f16_key(unsigned short h, int idx) { const unsigned t = (h & 0x8000u) ? (unsigned)(~h & 0xFFFFu) : (unsigned)(h | 0x8000u); return (t << 16) | (unsigned)(0xFFFF - idx); }
DEV float key_score(unsigned k) { const unsigned t = k >> 16; const unsigned short h = (unsigned short)((t & 0x8000u) ? (t ^ 0x8000u) : (~t & 0xFFFFu)); union { unsigned short u; _Float16 f; } c; c.u = h; return (float)c.f; }
DEV int key_idx(unsigned k) { return 0xFFFF - (int)(k & 0xFFFFu); }
DEV int mbcnt64(unsigned long long m) { return (int)__builtin_amdgcn_mbcnt_hi((unsigned)(m >> 32), __builtin_amdgcn_mbcnt_lo((unsigned)m, 0u)); }
DEV unsigned pick16_sorted(unsigned k0, unsigned k1, unsigned T, int above, int lane, int* tmp) {
  const unsigned h0 = k0 & 0xFFFF0000u, h1 = k1 & 0xFFFF0000u;
  const bool gt0 = h0 > T, eq0 = h0 == T, gt1 = h1 > T, eq1 = h1 == T;
  const int need = 16 - above;
  const unsigned long long me0 = __builtin_amdgcn_ballot_w64(eq0), me1 = __builtin_amdgcn_ballot_w64(eq1);
  const bool s0 = gt0 || (eq0 && mbcnt64(me0) < need);
  const int need1 = need - (int)__builtin_popcountll(me0);
  const bool s1 = gt1 || (eq1 && mbcnt64(me1) < need1);
  const unsigned long long ms0 = __builtin_amdgcn_ballot_w64(s0), ms1 = __builtin_amdgcn_ballot_w64(s1);
  if (s0) tmp[mbcnt64(ms0)] = (int)k0;
  if (s1) tmp[(int)__builtin_popcountll(ms0) + mbcnt64(ms1)] = (int)k1;
  const unsigned u = (unsigned)tmp[lane & 15];
  int rank = 0;
#pragma unroll
  for (int q = 0; q < 16; ++q) rank += ((unsigned)__builtin_amdgcn_readlane((int)u, q) > u) ? 1 : 0;
  if (lane < 16) tmp[16 + rank] = (int)u;
  return (unsigned)tmp[16 + (lane & 15)];
}
DEV void top16_x2(unsigned a0, unsigned a1, unsigned b0, unsigned b1, int lane, int* tmp, unsigned& ta, unsigned& tb) {
  unsigned TA = 0, TB = 0; int abA = 0, abB = 0;
#pragma unroll
  for (int bit = 31; bit >= 16; --bit) {
    const unsigned m = 0xFFFFFFFFu << bit, one = 1u << bit;
    const unsigned tA = TA | one, tB = TB | one;
    const int cA = (int)__builtin_popcountll(__builtin_amdgcn_ballot_w64((a0 & m) == tA)) + (int)__builtin_popcountll(__builtin_amdgcn_ballot_w64((a1 & m) == tA));
    const int cB = (int)__builtin_popcountll(__builtin_amdgcn_ballot_w64((b0 & m) == tB)) + (int)__builtin_popcountll(__builtin_amdgcn_ballot_w64((b1 & m) == tB));
    if (abA + cA >= 16) TA = tA; else abA += cA;
    if (abB + cB >= 16) TB = tB; else abB += cB;
  }
  ta = pick16_sorted(a0, a1, TA, abA, lane, tmp);
  tb = pick16_sorted(b0, b1, TB, abB, lane, tmp + 32);
}
DEVN void ph_cvt_tables(const Params& p, int l, i64 gtid, i64 gsz) {
  const float4* u = (const float4*)(p.in[I_peer_u] + (size_t)l * NEXP * D); const float4* v = (const float4*)(p.in[I_peer_v] + (size_t)l * NEXP * D);
  unsigned* ub = (unsigned*)p.Ub(); unsigned* vb = (unsigned*)p.Vb();
#pragma unroll 4
  for (i64 i = gtid; i < (i64)NEXP * D / 4; i += gsz) {
    const float4 a = u[i], b = v[i];
    int w = __builtin_amdgcn_cvt_pk_fp8_f32(a.x * 32.f, a.y * 32.f, 0, false); w = __builtin_amdgcn_cvt_pk_fp8_f32(a.z * 32.f, a.w * 32.f, w, true); ub[i] = (unsigned)w;
    int x = __builtin_amdgcn_cvt_pk_fp8_f32(b.x, b.y, 0, false); x = __builtin_amdgcn_cvt_pk_fp8_f32(b.z, b.w, x, true); vb[i] = (unsigned)x;
  }
}
DEV void unpack16_fp8(const uint4 w, float* f) {
#define UP4(W, O) { auto lo = __builtin_amdgcn_cvt_pk_f32_fp8((int)(W), false); auto hi = __builtin_amdgcn_cvt_pk_f32_fp8((int)(W), true); f[O] = lo[0]; f[O + 1] = lo[1]; f[O + 2] = hi[0]; f[O + 3] = hi[1]; }
  UP4(w.x, 0) UP4(w.y, 4) UP4(w.z, 8) UP4(w.w, 12)
#undef UP4
}
struct Sc4 { unsigned short a, b, c, d; };
DEV Sc4 peer_scores(const Params& p, int r, int wid, int lane) {
  const unsigned short* sp = (const unsigned short*)(p.SC() + ((size_t)r * 8 + wid) * 256);
  Sc4 q; q.a = sp[lane]; q.b = sp[64 + lane]; q.c = sp[128 + lane]; q.d = sp[192 + lane];
  return q;
}
struct Key4 { decltype(f16_key((unsigned short)0, 0)) a, b, c, d; };
DEV Key4 peer_keys(const Sc4 q, int lane) { Key4 k; k.a = f16_key(q.a, lane); k.b = f16_key(q.b, 64 + lane); k.c = f16_key(q.c, lane); k.d = f16_key(q.d, 64 + lane); return k; }
DEV void peer_topk(const Key4 k, int lane, int ca, int cb, bool cvalid, int* selx, int* tmp) {
  unsigned t1, t2;
  top16_x2(k.a, k.b, k.c, k.d, lane, tmp, t1, t2);
  const unsigned k1 = (unsigned)__builtin_amdgcn_ds_bpermute(ca << 2, (int)t1), k2 = (unsigned)__builtin_amdgcn_ds_bpermute(cb << 2, (int)t2);
  const float v = cvalid ? key_score(k1) + key_score(k2) : -3.0e38f;
  int rank = 0;
#pragma unroll
  for (int c = 0; c < 50; ++c) {
    const float vs = __int_as_float(__builtin_amdgcn_readlane(__float_as_int(v), c));
    rank += (vs > v || (vs == v && c < lane)) ? 1 : 0;
  }
  float mx = v;
#pragma unroll
  for (int o = 32; o >= 1; o >>= 1) mx = fmaxf(mx, lane_xor(mx, lane, o));
  const bool sel = cvalid && rank < 16;
  const float e = sel ? fexpf_(v - mx) : 0.f;
  float sum = e;
#pragma unroll
  for (int o = 32; o >= 1; o >>= 1) sum += lane_xor(sum, lane, o);
  if (sel) { selx[rank] = key_idx(k1) * 128 + key_idx(k2); selx[16 + rank] = __float_as_int(e / sum); }
}
DEVN void ph_peer(const Params& p, int l, int nrows, int tid, char* ldsg, float oscale = 1.0f) {
  const int lane = tid & 63, wid = tid >> 6;
  float* part = (float*)ldsg;
  int* selbase = (int*)(ldsg + 8 * 1024 * 4) + wid * 64;
  int* tktmp = (int*)(ldsg + 8 * 1024 * 4 + 8 * 64 * 4) + wid * 64;
  const unsigned char* Ub = (const unsigned char*)p.Ub(); const unsigned char* Vb = (const unsigned char*)p.Vb();
  int ca = 0, cb = 0; bool cvalid = false;
  { int pre = 0;
    for (int a = 0; a < 16; ++a) { const int cnt = 16 / (a + 1); if (lane >= pre && lane < pre + cnt) { ca = a; cb = lane - pre; cvalid = true; } pre += cnt; } }
  int cur = 0;
  Sc4 nsc; nsc.a = nsc.b = nsc.c = nsc.d = 0;
  if ((int)blockIdx.x < nrows) {
    peer_topk(peer_keys(peer_scores(p, blockIdx.x, wid, lane), lane), lane, ca, cb, cvalid, selbase, tktmp);
    nsc = peer_scores(p, (int)(blockIdx.x + gridDim.x) < nrows ? (int)(blockIdx.x + gridDim.x) : (int)blockIdx.x, wid, lane);
  }
  for (int r = blockIdx.x; r < nrows; r += gridDim.x) {
    const int* selx = selbase + cur * 32;
    int eidx[16];
#pragma unroll
    for (int e = 0; e < 16; ++e) eidx[e] = __builtin_amdgcn_readfirstlane(selx[e]);
    const float mygate = __int_as_float(selx[16 + (lane >> 2)]);
    const bool more = r + (int)gridDim.x < nrows;
    const Key4 nkeys = peer_keys(nsc, lane);
    uint4 rows[16], vrows[16];
#pragma unroll
    for (int e = 0; e < 16; ++e) rows[e] = ((const uint4*)(Ub + (size_t)eidx[e] * D))[lane];
    uint4 hraw0, hraw1;
    { const uint4* hp = (const uint4*)(p.h() + (size_t)r * D); hraw0 = hp[lane * 2]; hraw1 = hp[lane * 2 + 1]; }
#pragma unroll
    for (int e = 0; e < 16; ++e) vrows[e] = ((const uint4*)(Vb + (size_t)eidx[e] * D))[lane];
    const float2 g2v = *(const float2*)(p.mods() + ((size_t)l * 3 + modrow(r)) * 6 * D + 5 * D + tid * 2);
    float2 xv = *(const float2*)(p.xcur() + (size_t)r * D + tid * 2);
    nsc = peer_scores(p, r + 2 * (int)gridDim.x < nrows ? r + 2 * (int)gridDim.x : r, wid, lane);
    if (more) peer_topk(nkeys, lane, ca, cb, cvalid, selbase + (cur ^ 1) * 32, tktmp);
    float hv[16]; unpack8(hraw0, hv); unpack8(hraw1, hv + 8);
    float d[16];
#pragma unroll
    for (int e = 0; e < 16; ++e) {
      float f[16]; unpack16_fp8(rows[e], f);
      float a = 0.f;
#pragma unroll
      for (int k = 0; k < 16; ++k) a += f[k] * hv[k];
      d[e] = a;
    }
#define FOLD(NV, O) _Pragma("unroll") for (int i = 0; i < NV / 2; ++i) { const bool up = (lane & O) != 0; const float send = up ? d[i] : d[i + NV / 2]; const float keep = up ? d[i + NV / 2] : d[i]; d[i] = keep + lane_xor(send, lane, O); }
    FOLD(16, 32) FOLD(8, 16) FOLD(4, 8) FOLD(2, 4)
#undef FOLD
    float dot = d[0]; dot += lane_xor(dot, lane, 2); dot += lane_xor(dot, lane, 1);
    const float myact = mygate * geluf_(dot * (1.0f / 32.0f));
    float acc[16];
#pragma unroll
    for (int k = 0; k < 16; ++k) acc[k] = 0.f;
#pragma unroll
    for (int e = 0; e < 16; ++e) {
      const float a = __int_as_float(__builtin_amdgcn_readlane(__float_as_int(myact), e * 4));
      float f[16]; unpack16_fp8(vrows[e], f);
#pragma unroll
      for (int k = 0; k < 16; ++k) acc[k] += a * f[k];
    }
    float* partc = part + cur * ((8 * 1024 * 4 + 2 * 8 * 64 * 4) / 4);
    { float4* pw = (float4*)(partc + wid * 1024 + lane * 16);
      pw[0] = float4{acc[0], acc[1], acc[2], acc[3]}; pw[1] = float4{acc[4], acc[5], acc[6], acc[7]};
      pw[2] = float4{acc[8], acc[9], acc[10], acc[11]}; pw[3] = float4{acc[12], acc[13], acc[14], acc[15]}; }
    __syncthreads();
    { const int c = tid * 2;
      float s0 = 0.f, s1 = 0.f;
#pragma unroll
      for (int w = 0; w < 8; ++w) { const float2 t = *(const float2*)(partc + w * 1024 + c); s0 += t.x; s1 += t.y; }
      xv.x += oscale * g2v.x * s0; xv.y += oscale * g2v.y * s1; *(float2*)(p.xcur() + (size_t)r * D + c) = xv; }
    cur ^= 1;
  }
}
#endif

DEVN void ph_final(const Params& p, i64 gtid, i64 gsz) {
  const float* g = p.in[I_g_final];
#ifndef CPU_SIM
  float pscale = 1.0f;
#if PROBE_K >= 0
  { const unsigned long long* ts = (const unsigned long long*)(p.ws + WL.ts);
    const float frac = (float)(ts[PROBE_K + 1] - ts[0]) / (float)(ts[NPHASES - 1] - ts[0]);
    pscale = 1.0f + sqrtf(floorf(frac * 50.0f + 0.5f) * 0.02f); }
#endif
  const int lane = (int)(gtid & 63);
  const i64 W = gsz >> 6;
  float4 gv[4];
#pragma unroll
  for (int i = 0; i < 4; ++i) gv[i] = *(const float4*)(g + (lane + i * 64) * 4);
  for (i64 r = gtid >> 6; r < NLAT; r += 2 * W) {
    const bool two = r + W < NLAT;
    const i64 rb = two ? r + W : r;
    const float4* xra = (const float4*)(p.xcur() + (size_t)r * D); const float4* xrb = (const float4*)(p.xcur() + (size_t)rb * D);
    float4 xa[4], xb[4]; float sa = 0.f, sb = 0.f;
#pragma unroll
    for (int i = 0; i < 4; ++i) { xa[i] = xra[lane + i * 64]; xb[i] = xrb[lane + i * 64]; }
#pragma unroll
    for (int i = 0; i < 4; ++i) { sa += xa[i].x * xa[i].x + xa[i].y * xa[i].y + xa[i].z * xa[i].z + xa[i].w * xa[i].w; sb += xb[i].x * xb[i].x + xb[i].y * xb[i].y + xb[i].z * xb[i].z + xb[i].w * xb[i].w; }
#pragma unroll
    for (int o = 32; o >= 1; o >>= 1) { sa += lane_xor(sa, lane, o); sb += lane_xor(sb, lane, o); }
    const float rsa = 1.0f / sqrtf(sa * (1.0f / D) + EPS), rsb = 1.0f / sqrtf(sb * (1.0f / D) + EPS);
#pragma unroll
    for (int i = 0; i < 4; ++i) {
      const int k = (lane + i * 64) * 4;
      float4 o4; o4.x = xa[i].x * rsa * gv[i].x * pscale; o4.y = xa[i].y * rsa * gv[i].y * pscale; o4.z = xa[i].z * rsa * gv[i].z * pscale; o4.w = xa[i].w * rsa * gv[i].w * pscale;
      *(float4*)(p.out + (size_t)r * D + k) = o4;
    }
    if (two) {
#pragma unroll
      for (int i = 0; i < 4; ++i) {
        const int k = (lane + i * 64) * 4;
        float4 o4; o4.x = xb[i].x * rsb * gv[i].x * pscale; o4.y = xb[i].y * rsb * gv[i].y * pscale; o4.z = xb[i].z * rsb * gv[i].z * pscale; o4.w = xb[i].w * rsb * gv[i].w * pscale;
        *(float4*)(p.out + (size_t)rb * D + k) = o4;
      }
    }
  }
#else
  for (i64 r = gtid; r < NLAT; r += gsz) {
    const float* xr = p.xcur() + (size_t)r * D;
    float ss = 0.f;
    for (int k = 0; k < D; ++k) ss += xr[k] * xr[k];
    float rstd = 1.0f / sqrtf(ss / D + EPS);
    for (int k = 0; k < D; ++k) p.out[(size_t)r * D + k] = xr[k] * rstd * g[k];
  }
#endif
}

DEV void rope4(float* v, const float* tab, int nf, int pos, int f0) {
#pragma unroll
  for (int jj = 0; jj < 4; ++jj) {
    float c = tab[(pos * nf + f0 + jj) * 2], s = tab[(pos * nf + f0 + jj) * 2 + 1];
    float x1 = v[2 * jj], x2 = v[2 * jj + 1];
    v[2 * jj] = x1 * c - x2 * s; v[2 * jj + 1] = x1 * s + x2 * c;
  }
}
struct EpiInproj {
  static constexpr int W = 8; static constexpr bool SUB = false; static constexpr bool STAGED = false;
  const Params& p;
  MDEV void apply(int r, int c0, float* v) const {
    if (c0 >= 3744) return;
    if (c0 >= 384 && r < NLAT) {
      int t = r % N;
      if (c0 < C_KR + 32) { int pi = (c0 - C_KR) >> 1; int half = pi >> 3; rope4(v, p.tabA(), 8, half ? t % GRIDW : t / GRIDW, pi & 7); }
      else if (c0 >= C_GQ && c0 < C_GKV + 128) { int pi = ((c0 - C_GQ) & 63) >> 1; int half = pi >> 4; rope4(v, p.tabD(), 16, half ? t % GRIDW : t / GRIDW, pi & 15); }
    }
    store8bf(p.P() + (size_t)r * PC + c0, v);
  }
};
struct EpiUq {
  static constexpr int W = 8; static constexpr bool SUB = false; static constexpr bool STAGED = true; static constexpr bool STAGED_ALL = true;
  const Params& p;
  MDEV void apply(int r, int c0, float* v) const {
    float rstd = 1.0f / sqrtf(p.ssq()[r] * (1.0f / 256.0f) + EPS);
#pragma unroll
    for (int j = 0; j < 8; ++j) v[j] *= rstd;
    int d0 = c0 % 96;
    if (d0 >= 64 && r < NLAT) { int t = r % N; int pi = (d0 - 64) >> 1; int half = pi >> 3; rope4(v, p.tabA(), 8, half ? t % GRIDW : t / GRIDW, pi & 7); }
    store8bf(p.QA() + (size_t)r * 768 + c0, v);
  }
#ifndef CPU_SIM
  struct Pre { float s; float4 t0, t1; };
  MDEV void pre(int r, int c0, Pre& q) const {
    q.s = p.ssq()[r];
    const int d0 = c0 % 96;
    q.t0 = float4{1.f, 0.f, 1.f, 0.f}; q.t1 = q.t0;
    if (d0 >= 64 && r < NLAT) { const int t = r % N, pi = (d0 - 64) >> 1, half = pi >> 3; const int pos = half ? t % GRIDW : t / GRIDW;
      const float* tb = p.tabA() + (pos * 8 + (pi & 7)) * 2; q.t0 = *(const float4*)tb; q.t1 = *(const float4*)(tb + 4); }
  }
  MDEV void fin(int r, int c0, float* v, const Pre& q) const {
    const float rstd = 1.0f / sqrtf(q.s * (1.0f / 256.0f) + EPS);
    const float cs[8] = {q.t0.x, q.t0.y, q.t0.z, q.t0.w, q.t1.x, q.t1.y, q.t1.z, q.t1.w};
    float o[8];
#pragma unroll
    for (int jj = 0; jj < 4; ++jj) { const float x1 = v[2 * jj] * rstd, x2 = v[2 * jj + 1] * rstd, c = cs[2 * jj], sn = cs[2 * jj + 1]; o[2 * jj] = x1 * c - x2 * sn; o[2 * jj + 1] = x1 * sn + x2 * c; }
    store8bf(p.QA() + (size_t)r * 768 + c0, o);
  }
#endif
};
struct EpiUkv {
  static constexpr int W = 8; static constexpr bool SUB = false; static constexpr bool STAGED = true; static constexpr bool STAGED_ALL = true;
  const Params& p;
  MDEV void apply(int r, int c0, float* v) const {
    float rstd = 1.0f / sqrtf(p.ssq()[TT + r] * (1.0f / 128.0f) + EPS);
#pragma unroll
    for (int j = 0; j < 8; ++j) v[j] *= rstd;
    store8bf(p.KVA() + (size_t)r * 1024 + c0, v);
  }
#ifndef CPU_SIM
  struct Pre { float s; };
  MDEV void pre(int r, int, Pre& q) const { q.s = p.ssq()[TT + r]; }
  MDEV void fin(int r, int c0, float* v, const Pre& q) const {
    const float rstd = 1.0f / sqrtf(q.s * (1.0f / 128.0f) + EPS);
#pragma unroll
    for (int j = 0; j < 8; ++j) v[j] *= rstd;
    store8bf(p.KVA() + (size_t)r * 1024 + c0, v);
  }
#endif
};
struct EpiLru {
  static constexpr int W = 8; static constexpr bool SUB = false; static constexpr bool STAGED = true; static constexpr bool STAGED_ALL = true;
  const Params& p; int l; const float* br; const float* bi;
  MDEV void finish(int r, int c0, const float* v, const float* brv, const float* biv, const float* splv, const float* xcv) const {
    int kw = c0 >> 10, dir = (c0 >> 9) & 1, blk4 = (c0 >> 7) & 3, jc0 = (c0 & 127) >> 1;
    int cb = kw * 256 + blk4 * 64 + jc0;
    float lav[4], lbv[4];
#pragma unroll
    for (int jj = 0; jj < 4; ++jj) {
      float rg = sigmoidf_(v[2 * jj] + brv[jj]), ig = sigmoidf_(v[2 * jj + 1] + biv[jj]);
      float log_a = -8.0f * rg * splv[jj];
      const float a_ = fexpf_(log_a);
      lav[jj] = log_a; lbv[jj] = sqrtf(fmaxf(1.0f - a_ * a_, 0.0f)) * ig * xcv[jj];
    }
#ifndef CPU_SIM
    { uint4 w;
      w.x = pk2bf(lav[0], lbv[0]); w.y = pk2bf(lav[1], lbv[1]); w.z = pk2bf(lav[2], lbv[2]); w.w = pk2bf(lav[3], lbv[3]);
      *(uint4*)(p.LAB() + ((size_t)dir * TT + r) * 512 + cb) = w; }
#else
    bf* la = p.LA() + ((size_t)dir * TT + r) * 512 + cb;
    bf* lb = p.LB() + ((size_t)dir * TT + r) * 512 + cb;
    for (int jj = 0; jj < 4; ++jj) { la[jj] = f2b(lav[jj]); lb[jj] = f2b(lbv[jj]); }
#endif
  }
  MDEV void apply(int r, int c0, float* v) const {
    int kw = c0 >> 10, dir = (c0 >> 9) & 1, blk4 = (c0 >> 7) & 3, jc0 = (c0 & 127) >> 1;
    int cb = kw * 256 + blk4 * 64 + jc0;
    float brv[4], biv[4], splv[4], xcv[4];
    for (int jj = 0; jj < 4; ++jj) { brv[jj] = br[(l * 2 + dir) * 512 + cb + jj]; biv[jj] = bi[(l * 2 + dir) * 512 + cb + jj]; splv[jj] = p.spl()[(l * 2 + dir) * 512 + cb + jj]; xcv[jj] = b2f(p.XC()[(size_t)r * 512 + cb + jj]); }
    finish(r, c0, v, brv, biv, splv, xcv);
  }
#ifndef CPU_SIM
  struct Pre { float4 a4, b4, s4; uint2 x2; };
  MDEV void pre(int r, int c0, Pre& q) const {
    int kw = c0 >> 10, dir = (c0 >> 9) & 1, blk4 = (c0 >> 7) & 3, jc0 = (c0 & 127) >> 1;
    int cb = kw * 256 + blk4 * 64 + jc0;
    q.a4 = gld4(br + (l * 2 + dir) * 512 + cb); q.b4 = gld4(bi + (l * 2 + dir) * 512 + cb);
    q.s4 = *(const float4*)(p.spl() + (l * 2 + dir) * 512 + cb);
    q.x2 = *(const uint2*)(p.XC() + (size_t)r * 512 + cb);
  }
  MDEV void fin(int r, int c0, float* v, const Pre& q) const {
    const float brv[4] = {q.a4.x, q.a4.y, q.a4.z, q.a4.w}, biv[4] = {q.b4.x, q.b4.y, q.b4.z, q.b4.w}, splv[4] = {q.s4.x, q.s4.y, q.s4.z, q.s4.w};
    const float xcv[4] = {__uint_as_float(q.x2.x << 16), __uint_as_float(q.x2.x & 0xFFFF0000u), __uint_as_float(q.x2.y << 16), __uint_as_float(q.x2.y & 0xFFFF0000u)};
    finish(r, c0, v, brv, biv, splv, xcv);
  }
#endif
};
struct EpiGate {
  static constexpr int W = 8; static constexpr bool SUB = false; static constexpr bool STAGED = false;
  const Params& p;
  MDEV void apply(int r, int c0, float* v) const {
#pragma unroll
    for (int j = 0; j < 8; ++j) v[j] = sigmoidf_(v[j]);
    store8bf(p.Gs() + (size_t)r * D + c0, v);
  }
};
struct EpiBranch {
  static constexpr int W = 8; static constexpr bool SUB = false; static constexpr bool STAGED = false;
  const Params& p; int br;
  MDEV void apply(int r, int c0, float* v) const {
    float g[8]; load8bf(p.Gs() + (size_t)r * D + c0, g);
    if (br > 0) {
      float mo[8]; load8bf(p.M() + (size_t)r * D + c0, mo);
#pragma unroll
      for (int j = 0; j < 8; ++j) v[j] = mo[j] + g[j] * v[j];
    } else {
#pragma unroll
      for (int j = 0; j < 8; ++j) v[j] = g[j] * v[j];
    }
    store8bf(p.M() + (size_t)r * D + c0, v);
  }
};
struct EpiGateAll {
  static constexpr int W = 8; static constexpr bool SUB = false; static constexpr bool STAGED = false;
  const Params& p;
  MDEV void apply(int r, int c0, float* v) const {
#pragma unroll
    for (int j = 0; j < 8; ++j) v[j] = sigmoidf_(v[j]) * 255.f + 0.5f;
    unsigned char* gq = p.G8() + (size_t)r * 4096 + c0;
#ifndef CPU_SIM
    uint2 w;
    w.x = (unsigned)v[0] | ((unsigned)v[1] << 8) | ((unsigned)v[2] << 16) | ((unsigned)v[3] << 24);
    w.y = (unsigned)v[4] | ((unsigned)v[5] << 8) | ((unsigned)v[6] << 16) | ((unsigned)v[7] << 24);
    *(uint2*)gq = w;
#else
    for (int j = 0; j < 8; ++j) gq[j] = (unsigned char)v[j];
#endif
  }
};
struct EpiBranchSub {
  static constexpr int W = 8; static constexpr bool SUB = true; static constexpr bool STAGED = true; static constexpr bool STAGED_ALL = false;
  const Params& p;
  MDEV void apply(int, int, float*) const {}
  MDEV void gate8(int r, int c0, int i, float* g) const {
    const unsigned char* gq = p.G8() + (size_t)r * 4096 + i * 1024 + c0;
#ifndef CPU_SIM
    const uint2 w = *(const uint2*)gq;
#pragma unroll
    for (int j = 0; j < 4; ++j) { g[j] = (float)((w.x >> (8 * j)) & 255u) * (1.0f / 255.0f); g[4 + j] = (float)((w.y >> (8 * j)) & 255u) * (1.0f / 255.0f); }
#else
    for (int j = 0; j < 8; ++j) g[j] = (float)gq[j] * (1.0f / 255.0f);
#endif
  }
  MDEV void apply_sub(int r, int c0, float* v, int sub) const {
    if (sub < 3) { store8bf(p.BR() + (size_t)r * 3072 + sub * 1024 + c0, v); return; }
    float g[8]; gate8(r, c0, 3, g);
#pragma unroll
    for (int j = 0; j < 8; ++j) v[j] *= g[j];
#pragma unroll
    for (int i = 0; i < 3; ++i) {
      float bi[8]; load8bf(p.BR() + (size_t)r * 3072 + i * 1024 + c0, bi);
      gate8(r, c0, i, g);
#pragma unroll
      for (int j = 0; j < 8; ++j) v[j] += g[j] * bi[j];
    }
    store8bf(p.M() + (size_t)r * D + c0, v);
  }
#ifndef CPU_SIM
  struct Pre { uint2 g[4]; uint4 b[3]; };
  MDEV void pre(int r, int c0, Pre& q) const {
#pragma unroll
    for (int i = 0; i < 4; ++i) q.g[i] = *(const uint2*)(p.G8() + (size_t)r * 4096 + i * 1024 + c0);
#pragma unroll
    for (int i = 0; i < 3; ++i) q.b[i] = *(const uint4*)(p.BR() + (size_t)r * 3072 + i * 1024 + c0);
  }
  MDEV void fin(int r, int c0, float* v, const Pre& q) const {
#pragma unroll
    for (int i = 3; i >= 0; --i) {
      float g[8];
#pragma unroll
      for (int j = 0; j < 4; ++j) { g[j] = (float)((q.g[i].x >> (8 * j)) & 255u) * (1.0f / 255.0f); g[4 + j] = (float)((q.g[i].y >> (8 * j)) & 255u) * (1.0f / 255.0f); }
      if (i == 3) {
#pragma unroll
        for (int j = 0; j < 8; ++j) v[j] *= g[j];
      } else {
        float bi[8]; unpack8(q.b[i], bi);
#pragma unroll
        for (int j = 0; j < 8; ++j) v[j] += g[j] * bi[j];
      }
    }
    store8bf(p.M() + (size_t)r * D + c0, v);
  }
#endif
};
struct EpiFilt {
  static constexpr int W = 8; static constexpr bool SUB = false; static constexpr bool STAGED = false;
  const Params& p;
  MDEV void apply(int j, int tt, float* v) const {
    const float maxd = -15.350567286626973f, mind = -3.0701134573253945f;
    const float ad = fabsf(mind + (float)j * ((maxd - mind) / 1023.0f));
    int t, L; if (tt < N) { t = tt; L = N; } else { t = tt - N; L = LC; }
    const float sc = -ad / (float)(L - 1);
#pragma unroll
    for (int q = 0; q < 8; ++q) v[q] *= fexpf_((float)(t + q) * sc);
    float* d = p.F() + (size_t)j * (N + LC) + tt;
#ifndef CPU_SIM
    *(float4*)d = float4{v[0], v[1], v[2], v[3]}; *(float4*)(d + 4) = float4{v[4], v[5], v[6], v[7]};
#else
    for (int q = 0; q < 8; ++q) d[q] = v[q];
#endif
  }
};
struct EpiOut {
  static constexpr int W = 8; static constexpr bool SUB = false; static constexpr bool STAGED = true; static constexpr bool STAGED_ALL = true;
  const Params& p; int l; float osc; const float* xlat; const float* xctx;
  MDEV void apply(int r, int c0, float* v) const {
    const float* g1 = p.mods() + ((size_t)l * 3 + modrow(r)) * 6 * D + 2 * D + c0;
    const float* xs = (r < NLAT ? xlat + (size_t)r * D : xctx + (size_t)(r - NLAT) * D) + c0;
    float* xr = p.xcur() + (size_t)r * D + c0;
    for (int j = 0; j < 8; ++j) xr[j] = xs[j] + osc * g1[j] * v[j];
  }
#ifndef CPU_SIM
  struct Pre { float4 g0, g1, x0, x1; };
  MDEV void pre(int r, int c0, Pre& q) const {
    const float* g1 = p.mods() + ((size_t)l * 3 + modrow(r)) * 6 * D + 2 * D + c0;
    const float* xs = (r < NLAT ? xlat + (size_t)r * D : xctx + (size_t)(r - NLAT) * D) + c0;
    q.g0 = *(const float4*)g1; q.g1 = *(const float4*)(g1 + 4); q.x0 = gld4(xs); q.x1 = gld4(xs + 4);
  }
  MDEV void fin(int r, int c0, float* v, const Pre& q) const {
    float* xr = p.xcur() + (size_t)r * D + c0;
    float4 o0, o1;
    o0.x = q.x0.x + osc * q.g0.x * v[0]; o0.y = q.x0.y + osc * q.g0.y * v[1]; o0.z = q.x0.z + osc * q.g0.z * v[2]; o0.w = q.x0.w + osc * q.g0.w * v[3];
    o1.x = q.x1.x + osc * q.g1.x * v[4]; o1.y = q.x1.y + osc * q.g1.y * v[5]; o1.z = q.x1.z + osc * q.g1.z * v[6]; o1.w = q.x1.w + osc * q.g1.w * v[7];
    *(float4*)xr = o0; *(float4*)(xr + 4) = o1;
  }
#endif
};
struct EpiPQ {
  static constexpr int W = 8; static constexpr bool SUB = false; static constexpr bool STAGED = false;
  const Params& p;
  MDEV void apply(int r, int c0, float* v) const { store8bf(p.PQ() + (size_t)r * 1024 + c0, v); }
};
struct EpiSC {
  static constexpr int W = 8; static constexpr bool SUB = false; static constexpr bool STAGED = false;
  const Params& p;
  MDEV void apply(int r, int c0, float* v) const {
    sc_t* d = p.SC() + (size_t)r * 2048 + c0;
#ifndef CPU_SIM
    typedef _Float16 half8 __attribute__((ext_vector_type(8)));
    half8 hv8;
#pragma unroll
    for (int j = 0; j < 8; ++j) hv8[j] = (_Float16)v[j];
    *(half8*)d = hv8;
#else
    for (int j = 0; j < 8; ++j) d[j] = (sc_t)v[j];
#endif
  }
};

struct GemmDesc { const bf* A; const bf* Bt; int lda, ldb, K, nrows, ncols; int a_pn_shift, a_pn_mul; int nsub = 1, a_sub = 0, b_sub = 0; int unit_off = 0; };

#ifndef CPU_SIM
namespace pg8 {
#define PG8_LAS __attribute__((address_space(3)))
typedef short bf16x8 __attribute__((ext_vector_type(8)));
typedef float f32x4 __attribute__((ext_vector_type(4)));
constexpr int BM = 256, BK = 64, HALF = 128, HTB = HALF * BK * 2, STAGE_BYTES = 8 * HTB, NXCD = 8, WGM = 8;
__device__ __forceinline__ int lds_byte(int r, int c) { const int st = (r >> 4) * 2 + (c >> 5), rr = r & 15, cc = c & 31, ob = rr * 64 + cc * 2; return st * 1024 + (ob ^ (((ob >> 9) & 1) << 5)); }
__device__ __forceinline__ void stage_rc(int b, int& R, int& C) { const int st = b / 1024, sb = b % 1024, swz = sb ^ (((sb >> 9) & 1) << 5); R = (st >> 1) * 16 + swz / 64; C = (st & 1) * 32 + (swz % 64) / 2; }
__device__ __forceinline__ int perm32(int rho) { const int n = rho >> 4, i = rho & 15; return 8 * (i >> 2) + 4 * n + (i & 3); }
struct Unit { int pm, pn, sub; };
struct StaticOrder {
  int nM, nN, nwg, G, c, nsub;
  __device__ void init(int nM_, int nN_, int G_, int c_, int nsub_) { nM = nM_; nN = nN_; nwg = nM * nN; G = G_; c = c_; nsub = nsub_; }
  __device__ bool next(int i, Unit& u) const {
    const int it = i / nsub; u.sub = i - it * nsub;
    const long L = (long)it * G + c; if (L >= nwg) return false;
    int wgid = (int)L; { const int q = nwg / NXCD, r = nwg % NXCD, xcd = wgid % NXCD, off = wgid / NXCD; wgid = (xcd < r ? xcd * (q + 1) : r * (q + 1) + (xcd - r) * q) + off; }
    const int nig = WGM * nN, gid = wgid / nig, fm = gid * WGM, gsz = (nM - fm) < WGM ? (nM - fm) : WGM;
    u.pm = fm + ((wgid % nig) % gsz); u.pn = (wgid % nig) / gsz; return true;
  }
};

template <class E>
__device__ __forceinline__ void epi_call(const E& e, const f32x4 (&acc)[2][2][4][2], const Unit& u, int wr, int wc, int fr_, int fq_) {
  int fr = fr_, fq = fq_;
  asm volatile("" : "+v"(fr), "+v"(fq));
  if constexpr (E::STAGED) {
    if (E::STAGED_ALL || u.sub == 3) {
#pragma unroll
      for (int ai = 0; ai < 2; ++ai)
#pragma unroll
        for (int m = 0; m < 4; ++m) {
          typename E::Pre q[2];
#pragma unroll
          for (int bj = 0; bj < 2; ++bj) { q[bj] = typename E::Pre{}; e.pre(u.pm * BM + ai * HALF + wr * 64 + m * 16 + fr, u.pn * BM + bj * HALF + wc * 32 + 8 * fq, q[bj]); }
#pragma unroll
          for (int bj = 0; bj < 2; ++bj) {
            float v[8];
#pragma unroll
            for (int j = 0; j < 4; ++j) { v[j] = acc[ai][bj][m][0][j]; v[4 + j] = acc[ai][bj][m][1][j]; }
            e.fin(u.pm * BM + ai * HALF + wr * 64 + m * 16 + fr, u.pn * BM + bj * HALF + wc * 32 + 8 * fq, v, q[bj]);
          }
          __builtin_amdgcn_sched_barrier(0);
        }
      return;
    }
  }
#pragma unroll
  for (int ai = 0; ai < 2; ++ai)
#pragma unroll
    for (int m = 0; m < 4; ++m) {
      const int r = u.pm * BM + ai * HALF + wr * 64 + m * 16 + fr;
#pragma unroll
      for (int bj = 0; bj < 2; ++bj) {
        if constexpr (E::W == 8) {
          const int c0 = u.pn * BM + bj * HALF + wc * 32 + 8 * fq;
          float v[8];
#pragma unroll
          for (int j = 0; j < 4; ++j) { v[j] = acc[ai][bj][m][0][j]; v[4 + j] = acc[ai][bj][m][1][j]; }
          if constexpr (E::W == 8 && E::SUB) e.apply_sub(r, c0, v, u.sub); else e.apply(r, c0, v);
        } else {
#pragma unroll
          for (int n = 0; n < 2; ++n) {
            const int c0 = u.pn * BM + bj * HALF + wc * 32 + 16 * n + 4 * fq;
            float v[4];
#pragma unroll
            for (int j = 0; j < 4; ++j) v[j] = acc[ai][bj][m][n][j];
            e.apply(r, c0, v);
          }
        }
      }
      if (m == 1 || m == 3) __builtin_amdgcn_sched_barrier(0);
    }
}

template <class Epi>
__device__ __forceinline__ void gemm_phase(PG8_LAS unsigned char* lds, const int tid, const GemmDesc g, const Epi& E) {
  constexpr bool PERM = (Epi::W == 8);
  const int wid = __builtin_amdgcn_readfirstlane(tid >> 6), lane = tid & 63, wr = wid >> 2, wc = wid & 3, fr = lane & 15, fq = lane >> 4;
  const int K = g.K, nt = K / BK;
  StaticOrder S; S.init(g.nrows / BM, g.ncols / BM, (int)gridDim.x, (int)((blockIdx.x + gridDim.x - (unsigned)g.unit_off % gridDim.x) % gridDim.x), g.nsub);
  unsigned voffA[2], voffB[2];
#pragma unroll
  for (int i = 0; i < 2; ++i) { int R, C; stage_rc(tid * 16 + i * 8192, R, C); const int Rb = PERM ? ((R & ~31) + perm32(R & 31)) : R;
    voffA[i] = (unsigned)(R * g.lda + C) * 2u; voffB[i] = (unsigned)(Rb * g.ldb + C) * 2u; }
  const size_t kstep = (size_t)(BK * 2);
  const size_t hstepA = (size_t)HALF * g.lda * 2, hstepB = (size_t)HALF * g.ldb * 2;
  const unsigned ldsw = (unsigned)wid * 1024u;
  const int aoff = lds_byte(wr * 64 + fr, fq * 8), boff = lds_byte(wc * 32 + fr, fq * 8);
#define PG8_SA(b, h) (((b) * 2 + (h)) * HTB)
#define PG8_SB(b, h) ((4 + (b) * 2 + (h)) * HTB)
#define PG8_STAGE(bufoff, gbase, voff) do { _Pragma("unroll") for (int _i = 0; _i < 2; ++_i) \
        __builtin_amdgcn_global_load_lds((const unsigned*)((const char*)(gbase) + (voff)[_i]), (PG8_LAS unsigned*)(lds + (bufoff) + ldsw + _i * 8192), 16, 0, 0); } while (0)
#define PG8_LDA(dst, b, h) do { _Pragma("unroll") for (int m = 0; m < 4; ++m) _Pragma("unroll") for (int k = 0; k < 2; ++k) dst[m][k] = *(const PG8_LAS bf16x8*)(lds + PG8_SA(b, h) + aoff + m * 2048 + k * 1024); } while (0)
#define PG8_LDB(dst, b, h) do { _Pragma("unroll") for (int n = 0; n < 2; ++n) _Pragma("unroll") for (int k = 0; k < 2; ++k) dst[n][k] = *(const PG8_LAS bf16x8*)(lds + PG8_SB(b, h) + boff + n * 2048 + k * 1024); } while (0)
#define PG8_MMA(ai, bj, At, Bt) do { __builtin_amdgcn_s_setprio(1); _Pragma("unroll") for (int m = 0; m < 4; ++m) _Pragma("unroll") for (int n = 0; n < 2; ++n) _Pragma("unroll") for (int k = 0; k < 2; ++k) \
        acc[ai][bj][m][n] = __builtin_amdgcn_mfma_f32_16x16x32_bf16(Bt[n][k], At[m][k], acc[ai][bj][m][n], 0, 0, 0); __builtin_amdgcn_s_setprio(0); } while (0)
#define PG8_WAIT_V(n) asm volatile("s_waitcnt vmcnt(" #n ")" ::: "memory")
#define PG8_WAIT_L(n) asm volatile("s_waitcnt lgkmcnt(" #n ")" ::: "memory")
#define PG8_BAR __builtin_amdgcn_s_barrier()
#define PG8_SCHED __builtin_amdgcn_sched_barrier(0)
#define PG8_ABASE(u) ((const char*)g.A + ((size_t)(u).pm * BM * g.lda + (size_t)((u).pn >> g.a_pn_shift) * g.a_pn_mul + (size_t)(u).sub * g.a_sub) * 2)
#define PG8_BBASE(u) ((const char*)g.Bt + ((size_t)(u).pn * BM * g.ldb + (size_t)(u).sub * g.b_sub) * 2)
  Unit cur, nxt; int ui = 0;
  if (!S.next(0, cur)) return;
  f32x4 acc[2][2][4][2];
#pragma unroll
  for (int a = 0; a < 2; ++a)
#pragma unroll
    for (int b = 0; b < 2; ++b)
#pragma unroll
      for (int m = 0; m < 4; ++m)
#pragma unroll
        for (int n = 0; n < 2; ++n) acc[a][b][m][n] = (f32x4){0.f, 0.f, 0.f, 0.f};
  bf16x8 At[4][2], B0[2][2], B1[2][2];
  const char* cA = PG8_ABASE(cur); const char* cB = PG8_BBASE(cur);
  asm volatile("" : "+v"(voffA[0]), "+v"(voffA[1]), "+v"(voffB[0]), "+v"(voffB[1]));
  PG8_STAGE(PG8_SB(0, 0), cB, voffB); PG8_STAGE(PG8_SA(0, 0), cA, voffA); PG8_STAGE(PG8_SB(0, 1), cB + hstepB, voffB); PG8_STAGE(PG8_SA(0, 1), cA + hstepA, voffA);
  if (wr == 1) PG8_BAR;
  PG8_WAIT_V(4); PG8_BAR;
  PG8_STAGE(PG8_SB(1, 0), cB + kstep, voffB); PG8_STAGE(PG8_SA(1, 0), cA + kstep, voffA); PG8_STAGE(PG8_SB(1, 1), cB + hstepB + kstep, voffB);
  PG8_WAIT_V(6); PG8_BAR;
  for (;;) {
    const bool has_next = S.next(ui + 1, nxt);
    const char* nA = has_next ? PG8_ABASE(nxt) : cA; const char* nB = has_next ? PG8_BBASE(nxt) : cB;
    for (int t = 0; t < nt; t += 2) {
      const bool last = (t == nt - 2);
      asm volatile("" : "+v"(voffA[0]), "+v"(voffA[1]), "+v"(voffB[0]), "+v"(voffB[1]));
      const char* a1 = cA + (size_t)(t + 1) * kstep;
      const char* a2 = last ? nA : cA + (size_t)(t + 2) * kstep; const char* b2 = last ? nB : cB + (size_t)(t + 2) * kstep;
      const char* a3 = a2 + kstep; const char* b3 = b2 + kstep;
      PG8_LDB(B0, 0, 0); PG8_SCHED; PG8_LDA(At, 0, 0); PG8_STAGE(PG8_SA(1, 1), a1 + hstepA, voffA);
      PG8_WAIT_L(8); PG8_BAR; PG8_WAIT_L(0); PG8_MMA(0, 0, At, B0); PG8_BAR; PG8_SCHED;
      PG8_LDB(B1, 0, 1); PG8_STAGE(PG8_SB(0, 0), b2, voffB);
      PG8_BAR; PG8_WAIT_L(0); PG8_MMA(0, 1, At, B1); PG8_BAR;
      PG8_LDA(At, 0, 1); PG8_STAGE(PG8_SA(0, 0), a2, voffA);
      PG8_BAR; PG8_WAIT_L(0); PG8_MMA(1, 0, At, B0); PG8_BAR; PG8_SCHED;
      PG8_STAGE(PG8_SB(0, 1), b2 + hstepB, voffB);
      PG8_WAIT_V(6); PG8_BAR; PG8_MMA(1, 1, At, B1); PG8_BAR;
      PG8_LDB(B0, 1, 0); PG8_SCHED; PG8_LDA(At, 1, 0); PG8_STAGE(PG8_SA(0, 1), a2 + hstepA, voffA);
      PG8_WAIT_L(8); PG8_BAR; PG8_WAIT_L(0); PG8_MMA(0, 0, At, B0); PG8_BAR; PG8_SCHED;
      PG8_LDB(B1, 1, 1); PG8_STAGE(PG8_SB(1, 0), b3, voffB);
      PG8_BAR; PG8_WAIT_L(0); PG8_MMA(0, 1, At, B1); PG8_BAR;
      PG8_LDA(At, 1, 1); PG8_STAGE(PG8_SA(1, 0), a3, voffA);
      PG8_BAR; PG8_WAIT_L(0); PG8_MMA(1, 0, At, B0); PG8_BAR; PG8_SCHED;
      PG8_STAGE(PG8_SB(1, 1), b3 + hstepB, voffB);
      PG8_WAIT_V(6); PG8_BAR; PG8_MMA(1, 1, At, B1); PG8_BAR;
    }
    epi_call(E, acc, cur, wr, wc, fr, fq);
    if (!has_next) break;
#pragma unroll
    for (int a = 0; a < 2; ++a)
#pragma unroll
      for (int b = 0; b < 2; ++b)
#pragma unroll
        for (int m = 0; m < 4; ++m)
#pragma unroll
          for (int n = 0; n < 2; ++n) acc[a][b][m][n] = (f32x4){0.f, 0.f, 0.f, 0.f};
    cur = nxt; cA = nA; cB = nB; ++ui;
  }
  PG8_WAIT_V(0);
  if (wr == 0) PG8_BAR;
  PG8_BAR;
#undef PG8_SA
#undef PG8_SB
#undef PG8_STAGE
#undef PG8_LDA
#undef PG8_LDB
#undef PG8_MMA
#undef PG8_WAIT_V
#undef PG8_WAIT_L
#undef PG8_BAR
#undef PG8_SCHED
#undef PG8_ABASE
#undef PG8_BBASE
}
}
struct Ctx { i64 gtid, gsz; PG8_LAS unsigned char* lds; char* ldsg; int tid; };
template <class E> DEV void run_gemm(const Ctx& cx, const GemmDesc& g, const E& e) { pg8::gemm_phase<E>(cx.lds, cx.tid, g, e); }
#else
struct Ctx { i64 gtid, gsz; };
template <class E> static void run_gemm(const Ctx& cx, const GemmDesc& g, const E& e) {
  constexpr int W = E::W;
  const int ng = g.ncols / W;
  for (i64 i = cx.gtid; i < (i64)g.nrows * ng; i += cx.gsz) {
    int r = (int)(i / ng), c0 = (int)(i % ng) * W;
    int pn = c0 / 256;
    for (int sub = 0; sub < g.nsub; ++sub) {
      const bf* a = g.A + (size_t)r * g.lda + (size_t)(pn >> g.a_pn_shift) * g.a_pn_mul + (size_t)sub * g.a_sub;
      float v[8];
      for (int j = 0; j < W; ++j) {
        const bf* b = g.Bt + (size_t)(c0 + j) * g.ldb + (size_t)sub * g.b_sub;
        float acc = 0.f;
        for (int k = 0; k < g.K; ++k) acc += b2f(a[k]) * b2f(b[k]);
        v[j] = acc;
      }
      if constexpr (E::SUB) e.apply_sub(r, c0, v, sub); else e.apply(r, c0, v);
    }
  }
}
#endif


#ifndef CPU_SIM
namespace fa {
using bf16x8 = __attribute__((ext_vector_type(8))) short;
using s16x4 = __attribute__((ext_vector_type(4))) short;
using f32x16 = __attribute__((ext_vector_type(16))) float;
using u32x4 = __attribute__((ext_vector_type(4))) unsigned;
constexpr int KVBLK = 64, QBLK = 32;
constexpr float THR = 8.f;
constexpr int SHM_V = KVBLK * 128 * 2, SHM_K = KVBLK * 128 * 2;
constexpr int NBUF = 3;
constexpr int SHM_ATTN = NBUF * SHM_V + NBUF * SHM_K + 8 * 64 * 4;
#define KSWZ(row, colB) ((row) * 256 + ((colB) ^ (((row) & 7) << 4)))
#define SBAR() __builtin_amdgcn_sched_barrier(0)
__device__ __forceinline__ int crow(int r, int hi) { return (r & 3) + 8 * (r >> 2) + 4 * hi; }
__device__ __forceinline__ unsigned cvtpk(float lo, float hi) { unsigned r; asm volatile("v_cvt_pk_bf16_f32 %0, %1, %2" : "=v"(r) : "v"(lo), "v"(hi)); return r; }
template <int SC1000000> __device__ __forceinline__ void partialSM(f32x16& p0, f32x16& p1, float& m_reg, float& mn, float& alpha) {
  constexpr float SCALE = SC1000000 * 1e-9f; constexpr float C = SCALE * 1.4426950408889634f;
  float pmax = p0[0];
#pragma unroll
  for (int r = 1; r < 16; ++r) pmax = fmaxf(pmax, p0[r]);
#pragma unroll
  for (int r = 0; r < 16; ++r) pmax = fmaxf(pmax, p1[r]);
  { auto rr = __builtin_amdgcn_permlane32_swap(__float_as_uint(pmax), __float_as_uint(pmax), false, false);
    pmax = fmaxf(__uint_as_float(rr[0]), __uint_as_float(rr[1])); }
  if (__builtin_expect(__all(pmax - m_reg <= THR / SCALE), 1)) { mn = m_reg; alpha = 1.f; }
  else { mn = fmaxf(m_reg, pmax); alpha = __builtin_amdgcn_exp2f((m_reg - mn) * C); m_reg = mn; }
  float mnC = -mn * C;
#pragma unroll
  for (int r = 0; r < 16; ++r) p0[r] = fmaf(p0[r], C, mnC);
#pragma unroll
  for (int r = 0; r < 16; ++r) p1[r] = fmaf(p1[r], C, mnC);
#pragma unroll
  for (int r = 0; r < 16; ++r) p0[r] = __builtin_amdgcn_exp2f(p0[r]);
}
__device__ __forceinline__ void finishSM(f32x16& p0, f32x16& p1, float alpha, float& l_reg, bf16x8& pa0, bf16x8& pa1, bf16x8& pa2, bf16x8& pa3) {
#pragma unroll
  for (int r = 0; r < 16; ++r) p1[r] = __builtin_amdgcn_exp2f(p1[r]);
  float ps = 0;
#pragma unroll
  for (int r = 0; r < 16; ++r) ps += p0[r];
#pragma unroll
  for (int r = 0; r < 16; ++r) ps += p1[r];
  { auto rr = __builtin_amdgcn_permlane32_swap(__float_as_uint(ps), __float_as_uint(ps), false, false);
    ps = __uint_as_float(rr[0]) + __uint_as_float(rr[1]); }
  l_reg = l_reg * alpha + ps;
#define PK4(P, BASE, OUT) do { unsigned a0 = cvtpk(P[BASE + 0], P[BASE + 1]), a1 = cvtpk(P[BASE + 2], P[BASE + 3]);   \
    unsigned b0 = cvtpk(P[BASE + 4], P[BASE + 5]), b1 = cvtpk(P[BASE + 6], P[BASE + 7]);                              \
    auto r0 = __builtin_amdgcn_permlane32_swap(a0, b0, false, false); auto r1 = __builtin_amdgcn_permlane32_swap(a1, b1, false, false); \
    u32x4 w = {r0[0], r1[0], r0[1], r1[1]}; OUT = *reinterpret_cast<bf16x8*>(&w); } while (0)
  PK4(p0, 0, pa0); PK4(p0, 8, pa1); PK4(p1, 0, pa2); PK4(p1, 8, pa3);
#undef PK4
}
template <int NK16>
__device__ __forceinline__ void qkt(f32x16& p0, f32x16& p1, const char* Ks, const bf16x8* qr, int r32, int hi) {
  p0 = f32x16{}; p1 = f32x16{};
#pragma unroll
  for (int d0 = 0; d0 < NK16; ++d0) { int cb = (d0 * 16 + hi * 8) * 2;
    bf16x8 b0 = *reinterpret_cast<const bf16x8*>(Ks + KSWZ(r32, cb));
    bf16x8 b1 = *reinterpret_cast<const bf16x8*>(Ks + KSWZ(32 + r32, cb));
    p0 = __builtin_amdgcn_mfma_f32_32x32x16_bf16(b0, qr[d0], p0, 0, 0, 0);
    p1 = __builtin_amdgcn_mfma_f32_32x32x16_bf16(b1, qr[d0], p1, 0, 0, 0); }
}
__device__ __forceinline__ int v_st(int k, int c) { const int kk = (k & ~0xC) | ((k & 4) << 1) | ((k & 8) >> 1); return ((kk >> 3) * 4 + (c >> 5)) * 512 + ((kk & 7) * 32 + (c & 31)) * 2; }
__device__ __forceinline__ int v_rd_base(int lane) { return ((lane & 3) << 3) | (((lane >> 2) & 3) << 6) | (((lane >> 4) & 1) << 5) | (((lane >> 5) & 1) << 8); }
constexpr int v_rd_off(int d0, int ks, int half) { return d0 * 512 + ks * 4096 + half * 2048; }
template <int OFF> __device__ __forceinline__ s16x4 tr_read(int vb) {
  s16x4 r; asm volatile("ds_read_b64_tr_b16 %0, %1 offset:%2" : "=&v"(r) : "v"(vb), "i"(OFF) : "memory"); return r;
}
template <int D0> __device__ __forceinline__ void pv_one(f32x16& od, int vb, bf16x8 pa0, bf16x8 pa1, bf16x8 pa2, bf16x8 pa3) {
  const s16x4 l0 = tr_read<v_rd_off(D0, 0, 0)>(vb), h0 = tr_read<v_rd_off(D0, 0, 1)>(vb), l1 = tr_read<v_rd_off(D0, 1, 0)>(vb), h1 = tr_read<v_rd_off(D0, 1, 1)>(vb);
  const s16x4 l2 = tr_read<v_rd_off(D0, 2, 0)>(vb), h2 = tr_read<v_rd_off(D0, 2, 1)>(vb), l3 = tr_read<v_rd_off(D0, 3, 0)>(vb), h3 = tr_read<v_rd_off(D0, 3, 1)>(vb);
  asm volatile("s_waitcnt lgkmcnt(0)" ::: "memory"); SBAR();
#define PK(L, H) (bf16x8){L[0], L[1], L[2], L[3], H[0], H[1], H[2], H[3]}
  od = __builtin_amdgcn_mfma_f32_32x32x16_bf16(pa0, PK(l0, h0), od, 0, 0, 0);
  od = __builtin_amdgcn_mfma_f32_32x32x16_bf16(pa1, PK(l1, h1), od, 0, 0, 0);
  od = __builtin_amdgcn_mfma_f32_32x32x16_bf16(pa2, PK(l2, h2), od, 0, 0, 0);
  od = __builtin_amdgcn_mfma_f32_32x32x16_bf16(pa3, PK(l3, h3), od, 0, 0, 0);
#undef PK
}
__device__ __forceinline__ void pv_d0(f32x16* o, int vb, bf16x8 pa0, bf16x8 pa1, bf16x8 pa2, bf16x8 pa3) {
  pv_one<0>(o[0], vb, pa0, pa1, pa2, pa3); pv_one<1>(o[1], vb, pa0, pa1, pa2, pa3);
}

struct Src { const bf* q; int qstride; const bf* ksrc; int kstride; const bf* vsrc; int vstride; bf* out; float m0, l0; int dq0; };
template <int NK16, int SC1000000, bool MASK>
__device__ __forceinline__ void unit(const Src& sd, const int tid, char* lds, int kbase0, int nt0, int kbase1, int NT) {
  const int wid = tid >> 6, lane = tid & 63, r32 = lane & 31, hi = lane >> 5;
  char* V_lds = lds; char* K_lds = lds + NBUF * SHM_V;
  float* wsl = (float*)(lds + NBUF * SHM_V + NBUF * SHM_K) + wid * 64; float* li_l = wsl; float* al_l = wsl + 32;
  float m_reg = sd.m0, l_reg = sd.l0; f32x16 o[2] = {}; bf16x8 qr[NK16];
  const bf* Qw = sd.q + (size_t)(wid * QBLK + r32) * sd.qstride + hi * 8;
#pragma unroll
  for (int d0 = 0; d0 < NK16; ++d0) qr[d0] = *reinterpret_cast<const bf16x8*>(Qw + d0 * 16);
  const int sr = tid >> 4, sc = (tid & 15) * 8, vst0 = v_st(sr, sc), vst1 = v_st(32 + sr, sc);
  const int vb0 = (int)(uintptr_t)V_lds + v_rd_base(lane);
  const bf* ksrc = sd.ksrc; const int kstride = sd.kstride; const bf* vsrc = sd.vsrc; const int vstride = sd.vstride;
  const int dqw = sd.dq0 + wid * QBLK + r32;
  struct { bf16x8 vs0, vs1, ks0, ks1; } sr_[2];
#define KROW(j) ((j) < nt0 ? kbase0 + (j) * KVBLK : kbase1 + ((j) - nt0) * KVBLK)
#define SLOAD(i, j) do { const int _kr = KROW(j); \
    sr_[i].vs0 = *reinterpret_cast<const bf16x8*>(vsrc + (size_t)(_kr + sr) * vstride); sr_[i].vs1 = *reinterpret_cast<const bf16x8*>(vsrc + (size_t)(_kr + 32 + sr) * vstride); \
    sr_[i].ks0 = *reinterpret_cast<const bf16x8*>(ksrc + (size_t)(_kr + sr) * kstride); sr_[i].ks1 = *reinterpret_cast<const bf16x8*>(ksrc + (size_t)(_kr + 32 + sr) * kstride); } while (0)
#define SWRITE(b, i) do { *(bf16x8*)(V_lds + (b) * SHM_V + vst0) = sr_[i].vs0;          \
    *(bf16x8*)(V_lds + (b) * SHM_V + vst1) = sr_[i].vs1; int kc = sc * 2;               \
    *(bf16x8*)(K_lds + (b) * SHM_K + KSWZ(sr, kc)) = sr_[i].ks0;                       \
    *(bf16x8*)(K_lds + (b) * SHM_K + KSWZ(32 + sr, kc)) = sr_[i].ks1; } while (0)
#define SWAIT() asm volatile("s_waitcnt vmcnt(4)" ::: "memory")
#define MASKT(P0, P1, J) do { if (MASK && (J) < nt0) { const int _d = (J) * KVBLK - dqw; \
    _Pragma("unroll") for (int r = 0; r < 16; ++r) { const int dd = _d + crow(r, hi); if (dd > 128 || dd < -128) P0[r] = -1e30f; if (dd + 32 > 128 || dd + 32 < -128) P1[r] = -1e30f; } } } while (0)
#define RESC(a) do { if (__any((a) < 1.f)) { if (hi == 0) al_l[r32] = (a); asm volatile("s_waitcnt lgkmcnt(0)" ::: "memory"); \
    _Pragma("unroll") for (int d = 0; d < 2; ++d) _Pragma("unroll") for (int r = 0; r < 16; ++r) o[d][r] *= al_l[crow(r, hi)]; } } while (0)
  f32x16 pA0, pA1, pB0, pB1; float mnA, mnB, alA, alB; bf16x8 pa0, pa1, pa2, pa3;
  constexpr int SE = 0, SO = 1;
  __syncthreads();
  SLOAD(SE, 0); asm volatile("s_waitcnt vmcnt(0)" ::: "memory"); SWRITE(0, SE); __syncthreads();
  qkt<NK16>(pA0, pA1, K_lds, qr, r32, hi); MASKT(pA0, pA1, 0); partialSM<SC1000000>(pA0, pA1, m_reg, mnA, alA);
  SLOAD(SO, 1); if (2 < NT) SLOAD(SE, 2);
  SWAIT();
  SWRITE(1, SO); __syncthreads();
  int bc = 1;
  for (int j = 1; j + 1 < NT; j += 2) {
    { const int bp = bc == 0 ? NBUF - 1 : bc - 1, bn = bc == NBUF - 1 ? 0 : bc + 1;
      SBAR(); qkt<NK16>(pB0, pB1, K_lds + bc * SHM_K, qr, r32, hi);
      finishSM(pA0, pA1, alA, l_reg, pa0, pa1, pa2, pa3); SBAR();
      SLOAD(SO, j + 2); SBAR();
      pv_d0(o, vb0 + bp * SHM_V, pa0, pa1, pa2, pa3); MASKT(pB0, pB1, j); partialSM<SC1000000>(pB0, pB1, m_reg, mnB, alB);
      SWAIT(); SWRITE(bn, SE);
      RESC(alB); __syncthreads();
      bc = bn; }
    { const int bp = bc == 0 ? NBUF - 1 : bc - 1, bn = bc == NBUF - 1 ? 0 : bc + 1;
      SBAR(); qkt<NK16>(pA0, pA1, K_lds + bc * SHM_K, qr, r32, hi);
      finishSM(pB0, pB1, alB, l_reg, pa0, pa1, pa2, pa3); SBAR();
      if (j + 3 < NT) SLOAD(SE, j + 3); SBAR();
      pv_d0(o, vb0 + bp * SHM_V, pa0, pa1, pa2, pa3); MASKT(pA0, pA1, j + 1); partialSM<SC1000000>(pA0, pA1, m_reg, mnA, alA);
      SWAIT(); SWRITE(bn, SO);
      RESC(alA); __syncthreads();
      bc = bn; }
  }
  { const int bp = bc == 0 ? NBUF - 1 : bc - 1;
    SBAR(); qkt<NK16>(pB0, pB1, K_lds + bc * SHM_K, qr, r32, hi);
    finishSM(pA0, pA1, alA, l_reg, pa0, pa1, pa2, pa3); SBAR();
    pv_d0(o, vb0 + bp * SHM_V, pa0, pa1, pa2, pa3); MASKT(pB0, pB1, NT - 1); partialSM<SC1000000>(pB0, pB1, m_reg, mnB, alB);
    RESC(alB);
    finishSM(pB0, pB1, alB, l_reg, pa0, pa1, pa2, pa3); SBAR();
    pv_d0(o, vb0 + bc * SHM_V, pa0, pa1, pa2, pa3); }
  asm volatile("s_waitcnt vmcnt(0)" ::: "memory");
  if (hi == 0) li_l[r32] = l_reg; asm volatile("s_waitcnt lgkmcnt(0)" ::: "memory");
  float rli[16];
#pragma unroll
  for (int r = 0; r < 16; ++r) rli[r] = __builtin_amdgcn_rcpf(li_l[crow(r, hi)]);
  bf* Ow = sd.out + (size_t)(wid * QBLK) * 2048;
#pragma unroll
  for (int r = 0; r < 16; ++r) { int orow = crow(r, hi);
#pragma unroll
    for (int d0 = 0; d0 < 2; ++d0) Ow[(size_t)orow * 2048 + d0 * 32 + r32] = f2b(o[d0][r] * rli[r]); }
#undef SLOAD
#undef SWRITE
#undef SWAIT
#undef MASKT
#undef RESC
#undef KROW
}
#undef KSWZ
#undef SBAR
}

DEV void ph_mla(const Params& p, const Ctx& cx, int last) {
  const int nlat_units = NB * 8 * (N / 256);
  const int nctx_units = last ? 0 : NB * 8 * (LC / 256);
  const int sc = (cx.tid & 15) * 8;
  for (int uu = blockIdx.x; uu < nlat_units + 256; uu += gridDim.x) {
    const int u = uu < nlat_units ? uu : nlat_units + ((uu - nlat_units + 256 - 32) & 255);
    if (u >= nlat_units + nctx_units) continue;
    int qrow0, hh, kb0, nt0, kb1, NT;
    if (u < nlat_units) {
      const int rnd = u / 256, within = u % 256, bh = (rnd * 8 + (within & 7)) % (NB * 8); int qb = within >> 3;
      hh = bh % 8; int b = bh / 8; qrow0 = b * N + qb * 256; kb0 = b * N; nt0 = N / 64; kb1 = NLAT + b * LC; NT = (N + LC) / 64; }
    else { int v = u - nlat_units; int qb = v % (LC / 256); hh = (v / (LC / 256)) % 8; int b = v / (8 * (LC / 256)); qrow0 = NLAT + b * LC + qb * 256; kb0 = NLAT + b * LC; nt0 = LC / 64; kb1 = 0; NT = LC / 64; }
    fa::Src sd;
    sd.q = p.QA() + (size_t)qrow0 * 768 + hh * 96; sd.qstride = 768;
    if (sc < 64) { sd.ksrc = p.KVA() + hh * 128 + sc; sd.kstride = 1024; } else { sd.ksrc = p.P() + C_KR + ((sc - 64) & 31); sd.kstride = PC; }
    sd.vsrc = p.KVA() + hh * 128 + 64 + (sc & 63); sd.vstride = 1024;
    sd.out = p.Y() + (size_t)qrow0 * 2048 + hh * 64; sd.m0 = -1e30f; sd.l0 = 0.f; sd.dq0 = 0;
    fa::unit<6, 102062073, false>(sd, cx.tid, cx.ldsg, kb0, nt0, kb1, NT);
  }
}
DEV void ph_gqa(const Params& p, const Ctx& cx, int l, int last) {
  const int nlat_units = NB * 8 * (N / 256);
  const int nctx_units = last ? 0 : NB * 8 * (LC / 256);
  const int sc = (cx.tid & 15) * 8;
  for (int uu = blockIdx.x; uu < nlat_units + 256; uu += gridDim.x) {
    const int u = uu < nlat_units ? uu : nlat_units + ((uu - nlat_units + 256 - 16) & 255);
    if (u >= nlat_units + nctx_units) continue;
    int qrow0, hh, kb0, nt0, kb1, NT, dq0 = 0;
    if (u < nlat_units) {
      const int rnd = u / 256, within = u % 256, bh = (rnd * 8 + (within & 7)) % (NB * 8); int qb = within >> 3;
      hh = bh % 8; int b = bh / 8;
      int q0 = qb * 256; int klo = q0 - 128 < 0 ? 0 : q0 - 128; int khi = q0 + 384 > N ? N : q0 + 384;
      qrow0 = b * N + q0; kb0 = b * N + klo; nt0 = (khi - klo) / 64; kb1 = NLAT + b * LC; NT = nt0 + LC / 64; dq0 = q0 - klo;
    } else { int v = u - nlat_units; int qb = v % (LC / 256); hh = (v / (LC / 256)) % 8; int b = v / (8 * (LC / 256)); qrow0 = NLAT + b * LC + qb * 256; kb0 = NLAT + b * LC; nt0 = 0; kb1 = kb0; NT = LC / 64; }
    const int kh = hh >> 2;
    fa::Src sd;
    sd.q = p.P() + (size_t)qrow0 * PC + C_GQ + hh * 64; sd.qstride = PC;
    sd.ksrc = p.P() + C_GKV + kh * 64 + (sc & 63); sd.kstride = PC;
    sd.vsrc = p.P() + C_GKV + 128 + kh * 64 + (sc & 63); sd.vstride = PC;
    sd.out = p.Y() + (size_t)qrow0 * 2048 + 1536 + hh * 64;
    sd.m0 = p.in[I_gqa_sink][l * 8 + hh] * 8.0f; sd.l0 = 1.0f; sd.dq0 = dq0;
    fa::unit<4, 125000000, true>(sd, cx.tid, cx.ldsg, kb0, nt0, kb1, NT);
  }
}
#endif


namespace hy {
constexpr int NF = 2 * N;
struct f2 { float x, y; };
DEV f2 cmul(f2 a, f2 b) { f2 r; r.x = a.x * b.x - a.y * b.y; r.y = a.x * b.y + a.y * b.x; return r; }
#ifndef CPU_SIM
DEV f2 twid(const f2*, int k) { const float x = (float)k * (1.0f / (float)NF); return f2{__builtin_amdgcn_cosf(x), -__builtin_amdgcn_sinf(x)}; }
#else
DEV f2 twid(const f2* tw, int k) { return tw[k]; }
#endif
DEV f2 cmulc(f2 a, f2 b) { f2 r; r.x = a.x * b.x + a.y * b.y; r.y = a.y * b.x - a.x * b.y; return r; }
DEV void fwd_pass(f2* buf, const f2* tw, int L, int tid, int nthr) {
  const int Q = L >> 2, tws = NF / L;
  for (int u = tid; u < NF / 4; u += nthr) {
    const int g = u / Q, j = u - g * Q, base = g * L + j;
    const f2 x0 = buf[base], x1 = buf[base + Q], x2 = buf[base + 2 * Q], x3 = buf[base + 3 * Q];
    f2 a0{x0.x + x2.x, x0.y + x2.y}, a1{x0.x - x2.x, x0.y - x2.y}, a2{x1.x + x3.x, x1.y + x3.y};
    f2 d{x1.x - x3.x, x1.y - x3.y}; f2 a3{d.y, -d.x};
    f2 y0{a0.x + a2.x, a0.y + a2.y}, y1{a1.x + a3.x, a1.y + a3.y}, y2{a0.x - a2.x, a0.y - a2.y}, y3{a1.x - a3.x, a1.y - a3.y};
    buf[base] = y0; buf[base + Q] = cmul(y1, twid(tw, j * tws)); buf[base + 2 * Q] = cmul(y2, twid(tw, 2 * j * tws)); buf[base + 3 * Q] = cmul(y3, twid(tw, 3 * j * tws));
  }
}
DEV void inv_pass(f2* buf, const f2* tw, int L, int tid, int nthr) {
  const int Q = L >> 2, tws = NF / L;
  for (int u = tid; u < NF / 4; u += nthr) {
    const int g = u / Q, j = u - g * Q, base = g * L + j;
    const f2 u0 = buf[base], u1 = cmulc(buf[base + Q], twid(tw, j * tws)), u2 = cmulc(buf[base + 2 * Q], twid(tw, 2 * j * tws)), u3 = cmulc(buf[base + 3 * Q], twid(tw, 3 * j * tws));
    f2 a0{u0.x + u2.x, u0.y + u2.y}, a1{u0.x - u2.x, u0.y - u2.y}, a2{u1.x + u3.x, u1.y + u3.y};
    f2 d{u1.x - u3.x, u1.y - u3.y}; f2 a3{-d.y, d.x};
    buf[base] = f2{a0.x + a2.x, a0.y + a2.y}; buf[base + Q] = f2{a1.x + a3.x, a1.y + a3.y};
    buf[base + 2 * Q] = f2{a0.x - a2.x, a0.y - a2.y}; buf[base + 3 * Q] = f2{a1.x - a3.x, a1.y - a3.y};
  }
}
DEV void s1_taps(const Params& p, f2* buf, float* red, int c, int tid, int nthr) {
  float ss = 0.f;
#pragma unroll 8
  for (int k = tid; k < NF; k += nthr) {
    float v = 0.f;
    if (k < N) v = p.F()[(size_t)k * 1024 + c];
    else if (k > N) v = p.F()[(size_t)(NF - k) * 1024 + 512 + c];
    buf[k] = f2{v, 0.f}; ss += v * v;
  }
  red[tid] = ss;
}
DEV float red_total(const float* red, int nthr) { float s = 0.f; for (int i = 0; i < nthr; ++i) s += red[i]; return s; }
DEV void s3_store(const f2* buf, unsigned* hs, int tid, int nthr) {
  for (int k = tid; k < NF; k += nthr) hs[k] = (unsigned)f2b(buf[k].x).v | ((unsigned)f2b(buf[k].y).v << 16);
}
DEV void s4_loadz(const Params& p, f2* buf, int c, int tid, int nthr) {
#pragma unroll 8
  for (int t = tid; t < NF; t += nthr) {
    f2 v{0.f, 0.f};
    if (t < N) { v.x = b2f(p.Z()[(size_t)t * 512 + c]); v.y = b2f(p.Z()[(size_t)(N + t) * 512 + c]); }
    buf[t] = v;
  }
}
DEV void s6_mul(f2* buf, const unsigned* hs, int tid, int nthr) {
  for (int k = tid; k < NF; k += nthr) {
    union { unsigned u; float f; } a, b; const unsigned w = hs[k]; a.u = w << 16; b.u = w & 0xFFFF0000u;
    buf[k] = cmul(buf[k], f2{a.f, b.f});
  }
}
DEV void s8_out(const Params& p, const f2* buf, const float* red, int l, int c, int tid, int nthr) {
  const float fn = 1.0f / sqrtf(red_total(red, nthr) + EPS) * (1.0f / (float)NF);
  const float* cw = p.in[I_hy_conv_w] + l * 3 * 1536; const float cb = p.in[I_hy_conv_b][l * 1536 + c];
  const float w0 = cw[c], w1 = cw[1536 + c], w2 = cw[2 * 1536 + c];
  const float skip = p.in[I_hy_skip][l * 512 + c];
#pragma unroll 4
  for (int i = tid; i < 2 * N; i += nthr) {
    const int b = i / N, t = i - b * N;
    const size_t r = (size_t)b * N + t;
    const float conv = (b ? buf[t].y : buf[t].x) * fn;
    float x0 = cb + w1 * b2f(p.P()[r * PC + C_HU + c]);
    if (t > 0) x0 += w0 * b2f(p.P()[(r - 1) * PC + C_HU + c]);
    if (t < N - 1) x0 += w2 * b2f(p.P()[(r + 1) * PC + C_HU + c]);
    const float y = conv + skip * b2f(p.Z()[r * 512 + c]);
    p.Y()[r * 2048 + 1024 + c] = f2b(x0 * y);
  }
}
#ifndef CPU_SIM
DEV void channel(const Params& p, int l, int c, int tid, f2* buf, float* red, unsigned* hs) {
  const f2* tw = (const f2*)p.tw();
#ifndef HY_EXP
#define HY_EXP 0
#endif
  __syncthreads();
  if (HY_EXP != 2) s1_taps(p, buf, red, c, tid, 512); __syncthreads();
  if (HY_EXP != 1) for (int L = NF; L >= 4; L >>= 2) { fwd_pass(buf, tw, L, tid, 512); __syncthreads(); }
  s3_store(buf, hs, tid, 512); __syncthreads();
  if (HY_EXP != 2) s4_loadz(p, buf, c, tid, 512); __syncthreads();
  if (HY_EXP != 1) for (int L = NF; L >= 4; L >>= 2) { fwd_pass(buf, tw, L, tid, 512); __syncthreads(); }
  s6_mul(buf, hs, tid, 512); __syncthreads();
  if (HY_EXP != 1) for (int L = 4; L <= NF; L <<= 2) { inv_pass(buf, tw, L, tid, 512); __syncthreads(); }
  if (HY_EXP != 2) s8_out(p, buf, red, l, c, tid, 512);
}
#endif
}


namespace tz {
constexpr int NBLK = N / 64;
constexpr int PADB = 31;
constexpr int ZLEN = (NBLK + 2 * PADB) * 64;
constexpr int HLEN = 2 * N + 16;
DEV int a_index(int m, int r, int h) { return N - m - r + 8 * h; }
DEV int b_index(int t1, int Dd, int ks, int h) { return 64 * (t1 - Dd + PADB) + 16 * ks + 8 * h; }
#ifndef CPU_SIM
using bf16x8 = __attribute__((ext_vector_type(8))) short;
using f32x16 = __attribute__((ext_vector_type(16))) float;
using u32x4 = __attribute__((ext_vector_type(4))) unsigned;
DEV bf16x8 load_afrag(const unsigned short* Hr, int e) {
  const unsigned* wp = (const unsigned*)(Hr + (e & ~1));
  const unsigned w0 = wp[0], w1 = wp[1], w2 = wp[2], w3 = wp[3], w4 = wp[4];
  const unsigned sh = (unsigned)(e & 1) << 4;
  u32x4 o;
  o.x = __builtin_amdgcn_alignbit(w1, w0, sh); o.y = __builtin_amdgcn_alignbit(w2, w1, sh); o.z = __builtin_amdgcn_alignbit(w3, w2, sh); o.w = __builtin_amdgcn_alignbit(w4, w3, sh);
  return *reinterpret_cast<bf16x8*>(&o);
}
DEV void channel(const Params& p, int l, int c, int tid, char* lds) {
  unsigned short* zp = (unsigned short*)lds;
  float* red = (float*)(zp + 2 * ZLEN);
  unsigned short* Hr = (unsigned short*)(red + 512);
  float* cv = (float*)Hr;
  const int lane = tid & 63, w = tid >> 6, r = lane & 31, h = lane >> 5;
  __syncthreads();
  float ss = 0.f;
  const float* ff = p.F() + (size_t)c * (N + LC); const float* fb = p.F() + (size_t)(512 + c) * (N + LC);
#pragma unroll 4
  for (int t = tid * 4; t < N; t += 2048) {
    const float4 a = *(const float4*)(ff + t), b = *(const float4*)(fb + t);
    ss += a.x * a.x + a.y * a.y + a.z * a.z + a.w * a.w + b.x * b.x + b.y * b.y + b.z * b.z + b.w * b.w;
    Hr[N - t] = f2b(a.x).v; Hr[N - t - 1] = f2b(a.y).v; Hr[N - t - 2] = f2b(a.z).v; Hr[N - t - 3] = f2b(a.w).v;
    if (t > 0) Hr[N + t] = f2b(b.x).v;
    Hr[N + t + 1] = f2b(b.y).v; Hr[N + t + 2] = f2b(b.z).v; Hr[N + t + 3] = f2b(b.w).v;
  }
  if (tid == 0) Hr[0] = 0;
  if (tid < 16) Hr[2 * N + tid] = 0;
  red[tid] = ss;
  for (int i = tid; i < 2 * PADB * 64; i += 512) {
    const int side = i / (PADB * 64), k = i % (PADB * 64);
    const int off = side ? (PADB + NBLK) * 64 + k : k;
    zp[off] = 0; zp[ZLEN + off] = 0;
  }
  { const unsigned short* zt = (const unsigned short*)p.Z() + (size_t)c * NB * N;
#pragma unroll 4
    for (int i = tid * 8; i < 2 * N; i += 4096) { const int b = i / N, t = i - b * N; *(uint4*)(zp + b * ZLEN + PADB * 64 + t) = *(const uint4*)(zt + i); } }
  __syncthreads();
  float tot = 0.f;
  for (int i = 0; i < 512; ++i) tot += red[i];
  const float fn = 1.0f / sqrtf(tot + EPS);
  const int t1 = 32 * (w & 3) + r;
  const unsigned short* zb = zp + (w >> 2) * ZLEN;
  f32x16 acc0 = {}, acc1 = {};
  const int Dlo = 32 * (w & 3) - (NBLK - 1), Dhi = 32 * (w & 3) + 31;
#define TZ_LOAD(AF, BF, PA, PB) do { _Pragma("unroll") for (int ks = 0; ks < 4; ++ks) BF[ks] = *reinterpret_cast<const bf16x8*>((PB) + 16 * ks); \
    _Pragma("unroll") for (int q = 0; q < 6; ++q) { const unsigned* wq_ = (PA) + 8 * (5 - q); const unsigned w0_ = wq_[0], w1_ = wq_[1], w2_ = wq_[2], w3_ = wq_[3], w4_ = wq_[4]; u32x4 o_; \
      o_.x = __builtin_amdgcn_alignbit(w1_, w0_, shA); o_.y = __builtin_amdgcn_alignbit(w2_, w1_, shA); o_.z = __builtin_amdgcn_alignbit(w3_, w2_, shA); o_.w = __builtin_amdgcn_alignbit(w4_, w3_, shA); \
      AF[q] = *reinterpret_cast<bf16x8*>(&o_); } } while (0)
#define TZ_MMA(AF, BF) do { _Pragma("unroll") for (int ks = 0; ks < 4; ++ks) { \
    acc0 = __builtin_amdgcn_mfma_f32_32x32x16_bf16(AF[3 - ks], BF[ks], acc0, 0, 0, 0); acc1 = __builtin_amdgcn_mfma_f32_32x32x16_bf16(AF[5 - ks], BF[ks], acc1, 0, 0, 0); } } while (0)
  const unsigned shA = (unsigned)(r & 1) << 4;
  const unsigned* pa = (const unsigned*)Hr + ((a_index(64 * Dlo - 48 + 80, r, h) & ~1) >> 1);
  const unsigned short* pb = zb + b_index(t1, Dlo, 0, h);
#define TZ_LOAD4(AF, BF, PREV, PA, PB) do { _Pragma("unroll") for (int ks = 0; ks < 4; ++ks) BF[ks] = *reinterpret_cast<const bf16x8*>((PB) + 16 * ks); \
    AF[0] = PREV[4]; AF[1] = PREV[5]; \
    _Pragma("unroll") for (int q = 2; q < 6; ++q) { const unsigned* wq_ = (PA) + 8 * (5 - q); const unsigned w0_ = wq_[0], w1_ = wq_[1], w2_ = wq_[2], w3_ = wq_[3], w4_ = wq_[4]; u32x4 o_; \
      o_.x = __builtin_amdgcn_alignbit(w1_, w0_, shA); o_.y = __builtin_amdgcn_alignbit(w2_, w1_, shA); o_.z = __builtin_amdgcn_alignbit(w3_, w2_, shA); o_.w = __builtin_amdgcn_alignbit(w4_, w3_, shA); \
      AF[q] = *reinterpret_cast<bf16x8*>(&o_); } } while (0)
  bf16x8 afA[6], bfA[4], afB[6], bfB[4];
  TZ_LOAD(afA, bfA, pa, pb);
#pragma unroll 1
  for (int Dd = Dlo; Dd + 2 <= Dhi; Dd += 2) {
    TZ_LOAD4(afB, bfB, afA, pa - 32, pb - 64);
    TZ_MMA(afA, bfA);
    pa -= 64; pb -= 128;
    TZ_LOAD4(afA, bfA, afB, pa, pb);
    TZ_MMA(afB, bfB);
  }
  TZ_MMA(afA, bfA);
#undef TZ_LOAD4
#undef TZ_LOAD
#undef TZ_MMA
  static_assert((NBLK + 31) % 2 == 1, "K-loop pairing assumes an odd number of steps");
  __syncthreads();
  { int t1e = t1, he = h;
    asm volatile("" : "+v"(t1e), "+v"(he));
    float* cvb = cv + (w >> 2) * N + 64 * t1e + 4 * he;
#pragma unroll
    for (int g = 0; g < 4; ++g) {
      *(float4*)(cvb + 8 * g) = float4{acc0[4 * g], acc0[4 * g + 1], acc0[4 * g + 2], acc0[4 * g + 3]};
      *(float4*)(cvb + 32 + 8 * g) = float4{acc1[4 * g], acc1[4 * g + 1], acc1[4 * g + 2], acc1[4 * g + 3]};
    } }
  __syncthreads();
  { const float skip = p.in[I_hy_skip][l * 512 + c];
    unsigned short* xy = (unsigned short*)p.XYT() + (size_t)c * NB * N;
#pragma unroll 4
    for (int i = tid * 8; i < 2 * N; i += 4096) {
      const int b = i / N, t = i - b * N;
      float x0[8]; unpack8(*(const uint4*)(xy + i), x0);
      float zf[8]; unpack8(*(const uint4*)(zp + b * ZLEN + PADB * 64 + t), zf);
      const float4 ca = *(const float4*)(cv + i), cb4 = *(const float4*)(cv + i + 4);
      float o[8];
      o[0] = x0[0] * (ca.x * fn + skip * zf[0]); o[1] = x0[1] * (ca.y * fn + skip * zf[1]); o[2] = x0[2] * (ca.z * fn + skip * zf[2]); o[3] = x0[3] * (ca.w * fn + skip * zf[3]);
      o[4] = x0[4] * (cb4.x * fn + skip * zf[4]); o[5] = x0[5] * (cb4.y * fn + skip * zf[5]); o[6] = x0[6] * (cb4.z * fn + skip * zf[6]); o[7] = x0[7] * (cb4.w * fn + skip * zf[7]);
      store8bf(p.YT() + (size_t)c * NB * N + i, o);
    } }
}
DEV void xyt_to_y(const Params& p, int tid, char* lds) {
  unsigned short* tl = (unsigned short*)lds;
  for (int tile = blockIdx.x; tile < (NLAT / 64) * 8; tile += gridDim.x) {
    const int rt = tile >> 3, c0 = (tile & 7) * 64;
    const int bq = (rt * 64) / N, tq = (rt * 64) % N;
    __syncthreads();
    { const int cc = tid >> 3, tg = (tid & 7) * 8;
      const uint4 v = *(const uint4*)((const unsigned short*)p.YT() + ((size_t)(c0 + cc) * NB + bq) * N + tq + tg);
      const unsigned short* e = (const unsigned short*)&v;
#pragma unroll
      for (int j = 0; j < 8; ++j) tl[(tg + j) * 72 + cc] = e[j]; }
    __syncthreads();
    { const int tr = tid >> 3, cg8 = (tid & 7) * 8;
      *(uint4*)((unsigned short*)p.Y() + (size_t)(rt * 64 + tr) * 2048 + 1024 + c0 + cg8) = *(const uint4*)(tl + tr * 72 + cg8); }
  }
}
#endif
}

#ifndef CPU_SIM
DEV void ph_hyena_fft(const Params& p, const Ctx& cx, int l) {
  const int nb = gridDim.x;
  for (int i = blockIdx.x; i < 512; i += nb) {
    const int xcd = i & 7, idx = i >> 3;
    const int c = xcd * 64 + idx;
    tz::channel(p, l, c, cx.tid, cx.ldsg);
  }
}
#endif


#ifndef CPU_SIM
DEV void ph_hyena_ctx(const Params& p, const Ctx& cx, int l) {
  constexpr int LP = 33;
  float* Zs = (float*)cx.ldsg; float* Ff = Zs + LC * LP; float* Fb = Ff + LC * LP;
  const int tid = cx.tid, c = tid & 31, t0 = tid >> 5;
  const float* cw = p.in[I_hy_conv_w] + l * 3 * 1536; const float* cbv = p.in[I_hy_conv_b] + l * 1536;
  constexpr int TP = 8, TLEN = LC / TP;
  for (int task = blockIdx.x; task < NB * 16 * TP; task += gridDim.x) {
    const int tp = task % TP, cgp = (task / TP) & 15, b = task / (TP * 16), c0 = cgp * 32;
    const int rbase = NLAT + b * LC;
    __syncthreads();
    for (int idx = tid; idx < LC * 32; idx += 512) {
      { const int t = idx >> 5, cc = idx & 31; Zs[t * LP + cc] = b2f(p.Z()[(size_t)(rbase + t) * 512 + c0 + cc]); }
      { const int cc = idx / LC, t = idx % LC;
        Ff[t * LP + cc] = p.F()[(size_t)(c0 + cc) * (N + LC) + N + t]; Fb[t * LP + cc] = p.F()[(size_t)(512 + c0 + cc) * (N + LC) + N + t]; }
    }
    __syncthreads();
    float ss = 0.f;
    for (int t = 0; t < LC; ++t) { const float a = Ff[t * LP + c], bb = Fb[t * LP + c]; ss += a * a + bb * bb; }
    const float fn = 1.0f / sqrtf(ss + EPS);
    const int cg_ = c0 + c;
    const float w0 = cw[cg_], w1 = cw[1536 + cg_], w2 = cw[2 * 1536 + cg_], cb0 = cbv[cg_], skip = p.in[I_hy_skip][l * 512 + cg_];
    for (int t = tp * TLEN + t0; t < (tp + 1) * TLEN; t += 16) {
      float acc = 0.f;
      for (int s_ = 0; s_ <= t; ++s_) acc += Ff[(t - s_) * LP + c] * Zs[s_ * LP + c];
      for (int s_ = t + 1; s_ < LC; ++s_) acc += Fb[(s_ - t) * LP + c] * Zs[s_ * LP + c];
      const size_t r = (size_t)(rbase + t);
      float x0 = cb0 + w1 * b2f(p.P()[r * PC + C_HU + cg_]);
      if (t > 0) x0 += w0 * b2f(p.P()[(r - 1) * PC + C_HU + cg_]);
      if (t < LC - 1) x0 += w2 * b2f(p.P()[(r + 1) * PC + C_HU + cg_]);
      p.Y()[r * 2048 + 1024 + cg_] = f2b(x0 * (acc * fn + skip * Zs[t * LP + c]));
    }
  }
}
#endif

constexpr int NOSH = 30;

#ifndef CPU_SIM
#define SIDE_PREP(NB0, PARTS) do { if (l == 0 && (int)blockIdx.x >= (NB0)) { PrepCtx pc; pc.tid = cx.tid; pc.tl = (float*)cx.ldsg; pc.rank = (int)blockIdx.x - (NB0); pc.nranks = (int)gridDim.x - (NB0); \
    ph_prep(p, 1, pc, gtid - (NB0) * 512, gsz - (NB0) * 512, (PARTS)); } } while (0)
#else
#define SIDE_PREP(NB0, PARTS)
#endif
DEV void run_phase(const Params& p, int ph, const Ctx& cx) {
  const i64 gtid = cx.gtid, gsz = cx.gsz;
  if (ph == 0) { ph_init(p, gtid, gsz); return; }
  if (ph == NPHASES - 1) { ph_final(p, gtid, gsz); return; }
  const int l = (ph - 1) / PH_PER_LAYER, s = (ph - 1) % PH_PER_LAYER;
  const int last = (l == 1);
  const int nr = last ? NLAT : TT;
#ifdef ONLY
  if (s != ONLY) return;
#endif
  switch (s) {
    case 0: {
      PrepCtx pc;
#ifndef CPU_SIM
      pc.tid = cx.tid; pc.tl = (float*)cx.ldsg; pc.rank = (int)blockIdx.x; pc.nranks = (int)gridDim.x;
      if (l == 0) ph_prep(p, l, pc, gtid, gsz, 15); else ph_prep(p, l, pc, gtid, gsz, 8);
#else
      pc.gtid = gtid; pc.gsz = gsz;
      ph_prep(p, l, pc, gtid, gsz, 15);
#endif
      ph_norm(p, l, 0, TT, gtid, gsz);
    } break;
    case 1: { GemmDesc g{p.h(), p.W_in(), D, D, D, TT, 3840, NOSH, 0}; EpiInproj e{p}; run_gemm(cx, g, e); } break;
#ifndef CPU_SIM
    case 2: ph_B0(p, l, gtid, gsz, cx.ldsg, cx.tid); break;
#else
    case 2: ph_B0(p, l, gtid, gsz); break;
#endif
    case 3: {
      { const int n_uq = (nr / 256) * 3, n_ukv = (TT / 256) * 4, n_lru = (TT / 256) * 8;
        { GemmDesc g{p.P() + C_CQ, p.W_uq(), PC, 256, 256, nr, 768, NOSH, 0}; EpiUq e{p}; run_gemm(cx, g, e); }
        { GemmDesc g{p.P() + C_CKV, p.W_ukv(), PC, 256, 256, TT, 1024, NOSH, 0}; g.unit_off = n_uq; EpiUkv e{p}; run_gemm(cx, g, e); }
        { GemmDesc g{p.XC(), p.W_lru(), 512, 256, 256, TT, 2048, 2, 256}; g.unit_off = n_uq + n_ukv; EpiLru e{p, l, p.in[I_lru_b_r], p.in[I_lru_b_i]}; run_gemm(cx, g, e); }
#ifndef CPU_SIM
        { GemmDesc g{p.W3T(), p.hdn2b() + (size_t)l * (N + LC) * 256, 256, 256, 256, 1024, N + LC, NOSH, 0}; g.unit_off = n_uq + n_ukv + n_lru; EpiFilt e{p}; run_gemm(cx, g, e); }
#endif
      }
#ifdef CPU_SIM
      ph_fnorm(p, gtid, gsz);
#endif
    } break;
    case 4:
      ph_lru1(p, gtid, gsz);
#ifndef CPU_SIM
#if PROBE_K >= 0
#define SUBSTAMP(k) do { cg::this_grid().sync(); if (l == 0) { const unsigned long long t_ = wall_clock64(); if (blockIdx.x == 0 && cx.tid == 0) ((unsigned long long*)(p.ws + WL.ts))[40 + (k)] = t_; } } while (0)
#else
#define SUBSTAMP(k)
#endif
      if (REPEAT_S == 40) ph_lru1(p, gtid, gsz);
      SUBSTAMP(0);
      ph_hyena_fft(p, cx, l);
      if (REPEAT_S == 41) ph_hyena_fft(p, cx, l);
      SUBSTAMP(1);
      ph_gqa(p, cx, l, last);
      if (REPEAT_S == 42) ph_gqa(p, cx, l, last);
      SUBSTAMP(2);
      ph_mla(p, cx, last);
      if (REPEAT_S == 43) ph_mla(p, cx, last);
      SUBSTAMP(3);
      if (!last) ph_hyena_ctx(p, cx, l);
      if (REPEAT_S == 44 && !last) ph_hyena_ctx(p, cx, l);
#else
      ph_C(p, l, last, gtid, gsz);
#endif
      break;
#ifndef CPU_SIM
    case 5: ph_lru3(p, last, gtid, gsz, (float*)cx.ldsg, cx.tid); __syncthreads(); tz::xyt_to_y(p, cx.tid, cx.ldsg); break;
#else
    case 5: ph_lru3(p, last, gtid, gsz, nullptr, 0); break;
#endif
    case 6: { GemmDesc g{p.h(), p.W_g(), D, D, D, nr, 4096, NOSH, 0}; EpiGateAll e{p}; run_gemm(cx, g, e); } break;
    case 7: { GemmDesc g{p.Y(), p.W_br(), 2048, 512, 512, nr, 1024, NOSH, 0, 4, 512, 1024 * 512}; EpiBranchSub e{p}; run_gemm(cx, g, e); }
      SIDE_PREP(8, 1);
      break;
    case 8: { GemmDesc g{p.M(), p.W_out(), D, D, D, nr, 1024, NOSH, 0}; EpiOut e{p, l, 1.0f, l == 0 ? p.in[I_x] : (const float*)p.xcur(), l == 0 ? p.in[I_ctx] : (const float*)p.xcur() + (size_t)NLAT * D}; run_gemm(cx, g, e); }
#ifndef CPU_SIM
      if (l == 0 && blockIdx.x >= 8) ph_cvt_tables(p, l, gtid - 8 * 512, gsz - 8 * 512);
#endif
      break;
    case 9:
#ifndef CPU_SIM
      if (l != 0) ph_cvt_tables(p, l, gtid, gsz);
#endif
      ph_norm(p, l, 1, nr, gtid, gsz); break;
    case 10: { GemmDesc g{p.h(), p.W_q(), D, D, D, nr, 1024, NOSH, 0}; EpiPQ e{p}; run_gemm(cx, g, e); }
      SIDE_PREP(8, 2);
      break;
    case 11: { GemmDesc g{p.PQ(), p.W_key(), 1024, 256, 256, nr, 2048, 1, 256}; EpiSC e{p}; run_gemm(cx, g, e); }
      SIDE_PREP(16, 4);
      break;
#ifndef CPU_SIM
    case 12: ph_peer(p, l, nr, cx.tid, cx.ldsg); if (REPEAT_S == 52) { __syncthreads(); ph_peer(p, l, nr, cx.tid, cx.ldsg, 0.0f); } break;
#else
    case 12: ph_E2a(p, nr, gtid, gsz); break;
    case 13: ph_E2b(p, nr, gtid, gsz); break;
    case 14: ph_E3(p, l, nr, gtid, gsz); break;
    case 15: ph_E4(p, l, nr, gtid, gsz); break;
#endif
  }
}

#ifdef CPU_SIM
static void fill_params(Params& p, void* const* d_in, void* d_out, void* d_ws) {
  p.in.t = (const float* const*)d_in;
  p.out = (float*)d_out;
  p.ws = (char*)d_ws;
}
#endif


#ifndef CPU_SIM
#define XB_TMO      128
#define XB_XCNT(j)  (256  + 64 * (j))
#define XB_XSUB(j)  (1280 + 64 * (j))
#define XB_XGEN(j)  (2304 + 64 * (j))
#define XB_TOP      3328
#define XB_TOPGEN   3392
#define XCD_BAR_WORDS 3456
#define XB_SPIN_CAP (1u << 18)
#define XB_LAS __attribute__((address_space(3)))
__device__ __forceinline__ unsigned xb_ld(unsigned* p)              { return __hip_atomic_load(p, __ATOMIC_RELAXED, __HIP_MEMORY_SCOPE_AGENT); }
__device__ __forceinline__ unsigned xb_add(unsigned* p, unsigned v) { return __hip_atomic_fetch_add(p, v, __ATOMIC_RELAXED, __HIP_MEMORY_SCOPE_AGENT); }
__device__ __forceinline__ unsigned xb_xcc_id() { return (unsigned)__builtin_amdgcn_s_getreg((3 << 11) | 20) & 0xFu; }
#define XB_SPIN(cond, bar) do { unsigned _sp = 0; while (cond) { __builtin_amdgcn_s_sleep(1); \
    if ((++_sp & 255u) == 0u) { if (xb_ld(&(bar)[XB_TMO])) break; if (_sp > XB_SPIN_CAP) { atomicAdd(&(bar)[XB_TMO], 1u); break; } } } } while (0)
struct XcdBarrier { unsigned* bar; unsigned x; volatile XB_LAS unsigned* st; };
__device__ __forceinline__ XcdBarrier xcd_barrier_post(unsigned* bar, volatile XB_LAS unsigned* st) {
  XcdBarrier b; b.bar = bar; b.x = xb_xcc_id(); b.st = st;
  if (threadIdx.x == 0) (void)xb_add(&bar[XB_XCNT(b.x)], 1u);
  return b;
}
__device__ __forceinline__ void xcd_barrier_complete(unsigned* bar, unsigned x, unsigned& nloc, unsigned& nx) {
  const unsigned G = gridDim.x * gridDim.y * gridDim.z;
  unsigned sum, cnt, mine, sp = 0u;
  for (;;) {
    sum = 0u; cnt = 0u; mine = 0u;
#pragma unroll
    for (unsigned j = 0; j < 16; ++j) { const unsigned c = xb_ld(&bar[XB_XCNT(j)]); sum += c; cnt += (c > 0u) ? 1u : 0u; mine = (j == x) ? c : mine; }
    if (sum == G) break;
    __builtin_amdgcn_s_sleep(1);
    if ((++sp & 255u) == 0u) { if (xb_ld(&bar[XB_TMO])) break; if (sp > XB_SPIN_CAP) { atomicAdd(&bar[XB_TMO], 1u); break; } }
  }
  nloc = mine > 0u ? mine : 1u; nx = cnt > 0u ? cnt : 1u;
}
__device__ __forceinline__ void xcd_barrier(const XcdBarrier& b) {
  asm volatile("s_waitcnt vmcnt(0)" ::: "memory");
  __syncthreads();
  if (threadIdx.x == 0) {
    unsigned* bar = b.bar;
    __builtin_amdgcn_s_waitcnt(0);
    unsigned nloc = b.st[0], nx = b.st[1];
    if (nloc == 0u) { xcd_barrier_complete(bar, b.x, nloc, nx); b.st[0] = nloc; b.st[1] = nx; }
    const unsigned old = xb_add(&bar[XB_XSUB(b.x)], 1u);
    const unsigned gen = old / nloc;
    if (old + 1u == (gen + 1u) * nloc) {
      __builtin_amdgcn_fence(__ATOMIC_RELEASE, "agent");
      asm volatile("s_waitcnt vmcnt(0)" ::: "memory");
      const unsigned og = xb_add(&bar[XB_TOP], 1u);
      const unsigned tg = og / nx;
      if (og + 1u == (tg + 1u) * nx) xb_add(&bar[XB_TOPGEN], 1u);
      else XB_SPIN(xb_ld(&bar[XB_TOPGEN]) == tg, bar);
      __builtin_amdgcn_fence(__ATOMIC_ACQUIRE, "agent");
      xb_add(&bar[XB_XGEN(b.x)], 1u);
      asm volatile("s_waitcnt vmcnt(0)" ::: "memory");
    } else {
      XB_SPIN(xb_ld(&bar[XB_XGEN(b.x)]) == gen, bar);
      __builtin_amdgcn_fence(__ATOMIC_ACQUIRE, "agent");
      asm volatile("s_waitcnt vmcnt(0)" ::: "memory");
    }
  }
  __syncthreads();
}
#endif

#ifndef CPU_SIM
static_assert(TT % 256 == 0 && NLAT % 256 == 0 && (N + LC) % 256 == 0, "row / column tiles");
static_assert(N / 256 == 32 && NB * 8 * (N / 256) == 512, "attention unit mapping assumes 32 q-blocks per (batch, head) and a 256-block grid");
constexpr int LDS_PHASE_BYTES = 131072 + 4096;
constexpr int LDS_BYTES = LDS_PHASE_BYTES + 16;
__global__ void __launch_bounds__(512, 2) mega_kernel(KArgs ka) {
  extern __shared__ __attribute__((aligned(16))) unsigned char shm[];
  cg::grid_group grid = cg::this_grid();
#if PROBE_K >= 0
  unsigned long long* const tsp = (unsigned long long*)(ka.ws + WL.ts);
#endif
  {
    int tid = threadIdx.x;
    asm volatile("" : "+v"(tid));
    const i64 gtid = (i64)blockIdx.x * 512 + tid, gsz = (i64)gridDim.x * 512;
    ph_init(ka, gtid, gsz, (char*)shm, tid);
    if (gtid < N_IN) ((const float**)(ka.ws + WL.tbl))[gtid] = ka.in[gtid];
#if PROBE_K >= 0
    { const unsigned long long t_ = wall_clock64(); if (gtid == 0) tsp[0] = t_; }
#endif
  }
  volatile XB_LAS unsigned* xst = (volatile XB_LAS unsigned*)(shm + LDS_PHASE_BYTES);
  if (threadIdx.x == 0) { xst[0] = 0u; xst[1] = 0u; }
  __syncthreads();
  const XcdBarrier xb = xcd_barrier_post((unsigned*)(ka.ws + WL.bar), xst);
  grid.sync();
#if PROBE_K >= 0
  { const unsigned long long t_ = wall_clock64(); if (blockIdx.x == 0 && threadIdx.x == 0) tsp[1] = t_; }
#endif
  Params p; p.out = ka.out; p.ws = ka.ws; p.in.t = (const float* const*)(ka.ws + WL.tbl);
  for (int ph = 1; ph < NPHASES - 1; ++ph) {
    int tid = threadIdx.x;
    asm volatile("" : "+v"(tid));
    Ctx cx;
    cx.tid = tid;
    cx.gtid = (i64)blockIdx.x * 512 + tid; cx.gsz = (i64)gridDim.x * 512;
    cx.lds = (PG8_LAS unsigned char*)shm; cx.ldsg = (char*)shm;
    run_phase(p, ph, cx);
    if (REPEAT_S >= 0 && REPEAT_S < 40 && (ph - 1) % PH_PER_LAYER == REPEAT_S) { __syncthreads(); run_phase(p, ph, cx); }
    xcd_barrier(xb);
#if PROBE_K >= 0
    { const unsigned long long t_ = wall_clock64(); if (blockIdx.x == 0 && threadIdx.x == 0) tsp[ph + 1] = t_; }
    if (ph == NPHASES - 2) grid.sync();
#endif
  }
  {
    int tid = threadIdx.x;
    asm volatile("" : "+v"(tid));
    ph_final(p, (i64)blockIdx.x * 512 + tid, (i64)gridDim.x * 512);
  }
}

extern "C" void kernel_launch(void* const* d_in, const int* in_sizes, int n_in, void* d_out, int out_size,
                              void* d_ws, size_t ws_size, hipStream_t stream) {
  static int grid_blocks = 0;
  if (!grid_blocks) {
    int dev = 0, cus = 0, per_cu = 0;
    (void)hipGetDevice(&dev);
    (void)hipDeviceGetAttribute(&cus, hipDeviceAttributeMultiprocessorCount, dev);
    if (hipFuncSetAttribute((const void*)mega_kernel, hipFuncAttributeMaxDynamicSharedMemorySize, LDS_BYTES) != hipSuccess)
      fprintf(stderr, "hipFuncSetAttribute failed\n");
    (void)hipOccupancyMaxActiveBlocksPerMultiprocessor(&per_cu, mega_kernel, 512, LDS_BYTES);
    if (per_cu > 1) per_cu = 1;
    if (per_cu < 1) per_cu = 1;
    grid_blocks = cus * per_cu;
  }
  (void)hipMemsetAsync((char*)d_ws + WL.bar, 0, (size_t)3456 * 4, stream);
  KArgs ka;
  std::memset((void*)&ka, 0, sizeof(ka));
  for (int i = 0; i < N_IN; ++i) ka.in[i] = (const float*)d_in[i];
  ka.out = (float*)d_out; ka.ws = (char*)d_ws;
  void* args[] = {&ka};
  hipError_t e = hipLaunchCooperativeKernel((void*)mega_kernel, dim3(grid_blocks), dim3(512), args, LDS_BYTES, stream);
  if (e != hipSuccess) fprintf(stderr, "cooperative launch failed: %s (grid %d)\n", hipGetErrorString(e), grid_blocks);
}
#endif
```

```cpp
#ifndef CPU_SIM
#include <hip/hip_runtime.h>
#include <hip/hip_cooperative_groups.h>
#include <cstdio>
#include <cstring>
namespace cg = cooperative_groups;
#define DEV __device__ __forceinline__
#define DEVN __device__ __forceinline__
#define MDEV __device__ __forceinline__
typedef _Float16 sc_t;
#else
#include <cmath>
#include <cstdio>
#include <cstdint>
#include <cstring>
#define DEV static inline
#define DEVN static
#define MDEV inline
typedef float sc_t;
#endif

#ifndef REPEAT_S
#define REPEAT_S -1
#endif
#ifndef PROBE_K
#define PROBE_K -1
#endif
#ifndef SEQ_N
#define SEQ_N 8192
#endif
#ifndef CTX_L
#define CTX_L 256
#endif

typedef long long i64;

constexpr int D = 1024, NB = 2, N = SEQ_N, LC = CTX_L;
constexpr int NLAT = NB * N, NCTX = NB * LC, TT = NLAT + NCTX;
constexpr int GRIDW = 64;
constexpr int INC = 7840, PC = 3840;
constexpr int C_CQ = 0, C_CKV = 256, C_KR = 384, C_LX = 416, C_LG = 928, C_HU = 1440, C_GQ = 2976, C_GKV = 3488, C_GT = 3744;
constexpr int NEXP = 16384;
constexpr float EPS = 1e-6f;
#ifndef CPU_SIM
constexpr int PH_PER_LAYER = 13;
#else
constexpr int PH_PER_LAYER = 16;
#endif
constexpr int NPHASES = 2 + 2 * PH_PER_LAYER;
constexpr int LCH = 64, NCC = LC / LCH, NCL = N / LCH, NCHK = NCC + NCL;

enum { I_x, I_c, I_ctx, I_c_ctx, I_g_mix, I_g_ffn, I_w_mod, I_b_mod, I_w_in, I_mla_g_cq, I_mla_g_ckv, I_mla_w_uq,
       I_mla_w_ukv, I_lru_conv_w, I_lru_conv_b, I_lru_w_r, I_lru_b_r, I_lru_w_i, I_lru_b_i, I_lru_lam,
       I_hy_conv_w, I_hy_conv_b, I_hy_w1, I_hy_b1, I_hy_f1, I_hy_w2, I_hy_b2, I_hy_f2, I_hy_w3, I_hy_skip,
       I_gqa_sink, I_w_branch, I_w_out, I_peer_w_q, I_peer_keys, I_peer_u, I_peer_v, I_g_final, N_IN };

struct bf { unsigned short v; };
DEV float b2f(bf x) { union { unsigned u; float f; } c; c.u = ((unsigned)x.v) << 16; return c.f; }
DEV bf f2b(float f) { union { unsigned u; float f; } c; c.f = f; unsigned r = c.u + 0x7FFFu + ((c.u >> 16) & 1u); bf o; o.v = (unsigned short)(r >> 16); return o; }


constexpr size_t al256(size_t x) { return (x + 255) & ~(size_t)255; }
struct WsLayout {
  size_t xcur, mods, hdn2, ssq, tabA, tabD, fnorm, SA, SB, tw, tbl, ts, spl, bar, hdn2b, W3T, h, Y, Z, XC, LA, LB, P, QA, KVA;
  size_t W_in, W_g, W_uq, W_ukv, W_lru, W_br, W_out, W_q, W_key;
  size_t M, Gs, G, SC, TKs, TKi, SELi, SELg, W, Ub, Vb, YT, total;
};
constexpr WsLayout make_layout() {
  WsLayout w{};
  size_t o = 0;
  w.xcur = o; o = al256(o + (size_t)TT * D * 4);
  w.mods = o; o = al256(o + (size_t)2 * 3 * 6 * D * 4);
  w.hdn2 = o; o = al256(o + (size_t)2 * (N + LC) * 64 * 4);
  w.ssq = o; o = al256(o + (size_t)2 * TT * 4);
  w.tabA = o; o = al256(o + (size_t)128 * 8 * 2 * 4);
  w.tabD = o; o = al256(o + (size_t)128 * 16 * 2 * 4);
  w.fnorm = o; o = al256(o + (size_t)2 * 512 * 4);
  w.tw = o; o = al256(o + (size_t)2 * N * 8);
  w.tbl = o; o = al256(o + (size_t)N_IN * 8);
  w.ts = o; o = al256(o + (size_t)64 * 8);
  w.spl = o; o = al256(o + (size_t)2 * 2 * 512 * 4);
  w.bar = o; o = al256(o + (size_t)3456 * 4);
  w.hdn2b = o; o = al256(o + (size_t)2 * (N + LC) * 256 * 2);
  w.W3T = o; o = al256(o + (size_t)1024 * 256 * 2);
  w.SA = o; o = al256(o + (size_t)2 * NB * NCHK * 512 * 4);
  w.SB = o; o = al256(o + (size_t)2 * NB * NCHK * 512 * 4);
  w.h = o; o = al256(o + (size_t)TT * D * 2);
  w.Y = o; w.Ub = o; w.Vb = o + (size_t)NEXP * D; o = al256(o + (size_t)TT * 2048 * 2);
  w.Z = o; o = al256(o + (size_t)TT * 512 * 2);
  w.W_in = o; o = al256(o + (size_t)3840 * 1024 * 2);
  w.W_g = o; o = al256(o + (size_t)4096 * 1024 * 2);
  w.W_uq = o; o = al256(o + (size_t)768 * 256 * 2);
  w.W_ukv = o; o = al256(o + (size_t)1024 * 256 * 2);
  w.W_lru = o; o = al256(o + (size_t)2048 * 256 * 2);
  w.W_br = o; o = al256(o + (size_t)4 * 1024 * 512 * 2);
  w.W_out = o; o = al256(o + (size_t)1024 * 1024 * 2);
  w.W_q = o; o = al256(o + (size_t)1024 * 1024 * 2);
  w.W_key = o; o = al256(o + (size_t)2048 * 256 * 2);
  size_t rl = o;
  w.XC = o; o = al256(o + (size_t)TT * 512 * 2);
  w.LA = o; o = al256(o + (size_t)2 * TT * 512 * 2);
  w.LB = o; o = al256(o + (size_t)2 * TT * 512 * 2);
  size_t rl_end = o;
  o = rl;
  w.TKs = o; o = al256(o + (size_t)TT * 256 * 4);
  w.TKi = o; o = al256(o + (size_t)TT * 256 * 4);
  w.SELi = o; o = al256(o + (size_t)TT * 128 * 4);
  w.SELg = o; o = al256(o + (size_t)TT * 128 * 4);
  w.W = o; o = al256(o + (size_t)TT * 128 * 4);
  if (o > rl_end) rl_end = o;
  o = rl_end;
  size_t rp = o;
  w.P = o; o = al256(o + (size_t)TT * PC * 2);
  w.QA = o; o = al256(o + (size_t)TT * 768 * 2);
  w.KVA = o; o = al256(o + (size_t)TT * 1024 * 2);
  size_t rp_end = o;
  o = rp;
  w.M = o; o = al256(o + (size_t)TT * D * 2);
  w.G = o; if (o + (size_t)TT * 3072 * 2 > rp_end) rp_end = o + (size_t)TT * 3072 * 2;
  w.Gs = o; o = al256(o + (size_t)TT * D * 2);
  w.SC = o; o = al256(o + (size_t)TT * 2048 * sizeof(sc_t));
  if (o > rp_end) rp_end = o;
  w.YT = rp_end; rp_end = al256(rp_end + (size_t)512 * NB * N * 2);
  w.total = rp_end;
  return w;
}
constexpr WsLayout WL = make_layout();
static_assert((size_t)TT * 4096 <= (size_t)TT * 512 * 2 + (size_t)4 * TT * 512 * 2, "uint8 gates must fit in the XC/LA/LB region");
static_assert(WL.LB == WL.LA + (size_t)2 * TT * 512 * 2, "LA and LB must be contiguous (packed GPU layout)");
static_assert(WL.total <= (size_t)512 * 1024 * 1024, "workspace too large");
#ifndef CPU_SIM
static_assert((size_t)2 * NEXP * D * 2 <= (size_t)TT * 2048 * 2, "bf16 expert tables must fit in Y");
#endif
struct WsAcc {
  float* out;
  char* ws;
  MDEV float* xcur() const { return (float*)(ws + WL.xcur); }
  MDEV float* mods() const { return (float*)(ws + WL.mods); }
  MDEV float* hdn2() const { return (float*)(ws + WL.hdn2); }
  MDEV float* ssq() const { return (float*)(ws + WL.ssq); }
  MDEV float* tabA() const { return (float*)(ws + WL.tabA); }
  MDEV float* tabD() const { return (float*)(ws + WL.tabD); }
  MDEV float* fnorm() const { return (float*)(ws + WL.fnorm); }
  MDEV float* tw() const { return (float*)(ws + WL.tw); }
  MDEV unsigned* Hs() const { return (unsigned*)((char*)out + (((size_t)(N + LC) * 1024 * 4 + 255) & ~(size_t)255)); }
  MDEV float* spl() const { return (float*)(ws + WL.spl); }
  MDEV bf* XYT() const { return (bf*)((char*)out + (((size_t)(N + LC) * 1024 * 4 + 255) & ~(size_t)255)); }
  MDEV bf* hdn2b() const { return (bf*)(ws + WL.hdn2b); }
  MDEV bf* W3T() const { return (bf*)(ws + WL.W3T); }
  MDEV float* SA() const { return (float*)(ws + WL.SA); }
  MDEV float* SB() const { return (float*)(ws + WL.SB); }
  MDEV bf* h() const { return (bf*)(ws + WL.h); }
  MDEV bf* Y() const { return (bf*)(ws + WL.Y); }
  MDEV bf* Z() const { return (bf*)(ws + WL.Z); }
  MDEV bf* XC() const { return (bf*)(ws + WL.XC); }
  MDEV bf* LA() const { return (bf*)(ws + WL.LA); }
  MDEV bf* LB() const { return (bf*)(ws + WL.LB); }
  MDEV bf* P() const { return (bf*)(ws + WL.P); }
  MDEV bf* QA() const { return (bf*)(ws + WL.QA); }
  MDEV bf* KVA() const { return (bf*)(ws + WL.KVA); }
  MDEV float* F() const { return out; }
  MDEV bf* W_in() const { return (bf*)(ws + WL.W_in); }
  MDEV bf* W_g() const { return (bf*)(ws + WL.W_g); }
  MDEV bf* W_uq() const { return (bf*)(ws + WL.W_uq); }
  MDEV bf* W_ukv() const { return (bf*)(ws + WL.W_ukv); }
  MDEV bf* W_lru() const { return (bf*)(ws + WL.W_lru); }
  MDEV bf* W_br() const { return (bf*)(ws + WL.W_br); }
  MDEV bf* W_out() const { return (bf*)(ws + WL.W_out); }
  MDEV bf* W_q() const { return (bf*)(ws + WL.W_q); }
  MDEV bf* W_key() const { return (bf*)(ws + WL.W_key); }
  MDEV bf* M() const { return (bf*)(ws + WL.M); }
  MDEV bf* Gs() const { return (bf*)(ws + WL.Gs); }
  MDEV bf* PQ() const { return (bf*)(ws + WL.Gs); }
  MDEV bf* BR() const { return (bf*)(ws + WL.G); }
  MDEV unsigned char* G8() const { return (unsigned char*)(ws + WL.XC); }
  MDEV unsigned* LAB() const { return (unsigned*)(ws + WL.LA); }
  MDEV bf* YT() const { return (bf*)(ws + WL.YT); }
  MDEV sc_t* SC() const { return (sc_t*)(ws + WL.SC); }
  MDEV float* TKs() const { return (float*)(ws + WL.TKs); }
  MDEV int* TKi() const { return (int*)(ws + WL.TKi); }
  MDEV int* SELi() const { return (int*)(ws + WL.SELi); }
  MDEV float* SELg() const { return (float*)(ws + WL.SELg); }
  MDEV float* W() const { return (float*)(ws + WL.W); }
  MDEV bf* Ub() const { return (bf*)(ws + WL.Ub); }
  MDEV bf* Vb() const { return (bf*)(ws + WL.Vb); }
  MDEV unsigned char* UbL(int l) const { return l == 0 ? (unsigned char*)(ws + WL.Ub) : (unsigned char*)out; }
  MDEV unsigned char* VbL(int l) const { return l == 0 ? (unsigned char*)(ws + WL.Vb) : (unsigned char*)out + (size_t)NEXP * D; }
};
struct KArgs : WsAcc { const float* in[N_IN]; };
#ifndef CPU_SIM
typedef float v4f_gl __attribute__((ext_vector_type(4)));
DEV float4 gld4(const void* q) { const v4f_gl r = *(const __attribute__((address_space(1))) v4f_gl*)q; return float4{r.x, r.y, r.z, r.w}; }
DEV float gld1(const float* q) { return *(const __attribute__((address_space(1))) float*)q; }
#else
DEV float gld1(const float* q) { return *q; }
#endif
#ifndef CPU_SIM
typedef const __attribute__((address_space(1))) float* GF;
#else
typedef const float* GF;
#endif
struct InTab {
  const float* const* t;
#ifndef CPU_SIM
  MDEV const float* operator[](int i) const { return t[i]; }
#else
  MDEV const float* operator[](int i) const { return t[i]; }
#endif
};
struct Params : WsAcc { InTab in; };
static_assert((size_t)(N + LC) * 1024 * 4 + 256 + (size_t)256 * 2 * N * 4 <= (size_t)NLAT * D * 4, "F + spectrum scratch must fit in d_out");

#ifndef CPU_SIM
DEV float fexpf_(float x) { return __builtin_amdgcn_exp2f(x * 1.4426950408889634f); }
DEV float sigmoidf_(float x) { return __builtin_amdgcn_rcpf(1.0f + __builtin_amdgcn_exp2f(-x * 1.4426950408889634f)); }
DEV float siluf_(float x) { return x * sigmoidf_(x); }
DEV float geluf_(float x) { return x * sigmoidf_(1.5957691216057308f * (x + 0.044715f * x * x * x)); }
#else
DEV float fexpf_(float x) { return expf(x); }
DEV float sigmoidf_(float x) { return 1.0f / (1.0f + expf(-x)); }
DEV float siluf_(float x) { return x * sigmoidf_(x); }
DEV float geluf_(float x) { return 0.5f * x * (1.0f + tanhf(0.7978845608028654f * (x + 0.044715f * x * x * x))); }
#endif
DEV float softplusf_(float x) { return x > 20.f ? x : log1pf(expf(x)); }

#ifndef CPU_SIM
DEV float lane_xor(float v, int lane, int o) { return __int_as_float(__builtin_amdgcn_ds_bpermute(((lane ^ o) & 63) << 2, __float_as_int(v))); }
#endif
#ifndef CPU_SIM
DEV void unpack8(const uint4 w, float* f) {
  union { unsigned u; float x; } c;
  c.u = w.x << 16; f[0] = c.x; c.u = w.x & 0xFFFF0000u; f[1] = c.x; c.u = w.y << 16; f[2] = c.x; c.u = w.y & 0xFFFF0000u; f[3] = c.x;
  c.u = w.z << 16; f[4] = c.x; c.u = w.z & 0xFFFF0000u; f[5] = c.x; c.u = w.w << 16; f[6] = c.x; c.u = w.w & 0xFFFF0000u; f[7] = c.x;
}
#endif
struct RowInfo { int b, t, L, base, lat; };
DEV RowInfo rowinfo(int r) {
  RowInfo ri;
  if (r < NLAT) { ri.b = r / N; ri.t = r - ri.b * N; ri.L = N; ri.base = ri.b * N; ri.lat = 1; }
  else { int rc = r - NLAT; ri.b = rc / LC; ri.t = rc - ri.b * LC; ri.L = LC; ri.base = NLAT + ri.b * LC; ri.lat = 0; }
  return ri;
}
DEV int modrow(int r) { return r < NLAT ? r / N : 2; }
template <class PT> DEV const float* xin_row(const PT& p, int r) { return r < NLAT ? p.in[I_x] + (size_t)r * D : p.in[I_ctx] + (size_t)(r - NLAT) * D; }

DEV void atomic_addf(float* p, float v) {
#ifndef CPU_SIM
  atomicAdd(p, v);
#else
#pragma omp atomic
  *p += v;
#endif
}
DEV void store8bf(bf* dst, const float* v) {
#ifndef CPU_SIM
  uint4 w;
  asm volatile("v_cvt_pk_bf16_f32 %0, %1, %2" : "=v"(w.x) : "v"(v[0]), "v"(v[1]));
  asm volatile("v_cvt_pk_bf16_f32 %0, %1, %2" : "=v"(w.y) : "v"(v[2]), "v"(v[3]));
  asm volatile("v_cvt_pk_bf16_f32 %0, %1, %2" : "=v"(w.z) : "v"(v[4]), "v"(v[5]));
  asm volatile("v_cvt_pk_bf16_f32 %0, %1, %2" : "=v"(w.w) : "v"(v[6]), "v"(v[7]));
  *(uint4*)dst = w;
#else
  for (int j = 0; j < 8; ++j) dst[j] = f2b(v[j]);
#endif
}
#ifndef CPU_SIM
DEV unsigned pk2bf(float lo, float hi) { unsigned r; asm volatile("v_cvt_pk_bf16_f32 %0, %1, %2" : "=v"(r) : "v"(lo), "v"(hi)); return r; }
#endif
DEV void load8bf(const bf* src, float* v) {
#ifndef CPU_SIM
  uint4 w = *(const uint4*)src;
  union { unsigned u; float f; } c;
  c.u = w.x << 16; v[0] = c.f; c.u = w.x & 0xFFFF0000u; v[1] = c.f;
  c.u = w.y << 16; v[2] = c.f; c.u = w.y & 0xFFFF0000u; v[3] = c.f;
  c.u = w.z << 16; v[4] = c.f; c.u = w.z & 0xFFFF0000u; v[5] = c.f;
  c.u = w.w << 16; v[6] = c.f; c.u = w.w & 0xFFFF0000u; v[7] = c.f;
#else
  for (int j = 0; j < 8; ++j) v[j] = b2f(src[j]);
#endif
}

DEV int win_src(int n) {
  if (n >= 3744) return -1;
  if (n >= C_KR && n < C_KR + 32) { int q = n - C_KR; int pi = q >> 1, wh = q & 1, half = pi >> 3, f = pi & 7; return C_KR + half * 16 + f + wh * 8; }
  if (n >= C_GQ && n < C_GKV + 128) { int q = n - C_GQ; int hh = q >> 6, d = q & 63; int pi = d >> 1, wh = d & 1, half = pi >> 4, f = pi & 15; return C_GQ + hh * 64 + half * 32 + f + wh * 16; }
  return n;
}
DEV int wuq_src(int n) {
  int hh = n / 96, d = n % 96;
  if (d < 64) return n;
  int q = d - 64; int pi = q >> 1, wh = q & 1, half = pi >> 3, f = pi & 7;
  return hh * 96 + 64 + half * 16 + f + wh * 8;
}

template <class PT> DEVN void ph_init(const PT& p, i64 gtid, i64 gsz, char* ilds = nullptr, int itid = 0) {
#ifndef CPU_SIM
  {
    float* sl = (float*)ilds;
    for (int q = itid; q < 3 * D; q += 512) { const int rr = q / D, k = q - rr * D; sl[q] = siluf_(rr < 2 ? p.in[I_c][rr * D + k] : p.in[I_c_ctx][k]); }
    __syncthreads();
    float* red3 = sl + 3 * D;
    const int wv_ = itid >> 6, ln_ = itid & 63;
    for (int task = blockIdx.x; task < 2 * 6 * D / 64; task += gridDim.x) {
      const int l = task / (6 * D / 64), j = (task % (6 * D / 64)) * 64 + ln_;
      const float* w = p.in[I_w_mod] + (size_t)l * D * 6 * D + j;
      float a0 = 0.f, a1 = 0.f, a2 = 0.f;
#pragma unroll 1
      for (int k0 = wv_ * 128; k0 < wv_ * 128 + 128; k0 += 16) {
        float wv[16];
#pragma unroll
        for (int q = 0; q < 16; ++q) wv[q] = w[(size_t)(k0 + q) * 6 * D];
#pragma unroll
        for (int q = 0; q < 16; ++q) { a0 += sl[k0 + q] * wv[q]; a1 += sl[D + k0 + q] * wv[q]; a2 += sl[2 * D + k0 + q] * wv[q]; }
      }
      __syncthreads();
      red3[(wv_ * 3 + 0) * 64 + ln_] = a0; red3[(wv_ * 3 + 1) * 64 + ln_] = a1; red3[(wv_ * 3 + 2) * 64 + ln_] = a2;
      __syncthreads();
      if (itid < 192) {
        const int v3 = itid >> 6, jj = itid & 63;
        float sum = p.in[I_b_mod][l * 6 * D + (task % (6 * D / 64)) * 64 + jj];
#pragma unroll
        for (int w8 = 0; w8 < 8; ++w8) sum += red3[(w8 * 3 + v3) * 64 + jj];
        p.mods()[((size_t)l * 3 + v3) * 6 * D + (task % (6 * D / 64)) * 64 + jj] = sum;
      }
    }
    __syncthreads();
  }
  {
    float* wl1 = (float*)ilds;
    float* wl2 = wl1 + 2 * 2240;
    float* h1 = wl2 + 2 * 4224;
    for (int q = itid; q < 2 * 2240; q += 512) { const int l = q / 2240, o = q - l * 2240;
      wl1[q] = o < 2112 ? p.in[I_hy_w1][l * 2112 + o] : (o < 2176 ? p.in[I_hy_b1][l * 64 + o - 2112] : p.in[I_hy_f1][l * 64 + o - 2176]); }
    for (int q = itid; q < 2 * 4224; q += 512) { const int l = q / 4224, o = q - l * 4224;
      wl2[q] = o < 4096 ? p.in[I_hy_w2][l * 4096 + o] : (o < 4160 ? p.in[I_hy_b2][l * 64 + o - 4096] : p.in[I_hy_f2][l * 64 + o - 4160]); }
    __syncthreads();
    const int per = (2 * (N + LC) + (int)gridDim.x - 1) / (int)gridDim.x;
    for (int base = 0; base < per; base += 128) {
      const int li = base + itid;
      const i64 i = (i64)blockIdx.x * per + li;
      if (itid < 128 && li < per && i < (i64)2 * (N + LC)) {
        const int l = (int)(i / (N + LC)), tt = (int)(i % (N + LC));
        int t, L; if (tt < N) { t = tt; L = N; } else { t = tt - N; L = LC; }
        const float tn = (float)t / (float)(L - 1);
        const float wt = 6.283185307179586f * (float)t / (float)L;
        const float* w1 = wl1 + l * 2240; const float* b1 = w1 + 2112; const float* f1 = w1 + 2176;
        const float* w2 = wl2 + l * 4224; const float* b2 = w2 + 4096; const float* f2 = w2 + 4160;
        { uint4* zp_ = (uint4*)(p.hdn2b() + ((size_t)l * (N + LC) + tt) * 256 + 64);
#pragma unroll
          for (int q = 0; q < 24; ++q) zp_[q] = uint4{0, 0, 0, 0}; }
        float zc[16], zs[16];
#pragma unroll
        for (int bd = 0; bd < 16; ++bd) { const float ang = (1e-4f + (float)bd * ((15.0f - 1e-4f) / 15.0f)) * wt; zc[bd] = cosf(ang); zs[bd] = sinf(ang); }
#pragma unroll 2
        for (int k1 = 0; k1 < 64; ++k1) {
          float a1 = b1[k1] + tn * w1[k1];
#pragma unroll
          for (int bd = 0; bd < 16; ++bd) a1 += zc[bd] * w1[(1 + bd) * 64 + k1] - zs[bd] * w1[(17 + bd) * 64 + k1];
          h1[k1 * 128 + itid] = sinf(f1[k1] * a1);
        }
#pragma unroll 1
        for (int j0 = 0; j0 < 64; j0 += 4) {
          float c0 = b2[j0], c1 = b2[j0 + 1], c2 = b2[j0 + 2], c3 = b2[j0 + 3];
#pragma unroll 8
          for (int k1 = 0; k1 < 64; ++k1) { const float hv = h1[k1 * 128 + itid]; const float4 wv = *(const float4*)(w2 + k1 * 64 + j0); c0 += hv * wv.x; c1 += hv * wv.y; c2 += hv * wv.z; c3 += hv * wv.w; }
          bf* ot = p.hdn2b() + ((size_t)l * (N + LC) + tt) * 256 + j0;
          ot[0] = f2b(sinf(f2[j0] * c0)); ot[1] = f2b(sinf(f2[j0 + 1] * c1)); ot[2] = f2b(sinf(f2[j0 + 2] * c2)); ot[3] = f2b(sinf(f2[j0 + 3] * c3));
        }
      }
    }
  }
#else
  for (i64 i = gtid; i < 2 * 3 * 6 * D; i += gsz) {
    int l = (int)(i / (3 * 6 * D)); int rr = (int)((i / (6 * D)) % 3); int j = (int)(i % (6 * D));
    const float* cv = rr < 2 ? p.in[I_c] + rr * D : p.in[I_c_ctx];
    const float* w = p.in[I_w_mod] + (size_t)l * D * 6 * D;
    float acc = p.in[I_b_mod][l * 6 * D + j];
    for (int k = 0; k < D; ++k) acc += siluf_(cv[k]) * w[(size_t)k * 6 * D + j];
    p.mods()[i] = acc;
  }
  for (i64 i = gtid; i < (i64)2 * (N + LC) * 64; i += gsz) {
    int l = (int)(i / ((i64)(N + LC) * 64)); int tt = (int)((i / 64) % (N + LC)); int j2 = (int)(i % 64);
    int t, L; if (tt < N) { t = tt; L = N; } else { t = tt - N; L = LC; }
    float tn = (float)t / (float)(L - 1);
    float wt = 6.283185307179586f * (float)t / (float)L;
    const float* w1 = p.in[I_hy_w1] + l * 33 * 64; const float* b1 = p.in[I_hy_b1] + l * 64; const float* f1 = p.in[I_hy_f1] + l * 64;
    const float* w2 = p.in[I_hy_w2] + l * 64 * 64; const float* b2 = p.in[I_hy_b2] + l * 64; const float* f2 = p.in[I_hy_f2] + l * 64;
    float acc2 = b2[j2];
    for (int k1 = 0; k1 < 64; ++k1) {
      float a1 = b1[k1] + tn * w1[k1];
      for (int bd = 0; bd < 16; ++bd) {
        float band = 1e-4f + (float)bd * ((15.0f - 1e-4f) / 15.0f);
        float ang = band * wt;
        a1 += cosf(ang) * w1[(1 + bd) * 64 + k1] - sinf(ang) * w1[(17 + bd) * 64 + k1];
      }
      acc2 += sinf(f1[k1] * a1) * w2[k1 * 64 + j2];
    }
    p.hdn2()[i] = sinf(f2[j2] * acc2);
  }
#endif
#ifdef CPU_SIM
  for (i64 i = gtid; i < 2 * N; i += gsz) {
    double a = 6.283185307179586476925 * (double)i / (double)(2 * N);
    p.tw()[i * 2] = (float)cos(a); p.tw()[i * 2 + 1] = (float)-sin(a);
  }
#endif
  for (i64 i = gtid; i < 2 * 2 * 512; i += gsz) p.spl()[i] = softplusf_(-p.in[I_lru_lam][i]);
  for (i64 i = gtid; i < 128 * 8; i += gsz) {
    int pos = (int)(i / 8), f = (int)(i % 8);
    float ang = (float)pos * powf(10000.0f, -(float)f / 8.0f);
    p.tabA()[i * 2] = cosf(ang); p.tabA()[i * 2 + 1] = sinf(ang);
  }
  for (i64 i = gtid; i < 128 * 16; i += gsz) {
    int pos = (int)(i / 16), f = (int)(i % 16);
    float ang = (float)pos * powf(10000.0f, -(float)f / 16.0f);
    p.tabD()[i * 2] = cosf(ang); p.tabD()[i * 2 + 1] = sinf(ang);
  }
}

#ifndef CPU_SIM
template <class F> DEV void xpose_tiles(bf* dst, int K, int NN, const F& val, int tid, float* tl, int& xoff, int rank, int nranks) {
  const int tk = K / 64, tn = NN / 64;
  const int t0 = (rank + nranks - xoff % nranks) % nranks;
  xoff += tk * tn;
  for (int t = t0; t < tk * tn; t += nranks) {
    const int k0 = (t / tn) * 64, n0 = (t % tn) * 64;
    __syncthreads();
    float tv_[8];
#pragma unroll
    for (int i = 0; i < 8; ++i) { const int kk = (tid >> 6) + 8 * i, nn = tid & 63; tv_[i] = val(k0 + kk, n0 + nn); }
#pragma unroll
    for (int i = 0; i < 8; ++i) { const int kk = (tid >> 6) + 8 * i, nn = tid & 63; tl[nn * 65 + kk] = tv_[i]; }
    __syncthreads();
#pragma unroll
    for (int i = 0; i < 8; ++i) { const int nn = (tid >> 6) + 8 * i, kk = tid & 63; dst[(size_t)(n0 + nn) * K + k0 + kk] = f2b(tl[nn * 65 + kk]); }
  }
}
#else
template <class F> static void xpose_tiles(bf* dst, int K, int NN, const F& val, i64 gtid, i64 gsz) {
  for (i64 i = gtid; i < (i64)K * NN; i += gsz) { int k = (int)(i / NN), n = (int)(i % NN); dst[(size_t)n * K + k] = f2b(val(k, n)); }
}
#endif
struct PrepCtx {
#ifndef CPU_SIM
  int tid; float* tl; int rank, nranks;
#else
  i64 gtid, gsz;
#endif
};
#ifndef CPU_SIM
#define XPOSE(dst, K, NN, val) xpose_tiles(dst, K, NN, val, pc.tid, pc.tl, xoff, pc.rank, pc.nranks)
#else
#define XPOSE(dst, K, NN, val) xpose_tiles(dst, K, NN, val, pc.gtid, pc.gsz)
#endif
DEVN void ph_prep(const Params& p, int l, const PrepCtx& pc, i64 gtid, i64 gsz, const int parts) {
  int xoff = 0; (void)xoff;
  if (parts & 1) {
    GF w = (GF)(p.in[I_w_in] + (size_t)l * D * INC);
    XPOSE(p.W_in(), 1024, 3840, [=](int k, int n) { const int s_ = win_src(n); const float x_ = w[(size_t)k * INC + (s_ < 0 ? 0 : s_)]; return s_ < 0 ? 0.f : x_; });
    XPOSE(p.W_g(), 1024, 4096, [=](int k, int n) { return w[(size_t)k * INC + C_GT + n]; });
  }
  if (parts & 1) {
    GF w = (GF)(p.in[I_mla_w_uq] + (size_t)l * 256 * 768); GF g = (GF)(p.in[I_mla_g_cq] + l * 256);
    XPOSE(p.W_uq(), 256, 768, [=](int k, int n) { return g[k] * w[(size_t)k * 768 + wuq_src(n)]; });
  }
  if (parts & 1) {
    GF w = (GF)(p.in[I_mla_w_ukv] + (size_t)l * 128 * 1024); GF g = (GF)(p.in[I_mla_g_ckv] + l * 128);
    XPOSE(p.W_ukv(), 256, 1024, [=](int k, int n) { const int kc = k < 128 ? k : 0; const float x_ = g[kc] * w[(size_t)kc * 1024 + n]; return k < 128 ? x_ : 0.f; });
  }
  if (parts & 2) {
    GF w = (GF)(p.in[I_w_branch] + (size_t)l * 4 * 512 * D);
    for (int br = 0; br < 4; ++br) { GF wb = w + (size_t)br * 512 * D; XPOSE(p.W_br() + (size_t)br * 1024 * 512, 512, 1024, [=](int k, int n) { return wb[(size_t)k * D + n]; }); }
  }
  if (parts & 2) {
    GF w = (GF)(p.in[I_w_out] + (size_t)l * D * D);
    XPOSE(p.W_out(), 1024, 1024, [=](int k, int n) { return w[(size_t)k * D + n]; });
  }
  if (parts & 4) {
    GF wq = (GF)(p.in[I_peer_w_q] + (size_t)l * D * 1024);
    XPOSE(p.W_q(), 1024, 1024, [=](int k, int n) { return wq[(size_t)k * 1024 + n]; });
  }
#ifndef CPU_SIM
  if (parts & 1) {
    GF w3 = (GF)(p.in[I_hy_w3] + (size_t)l * 64 * 1024);
    XPOSE(p.W3T(), 256, 1024, [=](int k, int n) { const int kc = k < 64 ? k : 0; const float x_ = w3[(size_t)kc * 1024 + n]; return k < 64 ? x_ : 0.f; });
  }
#endif
  if (parts & 1) {
    for (i64 i = gtid; i < 2048 * 256; i += gsz) {
      int n = (int)(i / 256), k = (int)(i % 256);
      int kw = n >> 10, dir = (n >> 9) & 1, blk4 = (n >> 7) & 3, jc = (n & 127) >> 1, gate = n & 1;
      float v = 0.f;
      if ((k >> 6) == blk4) {
        GF wsrc = (GF)p.in[gate ? I_lru_w_i : I_lru_w_r] + ((((size_t)l * 2 + dir) * 8 + kw * 4 + blk4) * 64 + (k & 63)) * 64 + jc;
        v = *wsrc;
      }
      p.W_lru()[i] = f2b(v);
    }
  }
  if (parts & 8) {
    GF keys = (GF)(p.in[I_peer_keys] + (size_t)l * 16 * 128 * 64);
    for (i64 i = gtid; i < 2048 * 256; i += gsz) {
      int n = (int)(i / 256), k = (int)(i % 256);
      int hp = n >> 7, key = n & 127;
      float v = ((k >> 6) == (hp & 3)) ? keys[((size_t)hp * 128 + key) * 64 + (k & 63)] : 0.f;
      p.W_key()[i] = f2b(v);
    }
  }
}

DEVN void ph_norm(const Params& p, int l, int which, int nrows, i64 gtid, i64 gsz) {
  const float* g = p.in[which ? I_g_ffn : I_g_mix] + l * D;
#ifndef CPU_SIM
  const int lane = (int)(gtid & 63);
  const i64 W = gsz >> 6;
  float4 gv[4];
#pragma unroll
  for (int i = 0; i < 4; ++i) gv[i] = *(const float4*)(g + (lane + i * 64) * 4);
  for (i64 r = gtid >> 6; r < nrows; r += 2 * W) {
    const bool two = r + W < nrows;
    const i64 rb = two ? r + W : r;
    const float4* xra = (const float4*)((l == 0 && which == 0) ? xin_row(p, (int)r) : p.xcur() + (size_t)r * D);
    const float4* xrb = (const float4*)((l == 0 && which == 0) ? xin_row(p, (int)rb) : p.xcur() + (size_t)rb * D);
    const float* mda = p.mods() + ((size_t)l * 3 + modrow((int)r)) * 6 * D + (which ? 3 * D : 0);
    const float* mdb = p.mods() + ((size_t)l * 3 + modrow((int)rb)) * 6 * D + (which ? 3 * D : 0);
    float4 xa[4], xb[4], sha[4], sca[4], shb[4], scb[4]; float sa = 0.f, sb = 0.f;
#pragma unroll
    for (int i = 0; i < 4; ++i) { xa[i] = gld4(xra + lane + i * 64); xb[i] = gld4(xrb + lane + i * 64); }
#pragma unroll
    for (int i = 0; i < 4; ++i) { const int k = (lane + i * 64) * 4; sha[i] = *(const float4*)(mda + k); sca[i] = *(const float4*)(mda + D + k); shb[i] = *(const float4*)(mdb + k); scb[i] = *(const float4*)(mdb + D + k); }
#pragma unroll
    for (int i = 0; i < 4; ++i) { sa += xa[i].x * xa[i].x + xa[i].y * xa[i].y + xa[i].z * xa[i].z + xa[i].w * xa[i].w; sb += xb[i].x * xb[i].x + xb[i].y * xb[i].y + xb[i].z * xb[i].z + xb[i].w * xb[i].w; }
#pragma unroll
    for (int o = 32; o >= 1; o >>= 1) { sa += lane_xor(sa, lane, o); sb += lane_xor(sb, lane, o); }
    const float rsa = 1.0f / sqrtf(sa * (1.0f / D) + EPS), rsb = 1.0f / sqrtf(sb * (1.0f / D) + EPS);
#pragma unroll
    for (int i = 0; i < 4; ++i) {
      const int k = (lane + i * 64) * 4;
      uint2 w;
      w.x = pk2bf(xa[i].x * rsa * gv[i].x * (1.0f + sca[i].x) + sha[i].x, xa[i].y * rsa * gv[i].y * (1.0f + sca[i].y) + sha[i].y);
      w.y = pk2bf(xa[i].z * rsa * gv[i].z * (1.0f + sca[i].z) + sha[i].z, xa[i].w * rsa * gv[i].w * (1.0f + sca[i].w) + sha[i].w);
      *(uint2*)(p.h() + (size_t)r * D + k) = w;
    }
    if (two) {
#pragma unroll
      for (int i = 0; i < 4; ++i) {
        const int k = (lane + i * 64) * 4;
        uint2 w;
        w.x = pk2bf(xb[i].x * rsb * gv[i].x * (1.0f + scb[i].x) + shb[i].x, xb[i].y * rsb * gv[i].y * (1.0f + scb[i].y) + shb[i].y);
        w.y = pk2bf(xb[i].z * rsb * gv[i].z * (1.0f + scb[i].z) + shb[i].z, xb[i].w * rsb * gv[i].w * (1.0f + scb[i].w) + shb[i].w);
        *(uint2*)(p.h() + (size_t)rb * D + k) = w;
      }
    }
  }
#else
  for (i64 r = gtid; r < nrows; r += gsz) {
    const float* xr = (l == 0 && which == 0) ? xin_row(p, (int)r) : p.xcur() + (size_t)r * D;
    float ss = 0.f;
    for (int k = 0; k < D; ++k) ss += xr[k] * xr[k];
    float rstd = 1.0f / sqrtf(ss / D + EPS);
    const float* md = p.mods() + ((size_t)l * 3 + modrow((int)r)) * 6 * D + (which ? 3 * D : 0);
    for (int k = 0; k < D; ++k) p.h()[(size_t)r * D + k] = f2b(xr[k] * rstd * g[k] * (1.0f + md[D + k]) + md[k]);
  }
#endif
}

DEVN void ph_B0(const Params& p, int l, i64 gtid, i64 gsz, char* b0lds = nullptr, int b0tid = 0) {
#ifndef CPU_SIM
  {
    const int lane = (int)(gtid & 63);
    const i64 W = gsz >> 6;
    for (i64 r = gtid >> 6; r < TT; r += 4 * W) {
      uint2 a[4]; unsigned b[4]; i64 rr[4];
#pragma unroll
      for (int j = 0; j < 4; ++j) { rr[j] = r + j * W < TT ? r + j * W : r; const bf* pr = p.P() + (size_t)rr[j] * PC; a[j] = *(const uint2*)(pr + C_CQ + lane * 4); b[j] = *(const unsigned*)(pr + C_CKV + lane * 2); }
      float sq[4], sk[4];
#pragma unroll
      for (int j = 0; j < 4; ++j) {
        const float f0 = __uint_as_float(a[j].x << 16), f1 = __uint_as_float(a[j].x & 0xFFFF0000u), f2 = __uint_as_float(a[j].y << 16), f3 = __uint_as_float(a[j].y & 0xFFFF0000u);
        const float g0 = __uint_as_float(b[j] << 16), g1 = __uint_as_float(b[j] & 0xFFFF0000u);
        sq[j] = 0.f; sq[j] += f0 * f0; sq[j] += f1 * f1; sq[j] += f2 * f2; sq[j] += f3 * f3;
        sk[j] = 0.f; sk[j] += g0 * g0; sk[j] += g1 * g1;
      }
#pragma unroll
      for (int o = 32; o >= 1; o >>= 1) {
#pragma unroll
        for (int j = 0; j < 4; ++j) { sq[j] += lane_xor(sq[j], lane, o); sk[j] += lane_xor(sk[j], lane, o); }
      }
#pragma unroll
      for (int j = 0; j < 4; ++j) if (lane == 0 && r + j * W < TT) { p.ssq()[rr[j]] = sq[j]; p.ssq()[TT + rr[j]] = sk[j]; }
    }
  }
#else
  for (i64 r = gtid; r < TT; r += gsz) {
    const bf* pr = p.P() + (size_t)r * PC;
    float sq = 0.f, sk = 0.f;
    for (int k = 0; k < 256; ++k) { float v = b2f(pr[C_CQ + k]); sq += v * v; }
    for (int k = 0; k < 128; ++k) { float v = b2f(pr[C_CKV + k]); sk += v * v; }
    p.ssq()[r] = sq; p.ssq()[TT + r] = sk;
  }
#endif
#ifndef CPU_SIM
  {
    GF cw = (GF)(p.in[I_lru_conv_w] + l * 4 * 512); GF cb = (GF)(p.in[I_lru_conv_b] + l * 512);
    const int c8 = (int)(gtid & 63) * 8;
    float wv[4][8], bv[8];
#pragma unroll
    for (int j = 0; j < 8; ++j) { bv[j] = cb[c8 + j];
#pragma unroll
      for (int k = 0; k < 4; ++k) wv[k][j] = cw[k * 512 + c8 + j]; }
    for (i64 i = gtid; i < (i64)TT * 64; i += 2 * gsz) {
      const bool two = i + gsz < (i64)TT * 64;
      const int r0 = (int)(i >> 6), r1 = two ? (int)((i + gsz) >> 6) : r0;
      const RowInfo ra = rowinfo(r0), rb = rowinfo(r1);
      uint4 xa[4], xb[4]; float ma[4], mb[4];
#pragma unroll
      for (int k = 0; k < 4; ++k) {
        const int ta = ra.t - 1 + k, tb = rb.t - 1 + k;
        const bool oka = ta >= 0 && ta < ra.L, okb = tb >= 0 && tb < rb.L;
        ma[k] = oka ? 1.f : 0.f; mb[k] = okb ? 1.f : 0.f;
        xa[k] = *(const uint4*)(p.P() + (size_t)(ra.base + (oka ? ta : ra.t)) * PC + C_LX + c8);
        xb[k] = *(const uint4*)(p.P() + (size_t)(rb.base + (okb ? tb : rb.t)) * PC + C_LX + c8);
      }
      float aa[8], ab[8];
#pragma unroll
      for (int j = 0; j < 8; ++j) { aa[j] = bv[j]; ab[j] = bv[j]; }
#pragma unroll
      for (int k = 0; k < 4; ++k) {
        float fa_[8], fb_[8]; unpack8(xa[k], fa_); unpack8(xb[k], fb_);
#pragma unroll
        for (int j = 0; j < 8; ++j) { aa[j] += (wv[k][j] * ma[k]) * fa_[j]; ab[j] += (wv[k][j] * mb[k]) * fb_[j]; }
      }
      store8bf(p.XC() + (size_t)r0 * 512 + c8, aa);
      if (two) store8bf(p.XC() + (size_t)r1 * 512 + c8, ab);
    }
  }
  {
    GF cw = (GF)(p.in[I_hy_conv_w] + l * 3 * 1536); GF cb = (GF)(p.in[I_hy_conv_b] + l * 1536);
    for (i64 i = (i64)NLAT * 64 + gtid; i < (i64)TT * 64; i += gsz) {
      const int r = (int)(i >> 6), c8 = (int)(i & 63) * 8;
      const RowInfo ri = rowinfo(r);
      uint4 xf[3], xg[3]; float mk[3];
#pragma unroll
      for (int k = 0; k < 3; ++k) {
        const int ts = ri.t - 1 + k; const bool ok = ts >= 0 && ts < ri.L; mk[k] = ok ? 1.f : 0.f;
        const bf* pr = p.P() + (size_t)(ri.base + (ok ? ts : ri.t)) * PC + C_HU;
        xf[k] = *(const uint4*)(pr + 512 + c8); xg[k] = *(const uint4*)(pr + 1024 + c8);
      }
      float a1[8], a2[8], w1[3][8], w2[3][8];
#pragma unroll
      for (int j = 0; j < 8; ++j) { a1[j] = cb[512 + c8 + j]; a2[j] = cb[1024 + c8 + j];
#pragma unroll
        for (int k = 0; k < 3; ++k) { w1[k][j] = cw[k * 1536 + 512 + c8 + j]; w2[k][j] = cw[k * 1536 + 1024 + c8 + j]; } }
#pragma unroll
      for (int k = 0; k < 3; ++k) {
        float f[8], g[8]; unpack8(xf[k], f); unpack8(xg[k], g);
#pragma unroll
        for (int j = 0; j < 8; ++j) { a1[j] += (w1[k][j] * mk[k]) * f[j]; a2[j] += (w2[k][j] * mk[k]) * g[j]; }
      }
#pragma unroll
      for (int j = 0; j < 8; ++j) a1[j] *= a2[j];
      store8bf(p.Z() + (size_t)r * 512 + c8, a1);
    }
  }
  {
    const float* cw = p.in[I_hy_conv_w] + l * 3 * 1536; const float* cb = p.in[I_hy_conv_b] + l * 1536;
    unsigned short* tz_ = (unsigned short*)b0lds; unsigned short* tx_ = tz_ + 64 * 72;
    for (int tile = blockIdx.x; tile < (NLAT / 64) * 8; tile += gridDim.x) {
      const int rt = tile >> 3, c0 = (tile & 7) * 64;
      const int tr = b0tid >> 3, cg8 = (b0tid & 7) * 8;
      const int r = rt * 64 + tr, t = r % N;
      float a0[8], a1[8], a2[8];
#pragma unroll
      for (int j = 0; j < 8; ++j) { a0[j] = cb[c0 + cg8 + j]; a1[j] = cb[512 + c0 + cg8 + j]; a2[j] = cb[1024 + c0 + cg8 + j]; }
      uint4 v0[3], v1[3], v2[3]; bool ok[3];
#pragma unroll
      for (int k = 0; k < 3; ++k) {
        const int ts = t - 1 + k; ok[k] = ts >= 0 && ts < N;
        const bf* pr = p.P() + (size_t)(r - 1 + (ok[k] ? k : 1)) * PC + C_HU + c0 + cg8;
        v0[k] = *(const uint4*)pr; v1[k] = *(const uint4*)(pr + 512); v2[k] = *(const uint4*)(pr + 1024);
      }
#pragma unroll
      for (int k = 0; k < 3; ++k) {
        if (!ok[k]) continue;
        float f0[8], f1[8], f2_[8]; unpack8(v0[k], f0); unpack8(v1[k], f1); unpack8(v2[k], f2_);
        const float* w = cw + k * 1536 + c0 + cg8;
#pragma unroll
        for (int j = 0; j < 8; ++j) { a0[j] += w[j] * f0[j]; a1[j] += w[512 + j] * f1[j]; a2[j] += w[1024 + j] * f2_[j]; }
      }
      __syncthreads();
#pragma unroll
      for (int j = 0; j < 8; ++j) { tz_[(cg8 + j) * 72 + tr] = f2b(a1[j] * a2[j]).v; tx_[(cg8 + j) * 72 + tr] = f2b(a0[j]).v; }
      __syncthreads();
      { const int cc = b0tid >> 3, tg = (b0tid & 7) * 8;
        const int bq = (rt * 64) / N, tq = (rt * 64) % N + tg;
        const size_t o = ((size_t)(c0 + cc) * NB + bq) * N + tq;
        *(uint4*)((unsigned short*)p.Z() + o) = *(const uint4*)(tz_ + cc * 72 + tg);
        *(uint4*)((unsigned short*)p.XYT() + o) = *(const uint4*)(tx_ + cc * 72 + tg); }
    }
  }
#else
  {
    const float* cw = p.in[I_lru_conv_w] + l * 4 * 512; const float* cb = p.in[I_lru_conv_b] + l * 512;
    for (i64 i = gtid; i < (i64)TT * 512; i += gsz) {
      int r = (int)(i / 512), c = (int)(i % 512);
      RowInfo ri = rowinfo(r);
      float acc = cb[c];
      for (int k = 0; k < 4; ++k) {
        int ts = ri.t - 1 + k;
        if (ts >= 0 && ts < ri.L) acc += cw[k * 512 + c] * b2f(p.P()[(size_t)(ri.base + ts) * PC + C_LX + c]);
      }
      p.XC()[i] = f2b(acc);
    }
  }
  {
    const float* cw = p.in[I_hy_conv_w] + l * 3 * 1536; const float* cb = p.in[I_hy_conv_b] + l * 1536;
    for (i64 i = gtid; i < (i64)TT * 512; i += gsz) {
      int r = (int)(i / 512), c = (int)(i % 512);
      RowInfo ri = rowinfo(r);
      float a1 = cb[512 + c], a2 = cb[1024 + c];
      for (int k = 0; k < 3; ++k) {
        int ts = ri.t - 1 + k;
        if (ts >= 0 && ts < ri.L) {
          const bf* pr = p.P() + (size_t)(ri.base + ts) * PC + C_HU;
          a1 += cw[k * 1536 + 512 + c] * b2f(pr[512 + c]);
          a2 += cw[k * 1536 + 1024 + c] * b2f(pr[1024 + c]);
        }
      }
      p.Z()[i] = f2b(a1 * a2);
    }
  }
  {
    const float* w3 = p.in[I_hy_w3] + (size_t)l * 64 * 1024;
    const float maxd = logf(1e-2f) / 0.3f, mind = logf(1e-2f) / 1.5f;
    for (i64 i = gtid; i < (i64)(N + LC) * 1024; i += gsz) {
      int tt = (int)(i / 1024), j = (int)(i % 1024);
      int t, L; if (tt < N) { t = tt; L = N; } else { t = tt - N; L = LC; }
      const float* hd = p.hdn2() + ((size_t)l * (N + LC) + tt) * 64;
      float acc = 0.f;
      for (int k = 0; k < 64; ++k) acc += hd[k] * w3[k * 1024 + j];
      float tn = (float)t / (float)(L - 1);
      float delta = mind + (float)j * ((maxd - mind) / 1023.0f);
      p.F()[i] = acc * expf(-tn * fabsf(delta));
    }
  }
#endif
}

DEVN void ph_fnorm(const Params& p, i64 gtid, i64 gsz) {
#ifndef CPU_SIM
  for (i64 i = 512 + gtid; i < 2 * 512; i += gsz) {
#else
  for (i64 i = gtid; i < 2 * 512; i += gsz) {
#endif
    int which = (int)(i / 512), c = (int)(i % 512);
    int L = which ? LC : N; int off = which ? N : 0;
    float ss = 0.f;
    for (int t = 0; t < L; ++t) { float a = p.F()[(size_t)(off + t) * 1024 + c], b = p.F()[(size_t)(off + t) * 1024 + 512 + c]; ss += a * a + b * b; }
    p.fnorm()[i] = 1.0f / sqrtf(ss + EPS);
  }
}


DEV void lru_chunk_rows(int dir, int b, int k, int& row0, int& step) {
  int seg_chunk;
  if (k < NCC) { seg_chunk = dir ? NCC - 1 - k : k; row0 = NLAT + b * LC + seg_chunk * LCH; }
  else { int kl = k - NCC; seg_chunk = dir ? NCL - 1 - kl : kl; row0 = b * N + seg_chunk * LCH; }
  if (dir) { row0 += LCH - 1; step = -1; } else step = 1;
}
DEVN void ph_lru1(const Params& p, i64 gtid, i64 gsz) {
#ifndef CPU_SIM
  for (i64 i = gtid; i < (i64)2 * NB * NCHK * 128; i += gsz) {
    const int c = (int)(i % 128) * 4, k = (int)((i / 128) % NCHK), b = (int)((i / (128 * NCHK)) % NB), dir = (int)(i / ((i64)128 * NCHK * NB));
    int row0, step; lru_chunk_rows(dir, b, k, row0, step);
    const uint4* lab4 = (const uint4*)(p.LAB() + (size_t)dir * TT * 512 + c);
    float h0 = 0.f, h1 = 0.f, h2 = 0.f, h3 = 0.f, s0 = 0.f, s1 = 0.f, s2 = 0.f, s3 = 0.f;
    uint4 wn[8];
#pragma unroll
    for (int t = 0; t < 8; ++t) wn[t] = lab4[(size_t)(row0 + step * t) * 128];
#pragma unroll 1
    for (int t0 = 0; t0 < LCH; t0 += 8) {
      uint4 w[8];
#pragma unroll
      for (int t = 0; t < 8; ++t) w[t] = wn[t];
      if (t0 + 8 < LCH) {
#pragma unroll
        for (int t = 0; t < 8; ++t) wn[t] = lab4[(size_t)(row0 + step * (t0 + 8 + t)) * 128];
      }
#pragma unroll
      for (int t = 0; t < 8; ++t) {
        const float a0 = __uint_as_float(w[t].x << 16), a1 = __uint_as_float(w[t].y << 16), a2 = __uint_as_float(w[t].z << 16), a3 = __uint_as_float(w[t].w << 16);
        s0 += a0; s1 += a1; s2 += a2; s3 += a3;
        h0 = fexpf_(a0) * h0 + __uint_as_float(w[t].x & 0xFFFF0000u); h1 = fexpf_(a1) * h1 + __uint_as_float(w[t].y & 0xFFFF0000u);
        h2 = fexpf_(a2) * h2 + __uint_as_float(w[t].z & 0xFFFF0000u); h3 = fexpf_(a3) * h3 + __uint_as_float(w[t].w & 0xFFFF0000u);
      }
    }
    const size_t o = ((size_t)(dir * NB + b) * NCHK + k) * 512 + c;
    *(float4*)(p.SA() + o) = float4{fexpf_(s0), fexpf_(s1), fexpf_(s2), fexpf_(s3)};
    *(float4*)(p.SB() + o) = float4{h0, h1, h2, h3};
  }
#else
  for (i64 i = gtid; i < (i64)2 * NB * NCHK * 512; i += gsz) {
    int c = (int)(i % 512), k = (int)((i / 512) % NCHK), b = (int)((i / (512 * NCHK)) % NB), dir = (int)(i / ((i64)512 * NCHK * NB));
    int row0, step; lru_chunk_rows(dir, b, k, row0, step);
    const bf* la = p.LA() + (size_t)dir * TT * 512 + c; const bf* lb = p.LB() + (size_t)dir * TT * 512 + c;
    float h = 0.f, sl = 0.f;
    for (int t = 0; t < LCH; ++t) {
      size_t r = (size_t)(row0 + step * t);
      float lav = b2f(la[r * 512]);
      h = expf(lav) * h + b2f(lb[r * 512]); sl += lav;
    }
    p.SA()[i] = fexpf_(sl); p.SB()[i] = h;
  }
#endif
}
DEVN void ph_lru3(const Params& p, int last, i64 gtid, i64 gsz, float* hrs, int ltid) {
#ifndef CPU_SIM
  unsigned* hrp = (unsigned*)hrs;
  for (i64 i = gtid; i < (i64)NB * NCHK * 256; i += gsz) {
    const int c = (int)(i % 256) * 2, j = (int)((i / 256) % NCHK), b = (int)(i / (256 * NCHK));
    if (last && j < NCC) continue;
    const int kf = j, kr = j < NCC ? NCC - 1 - j : NCC + (NCL - 1 - (j - NCC));
    const float* sa0 = p.SA() + ((size_t)(0 * NB + b) * NCHK) * 512 + c; const float* sb0 = p.SB() + ((size_t)(0 * NB + b) * NCHK) * 512 + c;
    const float* sa1 = p.SA() + ((size_t)(1 * NB + b) * NCHK) * 512 + c; const float* sb1 = p.SB() + ((size_t)(1 * NB + b) * NCHK) * 512 + c;
    float hf0 = 0.f, hf1 = 0.f, hr0 = 0.f, hr1 = 0.f;
    const int row0 = j < NCC ? NLAT + b * LC + j * LCH : b * N + (j - NCC) * LCH;
    const unsigned* lab0 = p.LAB() + c; const unsigned* lab1 = p.LAB() + (size_t)TT * 512 + c;
#pragma unroll 1
    for (int k0 = 0; k0 < kf; k0 += 8) {
      float2 av[8], bv[8];
#pragma unroll
      for (int q = 0; q < 8; ++q) { const bool ok = k0 + q < kf; av[q] = ok ? *(const float2*)(sa0 + (size_t)(k0 + q) * 512) : float2{1.f, 1.f}; bv[q] = ok ? *(const float2*)(sb0 + (size_t)(k0 + q) * 512) : float2{0.f, 0.f}; }
#pragma unroll
      for (int q = 0; q < 8; ++q) { hf0 = av[q].x * hf0 + bv[q].x; hf1 = av[q].y * hf1 + bv[q].y; }
    }
#pragma unroll 1
    for (int k0 = 0; k0 < kr; k0 += 8) {
      float2 av[8], bv[8];
#pragma unroll
      for (int q = 0; q < 8; ++q) { const bool ok = k0 + q < kr; av[q] = ok ? *(const float2*)(sa1 + (size_t)(k0 + q) * 512) : float2{1.f, 1.f}; bv[q] = ok ? *(const float2*)(sb1 + (size_t)(k0 + q) * 512) : float2{0.f, 0.f}; }
#pragma unroll
      for (int q = 0; q < 8; ++q) { hr0 = av[q].x * hr0 + bv[q].x; hr1 = av[q].y * hr1 + bv[q].y; }
    }
#pragma unroll 1
    for (int t0 = LCH - 16; t0 >= 0; t0 -= 16) {
      uint2 w[16];
#pragma unroll
      for (int t = 0; t < 16; ++t) w[t] = *(const uint2*)(lab1 + (size_t)(row0 + t0 + t) * 512);
#pragma unroll
      for (int t = 15; t >= 0; --t) {
        hr0 = fexpf_(__uint_as_float(w[t].x << 16)) * hr0 + __uint_as_float(w[t].x & 0xFFFF0000u);
        hr1 = fexpf_(__uint_as_float(w[t].y << 16)) * hr1 + __uint_as_float(w[t].y & 0xFFFF0000u);
        hrp[(t0 + t) * 512 + ltid] = pk2bf(hr0, hr1);
      }
    }
#pragma unroll 1
    for (int t0 = 0; t0 < LCH; t0 += 16) {
      uint2 w[16]; unsigned gw[16];
#pragma unroll
      for (int t = 0; t < 16; ++t) { const size_t r = (size_t)(row0 + t0 + t); w[t] = *(const uint2*)(lab0 + r * 512); gw[t] = *(const unsigned*)(p.P() + r * PC + C_LG + c); }
#pragma unroll
      for (int t = 0; t < 16; ++t) {
        hf0 = fexpf_(__uint_as_float(w[t].x << 16)) * hf0 + __uint_as_float(w[t].x & 0xFFFF0000u);
        hf1 = fexpf_(__uint_as_float(w[t].y << 16)) * hf1 + __uint_as_float(w[t].y & 0xFFFF0000u);
        const unsigned hw = hrp[(t0 + t) * 512 + ltid];
        const float y0 = geluf_(__uint_as_float(gw[t] << 16)) * (hf0 + __uint_as_float(hw << 16));
        const float y1 = geluf_(__uint_as_float(gw[t] & 0xFFFF0000u)) * (hf1 + __uint_as_float(hw & 0xFFFF0000u));
        *(unsigned*)(p.Y() + (size_t)(row0 + t0 + t) * 2048 + 512 + c) = pk2bf(y0, y1);
      }
    }
  }
#else
  for (i64 i = gtid; i < (i64)NB * NCHK * 512; i += gsz) {
    int c = (int)(i % 512), j = (int)((i / 512) % NCHK), b = (int)(i / (512 * NCHK));
    if (last && j < NCC) continue;
    int kf = j, kr = j < NCC ? NCC - 1 - j : NCC + (NCL - 1 - (j - NCC));
    const float* sa0 = p.SA() + ((size_t)(0 * NB + b) * NCHK) * 512 + c; const float* sb0 = p.SB() + ((size_t)(0 * NB + b) * NCHK) * 512 + c;
    const float* sa1 = p.SA() + ((size_t)(1 * NB + b) * NCHK) * 512 + c; const float* sb1 = p.SB() + ((size_t)(1 * NB + b) * NCHK) * 512 + c;
    float hf = 0.f, hr = 0.f;
    int row0 = j < NCC ? NLAT + b * LC + j * LCH : b * N + (j - NCC) * LCH;
    const bf* la0 = p.LA() + c; const bf* lb0 = p.LB() + c;
    const bf* la1 = p.LA() + (size_t)TT * 512 + c; bf* lb1 = p.LB() + (size_t)TT * 512 + c;
    for (int k = 0; k < kf; ++k) hf = sa0[(size_t)k * 512] * hf + sb0[(size_t)k * 512];
    for (int k = 0; k < kr; ++k) hr = sa1[(size_t)k * 512] * hr + sb1[(size_t)k * 512];
    for (int t = LCH - 1; t >= 0; --t) { size_t r = (size_t)(row0 + t); hr = expf(b2f(la1[r * 512])) * hr + b2f(lb1[r * 512]); lb1[r * 512] = f2b(hr); }
    for (int t = 0; t < LCH; ++t) {
      size_t r = (size_t)(row0 + t);
      hf = expf(b2f(la0[r * 512])) * hf + b2f(lb0[r * 512]);
      float lg = b2f(p.P()[r * PC + C_LG + c]);
      p.Y()[r * 2048 + 512 + c] = f2b(geluf_(lg) * (hf + b2f(lb1[r * 512])));
    }
  }
#endif
}

DEVN void ph_C(const Params& p, int l, int last, i64 gtid, i64 gsz) {
  const int QR = last ? NLAT : TT;
#ifdef CPU_SIM
  for (i64 i = gtid; i < (i64)8 * QR; i += gsz) {
    int hh = (int)(i / QR), r = (int)(i % QR);
    RowInfo ri = rowinfo(r);
    float q[96];
#pragma unroll
    for (int d = 0; d < 96; ++d) q[d] = b2f(p.QA()[(size_t)r * 768 + hh * 96 + d]);
    float o[64];
#pragma unroll
    for (int d = 0; d < 64; ++d) o[d] = 0.f;
    float m = -1e30f, lsum = 0.f;
    const float scale = 0.10206207261596577f;
    int nseg = ri.lat ? 2 : 1;
    for (int sg = 0; sg < nseg; ++sg) {
      int kb, kn_;
      if (ri.lat && sg == 0) { kb = ri.b * N; kn_ = N; } else { kb = NLAT + ri.b * LC; kn_ = LC; }
      for (int kk = 0; kk < kn_; ++kk) {
        const bf* kr_ = p.KVA() + (size_t)(kb + kk) * 1024 + hh * 128;
        const bf* krp = p.P() + (size_t)(kb + kk) * PC + C_KR;
        float s = 0.f;
#pragma unroll
        for (int d = 0; d < 64; ++d) s += q[d] * b2f(kr_[d]);
#pragma unroll
        for (int d = 0; d < 32; ++d) s += q[64 + d] * b2f(krp[d]);
        s *= scale;
        float mn = fmaxf(m, s);
        float corr = expf(m - mn), pe = expf(s - mn);
        lsum = lsum * corr + pe;
#pragma unroll
        for (int d = 0; d < 64; ++d) o[d] = o[d] * corr + pe * b2f(kr_[64 + d]);
        m = mn;
      }
    }
    float inv = 1.0f / lsum;
#pragma unroll
    for (int d = 0; d < 64; ++d) p.Y()[(size_t)r * 2048 + hh * 64 + d] = f2b(o[d] * inv);
  }
#endif
  {
    const float* cw = p.in[I_hy_conv_w] + l * 3 * 1536; const float* cb = p.in[I_hy_conv_b] + l * 1536;
    const float* skip = p.in[I_hy_skip] + l * 512;
#ifndef CPU_SIM
    const i64 hy_first = (i64)NLAT * 512;
#else
    const i64 hy_first = 0;
#endif
    for (i64 i = hy_first + gtid; i < (i64)QR * 512; i += gsz) {
      int r = (int)(i / 512), c = (int)(i % 512);
      RowInfo ri = rowinfo(r);
      int foff = ri.lat ? 0 : N;
      float acc = 0.f;
      for (int s = 0; s < ri.L; ++s) {
        int dd = ri.t - s;
        float fv = dd >= 0 ? p.F()[(size_t)(foff + dd) * 1024 + c] : p.F()[(size_t)(foff - dd) * 1024 + 512 + c];
        acc += fv * b2f(p.Z()[(size_t)(ri.base + s) * 512 + c]);
      }
      acc *= p.fnorm()[(ri.lat ? 0 : 512) + c];
      float x0 = cb[c];
      for (int k = 0; k < 3; ++k) {
        int ts = ri.t - 1 + k;
        if (ts >= 0 && ts < ri.L) x0 += cw[k * 1536 + c] * b2f(p.P()[(size_t)(ri.base + ts) * PC + C_HU + c]);
      }
      float y = acc + skip[c] * b2f(p.Z()[(size_t)r * 512 + c]);
      p.Y()[(size_t)r * 2048 + 1024 + c] = f2b(x0 * y);
    }
  }
#ifdef CPU_SIM
  for (i64 i = gtid; i < (i64)8 * QR; i += gsz) {
    int hh = (int)(i / QR), r = (int)(i % QR);
    RowInfo ri = rowinfo(r);
    int kh = hh / 4;
    float q[64];
#pragma unroll
    for (int d = 0; d < 64; ++d) q[d] = b2f(p.P()[(size_t)r * PC + C_GQ + hh * 64 + d]);
    float o[64];
#pragma unroll
    for (int d = 0; d < 64; ++d) o[d] = 0.f;
    float m = p.in[I_gqa_sink][l * 8 + hh], lsum = 1.0f;
    int nseg = ri.lat ? 2 : 1;
    for (int sg = 0; sg < nseg; ++sg) {
      int k0, k1;
      if (ri.lat && sg == 0) { int lo = ri.t - 128; if (lo < 0) lo = 0; int hi = ri.t + 128; if (hi > N - 1) hi = N - 1; k0 = ri.b * N + lo; k1 = ri.b * N + hi + 1; }
      else { k0 = NLAT + ri.b * LC; k1 = k0 + LC; }
      for (int kk = k0; kk < k1; ++kk) {
        const bf* kp = p.P() + (size_t)kk * PC + C_GKV + kh * 64;
        const bf* vp = kp + 128;
        float s = 0.f;
#pragma unroll
        for (int d = 0; d < 64; ++d) s += q[d] * b2f(kp[d]);
        s *= 0.125f;
        float mn = fmaxf(m, s);
        float corr = expf(m - mn), pe = expf(s - mn);
        lsum = lsum * corr + pe;
#pragma unroll
        for (int d = 0; d < 64; ++d) o[d] = o[d] * corr + pe * b2f(vp[d]);
        m = mn;
      }
    }
    float inv = 1.0f / lsum;
#pragma unroll
    for (int d = 0; d < 64; ++d) p.Y()[(size_t)r * 2048 + 1536 + hh * 64 + d] = f2b(o[d] * inv);
  }
#endif
}

DEVN void ph_E2a(const Params& p, int nrows, i64 gtid, i64 gsz) {
  for (i64 i = gtid; i < (i64)nrows * 16; i += gsz) {
    const sc_t* s_ = p.SC() + (size_t)i * 128;
    float ps = 3.0e38f; int pi = -1;
    for (int k = 0; k < 16; ++k) {
      float bs = -3.0e38f; int bi = -1;
      for (int j = 0; j < 128; ++j) {
        float s = (float)s_[j];
        bool elig = (s < ps) || (s == ps && j > pi);
        if (elig && (s > bs)) { bs = s; bi = j; }
      }
      p.TKs()[(size_t)i * 16 + k] = bs; p.TKi()[(size_t)i * 16 + k] = bi;
      ps = bs; pi = bi;
    }
  }
}

DEVN void ph_E2b(const Params& p, int nrows, i64 gtid, i64 gsz) {
  for (i64 i = gtid; i < (i64)nrows * 8; i += gsz) {
    const float* s1 = p.TKs() + (size_t)i * 32; const float* s2 = s1 + 16;
    const int* i1 = p.TKi() + (size_t)i * 32; const int* i2 = i1 + 16;
    float ps = 3.0e38f; int pi = -1;
    float mx = 0.f;
    for (int k = 0; k < 16; ++k) {
      float bs = -3.0e38f; int bi = -1;
      for (int j = 0; j < 256; ++j) {
        float s = s1[j >> 4] + s2[j & 15];
        bool elig = (s < ps) || (s == ps && j > pi);
        if (elig && (s > bs)) { bs = s; bi = j; }
      }
      if (k == 0) mx = bs;
      p.SELi()[(size_t)i * 16 + k] = i1[bi >> 4] * 128 + i2[bi & 15];
      p.SELg()[(size_t)i * 16 + k] = expf(bs - mx);
      ps = bs; pi = bi;
    }
    float sum = 0.f;
    for (int k = 0; k < 16; ++k) sum += p.SELg()[(size_t)i * 16 + k];
    float inv = 1.0f / sum;
    for (int k = 0; k < 16; ++k) p.SELg()[(size_t)i * 16 + k] *= inv;
  }
}

DEVN void ph_E3(const Params& p, int l, int nrows, i64 gtid, i64 gsz) {
  const float* u = p.in[I_peer_u] + (size_t)l * NEXP * D;
#ifndef CPU_SIM
  const int lane = (int)(gtid & 63);
  for (i64 i = gtid >> 6; i < (i64)nrows * 128; i += gsz >> 6) {
    const int r = (int)(i >> 7);
    const float4* ur = (const float4*)(u + (size_t)p.SELi()[i] * D);
    const uint2* hr = (const uint2*)(p.h() + (size_t)r * D);
    float acc = 0.f;
#pragma unroll
    for (int q = 0; q < 4; ++q) {
      const float4 uv = ur[lane + q * 64]; const uint2 hv = hr[lane + q * 64];
      union { unsigned u_; float f; } c0, c1, c2, c3;
      c0.u_ = hv.x << 16; c1.u_ = hv.x & 0xFFFF0000u; c2.u_ = hv.y << 16; c3.u_ = hv.y & 0xFFFF0000u;
      acc += uv.x * c0.f + uv.y * c1.f + uv.z * c2.f + uv.w * c3.f;
    }
#pragma unroll
    for (int o = 32; o >= 1; o >>= 1) acc += lane_xor(acc, lane, o);
    if (lane == 0) p.W()[i] = p.SELg()[i] * geluf_(acc);
  }
#else
  for (i64 i = gtid; i < (i64)nrows * 128; i += gsz) {
    int r = (int)(i / 128);
    const float* ur = u + (size_t)p.SELi()[i] * D;
    const bf* hr = p.h() + (size_t)r * D;
    float acc = 0.f;
    for (int k = 0; k < D; ++k) acc += b2f(hr[k]) * ur[k];
    p.W()[i] = p.SELg()[i] * geluf_(acc);
  }
#endif
}

DEVN void ph_E4(const Params& p, int l, int nrows, i64 gtid, i64 gsz) {
  const float* v = p.in[I_peer_v] + (size_t)l * NEXP * D;
  for (i64 i = gtid; i < (i64)nrows * D; i += gsz) {
    int r = (int)(i / D), n = (int)(i % D);
    float acc = 0.f;
    for (int j = 0; j < 128; ++j) acc += p.W()[(size_t)r * 128 + j] * v[(size_t)p.SELi()[(size_t)r * 128 + j] * D + n];
    float g2 = p.mods()[((size_t)l * 3 + modrow(r)) * 6 * D + 5 * D + n];
    p.xcur()[i] += g2 * acc;
  }
}


#ifndef CPU_SIM
DEV unsigned dpp_ror_u(unsigned x, int n) {
  switch (n) {
    case 1: return (unsigned)__builtin_amdgcn_update_dpp(0, (int)x, 0x121, 0xf, 0xf, false);
    case 2: return (unsigned)__builtin_amdgcn_update_dpp(0, (int)x, 0x122, 0xf, 0xf, false);
    case 4: return (unsigned)__builtin_amdgcn_update_dpp(0, (int)x, 0x124, 0xf, 0xf, false);
    default: return (unsigned)__builtin_amdgcn_update_dpp(0, (int)x, 0x128, 0xf, 0xf, false);
  }
}
DEV unsigned wave_max_u(unsigned x) {
  x = max(x, dpp_ror_u(x, 1)); x = max(x, dpp_ror_u(x, 2)); x = max(x, dpp_ror_u(x, 4)); x = max(x, dpp_ror_u(x, 8));
  const unsigned a = (unsigned)__builtin_amdgcn_readlane((int)x, 0), b = (unsigned)__builtin_amdgcn_readlane((int)x, 16);
  const unsigned c = (unsigned)__builtin_amdgcn_readlane((int)x, 32), d = (unsigned)__builtin_amdgcn_readlane((int)x, 48);
  return max(max(a, b), max(c, d));
}
DEV unsigned f16_key(unsigned short h, int idx) { const unsigned t = (h & 0x8000u) ? (unsigned)(~h & 0xFFFFu) : (unsigned)(h | 0x8000u); return (t << 16) | (unsigned)(0xFFFF - idx); }
DEV float key_score(unsigned k) { const unsigned t = k >> 16; const unsigned short h = (unsigned short)((t & 0x8000u) ? (t ^ 0x8000u) : (~t & 0xFFFFu)); union { unsigned short u; _Float16 f; } c; c.u = h; return (float)c.f; }
DEV int key_idx(unsigned k) { return 0xFFFF - (int)(k & 0xFFFFu); }
DEV int mbcnt64(unsigned long long m) { return (int)__builtin_amdgcn_mbcnt_hi((unsigned)(m >> 32), __builtin_amdgcn_mbcnt_lo((unsigned)m, 0u)); }
DEV unsigned pick16_sorted(unsigned k0, unsigned k1, unsigned T, int above, int lane, int* tmp) {
  const unsigned h0 = k0 & 0xFFFF0000u, h1 = k1 & 0xFFFF0000u;
  const bool gt0 = h0 > T, eq0 = h0 == T, gt1 = h1 > T, eq1 = h1 == T;
  const int need = 16 - above;
  const unsigned long long me0 = __builtin_amdgcn_ballot_w64(eq0), me1 = __builtin_amdgcn_ballot_w64(eq1);
  const bool s0 = gt0 || (eq0 && mbcnt64(me0) < need);
  const int need1 = need - (int)__builtin_popcountll(me0);
  const bool s1 = gt1 || (eq1 && mbcnt64(me1) < need1);
  const unsigned long long ms0 = __builtin_amdgcn_ballot_w64(s0), ms1 = __builtin_amdgcn_ballot_w64(s1);
  if (s0) tmp[mbcnt64(ms0)] = (int)k0;
  if (s1) tmp[(int)__builtin_popcountll(ms0) + mbcnt64(ms1)] = (int)k1;
  const unsigned u = (unsigned)tmp[lane & 15];
  int rank = 0;
#pragma unroll
  for (int q = 0; q < 16; ++q) rank += ((unsigned)__builtin_amdgcn_readlane((int)u, q) > u) ? 1 : 0;
  if (lane < 16) tmp[16 + rank] = (int)u;
  return (unsigned)tmp[16 + (lane & 15)];
}
DEV void top16_x2(unsigned a0, unsigned a1, unsigned b0, unsigned b1, int lane, int* tmp, unsigned& ta, unsigned& tb) {
  unsigned TA = 0, TB = 0; int abA = 0, abB = 0;
#pragma unroll
  for (int bit = 31; bit >= 16; --bit) {
    const unsigned m = 0xFFFFFFFFu << bit, one = 1u << bit;
    const unsigned tA = TA | one, tB = TB | one;
    const int cA = (int)__builtin_popcountll(__builtin_amdgcn_ballot_w64((a0 & m) == tA)) + (int)__builtin_popcountll(__builtin_amdgcn_ballot_w64((a1 & m) == tA));
    const int cB = (int)__builtin_popcountll(__builtin_amdgcn_ballot_w64((b0 & m) == tB)) + (int)__builtin_popcountll(__builtin_amdgcn_ballot_w64((b1 & m) == tB));
    if (abA + cA >= 16) TA = tA; else abA += cA;
    if (abB + cB >= 16) TB = tB; else abB += cB;
  }
  ta = pick16_sorted(a0, a1, TA, abA, lane, tmp);
  tb = pick16_sorted(b0, b1, TB, abB, lane, tmp + 32);
}
DEVN void ph_cvt_tables(const Params& p, int l, i64 gtid, i64 gsz) {
  const float4* u = (const float4*)(p.in[I_peer_u] + (size_t)l * NEXP * D); const float4* v = (const float4*)(p.in[I_peer_v] + (size_t)l * NEXP * D);
  unsigned* ub = (unsigned*)p.UbL(l); unsigned* vb = (unsigned*)p.VbL(l);
#pragma unroll 4
  for (i64 i = gtid; i < (i64)NEXP * D / 4; i += gsz) {
    const float4 a = u[i], b = v[i];
    int w = __builtin_amdgcn_cvt_pk_fp8_f32(a.x * 32.f, a.y * 32.f, 0, false); w = __builtin_amdgcn_cvt_pk_fp8_f32(a.z * 32.f, a.w * 32.f, w, true); ub[i] = (unsigned)w;
    int x = __builtin_amdgcn_cvt_pk_fp8_f32(b.x, b.y, 0, false); x = __builtin_amdgcn_cvt_pk_fp8_f32(b.z, b.w, x, true); vb[i] = (unsigned)x;
  }
}
DEV void unpack16_fp8(const uint4 w, float* f) {
#define UP4(W, O) { auto lo = __builtin_amdgcn_cvt_pk_f32_fp8((int)(W), false); auto hi = __builtin_amdgcn_cvt_pk_f32_fp8((int)(W), true); f[O] = lo[0]; f[O + 1] = lo[1]; f[O + 2] = hi[0]; f[O + 3] = hi[1]; }
  UP4(w.x, 0) UP4(w.y, 4) UP4(w.z, 8) UP4(w.w, 12)
#undef UP4
}
struct Sc4 { unsigned short a, b, c, d; };
DEV Sc4 peer_scores(const Params& p, int r, int wid, int lane) {
  const unsigned short* sp = (const unsigned short*)(p.SC() + ((size_t)r * 8 + wid) * 256);
  Sc4 q; q.a = sp[lane]; q.b = sp[64 + lane]; q.c = sp[128 + lane]; q.d = sp[192 + lane];
  return q;
}
struct Key4 { decltype(f16_key((unsigned short)0, 0)) a, b, c, d; };
DEV Key4 peer_keys(const Sc4 q, int lane) { Key4 k; k.a = f16_key(q.a, lane); k.b = f16_key(q.b, 64 + lane); k.c = f16_key(q.c, lane); k.d = f16_key(q.d, 64 + lane); return k; }
DEV void peer_topk(const Key4 k, int lane, int ca, int cb, bool cvalid, int* selx, int* tmp) {
  unsigned t1, t2;
  top16_x2(k.a, k.b, k.c, k.d, lane, tmp, t1, t2);
  const unsigned k1 = (unsigned)__builtin_amdgcn_ds_bpermute(ca << 2, (int)t1), k2 = (unsigned)__builtin_amdgcn_ds_bpermute(cb << 2, (int)t2);
  const float v = cvalid ? key_score(k1) + key_score(k2) : -3.0e38f;
  const int ib = __float_as_int(v);
  const unsigned ku = (((unsigned)ib ^ ((unsigned)(ib >> 31) | 0x80000000u)) & ~63u) | (unsigned)(63 - lane);
  int rank = 0;
#pragma unroll
  for (int c = 0; c < 50; ++c) {
    const unsigned ks = (unsigned)__builtin_amdgcn_readlane((int)ku, c);
    rank += (ks > ku) ? 1 : 0;
  }
  const unsigned long long m0 = __builtin_amdgcn_ballot_w64(cvalid && rank == 0);
  const float mx = __int_as_float(__builtin_amdgcn_readlane(ib, (int)__builtin_ctzll(m0)));
  const bool sel = cvalid && rank < 16;
  const float e = sel ? fexpf_(v - mx) : 0.f;
  float sum = e;
#pragma unroll
  for (int o = 32; o >= 1; o >>= 1) sum += lane_xor(sum, lane, o);
  if (sel) { selx[rank] = key_idx(k1) * 128 + key_idx(k2); selx[16 + rank] = __float_as_int(e / sum); }
}
DEVN void ph_peer(const Params& p, int l, int nrows, int tid, char* ldsg, float oscale = 1.0f) {
  const int lane = tid & 63, wid = tid >> 6;
  float* part = (float*)ldsg;
  int* selbase = (int*)(ldsg + 8 * 1024 * 4) + wid * 64;
  int* tktmp = (int*)(ldsg + 8 * 1024 * 4 + 8 * 64 * 4) + wid * 64;
  const unsigned char* Ub = p.UbL(l); const unsigned char* Vb = p.VbL(l);
  int ca = 0, cb = 0; bool cvalid = false;
  { int pre = 0;
    for (int a = 0; a < 16; ++a) { const int cnt = 16 / (a + 1); if (lane >= pre && lane < pre + cnt) { ca = a; cb = lane - pre; cvalid = true; } pre += cnt; } }
  int cur = 0;
  Sc4 nsc; nsc.a = nsc.b = nsc.c = nsc.d = 0;
  if ((int)blockIdx.x < nrows) {
    peer_topk(peer_keys(peer_scores(p, blockIdx.x, wid, lane), lane), lane, ca, cb, cvalid, selbase, tktmp);
    nsc = peer_scores(p, (int)(blockIdx.x + gridDim.x) < nrows ? (int)(blockIdx.x + gridDim.x) : (int)blockIdx.x, wid, lane);
  }
  for (int r = blockIdx.x; r < nrows; r += gridDim.x) {
    const int* selx = selbase + cur * 32;
    int eidx[16];
#pragma unroll
    for (int e = 0; e < 16; ++e) eidx[e] = __builtin_amdgcn_readfirstlane(selx[e]);
    const float mygate = __int_as_float(selx[16 + (lane >> 2)]);
    const bool more = r + (int)gridDim.x < nrows;
    const Key4 nkeys = peer_keys(nsc, lane);
    uint4 rows[16], vrows[16];
#pragma unroll
    for (int e = 0; e < 16; ++e) rows[e] = ((const uint4*)(Ub + (size_t)eidx[e] * D))[lane];
    uint4 hraw0, hraw1;
    { const uint4* hp = (const uint4*)(p.h() + (size_t)r * D); hraw0 = hp[lane * 2]; hraw1 = hp[lane * 2 + 1]; }
    __builtin_amdgcn_sched_barrier(0);
#pragma unroll
    for (int e = 0; e < 16; ++e) vrows[e] = ((const uint4*)(Vb + (size_t)eidx[e] * D))[lane];
    const float2 g2v = *(const float2*)(p.mods() + ((size_t)l * 3 + modrow(r)) * 6 * D + 5 * D + tid * 2);
    float2 xv = *(const float2*)(p.xcur() + (size_t)r * D + tid * 2);
    nsc = peer_scores(p, r + 2 * (int)gridDim.x < nrows ? r + 2 * (int)gridDim.x : r, wid, lane);
    if (more) peer_topk(nkeys, lane, ca, cb, cvalid, selbase + (cur ^ 1) * 32, tktmp);
    typedef __bf16 v2bf_t __attribute__((ext_vector_type(2)));
    const v2bf_t hb[8] = {__builtin_bit_cast(v2bf_t, hraw0.x), __builtin_bit_cast(v2bf_t, hraw0.y), __builtin_bit_cast(v2bf_t, hraw0.z), __builtin_bit_cast(v2bf_t, hraw0.w),
                          __builtin_bit_cast(v2bf_t, hraw1.x), __builtin_bit_cast(v2bf_t, hraw1.y), __builtin_bit_cast(v2bf_t, hraw1.z), __builtin_bit_cast(v2bf_t, hraw1.w)};
    float d[16];
#pragma unroll
    for (int e = 0; e < 16; ++e) {
      const unsigned wd[4] = {rows[e].x, rows[e].y, rows[e].z, rows[e].w};
      float a = 0.f;
#pragma unroll
      for (int dd = 0; dd < 4; ++dd) {
        a = __builtin_amdgcn_fdot2_f32_bf16(__builtin_amdgcn_cvt_scalef32_pk_bf16_fp8(wd[dd], 1.0f, false), hb[2 * dd], a, false);
        a = __builtin_amdgcn_fdot2_f32_bf16(__builtin_amdgcn_cvt_scalef32_pk_bf16_fp8(wd[dd], 1.0f, true), hb[2 * dd + 1], a, false);
      }
      d[e] = a;
    }
#define FOLD(NV, O) _Pragma("unroll") for (int i = 0; i < NV / 2; ++i) { const bool up = (lane & O) != 0; const float send = up ? d[i] : d[i + NV / 2]; const float keep = up ? d[i + NV / 2] : d[i]; d[i] = keep + lane_xor(send, lane, O); }
    FOLD(16, 32) FOLD(8, 16) FOLD(4, 8) FOLD(2, 4)
#undef FOLD
    float dot = d[0]; dot += lane_xor(dot, lane, 2); dot += lane_xor(dot, lane, 1);
    const float myact = mygate * geluf_(dot * (1.0f / 32.0f));
    float acc[16];
#pragma unroll
    for (int k = 0; k < 16; ++k) acc[k] = 0.f;
#pragma unroll
    for (int e = 0; e < 16; ++e) {
      const float a = __int_as_float(__builtin_amdgcn_readlane(__float_as_int(myact), e * 4));
      float f[16]; unpack16_fp8(vrows[e], f);
#pragma unroll
      for (int k = 0; k < 16; ++k) acc[k] += a * f[k];
    }
    float* partc = part + cur * ((8 * 1024 * 4 + 2 * 8 * 64 * 4) / 4);
    { float4* pw = (float4*)(partc + wid * 1024 + lane * 16);
      pw[0] = float4{acc[0], acc[1], acc[2], acc[3]}; pw[1] = float4{acc[4], acc[5], acc[6], acc[7]};
      pw[2] = float4{acc[8], acc[9], acc[10], acc[11]}; pw[3] = float4{acc[12], acc[13], acc[14], acc[15]}; }
    __syncthreads();
    { const int c = tid * 2;
      float s0 = 0.f, s1 = 0.f;
#pragma unroll
      for (int w = 0; w < 8; ++w) { const float2 t = *(const float2*)(partc + w * 1024 + c); s0 += t.x; s1 += t.y; }
      xv.x += oscale * g2v.x * s0; xv.y += oscale * g2v.y * s1; *(float2*)(p.xcur() + (size_t)r * D + c) = xv; }
    cur ^= 1;
  }
}
#endif

DEVN void ph_final(const Params& p, i64 gtid, i64 gsz) {
  const float* g = p.in[I_g_final];
#ifndef CPU_SIM
  float pscale = 1.0f;
#if PROBE_K >= 0
  { const unsigned long long* ts = (const unsigned long long*)(p.ws + WL.ts);
    const float frac = (float)(ts[PROBE_K + 1] - ts[0]) / (float)(ts[NPHASES - 1] - ts[0]);
    pscale = 1.0f + sqrtf(floorf(frac * 50.0f + 0.5f) * 0.02f); }
#endif
  const int lane = (int)(gtid & 63);
  const i64 W = gsz >> 6;
  float4 gv[4];
#pragma unroll
  for (int i = 0; i < 4; ++i) gv[i] = *(const float4*)(g + (lane + i * 64) * 4);
  for (i64 r = gtid >> 6; r < NLAT; r += 2 * W) {
    const bool two = r + W < NLAT;
    const i64 rb = two ? r + W : r;
    const float4* xra = (const float4*)(p.xcur() + (size_t)r * D); const float4* xrb = (const float4*)(p.xcur() + (size_t)rb * D);
    float4 xa[4], xb[4]; float sa = 0.f, sb = 0.f;
#pragma unroll
    for (int i = 0; i < 4; ++i) { xa[i] = xra[lane + i * 64]; xb[i] = xrb[lane + i * 64]; }
#pragma unroll
    for (int i = 0; i < 4; ++i) { sa += xa[i].x * xa[i].x + xa[i].y * xa[i].y + xa[i].z * xa[i].z + xa[i].w * xa[i].w; sb += xb[i].x * xb[i].x + xb[i].y * xb[i].y + xb[i].z * xb[i].z + xb[i].w * xb[i].w; }
#pragma unroll
    for (int o = 32; o >= 1; o >>= 1) { sa += lane_xor(sa, lane, o); sb += lane_xor(sb, lane, o); }
    const float rsa = 1.0f / sqrtf(sa * (1.0f / D) + EPS), rsb = 1.0f / sqrtf(sb * (1.0f / D) + EPS);
#pragma unroll
    for (int i = 0; i < 4; ++i) {
      const int k = (lane + i * 64) * 4;
      float4 o4; o4.x = xa[i].x * rsa * gv[i].x * pscale; o4.y = xa[i].y * rsa * gv[i].y * pscale; o4.z = xa[i].z * rsa * gv[i].z * pscale; o4.w = xa[i].w * rsa * gv[i].w * pscale;
      *(float4*)(p.out + (size_t)r * D + k) = o4;
    }
    if (two) {
#pragma unroll
      for (int i = 0; i < 4; ++i) {
        const int k = (lane + i * 64) * 4;
        float4 o4; o4.x = xb[i].x * rsb * gv[i].x * pscale; o4.y = xb[i].y * rsb * gv[i].y * pscale; o4.z = xb[i].z * rsb * gv[i].z * pscale; o4.w = xb[i].w * rsb * gv[i].w * pscale;
        *(float4*)(p.out + (size_t)rb * D + k) = o4;
      }
    }
  }
#else
  for (i64 r = gtid; r < NLAT; r += gsz) {
    const float* xr = p.xcur() + (size_t)r * D;
    float ss = 0.f;
    for (int k = 0; k < D; ++k) ss += xr[k] * xr[k];
    float rstd = 1.0f / sqrtf(ss / D + EPS);
    for (int k = 0; k < D; ++k) p.out[(size_t)r * D + k] = xr[k] * rstd * g[k];
  }
#endif
}

DEV void rope4(float* v, const float* tab, int nf, int pos, int f0) {
#pragma unroll
  for (int jj = 0; jj < 4; ++jj) {
    float c = tab[(pos * nf + f0 + jj) * 2], s = tab[(pos * nf + f0 + jj) * 2 + 1];
    float x1 = v[2 * jj], x2 = v[2 * jj + 1];
    v[2 * jj] = x1 * c - x2 * s; v[2 * jj + 1] = x1 * s + x2 * c;
  }
}
struct EpiInproj {
  static constexpr int W = 8; static constexpr bool SUB = false; static constexpr bool STAGED = false;
  const Params& p;
  MDEV void apply(int r, int c0, float* v) const {
    if (c0 >= 3744) return;
    if (c0 >= 384 && r < NLAT) {
      int t = r % N;
      if (c0 < C_KR + 32) { int pi = (c0 - C_KR) >> 1; int half = pi >> 3; rope4(v, p.tabA(), 8, half ? t % GRIDW : t / GRIDW, pi & 7); }
      else if (c0 >= C_GQ && c0 < C_GKV + 128) { int pi = ((c0 - C_GQ) & 63) >> 1; int half = pi >> 4; rope4(v, p.tabD(), 16, half ? t % GRIDW : t / GRIDW, pi & 15); }
    }
    store8bf(p.P() + (size_t)r * PC + c0, v);
  }
};
struct EpiUq {
  static constexpr int W = 8; static constexpr bool SUB = false; static constexpr bool STAGED = true; static constexpr bool STAGED_ALL = true;
  const Params& p;
  MDEV void apply(int r, int c0, float* v) const {
    float rstd = 1.0f / sqrtf(p.ssq()[r] * (1.0f / 256.0f) + EPS);
#pragma unroll
    for (int j = 0; j < 8; ++j) v[j] *= rstd;
    int d0 = c0 % 96;
    if (d0 >= 64 && r < NLAT) { int t = r % N; int pi = (d0 - 64) >> 1; int half = pi >> 3; rope4(v, p.tabA(), 8, half ? t % GRIDW : t / GRIDW, pi & 7); }
    store8bf(p.QA() + (size_t)r * 768 + c0, v);
  }
#ifndef CPU_SIM
  struct Pre { float s; float4 t0, t1; };
  MDEV void pre(int r, int c0, Pre& q) const {
    q.s = p.ssq()[r];
    const int d0 = c0 % 96;
    q.t0 = float4{1.f, 0.f, 1.f, 0.f}; q.t1 = q.t0;
    if (d0 >= 64 && r < NLAT) { const int t = r % N, pi = (d0 - 64) >> 1, half = pi >> 3; const int pos = half ? t % GRIDW : t / GRIDW;
      const float* tb = p.tabA() + (pos * 8 + (pi & 7)) * 2; q.t0 = *(const float4*)tb; q.t1 = *(const float4*)(tb + 4); }
  }
  MDEV void fin(int r, int c0, float* v, const Pre& q) const {
    const float rstd = 1.0f / sqrtf(q.s * (1.0f / 256.0f) + EPS);
    const float cs[8] = {q.t0.x, q.t0.y, q.t0.z, q.t0.w, q.t1.x, q.t1.y, q.t1.z, q.t1.w};
    float o[8];
#pragma unroll
    for (int jj = 0; jj < 4; ++jj) { const float x1 = v[2 * jj] * rstd, x2 = v[2 * jj + 1] * rstd, c = cs[2 * jj], sn = cs[2 * jj + 1]; o[2 * jj] = x1 * c - x2 * sn; o[2 * jj + 1] = x1 * sn + x2 * c; }
    store8bf(p.QA() + (size_t)r * 768 + c0, o);
  }
#endif
};
struct EpiUkv {
  static constexpr int W = 8; static constexpr bool SUB = false; static constexpr bool STAGED = true; static constexpr bool STAGED_ALL = true;
  const Params& p;
  MDEV void apply(int r, int c0, float* v) const {
    float rstd = 1.0f / sqrtf(p.ssq()[TT + r] * (1.0f / 128.0f) + EPS);
#pragma unroll
    for (int j = 0; j < 8; ++j) v[j] *= rstd;
    store8bf(p.KVA() + (size_t)r * 1024 + c0, v);
  }
#ifndef CPU_SIM
  struct Pre { float s; };
  MDEV void pre(int r, int, Pre& q) const { q.s = p.ssq()[TT + r]; }
  MDEV void fin(int r, int c0, float* v, const Pre& q) const {
    const float rstd = 1.0f / sqrtf(q.s * (1.0f / 128.0f) + EPS);
#pragma unroll
    for (int j = 0; j < 8; ++j) v[j] *= rstd;
    store8bf(p.KVA() + (size_t)r * 1024 + c0, v);
  }
#endif
};
struct EpiLru {
  static constexpr int W = 8; static constexpr bool SUB = false; static constexpr bool STAGED = true; static constexpr bool STAGED_ALL = true;
  const Params& p; int l; const float* br; const float* bi;
  MDEV void finish(int r, int c0, const float* v, const float* brv, const float* biv, const float* splv, const float* xcv) const {
    int kw = c0 >> 10, dir = (c0 >> 9) & 1, blk4 = (c0 >> 7) & 3, jc0 = (c0 & 127) >> 1;
    int cb = kw * 256 + blk4 * 64 + jc0;
    float lav[4], lbv[4];
#pragma unroll
    for (int jj = 0; jj < 4; ++jj) {
      float rg = sigmoidf_(v[2 * jj] + brv[jj]), ig = sigmoidf_(v[2 * jj + 1] + biv[jj]);
      float log_a = -8.0f * rg * splv[jj];
      const float a_ = fexpf_(log_a);
      lav[jj] = log_a; lbv[jj] = sqrtf(fmaxf(1.0f - a_ * a_, 0.0f)) * ig * xcv[jj];
    }
#ifndef CPU_SIM
    { uint4 w;
      w.x = pk2bf(lav[0], lbv[0]); w.y = pk2bf(lav[1], lbv[1]); w.z = pk2bf(lav[2], lbv[2]); w.w = pk2bf(lav[3], lbv[3]);
      *(uint4*)(p.LAB() + ((size_t)dir * TT + r) * 512 + cb) = w; }
#else
    bf* la = p.LA() + ((size_t)dir * TT + r) * 512 + cb;
    bf* lb = p.LB() + ((size_t)dir * TT + r) * 512 + cb;
    for (int jj = 0; jj < 4; ++jj) { la[jj] = f2b(lav[jj]); lb[jj] = f2b(lbv[jj]); }
#endif
  }
  MDEV void apply(int r, int c0, float* v) const {
    int kw = c0 >> 10, dir = (c0 >> 9) & 1, blk4 = (c0 >> 7) & 3, jc0 = (c0 & 127) >> 1;
    int cb = kw * 256 + blk4 * 64 + jc0;
    float brv[4], biv[4], splv[4], xcv[4];
    for (int jj = 0; jj < 4; ++jj) { brv[jj] = br[(l * 2 + dir) * 512 + cb + jj]; biv[jj] = bi[(l * 2 + dir) * 512 + cb + jj]; splv[jj] = p.spl()[(l * 2 + dir) * 512 + cb + jj]; xcv[jj] = b2f(p.XC()[(size_t)r * 512 + cb + jj]); }
    finish(r, c0, v, brv, biv, splv, xcv);
  }
#ifndef CPU_SIM
  struct Pre { float4 a4, b4, s4; uint2 x2; };
  MDEV void pre(int r, int c0, Pre& q) const {
    int kw = c0 >> 10, dir = (c0 >> 9) & 1, blk4 = (c0 >> 7) & 3, jc0 = (c0 & 127) >> 1;
    int cb = kw * 256 + blk4 * 64 + jc0;
    q.a4 = gld4(br + (l * 2 + dir) * 512 + cb); q.b4 = gld4(bi + (l * 2 + dir) * 512 + cb);
    q.s4 = *(const float4*)(p.spl() + (l * 2 + dir) * 512 + cb);
    q.x2 = *(const uint2*)(p.XC() + (size_t)r * 512 + cb);
  }
  MDEV void fin(int r, int c0, float* v, const Pre& q) const {
    const float brv[4] = {q.a4.x, q.a4.y, q.a4.z, q.a4.w}, biv[4] = {q.b4.x, q.b4.y, q.b4.z, q.b4.w}, splv[4] = {q.s4.x, q.s4.y, q.s4.z, q.s4.w};
    const float xcv[4] = {__uint_as_float(q.x2.x << 16), __uint_as_float(q.x2.x & 0xFFFF0000u), __uint_as_float(q.x2.y << 16), __uint_as_float(q.x2.y & 0xFFFF0000u)};
    finish(r, c0, v, brv, biv, splv, xcv);
  }
#endif
};
struct EpiGate {
  static constexpr int W = 8; static constexpr bool SUB = false; static constexpr bool STAGED = false;
  const Params& p;
  MDEV void apply(int r, int c0, float* v) const {
#pragma unroll
    for (int j = 0; j < 8; ++j) v[j] = sigmoidf_(v[j]);
    store8bf(p.Gs() + (size_t)r * D + c0, v);
  }
};
struct EpiBranch {
  static constexpr int W = 8; static constexpr bool SUB = false; static constexpr bool STAGED = false;
  const Params& p; int br;
  MDEV void apply(int r, int c0, float* v) const {
    float g[8]; load8bf(p.Gs() + (size_t)r * D + c0, g);
    if (br > 0) {
      float mo[8]; load8bf(p.M() + (size_t)r * D + c0, mo);
#pragma unroll
      for (int j = 0; j < 8; ++j) v[j] = mo[j] + g[j] * v[j];
    } else {
#pragma unroll
      for (int j = 0; j < 8; ++j) v[j] = g[j] * v[j];
    }
    store8bf(p.M() + (size_t)r * D + c0, v);
  }
};
struct EpiGateAll {
  static constexpr int W = 8; static constexpr bool SUB = false; static constexpr bool STAGED = false;
  const Params& p;
  MDEV void apply(int r, int c0, float* v) const {
#pragma unroll
    for (int j = 0; j < 8; ++j) v[j] = sigmoidf_(v[j]) * 255.f + 0.5f;
    unsigned char* gq = p.G8() + (size_t)r * 4096 + c0;
#ifndef CPU_SIM
    uint2 w;
    w.x = (unsigned)v[0] | ((unsigned)v[1] << 8) | ((unsigned)v[2] << 16) | ((unsigned)v[3] << 24);
    w.y = (unsigned)v[4] | ((unsigned)v[5] << 8) | ((unsigned)v[6] << 16) | ((unsigned)v[7] << 24);
    *(uint2*)gq = w;
#else
    for (int j = 0; j < 8; ++j) gq[j] = (unsigned char)v[j];
#endif
  }
};
struct EpiBranchSub {
  static constexpr int W = 8; static constexpr bool SUB = true; static constexpr bool STAGED = true; static constexpr bool STAGED_ALL = false;
  const Params& p;
  MDEV void apply(int, int, float*) const {}
  MDEV void gate8(int r, int c0, int i, float* g) const {
    const unsigned char* gq = p.G8() + (size_t)r * 4096 + i * 1024 + c0;
#ifndef CPU_SIM
    const uint2 w = *(const uint2*)gq;
#pragma unroll
    for (int j = 0; j < 4; ++j) { g[j] = (float)((w.x >> (8 * j)) & 255u) * (1.0f / 255.0f); g[4 + j] = (float)((w.y >> (8 * j)) & 255u) * (1.0f / 255.0f); }
#else
    for (int j = 0; j < 8; ++j) g[j] = (float)gq[j] * (1.0f / 255.0f);
#endif
  }
  MDEV void apply_sub(int r, int c0, float* v, int sub) const {
    if (sub < 3) { store8bf(p.BR() + (size_t)r * 3072 + sub * 1024 + c0, v); return; }
    float g[8]; gate8(r, c0, 3, g);
#pragma unroll
    for (int j = 0; j < 8; ++j) v[j] *= g[j];
#pragma unroll
    for (int i = 0; i < 3; ++i) {
      float bi[8]; load8bf(p.BR() + (size_t)r * 3072 + i * 1024 + c0, bi);
      gate8(r, c0, i, g);
#pragma unroll
      for (int j = 0; j < 8; ++j) v[j] += g[j] * bi[j];
    }
    store8bf(p.M() + (size_t)r * D + c0, v);
  }
#ifndef CPU_SIM
  struct Pre { uint2 g[4]; uint4 b[3]; };
  MDEV void pre(int r, int c0, Pre& q) const {
#pragma unroll
    for (int i = 0; i < 4; ++i) q.g[i] = *(const uint2*)(p.G8() + (size_t)r * 4096 + i * 1024 + c0);
#pragma unroll
    for (int i = 0; i < 3; ++i) q.b[i] = *(const uint4*)(p.BR() + (size_t)r * 3072 + i * 1024 + c0);
  }
  MDEV void fin(int r, int c0, float* v, const Pre& q) const {
#pragma unroll
    for (int i = 3; i >= 0; --i) {
      float g[8];
#pragma unroll
      for (int j = 0; j < 4; ++j) { g[j] = (float)((q.g[i].x >> (8 * j)) & 255u) * (1.0f / 255.0f); g[4 + j] = (float)((q.g[i].y >> (8 * j)) & 255u) * (1.0f / 255.0f); }
      if (i == 3) {
#pragma unroll
        for (int j = 0; j < 8; ++j) v[j] *= g[j];
      } else {
        float bi[8]; unpack8(q.b[i], bi);
#pragma unroll
        for (int j = 0; j < 8; ++j) v[j] += g[j] * bi[j];
      }
    }
    store8bf(p.M() + (size_t)r * D + c0, v);
  }
#endif
};
struct EpiFilt {
  static constexpr int W = 8; static constexpr bool SUB = false; static constexpr bool STAGED = false;
  const Params& p;
  MDEV void apply(int j, int tt, float* v) const {
    const float maxd = -15.350567286626973f, mind = -3.0701134573253945f;
    const float ad = fabsf(mind + (float)j * ((maxd - mind) / 1023.0f));
    int t, L; if (tt < N) { t = tt; L = N; } else { t = tt - N; L = LC; }
    const float sc = -ad / (float)(L - 1);
#pragma unroll
    for (int q = 0; q < 8; ++q) v[q] *= fexpf_((float)(t + q) * sc);
    float* d = p.F() + (size_t)j * (N + LC) + tt;
#ifndef CPU_SIM
    *(float4*)d = float4{v[0], v[1], v[2], v[3]}; *(float4*)(d + 4) = float4{v[4], v[5], v[6], v[7]};
#else
    for (int q = 0; q < 8; ++q) d[q] = v[q];
#endif
  }
};
struct EpiOut {
  static constexpr int W = 8; static constexpr bool SUB = false; static constexpr bool STAGED = true; static constexpr bool STAGED_ALL = true;
  const Params& p; int l; float osc; const float* xlat; const float* xctx;
  MDEV void apply(int r, int c0, float* v) const {
    const float* g1 = p.mods() + ((size_t)l * 3 + modrow(r)) * 6 * D + 2 * D + c0;
    const float* xs = (r < NLAT ? xlat + (size_t)r * D : xctx + (size_t)(r - NLAT) * D) + c0;
    float* xr = p.xcur() + (size_t)r * D + c0;
    for (int j = 0; j < 8; ++j) xr[j] = xs[j] + osc * g1[j] * v[j];
  }
#ifndef CPU_SIM
  struct Pre { float4 g0, g1, x0, x1; };
  MDEV void pre(int r, int c0, Pre& q) const {
    const float* g1 = p.mods() + ((size_t)l * 3 + modrow(r)) * 6 * D + 2 * D + c0;
    const float* xs = (r < NLAT ? xlat + (size_t)r * D : xctx + (size_t)(r - NLAT) * D) + c0;
    q.g0 = *(const float4*)g1; q.g1 = *(const float4*)(g1 + 4); q.x0 = gld4(xs); q.x1 = gld4(xs + 4);
  }
  MDEV void fin(int r, int c0, float* v, const Pre& q) const {
    float* xr = p.xcur() + (size_t)r * D + c0;
    float4 o0, o1;
    o0.x = q.x0.x + osc * q.g0.x * v[0]; o0.y = q.x0.y + osc * q.g0.y * v[1]; o0.z = q.x0.z + osc * q.g0.z * v[2]; o0.w = q.x0.w + osc * q.g0.w * v[3];
    o1.x = q.x1.x + osc * q.g1.x * v[4]; o1.y = q.x1.y + osc * q.g1.y * v[5]; o1.z = q.x1.z + osc * q.g1.z * v[6]; o1.w = q.x1.w + osc * q.g1.w * v[7];
    *(float4*)xr = o0; *(float4*)(xr + 4) = o1;
  }
#endif
};
struct EpiPQ {
  static constexpr int W = 8; static constexpr bool SUB = false; static constexpr bool STAGED = false;
  const Params& p;
  MDEV void apply(int r, int c0, float* v) const { store8bf(p.PQ() + (size_t)r * 1024 + c0, v); }
};
struct EpiSC {
  static constexpr int W = 8; static constexpr bool SUB = false; static constexpr bool STAGED = false;
  const Params& p;
  MDEV void apply(int r, int c0, float* v) const {
    sc_t* d = p.SC() + (size_t)r * 2048 + c0;
#ifndef CPU_SIM
    typedef _Float16 half8 __attribute__((ext_vector_type(8)));
    half8 hv8;
#pragma unroll
    for (int j = 0; j < 8; ++j) hv8[j] = (_Float16)v[j];
    *(half8*)d = hv8;
#else
    for (int j = 0; j < 8; ++j) d[j] = (sc_t)v[j];
#endif
  }
};

struct GemmDesc { const bf* A; const bf* Bt; int lda, ldb, K, nrows, ncols; int a_pn_shift, a_pn_mul; int nsub = 1, a_sub = 0, b_sub = 0; int unit_off = 0; };

#ifndef CPU_SIM
namespace pg8 {
#define PG8_LAS __attribute__((address_space(3)))
typedef short bf16x8 __attribute__((ext_vector_type(8)));
typedef float f32x4 __attribute__((ext_vector_type(4)));
constexpr int BM = 256, BK = 64, HALF = 128, HTB = HALF * BK * 2, STAGE_BYTES = 8 * HTB, NXCD = 8, WGM = 8;
__device__ __forceinline__ int lds_byte(int r, int c) { const int st = (r >> 4) * 2 + (c >> 5), rr = r & 15, cc = c & 31, ob = rr * 64 + cc * 2; return st * 1024 + (ob ^ (((ob >> 9) & 1) << 5)); }
__device__ __forceinline__ void stage_rc(int b, int& R, int& C) { const int st = b / 1024, sb = b % 1024, swz = sb ^ (((sb >> 9) & 1) << 5); R = (st >> 1) * 16 + swz / 64; C = (st & 1) * 32 + (swz % 64) / 2; }
__device__ __forceinline__ int perm32(int rho) { const int n = rho >> 4, i = rho & 15; return 8 * (i >> 2) + 4 * n + (i & 3); }
struct Unit { int pm, pn, sub; };
struct StaticOrder {
  int nM, nN, nwg, G, c, nsub;
  __device__ void init(int nM_, int nN_, int G_, int c_, int nsub_) { nM = nM_; nN = nN_; nwg = nM * nN; G = G_; c = c_; nsub = nsub_; }
  __device__ bool next(int i, Unit& u) const {
    const int it = i / nsub; u.sub = i - it * nsub;
    const long L = (long)it * G + c; if (L >= nwg) return false;
    int wgid = (int)L; { const int q = nwg / NXCD, r = nwg % NXCD, xcd = wgid % NXCD, off = wgid / NXCD; wgid = (xcd < r ? xcd * (q + 1) : r * (q + 1) + (xcd - r) * q) + off; }
    const int nig = WGM * nN, gid = wgid / nig, fm = gid * WGM, gsz = (nM - fm) < WGM ? (nM - fm) : WGM;
    u.pm = fm + ((wgid % nig) % gsz); u.pn = (wgid % nig) / gsz; return true;
  }
};

template <class E>
__device__ __forceinline__ void epi_call(const E& e, const f32x4 (&acc)[2][2][4][2], const Unit& u, int wr, int wc, int fr_, int fq_) {
  int fr = fr_, fq = fq_;
  asm volatile("" : "+v"(fr), "+v"(fq));
  if constexpr (E::STAGED) {
    if (E::STAGED_ALL || u.sub == 3) {
#pragma unroll
      for (int ai = 0; ai < 2; ++ai)
#pragma unroll
        for (int m = 0; m < 4; ++m) {
          typename E::Pre q[2];
#pragma unroll
          for (int bj = 0; bj < 2; ++bj) { q[bj] = typename E::Pre{}; e.pre(u.pm * BM + ai * HALF + wr * 64 + m * 16 + fr, u.pn * BM + bj * HALF + wc * 32 + 8 * fq, q[bj]); }
#pragma unroll
          for (int bj = 0; bj < 2; ++bj) {
            float v[8];
#pragma unroll
            for (int j = 0; j < 4; ++j) { v[j] = acc[ai][bj][m][0][j]; v[4 + j] = acc[ai][bj][m][1][j]; }
            e.fin(u.pm * BM + ai * HALF + wr * 64 + m * 16 + fr, u.pn * BM + bj * HALF + wc * 32 + 8 * fq, v, q[bj]);
          }
          __builtin_amdgcn_sched_barrier(0);
        }
      return;
    }
  }
#pragma unroll
  for (int ai = 0; ai < 2; ++ai)
#pragma unroll
    for (int m = 0; m < 4; ++m) {
      const int r = u.pm * BM + ai * HALF + wr * 64 + m * 16 + fr;
#pragma unroll
      for (int bj = 0; bj < 2; ++bj) {
        if constexpr (E::W == 8) {
          const int c0 = u.pn * BM + bj * HALF + wc * 32 + 8 * fq;
          float v[8];
#pragma unroll
          for (int j = 0; j < 4; ++j) { v[j] = acc[ai][bj][m][0][j]; v[4 + j] = acc[ai][bj][m][1][j]; }
          if constexpr (E::W == 8 && E::SUB) e.apply_sub(r, c0, v, u.sub); else e.apply(r, c0, v);
        } else {
#pragma unroll
          for (int n = 0; n < 2; ++n) {
            const int c0 = u.pn * BM + bj * HALF + wc * 32 + 16 * n + 4 * fq;
            float v[4];
#pragma unroll
            for (int j = 0; j < 4; ++j) v[j] = acc[ai][bj][m][n][j];
            e.apply(r, c0, v);
          }
        }
      }
      if (m == 1 || m == 3) __builtin_amdgcn_sched_barrier(0);
    }
}

template <class Epi>
__device__ __forceinline__ void gemm_phase(PG8_LAS unsigned char* lds, const int tid, const GemmDesc g, const Epi& E) {
  constexpr bool PERM = (Epi::W == 8);
  const int wid = __builtin_amdgcn_readfirstlane(tid >> 6), lane = tid & 63, wr = wid >> 2, wc = wid & 3, fr = lane & 15, fq = lane >> 4;
  const int K = g.K, nt = K / BK;
  StaticOrder S; S.init(g.nrows / BM, g.ncols / BM, (int)gridDim.x, (int)((blockIdx.x + gridDim.x - (unsigned)g.unit_off % gridDim.x) % gridDim.x), g.nsub);
  unsigned voffA[2], voffB[2];
#pragma unroll
  for (int i = 0; i < 2; ++i) { int R, C; stage_rc(tid * 16 + i * 8192, R, C); const int Rb = PERM ? ((R & ~31) + perm32(R & 31)) : R;
    voffA[i] = (unsigned)(R * g.lda + C) * 2u; voffB[i] = (unsigned)(Rb * g.ldb + C) * 2u; }
  const size_t kstep = (size_t)(BK * 2);
  const size_t hstepA = (size_t)HALF * g.lda * 2, hstepB = (size_t)HALF * g.ldb * 2;
  const unsigned ldsw = (unsigned)wid * 1024u;
  const int aoff = lds_byte(wr * 64 + fr, fq * 8), boff = lds_byte(wc * 32 + fr, fq * 8);
#define PG8_SA(b, h) (((b) * 2 + (h)) * HTB)
#define PG8_SB(b, h) ((4 + (b) * 2 + (h)) * HTB)
#define PG8_STAGE(bufoff, gbase, voff) do { _Pragma("unroll") for (int _i = 0; _i < 2; ++_i) \
        __builtin_amdgcn_global_load_lds((const unsigned*)((const char*)(gbase) + (voff)[_i]), (PG8_LAS unsigned*)(lds + (bufoff) + ldsw + _i * 8192), 16, 0, 0); } while (0)
#define PG8_LDA(dst, b, h) do { _Pragma("unroll") for (int m = 0; m < 4; ++m) _Pragma("unroll") for (int k = 0; k < 2; ++k) dst[m][k] = *(const PG8_LAS bf16x8*)(lds + PG8_SA(b, h) + aoff + m * 2048 + k * 1024); } while (0)
#define PG8_LDB(dst, b, h) do { _Pragma("unroll") for (int n = 0; n < 2; ++n) _Pragma("unroll") for (int k = 0; k < 2; ++k) dst[n][k] = *(const PG8_LAS bf16x8*)(lds + PG8_SB(b, h) + boff + n * 2048 + k * 1024); } while (0)
#define PG8_MMA(ai, bj, At, Bt) do { __builtin_amdgcn_s_setprio(1); _Pragma("unroll") for (int m = 0; m < 4; ++m) _Pragma("unroll") for (int n = 0; n < 2; ++n) _Pragma("unroll") for (int k = 0; k < 2; ++k) \
        acc[ai][bj][m][n] = __builtin_amdgcn_mfma_f32_16x16x32_bf16(Bt[n][k], At[m][k], acc[ai][bj][m][n], 0, 0, 0); __builtin_amdgcn_s_setprio(0); } while (0)
#define PG8_WAIT_V(n) asm volatile("s_waitcnt vmcnt(" #n ")" ::: "memory")
#define PG8_WAIT_L(n) asm volatile("s_waitcnt lgkmcnt(" #n ")" ::: "memory")
#define PG8_BAR __builtin_amdgcn_s_barrier()
#define PG8_SCHED __builtin_amdgcn_sched_barrier(0)
#define PG8_ABASE(u) ((const char*)g.A + ((size_t)(u).pm * BM * g.lda + (size_t)((u).pn >> g.a_pn_shift) * g.a_pn_mul + (size_t)(u).sub * g.a_sub) * 2)
#define PG8_BBASE(u) ((const char*)g.Bt + ((size_t)(u).pn * BM * g.ldb + (size_t)(u).sub * g.b_sub) * 2)
  Unit cur, nxt; int ui = 0;
  if (!S.next(0, cur)) return;
  f32x4 acc[2][2][4][2];
#pragma unroll
  for (int a = 0; a < 2; ++a)
#pragma unroll
    for (int b = 0; b < 2; ++b)
#pragma unroll
      for (int m = 0; m < 4; ++m)
#pragma unroll
        for (int n = 0; n < 2; ++n) acc[a][b][m][n] = (f32x4){0.f, 0.f, 0.f, 0.f};
  bf16x8 At[4][2], B0[2][2], B1[2][2];
  const char* cA = PG8_ABASE(cur); const char* cB = PG8_BBASE(cur);
  asm volatile("" : "+v"(voffA[0]), "+v"(voffA[1]), "+v"(voffB[0]), "+v"(voffB[1]));
  PG8_STAGE(PG8_SB(0, 0), cB, voffB); PG8_STAGE(PG8_SA(0, 0), cA, voffA); PG8_STAGE(PG8_SB(0, 1), cB + hstepB, voffB); PG8_STAGE(PG8_SA(0, 1), cA + hstepA, voffA);
  if (wr == 1) PG8_BAR;
  PG8_WAIT_V(4); PG8_BAR;
  PG8_STAGE(PG8_SB(1, 0), cB + kstep, voffB); PG8_STAGE(PG8_SA(1, 0), cA + kstep, voffA); PG8_STAGE(PG8_SB(1, 1), cB + hstepB + kstep, voffB);
  PG8_WAIT_V(6); PG8_BAR;
  for (;;) {
    const bool has_next = S.next(ui + 1, nxt);
    const char* nA = has_next ? PG8_ABASE(nxt) : cA; const char* nB = has_next ? PG8_BBASE(nxt) : cB;
    for (int t = 0; t < nt; t += 2) {
      const bool last = (t == nt - 2);
      asm volatile("" : "+v"(voffA[0]), "+v"(voffA[1]), "+v"(voffB[0]), "+v"(voffB[1]));
      const char* a1 = cA + (size_t)(t + 1) * kstep;
      const char* a2 = last ? nA : cA + (size_t)(t + 2) * kstep; const char* b2 = last ? nB : cB + (size_t)(t + 2) * kstep;
      const char* a3 = a2 + kstep; const char* b3 = b2 + kstep;
      PG8_LDB(B0, 0, 0); PG8_SCHED; PG8_LDA(At, 0, 0); PG8_STAGE(PG8_SA(1, 1), a1 + hstepA, voffA);
      PG8_WAIT_L(8); PG8_BAR; PG8_WAIT_L(0); PG8_MMA(0, 0, At, B0); PG8_BAR; PG8_SCHED;
      PG8_LDB(B1, 0, 1); PG8_STAGE(PG8_SB(0, 0), b2, voffB);
      PG8_BAR; PG8_WAIT_L(0); PG8_MMA(0, 1, At, B1); PG8_BAR;
      PG8_LDA(At, 0, 1); PG8_STAGE(PG8_SA(0, 0), a2, voffA);
      PG8_BAR; PG8_WAIT_L(0); PG8_MMA(1, 0, At, B0); PG8_BAR; PG8_SCHED;
      PG8_STAGE(PG8_SB(0, 1), b2 + hstepB, voffB);
      PG8_WAIT_V(6); PG8_BAR; PG8_MMA(1, 1, At, B1); PG8_BAR;
      PG8_LDB(B0, 1, 0); PG8_SCHED; PG8_LDA(At, 1, 0); PG8_STAGE(PG8_SA(0, 1), a2 + hstepA, voffA);
      PG8_WAIT_L(8); PG8_BAR; PG8_WAIT_L(0); PG8_MMA(0, 0, At, B0); PG8_BAR; PG8_SCHED;
      PG8_LDB(B1, 1, 1); PG8_STAGE(PG8_SB(1, 0), b3, voffB);
      PG8_BAR; PG8_WAIT_L(0); PG8_MMA(0, 1, At, B1); PG8_BAR;
      PG8_LDA(At, 1, 1); PG8_STAGE(PG8_SA(1, 0), a3, voffA);
      PG8_BAR; PG8_WAIT_L(0); PG8_MMA(1, 0, At, B0); PG8_BAR; PG8_SCHED;
      PG8_STAGE(PG8_SB(1, 1), b3 + hstepB, voffB);
      PG8_WAIT_V(6); PG8_BAR; PG8_MMA(1, 1, At, B1); PG8_BAR;
    }
    epi_call(E, acc, cur, wr, wc, fr, fq);
    if (!has_next) break;
#pragma unroll
    for (int a = 0; a < 2; ++a)
#pragma unroll
      for (int b = 0; b < 2; ++b)
#pragma unroll
        for (int m = 0; m < 4; ++m)
#pragma unroll
          for (int n = 0; n < 2; ++n) acc[a][b][m][n] = (f32x4){0.f, 0.f, 0.f, 0.f};
    cur = nxt; cA = nA; cB = nB; ++ui;
  }
  PG8_WAIT_V(0);
  if (wr == 0) PG8_BAR;
  PG8_BAR;
#undef PG8_SA
#undef PG8_SB
#undef PG8_STAGE
#undef PG8_LDA
#undef PG8_LDB
#undef PG8_MMA
#undef PG8_WAIT_V
#undef PG8_WAIT_L
#undef PG8_BAR
#undef PG8_SCHED
#undef PG8_ABASE
#undef PG8_BBASE
}
}
struct Ctx { i64 gtid, gsz; PG8_LAS unsigned char* lds; char* ldsg; int tid; };
template <class E> DEV void run_gemm(const Ctx& cx, const GemmDesc& g, const E& e) { pg8::gemm_phase<E>(cx.lds, cx.tid, g, e); }
#else
struct Ctx { i64 gtid, gsz; };
template <class E> static void run_gemm(const Ctx& cx, const GemmDesc& g, const E& e) {
  constexpr int W = E::W;
  const int ng = g.ncols / W;
  for (i64 i = cx.gtid; i < (i64)g.nrows * ng; i += cx.gsz) {
    int r = (int)(i / ng), c0 = (int)(i % ng) * W;
    int pn = c0 / 256;
    for (int sub = 0; sub < g.nsub; ++sub) {
      const bf* a = g.A + (size_t)r * g.lda + (size_t)(pn >> g.a_pn_shift) * g.a_pn_mul + (size_t)sub * g.a_sub;
      float v[8];
      for (int j = 0; j < W; ++j) {
        const bf* b = g.Bt + (size_t)(c0 + j) * g.ldb + (size_t)sub * g.b_sub;
        float acc = 0.f;
        for (int k = 0; k < g.K; ++k) acc += b2f(a[k]) * b2f(b[k]);
        v[j] = acc;
      }
      if constexpr (E::SUB) e.apply_sub(r, c0, v, sub); else e.apply(r, c0, v);
    }
  }
}
#endif


#ifndef CPU_SIM
namespace fa {
using bf16x8 = __attribute__((ext_vector_type(8))) short;
using s16x4 = __attribute__((ext_vector_type(4))) short;
using f32x16 = __attribute__((ext_vector_type(16))) float;
using u32x4 = __attribute__((ext_vector_type(4))) unsigned;
constexpr int KVBLK = 64, QBLK = 32;
constexpr float THR = 8.f;
constexpr int SHM_V = KVBLK * 128 * 2, SHM_K = KVBLK * 128 * 2;
constexpr int NBUF = 3;
constexpr int SHM_ATTN = NBUF * SHM_V + NBUF * SHM_K + 8 * 64 * 4;
#define KSWZ(row, colB) ((row) * 256 + ((colB) ^ (((row) & 7) << 4)))
#define SBAR() __builtin_amdgcn_sched_barrier(0)
__device__ __forceinline__ int crow(int r, int hi) { return (r & 3) + 8 * (r >> 2) + 4 * hi; }
__device__ __forceinline__ unsigned cvtpk(float lo, float hi) { unsigned r; asm volatile("v_cvt_pk_bf16_f32 %0, %1, %2" : "=v"(r) : "v"(lo), "v"(hi)); return r; }
template <int SC1000000> __device__ __forceinline__ void partialSM(f32x16& p0, f32x16& p1, float& m_reg, float& mn, float& alpha) {
  constexpr float SCALE = SC1000000 * 1e-9f; constexpr float C = SCALE * 1.4426950408889634f;
  float pmax = p0[0];
#pragma unroll
  for (int r = 1; r < 16; ++r) pmax = fmaxf(pmax, p0[r]);
#pragma unroll
  for (int r = 0; r < 16; ++r) pmax = fmaxf(pmax, p1[r]);
  { auto rr = __builtin_amdgcn_permlane32_swap(__float_as_uint(pmax), __float_as_uint(pmax), false, false);
    pmax = fmaxf(__uint_as_float(rr[0]), __uint_as_float(rr[1])); }
  if (__builtin_expect(__all(pmax - m_reg <= THR / SCALE), 1)) { mn = m_reg; alpha = 1.f; }
  else { mn = fmaxf(m_reg, pmax); alpha = __builtin_amdgcn_exp2f((m_reg - mn) * C); m_reg = mn; }
  float mnC = -mn * C;
#pragma unroll
  for (int r = 0; r < 16; ++r) p0[r] = fmaf(p0[r], C, mnC);
#pragma unroll
  for (int r = 0; r < 16; ++r) p1[r] = fmaf(p1[r], C, mnC);
#pragma unroll
  for (int r = 0; r < 16; ++r) p0[r] = __builtin_amdgcn_exp2f(p0[r]);
}
__device__ __forceinline__ void finishSM(f32x16& p0, f32x16& p1, float alpha, float& l_reg, bf16x8& pa0, bf16x8& pa1, bf16x8& pa2, bf16x8& pa3) {
#pragma unroll
  for (int r = 0; r < 16; ++r) p1[r] = __builtin_amdgcn_exp2f(p1[r]);
  float ps = 0;
#pragma unroll
  for (int r = 0; r < 16; ++r) ps += p0[r];
#pragma unroll
  for (int r = 0; r < 16; ++r) ps += p1[r];
  { auto rr = __builtin_amdgcn_permlane32_swap(__float_as_uint(ps), __float_as_uint(ps), false, false);
    ps = __uint_as_float(rr[0]) + __uint_as_float(rr[1]); }
  l_reg = l_reg * alpha + ps;
#define PK4(P, BASE, OUT) do { unsigned a0 = cvtpk(P[BASE + 0], P[BASE + 1]), a1 = cvtpk(P[BASE + 2], P[BASE + 3]);   \
    unsigned b0 = cvtpk(P[BASE + 4], P[BASE + 5]), b1 = cvtpk(P[BASE + 6], P[BASE + 7]);                              \
    auto r0 = __builtin_amdgcn_permlane32_swap(a0, b0, false, false); auto r1 = __builtin_amdgcn_permlane32_swap(a1, b1, false, false); \
    u32x4 w = {r0[0], r1[0], r0[1], r1[1]}; OUT = *reinterpret_cast<bf16x8*>(&w); } while (0)
  PK4(p0, 0, pa0); PK4(p0, 8, pa1); PK4(p1, 0, pa2); PK4(p1, 8, pa3);
#undef PK4
}
template <int NK16>
__device__ __forceinline__ void qkt(f32x16& p0, f32x16& p1, const char* Ks, const bf16x8* qr, int r32, int hi) {
  p0 = f32x16{}; p1 = f32x16{};
#pragma unroll
  for (int d0 = 0; d0 < NK16; ++d0) { int cb = (d0 * 16 + hi * 8) * 2;
    bf16x8 b0 = *reinterpret_cast<const bf16x8*>(Ks + KSWZ(r32, cb));
    bf16x8 b1 = *reinterpret_cast<const bf16x8*>(Ks + KSWZ(32 + r32, cb));
    p0 = __builtin_amdgcn_mfma_f32_32x32x16_bf16(b0, qr[d0], p0, 0, 0, 0);
    p1 = __builtin_amdgcn_mfma_f32_32x32x16_bf16(b1, qr[d0], p1, 0, 0, 0); }
}
__device__ __forceinline__ int v_st(int k, int c) { const int kk = (k & ~0xC) | ((k & 4) << 1) | ((k & 8) >> 1); return ((kk >> 3) * 4 + (c >> 5)) * 512 + ((kk & 7) * 32 + (c & 31)) * 2; }
__device__ __forceinline__ int v_rd_base(int lane) { return ((lane & 3) << 3) | (((lane >> 2) & 3) << 6) | (((lane >> 4) & 1) << 5) | (((lane >> 5) & 1) << 8); }
constexpr int v_rd_off(int d0, int ks, int half) { return d0 * 512 + ks * 4096 + half * 2048; }
template <int OFF> __device__ __forceinline__ s16x4 tr_read(int vb) {
  s16x4 r; asm volatile("ds_read_b64_tr_b16 %0, %1 offset:%2" : "=&v"(r) : "v"(vb), "i"(OFF) : "memory"); return r;
}
template <int D0> __device__ __forceinline__ void pv_one(f32x16& od, int vb, bf16x8 pa0, bf16x8 pa1, bf16x8 pa2, bf16x8 pa3) {
  const s16x4 l0 = tr_read<v_rd_off(D0, 0, 0)>(vb), h0 = tr_read<v_rd_off(D0, 0, 1)>(vb), l1 = tr_read<v_rd_off(D0, 1, 0)>(vb), h1 = tr_read<v_rd_off(D0, 1, 1)>(vb);
  const s16x4 l2 = tr_read<v_rd_off(D0, 2, 0)>(vb), h2 = tr_read<v_rd_off(D0, 2, 1)>(vb), l3 = tr_read<v_rd_off(D0, 3, 0)>(vb), h3 = tr_read<v_rd_off(D0, 3, 1)>(vb);
  asm volatile("s_waitcnt lgkmcnt(0)" ::: "memory"); SBAR();
#define PK(L, H) (bf16x8){L[0], L[1], L[2], L[3], H[0], H[1], H[2], H[3]}
  od = __builtin_amdgcn_mfma_f32_32x32x16_bf16(pa0, PK(l0, h0), od, 0, 0, 0);
  od = __builtin_amdgcn_mfma_f32_32x32x16_bf16(pa1, PK(l1, h1), od, 0, 0, 0);
  od = __builtin_amdgcn_mfma_f32_32x32x16_bf16(pa2, PK(l2, h2), od, 0, 0, 0);
  od = __builtin_amdgcn_mfma_f32_32x32x16_bf16(pa3, PK(l3, h3), od, 0, 0, 0);
#undef PK
}
__device__ __forceinline__ void pv_d0(f32x16* o, int vb, bf16x8 pa0, bf16x8 pa1, bf16x8 pa2, bf16x8 pa3) {
  pv_one<0>(o[0], vb, pa0, pa1, pa2, pa3); pv_one<1>(o[1], vb, pa0, pa1, pa2, pa3);
}

struct Src { const bf* q; int qstride; const bf* ksrc; int kstride; const bf* vsrc; int vstride; bf* out; float m0, l0; int dq0; };
template <int NK16, int SC1000000, bool MASK>
__device__ __forceinline__ void unit(const Src& sd, const int tid, char* lds, int kbase0, int nt0, int kbase1, int NT) {
  const int wid = tid >> 6, lane = tid & 63, r32 = lane & 31, hi = lane >> 5;
  char* V_lds = lds; char* K_lds = lds + NBUF * SHM_V;
  float* wsl = (float*)(lds + NBUF * SHM_V + NBUF * SHM_K) + wid * 64; float* li_l = wsl; float* al_l = wsl + 32;
  float m_reg = sd.m0, l_reg = sd.l0; f32x16 o[2] = {}; bf16x8 qr[NK16];
  const bf* Qw = sd.q + (size_t)(wid * QBLK + r32) * sd.qstride + hi * 8;
#pragma unroll
  for (int d0 = 0; d0 < NK16; ++d0) qr[d0] = *reinterpret_cast<const bf16x8*>(Qw + d0 * 16);
  const int sr = tid >> 4, sc = (tid & 15) * 8, vst0 = v_st(sr, sc), vst1 = v_st(32 + sr, sc);
  const int vb0 = (int)(uintptr_t)V_lds + v_rd_base(lane);
  const bf* ksrc = sd.ksrc; const int kstride = sd.kstride; const bf* vsrc = sd.vsrc; const int vstride = sd.vstride;
  const int dqw = sd.dq0 + wid * QBLK + r32;
  struct { bf16x8 vs0, vs1, ks0, ks1; } sr_[2];
#define KROW(j) ((j) < nt0 ? kbase0 + (j) * KVBLK : kbase1 + ((j) - nt0) * KVBLK)
#define SLOAD(i, j) do { const int _kr = KROW(j); \
    sr_[i].vs0 = *reinterpret_cast<const bf16x8*>(vsrc + (size_t)(_kr + sr) * vstride); sr_[i].vs1 = *reinterpret_cast<const bf16x8*>(vsrc + (size_t)(_kr + 32 + sr) * vstride); \
    sr_[i].ks0 = *reinterpret_cast<const bf16x8*>(ksrc + (size_t)(_kr + sr) * kstride); sr_[i].ks1 = *reinterpret_cast<const bf16x8*>(ksrc + (size_t)(_kr + 32 + sr) * kstride); } while (0)
#define SWRITE(b, i) do { *(bf16x8*)(V_lds + (b) * SHM_V + vst0) = sr_[i].vs0;          \
    *(bf16x8*)(V_lds + (b) * SHM_V + vst1) = sr_[i].vs1; int kc = sc * 2;               \
    *(bf16x8*)(K_lds + (b) * SHM_K + KSWZ(sr, kc)) = sr_[i].ks0;                       \
    *(bf16x8*)(K_lds + (b) * SHM_K + KSWZ(32 + sr, kc)) = sr_[i].ks1; } while (0)
#define SWAIT() asm volatile("s_waitcnt vmcnt(4)" ::: "memory")
#define MASKT(P0, P1, J) do { if (MASK && (J) < nt0) { const int _d = (J) * KVBLK - dqw; \
    _Pragma("unroll") for (int r = 0; r < 16; ++r) { const int dd = _d + crow(r, hi); if (dd > 128 || dd < -128) P0[r] = -1e30f; if (dd + 32 > 128 || dd + 32 < -128) P1[r] = -1e30f; } } } while (0)
#define RESC(a) do { if (__any((a) < 1.f)) { if (hi == 0) al_l[r32] = (a); asm volatile("s_waitcnt lgkmcnt(0)" ::: "memory"); \
    _Pragma("unroll") for (int d = 0; d < 2; ++d) _Pragma("unroll") for (int r = 0; r < 16; ++r) o[d][r] *= al_l[crow(r, hi)]; } } while (0)
  f32x16 pA0, pA1, pB0, pB1; float mnA, mnB, alA, alB; bf16x8 pa0, pa1, pa2, pa3;
  constexpr int SE = 0, SO = 1;
  __syncthreads();
  SLOAD(SE, 0); asm volatile("s_waitcnt vmcnt(0)" ::: "memory"); SWRITE(0, SE); __syncthreads();
  qkt<NK16>(pA0, pA1, K_lds, qr, r32, hi); MASKT(pA0, pA1, 0); partialSM<SC1000000>(pA0, pA1, m_reg, mnA, alA);
  SLOAD(SO, 1); if (2 < NT) SLOAD(SE, 2);
  SWAIT();
  SWRITE(1, SO); __syncthreads();
  int bc = 1;
  for (int j = 1; j + 1 < NT; j += 2) {
    { const int bp = bc == 0 ? NBUF - 1 : bc - 1, bn = bc == NBUF - 1 ? 0 : bc + 1;
      SBAR(); qkt<NK16>(pB0, pB1, K_lds + bc * SHM_K, qr, r32, hi);
      finishSM(pA0, pA1, alA, l_reg, pa0, pa1, pa2, pa3); SBAR();
      SLOAD(SO, j + 2); SBAR();
      pv_d0(o, vb0 + bp * SHM_V, pa0, pa1, pa2, pa3); MASKT(pB0, pB1, j); partialSM<SC1000000>(pB0, pB1, m_reg, mnB, alB);
      SWAIT(); SWRITE(bn, SE);
      RESC(alB); __syncthreads();
      bc = bn; }
    { const int bp = bc == 0 ? NBUF - 1 : bc - 1, bn = bc == NBUF - 1 ? 0 : bc + 1;
      SBAR(); qkt<NK16>(pA0, pA1, K_lds + bc * SHM_K, qr, r32, hi);
      finishSM(pB0, pB1, alB, l_reg, pa0, pa1, pa2, pa3); SBAR();
      if (j + 3 < NT) SLOAD(SE, j + 3); SBAR();
      pv_d0(o, vb0 + bp * SHM_V, pa0, pa1, pa2, pa3); MASKT(pA0, pA1, j + 1); partialSM<SC1000000>(pA0, pA1, m_reg, mnA, alA);
      SWAIT(); SWRITE(bn, SO);
      RESC(alA); __syncthreads();
      bc = bn; }
  }
  { const int bp = bc == 0 ? NBUF - 1 : bc - 1;
    SBAR(); qkt<NK16>(pB0, pB1, K_lds + bc * SHM_K, qr, r32, hi);
    finishSM(pA0, pA1, alA, l_reg, pa0, pa1, pa2, pa3); SBAR();
    pv_d0(o, vb0 + bp * SHM_V, pa0, pa1, pa2, pa3); MASKT(pB0, pB1, NT - 1); partialSM<SC1000000>(pB0, pB1, m_reg, mnB, alB);
    RESC(alB);
    finishSM(pB0, pB1, alB, l_reg, pa0, pa1, pa2, pa3); SBAR();
    pv_d0(o, vb0 + bc * SHM_V, pa0, pa1, pa2, pa3); }
  asm volatile("s_waitcnt vmcnt(0)" ::: "memory");
  if (hi == 0) li_l[r32] = l_reg; asm volatile("s_waitcnt lgkmcnt(0)" ::: "memory");
  float rli[16];
#pragma unroll
  for (int r = 0; r < 16; ++r) rli[r] = __builtin_amdgcn_rcpf(li_l[crow(r, hi)]);
  bf* Ow = sd.out + (size_t)(wid * QBLK) * 2048;
#pragma unroll
  for (int r = 0; r < 16; ++r) { int orow = crow(r, hi);
#pragma unroll
    for (int d0 = 0; d0 < 2; ++d0) Ow[(size_t)orow * 2048 + d0 * 32 + r32] = f2b(o[d0][r] * rli[r]); }
#undef SLOAD
#undef SWRITE
#undef SWAIT
#undef MASKT
#undef RESC
#undef KROW
}
#undef KSWZ
#undef SBAR
}

DEV void ph_mla(const Params& p, const Ctx& cx, int last) {
  const int nlat_units = NB * 8 * (N / 256);
  const int nctx_units = last ? 0 : NB * 8 * (LC / 256);
  const int sc = (cx.tid & 15) * 8;
  for (int uu = blockIdx.x; uu < nlat_units + 256; uu += gridDim.x) {
    const int u = uu < nlat_units ? uu : nlat_units + ((uu - nlat_units + 256 - 32) & 255);
    if (u >= nlat_units + nctx_units) continue;
    int qrow0, hh, kb0, nt0, kb1, NT;
    if (u < nlat_units) {
      const int rnd = u / 256, within = u % 256, bh = (rnd * 8 + (within & 7)) % (NB * 8); int qb = within >> 3;
      hh = bh % 8; int b = bh / 8; qrow0 = b * N + qb * 256; kb0 = b * N; nt0 = N / 64; kb1 = NLAT + b * LC; NT = (N + LC) / 64; }
    else { int v = u - nlat_units; int qb = v % (LC / 256); hh = (v / (LC / 256)) % 8; int b = v / (8 * (LC / 256)); qrow0 = NLAT + b * LC + qb * 256; kb0 = NLAT + b * LC; nt0 = LC / 64; kb1 = 0; NT = LC / 64; }
    fa::Src sd;
    sd.q = p.QA() + (size_t)qrow0 * 768 + hh * 96; sd.qstride = 768;
    if (sc < 64) { sd.ksrc = p.KVA() + hh * 128 + sc; sd.kstride = 1024; } else { sd.ksrc = p.P() + C_KR + ((sc - 64) & 31); sd.kstride = PC; }
    sd.vsrc = p.KVA() + hh * 128 + 64 + (sc & 63); sd.vstride = 1024;
    sd.out = p.Y() + (size_t)qrow0 * 2048 + hh * 64; sd.m0 = -1e30f; sd.l0 = 0.f; sd.dq0 = 0;
    fa::unit<6, 102062073, false>(sd, cx.tid, cx.ldsg, kb0, nt0, kb1, NT);
  }
}
DEV void ph_gqa(const Params& p, const Ctx& cx, int l, int last) {
  const int nlat_units = NB * 8 * (N / 256);
  const int nctx_units = last ? 0 : NB * 8 * (LC / 256);
  const int sc = (cx.tid & 15) * 8;
  for (int uu = blockIdx.x; uu < nlat_units + 256; uu += gridDim.x) {
    const int u = uu < nlat_units ? uu : nlat_units + ((uu - nlat_units + 256 - 16) & 255);
    if (u >= nlat_units + nctx_units) continue;
    int qrow0, hh, kb0, nt0, kb1, NT, dq0 = 0;
    if (u < nlat_units) {
      const int rnd = u / 256, within = u % 256, bh = (rnd * 8 + (within & 7)) % (NB * 8); int qb = within >> 3;
      hh = bh % 8; int b = bh / 8;
      int q0 = qb * 256; int klo = q0 - 128 < 0 ? 0 : q0 - 128; int khi = q0 + 384 > N ? N : q0 + 384;
      qrow0 = b * N + q0; kb0 = b * N + klo; nt0 = (khi - klo) / 64; kb1 = NLAT + b * LC; NT = nt0 + LC / 64; dq0 = q0 - klo;
    } else { int v = u - nlat_units; int qb = v % (LC / 256); hh = (v / (LC / 256)) % 8; int b = v / (8 * (LC / 256)); qrow0 = NLAT + b * LC + qb * 256; kb0 = NLAT + b * LC; nt0 = 0; kb1 = kb0; NT = LC / 64; }
    const int kh = hh >> 2;
    fa::Src sd;
    sd.q = p.P() + (size_t)qrow0 * PC + C_GQ + hh * 64; sd.qstride = PC;
    sd.ksrc = p.P() + C_GKV + kh * 64 + (sc & 63); sd.kstride = PC;
    sd.vsrc = p.P() + C_GKV + 128 + kh * 64 + (sc & 63); sd.vstride = PC;
    sd.out = p.Y() + (size_t)qrow0 * 2048 + 1536 + hh * 64;
    sd.m0 = p.in[I_gqa_sink][l * 8 + hh] * 8.0f; sd.l0 = 1.0f; sd.dq0 = dq0;
    fa::unit<4, 125000000, true>(sd, cx.tid, cx.ldsg, kb0, nt0, kb1, NT);
  }
}
#endif


namespace hy {
constexpr int NF = 2 * N;
struct f2 { float x, y; };
DEV f2 cmul(f2 a, f2 b) { f2 r; r.x = a.x * b.x - a.y * b.y; r.y = a.x * b.y + a.y * b.x; return r; }
#ifndef CPU_SIM
DEV f2 twid(const f2*, int k) { const float x = (float)k * (1.0f / (float)NF); return f2{__builtin_amdgcn_cosf(x), -__builtin_amdgcn_sinf(x)}; }
#else
DEV f2 twid(const f2* tw, int k) { return tw[k]; }
#endif
DEV f2 cmulc(f2 a, f2 b) { f2 r; r.x = a.x * b.x + a.y * b.y; r.y = a.y * b.x - a.x * b.y; return r; }
DEV void fwd_pass(f2* buf, const f2* tw, int L, int tid, int nthr) {
  const int Q = L >> 2, tws = NF / L;
  for (int u = tid; u < NF / 4; u += nthr) {
    const int g = u / Q, j = u - g * Q, base = g * L + j;
    const f2 x0 = buf[base], x1 = buf[base + Q], x2 = buf[base + 2 * Q], x3 = buf[base + 3 * Q];
    f2 a0{x0.x + x2.x, x0.y + x2.y}, a1{x0.x - x2.x, x0.y - x2.y}, a2{x1.x + x3.x, x1.y + x3.y};
    f2 d{x1.x - x3.x, x1.y - x3.y}; f2 a3{d.y, -d.x};
    f2 y0{a0.x + a2.x, a0.y + a2.y}, y1{a1.x + a3.x, a1.y + a3.y}, y2{a0.x - a2.x, a0.y - a2.y}, y3{a1.x - a3.x, a1.y - a3.y};
    buf[base] = y0; buf[base + Q] = cmul(y1, twid(tw, j * tws)); buf[base + 2 * Q] = cmul(y2, twid(tw, 2 * j * tws)); buf[base + 3 * Q] = cmul(y3, twid(tw, 3 * j * tws));
  }
}
DEV void inv_pass(f2* buf, const f2* tw, int L, int tid, int nthr) {
  const int Q = L >> 2, tws = NF / L;
  for (int u = tid; u < NF / 4; u += nthr) {
    const int g = u / Q, j = u - g * Q, base = g * L + j;
    const f2 u0 = buf[base], u1 = cmulc(buf[base + Q], twid(tw, j * tws)), u2 = cmulc(buf[base + 2 * Q], twid(tw, 2 * j * tws)), u3 = cmulc(buf[base + 3 * Q], twid(tw, 3 * j * tws));
    f2 a0{u0.x + u2.x, u0.y + u2.y}, a1{u0.x - u2.x, u0.y - u2.y}, a2{u1.x + u3.x, u1.y + u3.y};
    f2 d{u1.x - u3.x, u1.y - u3.y}; f2 a3{-d.y, d.x};
    buf[base] = f2{a0.x + a2.x, a0.y + a2.y}; buf[base + Q] = f2{a1.x + a3.x, a1.y + a3.y};
    buf[base + 2 * Q] = f2{a0.x - a2.x, a0.y - a2.y}; buf[base + 3 * Q] = f2{a1.x - a3.x, a1.y - a3.y};
  }
}
DEV void s1_taps(const Params& p, f2* buf, float* red, int c, int tid, int nthr) {
  float ss = 0.f;
#pragma unroll 8
  for (int k = tid; k < NF; k += nthr) {
    float v = 0.f;
    if (k < N) v = p.F()[(size_t)k * 1024 + c];
    else if (k > N) v = p.F()[(size_t)(NF - k) * 1024 + 512 + c];
    buf[k] = f2{v, 0.f}; ss += v * v;
  }
  red[tid] = ss;
}
DEV float red_total(const float* red, int nthr) { float s = 0.f; for (int i = 0; i < nthr; ++i) s += red[i]; return s; }
DEV void s3_store(const f2* buf, unsigned* hs, int tid, int nthr) {
  for (int k = tid; k < NF; k += nthr) hs[k] = (unsigned)f2b(buf[k].x).v | ((unsigned)f2b(buf[k].y).v << 16);
}
DEV void s4_loadz(const Params& p, f2* buf, int c, int tid, int nthr) {
#pragma unroll 8
  for (int t = tid; t < NF; t += nthr) {
    f2 v{0.f, 0.f};
    if (t < N) { v.x = b2f(p.Z()[(size_t)t * 512 + c]); v.y = b2f(p.Z()[(size_t)(N + t) * 512 + c]); }
    buf[t] = v;
  }
}
DEV void s6_mul(f2* buf, const unsigned* hs, int tid, int nthr) {
  for (int k = tid; k < NF; k += nthr) {
    union { unsigned u; float f; } a, b; const unsigned w = hs[k]; a.u = w << 16; b.u = w & 0xFFFF0000u;
    buf[k] = cmul(buf[k], f2{a.f, b.f});
  }
}
DEV void s8_out(const Params& p, const f2* buf, const float* red, int l, int c, int tid, int nthr) {
  const float fn = 1.0f / sqrtf(red_total(red, nthr) + EPS) * (1.0f / (float)NF);
  const float* cw = p.in[I_hy_conv_w] + l * 3 * 1536; const float cb = p.in[I_hy_conv_b][l * 1536 + c];
  const float w0 = cw[c], w1 = cw[1536 + c], w2 = cw[2 * 1536 + c];
  const float skip = p.in[I_hy_skip][l * 512 + c];
#pragma unroll 4
  for (int i = tid; i < 2 * N; i += nthr) {
    const int b = i / N, t = i - b * N;
    const size_t r = (size_t)b * N + t;
    const float conv = (b ? buf[t].y : buf[t].x) * fn;
    float x0 = cb + w1 * b2f(p.P()[r * PC + C_HU + c]);
    if (t > 0) x0 += w0 * b2f(p.P()[(r - 1) * PC + C_HU + c]);
    if (t < N - 1) x0 += w2 * b2f(p.P()[(r + 1) * PC + C_HU + c]);
    const float y = conv + skip * b2f(p.Z()[r * 512 + c]);
    p.Y()[r * 2048 + 1024 + c] = f2b(x0 * y);
  }
}
#ifndef CPU_SIM
DEV void channel(const Params& p, int l, int c, int tid, f2* buf, float* red, unsigned* hs) {
  const f2* tw = (const f2*)p.tw();
#ifndef HY_EXP
#define HY_EXP 0
#endif
  __syncthreads();
  if (HY_EXP != 2) s1_taps(p, buf, red, c, tid, 512); __syncthreads();
  if (HY_EXP != 1) for (int L = NF; L >= 4; L >>= 2) { fwd_pass(buf, tw, L, tid, 512); __syncthreads(); }
  s3_store(buf, hs, tid, 512); __syncthreads();
  if (HY_EXP != 2) s4_loadz(p, buf, c, tid, 512); __syncthreads();
  if (HY_EXP != 1) for (int L = NF; L >= 4; L >>= 2) { fwd_pass(buf, tw, L, tid, 512); __syncthreads(); }
  s6_mul(buf, hs, tid, 512); __syncthreads();
  if (HY_EXP != 1) for (int L = 4; L <= NF; L <<= 2) { inv_pass(buf, tw, L, tid, 512); __syncthreads(); }
  if (HY_EXP != 2) s8_out(p, buf, red, l, c, tid, 512);
}
#endif
}


namespace tz {
constexpr int NBLK = N / 64;
constexpr int PADB = 31;
constexpr int ZB = 72;
constexpr int ZLEN = (NBLK + 2 * PADB) * ZB;
constexpr int HLEN = 2 * N + 16;
DEV int a_index(int m, int r, int h) { return N - m - r + 8 * h; }
DEV int b_index(int t1, int Dd, int ks, int h) { return ZB * (t1 - Dd + PADB) + 16 * ks + 8 * h; }
#ifndef CPU_SIM
using bf16x8 = __attribute__((ext_vector_type(8))) short;
using f32x16 = __attribute__((ext_vector_type(16))) float;
using u32x4 = __attribute__((ext_vector_type(4))) unsigned;
DEV bf16x8 load_afrag(const unsigned short* Hr, int e) {
  const unsigned* wp = (const unsigned*)(Hr + (e & ~1));
  const unsigned w0 = wp[0], w1 = wp[1], w2 = wp[2], w3 = wp[3], w4 = wp[4];
  const unsigned sh = (unsigned)(e & 1) << 4;
  u32x4 o;
  o.x = __builtin_amdgcn_alignbit(w1, w0, sh); o.y = __builtin_amdgcn_alignbit(w2, w1, sh); o.z = __builtin_amdgcn_alignbit(w3, w2, sh); o.w = __builtin_amdgcn_alignbit(w4, w3, sh);
  return *reinterpret_cast<bf16x8*>(&o);
}
DEV void channel(const Params& p, int l, int c, int tid, char* lds) {
  unsigned short* zp = (unsigned short*)lds;
  float* red = (float*)(zp + 2 * ZLEN);
  unsigned short* Hr = (unsigned short*)(red + 512);
  float* cv = (float*)Hr;
  const int lane = tid & 63, w = tid >> 6, r = lane & 31, h = lane >> 5;
  __syncthreads();
  float ss = 0.f;
  const float* ff = p.F() + (size_t)c * (N + LC); const float* fb = p.F() + (size_t)(512 + c) * (N + LC);
#pragma unroll 4
  for (int t = tid * 4; t < N; t += 2048) {
    const float4 a = *(const float4*)(ff + t), b = *(const float4*)(fb + t);
    ss += a.x * a.x + a.y * a.y + a.z * a.z + a.w * a.w + b.x * b.x + b.y * b.y + b.z * b.z + b.w * b.w;
    Hr[N - t] = f2b(a.x).v; Hr[N - t - 1] = f2b(a.y).v; Hr[N - t - 2] = f2b(a.z).v; Hr[N - t - 3] = f2b(a.w).v;
    if (t > 0) Hr[N + t] = f2b(b.x).v;
    Hr[N + t + 1] = f2b(b.y).v; Hr[N + t + 2] = f2b(b.z).v; Hr[N + t + 3] = f2b(b.w).v;
  }
  if (tid == 0) Hr[0] = 0;
  if (tid < 16) Hr[2 * N + tid] = 0;
  red[tid] = ss;
  for (int i = tid; i < 2 * PADB * 64; i += 512) {
    const int side = i / (PADB * 64), k = i % (PADB * 64);
    const int off = ((side ? PADB + NBLK : 0) + (k >> 6)) * ZB + (k & 63);
    zp[off] = 0; zp[ZLEN + off] = 0;
  }
  { const unsigned short* zt = (const unsigned short*)p.Z() + (size_t)c * NB * N;
#pragma unroll 4
    for (int i = tid * 8; i < 2 * N; i += 4096) { const int b = i / N, t = i - b * N; *(uint4*)(zp + b * ZLEN + (PADB + (t >> 6)) * ZB + (t & 63)) = *(const uint4*)(zt + i); } }
  __syncthreads();
  float tot = 0.f;
  for (int i = 0; i < 512; ++i) tot += red[i];
  const float fn = 1.0f / sqrtf(tot + EPS);
  const int t1 = 32 * (w & 3) + r;
  const unsigned short* zb = zp + (w >> 2) * ZLEN;
  f32x16 acc0 = {}, acc1 = {};
  const int Dlo = 32 * (w & 3) - (NBLK - 1), Dhi = 32 * (w & 3) + 31;
#define TZ_LOAD(AF, BF, PA, PB) do { _Pragma("unroll") for (int ks = 0; ks < 4; ++ks) BF[ks] = *reinterpret_cast<const bf16x8*>((PB) + 16 * ks); \
    _Pragma("unroll") for (int q = 0; q < 6; ++q) { const unsigned* wq_ = (PA) + 8 * (5 - q); const unsigned w0_ = wq_[0], w1_ = wq_[1], w2_ = wq_[2], w3_ = wq_[3], w4_ = wq_[4]; u32x4 o_; \
      o_.x = __builtin_amdgcn_alignbit(w1_, w0_, shA); o_.y = __builtin_amdgcn_alignbit(w2_, w1_, shA); o_.z = __builtin_amdgcn_alignbit(w3_, w2_, shA); o_.w = __builtin_amdgcn_alignbit(w4_, w3_, shA); \
      AF[q] = *reinterpret_cast<bf16x8*>(&o_); } } while (0)
#define TZ_MMA(AF, BF) do { _Pragma("unroll") for (int ks = 0; ks < 4; ++ks) { \
    acc0 = __builtin_amdgcn_mfma_f32_32x32x16_bf16(AF[3 - ks], BF[ks], acc0, 0, 0, 0); acc1 = __builtin_amdgcn_mfma_f32_32x32x16_bf16(AF[5 - ks], BF[ks], acc1, 0, 0, 0); } } while (0)
  const unsigned shA = (unsigned)(r & 1) << 4;
  const unsigned* pa = (const unsigned*)Hr + ((a_index(64 * Dlo - 48 + 80, r, h) & ~1) >> 1);
  const unsigned short* pb = zb + b_index(t1, Dlo, 0, h);
#define TZ_LOAD4(AF, BF, PREV, PA, PB) do { _Pragma("unroll") for (int ks = 0; ks < 4; ++ks) BF[ks] = *reinterpret_cast<const bf16x8*>((PB) + 16 * ks); \
    AF[0] = PREV[4]; AF[1] = PREV[5]; \
    _Pragma("unroll") for (int q = 2; q < 6; ++q) { const unsigned* wq_ = (PA) + 8 * (5 - q); const unsigned w0_ = wq_[0], w1_ = wq_[1], w2_ = wq_[2], w3_ = wq_[3], w4_ = wq_[4]; u32x4 o_; \
      o_.x = __builtin_amdgcn_alignbit(w1_, w0_, shA); o_.y = __builtin_amdgcn_alignbit(w2_, w1_, shA); o_.z = __builtin_amdgcn_alignbit(w3_, w2_, shA); o_.w = __builtin_amdgcn_alignbit(w4_, w3_, shA); \
      AF[q] = *reinterpret_cast<bf16x8*>(&o_); } } while (0)
  bf16x8 afA[6], bfA[4], afB[6], bfB[4];
  TZ_LOAD(afA, bfA, pa, pb);
#pragma unroll 1
  for (int Dd = Dlo; Dd + 2 <= Dhi; Dd += 2) {
    TZ_LOAD4(afB, bfB, afA, pa - 32, pb - ZB);
    TZ_MMA(afA, bfA);
    pa -= 64; pb -= 2 * ZB;
    TZ_LOAD4(afA, bfA, afB, pa, pb);
    TZ_MMA(afB, bfB);
  }
  TZ_MMA(afA, bfA);
#undef TZ_LOAD4
#undef TZ_LOAD
#undef TZ_MMA
  static_assert((NBLK + 31) % 2 == 1, "K-loop pairing assumes an odd number of steps");
  __syncthreads();
  { int t1e = t1, he = h;
    asm volatile("" : "+v"(t1e), "+v"(he));
    float* cvb = cv + (w >> 2) * N + 64 * t1e + 4 * he;
#pragma unroll
    for (int g = 0; g < 4; ++g) {
      *(float4*)(cvb + 8 * g) = float4{acc0[4 * g], acc0[4 * g + 1], acc0[4 * g + 2], acc0[4 * g + 3]};
      *(float4*)(cvb + 32 + 8 * g) = float4{acc1[4 * g], acc1[4 * g + 1], acc1[4 * g + 2], acc1[4 * g + 3]};
    } }
  __syncthreads();
  { const float skip = p.in[I_hy_skip][l * 512 + c];
    unsigned short* xy = (unsigned short*)p.XYT() + (size_t)c * NB * N;
#pragma unroll 4
    for (int i = tid * 8; i < 2 * N; i += 4096) {
      const int b = i / N, t = i - b * N;
      float x0[8]; unpack8(*(const uint4*)(xy + i), x0);
      float zf[8]; unpack8(*(const uint4*)(zp + b * ZLEN + (PADB + (t >> 6)) * ZB + (t & 63)), zf);
      const float4 ca = *(const float4*)(cv + i), cb4 = *(const float4*)(cv + i + 4);
      float o[8];
      o[0] = x0[0] * (ca.x * fn + skip * zf[0]); o[1] = x0[1] * (ca.y * fn + skip * zf[1]); o[2] = x0[2] * (ca.z * fn + skip * zf[2]); o[3] = x0[3] * (ca.w * fn + skip * zf[3]);
      o[4] = x0[4] * (cb4.x * fn + skip * zf[4]); o[5] = x0[5] * (cb4.y * fn + skip * zf[5]); o[6] = x0[6] * (cb4.z * fn + skip * zf[6]); o[7] = x0[7] * (cb4.w * fn + skip * zf[7]);
      store8bf(p.YT() + (size_t)c * NB * N + i, o);
    } }
}
DEV void xyt_to_y(const Params& p, int tid, char* lds) {
  unsigned short* tl = (unsigned short*)lds;
  for (int tile = blockIdx.x; tile < (NLAT / 64) * 8; tile += gridDim.x) {
    const int rt = tile >> 3, c0 = (tile & 7) * 64;
    const int bq = (rt * 64) / N, tq = (rt * 64) % N;
    __syncthreads();
    { const int cc = tid >> 3, tg = (tid & 7) * 8;
      const uint4 v = *(const uint4*)((const unsigned short*)p.YT() + ((size_t)(c0 + cc) * NB + bq) * N + tq + tg);
      const unsigned short* e = (const unsigned short*)&v;
#pragma unroll
      for (int j = 0; j < 8; ++j) tl[(tg + j) * 72 + cc] = e[j]; }
    __syncthreads();
    { const int tr = tid >> 3, cg8 = (tid & 7) * 8;
      *(uint4*)((unsigned short*)p.Y() + (size_t)(rt * 64 + tr) * 2048 + 1024 + c0 + cg8) = *(const uint4*)(tl + tr * 72 + cg8); }
  }
}
#endif
}

#ifndef CPU_SIM
DEV void ph_hyena_fft(const Params& p, const Ctx& cx, int l) {
  const int nb = gridDim.x;
  for (int i = blockIdx.x; i < 512; i += nb) {
    const int xcd = i & 7, idx = i >> 3;
    const int c = xcd * 64 + idx;
    tz::channel(p, l, c, cx.tid, cx.ldsg);
  }
}
#endif


#ifndef CPU_SIM
DEV void ph_hyena_ctx(const Params& p, const Ctx& cx, int l) {
  constexpr int LP = 33;
  float* Zs = (float*)cx.ldsg; float* Ff = Zs + LC * LP; float* Fb = Ff + LC * LP;
  const int tid = cx.tid, c = tid & 31, t0 = tid >> 5;
  const float* cw = p.in[I_hy_conv_w] + l * 3 * 1536; const float* cbv = p.in[I_hy_conv_b] + l * 1536;
  constexpr int TP = 8, TLEN = LC / TP;
  for (int task = blockIdx.x; task < NB * 16 * TP; task += gridDim.x) {
    const int tp = task % TP, cgp = (task / TP) & 15, b = task / (TP * 16), c0 = cgp * 32;
    const int rbase = NLAT + b * LC;
    __syncthreads();
    for (int idx = tid; idx < LC * 32; idx += 512) {
      { const int t = idx >> 5, cc = idx & 31; Zs[t * LP + cc] = b2f(p.Z()[(size_t)(rbase + t) * 512 + c0 + cc]); }
      { const int cc = idx / LC, t = idx % LC;
        Ff[t * LP + cc] = p.F()[(size_t)(c0 + cc) * (N + LC) + N + t]; Fb[t * LP + cc] = p.F()[(size_t)(512 + c0 + cc) * (N + LC) + N + t]; }
    }
    __syncthreads();
    float ss = 0.f;
    for (int t = 0; t < LC; ++t) { const float a = Ff[t * LP + c], bb = Fb[t * LP + c]; ss += a * a + bb * bb; }
    const float fn = 1.0f / sqrtf(ss + EPS);
    const int cg_ = c0 + c;
    const float w0 = cw[cg_], w1 = cw[1536 + cg_], w2 = cw[2 * 1536 + cg_], cb0 = cbv[cg_], skip = p.in[I_hy_skip][l * 512 + cg_];
    for (int t = tp * TLEN + t0; t < (tp + 1) * TLEN; t += 16) {
      float acc = 0.f;
      for (int s_ = 0; s_ <= t; ++s_) acc += Ff[(t - s_) * LP + c] * Zs[s_ * LP + c];
      for (int s_ = t + 1; s_ < LC; ++s_) acc += Fb[(s_ - t) * LP + c] * Zs[s_ * LP + c];
      const size_t r = (size_t)(rbase + t);
      float x0 = cb0 + w1 * b2f(p.P()[r * PC + C_HU + cg_]);
      if (t > 0) x0 += w0 * b2f(p.P()[(r - 1) * PC + C_HU + cg_]);
      if (t < LC - 1) x0 += w2 * b2f(p.P()[(r + 1) * PC + C_HU + cg_]);
      p.Y()[r * 2048 + 1024 + cg_] = f2b(x0 * (acc * fn + skip * Zs[t * LP + c]));
    }
  }
}
#endif

constexpr int NOSH = 30;

#ifndef CPU_SIM
#define SIDE_PREP(NB0, PARTS) do { if (l == 0 && (int)blockIdx.x >= (NB0)) { PrepCtx pc; pc.tid = cx.tid; pc.tl = (float*)cx.ldsg; pc.rank = (int)blockIdx.x - (NB0); pc.nranks = (int)gridDim.x - (NB0); \
    ph_prep(p, 1, pc, gtid - (NB0) * 512, gsz - (NB0) * 512, (PARTS)); } } while (0)
#else
#define SIDE_PREP(NB0, PARTS)
#endif
DEV void run_phase(const Params& p, int ph, const Ctx& cx) {
  const i64 gtid = cx.gtid, gsz = cx.gsz;
  if (ph == 0) { ph_init(p, gtid, gsz); return; }
  if (ph == NPHASES - 1) { ph_final(p, gtid, gsz); return; }
  const int l = (ph - 1) / PH_PER_LAYER, s = (ph - 1) % PH_PER_LAYER;
  const int last = (l == 1);
  const int nr = last ? NLAT : TT;
#ifdef ONLY
  if (s != ONLY) return;
#endif
  switch (s) {
    case 0: {
      PrepCtx pc;
#ifndef CPU_SIM
      pc.tid = cx.tid; pc.tl = (float*)cx.ldsg; pc.rank = (int)blockIdx.x; pc.nranks = (int)gridDim.x;
      if (l == 0) ph_prep(p, l, pc, gtid, gsz, 15); else ph_prep(p, l, pc, gtid, gsz, 8);
#else
      pc.gtid = gtid; pc.gsz = gsz;
      ph_prep(p, l, pc, gtid, gsz, 15);
#endif
      ph_norm(p, l, 0, TT, gtid, gsz);
    } break;
    case 1: { GemmDesc g{p.h(), p.W_in(), D, D, D, TT, 3840, NOSH, 0}; EpiInproj e{p}; run_gemm(cx, g, e); } break;
#ifndef CPU_SIM
    case 2: ph_B0(p, l, gtid, gsz, cx.ldsg, cx.tid); break;
#else
    case 2: ph_B0(p, l, gtid, gsz); break;
#endif
    case 3: {
      { const int n_uq = (nr / 256) * 3, n_ukv = (TT / 256) * 4, n_lru = (TT / 256) * 8;
        { GemmDesc g{p.P() + C_CQ, p.W_uq(), PC, 256, 256, nr, 768, NOSH, 0}; EpiUq e{p}; run_gemm(cx, g, e); }
        { GemmDesc g{p.P() + C_CKV, p.W_ukv(), PC, 256, 256, TT, 1024, NOSH, 0}; g.unit_off = n_uq; EpiUkv e{p}; run_gemm(cx, g, e); }
        { GemmDesc g{p.XC(), p.W_lru(), 512, 256, 256, TT, 2048, 2, 256}; g.unit_off = n_uq + n_ukv; EpiLru e{p, l, p.in[I_lru_b_r], p.in[I_lru_b_i]}; run_gemm(cx, g, e); }
#ifndef CPU_SIM
        { GemmDesc g{p.W3T(), p.hdn2b() + (size_t)l * (N + LC) * 256, 256, 256, 256, 1024, N + LC, NOSH, 0}; g.unit_off = n_uq + n_ukv + n_lru; EpiFilt e{p}; run_gemm(cx, g, e); }
#endif
      }
#ifdef CPU_SIM
      ph_fnorm(p, gtid, gsz);
#endif
    } break;
    case 4:
      ph_lru1(p, gtid, gsz);
#ifndef CPU_SIM
#if PROBE_K >= 0
#define SUBSTAMP(k) do { cg::this_grid().sync(); if (l == 0) { const unsigned long long t_ = wall_clock64(); if (blockIdx.x == 0 && cx.tid == 0) ((unsigned long long*)(p.ws + WL.ts))[40 + (k)] = t_; } } while (0)
#else
#define SUBSTAMP(k)
#endif
      if (REPEAT_S == 40) ph_lru1(p, gtid, gsz);
      SUBSTAMP(0);
      ph_hyena_fft(p, cx, l);
      if (REPEAT_S == 41) ph_hyena_fft(p, cx, l);
      SUBSTAMP(1);
      ph_gqa(p, cx, l, last);
      if (REPEAT_S == 42) ph_gqa(p, cx, l, last);
      SUBSTAMP(2);
      ph_mla(p, cx, last);
      if (REPEAT_S == 43) ph_mla(p, cx, last);
      SUBSTAMP(3);
      if (!last) ph_hyena_ctx(p, cx, l);
      if (REPEAT_S == 44 && !last) ph_hyena_ctx(p, cx, l);
#else
      ph_C(p, l, last, gtid, gsz);
#endif
      break;
#ifndef CPU_SIM
    case 5: ph_lru3(p, last, gtid, gsz, (float*)cx.ldsg, cx.tid);
      {
        constexpr int NB3 = (NB * NCHK * 256 + 511) / 512;
        if (l == 1 && (int)gridDim.x > NB3 && (int)blockIdx.x >= NB3) ph_cvt_tables(p, l, gtid - (i64)NB3 * 512, gsz - (i64)NB3 * 512);
        else if (l == 1 && (int)gridDim.x <= NB3) ph_cvt_tables(p, l, gtid, gsz); }
      __syncthreads(); tz::xyt_to_y(p, cx.tid, cx.ldsg); break;
#else
    case 5: ph_lru3(p, last, gtid, gsz, nullptr, 0); break;
#endif
    case 6: { GemmDesc g{p.h(), p.W_g(), D, D, D, nr, 4096, NOSH, 0}; EpiGateAll e{p}; run_gemm(cx, g, e); } break;
    case 7: { GemmDesc g{p.Y(), p.W_br(), 2048, 512, 512, nr, 1024, NOSH, 0, 4, 512, 1024 * 512}; EpiBranchSub e{p}; run_gemm(cx, g, e); }
      SIDE_PREP(8, 1);
      break;
    case 8: { GemmDesc g{p.M(), p.W_out(), D, D, D, nr, 1024, NOSH, 0}; EpiOut e{p, l, 1.0f, l == 0 ? p.in[I_x] : (const float*)p.xcur(), l == 0 ? p.in[I_ctx] : (const float*)p.xcur() + (size_t)NLAT * D}; run_gemm(cx, g, e); }
#ifndef CPU_SIM
      if (l == 0 && blockIdx.x >= 8) ph_cvt_tables(p, l, gtid - 8 * 512, gsz - 8 * 512);
#endif
      break;
    case 9:
#ifndef CPU_SIM
#endif
      ph_norm(p, l, 1, nr, gtid, gsz); break;
    case 10: { GemmDesc g{p.h(), p.W_q(), D, D, D, nr, 1024, NOSH, 0}; EpiPQ e{p}; run_gemm(cx, g, e); }
      SIDE_PREP(8, 2);
      break;
    case 11: { GemmDesc g{p.PQ(), p.W_key(), 1024, 256, 256, nr, 2048, 1, 256}; EpiSC e{p}; run_gemm(cx, g, e); }
      SIDE_PREP(16, 4);
      break;
#ifndef CPU_SIM
    case 12: ph_peer(p, l, nr, cx.tid, cx.ldsg); if (REPEAT_S == 52) { __syncthreads(); ph_peer(p, l, nr, cx.tid, cx.ldsg, 0.0f); } break;
#else
    case 12: ph_E2a(p, nr, gtid, gsz); break;
    case 13: ph_E2b(p, nr, gtid, gsz); break;
    case 14: ph_E3(p, l, nr, gtid, gsz); break;
    case 15: ph_E4(p, l, nr, gtid, gsz); break;
#endif
  }
}

#ifdef CPU_SIM
static void fill_params(Params& p, void* const* d_in, void* d_out, void* d_ws) {
  p.in.t = (const float* const*)d_in;
  p.out = (float*)d_out;
  p.ws = (char*)d_ws;
}
#endif


#ifndef CPU_SIM
#define XB_TMO      128
#define XB_XCNT(j)  (256  + 64 * (j))
#define XB_XSUB(j)  (1280 + 64 * (j))
#define XB_XGEN(j)  (2304 + 64 * (j))
#define XB_TOP      3328
#define XB_TOPGEN   3392
#define XCD_BAR_WORDS 3456
#define XB_SPIN_CAP (1u << 18)
#define XB_LAS __attribute__((address_space(3)))
__device__ __forceinline__ unsigned xb_ld(unsigned* p)              { return __hip_atomic_load(p, __ATOMIC_RELAXED, __HIP_MEMORY_SCOPE_AGENT); }
__device__ __forceinline__ unsigned xb_add(unsigned* p, unsigned v) { return __hip_atomic_fetch_add(p, v, __ATOMIC_RELAXED, __HIP_MEMORY_SCOPE_AGENT); }
__device__ __forceinline__ unsigned xb_xcc_id() { return (unsigned)__builtin_amdgcn_s_getreg((3 << 11) | 20) & 0xFu; }
#define XB_SPIN(cond, bar) do { unsigned _sp = 0; while (cond) { __builtin_amdgcn_s_sleep(1); \
    if ((++_sp & 255u) == 0u) { if (xb_ld(&(bar)[XB_TMO])) break; if (_sp > XB_SPIN_CAP) { atomicAdd(&(bar)[XB_TMO], 1u); break; } } } } while (0)
struct XcdBarrier { unsigned* bar; unsigned x; volatile XB_LAS unsigned* st; };
__device__ __forceinline__ XcdBarrier xcd_barrier_post(unsigned* bar, volatile XB_LAS unsigned* st) {
  XcdBarrier b; b.bar = bar; b.x = xb_xcc_id(); b.st = st;
  if (threadIdx.x == 0) (void)xb_add(&bar[XB_XCNT(b.x)], 1u);
  return b;
}
__device__ __forceinline__ void xcd_barrier_complete(unsigned* bar, unsigned x, unsigned& nloc, unsigned& nx) {
  const unsigned G = gridDim.x * gridDim.y * gridDim.z;
  unsigned sum, cnt, mine, sp = 0u;
  for (;;) {
    sum = 0u; cnt = 0u; mine = 0u;
#pragma unroll
    for (unsigned j = 0; j < 16; ++j) { const unsigned c = xb_ld(&bar[XB_XCNT(j)]); sum += c; cnt += (c > 0u) ? 1u : 0u; mine = (j == x) ? c : mine; }
    if (sum == G) break;
    __builtin_amdgcn_s_sleep(1);
    if ((++sp & 255u) == 0u) { if (xb_ld(&bar[XB_TMO])) break; if (sp > XB_SPIN_CAP) { atomicAdd(&bar[XB_TMO], 1u); break; } }
  }
  nloc = mine > 0u ? mine : 1u; nx = cnt > 0u ? cnt : 1u;
}
__device__ __forceinline__ void xcd_barrier(const XcdBarrier& b) {
  asm volatile("s_waitcnt vmcnt(0)" ::: "memory");
  __syncthreads();
  if (threadIdx.x == 0) {
    unsigned* bar = b.bar;
    __builtin_amdgcn_s_waitcnt(0);
    unsigned nloc = b.st[0], nx = b.st[1];
    if (nloc == 0u) { xcd_barrier_complete(bar, b.x, nloc, nx); b.st[0] = nloc; b.st[1] = nx; }
    const unsigned old = xb_add(&bar[XB_XSUB(b.x)], 1u);
    const unsigned gen = old / nloc;
    if (old + 1u == (gen + 1u) * nloc) {
      __builtin_amdgcn_fence(__ATOMIC_RELEASE, "agent");
      asm volatile("s_waitcnt vmcnt(0)" ::: "memory");
      const unsigned og = xb_add(&bar[XB_TOP], 1u);
      const unsigned tg = og / nx;
      if (og + 1u == (tg + 1u) * nx) xb_add(&bar[XB_TOPGEN], 1u);
      else XB_SPIN(xb_ld(&bar[XB_TOPGEN]) == tg, bar);
      __builtin_amdgcn_fence(__ATOMIC_ACQUIRE, "agent");
      xb_add(&bar[XB_XGEN(b.x)], 1u);
      asm volatile("s_waitcnt vmcnt(0)" ::: "memory");
    } else {
      XB_SPIN(xb_ld(&bar[XB_XGEN(b.x)]) == gen, bar);
      __builtin_amdgcn_fence(__ATOMIC_ACQUIRE, "agent");
      asm volatile("s_waitcnt vmcnt(0)" ::: "memory");
    }
  }
  __syncthreads();
}
#endif

#ifndef CPU_SIM
static_assert(TT % 256 == 0 && NLAT % 256 == 0 && (N + LC) % 256 == 0, "row / column tiles");
static_assert(N / 256 == 32 && NB * 8 * (N / 256) == 512, "attention unit mapping assumes 32 q-blocks per (batch, head) and a 256-block grid");
constexpr int LDS_PHASE_BYTES = 131072 + 4096;
constexpr int LDS_BYTES = LDS_PHASE_BYTES + 16;
__global__ void __launch_bounds__(512, 2) mega_kernel(KArgs ka) {
  extern __shared__ __attribute__((aligned(16))) unsigned char shm[];
  cg::grid_group grid = cg::this_grid();
#if PROBE_K >= 0
  unsigned long long* const tsp = (unsigned long long*)(ka.ws + WL.ts);
#endif
  {
    int tid = threadIdx.x;
    asm volatile("" : "+v"(tid));
    const i64 gtid = (i64)blockIdx.x * 512 + tid, gsz = (i64)gridDim.x * 512;
    ph_init(ka, gtid, gsz, (char*)shm, tid);
    if (gtid < N_IN) ((const float**)(ka.ws + WL.tbl))[gtid] = ka.in[gtid];
#if PROBE_K >= 0
    { const unsigned long long t_ = wall_clock64(); if (gtid == 0) tsp[0] = t_; }
#endif
  }
  volatile XB_LAS unsigned* xst = (volatile XB_LAS unsigned*)(shm + LDS_PHASE_BYTES);
  if (threadIdx.x == 0) { xst[0] = 0u; xst[1] = 0u; }
  __syncthreads();
  const XcdBarrier xb = xcd_barrier_post((unsigned*)(ka.ws + WL.bar), xst);
  grid.sync();
#if PROBE_K >= 0
  { const unsigned long long t_ = wall_clock64(); if (blockIdx.x == 0 && threadIdx.x == 0) tsp[1] = t_; }
#endif
  Params p; p.out = ka.out; p.ws = ka.ws; p.in.t = (const float* const*)(ka.ws + WL.tbl);
  for (int ph = 1; ph < NPHASES - 1; ++ph) {
    int tid = threadIdx.x;
    asm volatile("" : "+v"(tid));
    Ctx cx;
    cx.tid = tid;
    cx.gtid = (i64)blockIdx.x * 512 + tid; cx.gsz = (i64)gridDim.x * 512;
    cx.lds = (PG8_LAS unsigned char*)shm; cx.ldsg = (char*)shm;
    run_phase(p, ph, cx);
    if (REPEAT_S >= 0 && REPEAT_S < 40 && (ph - 1) % PH_PER_LAYER == REPEAT_S) { __syncthreads(); run_phase(p, ph, cx); }
    xcd_barrier(xb);
#if PROBE_K >= 0
    { const unsigned long long t_ = wall_clock64(); if (blockIdx.x == 0 && threadIdx.x == 0) tsp[ph + 1] = t_; }
    if (ph == NPHASES - 2) grid.sync();
#endif
  }
  {
    int tid = threadIdx.x;
    asm volatile("" : "+v"(tid));
    ph_final(p, (i64)blockIdx.x * 512 + tid, (i64)gridDim.x * 512);
  }
}

extern "C" void kernel_launch(void* const* d_in, const int* in_sizes, int n_in, void* d_out, int out_size,
                              void* d_ws, size_t ws_size, hipStream_t stream) {
  static int grid_blocks = 0;
  if (!grid_blocks) {
    int dev = 0, cus = 0, per_cu = 0;
    (void)hipGetDevice(&dev);
    (void)hipDeviceGetAttribute(&cus, hipDeviceAttributeMultiprocessorCount, dev);
    if (hipFuncSetAttribute((const void*)mega_kernel, hipFuncAttributeMaxDynamicSharedMemorySize, LDS_BYTES) != hipSuccess)
      fprintf(stderr, "hipFuncSetAttribute failed\n");
    (void)hipOccupancyMaxActiveBlocksPerMultiprocessor(&per_cu, mega_kernel, 512, LDS_BYTES);
    if (per_cu > 1) per_cu = 1;
    if (per_cu < 1) per_cu = 1;
    grid_blocks = cus * per_cu;
  }
  (void)hipMemsetAsync((char*)d_ws + WL.bar, 0, (size_t)3456 * 4, stream);
  KArgs ka;
  std::memset((void*)&ka, 0, sizeof(ka));
  for (int i = 0; i < N_IN; ++i) ka.in[i] = (const float*)d_in[i];
  ka.out = (float*)d_out; ka.ws = (char*)d_ws;
  void* args[] = {&ka};
  hipError_t e = hipLaunchCooperativeKernel((void*)mega_kernel, dim3(grid_blocks), dim3(512), args, LDS_BYTES, stream);
  if (e != hipSuccess) fprintf(stderr, "cooperative launch failed: %s (grid %d)\n", hipGetErrorString(e), grid_blocks);
}
#endif
```
